# Optimizing an MI355X kernel written in HIP

```python
import math
import jax, jax.numpy as jnp
from jax import lax
import numpy as np

D_MODEL = 1024
BATCH = 4
SEQ = 4096
DEPTH = 1

D_MIX = D_MODEL
D_POOL = D_MIX // 2
D_SSM = D_MIX - D_POOL
POOL_WINDOWS = (2, 4, 8, 16)
N_POOL_GROUPS = len(POOL_WINDOWS)
POOL_GROUP = D_POOL // N_POOL_GROUPS
SSM_GROUP = 16
N_SSM_GROUPS = D_SSM // SSM_GROUP
SSM_STATE = 64
DT_MIN = 0.001
DT_MAX = 0.1
D_FF = 2816
CONV_WIDTH = 3
EPS = 1e-6

kernel_name = "hybrid_pool_s5_convffn_encoder"


def _rmsnorm(x, g):
    xf = x.astype(jnp.float32)
    inv = lax.rsqrt(jnp.mean(xf * xf, axis=-1, keepdims=True) + EPS)
    return (xf * inv).astype(x.dtype) * g


def _window_bounds(window, length):
    half = window // 2
    t = np.arange(length)
    lo = np.clip(t - half, 0, length)
    hi = np.clip(t + half, 0, length)
    return lo.astype(np.int32), hi.astype(np.int32), (hi - lo).astype(np.float32)


def _pool_mixer(u, pool_w, pool_scale):
    L = u.shape[1]
    outs = []
    for gi, w in enumerate(POOL_WINDOWS):
        ug = u[..., gi * POOL_GROUP:(gi + 1) * POOL_GROUP].astype(jnp.float32)
        cs = jnp.concatenate([jnp.zeros_like(ug[:, :1]), jnp.cumsum(ug, axis=1)], axis=1)
        lo, hi, cnt = _window_bounds(w, L)
        mean = (jnp.take(cs, hi, axis=1) - jnp.take(cs, lo, axis=1)) / cnt[None, :, None]
        pooled = (mean - ug).astype(u.dtype)
        outs.append(jnp.einsum('blc,cd->bld', pooled, pool_w[gi]))
    return jnp.concatenate(outs, axis=-1) * pool_scale


def _cmul(ar, ai, br, bi):
    return ar * br - ai * bi, ar * bi + ai * br


def _scan_combine(e_i, e_j):
    ai_re, ai_im, bi_re, bi_im = e_i
    aj_re, aj_im, bj_re, bj_im = e_j
    a_re, a_im = _cmul(aj_re, aj_im, ai_re, ai_im)
    t_re, t_im = _cmul(aj_re, aj_im, bi_re, bi_im)
    return a_re, a_im, t_re + bj_re, t_im + bj_im


def _s5_direction(u, log_neg_a_re, a_im, log_dt, b_re, b_im, c_re, c_im, reverse):
    L = u.shape[1]
    log_neg_a_re = log_neg_a_re.astype(jnp.float32)
    a_im = a_im.astype(jnp.float32)
    dt = jnp.exp(log_dt.astype(jnp.float32))[:, None]
    a_re = -jnp.exp(log_neg_a_re)
    mag = jnp.exp(a_re * dt)
    ang = a_im * dt
    lam_re, lam_im = mag * jnp.cos(ang), mag * jnp.sin(ang)
    den = a_re * a_re + a_im * a_im
    f_re = ((lam_re - 1.0) * a_re + lam_im * a_im) / den
    f_im = (lam_im * a_re - (lam_re - 1.0) * a_im) / den
    bu_re = jnp.einsum('blgh,gnh->blgn', u, b_re.astype(jnp.float32))
    bu_im = jnp.einsum('blgh,gnh->blgn', u, b_im.astype(jnp.float32))
    in_re, in_im = _cmul(f_re, f_im, bu_re, bu_im)
    shape = (1, L) + lam_re.shape
    lam_re_l = jnp.broadcast_to(lam_re[None, None], shape)
    lam_im_l = jnp.broadcast_to(lam_im[None, None], shape)
    _, _, s_re, s_im = lax.associative_scan(
        _scan_combine, (lam_re_l, lam_im_l, in_re, in_im), reverse=reverse, axis=1)
    return (jnp.einsum('blgn,ghn->blgh', s_re, c_re.astype(jnp.float32))
            - jnp.einsum('blgn,ghn->blgh', s_im, c_im.astype(jnp.float32)))


def _s5_mixer(u, ssm_log_neg_a_re, ssm_a_im, ssm_log_dt, ssm_b_re, ssm_b_im,
              ssm_c_re, ssm_c_im, ssm_d, glu_w, glu_b):
    Bsz, L, _ = u.shape
    uf = u.astype(jnp.float32).reshape(Bsz, L, N_SSM_GROUPS, SSM_GROUP)
    y_fwd = _s5_direction(uf, ssm_log_neg_a_re[0], ssm_a_im[0], ssm_log_dt[0], ssm_b_re[0],
                          ssm_b_im[0], ssm_c_re[0], ssm_c_im[0], reverse=False)
    y_bwd = _s5_direction(uf, ssm_log_neg_a_re[1], ssm_a_im[1], ssm_log_dt[1], ssm_b_re[1],
                          ssm_b_im[1], ssm_c_re[1], ssm_c_im[1], reverse=True)
    y = (y_fwd + y_bwd).reshape(Bsz, L, D_SSM).astype(u.dtype) + ssm_d * u
    z = jax.nn.gelu(y)
    return z * jax.nn.sigmoid(jnp.einsum('bld,de->ble', z, glu_w) + glu_b)


def _dwconv_centred(h, w, b):
    hp = jnp.pad(h, ((0, 0), (1, 1), (0, 0)))
    return hp[:, :-2] * w[0] + hp[:, 1:-1] * w[1] + hp[:, 2:] * w[2] + b


def setup_inputs(seed: int = 0) -> dict:
    key = jax.random.key(seed)
    ks = jax.random.split(key, 24)
    G, N, H = N_SSM_GROUPS, SSM_STATE, SSM_GROUP
    f32 = jnp.float32
    nrm = lambda k, shape, s: (jax.random.normal(k, shape, f32) * s)
    x = jax.random.normal(ks[0], (BATCH, SEQ, D_MODEL), f32)
    norm_mix_g = 1.0 + nrm(ks[1], (D_MODEL,), 0.02)
    w_in = nrm(ks[2], (D_MODEL, D_MIX), D_MODEL ** -0.5)
    pool_w = nrm(ks[3], (N_POOL_GROUPS, POOL_GROUP, POOL_GROUP), POOL_GROUP ** -0.5)
    pool_scale = 1.0 + nrm(ks[4], (D_POOL,), 0.02)
    ssm_log_neg_a_re = math.log(0.5) + nrm(ks[5], (2, G, N), 0.01)
    ssm_a_im = math.pi * jnp.arange(N, dtype=f32)[None, None, :] + nrm(ks[6], (2, G, N), 0.01)
    ssm_log_dt = jax.random.uniform(ks[7], (2, G), f32, math.log(DT_MIN), math.log(DT_MAX))
    ssm_b_re = nrm(ks[8], (2, G, N, H), (2.0 * H) ** -0.5)
    ssm_b_im = nrm(ks[9], (2, G, N, H), (2.0 * H) ** -0.5)
    ssm_c_re = nrm(ks[10], (2, G, H, N), (2.0 * N) ** -0.5)
    ssm_c_im = nrm(ks[11], (2, G, H, N), (2.0 * N) ** -0.5)
    ssm_d = nrm(ks[12], (D_SSM,), 1.0)
    glu_w = nrm(ks[13], (D_SSM, D_SSM), D_SSM ** -0.5)
    glu_b = nrm(ks[14], (D_SSM,), 0.01)
    out_norm_pool_g = 1.0 + nrm(ks[15], (D_POOL,), 0.02)
    out_norm_ssm_g = 1.0 + nrm(ks[16], (D_SSM,), 0.02)
    w_out = nrm(ks[17], (D_MIX, D_MODEL), D_MIX ** -0.5)
    norm_ffn_g = 1.0 + nrm(ks[18], (D_MODEL,), 0.02)
    w_up = nrm(ks[19], (D_MODEL, 2 * D_FF), D_MODEL ** -0.5)
    conv_w = nrm(ks[20], (CONV_WIDTH, 2 * D_FF), CONV_WIDTH ** -0.5)
    conv_b = nrm(ks[21], (2 * D_FF,), 0.01)
    w_down = nrm(ks[22], (D_FF, D_MODEL), D_FF ** -0.5)
    final_norm_g = 1.0 + nrm(ks[23], (D_MODEL,), 0.02)
    return {"x": x, "norm_mix_g": norm_mix_g, "w_in": w_in, "pool_w": pool_w,
            "pool_scale": pool_scale, "ssm_log_neg_a_re": ssm_log_neg_a_re, "ssm_a_im": ssm_a_im,
            "ssm_log_dt": ssm_log_dt, "ssm_b_re": ssm_b_re, "ssm_b_im": ssm_b_im,
            "ssm_c_re": ssm_c_re, "ssm_c_im": ssm_c_im, "ssm_d": ssm_d, "glu_w": glu_w,
            "glu_b": glu_b, "out_norm_pool_g": out_norm_pool_g, "out_norm_ssm_g": out_norm_ssm_g,
            "w_out": w_out, "norm_ffn_g": norm_ffn_g, "w_up": w_up, "conv_w": conv_w,
            "conv_b": conv_b, "w_down": w_down, "final_norm_g": final_norm_g}


def reference(x, norm_mix_g, w_in, pool_w, pool_scale, ssm_log_neg_a_re, ssm_a_im, ssm_log_dt,
              ssm_b_re, ssm_b_im, ssm_c_re, ssm_c_im, ssm_d, glu_w, glu_b, out_norm_pool_g,
              out_norm_ssm_g, w_out, norm_ffn_g, w_up, conv_w, conv_b, w_down, final_norm_g):
    h = x
    for _ in range(DEPTH):
        u = jnp.einsum('bld,de->ble', _rmsnorm(h, norm_mix_g), w_in)
        u_pool, u_ssm = u[..., :D_POOL], u[..., D_POOL:]
        y_pool = _pool_mixer(u_pool, pool_w, pool_scale)
        y_ssm = _s5_mixer(u_ssm, ssm_log_neg_a_re, ssm_a_im, ssm_log_dt, ssm_b_re, ssm_b_im,
                          ssm_c_re, ssm_c_im, ssm_d, glu_w, glu_b)
        y = jnp.concatenate([_rmsnorm(y_pool, out_norm_pool_g),
                             _rmsnorm(y_ssm, out_norm_ssm_g)], axis=-1)
        h = h + jnp.einsum('ble,ed->bld', y, w_out)
        up = jnp.einsum('bld,df->blf', _rmsnorm(h, norm_ffn_g), w_up)
        up = _dwconv_centred(up, conv_w, conv_b)
        val, gate = up[..., :D_FF], up[..., D_FF:]
        h = h + jnp.einsum('blf,fd->bld', val * jax.nn.silu(gate), w_down)
    return _rmsnorm(h, final_norm_g)
```

```cpp
#include <hip/hip_runtime.h>
#include <math.h>

constexpr int BATCH = 4, SEQ = 4096, DM = 1024, MT = BATCH * SEQ;
constexpr int DPOOL = 512, DSSM = 512, NG = 32, NH = 16, NS = 64;
constexpr int DFF = 2816, DFF2 = 5632;
constexpr float EPS = 1e-6f;

__global__ void k_rmsnorm(const float* x, int ldx, const float* __restrict__ pre,
                          const float* __restrict__ g, float* out, int ldo, int D, int rows) {
    const int wave = (blockIdx.x * blockDim.x + threadIdx.x) >> 6, lane = threadIdx.x & 63;
    if (wave >= rows) return;
    const float* xr = x + (size_t)wave * ldx;
    float ss = 0.f;
    for (int c = lane; c < D; c += 64) { float v = xr[c]; if (pre) v *= pre[c]; ss += v * v; }
    for (int o = 32; o; o >>= 1) ss += __shfl_xor(ss, o);
    const float inv = rsqrtf(ss / (float)D + EPS);
    float* orow = out + (size_t)wave * ldo;
    for (int c = lane; c < D; c += 64) { float v = xr[c]; if (pre) v *= pre[c]; orow[c] = v * inv * g[c]; }
}

__global__ void __launch_bounds__(256) k_gemm(const float* __restrict__ A, int lda, const float* __restrict__ B, int ldb,
                                               float* C, int ldc, const float* R, int ldr, int K) {
    __shared__ float As[16][132];
    __shared__ float Bs[16][132];
    const int tid = threadIdx.x, tx = tid & 15, ty = tid >> 4;
    const int row0 = blockIdx.y * 128, col0 = blockIdx.x * 128;
    float acc[8][8];
#pragma unroll
    for (int i = 0; i < 8; ++i)
#pragma unroll
        for (int j = 0; j < 8; ++j) acc[i][j] = 0.f;
    for (int k0 = 0; k0 < K; k0 += 16) {
#pragma unroll
        for (int p = 0; p < 2; ++p) {
            const int i = tid + p * 256, r = i >> 2, kk = (i & 3) * 4;
            const float4 v = *(const float4*)(A + (size_t)(row0 + r) * lda + k0 + kk);
            As[kk + 0][r] = v.x; As[kk + 1][r] = v.y; As[kk + 2][r] = v.z; As[kk + 3][r] = v.w;
        }
#pragma unroll
        for (int p = 0; p < 2; ++p) {
            const int i = tid + p * 256, kk = i >> 5, c = (i & 31) * 4;
            const float4 v = *(const float4*)(B + (size_t)(k0 + kk) * ldb + col0 + c);
            *(float4*)&Bs[kk][c] = v;
        }
        __syncthreads();
#pragma unroll
        for (int kk = 0; kk < 16; ++kk) {
            float a[8], b[8];
            const float4 a0 = *(const float4*)&As[kk][ty * 4], a1 = *(const float4*)&As[kk][64 + ty * 4];
            const float4 b0 = *(const float4*)&Bs[kk][tx * 4], b1 = *(const float4*)&Bs[kk][64 + tx * 4];
            a[0] = a0.x; a[1] = a0.y; a[2] = a0.z; a[3] = a0.w; a[4] = a1.x; a[5] = a1.y; a[6] = a1.z; a[7] = a1.w;
            b[0] = b0.x; b[1] = b0.y; b[2] = b0.z; b[3] = b0.w; b[4] = b1.x; b[5] = b1.y; b[6] = b1.z; b[7] = b1.w;
#pragma unroll
            for (int i = 0; i < 8; ++i)
#pragma unroll
                for (int j = 0; j < 8; ++j) acc[i][j] = fmaf(a[i], b[j], acc[i][j]);
        }
        __syncthreads();
    }
#pragma unroll
    for (int i = 0; i < 8; ++i) {
        const int r = row0 + (i < 4 ? ty * 4 + i : 64 + ty * 4 + (i - 4));
#pragma unroll
        for (int jh = 0; jh < 2; ++jh) {
            const int c = col0 + jh * 64 + tx * 4;
            float4 v = make_float4(acc[i][jh * 4 + 0], acc[i][jh * 4 + 1], acc[i][jh * 4 + 2], acc[i][jh * 4 + 3]);
            if (R) { const float4 rr = *(const float4*)(R + (size_t)r * ldr + c); v.x += rr.x; v.y += rr.y; v.z += rr.z; v.w += rr.w; }
            *(float4*)(C + (size_t)r * ldc + c) = v;
        }
    }
}

__global__ void k_pool(const float* __restrict__ u  , float* __restrict__ pooled  ) {
    const int idx = blockIdx.x * blockDim.x + threadIdx.x;
    if (idx >= MT * DPOOL) return;
    const int c = idx % DPOOL, row = idx / DPOOL, b = row / SEQ, t = row % SEQ;
    const int gi = c / 128, w = 2 << gi, half = w / 2;
    int lo = t - half, hi = t + half; if (lo < 0) lo = 0; if (hi > SEQ) hi = SEQ;
    float s = 0.f;
    for (int q = lo; q < hi; ++q) s += u[(size_t)(b * SEQ + q) * DM + c];
    pooled[idx] = s / (float)(hi - lo) - u[(size_t)row * DM + c];
}

__global__ void __launch_bounds__(64) k_ssm_scan(const float* __restrict__ u  ,
        const float* __restrict__ lnar, const float* __restrict__ aim, const float* __restrict__ ldt,
        const float* __restrict__ bre, const float* __restrict__ bim, const float* __restrict__ cre, const float* __restrict__ cim,
        float* __restrict__ y  ) {
    const int n = threadIdx.x;
    const int g = blockIdx.x % NG, b = (blockIdx.x / NG) % BATCH, dir = blockIdx.x / (NG * BATCH);
    const float dt = expf(ldt[dir * NG + g]);
    const float a_re = -expf(lnar[(dir * NG + g) * NS + n]), a_im = aim[(dir * NG + g) * NS + n];
    const float mag = expf(a_re * dt), ang = a_im * dt;
    const float lam_re = mag * cosf(ang), lam_im = mag * sinf(ang);
    const float den = a_re * a_re + a_im * a_im;
    const float f_re = ((lam_re - 1.0f) * a_re + lam_im * a_im) / den;
    const float f_im = (lam_im * a_re - (lam_re - 1.0f) * a_im) / den;
    float Br[NH], Bi[NH], Cr[NH], Ci[NH];
#pragma unroll
    for (int h = 0; h < NH; ++h) {
        Br[h] = bre[((size_t)(dir * NG + g) * NS + n) * NH + h];
        Bi[h] = bim[((size_t)(dir * NG + g) * NS + n) * NH + h];
        Cr[h] = cre[((size_t)(dir * NG + g) * NH + h) * NS + n];
        Ci[h] = cim[((size_t)(dir * NG + g) * NH + h) * NS + n];
    }
    float s_re = 0.f, s_im = 0.f;
    float* yd = y + (size_t)dir * MT * DSSM;
    for (int i = 0; i < SEQ; ++i) {
        const int t = dir ? (SEQ - 1 - i) : i;
        const float* ur = u + (size_t)(b * SEQ + t) * DM + DPOOL + g * NH;
        float bu_re = 0.f, bu_im = 0.f;
#pragma unroll
        for (int h = 0; h < NH; ++h) { const float uv = ur[h]; bu_re = fmaf(Br[h], uv, bu_re); bu_im = fmaf(Bi[h], uv, bu_im); }
        const float in_re = f_re * bu_re - f_im * bu_im, in_im = f_re * bu_im + f_im * bu_re;
        const float nr = lam_re * s_re - lam_im * s_im + in_re;
        const float ni = lam_re * s_im + lam_im * s_re + in_im;
        s_re = nr; s_im = ni;
        float mine = 0.f;
#pragma unroll
        for (int h = 0; h < NH; ++h) {
            float p = Cr[h] * s_re - Ci[h] * s_im;
#pragma unroll
            for (int o = 32; o; o >>= 1) p += __shfl_xor(p, o);
            if (n == h) mine = p;
        }
        if (n < NH) yd[(size_t)(b * SEQ + t) * DSSM + g * NH + n] = mine;
    }
}

__device__ __forceinline__ float gelu_tanh(float x) {
    const float k = 0.7978845608028654f;
    return 0.5f * x * (1.0f + tanhf(k * (x + 0.044715f * x * x * x)));
}
__device__ __forceinline__ float sigmoidf_(float x) { return 1.0f / (1.0f + expf(-x)); }

__global__ void k_ssm_post(const float* __restrict__ y2, const float* __restrict__ u, const float* __restrict__ d, float* __restrict__ z) {
    const int idx = blockIdx.x * blockDim.x + threadIdx.x;
    if (idx >= MT * DSSM) return;
    const int c = idx % DSSM, row = idx / DSSM;
    const float yv = y2[idx] + y2[(size_t)MT * DSSM + idx] + d[c] * u[(size_t)row * DM + DPOOL + c];
    z[idx] = gelu_tanh(yv);
}
__global__ void k_glu(const float* __restrict__ z, float* __restrict__ pre, const float* __restrict__ gb) {
    const int idx = blockIdx.x * blockDim.x + threadIdx.x;
    if (idx >= MT * DSSM) return;
    const int c = idx % DSSM;
    pre[idx] = z[idx] * sigmoidf_(pre[idx] + gb[c]);
}
__global__ void k_convact(const float* __restrict__ up  , const float* __restrict__ cw, const float* __restrict__ cb, float* __restrict__ act  ) {
    const int idx = blockIdx.x * blockDim.x + threadIdx.x;
    if (idx >= SEQ * DFF) return;
    const int f = idx % DFF, t = idx / DFF;
    float v = cb[f], gt = cb[DFF + f];
#pragma unroll
    for (int k = 0; k < 3; ++k) {
        const int q = t + k - 1;
        if (q >= 0 && q < SEQ) {
            v = fmaf(up[(size_t)q * DFF2 + f], cw[k * DFF2 + f], v);
            gt = fmaf(up[(size_t)q * DFF2 + DFF + f], cw[k * DFF2 + DFF + f], gt);
        }
    }
    act[idx] = v * (gt * sigmoidf_(gt));
}

static void gemm(hipStream_t s, const float* A, int lda, const float* B, int ldb, float* C, int ldc, const float* R, int ldr, int M, int N, int K) {
    hipLaunchKernelGGL(k_gemm, dim3(N / 128, M / 128), dim3(256), 0, s, A, lda, B, ldb, C, ldc, R, ldr, K);
}

extern "C" void kernel_launch(void* const* d_in, const int* in_sizes, int n_in, void* d_out, int out_size, void* d_ws, size_t ws_size, hipStream_t stream) {
    const float* x = (const float*)d_in[0];        const float* norm_mix_g = (const float*)d_in[1];
    const float* w_in = (const float*)d_in[2];     const float* pool_w = (const float*)d_in[3];
    const float* pool_scale = (const float*)d_in[4];
    const float* lnar = (const float*)d_in[5];     const float* aim = (const float*)d_in[6];   const float* ldt = (const float*)d_in[7];
    const float* bre = (const float*)d_in[8];      const float* bim = (const float*)d_in[9];
    const float* cre = (const float*)d_in[10];     const float* cim = (const float*)d_in[11];
    const float* ssm_d = (const float*)d_in[12];   const float* glu_w = (const float*)d_in[13]; const float* glu_b = (const float*)d_in[14];
    const float* g_pool = (const float*)d_in[15];  const float* g_ssm = (const float*)d_in[16];
    const float* w_out = (const float*)d_in[17];   const float* g_ffn = (const float*)d_in[18];
    const float* w_up = (const float*)d_in[19];    const float* conv_w = (const float*)d_in[20]; const float* conv_b = (const float*)d_in[21];
    const float* w_down = (const float*)d_in[22];  const float* g_final = (const float*)d_in[23];
    float* out = (float*)d_out;
    char* ws = (char*)d_ws;
    const size_t MiB = 1u << 20;
    float* bufA = (float*)(ws + 0 * MiB);
    float* bufB = (float*)(ws + 64 * MiB);
    float* bufC = (float*)(ws + 128 * MiB);
    float* bufD = (float*)(ws + 192 * MiB);
    const int EB = 256;

    hipLaunchKernelGGL(k_rmsnorm, dim3(MT / 4), dim3(256), 0, stream, x, DM, (const float*)nullptr, norm_mix_g, bufA, DM, DM, MT);
    gemm(stream, bufA, DM, w_in, DM, bufB, DM, nullptr, 0, MT, DM, DM);
    float* u = bufB;
    float* pooled = bufA; float* ypool = bufA + (size_t)MT * DPOOL;
    hipLaunchKernelGGL(k_pool, dim3(MT * DPOOL / EB), dim3(EB), 0, stream, u, pooled);
    for (int gi = 0; gi < 4; ++gi)
        gemm(stream, pooled + gi * 128, DPOOL, pool_w + (size_t)gi * 128 * 128, 128, ypool + gi * 128, DPOOL, nullptr, 0, MT, 128, 128);
    float* y2 = bufC;
    hipLaunchKernelGGL(k_ssm_scan, dim3(2 * BATCH * NG), dim3(64), 0, stream, u, lnar, aim, ldt, bre, bim, cre, cim, y2);
    float* z = pooled;
    hipLaunchKernelGGL(k_ssm_post, dim3(MT * DSSM / EB), dim3(EB), 0, stream, y2, u, ssm_d, z);
    float* pre = bufD;
    gemm(stream, z, DSSM, glu_w, DSSM, pre, DSSM, nullptr, 0, MT, DSSM, DSSM);
    hipLaunchKernelGGL(k_glu, dim3(MT * DSSM / EB), dim3(EB), 0, stream, z, pre, glu_b);
    float* ycat = bufB;
    hipLaunchKernelGGL(k_rmsnorm, dim3(MT / 4), dim3(256), 0, stream, ypool, DPOOL, pool_scale, g_pool, ycat, DM, DPOOL, MT);
    hipLaunchKernelGGL(k_rmsnorm, dim3(MT / 4), dim3(256), 0, stream, pre, DSSM, (const float*)nullptr, g_ssm, ycat + DPOOL, DM, DSSM, MT);
    gemm(stream, ycat, DM, w_out, DM, out, DM, x, DM, MT, DM, DM);
    float* xn2 = bufA;
    hipLaunchKernelGGL(k_rmsnorm, dim3(MT / 4), dim3(256), 0, stream, out, DM, (const float*)nullptr, g_ffn, xn2, DM, DM, MT);
    float* up = (float*)(ws + 64 * MiB);
    float* act = (float*)(ws + 152 * MiB);
    for (int b = 0; b < BATCH; ++b) {
        gemm(stream, xn2 + (size_t)b * SEQ * DM, DM, w_up, DFF2, up, DFF2, nullptr, 0, SEQ, DFF2, DM);
        hipLaunchKernelGGL(k_convact, dim3(SEQ * DFF / EB), dim3(EB), 0, stream, up, conv_w, conv_b, act);
        gemm(stream, act, DFF, w_down, DM, out + (size_t)b * SEQ * DM, DM, out + (size_t)b * SEQ * DM, DM, SEQ, DM, DFF);
    }
    hipLaunchKernelGGL(k_rmsnorm, dim3(MT / 4), dim3(256), 0, stream, out, DM, (const float*)nullptr, g_final, out, DM, DM, MT);
}
```

```cpp
#define MK_CUT 8
#include <hip/hip_runtime.h>
#include <math.h>

constexpr int BATCH = 4, SEQ = 4096, DM = 1024, MT = BATCH * SEQ;
constexpr int DPOOL = 512, DSSM = 512, NG = 32, NH = 16, NS = 64;
constexpr int DFF = 2816, DFF2 = 5632;
constexpr float EPS = 1e-6f;

__global__ void k_rmsnorm(const float* x, int ldx, const float* __restrict__ pre,
                          const float* __restrict__ g, float* out, int ldo, int D, int rows) {
    const int wave = (blockIdx.x * blockDim.x + threadIdx.x) >> 6, lane = threadIdx.x & 63;
    if (wave >= rows) return;
    const float* xr = x + (size_t)wave * ldx;
    float ss = 0.f;
    for (int c = lane; c < D; c += 64) { float v = xr[c]; if (pre) v *= pre[c]; ss += v * v; }
    for (int o = 32; o; o >>= 1) ss += __shfl_xor(ss, o);
    const float inv = rsqrtf(ss / (float)D + EPS);
    float* orow = out + (size_t)wave * ldo;
    for (int c = lane; c < D; c += 64) { float v = xr[c]; if (pre) v *= pre[c]; orow[c] = v * inv * g[c]; }
}

__global__ void __launch_bounds__(256) k_gemm(const float* __restrict__ A, int lda, const float* __restrict__ B, int ldb,
                                               float* C, int ldc, const float* R, int ldr, int K) {
    __shared__ float As[16][132];
    __shared__ float Bs[16][132];
    const int tid = threadIdx.x, tx = tid & 15, ty = tid >> 4;
    const int row0 = blockIdx.y * 128, col0 = blockIdx.x * 128;
    float acc[8][8];
#pragma unroll
    for (int i = 0; i < 8; ++i)
#pragma unroll
        for (int j = 0; j < 8; ++j) acc[i][j] = 0.f;
    for (int k0 = 0; k0 < K; k0 += 16) {
#pragma unroll
        for (int p = 0; p < 2; ++p) {
            const int i = tid + p * 256, r = i >> 2, kk = (i & 3) * 4;
            const float4 v = *(const float4*)(A + (size_t)(row0 + r) * lda + k0 + kk);
            As[kk + 0][r] = v.x; As[kk + 1][r] = v.y; As[kk + 2][r] = v.z; As[kk + 3][r] = v.w;
        }
#pragma unroll
        for (int p = 0; p < 2; ++p) {
            const int i = tid + p * 256, kk = i >> 5, c = (i & 31) * 4;
            const float4 v = *(const float4*)(B + (size_t)(k0 + kk) * ldb + col0 + c);
            *(float4*)&Bs[kk][c] = v;
        }
        __syncthreads();
#pragma unroll
        for (int kk = 0; kk < 16; ++kk) {
            float a[8], b[8];
            const float4 a0 = *(const float4*)&As[kk][ty * 4], a1 = *(const float4*)&As[kk][64 + ty * 4];
            const float4 b0 = *(const float4*)&Bs[kk][tx * 4], b1 = *(const float4*)&Bs[kk][64 + tx * 4];
            a[0] = a0.x; a[1] = a0.y; a[2] = a0.z; a[3] = a0.w; a[4] = a1.x; a[5] = a1.y; a[6] = a1.z; a[7] = a1.w;
            b[0] = b0.x; b[1] = b0.y; b[2] = b0.z; b[3] = b0.w; b[4] = b1.x; b[5] = b1.y; b[6] = b1.z; b[7] = b1.w;
#pragma unroll
            for (int i = 0; i < 8; ++i)
#pragma unroll
                for (int j = 0; j < 8; ++j) acc[i][j] = fmaf(a[i], b[j], acc[i][j]);
        }
        __syncthreads();
    }
#pragma unroll
    for (int i = 0; i < 8; ++i) {
        const int r = row0 + (i < 4 ? ty * 4 + i : 64 + ty * 4 + (i - 4));
#pragma unroll
        for (int jh = 0; jh < 2; ++jh) {
            const int c = col0 + jh * 64 + tx * 4;
            float4 v = make_float4(acc[i][jh * 4 + 0], acc[i][jh * 4 + 1], acc[i][jh * 4 + 2], acc[i][jh * 4 + 3]);
            if (R) { const float4 rr = *(const float4*)(R + (size_t)r * ldr + c); v.x += rr.x; v.y += rr.y; v.z += rr.z; v.w += rr.w; }
            *(float4*)(C + (size_t)r * ldc + c) = v;
        }
    }
}

__global__ void k_pool(const float* __restrict__ u  , float* __restrict__ pooled  ) {
    const int idx = blockIdx.x * blockDim.x + threadIdx.x;
    if (idx >= MT * DPOOL) return;
    const int c = idx % DPOOL, row = idx / DPOOL, b = row / SEQ, t = row % SEQ;
    const int gi = c / 128, w = 2 << gi, half = w / 2;
    int lo = t - half, hi = t + half; if (lo < 0) lo = 0; if (hi > SEQ) hi = SEQ;
    float s = 0.f;
    for (int q = lo; q < hi; ++q) s += u[(size_t)(b * SEQ + q) * DM + c];
    pooled[idx] = s / (float)(hi - lo) - u[(size_t)row * DM + c];
}

__global__ void __launch_bounds__(64) k_ssm_scan(const float* __restrict__ u  ,
        const float* __restrict__ lnar, const float* __restrict__ aim, const float* __restrict__ ldt,
        const float* __restrict__ bre, const float* __restrict__ bim, const float* __restrict__ cre, const float* __restrict__ cim,
        float* __restrict__ y  ) {
    const int n = threadIdx.x;
    const int g = blockIdx.x % NG, b = (blockIdx.x / NG) % BATCH, dir = blockIdx.x / (NG * BATCH);
    const float dt = expf(ldt[dir * NG + g]);
    const float a_re = -expf(lnar[(dir * NG + g) * NS + n]), a_im = aim[(dir * NG + g) * NS + n];
    const float mag = expf(a_re * dt), ang = a_im * dt;
    const float lam_re = mag * cosf(ang), lam_im = mag * sinf(ang);
    const float den = a_re * a_re + a_im * a_im;
    const float f_re = ((lam_re - 1.0f) * a_re + lam_im * a_im) / den;
    const float f_im = (lam_im * a_re - (lam_re - 1.0f) * a_im) / den;
    float Br[NH], Bi[NH], Cr[NH], Ci[NH];
#pragma unroll
    for (int h = 0; h < NH; ++h) {
        Br[h] = bre[((size_t)(dir * NG + g) * NS + n) * NH + h];
        Bi[h] = bim[((size_t)(dir * NG + g) * NS + n) * NH + h];
        Cr[h] = cre[((size_t)(dir * NG + g) * NH + h) * NS + n];
        Ci[h] = cim[((size_t)(dir * NG + g) * NH + h) * NS + n];
    }
    float s_re = 0.f, s_im = 0.f;
    float* yd = y + (size_t)dir * MT * DSSM;
    for (int i = 0; i < SEQ; ++i) {
        const int t = dir ? (SEQ - 1 - i) : i;
        const float* ur = u + (size_t)(b * SEQ + t) * DM + DPOOL + g * NH;
        float bu_re = 0.f, bu_im = 0.f;
#pragma unroll
        for (int h = 0; h < NH; ++h) { const float uv = ur[h]; bu_re = fmaf(Br[h], uv, bu_re); bu_im = fmaf(Bi[h], uv, bu_im); }
        const float in_re = f_re * bu_re - f_im * bu_im, in_im = f_re * bu_im + f_im * bu_re;
        const float nr = lam_re * s_re - lam_im * s_im + in_re;
        const float ni = lam_re * s_im + lam_im * s_re + in_im;
        s_re = nr; s_im = ni;
        float mine = 0.f;
#pragma unroll
        for (int h = 0; h < NH; ++h) {
            float p = Cr[h] * s_re - Ci[h] * s_im;
#pragma unroll
            for (int o = 32; o; o >>= 1) p += __shfl_xor(p, o);
            if (n == h) mine = p;
        }
        if (n < NH) yd[(size_t)(b * SEQ + t) * DSSM + g * NH + n] = mine;
    }
}

__device__ __forceinline__ float gelu_tanh(float x) {
    const float k = 0.7978845608028654f;
    return 0.5f * x * (1.0f + tanhf(k * (x + 0.044715f * x * x * x)));
}
__device__ __forceinline__ float sigmoidf_(float x) { return 1.0f / (1.0f + expf(-x)); }

__global__ void k_ssm_post(const float* __restrict__ y2, const float* __restrict__ u, const float* __restrict__ d, float* __restrict__ z) {
    const int idx = blockIdx.x * blockDim.x + threadIdx.x;
    if (idx >= MT * DSSM) return;
    const int c = idx % DSSM, row = idx / DSSM;
    const float yv = y2[idx] + y2[(size_t)MT * DSSM + idx] + d[c] * u[(size_t)row * DM + DPOOL + c];
    z[idx] = gelu_tanh(yv);
}
__global__ void k_glu(const float* __restrict__ z, float* __restrict__ pre, const float* __restrict__ gb) {
    const int idx = blockIdx.x * blockDim.x + threadIdx.x;
    if (idx >= MT * DSSM) return;
    const int c = idx % DSSM;
    pre[idx] = z[idx] * sigmoidf_(pre[idx] + gb[c]);
}
__global__ void k_convact(const float* __restrict__ up  , const float* __restrict__ cw, const float* __restrict__ cb, float* __restrict__ act  ) {
    const int idx = blockIdx.x * blockDim.x + threadIdx.x;
    if (idx >= SEQ * DFF) return;
    const int f = idx % DFF, t = idx / DFF;
    float v = cb[f], gt = cb[DFF + f];
#pragma unroll
    for (int k = 0; k < 3; ++k) {
        const int q = t + k - 1;
        if (q >= 0 && q < SEQ) {
            v = fmaf(up[(size_t)q * DFF2 + f], cw[k * DFF2 + f], v);
            gt = fmaf(up[(size_t)q * DFF2 + DFF + f], cw[k * DFF2 + DFF + f], gt);
        }
    }
    act[idx] = v * (gt * sigmoidf_(gt));
}


#include <cstdio>
#include <cstdint>
#define LAS __attribute__((address_space(3)))
#define GAS __attribute__((address_space(1)))
typedef unsigned short bf16_t;
typedef short bf16x8 __attribute__((ext_vector_type(8)));
typedef float f32x4 __attribute__((ext_vector_type(4)));
typedef float f32x2 __attribute__((ext_vector_type(2)));
typedef unsigned u32x4 __attribute__((ext_vector_type(4)));
typedef unsigned u32x2 __attribute__((ext_vector_type(2)));

namespace mk {
constexpr int TCH = 32;
constexpr int K1 = 16 * TCH;
constexpr int ROWLEN = K1 + 256;
constexpr int NCR = MT / TCH;
constexpr int NCHB = SEQ / TCH;
constexpr int PADROWS = 4352;
constexpr int UPT = 17;
constexpr int UPROWS = 252;

constexpr size_t MiB = 1u << 20;
constexpr size_t WS_CTL = 0, CTL_ZERO_BYTES = 64 * 1024;
constexpr size_t WS_R0 = 1 * MiB;
constexpr size_t WS_SSPOOL = 2 * MiB;
constexpr size_t WS_SSSSM = WS_SSPOOL + 8 * MT * 4;
constexpr size_t WS_SSH1 = WS_SSSSM + 8 * MT * 4;
constexpr size_t WS_SSH2 = WS_SSH1 + 4 * MT * 4;
constexpr size_t WS_WIN = 8 * MiB, WS_WOUT = 10 * MiB, WS_WGLU = 12 * MiB, WS_PW = 12 * MiB + 512 * 1024;
constexpr size_t WS_WUP = 13 * MiB, WS_WDOWN = 24 * MiB;
constexpr size_t WS_WAB = 30 * MiB;
constexpr size_t WS_TB = 38 * MiB;
constexpr size_t WS_H1B = 62 * MiB;
constexpr size_t WS_XB = 96 * MiB;
constexpr size_t WS_YCAT = 96 * MiB;
constexpr size_t WS_UPOOL = 128 * MiB;
constexpr size_t WS_USSM = 144 * MiB;
constexpr size_t WS_FG = 168 * MiB;
constexpr size_t WS_POOLED = 184 * MiB;
constexpr size_t WS_ZG = 200 * MiB;
constexpr size_t WS_ACT = 96 * MiB;
constexpr size_t WS_END = 216 * MiB;

constexpr int RING_BYTES = 131072, XTRA_OFF = RING_BYTES, XTRA_BYTES = 12288, LDSCTL_OFF = XTRA_OFF + XTRA_BYTES, LDS_BYTES = 147456;

__device__ __forceinline__ unsigned f2bf(float f) { unsigned u = __builtin_bit_cast(unsigned, f); return (u + 0x7fffu + ((u >> 16) & 1u)) >> 16; }
__device__ __forceinline__ unsigned pk2(float lo, float hi) { return f2bf(lo) | (f2bf(hi) << 16); }
__device__ __forceinline__ unsigned cvt_pk_bf16(float lo, float hi) { unsigned r; asm volatile("v_cvt_pk_bf16_f32 %0, %1, %2" : "=v"(r) : "v"(lo), "v"(hi)); return r; }
__device__ __forceinline__ u32x4 pack8(f32x4 a, f32x4 b) { u32x4 w; w.x = cvt_pk_bf16(a[0], a[1]); w.y = cvt_pk_bf16(a[2], a[3]); w.z = cvt_pk_bf16(b[0], b[1]); w.w = cvt_pk_bf16(b[2], b[3]); return w; }
__device__ __forceinline__ u32x2 pack4(f32x4 a) { u32x2 w; w.x = cvt_pk_bf16(a[0], a[1]); w.y = cvt_pk_bf16(a[2], a[3]); return w; }
__device__ __forceinline__ float bflo(unsigned w) { return __builtin_bit_cast(float, w << 16); }
__device__ __forceinline__ float bfhi(unsigned w) { return __builtin_bit_cast(float, w & 0xffff0000u); }
__device__ __forceinline__ void unpack8(u32x4 w, f32x4& a, f32x4& b) { a[0] = bflo(w.x); a[1] = bfhi(w.x); a[2] = bflo(w.y); a[3] = bfhi(w.y); b[0] = bflo(w.z); b[1] = bfhi(w.z); b[2] = bflo(w.w); b[3] = bfhi(w.w); }
__device__ __forceinline__ float fast_sigmoid(float x) { return __builtin_amdgcn_rcpf(1.0f + __builtin_amdgcn_exp2f(-1.4426950408889634f * x)); }
__device__ __forceinline__ float fast_gelu_tanh(float x) {
    const float t = x * (1.0f + 0.044715f * x * x);
    return x * __builtin_amdgcn_rcpf(1.0f + __builtin_amdgcn_exp2f(-2.0f * 0.7978845608028654f * 1.4426950408889634f * t));
}
__device__ __forceinline__ float wave_sum(float v) {
#pragma unroll
    for (int o = 1; o < 64; o <<= 1) v += __shfl_xor(v, o);
    return v;
}
__device__ __forceinline__ float dpp_ror1(float v)  { return __builtin_bit_cast(float, __builtin_amdgcn_update_dpp(0, __builtin_bit_cast(int, v), 0x121, 0xf, 0xf, false)); }
__device__ __forceinline__ float dpp_ror15(float v) { return __builtin_bit_cast(float, __builtin_amdgcn_update_dpp(0, __builtin_bit_cast(int, v), 0x12F, 0xf, 0xf, false)); }
#define LDS_WAIT() asm volatile("s_waitcnt lgkmcnt(0)" ::: "memory")
#define VM_WAIT() asm volatile("s_waitcnt vmcnt(0)" ::: "memory")

#define XB_TMO      128
#define XB_XCNT(j)  (256  + 64 * (j))
#define XB_XSUB(j)  (1280 + 64 * (j))
#define XB_XGEN(j)  (2304 + 64 * (j))
#define XB_TOP      3328
#define XB_TOPGEN   3392
#define XCD_BAR_WORDS 3456
#define XB_SPIN_CAP (1u << 18)
__device__ __forceinline__ unsigned xb_ld(unsigned* p)              { return __hip_atomic_load(p, __ATOMIC_RELAXED, __HIP_MEMORY_SCOPE_AGENT); }
__device__ __forceinline__ unsigned xb_add(unsigned* p, unsigned v) { return __hip_atomic_fetch_add(p, v, __ATOMIC_RELAXED, __HIP_MEMORY_SCOPE_AGENT); }
__device__ __forceinline__ unsigned xb_xcc_id() { return (unsigned)__builtin_amdgcn_s_getreg((3 << 11) | 20) & 0xFu; }
#define XB_SPIN(cond, bar) do { unsigned _sp = 0; while (cond) { __builtin_amdgcn_s_sleep(1); \
    if ((++_sp & 255u) == 0u) { if (xb_ld(&(bar)[XB_TMO])) break; if (_sp > XB_SPIN_CAP) { atomicAdd(&(bar)[XB_TMO], 1u); break; } } } } while (0)
struct XcdBarrier { unsigned* bar; unsigned x; volatile LAS unsigned* st; };
__device__ __forceinline__ XcdBarrier xcd_barrier_post(unsigned* bar, volatile LAS unsigned* st) {
    XcdBarrier b; b.bar = bar; b.x = xb_xcc_id(); b.st = st;
    if (threadIdx.x == 0) (void)xb_add(&bar[XB_XCNT(b.x)], 1u);
    return b;
}
__device__ __forceinline__ void xcd_barrier_complete(unsigned* bar, unsigned x, unsigned& nloc, unsigned& nx) {
    const unsigned G = gridDim.x * gridDim.y * gridDim.z;
    unsigned sum, cnt, mine, sp = 0u;
    for (;;) {
        sum = 0u; cnt = 0u; mine = 0u;
#pragma unroll
        for (unsigned j = 0; j < 16; ++j) { const unsigned c = xb_ld(&bar[XB_XCNT(j)]); sum += c; cnt += (c > 0u) ? 1u : 0u; mine = (j == x) ? c : mine; }
        if (sum == G) break;
        __builtin_amdgcn_s_sleep(1);
        if ((++sp & 255u) == 0u) { if (xb_ld(&bar[XB_TMO])) break; if (sp > XB_SPIN_CAP) { atomicAdd(&bar[XB_TMO], 1u); break; } }
    }
    nloc = mine > 0u ? mine : 1u; nx = cnt > 0u ? cnt : 1u;
}
__device__ __forceinline__ void xcd_barrier(const XcdBarrier& b) {
    asm volatile("s_waitcnt vmcnt(0)" ::: "memory");
    __syncthreads();
    if (threadIdx.x == 0) {
        unsigned* bar = b.bar;
        __builtin_amdgcn_s_waitcnt(0);
        unsigned nloc = b.st[0], nx = b.st[1];
        if (nloc == 0u) { xcd_barrier_complete(bar, b.x, nloc, nx); b.st[0] = nloc; b.st[1] = nx; }
        const unsigned old = xb_add(&bar[XB_XSUB(b.x)], 1u);
        const unsigned gen = old / nloc;
        if (old + 1u == (gen + 1u) * nloc) {
            __builtin_amdgcn_fence(__ATOMIC_RELEASE, "agent");
            asm volatile("s_waitcnt vmcnt(0)" ::: "memory");
            const unsigned og = xb_add(&bar[XB_TOP], 1u);
            const unsigned tg = og / nx;
            if (og + 1u == (tg + 1u) * nx) xb_add(&bar[XB_TOPGEN], 1u);
            else XB_SPIN(xb_ld(&bar[XB_TOPGEN]) == tg, bar);
            __builtin_amdgcn_fence(__ATOMIC_ACQUIRE, "agent");
            xb_add(&bar[XB_XGEN(b.x)], 1u);
            asm volatile("s_waitcnt vmcnt(0)" ::: "memory");
        } else {
            XB_SPIN(xb_ld(&bar[XB_XGEN(b.x)]) == gen, bar);
            __builtin_amdgcn_fence(__ATOMIC_ACQUIRE, "agent");
            asm volatile("s_waitcnt vmcnt(0)" ::: "memory");
        }
    }
    __syncthreads();
}

constexpr int BM = 256, BK = 64, HALF = 128, HTB = HALF * BK * 2, STAGE_BYTES = 8 * HTB, NXCD = 8, WGM = 8;
__host__ __device__ __forceinline__ int lds_byte(int r, int c) { const int st = (r >> 4) * 2 + (c >> 5), rr = r & 15, cc = c & 31, ob = rr * 64 + cc * 2; return st * 1024 + (ob ^ (((ob >> 9) & 1) << 5)); }
__host__ __device__ __forceinline__ void stage_rc(int b, int& R, int& C) { const int st = b / 1024, sb = b % 1024, swz = sb ^ (((sb >> 9) & 1) << 5); R = (st >> 1) * 16 + swz / 64; C = (st & 1) * 32 + (swz % 64) / 2; }
__host__ __device__ __forceinline__ int perm32(int rho) { const int n = rho >> 4, i = rho & 15; return 8 * (i >> 2) + 4 * n + (i & 3); }

struct Unit { int pm, pn, g; };
struct GemmDesc { const char* A; const char* B; long a_pm, a_g, b_pn, b_g, a_h, b_h, a_k, b_k; int nt; };

struct StaticOrder {
    int nM, nN, nwg, G, c;
    __device__ void init(int nM_, int nN_, int G_, int c_) { nM = nM_; nN = nN_; nwg = nM * nN; G = G_; c = c_; }
    __device__ bool next(int i, Unit& u) const {
        const long L = (long)i * G + c; if (L >= nwg) return false;
        int wgid = (int)L; { const int q = nwg / NXCD, r = nwg % NXCD, xcd = wgid % NXCD, off = wgid / NXCD; wgid = (xcd < r ? xcd * (q + 1) : r * (q + 1) + (xcd - r) * q) + off; }
        const int nig = WGM * nN, gid = wgid / nig, fm = gid * WGM, gsz = (nM - fm) < WGM ? (nM - fm) : WGM;
        u.pm = fm + ((wgid % nig) % gsz); u.pn = (wgid % nig) / gsz; u.g = 0; return true;
    }
};

template <class Epi, class Sched, bool ALIGN_EPI>
__device__ __forceinline__ void gemm_phase(LAS unsigned char* lds, const GemmDesc g, const unsigned (&voffA)[2], const unsigned (&voffB)[2], const Sched& S, Epi& E) {
    const int tid = threadIdx.x, wid = __builtin_amdgcn_readfirstlane(tid >> 6), lane = tid & 63, wr = wid >> 2, wc = wid & 3, fr = lane & 15, fq = lane >> 4;
    const int nt = g.nt;
    const long kstepA = g.a_k, kstepB = g.b_k, hstepA = g.a_h, hstepB = g.b_h;
    const unsigned ldsw = (unsigned)wid * 1024u;
    const int aoff = lds_byte(wr * 64 + fr, fq * 8), boff = lds_byte(wc * 32 + fr, fq * 8);
#define PG8_SA(b, h) (((b) * 2 + (h)) * HTB)
#define PG8_SB(b, h) ((4 + (b) * 2 + (h)) * HTB)
#define PG8_STAGE(bufoff, gbase, voff) do { _Pragma("unroll") for (int _i = 0; _i < 2; ++_i) \
        __builtin_amdgcn_global_load_lds((const unsigned*)((const char*)(gbase) + (voff)[_i]), (LAS unsigned*)(lds + (bufoff) + ldsw + _i * 8192), 16, 0, 0); } while (0)
#define PG8_LDA(dst, b, h) do { _Pragma("unroll") for (int m = 0; m < 4; ++m) _Pragma("unroll") for (int k = 0; k < 2; ++k) dst[m][k] = *(const LAS bf16x8*)(lds + PG8_SA(b, h) + aoff + m * 2048 + k * 1024); } while (0)
#define PG8_LDB(dst, b, h) do { _Pragma("unroll") for (int n = 0; n < 2; ++n) _Pragma("unroll") for (int k = 0; k < 2; ++k) dst[n][k] = *(const LAS bf16x8*)(lds + PG8_SB(b, h) + boff + n * 2048 + k * 1024); } while (0)
#define PG8_MMA(ai, bj, At, Bt) do { __builtin_amdgcn_s_setprio(1); _Pragma("unroll") for (int m = 0; m < 4; ++m) _Pragma("unroll") for (int n = 0; n < 2; ++n) _Pragma("unroll") for (int k = 0; k < 2; ++k) \
        acc[ai][bj][m][n] = __builtin_amdgcn_mfma_f32_16x16x32_bf16(Bt[n][k], At[m][k], acc[ai][bj][m][n], 0, 0, 0); __builtin_amdgcn_s_setprio(0); } while (0)
#define PG8_WAIT_V(n) asm volatile("s_waitcnt vmcnt(" #n ")" ::: "memory")
#define PG8_WAIT_L(n) asm volatile("s_waitcnt lgkmcnt(" #n ")" ::: "memory")
#define PG8_BAR __builtin_amdgcn_s_barrier()
#define PG8_SCHED __builtin_amdgcn_sched_barrier(0)
    Unit cur, nxt; int ui = 0;
    if (!S.next(0, cur)) return;
    f32x4 acc[2][2][4][2];
#pragma unroll
    for (int a = 0; a < 2; ++a)
#pragma unroll
        for (int b = 0; b < 2; ++b)
#pragma unroll
            for (int m = 0; m < 4; ++m)
#pragma unroll
                for (int n = 0; n < 2; ++n) acc[a][b][m][n] = (f32x4){0.f, 0.f, 0.f, 0.f};
    bf16x8 At[4][2], B0[2][2], B1[2][2];
    const char* cA = g.A + (long)cur.pm * g.a_pm + (long)cur.g * g.a_g; const char* cB = g.B + (long)cur.pn * g.b_pn + (long)cur.g * g.b_g;
    PG8_STAGE(PG8_SB(0, 0), cB, voffB); PG8_STAGE(PG8_SB(0, 1), cB + hstepB, voffB); PG8_STAGE(PG8_SA(0, 0), cA, voffA); PG8_STAGE(PG8_SA(0, 1), cA + hstepA, voffA);
    if (wr == 1) PG8_BAR;
    PG8_WAIT_V(2); PG8_BAR;
    PG8_STAGE(PG8_SB(1, 0), cB + kstepB, voffB); PG8_STAGE(PG8_SA(1, 0), cA + kstepA, voffA); PG8_STAGE(PG8_SB(1, 1), cB + hstepB + kstepB, voffB);
    PG8_WAIT_V(6); PG8_BAR;
    for (;;) {
        const bool has_next = S.next(ui + 1, nxt);
        const char* nA = has_next ? g.A + (long)nxt.pm * g.a_pm + (long)nxt.g * g.a_g : cA; const char* nB = has_next ? g.B + (long)nxt.pn * g.b_pn + (long)nxt.g * g.b_g : cB;
        for (int t = 0; t < nt; t += 2) {
            const bool last = (t == nt - 2);
            const char* a1 = cA + (long)(t + 1) * kstepA;
            const char* a2 = last ? nA : cA + (long)(t + 2) * kstepA; const char* b2 = last ? nB : cB + (long)(t + 2) * kstepB;
            const char* a3 = a2 + kstepA; const char* b3 = b2 + kstepB;
            PG8_LDB(B0, 0, 0); PG8_LDB(B1, 0, 1); PG8_SCHED; PG8_LDA(At, 0, 0); PG8_STAGE(PG8_SA(1, 1), a1 + hstepA, voffA);
            PG8_WAIT_V(8); PG8_WAIT_L(0); PG8_BAR; PG8_MMA(0, 0, At, B0); PG8_MMA(0, 1, At, B1); PG8_BAR; PG8_SCHED;
            PG8_LDA(At, 0, 1); PG8_STAGE(PG8_SB(0, 0), b2, voffB); PG8_STAGE(PG8_SB(0, 1), b2 + hstepB, voffB); PG8_STAGE(PG8_SA(0, 0), a2, voffA);
            PG8_WAIT_V(8); PG8_WAIT_L(0); PG8_BAR; PG8_MMA(1, 0, At, B0); PG8_MMA(1, 1, At, B1); PG8_BAR; PG8_SCHED;
            PG8_LDB(B0, 1, 0); PG8_LDB(B1, 1, 1); PG8_SCHED; PG8_LDA(At, 1, 0); PG8_STAGE(PG8_SA(0, 1), a2 + hstepA, voffA);
            PG8_WAIT_V(8); PG8_WAIT_L(0); PG8_BAR; PG8_MMA(0, 0, At, B0); PG8_MMA(0, 1, At, B1); PG8_BAR; PG8_SCHED;
            PG8_LDA(At, 1, 1); PG8_STAGE(PG8_SB(1, 0), b3, voffB); PG8_STAGE(PG8_SB(1, 1), b3 + hstepB, voffB); PG8_STAGE(PG8_SA(1, 0), a3, voffA);
            PG8_WAIT_V(8); PG8_WAIT_L(0); PG8_BAR; PG8_MMA(1, 0, At, B0); PG8_MMA(1, 1, At, B1); PG8_BAR; PG8_SCHED;
            if constexpr (Epi::HAS_MID) { if (t + 2 == Epi::MID_T) E.mid(acc, wr, fr); }
        }
        if constexpr (ALIGN_EPI) { if (wr == 0) PG8_BAR; }
        if constexpr (!Epi::AFTER_DRAIN) { E(acc, cur, wr, wc, fr, fq); }
        if (!has_next) break;
#pragma unroll
        for (int a = 0; a < 2; ++a)
#pragma unroll
            for (int b = 0; b < 2; ++b)
#pragma unroll
                for (int m = 0; m < 4; ++m)
#pragma unroll
                    for (int n = 0; n < 2; ++n) acc[a][b][m][n] = (f32x4){0.f, 0.f, 0.f, 0.f};
        cur = nxt; cA = nA; cB = nB; ++ui;
        if constexpr (ALIGN_EPI) { if (wr == 1) PG8_BAR; }
    }
    PG8_WAIT_V(0);
    if constexpr (!ALIGN_EPI) { if (wr == 0) PG8_BAR; }
    PG8_BAR;
    if constexpr (Epi::AFTER_DRAIN) { E.fused(acc, cur, wr, wc, fr, fq, lds, wid, lane); }
#undef PG8_SA
#undef PG8_SB
#undef PG8_STAGE
#undef PG8_LDA
#undef PG8_LDB
#undef PG8_MMA
#undef PG8_WAIT_V
#undef PG8_WAIT_L
#undef PG8_BAR
#undef PG8_SCHED
}

__device__ __forceinline__ void voff_std(unsigned (&v)[2], int ld, bool perm) {
#pragma unroll
    for (int i = 0; i < 2; ++i) { int R, C; stage_rc((int)threadIdx.x * 16 + i * 8192, R, C); const int Rb = perm ? ((R & ~31) + perm32(R & 31)) : R; v[i] = (unsigned)(Rb * ld + C) * 2u; }
}

typedef f32x4 Acc[2][2][4][2];

struct EpiU {
    static constexpr bool PERM = true, AFTER_DRAIN = false, HAS_MID = false; static constexpr int MID_T = 0;
    const float* r0; bf16_t* upool; bf16_t* ussm;
    __device__ __forceinline__ void operator()(Acc& acc, const Unit& u, int wr, int wc, int fr, int fq) const {
#pragma unroll
        for (int ai = 0; ai < 2; ++ai)
#pragma unroll
            for (int m = 0; m < 4; ++m) {
                const int row = u.pm * BM + ai * HALF + wr * 64 + m * 16 + fr; const float rs = r0[row];
#pragma unroll
                for (int bj = 0; bj < 2; ++bj) {
                    const int c8 = u.pn * BM + bj * HALF + wc * 32 + 8 * fq;
                    const u32x4 w = pack8(acc[ai][bj][m][0] * rs, acc[ai][bj][m][1] * rs);
                    if (u.pn < 2) *(u32x4*)(upool + (size_t)row * DPOOL + c8) = w;
                    else { const int cs = c8 - DPOOL, gg = cs >> 4, h0 = cs & 15, cr = row / TCH, p = row % TCH;
                           *(u32x4*)(ussm + ((size_t)(gg * NCR + cr) * ROWLEN + 16 * p + h0)) = w; }
                }
            }
    }
};
struct EpiFG {
    static constexpr bool PERM = false, AFTER_DRAIN = false, HAS_MID = false; static constexpr int MID_T = 0;
    float* fg;
    __device__ __forceinline__ void operator()(Acc& acc, const Unit& u, int wr, int wc, int fr, int fq) const {
#pragma unroll
        for (int ai = 0; ai < 2; ++ai)
#pragma unroll
            for (int m = 0; m < 4; ++m) {
                const int cr = u.pm * BM + ai * HALF + wr * 64 + m * 16 + fr; float* rowp = fg + ((size_t)u.g * NCR + cr) * 256 + wc * 32 + 4 * fq;
#pragma unroll
                for (int bj = 0; bj < 2; ++bj)
#pragma unroll
                    for (int n = 0; n < 2; ++n) *(f32x4*)(rowp + bj * HALF + n * 16) = acc[ai][bj][m][n];
            }
    }
};
struct EpiZ {
    static constexpr bool PERM = true, AFTER_DRAIN = false, HAS_MID = false; static constexpr int MID_T = 0;
    const bf16_t* ussm; const float* dvec; bf16_t* zg;
    __device__ __forceinline__ void operator()(Acc& acc, const Unit& u, int wr, int wc, int fr, int fq) const {
#pragma unroll
        for (int bj = 0; bj < 2; ++bj) {
            const int c8 = u.pn * BM + bj * HALF + wc * 32 + 8 * fq;
            const f32x4 d0 = *(const f32x4*)(dvec + u.g * 16 + (c8 & 15)), d1 = *(const f32x4*)(dvec + u.g * 16 + (c8 & 15) + 4);
#pragma unroll
            for (int ai = 0; ai < 2; ++ai)
#pragma unroll
                for (int m = 0; m < 4; ++m) {
                    const int cr = u.pm * BM + ai * HALF + wr * 64 + m * 16 + fr;
                    const u32x4 uw = *(const u32x4*)(ussm + ((size_t)(u.g * NCR + cr) * ROWLEN + c8));
                    f32x4 u0, u1; unpack8(uw, u0, u1);
                    f32x4 y0 = acc[ai][bj][m][0] + d0 * u0, y1 = acc[ai][bj][m][1] + d1 * u1;
#pragma unroll
                    for (int i = 0; i < 4; ++i) { y0[i] = fast_gelu_tanh(y0[i]); y1[i] = fast_gelu_tanh(y1[i]); }
                    *(u32x4*)(zg + ((size_t)u.g * MT * 16 + (size_t)cr * K1 + c8)) = pack8(y0, y1);
                }
        }
    }
};
struct EpiPool {
    static constexpr bool PERM = true, AFTER_DRAIN = false, HAS_MID = false; static constexpr int MID_T = 0;
    const float* pscale; bf16_t* ycat; float* ss;
    __device__ __forceinline__ void operator()(Acc& acc, const Unit& u, int wr, int wc, int fr, int fq) const {
        f32x4 sc[2][2];
#pragma unroll
        for (int bj = 0; bj < 2; ++bj) { const int c8 = u.pn * BM + bj * HALF + wc * 32 + 8 * fq; sc[bj][0] = *(const f32x4*)(pscale + c8); sc[bj][1] = *(const f32x4*)(pscale + c8 + 4); }
#pragma unroll
        for (int ai = 0; ai < 2; ++ai)
#pragma unroll
            for (int m = 0; m < 4; ++m) {
                const int row = u.pm * BM + ai * HALF + wr * 64 + m * 16 + fr; float q = 0.f;
#pragma unroll
                for (int bj = 0; bj < 2; ++bj) {
                    const int c8 = u.pn * BM + bj * HALF + wc * 32 + 8 * fq;
                    const f32x4 v0 = acc[ai][bj][m][0] * sc[bj][0], v1 = acc[ai][bj][m][1] * sc[bj][1];
                    q += (v0[0] * v0[0] + v0[1] * v0[1]) + (v0[2] * v0[2] + v0[3] * v0[3]) + (v1[0] * v1[0] + v1[1] * v1[1]) + (v1[2] * v1[2] + v1[3] * v1[3]);
                    *(u32x4*)(ycat + (size_t)row * DM + c8) = pack8(v0, v1);
                }
                q += __shfl_xor(q, 16); q += __shfl_xor(q, 32);
                if (fq == 0) ss[(size_t)(u.pn * 4 + wc) * MT + row] = q;
            }
    }
};
struct EpiGlu {
    static constexpr bool PERM = true, AFTER_DRAIN = false, HAS_MID = false; static constexpr int MID_T = 0;
    const float* gb; const bf16_t* zg; bf16_t* ycat; float* ss;
    __device__ __forceinline__ void operator()(Acc& acc, const Unit& u, int wr, int wc, int fr, int fq) const {
        f32x4 bv[2][2];
#pragma unroll
        for (int bj = 0; bj < 2; ++bj) { const int c8 = u.pn * BM + bj * HALF + wc * 32 + 8 * fq; bv[bj][0] = *(const f32x4*)(gb + c8); bv[bj][1] = *(const f32x4*)(gb + c8 + 4); }
#pragma unroll
        for (int ai = 0; ai < 2; ++ai)
#pragma unroll
            for (int m = 0; m < 4; ++m) {
                const int row = u.pm * BM + ai * HALF + wr * 64 + m * 16 + fr; float q = 0.f;
#pragma unroll
                for (int bj = 0; bj < 2; ++bj) {
                    const int c8 = u.pn * BM + bj * HALF + wc * 32 + 8 * fq;
                    const u32x4 zw = *(const u32x4*)(zg + ((size_t)(c8 >> 4) * MT + row) * 16 + (c8 & 15));
                    f32x4 z0, z1; unpack8(zw, z0, z1);
                    f32x4 v0 = acc[ai][bj][m][0] + bv[bj][0], v1 = acc[ai][bj][m][1] + bv[bj][1];
#pragma unroll
                    for (int i = 0; i < 4; ++i) { v0[i] = z0[i] * fast_sigmoid(v0[i]); v1[i] = z1[i] * fast_sigmoid(v1[i]); }
                    q += (v0[0] * v0[0] + v0[1] * v0[1]) + (v0[2] * v0[2] + v0[3] * v0[3]) + (v1[0] * v1[0] + v1[1] * v1[1]) + (v1[2] * v1[2] + v1[3] * v1[3]);
                    *(u32x4*)(ycat + (size_t)row * DM + DPOOL + c8) = pack8(v0, v1);
                }
                q += __shfl_xor(q, 16); q += __shfl_xor(q, 32);
                if (fq == 0) ss[(size_t)(u.pn * 4 + wc) * MT + row] = q;
            }
    }
};
struct EpiOut {
    static constexpr bool PERM = false, AFTER_DRAIN = true, HAS_MID = true; static constexpr int MID_T = 8;
    const float* x; float* h1; bf16_t* h1b; float* ss; LAS f32x2* XR;
    __device__ __forceinline__ void mid(Acc& acc, int wr, int fr) const {
#pragma unroll
        for (int ai = 0; ai < 2; ++ai)
#pragma unroll
            for (int m = 0; m < 4; ++m) { const float ratio = XR[ai * HALF + wr * 64 + m * 16 + fr].x;
#pragma unroll
                for (int bj = 0; bj < 2; ++bj)
#pragma unroll
                    for (int n = 0; n < 2; ++n) acc[ai][bj][m][n] = acc[ai][bj][m][n] * ratio; }
    }
    __device__ __forceinline__ void fused(Acc& acc, const Unit& u, int wr, int wc, int fr, int fq, LAS unsigned char* lds, int wid, int lane) const {
        LAS float* P = (LAS float*)lds;
        const int col0 = u.pn * BM + wc * 32 + 4 * fq;
#pragma unroll
        for (int ai = 0; ai < 2; ++ai)
#pragma unroll
            for (int m = 0; m < 4; ++m) {
                const int lr = ai * HALF + wr * 64 + m * 16 + fr, row = u.pm * BM + lr; const float rs = XR[lr].y; float q = 0.f;
                const size_t prow = (size_t)(row >> 12) * PADROWS + 1 + (row & 4095);
#pragma unroll
                for (int bj = 0; bj < 2; ++bj)
#pragma unroll
                    for (int n = 0; n < 2; ++n) {
                        const int c = col0 + bj * HALF + n * 16;
                        const f32x4 xv = *(const f32x4*)(x + (size_t)row * DM + c);
                        const f32x4 hv = xv + acc[ai][bj][m][n] * rs;
                        q += (hv[0] * hv[0] + hv[1] * hv[1]) + (hv[2] * hv[2] + hv[3] * hv[3]);
                        *(f32x4*)(h1 + (size_t)row * DM + c) = hv;
                        *(u32x2*)(h1b + prow * DM + c) = pack4(hv);
                    }
                q += __shfl_xor(q, 16); q += __shfl_xor(q, 32);
                if (fq == 0) P[lr * 4 + wc] = q;
            }
        LDS_WAIT(); __builtin_amdgcn_s_barrier(); asm volatile("" ::: "memory");
        const int tid = wid * 64 + lane;
        if (tid < 256) ss[(size_t)u.pn * MT + u.pm * BM + tid] = (P[tid * 4 + 0] + P[tid * 4 + 1]) + (P[tid * 4 + 2] + P[tid * 4 + 3]);
    }
};
struct EpiUp {
    static constexpr bool PERM = true, AFTER_DRAIN = false, HAS_MID = false; static constexpr int MID_T = 0;
    const float* ssh1; const float* cw; const float* cb; bf16_t* act;
    __device__ __forceinline__ void operator()(Acc& acc, const Unit& u, int wr, int wc, int fr, int fq) const {
        const int j = u.pm, b = u.g;
        int tokv[2][4];
#pragma unroll
        for (int ai = 0; ai < 2; ++ai)
#pragma unroll
            for (int m = 0; m < 4; ++m) {
                const int w = 64 * ai + 16 * m + fr, t = UPROWS * j + 126 * wr + w - 1; const bool in = (t >= 0 && t < SEQ);
                const int tok = b * SEQ + (in ? t : 0);
                const float s = (ssh1[tok] + ssh1[MT + tok]) + (ssh1[2 * MT + tok] + ssh1[3 * MT + tok]);
                const float rs = in ? rsqrtf(s * (1.0f / DM) + EPS) : 0.f;
                tokv[ai][m] = (in && w >= 1 && w <= 126) ? tok : -1;
#pragma unroll
                for (int bj = 0; bj < 2; ++bj)
#pragma unroll
                    for (int n = 0; n < 2; ++n) acc[ai][bj][m][n] = acc[ai][bj][m][n] * rs;
            }
        const int f0 = 128 * u.pn + 32 * wc + 8 * fq;
        u32x2 keep[8];
#pragma unroll
        for (int n = 0; n < 2; ++n) {
            const int fc = f0 + 4 * n;
            const f32x4 wv0 = *(const f32x4*)(cw + fc), wv1 = *(const f32x4*)(cw + DFF2 + fc), wv2 = *(const f32x4*)(cw + 2 * DFF2 + fc), bvv = *(const f32x4*)(cb + fc);
            const f32x4 wg0 = *(const f32x4*)(cw + DFF + fc), wg1 = *(const f32x4*)(cw + DFF2 + DFF + fc), wg2 = *(const f32x4*)(cw + 2 * DFF2 + DFF + fc), bgv = *(const f32x4*)(cb + DFF + fc);
#pragma unroll
            for (int gi = 0; gi < 8; ++gi) {
                const int ai = gi >> 2, m = gi & 3, pi = gi > 0 ? gi - 1 : gi, ni = gi < 7 ? gi + 1 : gi;
                const f32x4 cv = acc[ai][0][m][n], cg = acc[ai][1][m][n];
                const f32x4 pv = acc[pi >> 2][0][pi & 3][n], pg = acc[pi >> 2][1][pi & 3][n];
                const f32x4 nv = acc[ni >> 2][0][ni & 3][n], ng = acc[ni >> 2][1][ni & 3][n];
                f32x4 o;
#pragma unroll
                for (int i = 0; i < 4; ++i) {
                    const float v_prev = dpp_ror1(fr == 15 ? pv[i] : cv[i]), v_next = dpp_ror15(fr == 0 ? nv[i] : cv[i]);
                    const float g_prev = dpp_ror1(fr == 15 ? pg[i] : cg[i]), g_next = dpp_ror15(fr == 0 ? ng[i] : cg[i]);
                    const float vv = bvv[i] + wv0[i] * v_prev + wv1[i] * cv[i] + wv2[i] * v_next;
                    const float gg = bgv[i] + wg0[i] * g_prev + wg1[i] * cg[i] + wg2[i] * g_next;
                    o[i] = vv * gg * fast_sigmoid(gg);
                }
                const u32x2 pk = pack4(o);
                if (n == 0) keep[gi] = pk;
                else if (tokv[ai][m] >= 0) { u32x4 w; w.x = keep[gi].x; w.y = keep[gi].y; w.z = pk.x; w.w = pk.y; *(u32x4*)(act + (size_t)tokv[ai][m] * DFF + f0) = w; }
            }
        }
    }
};
struct EpiDown {
    static constexpr bool PERM = false, AFTER_DRAIN = true, HAS_MID = false; static constexpr int MID_T = 0;
    const float* h1; float* out; const float* gfin; float* ss; const XcdBarrier* bar;
    __device__ __forceinline__ void fused(Acc& acc, const Unit& u, int wr, int wc, int fr, int fq, LAS unsigned char* lds, int wid, int lane) const {
        LAS float* P = (LAS float*)lds;
        LAS float* Sr = (LAS float*)(lds + 8192);
        const int col0 = u.pn * BM + wc * 32 + 4 * fq;
#pragma unroll
        for (int ai = 0; ai < 2; ++ai)
#pragma unroll
            for (int m = 0; m < 4; ++m) {
                const int lr = ai * HALF + wr * 64 + m * 16 + fr, row = u.pm * BM + lr; float q = 0.f;
#pragma unroll
                for (int bj = 0; bj < 2; ++bj)
#pragma unroll
                    for (int n = 0; n < 2; ++n) {
                        const f32x4 hv = *(const f32x4*)(h1 + (size_t)row * DM + col0 + bj * HALF + n * 16) + acc[ai][bj][m][n];
                        acc[ai][bj][m][n] = hv;
                        q += (hv[0] * hv[0] + hv[1] * hv[1]) + (hv[2] * hv[2] + hv[3] * hv[3]);
                    }
                q += __shfl_xor(q, 16); q += __shfl_xor(q, 32);
                if (fq == 0) P[lr * 4 + wc] = q;
            }
        LDS_WAIT(); __builtin_amdgcn_s_barrier(); asm volatile("" ::: "memory");
        const int tid = wid * 64 + lane;
        if (tid < 256) ss[(size_t)u.pn * MT + u.pm * BM + tid] = (P[tid * 4 + 0] + P[tid * 4 + 1]) + (P[tid * 4 + 2] + P[tid * 4 + 3]);
        xcd_barrier(*bar);
        if (tid < 256) { const int row = u.pm * BM + tid; const float s = (ss[row] + ss[MT + row]) + (ss[2 * MT + row] + ss[3 * MT + row]); Sr[tid] = rsqrtf(s * (1.0f / DM) + EPS); }
        LDS_WAIT(); __builtin_amdgcn_s_barrier(); asm volatile("" ::: "memory");
#pragma unroll
        for (int bj = 0; bj < 2; ++bj)
#pragma unroll
            for (int n = 0; n < 2; ++n) {
                const int c = col0 + bj * HALF + n * 16; const f32x4 gv = *(const f32x4*)(gfin + c);
#pragma unroll
                for (int ai = 0; ai < 2; ++ai)
#pragma unroll
                    for (int m = 0; m < 4; ++m) { const int lr = ai * HALF + wr * 64 + m * 16 + fr; const float r = Sr[lr];
                        *(f32x4*)(out + (size_t)(u.pm * BM + lr) * DM + c) = acc[ai][bj][m][n] * r * gv; }
            }
    }
};

struct OrdSsmA { int c; __device__ bool next(int i, Unit& u) const { if (i > 0 || c >= 64) return false; const int x = c & 7, k = c >> 3; u.g = x * 4 + (k >> 1); u.pm = k & 1; u.pn = 0; return true; } };
struct OrdSsmB { int c; __device__ bool next(int i, Unit& u) const { if (i > 0 || c >= 128) return false; const int x = c & 7, k = c >> 3; u.g = x * 4 + (k >> 2); u.pm = (k >> 1) & 1; u.pn = k & 1; return true; } };
struct OrdPool { int c; __device__ bool next(int i, Unit& u) const { if (i > 0 || c < 128 || c >= 256) return false; const int cc = c - 128, x = cc & 7, k = cc >> 3; u.pm = x * 8 + (k >> 1); u.pn = k & 1; u.g = u.pn; return true; } };
struct OrdGlu  { int c; __device__ bool next(int i, Unit& u) const { if (i > 0 || c >= 128) return false; const int x = c & 7, k = c >> 3; u.pm = x * 8 + (k >> 1); u.pn = k & 1; u.g = 0; return true; } };
struct OrdUp { StaticOrder so; __device__ bool next(int i, Unit& u) const { if (!so.next(i, u)) return false; u.g = u.pm / UPT; u.pm = u.pm % UPT; return true; } };

struct Args { const float* in[24]; float* out; unsigned char* ws; int ph_lo, ph_hi; };

struct Frame { LAS unsigned char* lds; int tid, lane, wave, G, bx; };

template <int MAP>
__device__ __forceinline__ void p0_transpose_item(const float* W, int K, int N, const float* kg0, const float* kg1, int ksplit, bf16_t* WT, LAS float* scr, int item, int lane) {
    const int nblk = N / 32, kb = item / nblk, nb = item % nblk, k0 = 64 * kb, n0 = 32 * nb;
#pragma unroll 8
    for (int i = 0; i < 32; ++i) { const int kk = 2 * i + (lane >> 5), k = k0 + kk; float v = W[(size_t)k * N + n0 + (lane & 31)];
        if (kg0) v *= (k < ksplit ? kg0[k] : kg1[k - ksplit]);
        scr[kk * 33 + (lane & 31)] = v; }
    LDS_WAIT(); asm volatile("" ::: "memory");
    const int c = lane & 7;
#pragma unroll
    for (int j = 0; j < 4; ++j) { const int n = (lane >> 3) + 8 * j; const LAS float* s = scr + (8 * c) * 33 + n;
        u32x4 o; o.x = pk2(s[0 * 33], s[1 * 33]); o.y = pk2(s[2 * 33], s[3 * 33]); o.z = pk2(s[4 * 33], s[5 * 33]); o.w = pk2(s[6 * 33], s[7 * 33]);
        int nr = n0 + n;
        if (MAP == 1) { const int bj = nr / DFF, rem = nr % DFF; nr = 256 * (rem >> 7) + 128 * bj + (rem & 127); }
        *(u32x4*)(WT + (size_t)nr * K + k0 + 8 * c) = o; }
    LDS_WAIT(); asm volatile("" ::: "memory");
}

__device__ __forceinline__ void p0_ssm_build(const Args& a, const Frame& F, int g, int jq) {
    const float* lnar = a.in[5]; const float* aim = a.in[6]; const float* ldt = a.in[7];
    const float* bre = a.in[8]; const float* bim = a.in[9]; const float* cre = a.in[10]; const float* cim = a.in[11];
    bf16_t* TB = (bf16_t*)(a.ws + WS_TB) + (size_t)g * K1 * ROWLEN;
    bf16_t* WAB = (bf16_t*)(a.ws + WS_WAB) + (size_t)g * 256 * K1;
    LAS float* Bre = (LAS float*)(F.lds);
    LAS float* Bim = Bre + 2048;
    LAS float* Cre = Bim + 2048;
    LAS float* Cim = Cre + 2048;
    LAS float* PAR = Cim + 2048;
    LAS float* Pc = PAR + 512;
    LAS float* Kl = Pc + 256;
    const int tid = F.tid;
    for (int i = tid; i < 2048; i += 512) { const int dir = i >> 10, r = i & 1023;
        Bre[i] = bre[((size_t)(dir * NG + g)) * 1024 + r]; Bim[i] = bim[((size_t)(dir * NG + g)) * 1024 + r];
        Cre[i] = cre[((size_t)(dir * NG + g)) * 1024 + r]; Cim[i] = cim[((size_t)(dir * NG + g)) * 1024 + r]; }
    if (tid < 128) { const int dir = tid >> 6, n = tid & 63;
        const float dt = expf(ldt[dir * NG + g]); const float a_re = -expf(lnar[(dir * NG + g) * NS + n]), a_im = aim[(dir * NG + g) * NS + n];
        const float mag = expf(a_re * dt), ang = a_im * dt; const float lam_re = mag * cosf(ang), lam_im = mag * sinf(ang);
        const float den = a_re * a_re + a_im * a_im;
        PAR[tid * 4 + 0] = a_re * dt; PAR[tid * 4 + 1] = ang;
        PAR[tid * 4 + 2] = ((lam_re - 1.0f) * a_re + lam_im * a_im) / den; PAR[tid * 4 + 3] = (lam_im * a_re - (lam_re - 1.0f) * a_im) / den; }
    __syncthreads();
    for (int li = 0; li < 4; ++li) {
        const int lag = 4 * jq + li;
        if (tid < 128) { const float ad = PAR[tid * 4 + 0], ang = PAR[tid * 4 + 1], fr_ = PAR[tid * 4 + 2], fi_ = PAR[tid * 4 + 3];
            const float mg = expf((float)lag * ad); float sn, cs; sincosf((float)lag * ang, &sn, &cs); const float lr = mg * cs, lim = mg * sn;
            Pc[tid * 2 + 0] = lr * fr_ - lim * fi_; Pc[tid * 2 + 1] = lr * fi_ + lim * fr_; }
        __syncthreads();
        { const int dir = tid >> 8, h = (tid >> 4) & 15, hp = tid & 15; float s = 0.f;
          for (int n = 0; n < 64; ++n) { const float cr_ = Cre[dir * 1024 + h * 64 + n], ci_ = Cim[dir * 1024 + h * 64 + n], pr = Pc[(dir * 64 + n) * 2], pi = Pc[(dir * 64 + n) * 2 + 1];
              const float er = cr_ * pr - ci_ * pi, ei = cr_ * pi + ci_ * pr;
              s += er * Bre[dir * 1024 + n * 16 + hp] - ei * Bim[dir * 1024 + n * 16 + hp]; }
          Kl[tid] = s; }
        __syncthreads();
        if (lag == 0) {
            const int p = tid >> 4, h = tid & 15; u32x4 w0, w1; float v[16];
#pragma unroll
            for (int i = 0; i < 16; ++i) v[i] = Kl[h * 16 + i] + Kl[256 + h * 16 + i];
            w0.x = pk2(v[0], v[1]); w0.y = pk2(v[2], v[3]); w0.z = pk2(v[4], v[5]); w0.w = pk2(v[6], v[7]); w1.x = pk2(v[8], v[9]); w1.y = pk2(v[10], v[11]); w1.z = pk2(v[12], v[13]); w1.w = pk2(v[14], v[15]);
            bf16_t* dst = TB + (size_t)(16 * p + h) * ROWLEN + 16 * p; *(u32x4*)dst = w0; *(u32x4*)(dst + 8) = w1;
        } else {
            const int nb = TCH - lag;
            for (int idx = tid; idx < 2 * nb * 16; idx += 512) {
                const int dir = idx / (nb * 16), r = idx % (nb * 16), bi = r >> 4, h = r & 15;
                const int p = dir == 0 ? lag + bi : bi, q = dir == 0 ? bi : lag + bi;
                u32x4 w0, w1; float v[16];
#pragma unroll
                for (int i = 0; i < 16; ++i) v[i] = Kl[dir * 256 + h * 16 + i];
                w0.x = pk2(v[0], v[1]); w0.y = pk2(v[2], v[3]); w0.z = pk2(v[4], v[5]); w0.w = pk2(v[6], v[7]); w1.x = pk2(v[8], v[9]); w1.y = pk2(v[10], v[11]); w1.z = pk2(v[12], v[13]); w1.w = pk2(v[14], v[15]);
                bf16_t* dst = TB + (size_t)(16 * p + h) * ROWLEN + 16 * q; *(u32x4*)dst = w0; *(u32x4*)(dst + 8) = w1;
            }
        }
        __syncthreads();
    }
    for (int li = 0; li < 4; ++li) {
        const int p = 4 * jq + li;
        if (tid < 128) { const int dir = tid >> 6; const float ad = PAR[tid * 4 + 0], ang = PAR[tid * 4 + 1]; const float e = dir == 0 ? (float)(p + 1) : (float)(TCH - p);
            const float mg = expf(e * ad); float sn, cs; sincosf(e * ang, &sn, &cs); Pc[tid * 2 + 0] = mg * cs; Pc[tid * 2 + 1] = mg * sn; }
        __syncthreads();
        { const int h = tid >> 5, dir = (tid >> 4) & 1, n4 = tid & 15; float v[8];
#pragma unroll
          for (int e = 0; e < 4; ++e) { const int n = 4 * n4 + e; const float cr_ = Cre[dir * 1024 + h * 64 + n], ci_ = Cim[dir * 1024 + h * 64 + n], pr = Pc[(dir * 64 + n) * 2], pi = Pc[(dir * 64 + n) * 2 + 1];
              v[2 * e] = cr_ * pr - ci_ * pi; v[2 * e + 1] = -(cr_ * pi + ci_ * pr); }
          u32x4 w; w.x = pk2(v[0], v[1]); w.y = pk2(v[2], v[3]); w.z = pk2(v[4], v[5]); w.w = pk2(v[6], v[7]);
          *(u32x4*)(TB + (size_t)(16 * p + h) * ROWLEN + K1 + dir * 128 + 8 * n4) = w; }
        __syncthreads();
    }
    for (int li = 0; li < 4; ++li) {
        const int q = 4 * jq + li;
        if (tid < 128) { const int dir = tid >> 6; const float ad = PAR[tid * 4 + 0], ang = PAR[tid * 4 + 1], fr_ = PAR[tid * 4 + 2], fi_ = PAR[tid * 4 + 3]; const float e = dir == 0 ? (float)(TCH - 1 - q) : (float)q;
            const float mg = expf(e * ad); float sn, cs; sincosf(e * ang, &sn, &cs); const float lr = mg * cs, lim = mg * sn;
            Pc[tid * 2 + 0] = lr * fr_ - lim * fi_; Pc[tid * 2 + 1] = lr * fi_ + lim * fr_; }
        __syncthreads();
        if (tid < 256) { const int dir = tid >> 7, n = (tid >> 1) & 63, part = tid & 1; const float pr = Pc[(dir * 64 + n) * 2], pi = Pc[(dir * 64 + n) * 2 + 1]; float v[16];
#pragma unroll
            for (int i = 0; i < 16; ++i) { const float br_ = Bre[dir * 1024 + n * 16 + i], bi_ = Bim[dir * 1024 + n * 16 + i]; v[i] = part == 0 ? (pr * br_ - pi * bi_) : (pr * bi_ + pi * br_); }
            u32x4 w0, w1; w0.x = pk2(v[0], v[1]); w0.y = pk2(v[2], v[3]); w0.z = pk2(v[4], v[5]); w0.w = pk2(v[6], v[7]); w1.x = pk2(v[8], v[9]); w1.y = pk2(v[10], v[11]); w1.z = pk2(v[12], v[13]); w1.w = pk2(v[14], v[15]);
            bf16_t* dst = WAB + (size_t)(dir * 128 + 2 * n + part) * K1 + 16 * q; *(u32x4*)dst = w0; *(u32x4*)(dst + 8) = w1; }
        __syncthreads();
    }
}

__device__ __forceinline__ void p0_prologue(const Args& a, const Frame& F) {
    const float* x = a.in[0];
    for (int it = F.bx; it < NG * 8; it += F.G) p0_ssm_build(a, F, it >> 3, it & 7);
    __syncthreads();
    LAS float* scr = (LAS float*)(F.lds + F.wave * 16384);
    const int gw = F.bx * 8 + F.wave, NGW = F.G * 8;
    constexpr int I_IN = (DM / 64) * (DM / 32), I_OUT = I_IN, I_GLU = (DSSM / 64) * (DSSM / 32), I_UP = (DM / 64) * (DFF2 / 32), I_DN = (DFF / 64) * (DM / 32);
    constexpr int NITEMS = I_IN + I_OUT + I_GLU + I_UP + I_DN;
    for (int it = gw; it < NITEMS; it += NGW) {
        int r = it;
        if (r < I_IN) { p0_transpose_item<0>(a.in[2], DM, DM, a.in[1], a.in[1], DM, (bf16_t*)(a.ws + WS_WIN), scr, r, F.lane); continue; } r -= I_IN;
        if (r < I_OUT) { p0_transpose_item<0>(a.in[17], DM, DM, a.in[15], a.in[16], DPOOL, (bf16_t*)(a.ws + WS_WOUT), scr, r, F.lane); continue; } r -= I_OUT;
        if (r < I_GLU) { p0_transpose_item<0>(a.in[13], DSSM, DSSM, nullptr, nullptr, 0, (bf16_t*)(a.ws + WS_WGLU), scr, r, F.lane); continue; } r -= I_GLU;
        if (r < I_UP) { p0_transpose_item<1>(a.in[19], DM, DFF2, a.in[18], a.in[18], DM, (bf16_t*)(a.ws + WS_WUP), scr, r, F.lane); continue; } r -= I_UP;
        p0_transpose_item<0>(a.in[22], DFF, DM, nullptr, nullptr, 0, (bf16_t*)(a.ws + WS_WDOWN), scr, r, F.lane);
    }
    { bf16_t* PW = (bf16_t*)(a.ws + WS_PW); const float* pw = a.in[3];
      for (int idx = F.bx * 512 + F.tid; idx < 2 * 256 * 256; idx += F.G * 512) { const int pn = idx >> 16, j = (idx >> 8) & 255, k = idx & 255;
          const float v = ((j >> 7) == (k >> 7)) ? pw[((size_t)(2 * pn + (j >> 7)) * 128 + (k & 127)) * 128 + (j & 127)] : 0.f; PW[idx] = (bf16_t)f2bf(v); } }
    { bf16_t* h1b = (bf16_t*)(a.ws + WS_H1B);
      for (int idx = F.bx * 512 + F.tid; idx < BATCH * 256 * (DM / 8); idx += F.G * 512) { const int b = idx / (256 * 128), r = (idx / 128) % 256, c = idx % 128; const int prow = b * PADROWS + (r == 0 ? 0 : 4096 + r);
          *(u32x4*)(h1b + (size_t)prow * DM + 8 * c) = (u32x4){0u, 0u, 0u, 0u}; } }
    { bf16_t* xb = (bf16_t*)(a.ws + WS_XB); float* r0 = (float*)(a.ws + WS_R0);
      for (int row = gw; row < MT; row += NGW) {
          const f32x4* xr = (const f32x4*)(x + (size_t)row * DM) + F.lane; f32x4 v[4]; float s = 0.f;
#pragma unroll
          for (int j = 0; j < 4; ++j) { v[j] = xr[64 * j]; s += (v[j][0] * v[j][0] + v[j][1] * v[j][1]) + (v[j][2] * v[j][2] + v[j][3] * v[j][3]); }
          s = wave_sum(s); if (F.lane == 0) r0[row] = rsqrtf(s * (1.0f / DM) + EPS);
          u32x2* o = (u32x2*)(xb + (size_t)row * DM) + F.lane;
#pragma unroll
          for (int j = 0; j < 4; ++j) o[64 * j] = pack4(v[j]);
      } }
}

__device__ __forceinline__ void p2_pooled(const Args& a, const Frame& F, int first_block) {
    const bf16_t* up = (const bf16_t*)(a.ws + WS_UPOOL); bf16_t* po = (bf16_t*)(a.ws + WS_POOLED);
    const int gw = (F.bx - first_block) * 8 + F.wave, NGW = (F.G - first_block) * 8;
    const int c0 = 8 * F.lane, half = 1 << (F.lane >> 4);
    for (int row = gw; row < MT; row += NGW) {
        const int b = row / SEQ, t = row % SEQ; int lo = t - half, hi = t + half; if (lo < 0) lo = 0; if (hi > SEQ) hi = SEQ;
        f32x4 s0 = {0.f, 0.f, 0.f, 0.f}, s1 = {0.f, 0.f, 0.f, 0.f};
        for (int q = lo; q < hi; ++q) { f32x4 a0, a1; unpack8(*(const u32x4*)(up + (size_t)(b * SEQ + q) * DPOOL + c0), a0, a1); s0 = s0 + a0; s1 = s1 + a1; }
        f32x4 c0v, c1v; unpack8(*(const u32x4*)(up + (size_t)row * DPOOL + c0), c0v, c1v);
        const float inv = 1.0f / (float)(hi - lo);
        *(u32x4*)(po + (size_t)row * DPOOL + c0) = pack8(s0 * inv - c0v, s1 * inv - c1v);
    }
}

__device__ __forceinline__ void p3_carries(const Args& a, const Frame& F, int g, int pm) {
    if (F.tid < 256) {
        const int bs = F.tid >> 7, dir = (F.tid >> 6) & 1, n = F.tid & 63, b = 2 * pm + bs;
        const float dt = expf(a.in[7][dir * NG + g]); const float a_re = -expf(a.in[5][(dir * NG + g) * NS + n]), a_im = a.in[6][(dir * NG + g) * NS + n];
        const float mg = expf((float)TCH * (a_re * dt)); float sn, cs; sincosf((float)TCH * (a_im * dt), &sn, &cs); const float lr = mg * cs, li = mg * sn;
        const float* fg = (const float*)(a.ws + WS_FG) + ((size_t)g * NCR + (size_t)b * NCHB) * 256 + dir * 128 + 2 * n;
        bf16_t* us = (bf16_t*)(a.ws + WS_USSM) + ((size_t)g * NCR + (size_t)b * NCHB) * ROWLEN + K1 + dir * 128 + 2 * n;
        float sr = 0.f, si = 0.f;
#pragma unroll 8
        for (int i = 0; i < NCHB; ++i) {
            const int c = dir == 0 ? i : NCHB - 1 - i;
            *(unsigned*)(us + (size_t)c * ROWLEN) = pk2(sr, si);
            const f32x2 f = *(const f32x2*)(fg + (size_t)c * 256);
            const float nr = lr * sr - li * si + f.x, ni = lr * si + li * sr + f.y; sr = nr; si = ni;
        }
    }
    VM_WAIT(); __syncthreads();
}

__global__ void __launch_bounds__(512, 2) mk_fwd(Args args) {
    extern __shared__ __attribute__((aligned(16))) unsigned char lds_raw[];
    Frame F; F.lds = (LAS unsigned char*)lds_raw; F.tid = threadIdx.x; F.lane = F.tid & 63; F.wave = __builtin_amdgcn_readfirstlane(F.tid >> 6); F.G = gridDim.x; F.bx = blockIdx.x;
    volatile LAS unsigned* MISC = (volatile LAS unsigned*)(F.lds + LDSCTL_OFF);
    for (int u = F.tid; u < (LDS_BYTES - LDSCTL_OFF) / 4; u += 512) ((LAS unsigned*)(F.lds + LDSCTL_OFF))[u] = 0u;
    __syncthreads();
    unsigned char* ws = args.ws;
    XcdBarrier bar = xcd_barrier_post((unsigned*)(ws + WS_CTL), MISC + 8);
    const int lo = args.ph_lo, hi = args.ph_hi;
#define IN(k) (lo <= (k) && (k) < hi)
#define BOTH(k) (IN(k) && IN((k) + 1))
    if (IN(0)) { p0_prologue(args, F); if (BOTH(0)) xcd_barrier(bar); }
    if (IN(1)) {
        GemmDesc g{(const char*)(ws + WS_XB), (const char*)(ws + WS_WIN), 256L * DM * 2, 0, 256L * DM * 2, 0, 128L * DM * 2, 128L * DM * 2, 128, 128, DM / BK};
        unsigned vA[2], vB[2]; voff_std(vA, DM, false); voff_std(vB, DM, true);
        StaticOrder S; S.init(MT / BM, DM / BM, F.G, F.bx);
        EpiU E{(const float*)(ws + WS_R0), (bf16_t*)(ws + WS_UPOOL), (bf16_t*)(ws + WS_USSM)};
        gemm_phase<EpiU, StaticOrder, true>(F.lds, g, vA, vB, S, E);
        if (BOTH(1)) xcd_barrier(bar);
    }
    if (IN(2)) {
        if (F.bx < 64) {
            GemmDesc g{(const char*)(ws + WS_USSM), (const char*)(ws + WS_WAB), 256L * ROWLEN * 2, (long)NCR * ROWLEN * 2, 0, 256L * K1 * 2, 128L * ROWLEN * 2, 128L * K1 * 2, 128, 128, K1 / BK};
            unsigned vA[2], vB[2]; voff_std(vA, ROWLEN, false); voff_std(vB, K1, false);
            OrdSsmA S{F.bx}; EpiFG E{(float*)(ws + WS_FG)};
            gemm_phase<EpiFG, OrdSsmA, true>(F.lds, g, vA, vB, S, E);
        } else p2_pooled(args, F, 64);
        if (BOTH(2)) xcd_barrier(bar);
    }
    if (IN(3)) {
        if (F.bx < 128) {
            OrdSsmB S{F.bx}; Unit u0; S.next(0, u0);
            p3_carries(args, F, u0.g, u0.pm);
            GemmDesc g{(const char*)(ws + WS_USSM), (const char*)(ws + WS_TB), 256L * ROWLEN * 2, (long)NCR * ROWLEN * 2, 256L * ROWLEN * 2, (long)K1 * ROWLEN * 2, 128L * ROWLEN * 2, 128L * ROWLEN * 2, 128, 128, ROWLEN / BK};
            unsigned vA[2], vB[2]; voff_std(vA, ROWLEN, false); voff_std(vB, ROWLEN, true);
            EpiZ E{(const bf16_t*)(ws + WS_USSM), args.in[12], (bf16_t*)(ws + WS_ZG)};
            gemm_phase<EpiZ, OrdSsmB, true>(F.lds, g, vA, vB, S, E);
        } else {
            GemmDesc g{(const char*)(ws + WS_POOLED), (const char*)(ws + WS_PW), 256L * DPOOL * 2, 256L * 2, 256L * 256 * 2, 0, 128L * DPOOL * 2, 128L * 256 * 2, 128, 128, 256 / BK};
            unsigned vA[2], vB[2]; voff_std(vA, DPOOL, false); voff_std(vB, 256, true);
            OrdPool S{F.bx}; EpiPool E{args.in[4], (bf16_t*)(ws + WS_YCAT), (float*)(ws + WS_SSPOOL)};
            gemm_phase<EpiPool, OrdPool, true>(F.lds, g, vA, vB, S, E);
        }
        if (BOTH(3)) xcd_barrier(bar);
    }
    if (IN(4)) {
        if (F.bx < 128) {
            constexpr long GSTR = (long)MT * 32;
            GemmDesc g{(const char*)(ws + WS_ZG), (const char*)(ws + WS_WGLU), 256L * 32, 0, 256L * DSSM * 2, 0, 128L * 32, 128L * DSSM * 2, 4 * GSTR, 128, DSSM / BK};
            unsigned vA[2], vB[2]; voff_std(vB, DSSM, true);
#pragma unroll
            for (int i = 0; i < 2; ++i) { int R, C; stage_rc(F.tid * 16 + i * 8192, R, C); vA[i] = (unsigned)(R * 32 + (C >> 4) * (int)GSTR + (C & 15) * 2); }
            OrdGlu S{F.bx}; EpiGlu E{args.in[14], (const bf16_t*)(ws + WS_ZG), (bf16_t*)(ws + WS_YCAT), (float*)(ws + WS_SSSSM)};
            gemm_phase<EpiGlu, OrdGlu, true>(F.lds, g, vA, vB, S, E);
        }
        if (BOTH(4)) xcd_barrier(bar);
    }
    if (IN(5)) {
        StaticOrder S; S.init(MT / BM, DM / BM, F.G, F.bx); Unit u0;
        LAS f32x2* XR = (LAS f32x2*)(F.lds + XTRA_OFF);
        if (S.next(0, u0)) {
            if (F.tid < 256) { const int row = u0.pm * BM + F.tid; const float* sp = (const float*)(ws + WS_SSPOOL); const float* sm = (const float*)(ws + WS_SSSSM); float a0 = 0.f, a1 = 0.f;
#pragma unroll
                for (int s = 0; s < 8; ++s) { a0 += sp[(size_t)s * MT + row]; a1 += sm[(size_t)s * MT + row]; }
                const float rp = rsqrtf(a0 * (1.0f / DPOOL) + EPS), rsm = rsqrtf(a1 * (1.0f / DSSM) + EPS); XR[F.tid] = (f32x2){rp / rsm, rsm}; }
        }
        __syncthreads();
        GemmDesc g{(const char*)(ws + WS_YCAT), (const char*)(ws + WS_WOUT), 256L * DM * 2, 0, 256L * DM * 2, 0, 128L * DM * 2, 128L * DM * 2, 128, 128, DM / BK};
        unsigned vA[2], vB[2]; voff_std(vA, DM, false); voff_std(vB, DM, false);
        EpiOut E{args.in[0], args.out, (bf16_t*)(ws + WS_H1B), (float*)(ws + WS_SSH1), XR};
        gemm_phase<EpiOut, StaticOrder, false>(F.lds, g, vA, vB, S, E);
        if (BOTH(5)) xcd_barrier(bar);
    }
    if (IN(6)) {
        GemmDesc g{(const char*)(ws + WS_H1B), (const char*)(ws + WS_WUP), (long)UPROWS * DM * 2, (long)PADROWS * DM * 2, 256L * DM * 2, 0, 64L * DM * 2, 128L * DM * 2, 128, 128, DM / BK};
        unsigned vA[2], vB[2]; voff_std(vB, DM, true);
#pragma unroll
        for (int i = 0; i < 2; ++i) { int R, C; stage_rc(F.tid * 16 + i * 8192, R, C); vA[i] = (unsigned)(((126 * (R >> 6) + (R & 63)) * DM + C) * 2); }
        OrdUp S; S.so.init(BATCH * UPT, DFF2 / BM, F.G, F.bx);
        EpiUp E{(const float*)(ws + WS_SSH1), args.in[20], args.in[21], (bf16_t*)(ws + WS_ACT)};
        gemm_phase<EpiUp, OrdUp, true>(F.lds, g, vA, vB, S, E);
        if (BOTH(6)) xcd_barrier(bar);
    }
    if (IN(7)) {
        GemmDesc g{(const char*)(ws + WS_ACT), (const char*)(ws + WS_WDOWN), 256L * DFF * 2, 0, 256L * DFF * 2, 0, 128L * DFF * 2, 128L * DFF * 2, 128, 128, DFF / BK};
        unsigned vA[2], vB[2]; voff_std(vA, DFF, false); voff_std(vB, DFF, false);
        StaticOrder S; S.init(MT / BM, DM / BM, F.G, F.bx);
        EpiDown E{args.out, args.out, args.in[23], (float*)(ws + WS_SSH2), &bar};
        gemm_phase<EpiDown, StaticOrder, false>(F.lds, g, vA, vB, S, E);
    }
#undef IN
#undef BOTH
}
}

__global__ void k_cvt_u(const bf16_t* __restrict__ upool, const bf16_t* __restrict__ ussm, float* __restrict__ u) {
    const int idx = blockIdx.x * blockDim.x + threadIdx.x; if (idx >= MT * DM) return;
    const int c = idx % DM, row = idx / DM; unsigned short v;
    if (c < DPOOL) v = upool[(size_t)row * DPOOL + c];
    else { const int cs = c - DPOOL, g = cs >> 4, h = cs & 15, cr = row / mk::TCH, p = row % mk::TCH; v = ussm[((size_t)(g * mk::NCR + cr)) * mk::ROWLEN + 16 * p + h]; }
    u[idx] = __builtin_bit_cast(float, (unsigned)v << 16);
}
__global__ void k_cvt_z(const bf16_t* __restrict__ zg, float* __restrict__ z) {
    const int idx = blockIdx.x * blockDim.x + threadIdx.x; if (idx >= MT * DSSM) return;
    const int c = idx % DSSM, row = idx / DSSM; const unsigned short v = zg[((size_t)(c >> 4) * MT + row) * 16 + (c & 15)];
    z[idx] = __builtin_bit_cast(float, (unsigned)v << 16);
}
__global__ void k_cvt_rows(const bf16_t* __restrict__ src, int lds_, float* __restrict__ dst, int ldd, int cols, int rows) {
    const size_t idx = (size_t)blockIdx.x * blockDim.x + threadIdx.x; if (idx >= (size_t)rows * cols) return;
    const int c = (int)(idx % cols); const size_t row = idx / cols; dst[row * ldd + c] = __builtin_bit_cast(float, (unsigned)src[row * lds_ + c] << 16);
}

#ifndef MK_CUT
#define MK_CUT 8
#endif
static void gemm(hipStream_t s, const float* A, int lda, const float* B, int ldb, float* C, int ldc, const float* R, int ldr, int M, int N, int K) {
    hipLaunchKernelGGL(k_gemm, dim3(N / 128, M / 128), dim3(256), 0, s, A, lda, B, ldb, C, ldc, R, ldr, K);
}

extern "C" void kernel_launch(void* const* d_in, const int* in_sizes, int n_in, void* d_out, int out_size, void* d_ws, size_t ws_size, hipStream_t stream) {
    static int grid = 0;
    if (grid == 0) {
        int dev = 0, cus = 0, per_cu = 0;
        if (n_in != 24 || out_size != MT * DM || ws_size < mk::WS_END) { fprintf(stderr, "kernel_launch: unexpected problem (n_in %d out %d ws %zu)\n", n_in, out_size, ws_size); grid = -1; return; }
        if (hipGetDevice(&dev) != hipSuccess || hipDeviceGetAttribute(&cus, hipDeviceAttributeMultiprocessorCount, dev) != hipSuccess) { grid = -1; return; }
        if (hipFuncSetAttribute((const void*)mk::mk_fwd, hipFuncAttributeMaxDynamicSharedMemorySize, mk::LDS_BYTES) != hipSuccess) { fprintf(stderr, "kernel_launch: hipFuncSetAttribute failed\n"); grid = -1; return; }
        if (hipOccupancyMaxActiveBlocksPerMultiprocessor(&per_cu, (const void*)mk::mk_fwd, 512, mk::LDS_BYTES) != hipSuccess || per_cu < 1) { fprintf(stderr, "kernel_launch: occupancy query says %d blocks/CU\n", per_cu); }
        (void)hipGetLastError();
        grid = cus;
        if (grid != 256) { fprintf(stderr, "kernel_launch: built for a 256-CU device, found %d CUs\n", cus); grid = -1; return; }
    }
    if (grid < 0) return;
    const float* x = (const float*)d_in[0];
    const float* pool_w = (const float*)d_in[3];   const float* pool_scale = (const float*)d_in[4];
    const float* lnar = (const float*)d_in[5];     const float* aim = (const float*)d_in[6];   const float* ldt = (const float*)d_in[7];
    const float* bre = (const float*)d_in[8];      const float* bim = (const float*)d_in[9];
    const float* cre = (const float*)d_in[10];     const float* cim = (const float*)d_in[11];
    const float* ssm_d = (const float*)d_in[12];   const float* glu_w = (const float*)d_in[13]; const float* glu_b = (const float*)d_in[14];
    const float* g_pool = (const float*)d_in[15];  const float* g_ssm = (const float*)d_in[16];
    const float* w_out = (const float*)d_in[17];   const float* g_ffn = (const float*)d_in[18];
    const float* w_up = (const float*)d_in[19];    const float* conv_w = (const float*)d_in[20]; const float* conv_b = (const float*)d_in[21];
    const float* w_down = (const float*)d_in[22];  const float* g_final = (const float*)d_in[23];
    float* out = (float*)d_out; char* ws = (char*)d_ws; const size_t MiB = 1u << 20; const int EB = 256;
    (void)x; (void)pool_w; (void)pool_scale; (void)lnar; (void)aim; (void)ldt; (void)bre; (void)bim; (void)cre; (void)cim; (void)ssm_d; (void)glu_w; (void)glu_b; (void)g_pool; (void)g_ssm; (void)w_out; (void)g_ffn; (void)w_up; (void)conv_w; (void)conv_b; (void)w_down; (void)g_final;

    (void)hipMemsetAsync(ws + mk::WS_CTL, 0, mk::CTL_ZERO_BYTES, stream);
    mk::Args a{};
    for (int i = 0; i < 24; ++i) a.in[i] = (const float*)d_in[i];
    a.out = out; a.ws = (unsigned char*)d_ws; a.ph_lo = 0; a.ph_hi = MK_CUT;
    hipLaunchKernelGGL(mk::mk_fwd, dim3(grid), dim3(512), mk::LDS_BYTES, stream, a);
#if MK_CUT < 8
    float* bufA = (float*)(ws + 0 * MiB); float* bufB = (float*)(ws + 64 * MiB); float* bufC = (float*)(ws + 128 * MiB); float* bufD = (float*)(ws + 192 * MiB);
    float* pooled = bufA; float* ypool = bufA + (size_t)MT * DPOOL; float* z = pooled; float* pre = bufD; float* ycat = bufB;
#if MK_CUT <= 2
    float* u = bufB;
    hipLaunchKernelGGL(k_cvt_u, dim3(MT * DM / EB), dim3(EB), 0, stream, (const bf16_t*)(ws + mk::WS_UPOOL), (const bf16_t*)(ws + mk::WS_USSM), u);
    hipLaunchKernelGGL(k_pool, dim3(MT * DPOOL / EB), dim3(EB), 0, stream, u, pooled);
    for (int gi = 0; gi < 4; ++gi) gemm(stream, pooled + gi * 128, DPOOL, pool_w + (size_t)gi * 128 * 128, 128, ypool + gi * 128, DPOOL, nullptr, 0, MT, 128, 128);
    float* y2 = bufC;
    hipLaunchKernelGGL(k_ssm_scan, dim3(2 * BATCH * NG), dim3(64), 0, stream, u, lnar, aim, ldt, bre, bim, cre, cim, y2);
    hipLaunchKernelGGL(k_ssm_post, dim3(MT * DSSM / EB), dim3(EB), 0, stream, y2, u, ssm_d, z);
    const float* pre_scale = pool_scale;
#elif MK_CUT <= 4
    hipLaunchKernelGGL(k_cvt_z, dim3(MT * DSSM / EB), dim3(EB), 0, stream, (const bf16_t*)(ws + mk::WS_ZG), z);
    hipLaunchKernelGGL(k_cvt_rows, dim3(MT * DPOOL / EB), dim3(EB), 0, stream, (const bf16_t*)(ws + mk::WS_YCAT), DM, ypool, DPOOL, DPOOL, MT);
    const float* pre_scale = nullptr;
#endif
#if MK_CUT <= 4
    gemm(stream, z, DSSM, glu_w, DSSM, pre, DSSM, nullptr, 0, MT, DSSM, DSSM);
    hipLaunchKernelGGL(k_glu, dim3(MT * DSSM / EB), dim3(EB), 0, stream, z, pre, glu_b);
#elif MK_CUT == 5
    hipLaunchKernelGGL(k_cvt_rows, dim3(MT * DPOOL / EB), dim3(EB), 0, stream, (const bf16_t*)(ws + mk::WS_YCAT), DM, ypool, DPOOL, DPOOL, MT);
    hipLaunchKernelGGL(k_cvt_rows, dim3(MT * DSSM / EB), dim3(EB), 0, stream, (const bf16_t*)(ws + mk::WS_YCAT) + DPOOL, DM, pre, DSSM, DSSM, MT);
    const float* pre_scale = nullptr;
#endif
#if MK_CUT <= 5
    hipLaunchKernelGGL(k_rmsnorm, dim3(MT / 4), dim3(256), 0, stream, ypool, DPOOL, pre_scale, g_pool, ycat, DM, DPOOL, MT);
    hipLaunchKernelGGL(k_rmsnorm, dim3(MT / 4), dim3(256), 0, stream, pre, DSSM, (const float*)nullptr, g_ssm, ycat + DPOOL, DM, DSSM, MT);
    gemm(stream, ycat, DM, w_out, DM, out, DM, x, DM, MT, DM, DM);
#endif
#if MK_CUT <= 6
    float* xn2 = bufA;
    hipLaunchKernelGGL(k_rmsnorm, dim3(MT / 4), dim3(256), 0, stream, out, DM, (const float*)nullptr, g_ffn, xn2, DM, DM, MT);
    float* up = (float*)(ws + 64 * MiB); float* act = (float*)(ws + 152 * MiB);
    for (int b = 0; b < BATCH; ++b) {
        gemm(stream, xn2 + (size_t)b * SEQ * DM, DM, w_up, DFF2, up, DFF2, nullptr, 0, SEQ, DFF2, DM);
        hipLaunchKernelGGL(k_convact, dim3(SEQ * DFF / EB), dim3(EB), 0, stream, up, conv_w, conv_b, act);
        gemm(stream, act, DFF, w_down, DM, out + (size_t)b * SEQ * DM, DM, out + (size_t)b * SEQ * DM, DM, SEQ, DM, DFF);
    }
#else
    float* actf = (float*)(ws + 0 * MiB);
    for (int b = 0; b < BATCH; ++b) {
        hipLaunchKernelGGL(k_cvt_rows, dim3(SEQ * DFF / EB), dim3(EB), 0, stream, (const bf16_t*)(ws + mk::WS_ACT) + (size_t)b * SEQ * DFF, DFF, actf, DFF, DFF, SEQ);
        gemm(stream, actf, DFF, w_down, DM, out + (size_t)b * SEQ * DM, DM, out + (size_t)b * SEQ * DM, DM, SEQ, DM, DFF);
    }
#endif
    hipLaunchKernelGGL(k_rmsnorm, dim3(MT / 4), dim3(256), 0, stream, out, DM, (const float*)nullptr, g_final, out, DM, DM, MT);
    (void)bufC;
#endif
}
```

```cpp
#define MK_CUT 8
#include <hip/hip_runtime.h>
#include <math.h>

constexpr int BATCH = 4, SEQ = 4096, DM = 1024, MT = BATCH * SEQ;
constexpr int DPOOL = 512, DSSM = 512, NG = 32, NH = 16, NS = 64;
constexpr int DFF = 2816, DFF2 = 5632;
constexpr float EPS = 1e-6f;

__global__ void k_rmsnorm(const float* x, int ldx, const float* __restrict__ pre,
                          const float* __restrict__ g, float* out, int ldo, int D, int rows) {
    const int wave = (blockIdx.x * blockDim.x + threadIdx.x) >> 6, lane = threadIdx.x & 63;
    if (wave >= rows) return;
    const float* xr = x + (size_t)wave * ldx;
    float ss = 0.f;
    for (int c = lane; c < D; c += 64) { float v = xr[c]; if (pre) v *= pre[c]; ss += v * v; }
    for (int o = 32; o; o >>= 1) ss += __shfl_xor(ss, o);
    const float inv = rsqrtf(ss / (float)D + EPS);
    float* orow = out + (size_t)wave * ldo;
    for (int c = lane; c < D; c += 64) { float v = xr[c]; if (pre) v *= pre[c]; orow[c] = v * inv * g[c]; }
}

__global__ void __launch_bounds__(256) k_gemm(const float* __restrict__ A, int lda, const float* __restrict__ B, int ldb,
                                               float* C, int ldc, const float* R, int ldr, int K) {
    __shared__ float As[16][132];
    __shared__ float Bs[16][132];
    const int tid = threadIdx.x, tx = tid & 15, ty = tid >> 4;
    const int row0 = blockIdx.y * 128, col0 = blockIdx.x * 128;
    float acc[8][8];
#pragma unroll
    for (int i = 0; i < 8; ++i)
#pragma unroll
        for (int j = 0; j < 8; ++j) acc[i][j] = 0.f;
    for (int k0 = 0; k0 < K; k0 += 16) {
#pragma unroll
        for (int p = 0; p < 2; ++p) {
            const int i = tid + p * 256, r = i >> 2, kk = (i & 3) * 4;
            const float4 v = *(const float4*)(A + (size_t)(row0 + r) * lda + k0 + kk);
            As[kk + 0][r] = v.x; As[kk + 1][r] = v.y; As[kk + 2][r] = v.z; As[kk + 3][r] = v.w;
        }
#pragma unroll
        for (int p = 0; p < 2; ++p) {
            const int i = tid + p * 256, kk = i >> 5, c = (i & 31) * 4;
            const float4 v = *(const float4*)(B + (size_t)(k0 + kk) * ldb + col0 + c);
            *(float4*)&Bs[kk][c] = v;
        }
        __syncthreads();
#pragma unroll
        for (int kk = 0; kk < 16; ++kk) {
            float a[8], b[8];
            const float4 a0 = *(const float4*)&As[kk][ty * 4], a1 = *(const float4*)&As[kk][64 + ty * 4];
            const float4 b0 = *(const float4*)&Bs[kk][tx * 4], b1 = *(const float4*)&Bs[kk][64 + tx * 4];
            a[0] = a0.x; a[1] = a0.y; a[2] = a0.z; a[3] = a0.w; a[4] = a1.x; a[5] = a1.y; a[6] = a1.z; a[7] = a1.w;
            b[0] = b0.x; b[1] = b0.y; b[2] = b0.z; b[3] = b0.w; b[4] = b1.x; b[5] = b1.y; b[6] = b1.z; b[7] = b1.w;
#pragma unroll
            for (int i = 0; i < 8; ++i)
#pragma unroll
                for (int j = 0; j < 8; ++j) acc[i][j] = fmaf(a[i], b[j], acc[i][j]);
        }
        __syncthreads();
    }
#pragma unroll
    for (int i = 0; i < 8; ++i) {
        const int r = row0 + (i < 4 ? ty * 4 + i : 64 + ty * 4 + (i - 4));
#pragma unroll
        for (int jh = 0; jh < 2; ++jh) {
            const int c = col0 + jh * 64 + tx * 4;
            float4 v = make_float4(acc[i][jh * 4 + 0], acc[i][jh * 4 + 1], acc[i][jh * 4 + 2], acc[i][jh * 4 + 3]);
            if (R) { const float4 rr = *(const float4*)(R + (size_t)r * ldr + c); v.x += rr.x; v.y += rr.y; v.z += rr.z; v.w += rr.w; }
            *(float4*)(C + (size_t)r * ldc + c) = v;
        }
    }
}

__global__ void k_pool(const float* __restrict__ u  , float* __restrict__ pooled  ) {
    const int idx = blockIdx.x * blockDim.x + threadIdx.x;
    if (idx >= MT * DPOOL) return;
    const int c = idx % DPOOL, row = idx / DPOOL, b = row / SEQ, t = row % SEQ;
    const int gi = c / 128, w = 2 << gi, half = w / 2;
    int lo = t - half, hi = t + half; if (lo < 0) lo = 0; if (hi > SEQ) hi = SEQ;
    float s = 0.f;
    for (int q = lo; q < hi; ++q) s += u[(size_t)(b * SEQ + q) * DM + c];
    pooled[idx] = s / (float)(hi - lo) - u[(size_t)row * DM + c];
}

__global__ void __launch_bounds__(64) k_ssm_scan(const float* __restrict__ u  ,
        const float* __restrict__ lnar, const float* __restrict__ aim, const float* __restrict__ ldt,
        const float* __restrict__ bre, const float* __restrict__ bim, const float* __restrict__ cre, const float* __restrict__ cim,
        float* __restrict__ y  ) {
    const int n = threadIdx.x;
    const int g = blockIdx.x % NG, b = (blockIdx.x / NG) % BATCH, dir = blockIdx.x / (NG * BATCH);
    const float dt = expf(ldt[dir * NG + g]);
    const float a_re = -expf(lnar[(dir * NG + g) * NS + n]), a_im = aim[(dir * NG + g) * NS + n];
    const float mag = expf(a_re * dt), ang = a_im * dt;
    const float lam_re = mag * cosf(ang), lam_im = mag * sinf(ang);
    const float den = a_re * a_re + a_im * a_im;
    const float f_re = ((lam_re - 1.0f) * a_re + lam_im * a_im) / den;
    const float f_im = (lam_im * a_re - (lam_re - 1.0f) * a_im) / den;
    float Br[NH], Bi[NH], Cr[NH], Ci[NH];
#pragma unroll
    for (int h = 0; h < NH; ++h) {
        Br[h] = bre[((size_t)(dir * NG + g) * NS + n) * NH + h];
        Bi[h] = bim[((size_t)(dir * NG + g) * NS + n) * NH + h];
        Cr[h] = cre[((size_t)(dir * NG + g) * NH + h) * NS + n];
        Ci[h] = cim[((size_t)(dir * NG + g) * NH + h) * NS + n];
    }
    float s_re = 0.f, s_im = 0.f;
    float* yd = y + (size_t)dir * MT * DSSM;
    for (int i = 0; i < SEQ; ++i) {
        const int t = dir ? (SEQ - 1 - i) : i;
        const float* ur = u + (size_t)(b * SEQ + t) * DM + DPOOL + g * NH;
        float bu_re = 0.f, bu_im = 0.f;
#pragma unroll
        for (int h = 0; h < NH; ++h) { const float uv = ur[h]; bu_re = fmaf(Br[h], uv, bu_re); bu_im = fmaf(Bi[h], uv, bu_im); }
        const float in_re = f_re * bu_re - f_im * bu_im, in_im = f_re * bu_im + f_im * bu_re;
        const float nr = lam_re * s_re - lam_im * s_im + in_re;
        const float ni = lam_re * s_im + lam_im * s_re + in_im;
        s_re = nr; s_im = ni;
        float mine = 0.f;
#pragma unroll
        for (int h = 0; h < NH; ++h) {
            float p = Cr[h] * s_re - Ci[h] * s_im;
#pragma unroll
            for (int o = 32; o; o >>= 1) p += __shfl_xor(p, o);
            if (n == h) mine = p;
        }
        if (n < NH) yd[(size_t)(b * SEQ + t) * DSSM + g * NH + n] = mine;
    }
}

__device__ __forceinline__ float gelu_tanh(float x) {
    const float k = 0.7978845608028654f;
    return 0.5f * x * (1.0f + tanhf(k * (x + 0.044715f * x * x * x)));
}
__device__ __forceinline__ float sigmoidf_(float x) { return 1.0f / (1.0f + expf(-x)); }

__global__ void k_ssm_post(const float* __restrict__ y2, const float* __restrict__ u, const float* __restrict__ d, float* __restrict__ z) {
    const int idx = blockIdx.x * blockDim.x + threadIdx.x;
    if (idx >= MT * DSSM) return;
    const int c = idx % DSSM, row = idx / DSSM;
    const float yv = y2[idx] + y2[(size_t)MT * DSSM + idx] + d[c] * u[(size_t)row * DM + DPOOL + c];
    z[idx] = gelu_tanh(yv);
}
__global__ void k_glu(const float* __restrict__ z, float* __restrict__ pre, const float* __restrict__ gb) {
    const int idx = blockIdx.x * blockDim.x + threadIdx.x;
    if (idx >= MT * DSSM) return;
    const int c = idx % DSSM;
    pre[idx] = z[idx] * sigmoidf_(pre[idx] + gb[c]);
}
__global__ void k_convact(const float* __restrict__ up  , const float* __restrict__ cw, const float* __restrict__ cb, float* __restrict__ act  ) {
    const int idx = blockIdx.x * blockDim.x + threadIdx.x;
    if (idx >= SEQ * DFF) return;
    const int f = idx % DFF, t = idx / DFF;
    float v = cb[f], gt = cb[DFF + f];
#pragma unroll
    for (int k = 0; k < 3; ++k) {
        const int q = t + k - 1;
        if (q >= 0 && q < SEQ) {
            v = fmaf(up[(size_t)q * DFF2 + f], cw[k * DFF2 + f], v);
            gt = fmaf(up[(size_t)q * DFF2 + DFF + f], cw[k * DFF2 + DFF + f], gt);
        }
    }
    act[idx] = v * (gt * sigmoidf_(gt));
}


#include <cstdio>
#include <cstdint>
#define LAS __attribute__((address_space(3)))
#define GAS __attribute__((address_space(1)))
typedef unsigned short bf16_t;
typedef short bf16x8 __attribute__((ext_vector_type(8)));
typedef float f32x4 __attribute__((ext_vector_type(4)));
typedef float f32x2 __attribute__((ext_vector_type(2)));
typedef unsigned u32x4 __attribute__((ext_vector_type(4)));
typedef unsigned u32x2 __attribute__((ext_vector_type(2)));

namespace mk {
constexpr int TCH = 32;
constexpr int K1 = 16 * TCH;
constexpr int ROWLEN = K1 + 256;
constexpr int NCR = MT / TCH;
constexpr int NCHB = SEQ / TCH;
constexpr int PADROWS = 4352;
constexpr int UPT = 17;
constexpr int UPROWS = 252;

constexpr size_t MiB = 1u << 20;
constexpr size_t WS_CTL = 0, CTL_ZERO_BYTES = 64 * 1024;
constexpr size_t WS_R0 = 1 * MiB;
constexpr size_t WS_SSPOOL = 2 * MiB;
constexpr size_t WS_SSSSM = WS_SSPOOL + 8 * MT * 4;
constexpr size_t WS_SSH1 = WS_SSSSM + 8 * MT * 4;
constexpr size_t WS_SSH2 = WS_SSH1 + 4 * MT * 4;
constexpr size_t WS_WIN = 8 * MiB, WS_WOUT = 10 * MiB, WS_WGLU = 12 * MiB, WS_PW = 12 * MiB + 512 * 1024;
constexpr size_t WS_WUP = 13 * MiB, WS_WDOWN = 24 * MiB;
constexpr size_t WS_WAB = 30 * MiB;
constexpr size_t WS_TB = 38 * MiB;
constexpr size_t WS_H1B = 62 * MiB;
constexpr size_t WS_XB = 96 * MiB;
constexpr size_t WS_YCAT = 96 * MiB;
constexpr size_t WS_UPOOL = 128 * MiB;
constexpr size_t WS_USSM = 144 * MiB;
constexpr size_t WS_FG = 168 * MiB;
constexpr size_t WS_POOLED = 184 * MiB;
constexpr size_t WS_ZG = 200 * MiB;
constexpr size_t WS_ACT = 96 * MiB;
constexpr size_t WS_END = 216 * MiB;

constexpr int RING_BYTES = 131072, XTRA_OFF = RING_BYTES, XTRA_BYTES = 12288, LDSCTL_OFF = XTRA_OFF + XTRA_BYTES, LDS_BYTES = 147456;

__device__ __forceinline__ unsigned f2bf(float f) { unsigned u = __builtin_bit_cast(unsigned, f); return (u + 0x7fffu + ((u >> 16) & 1u)) >> 16; }
__device__ __forceinline__ unsigned pk2(float lo, float hi) { return f2bf(lo) | (f2bf(hi) << 16); }
__device__ __forceinline__ unsigned cvt_pk_bf16(float lo, float hi) { unsigned r; asm volatile("v_cvt_pk_bf16_f32 %0, %1, %2" : "=v"(r) : "v"(lo), "v"(hi)); return r; }
__device__ __forceinline__ u32x4 pack8(f32x4 a, f32x4 b) { u32x4 w; w.x = cvt_pk_bf16(a[0], a[1]); w.y = cvt_pk_bf16(a[2], a[3]); w.z = cvt_pk_bf16(b[0], b[1]); w.w = cvt_pk_bf16(b[2], b[3]); return w; }
__device__ __forceinline__ u32x2 pack4(f32x4 a) { u32x2 w; w.x = cvt_pk_bf16(a[0], a[1]); w.y = cvt_pk_bf16(a[2], a[3]); return w; }
__device__ __forceinline__ float bflo(unsigned w) { return __builtin_bit_cast(float, w << 16); }
__device__ __forceinline__ float bfhi(unsigned w) { return __builtin_bit_cast(float, w & 0xffff0000u); }
__device__ __forceinline__ void unpack8(u32x4 w, f32x4& a, f32x4& b) { a[0] = bflo(w.x); a[1] = bfhi(w.x); a[2] = bflo(w.y); a[3] = bfhi(w.y); b[0] = bflo(w.z); b[1] = bfhi(w.z); b[2] = bflo(w.w); b[3] = bfhi(w.w); }
__device__ __forceinline__ float fast_sigmoid(float x) { return __builtin_amdgcn_rcpf(1.0f + __builtin_amdgcn_exp2f(-1.4426950408889634f * x)); }
__device__ __forceinline__ float fast_gelu_tanh(float x) {
    const float t = x * (1.0f + 0.044715f * x * x);
    return x * __builtin_amdgcn_rcpf(1.0f + __builtin_amdgcn_exp2f(-2.0f * 0.7978845608028654f * 1.4426950408889634f * t));
}
__device__ __forceinline__ float wave_sum(float v) {
#pragma unroll
    for (int o = 1; o < 64; o <<= 1) v += __shfl_xor(v, o);
    return v;
}
__device__ __forceinline__ float dpp_ror1(float v)  { return __builtin_bit_cast(float, __builtin_amdgcn_update_dpp(0, __builtin_bit_cast(int, v), 0x121, 0xf, 0xf, false)); }
__device__ __forceinline__ float dpp_ror15(float v) { return __builtin_bit_cast(float, __builtin_amdgcn_update_dpp(0, __builtin_bit_cast(int, v), 0x12F, 0xf, 0xf, false)); }
#define LDS_WAIT() asm volatile("s_waitcnt lgkmcnt(0)" ::: "memory")
#define VM_WAIT() asm volatile("s_waitcnt vmcnt(0)" ::: "memory")

#define XB_TMO      128
#define XB_XCNT(j)  (256  + 64 * (j))
#define XB_XSUB(j)  (1280 + 64 * (j))
#define XB_XGEN(j)  (2304 + 64 * (j))
#define XB_TOP      3328
#define XB_TOPGEN   3392
#define XCD_BAR_WORDS 3456
#define XB_SPIN_CAP (1u << 18)
__device__ __forceinline__ unsigned xb_ld(unsigned* p)              { return __hip_atomic_load(p, __ATOMIC_RELAXED, __HIP_MEMORY_SCOPE_AGENT); }
__device__ __forceinline__ unsigned xb_add(unsigned* p, unsigned v) { return __hip_atomic_fetch_add(p, v, __ATOMIC_RELAXED, __HIP_MEMORY_SCOPE_AGENT); }
__device__ __forceinline__ unsigned xb_xcc_id() { return (unsigned)__builtin_amdgcn_s_getreg((3 << 11) | 20) & 0xFu; }
#define XB_SPIN(cond, bar) do { unsigned _sp = 0; while (cond) { __builtin_amdgcn_s_sleep(1); \
    if ((++_sp & 255u) == 0u) { if (xb_ld(&(bar)[XB_TMO])) break; if (_sp > XB_SPIN_CAP) { atomicAdd(&(bar)[XB_TMO], 1u); break; } } } } while (0)
struct XcdBarrier { unsigned* bar; unsigned x; volatile LAS unsigned* st; };
__device__ __forceinline__ XcdBarrier xcd_barrier_post(unsigned* bar, volatile LAS unsigned* st) {
    XcdBarrier b; b.bar = bar; b.x = xb_xcc_id(); b.st = st;
    if (threadIdx.x == 0) (void)xb_add(&bar[XB_XCNT(b.x)], 1u);
    return b;
}
__device__ __forceinline__ void xcd_barrier_complete(unsigned* bar, unsigned x, unsigned& nloc, unsigned& nx) {
    const unsigned G = gridDim.x * gridDim.y * gridDim.z;
    unsigned sum, cnt, mine, sp = 0u;
    for (;;) {
        sum = 0u; cnt = 0u; mine = 0u;
#pragma unroll
        for (unsigned j = 0; j < 16; ++j) { const unsigned c = xb_ld(&bar[XB_XCNT(j)]); sum += c; cnt += (c > 0u) ? 1u : 0u; mine = (j == x) ? c : mine; }
        if (sum == G) break;
        __builtin_amdgcn_s_sleep(1);
        if ((++sp & 255u) == 0u) { if (xb_ld(&bar[XB_TMO])) break; if (sp > XB_SPIN_CAP) { atomicAdd(&bar[XB_TMO], 1u); break; } }
    }
    nloc = mine > 0u ? mine : 1u; nx = cnt > 0u ? cnt : 1u;
}
__device__ __forceinline__ void xcd_barrier(const XcdBarrier& b) {
    asm volatile("s_waitcnt vmcnt(0)" ::: "memory");
    __syncthreads();
    if (threadIdx.x == 0) {
        unsigned* bar = b.bar;
        __builtin_amdgcn_s_waitcnt(0);
        unsigned nloc = b.st[0], nx = b.st[1];
        if (nloc == 0u) { xcd_barrier_complete(bar, b.x, nloc, nx); b.st[0] = nloc; b.st[1] = nx; }
        const unsigned old = xb_add(&bar[XB_XSUB(b.x)], 1u);
        const unsigned gen = old / nloc;
        if (old + 1u == (gen + 1u) * nloc) {
            __builtin_amdgcn_fence(__ATOMIC_RELEASE, "agent");
            asm volatile("s_waitcnt vmcnt(0)" ::: "memory");
            const unsigned og = xb_add(&bar[XB_TOP], 1u);
            const unsigned tg = og / nx;
            if (og + 1u == (tg + 1u) * nx) xb_add(&bar[XB_TOPGEN], 1u);
            else XB_SPIN(xb_ld(&bar[XB_TOPGEN]) == tg, bar);
            __builtin_amdgcn_fence(__ATOMIC_ACQUIRE, "agent");
            xb_add(&bar[XB_XGEN(b.x)], 1u);
            asm volatile("s_waitcnt vmcnt(0)" ::: "memory");
        } else {
            XB_SPIN(xb_ld(&bar[XB_XGEN(b.x)]) == gen, bar);
            __builtin_amdgcn_fence(__ATOMIC_ACQUIRE, "agent");
            asm volatile("s_waitcnt vmcnt(0)" ::: "memory");
        }
    }
    __syncthreads();
}

constexpr int BM = 256, BK = 64, HALF = 128, HTB = HALF * BK * 2, STAGE_BYTES = 8 * HTB, NXCD = 8, WGM = 8;
__host__ __device__ __forceinline__ int lds_byte(int r, int c) { const int st = (r >> 4) * 2 + (c >> 5), rr = r & 15, cc = c & 31, ob = rr * 64 + cc * 2; return st * 1024 + (ob ^ (((ob >> 9) & 1) << 5)); }
__host__ __device__ __forceinline__ void stage_rc(int b, int& R, int& C) { const int st = b / 1024, sb = b % 1024, swz = sb ^ (((sb >> 9) & 1) << 5); R = (st >> 1) * 16 + swz / 64; C = (st & 1) * 32 + (swz % 64) / 2; }
__host__ __device__ __forceinline__ int perm32(int rho) { const int n = rho >> 4, i = rho & 15; return 8 * (i >> 2) + 4 * n + (i & 3); }

struct Unit { int pm, pn, g; };
struct GemmDesc { const char* A; const char* B; long a_pm, a_g, b_pn, b_g, a_h, b_h, a_k, b_k; int nt; };

struct StaticOrder {
    int nM, nN, nwg, G, c;
    __device__ void init(int nM_, int nN_, int G_, int c_) { nM = nM_; nN = nN_; nwg = nM * nN; G = G_; c = c_; }
    __device__ bool next(int i, Unit& u) const {
        const long L = (long)i * G + c; if (L >= nwg) return false;
        int wgid = (int)L; { const int q = nwg / NXCD, r = nwg % NXCD, xcd = wgid % NXCD, off = wgid / NXCD; wgid = (xcd < r ? xcd * (q + 1) : r * (q + 1) + (xcd - r) * q) + off; }
        const int nig = WGM * nN, gid = wgid / nig, fm = gid * WGM, gsz = (nM - fm) < WGM ? (nM - fm) : WGM;
        u.pm = fm + ((wgid % nig) % gsz); u.pn = (wgid % nig) / gsz; u.g = 0; return true;
    }
};

template <class Epi, class Sched, bool ALIGN_EPI>
__device__ __forceinline__ void gemm_phase(LAS unsigned char* lds, const GemmDesc g, const unsigned (&voffA)[2], const unsigned (&voffB)[2], const Sched& S, Epi& E) {
    const int tid = threadIdx.x, wid = __builtin_amdgcn_readfirstlane(tid >> 6), lane = tid & 63, wr = wid >> 2, wc = wid & 3, fr = lane & 15, fq = lane >> 4;
    const int nt = g.nt;
    const long kstepA = g.a_k, kstepB = g.b_k, hstepA = g.a_h, hstepB = g.b_h;
    const unsigned ldsw = (unsigned)wid * 1024u;
    const int aoff = lds_byte(wr * 64 + fr, fq * 8), boff = lds_byte(wc * 32 + fr, fq * 8);
#define PG8_SA(b, h) (((b) * 2 + (h)) * HTB)
#define PG8_SB(b, h) ((4 + (b) * 2 + (h)) * HTB)
#define PG8_STAGE(bufoff, gbase, voff) do { _Pragma("unroll") for (int _i = 0; _i < 2; ++_i) \
        __builtin_amdgcn_global_load_lds((const unsigned*)((const char*)(gbase) + (voff)[_i]), (LAS unsigned*)(lds + (bufoff) + ldsw + _i * 8192), 16, 0, 0); } while (0)
#define PG8_LDA(dst, b, h) do { _Pragma("unroll") for (int m = 0; m < 4; ++m) _Pragma("unroll") for (int k = 0; k < 2; ++k) dst[m][k] = *(const LAS bf16x8*)(lds + PG8_SA(b, h) + aoff + m * 2048 + k * 1024); } while (0)
#define PG8_LDB(dst, b, h) do { _Pragma("unroll") for (int n = 0; n < 2; ++n) _Pragma("unroll") for (int k = 0; k < 2; ++k) dst[n][k] = *(const LAS bf16x8*)(lds + PG8_SB(b, h) + boff + n * 2048 + k * 1024); } while (0)
#define PG8_MMA(ai, bj, At, Bt) do { __builtin_amdgcn_s_setprio(1); _Pragma("unroll") for (int m = 0; m < 4; ++m) _Pragma("unroll") for (int n = 0; n < 2; ++n) _Pragma("unroll") for (int k = 0; k < 2; ++k) \
        acc[ai][bj][m][n] = __builtin_amdgcn_mfma_f32_16x16x32_bf16(Bt[n][k], At[m][k], acc[ai][bj][m][n], 0, 0, 0); __builtin_amdgcn_s_setprio(0); } while (0)
#define PG8_WAIT_V(n) asm volatile("s_waitcnt vmcnt(" #n ")" ::: "memory")
#define PG8_WAIT_L(n) asm volatile("s_waitcnt lgkmcnt(" #n ")" ::: "memory")
#define PG8_BAR __builtin_amdgcn_s_barrier()
#define PG8_SCHED __builtin_amdgcn_sched_barrier(0)
    Unit cur, nxt; int ui = 0;
    if (!S.next(0, cur)) return;
    f32x4 acc[2][2][4][2];
#pragma unroll
    for (int a = 0; a < 2; ++a)
#pragma unroll
        for (int b = 0; b < 2; ++b)
#pragma unroll
            for (int m = 0; m < 4; ++m)
#pragma unroll
                for (int n = 0; n < 2; ++n) acc[a][b][m][n] = (f32x4){0.f, 0.f, 0.f, 0.f};
    bf16x8 At[4][2], B0[2][2], B1[2][2];
    const char* cA = g.A + (long)cur.pm * g.a_pm + (long)cur.g * g.a_g; const char* cB = g.B + (long)cur.pn * g.b_pn + (long)cur.g * g.b_g;
    PG8_STAGE(PG8_SB(0, 0), cB, voffB); PG8_STAGE(PG8_SB(0, 1), cB + hstepB, voffB); PG8_STAGE(PG8_SA(0, 0), cA, voffA); PG8_STAGE(PG8_SA(0, 1), cA + hstepA, voffA);
    if (wr == 1) PG8_BAR;
    PG8_WAIT_V(2); PG8_BAR;
    PG8_STAGE(PG8_SB(1, 0), cB + kstepB, voffB); PG8_STAGE(PG8_SA(1, 0), cA + kstepA, voffA); PG8_STAGE(PG8_SB(1, 1), cB + hstepB + kstepB, voffB);
    PG8_WAIT_V(6); PG8_BAR;
    for (;;) {
        const bool has_next = S.next(ui + 1, nxt);
        const char* nA = has_next ? g.A + (long)nxt.pm * g.a_pm + (long)nxt.g * g.a_g : cA; const char* nB = has_next ? g.B + (long)nxt.pn * g.b_pn + (long)nxt.g * g.b_g : cB;
        for (int t = 0; t < nt; t += 2) {
            const bool last = (t == nt - 2);
            const char* a1 = cA + (long)(t + 1) * kstepA;
            const char* a2 = last ? nA : cA + (long)(t + 2) * kstepA; const char* b2 = last ? nB : cB + (long)(t + 2) * kstepB;
            const char* a3 = a2 + kstepA; const char* b3 = b2 + kstepB;
            PG8_LDB(B0, 0, 0); PG8_LDB(B1, 0, 1); PG8_SCHED; PG8_LDA(At, 0, 0); PG8_STAGE(PG8_SA(1, 1), a1 + hstepA, voffA);
            PG8_WAIT_V(8); PG8_WAIT_L(0); PG8_BAR; PG8_MMA(0, 0, At, B0); PG8_MMA(0, 1, At, B1); PG8_BAR; PG8_SCHED;
            PG8_LDA(At, 0, 1); PG8_STAGE(PG8_SB(0, 0), b2, voffB); PG8_STAGE(PG8_SB(0, 1), b2 + hstepB, voffB); PG8_STAGE(PG8_SA(0, 0), a2, voffA);
            PG8_WAIT_V(8); PG8_WAIT_L(0); PG8_BAR; PG8_MMA(1, 0, At, B0); PG8_MMA(1, 1, At, B1); PG8_BAR; PG8_SCHED;
            PG8_LDB(B0, 1, 0); PG8_LDB(B1, 1, 1); PG8_SCHED; PG8_LDA(At, 1, 0); PG8_STAGE(PG8_SA(0, 1), a2 + hstepA, voffA);
            PG8_WAIT_V(8); PG8_WAIT_L(0); PG8_BAR; PG8_MMA(0, 0, At, B0); PG8_MMA(0, 1, At, B1); PG8_BAR; PG8_SCHED;
            PG8_LDA(At, 1, 1); PG8_STAGE(PG8_SB(1, 0), b3, voffB); PG8_STAGE(PG8_SB(1, 1), b3 + hstepB, voffB); PG8_STAGE(PG8_SA(1, 0), a3, voffA);
            PG8_WAIT_V(8); PG8_WAIT_L(0); PG8_BAR; PG8_MMA(1, 0, At, B0); PG8_MMA(1, 1, At, B1); PG8_BAR; PG8_SCHED;
            if constexpr (Epi::HAS_MID) { if (t + 2 == Epi::MID_T) E.mid(acc, wr, fr); }
        }
        if constexpr (ALIGN_EPI) { if (wr == 0) PG8_BAR; }
        if constexpr (!Epi::AFTER_DRAIN) { E(acc, cur, wr, wc, fr, fq); }
        if (!has_next) break;
#pragma unroll
        for (int a = 0; a < 2; ++a)
#pragma unroll
            for (int b = 0; b < 2; ++b)
#pragma unroll
                for (int m = 0; m < 4; ++m)
#pragma unroll
                    for (int n = 0; n < 2; ++n) acc[a][b][m][n] = (f32x4){0.f, 0.f, 0.f, 0.f};
        cur = nxt; cA = nA; cB = nB; ++ui;
        if constexpr (ALIGN_EPI) { if (wr == 1) PG8_BAR; }
    }
    PG8_WAIT_V(0);
    if constexpr (!ALIGN_EPI) { if (wr == 0) PG8_BAR; }
    PG8_BAR;
    if constexpr (Epi::AFTER_DRAIN) { E.fused(acc, cur, wr, wc, fr, fq, lds, wid, lane); }
#undef PG8_SA
#undef PG8_SB
#undef PG8_STAGE
#undef PG8_LDA
#undef PG8_LDB
#undef PG8_MMA
#undef PG8_WAIT_V
#undef PG8_WAIT_L
#undef PG8_BAR
#undef PG8_SCHED
}

__device__ __forceinline__ void voff_std(unsigned (&v)[2], int ld, bool perm) {
#pragma unroll
    for (int i = 0; i < 2; ++i) { int R, C; stage_rc((int)threadIdx.x * 16 + i * 8192, R, C); const int Rb = perm ? ((R & ~31) + perm32(R & 31)) : R; v[i] = (unsigned)(Rb * ld + C) * 2u; }
}

typedef f32x4 Acc[2][2][4][2];

struct EpiU {
    static constexpr bool PERM = true, AFTER_DRAIN = false, HAS_MID = false; static constexpr int MID_T = 0;
    const float* r0; bf16_t* upool; bf16_t* ussm;
    __device__ __forceinline__ void operator()(Acc& acc, const Unit& u, int wr, int wc, int fr, int fq) const {
#pragma unroll
        for (int ai = 0; ai < 2; ++ai)
#pragma unroll
            for (int m = 0; m < 4; ++m) {
                const int row = u.pm * BM + ai * HALF + wr * 64 + m * 16 + fr; const float rs = r0[row];
#pragma unroll
                for (int bj = 0; bj < 2; ++bj) {
                    const int c8 = u.pn * BM + bj * HALF + wc * 32 + 8 * fq;
                    const u32x4 w = pack8(acc[ai][bj][m][0] * rs, acc[ai][bj][m][1] * rs);
                    if (u.pn < 2) *(u32x4*)(upool + (size_t)row * DPOOL + c8) = w;
                    else { const int cs = c8 - DPOOL, gg = cs >> 4, h0 = cs & 15, cr = row / TCH, p = row % TCH;
                           *(u32x4*)(ussm + ((size_t)(gg * NCR + cr) * ROWLEN + 16 * p + h0)) = w; }
                }
            }
    }
};
struct EpiFG {
    static constexpr bool PERM = false, AFTER_DRAIN = false, HAS_MID = false; static constexpr int MID_T = 0;
    float* fg;
    __device__ __forceinline__ void operator()(Acc& acc, const Unit& u, int wr, int wc, int fr, int fq) const {
#pragma unroll
        for (int ai = 0; ai < 2; ++ai)
#pragma unroll
            for (int m = 0; m < 4; ++m) {
                const int cr = u.pm * BM + ai * HALF + wr * 64 + m * 16 + fr; float* rowp = fg + ((size_t)u.g * NCR + cr) * 256 + wc * 32 + 4 * fq;
#pragma unroll
                for (int bj = 0; bj < 2; ++bj)
#pragma unroll
                    for (int n = 0; n < 2; ++n) *(f32x4*)(rowp + bj * HALF + n * 16) = acc[ai][bj][m][n];
            }
    }
};
struct EpiZ {
    static constexpr bool PERM = true, AFTER_DRAIN = false, HAS_MID = false; static constexpr int MID_T = 0;
    const bf16_t* ussm; const float* dvec; bf16_t* zg;
    __device__ __forceinline__ void operator()(Acc& acc, const Unit& u, int wr, int wc, int fr, int fq) const {
#pragma unroll
        for (int bj = 0; bj < 2; ++bj) {
            const int c8 = u.pn * BM + bj * HALF + wc * 32 + 8 * fq;
            const f32x4 d0 = *(const f32x4*)(dvec + u.g * 16 + (c8 & 15)), d1 = *(const f32x4*)(dvec + u.g * 16 + (c8 & 15) + 4);
#pragma unroll
            for (int ai = 0; ai < 2; ++ai)
#pragma unroll
                for (int m = 0; m < 4; ++m) {
                    const int cr = u.pm * BM + ai * HALF + wr * 64 + m * 16 + fr;
                    const u32x4 uw = *(const u32x4*)(ussm + ((size_t)(u.g * NCR + cr) * ROWLEN + c8));
                    f32x4 u0, u1; unpack8(uw, u0, u1);
                    f32x4 y0 = acc[ai][bj][m][0] + d0 * u0, y1 = acc[ai][bj][m][1] + d1 * u1;
#pragma unroll
                    for (int i = 0; i < 4; ++i) { y0[i] = fast_gelu_tanh(y0[i]); y1[i] = fast_gelu_tanh(y1[i]); }
                    *(u32x4*)(zg + ((size_t)u.g * MT * 16 + (size_t)cr * K1 + c8)) = pack8(y0, y1);
                }
        }
    }
};
struct EpiPool {
    static constexpr bool PERM = true, AFTER_DRAIN = false, HAS_MID = false; static constexpr int MID_T = 0;
    const float* pscale; bf16_t* ycat; float* ss;
    __device__ __forceinline__ void operator()(Acc& acc, const Unit& u, int wr, int wc, int fr, int fq) const {
        f32x4 sc[2][2];
#pragma unroll
        for (int bj = 0; bj < 2; ++bj) { const int c8 = u.pn * BM + bj * HALF + wc * 32 + 8 * fq; sc[bj][0] = *(const f32x4*)(pscale + c8); sc[bj][1] = *(const f32x4*)(pscale + c8 + 4); }
#pragma unroll
        for (int ai = 0; ai < 2; ++ai)
#pragma unroll
            for (int m = 0; m < 4; ++m) {
                const int row = u.pm * BM + ai * HALF + wr * 64 + m * 16 + fr; float q = 0.f;
#pragma unroll
                for (int bj = 0; bj < 2; ++bj) {
                    const int c8 = u.pn * BM + bj * HALF + wc * 32 + 8 * fq;
                    const f32x4 v0 = acc[ai][bj][m][0] * sc[bj][0], v1 = acc[ai][bj][m][1] * sc[bj][1];
                    q += (v0[0] * v0[0] + v0[1] * v0[1]) + (v0[2] * v0[2] + v0[3] * v0[3]) + (v1[0] * v1[0] + v1[1] * v1[1]) + (v1[2] * v1[2] + v1[3] * v1[3]);
                    *(u32x4*)(ycat + (size_t)row * DM + c8) = pack8(v0, v1);
                }
                q += __shfl_xor(q, 16); q += __shfl_xor(q, 32);
                if (fq == 0) ss[(size_t)(u.pn * 4 + wc) * MT + row] = q;
            }
    }
};
struct EpiGlu {
    static constexpr bool PERM = true, AFTER_DRAIN = false, HAS_MID = false; static constexpr int MID_T = 0;
    const float* gb; const bf16_t* zg; bf16_t* ycat; float* ss;
    __device__ __forceinline__ void operator()(Acc& acc, const Unit& u, int wr, int wc, int fr, int fq) const {
        f32x4 bv[2][2];
#pragma unroll
        for (int bj = 0; bj < 2; ++bj) { const int c8 = u.pn * BM + bj * HALF + wc * 32 + 8 * fq; bv[bj][0] = *(const f32x4*)(gb + c8); bv[bj][1] = *(const f32x4*)(gb + c8 + 4); }
#pragma unroll
        for (int ai = 0; ai < 2; ++ai)
#pragma unroll
            for (int m = 0; m < 4; ++m) {
                const int row = u.pm * BM + ai * HALF + wr * 64 + m * 16 + fr; float q = 0.f;
#pragma unroll
                for (int bj = 0; bj < 2; ++bj) {
                    const int c8 = u.pn * BM + bj * HALF + wc * 32 + 8 * fq;
                    const u32x4 zw = *(const u32x4*)(zg + ((size_t)(c8 >> 4) * MT + row) * 16 + (c8 & 15));
                    f32x4 z0, z1; unpack8(zw, z0, z1);
                    f32x4 v0 = acc[ai][bj][m][0] + bv[bj][0], v1 = acc[ai][bj][m][1] + bv[bj][1];
#pragma unroll
                    for (int i = 0; i < 4; ++i) { v0[i] = z0[i] * fast_sigmoid(v0[i]); v1[i] = z1[i] * fast_sigmoid(v1[i]); }
                    q += (v0[0] * v0[0] + v0[1] * v0[1]) + (v0[2] * v0[2] + v0[3] * v0[3]) + (v1[0] * v1[0] + v1[1] * v1[1]) + (v1[2] * v1[2] + v1[3] * v1[3]);
                    *(u32x4*)(ycat + (size_t)row * DM + DPOOL + c8) = pack8(v0, v1);
                }
                q += __shfl_xor(q, 16); q += __shfl_xor(q, 32);
                if (fq == 0) ss[(size_t)(u.pn * 4 + wc) * MT + row] = q;
            }
    }
};
struct EpiOut {
    static constexpr bool PERM = false, AFTER_DRAIN = true, HAS_MID = true; static constexpr int MID_T = 8;
    const float* x; bf16_t* h1b; float* ss; LAS f32x2* XR; float ratio[2][4];
    __device__ __forceinline__ void mid(Acc& acc, int wr, int fr) const {
#pragma unroll
        for (int ai = 0; ai < 2; ++ai)
#pragma unroll
            for (int m = 0; m < 4; ++m) { const float ratio = this->ratio[ai][m];
#pragma unroll
                for (int bj = 0; bj < 2; ++bj)
#pragma unroll
                    for (int n = 0; n < 2; ++n) acc[ai][bj][m][n] = acc[ai][bj][m][n] * ratio; }
    }
    __device__ __forceinline__ void fused(Acc& acc, const Unit& u, int wr, int wc, int fr, int fq, LAS unsigned char* lds, int wid, int lane) const {
        LAS float* P = (LAS float*)lds;
        const int col0 = u.pn * BM + wc * 32 + 4 * fq;
#pragma unroll
        for (int ai = 0; ai < 2; ++ai)
#pragma unroll
            for (int m = 0; m < 4; ++m) {
                const int lr = ai * HALF + wr * 64 + m * 16 + fr, row = u.pm * BM + lr; const float rs = XR[lr].y; float q = 0.f;
                const size_t prow = (size_t)(row >> 12) * PADROWS + 1 + (row & 4095);
#pragma unroll
                for (int bj = 0; bj < 2; ++bj)
#pragma unroll
                    for (int n = 0; n < 2; ++n) {
                        const int c = col0 + bj * HALF + n * 16;
                        const f32x4 xv = *(const f32x4*)(x + (size_t)row * DM + c);
                        const f32x4 hv = xv + acc[ai][bj][m][n] * rs;
                        q += (hv[0] * hv[0] + hv[1] * hv[1]) + (hv[2] * hv[2] + hv[3] * hv[3]);
                        *(u32x2*)(h1b + prow * DM + c) = pack4(hv);
                    }
                q += __shfl_xor(q, 16); q += __shfl_xor(q, 32);
                if (fq == 0) P[lr * 4 + wc] = q;
            }
        LDS_WAIT(); __builtin_amdgcn_s_barrier(); asm volatile("" ::: "memory");
        const int tid = wid * 64 + lane;
        if (tid < 256) ss[(size_t)u.pn * MT + u.pm * BM + tid] = (P[tid * 4 + 0] + P[tid * 4 + 1]) + (P[tid * 4 + 2] + P[tid * 4 + 3]);
    }
};
struct EpiUp {
    static constexpr bool PERM = true, AFTER_DRAIN = false, HAS_MID = false; static constexpr int MID_T = 0;
    const float* ssh1; const float* cw; const float* cb; bf16_t* act;
    __device__ __forceinline__ void operator()(Acc& acc, const Unit& u, int wr, int wc, int fr, int fq) const {
        const int j = u.pm, b = u.g;
        int tokv[2][4];
#pragma unroll
        for (int ai = 0; ai < 2; ++ai)
#pragma unroll
            for (int m = 0; m < 4; ++m) {
                const int w = 64 * ai + 16 * m + fr, t = UPROWS * j + 126 * wr + w - 1; const bool in = (t >= 0 && t < SEQ);
                const int tok = b * SEQ + (in ? t : 0);
                const float s = (ssh1[tok] + ssh1[MT + tok]) + (ssh1[2 * MT + tok] + ssh1[3 * MT + tok]);
                const float rs = in ? rsqrtf(s * (1.0f / DM) + EPS) : 0.f;
                tokv[ai][m] = (in && w >= 1 && w <= 126) ? tok : -1;
#pragma unroll
                for (int bj = 0; bj < 2; ++bj)
#pragma unroll
                    for (int n = 0; n < 2; ++n) acc[ai][bj][m][n] = acc[ai][bj][m][n] * rs;
            }
        const int f0 = 128 * u.pn + 32 * wc + 8 * fq;
        u32x2 keep[8];
#pragma unroll
        for (int n = 0; n < 2; ++n) {
            const int fc = f0 + 4 * n;
            const f32x4 wv0 = *(const f32x4*)(cw + fc), wv1 = *(const f32x4*)(cw + DFF2 + fc), wv2 = *(const f32x4*)(cw + 2 * DFF2 + fc), bvv = *(const f32x4*)(cb + fc);
            const f32x4 wg0 = *(const f32x4*)(cw + DFF + fc), wg1 = *(const f32x4*)(cw + DFF2 + DFF + fc), wg2 = *(const f32x4*)(cw + 2 * DFF2 + DFF + fc), bgv = *(const f32x4*)(cb + DFF + fc);
#pragma unroll
            for (int gi = 0; gi < 8; ++gi) {
                const int ai = gi >> 2, m = gi & 3, pi = gi > 0 ? gi - 1 : gi, ni = gi < 7 ? gi + 1 : gi;
                const f32x4 cv = acc[ai][0][m][n], cg = acc[ai][1][m][n];
                const f32x4 pv = acc[pi >> 2][0][pi & 3][n], pg = acc[pi >> 2][1][pi & 3][n];
                const f32x4 nv = acc[ni >> 2][0][ni & 3][n], ng = acc[ni >> 2][1][ni & 3][n];
                f32x4 o;
#pragma unroll
                for (int i = 0; i < 4; ++i) {
                    const float v_prev = dpp_ror1(fr == 15 ? pv[i] : cv[i]), v_next = dpp_ror15(fr == 0 ? nv[i] : cv[i]);
                    const float g_prev = dpp_ror1(fr == 15 ? pg[i] : cg[i]), g_next = dpp_ror15(fr == 0 ? ng[i] : cg[i]);
                    const float vv = bvv[i] + wv0[i] * v_prev + wv1[i] * cv[i] + wv2[i] * v_next;
                    const float gg = bgv[i] + wg0[i] * g_prev + wg1[i] * cg[i] + wg2[i] * g_next;
                    o[i] = vv * gg * fast_sigmoid(gg);
                }
                const u32x2 pk = pack4(o);
                if (n == 0) keep[gi] = pk;
                else if (tokv[ai][m] >= 0) { u32x4 w; w.x = keep[gi].x; w.y = keep[gi].y; w.z = pk.x; w.w = pk.y; *(u32x4*)(act + (size_t)tokv[ai][m] * DFF + f0) = w; }
            }
        }
    }
};
struct EpiDown {
    static constexpr bool PERM = false, AFTER_DRAIN = true, HAS_MID = false; static constexpr int MID_T = 0;
    const bf16_t* h1b; float* out; const float* gfin; float* ss; const XcdBarrier* bar;
    __device__ __forceinline__ void fused(Acc& acc, const Unit& u, int wr, int wc, int fr, int fq, LAS unsigned char* lds, int wid, int lane) const {
        LAS float* P = (LAS float*)lds;
        LAS float* Sr = (LAS float*)(lds + 8192);
        const int col0 = u.pn * BM + wc * 32 + 4 * fq;
#pragma unroll
        for (int ai = 0; ai < 2; ++ai)
#pragma unroll
            for (int m = 0; m < 4; ++m) {
                const int lr = ai * HALF + wr * 64 + m * 16 + fr, row = u.pm * BM + lr; float q = 0.f;
                const size_t prow = (size_t)(row >> 12) * PADROWS + 1 + (row & 4095);
#pragma unroll
                for (int bj = 0; bj < 2; ++bj)
#pragma unroll
                    for (int n = 0; n < 2; ++n) {
                        const u32x2 hw = *(const u32x2*)(h1b + prow * DM + col0 + bj * HALF + n * 16);
                        const f32x4 hv = (f32x4){bflo(hw.x), bfhi(hw.x), bflo(hw.y), bfhi(hw.y)} + acc[ai][bj][m][n];
                        acc[ai][bj][m][n] = hv;
                        q += (hv[0] * hv[0] + hv[1] * hv[1]) + (hv[2] * hv[2] + hv[3] * hv[3]);
                    }
                q += __shfl_xor(q, 16); q += __shfl_xor(q, 32);
                if (fq == 0) P[lr * 4 + wc] = q;
            }
        LDS_WAIT(); __builtin_amdgcn_s_barrier(); asm volatile("" ::: "memory");
        const int tid = wid * 64 + lane;
        if (tid < 256) ss[(size_t)u.pn * MT + u.pm * BM + tid] = (P[tid * 4 + 0] + P[tid * 4 + 1]) + (P[tid * 4 + 2] + P[tid * 4 + 3]);
        xcd_barrier(*bar);
        if (tid < 256) { const int row = u.pm * BM + tid; const float s = (ss[row] + ss[MT + row]) + (ss[2 * MT + row] + ss[3 * MT + row]); Sr[tid] = rsqrtf(s * (1.0f / DM) + EPS); }
        LDS_WAIT(); __builtin_amdgcn_s_barrier(); asm volatile("" ::: "memory");
#pragma unroll
        for (int bj = 0; bj < 2; ++bj)
#pragma unroll
            for (int n = 0; n < 2; ++n) {
                const int c = col0 + bj * HALF + n * 16; const f32x4 gv = *(const f32x4*)(gfin + c);
#pragma unroll
                for (int ai = 0; ai < 2; ++ai)
#pragma unroll
                    for (int m = 0; m < 4; ++m) { const int lr = ai * HALF + wr * 64 + m * 16 + fr; const float r = Sr[lr];
                        *(f32x4*)(out + (size_t)(u.pm * BM + lr) * DM + c) = acc[ai][bj][m][n] * r * gv; }
            }
    }
};

struct OrdSsmA { int c; __device__ bool next(int i, Unit& u) const { if (i > 0 || c >= 64) return false; const int x = c & 7, k = c >> 3; u.g = x * 4 + (k >> 1); u.pm = k & 1; u.pn = 0; return true; } };
struct OrdSsmB { int c; __device__ bool next(int i, Unit& u) const { if (i > 0 || c >= 128) return false; const int x = c & 7, k = c >> 3; u.g = x * 4 + (k >> 2); u.pm = (k >> 1) & 1; u.pn = k & 1; return true; } };
struct OrdPool { int c; __device__ bool next(int i, Unit& u) const { if (i > 0 || c < 128 || c >= 256) return false; const int cc = c - 128, x = cc & 7, k = cc >> 3; u.pm = x * 8 + (k >> 1); u.pn = k & 1; u.g = u.pn; return true; } };
struct OrdGlu  { int c; __device__ bool next(int i, Unit& u) const { if (i > 0 || c >= 128) return false; const int x = c & 7, k = c >> 3; u.pm = x * 8 + (k >> 1); u.pn = k & 1; u.g = 0; return true; } };
struct OrdUp { StaticOrder so; __device__ bool next(int i, Unit& u) const { if (!so.next(i, u)) return false; u.g = u.pm / UPT; u.pm = u.pm % UPT; return true; } };

struct Args { const float* in[24]; float* out; unsigned char* ws; int ph_lo, ph_hi; };

struct Frame { LAS unsigned char* lds; int tid, lane, wave, G, bx; };

template <int MAP>
__device__ __forceinline__ void p0_transpose_item(const float* W, int K, int N, const float* kg0, const float* kg1, int ksplit, bf16_t* WT, LAS float* scr, int item, int lane) {
    const int nblk = N / 32, kb = item / nblk, nb = item % nblk, k0 = 64 * kb, n0 = 32 * nb;
#pragma unroll 8
    for (int i = 0; i < 32; ++i) { const int kk = 2 * i + (lane >> 5), k = k0 + kk; float v = W[(size_t)k * N + n0 + (lane & 31)];
        if (kg0) v *= (k < ksplit ? kg0[k] : kg1[k - ksplit]);
        scr[kk * 33 + (lane & 31)] = v; }
    LDS_WAIT(); asm volatile("" ::: "memory");
    const int c = lane & 7;
#pragma unroll
    for (int j = 0; j < 4; ++j) { const int n = (lane >> 3) + 8 * j; const LAS float* s = scr + (8 * c) * 33 + n;
        u32x4 o; o.x = pk2(s[0 * 33], s[1 * 33]); o.y = pk2(s[2 * 33], s[3 * 33]); o.z = pk2(s[4 * 33], s[5 * 33]); o.w = pk2(s[6 * 33], s[7 * 33]);
        int nr = n0 + n;
        if (MAP == 1) { const int bj = nr / DFF, rem = nr % DFF; nr = 256 * (rem >> 7) + 128 * bj + (rem & 127); }
        *(u32x4*)(WT + (size_t)nr * K + k0 + 8 * c) = o; }
    LDS_WAIT(); asm volatile("" ::: "memory");
}

struct SsmLds { LAS float* Bre; LAS float* Bim; LAS float* Cre; LAS float* Cim; LAS float* PAR; LAS float* Pc; LAS float* Kl; };
__device__ __forceinline__ SsmLds ssm_lds(const Frame& F) { SsmLds L; L.Bre = (LAS float*)(F.lds); L.Bim = L.Bre + 2048; L.Cre = L.Bim + 2048; L.Cim = L.Cre + 2048; L.PAR = L.Cim + 2048; L.Pc = L.PAR + 512; L.Kl = L.Pc + 1024; return L; }
__device__ __forceinline__ void ssm_stage(const Args& a, const Frame& F, const SsmLds& L, int g) {
    const float* lnar = a.in[5]; const float* aim = a.in[6]; const float* ldt = a.in[7];
    const float* bre = a.in[8]; const float* bim = a.in[9]; const float* cre = a.in[10]; const float* cim = a.in[11];
    const int tid = F.tid;
    for (int i = tid; i < 2048; i += 512) { const int dir = i >> 10, r = i & 1023;
        L.Bre[i] = bre[((size_t)(dir * NG + g)) * 1024 + r]; L.Bim[i] = bim[((size_t)(dir * NG + g)) * 1024 + r];
        L.Cre[i] = cre[((size_t)(dir * NG + g)) * 1024 + r]; L.Cim[i] = cim[((size_t)(dir * NG + g)) * 1024 + r]; }
    if (tid < 128) { const int dir = tid >> 6, n = tid & 63;
        const float dt = expf(ldt[dir * NG + g]); const float a_re = -expf(lnar[(dir * NG + g) * NS + n]), a_im = aim[(dir * NG + g) * NS + n];
        const float mag = expf(a_re * dt), ang = a_im * dt; const float lam_re = mag * cosf(ang), lam_im = mag * sinf(ang);
        const float den = a_re * a_re + a_im * a_im;
        L.PAR[tid * 4 + 0] = a_re * dt; L.PAR[tid * 4 + 1] = ang;
        L.PAR[tid * 4 + 2] = ((lam_re - 1.0f) * a_re + lam_im * a_im) / den; L.PAR[tid * 4 + 3] = (lam_im * a_re - (lam_re - 1.0f) * a_im) / den; }
    __syncthreads();
}
__device__ __forceinline__ void ssm_build_tb(const Args& a, const Frame& F, const SsmLds& L, int g, int jq) {
    bf16_t* TB = (bf16_t*)(a.ws + WS_TB) + (size_t)g * K1 * ROWLEN;
    const int tid = F.tid;
    { const int li = tid >> 7, dn = tid & 127, lag = 4 * jq + li; const float ad = L.PAR[dn * 4 + 0], ang = L.PAR[dn * 4 + 1], fr_ = L.PAR[dn * 4 + 2], fi_ = L.PAR[dn * 4 + 3];
      const float mg = expf((float)lag * ad); float sn, cs; sincosf((float)lag * ang, &sn, &cs); const float lr = mg * cs, lim = mg * sn;
      L.Pc[(li * 128 + dn) * 2 + 0] = lr * fr_ - lim * fi_; L.Pc[(li * 128 + dn) * 2 + 1] = lr * fi_ + lim * fr_; }
    __syncthreads();
    { const int dir = tid >> 8, h = (tid >> 4) & 15, hp = tid & 15; float s[4] = {0.f, 0.f, 0.f, 0.f};
      for (int n = 0; n < 64; ++n) { const float cr_ = L.Cre[dir * 1024 + h * 64 + n], ci_ = L.Cim[dir * 1024 + h * 64 + n], br_ = L.Bre[dir * 1024 + n * 16 + hp], bi_ = L.Bim[dir * 1024 + n * 16 + hp];
          const float xr = cr_ * br_, xi = ci_ * br_, yr = cr_ * bi_, yi = ci_ * bi_;
          const float m0 = xr - yi, m1 = yr + xi;
#pragma unroll
          for (int li = 0; li < 4; ++li) { const float pr = L.Pc[(li * 128 + dir * 64 + n) * 2], pi = L.Pc[(li * 128 + dir * 64 + n) * 2 + 1]; s[li] += pr * m0 - pi * m1; } }
#pragma unroll
      for (int li = 0; li < 4; ++li) L.Kl[li * 512 + tid] = s[li]; }
    __syncthreads();
    for (int li = 0; li < 4; ++li) {
        const int lag = 4 * jq + li; const LAS float* Kq = L.Kl + li * 512;
        if (lag == 0) {
            const int p = tid >> 4, h = tid & 15; u32x4 w0, w1; float v[16];
#pragma unroll
            for (int i = 0; i < 16; ++i) v[i] = Kq[h * 16 + i] + Kq[256 + h * 16 + i];
            w0.x = pk2(v[0], v[1]); w0.y = pk2(v[2], v[3]); w0.z = pk2(v[4], v[5]); w0.w = pk2(v[6], v[7]); w1.x = pk2(v[8], v[9]); w1.y = pk2(v[10], v[11]); w1.z = pk2(v[12], v[13]); w1.w = pk2(v[14], v[15]);
            bf16_t* dst = TB + (size_t)(16 * p + h) * ROWLEN + 16 * p; *(u32x4*)dst = w0; *(u32x4*)(dst + 8) = w1;
        } else {
            const int nb = TCH - lag;
            for (int idx = tid; idx < 2 * nb * 16; idx += 512) {
                const int dir = idx / (nb * 16), r = idx % (nb * 16), bi = r >> 4, h = r & 15;
                const int p = dir == 0 ? lag + bi : bi, q = dir == 0 ? bi : lag + bi;
                u32x4 w0, w1; float v[16];
#pragma unroll
                for (int i = 0; i < 16; ++i) v[i] = Kq[dir * 256 + h * 16 + i];
                w0.x = pk2(v[0], v[1]); w0.y = pk2(v[2], v[3]); w0.z = pk2(v[4], v[5]); w0.w = pk2(v[6], v[7]); w1.x = pk2(v[8], v[9]); w1.y = pk2(v[10], v[11]); w1.z = pk2(v[12], v[13]); w1.w = pk2(v[14], v[15]);
                bf16_t* dst = TB + (size_t)(16 * p + h) * ROWLEN + 16 * q; *(u32x4*)dst = w0; *(u32x4*)(dst + 8) = w1;
            }
        }
    }
    __syncthreads();
    { const int li = tid >> 7, dn = tid & 127, dir = dn >> 6, p = 4 * jq + li; const float ad = L.PAR[dn * 4 + 0], ang = L.PAR[dn * 4 + 1]; const float e = dir == 0 ? (float)(p + 1) : (float)(TCH - p);
      const float mg = expf(e * ad); float sn, cs; sincosf(e * ang, &sn, &cs); L.Pc[(li * 128 + dn) * 2 + 0] = mg * cs; L.Pc[(li * 128 + dn) * 2 + 1] = mg * sn; }
    __syncthreads();
    for (int li = 0; li < 4; ++li) {
        const int p = 4 * jq + li, h = tid >> 5, dir = (tid >> 4) & 1, n4 = tid & 15; float v[8];
#pragma unroll
        for (int e = 0; e < 4; ++e) { const int n = 4 * n4 + e; const float cr_ = L.Cre[dir * 1024 + h * 64 + n], ci_ = L.Cim[dir * 1024 + h * 64 + n], pr = L.Pc[(li * 128 + dir * 64 + n) * 2], pi = L.Pc[(li * 128 + dir * 64 + n) * 2 + 1];
            v[2 * e] = cr_ * pr - ci_ * pi; v[2 * e + 1] = -(cr_ * pi + ci_ * pr); }
        u32x4 w; w.x = pk2(v[0], v[1]); w.y = pk2(v[2], v[3]); w.z = pk2(v[4], v[5]); w.w = pk2(v[6], v[7]);
        *(u32x4*)(TB + (size_t)(16 * p + h) * ROWLEN + K1 + dir * 128 + 8 * n4) = w;
    }
    __syncthreads();
}
__device__ __forceinline__ void ssm_build_wab(const Args& a, const Frame& F, const SsmLds& L, int g, int jq) {
    bf16_t* WAB = (bf16_t*)(a.ws + WS_WAB) + (size_t)g * 256 * K1;
    const int tid = F.tid;
    { const int li = tid >> 7, dn = tid & 127, dir = dn >> 6, q = 4 * jq + li; const float ad = L.PAR[dn * 4 + 0], ang = L.PAR[dn * 4 + 1], fr_ = L.PAR[dn * 4 + 2], fi_ = L.PAR[dn * 4 + 3]; const float e = dir == 0 ? (float)(TCH - 1 - q) : (float)q;
      const float mg = expf(e * ad); float sn, cs; sincosf(e * ang, &sn, &cs); const float lr = mg * cs, lim = mg * sn;
      L.Pc[(li * 128 + dn) * 2 + 0] = lr * fr_ - lim * fi_; L.Pc[(li * 128 + dn) * 2 + 1] = lr * fi_ + lim * fr_; }
    __syncthreads();
#pragma unroll
    for (int half = 0; half < 2; ++half) {
        const int li = 2 * half + (tid >> 8), q = 4 * jq + li, t2 = tid & 255, dir = t2 >> 7, n = (t2 >> 1) & 63, part = t2 & 1;
        const float pr = L.Pc[(li * 128 + dir * 64 + n) * 2], pi = L.Pc[(li * 128 + dir * 64 + n) * 2 + 1]; float v[16];
#pragma unroll
        for (int i = 0; i < 16; ++i) { const float br_ = L.Bre[dir * 1024 + n * 16 + i], bi_ = L.Bim[dir * 1024 + n * 16 + i]; v[i] = part == 0 ? (pr * br_ - pi * bi_) : (pr * bi_ + pi * br_); }
        u32x4 w0, w1; w0.x = pk2(v[0], v[1]); w0.y = pk2(v[2], v[3]); w0.z = pk2(v[4], v[5]); w0.w = pk2(v[6], v[7]); w1.x = pk2(v[8], v[9]); w1.y = pk2(v[10], v[11]); w1.z = pk2(v[12], v[13]); w1.w = pk2(v[14], v[15]);
        bf16_t* dst = WAB + (size_t)(dir * 128 + 2 * n + part) * K1 + 16 * q; *(u32x4*)dst = w0; *(u32x4*)(dst + 8) = w1;
    }
    __syncthreads();
}

__device__ __forceinline__ void p0_prologue(const Args& a, const Frame& F) {
    const float* x = a.in[0];
    { const SsmLds L = ssm_lds(F);
      for (int it = F.bx; it < NG * 8; it += F.G) { ssm_stage(a, F, L, it >> 3); ssm_build_wab(a, F, L, it >> 3, it & 7); } }
    __syncthreads();
    LAS float* scr = (LAS float*)(F.lds + F.wave * 16384);
    const int gw = F.bx * 8 + F.wave, NGW = F.G * 8;
    constexpr int I_IN = (DM / 64) * (DM / 32);
    for (int it = gw; it < I_IN; it += NGW) p0_transpose_item<0>(a.in[2], DM, DM, a.in[1], a.in[1], DM, (bf16_t*)(a.ws + WS_WIN), scr, it, F.lane);
    { bf16_t* PW = (bf16_t*)(a.ws + WS_PW); const float* pw = a.in[3];
      for (int idx = F.bx * 512 + F.tid; idx < 2 * 256 * 256; idx += F.G * 512) { const int pn = idx >> 16, j = (idx >> 8) & 255, k = idx & 255;
          const float v = ((j >> 7) == (k >> 7)) ? pw[((size_t)(2 * pn + (j >> 7)) * 128 + (k & 127)) * 128 + (j & 127)] : 0.f; PW[idx] = (bf16_t)f2bf(v); } }
    { bf16_t* h1b = (bf16_t*)(a.ws + WS_H1B);
      for (int idx = F.bx * 512 + F.tid; idx < BATCH * 256 * (DM / 8); idx += F.G * 512) { const int b = idx / (256 * 128), r = (idx / 128) % 256, c = idx % 128; const int prow = b * PADROWS + (r == 0 ? 0 : 4096 + r);
          *(u32x4*)(h1b + (size_t)prow * DM + 8 * c) = (u32x4){0u, 0u, 0u, 0u}; } }
    { bf16_t* xb = (bf16_t*)(a.ws + WS_XB); float* r0 = (float*)(a.ws + WS_R0);
      for (int row = gw; row < MT; row += NGW) {
          const f32x4* xr = (const f32x4*)(x + (size_t)row * DM) + F.lane; f32x4 v[4]; float s = 0.f;
#pragma unroll
          for (int j = 0; j < 4; ++j) { v[j] = xr[64 * j]; s += (v[j][0] * v[j][0] + v[j][1] * v[j][1]) + (v[j][2] * v[j][2] + v[j][3] * v[j][3]); }
          s = wave_sum(s); if (F.lane == 0) r0[row] = rsqrtf(s * (1.0f / DM) + EPS);
          u32x2* o = (u32x2*)(xb + (size_t)row * DM) + F.lane;
#pragma unroll
          for (int j = 0; j < 4; ++j) o[64 * j] = pack4(v[j]);
      } }
}

__device__ __forceinline__ void p2_side(const Args& a, const Frame& F, int first_block) {
    const int nb = F.G - first_block, sb = F.bx - first_block;
    { const SsmLds L = ssm_lds(F);
      for (int it = sb; it < NG * 8; it += nb) { ssm_stage(a, F, L, it >> 3); ssm_build_tb(a, F, L, it >> 3, it & 7); } }
    __syncthreads();
    LAS float* scr = (LAS float*)(F.lds + F.wave * 16384);
    const int gw = sb * 8 + F.wave, NGW = nb * 8;
    constexpr int I_OUT = (DM / 64) * (DM / 32), I_GLU = (DSSM / 64) * (DSSM / 32);
    for (int it = gw; it < I_OUT + I_GLU; it += NGW) {
        if (it < I_OUT) p0_transpose_item<0>(a.in[17], DM, DM, a.in[15], a.in[16], DPOOL, (bf16_t*)(a.ws + WS_WOUT), scr, it, F.lane);
        else p0_transpose_item<0>(a.in[13], DSSM, DSSM, nullptr, nullptr, 0, (bf16_t*)(a.ws + WS_WGLU), scr, it - I_OUT, F.lane);
    }
}
__device__ __forceinline__ void p4_side(const Args& a, const Frame& F, int first_block) {
    const int nb = F.G - first_block, sb = F.bx - first_block;
    LAS float* scr = (LAS float*)(F.lds + F.wave * 16384);
    const int gw = sb * 8 + F.wave, NGW = nb * 8;
    constexpr int I_UP = (DM / 64) * (DFF2 / 32), I_DN = (DFF / 64) * (DM / 32);
    for (int it = gw; it < I_UP + I_DN; it += NGW) {
        if (it < I_UP) p0_transpose_item<1>(a.in[19], DM, DFF2, a.in[18], a.in[18], DM, (bf16_t*)(a.ws + WS_WUP), scr, it, F.lane);
        else p0_transpose_item<0>(a.in[22], DFF, DM, nullptr, nullptr, 0, (bf16_t*)(a.ws + WS_WDOWN), scr, it - I_UP, F.lane);
    }
}

__device__ __forceinline__ void p2_pooled(const Args& a, const Frame& F, int first_block) {
    const bf16_t* up = (const bf16_t*)(a.ws + WS_UPOOL); bf16_t* po = (bf16_t*)(a.ws + WS_POOLED);
    const int gw = (F.bx - first_block) * 8 + F.wave, NGW = (F.G - first_block) * 8;
    const int c0 = 8 * F.lane, half = 1 << (F.lane >> 4);
    for (int row = gw; row < MT; row += NGW) {
        const int b = row / SEQ, t = row % SEQ;
        u32x4 w[16];
#pragma unroll
        for (int o = 0; o < 16; ++o) { int q = t + o - 8; q = q < 0 ? 0 : (q >= SEQ ? SEQ - 1 : q); w[o] = *(const u32x4*)(up + (size_t)(b * SEQ + q) * DPOOL + c0); }
        f32x4 s0 = {0.f, 0.f, 0.f, 0.f}, s1 = {0.f, 0.f, 0.f, 0.f}; float cnt = 0.f;
#pragma unroll
        for (int o = 0; o < 16; ++o) { const int d = o - 8, q = t + d; const float m = (d >= -half && d < half && q >= 0 && q < SEQ) ? 1.f : 0.f; f32x4 a0, a1; unpack8(w[o], a0, a1); s0 = s0 + a0 * m; s1 = s1 + a1 * m; cnt += m; }
        f32x4 c0v, c1v; unpack8(w[8], c0v, c1v);
        const float inv = 1.0f / cnt;
        *(u32x4*)(po + (size_t)row * DPOOL + c0) = pack8(s0 * inv - c0v, s1 * inv - c1v);
    }
}

__device__ __forceinline__ void p3_carries(const Args& a, const Frame& F, int g, int pm) {
    LAS float* TOT = (LAS float*)(F.lds);
    const int bs = F.tid >> 8, seg = (F.tid >> 6) & 3, n = F.tid & 63, b = 2 * pm + bs;
    for (int dir = 0; dir < 2; ++dir) {
        const float dt = expf(a.in[7][dir * NG + g]); const float a_re = -expf(a.in[5][(dir * NG + g) * NS + n]), a_im = a.in[6][(dir * NG + g) * NS + n];
        const float mg = expf((float)TCH * (a_re * dt)); float sn, cs; sincosf((float)TCH * (a_im * dt), &sn, &cs); const float lr = mg * cs, li = mg * sn;
        const float* fg = (const float*)(a.ws + WS_FG) + ((size_t)g * NCR + (size_t)b * NCHB) * 256 + dir * 128 + 2 * n;
        bf16_t* us = (bf16_t*)(a.ws + WS_USSM) + ((size_t)g * NCR + (size_t)b * NCHB) * ROWLEN + K1 + dir * 128 + 2 * n;
        f32x2 f[32];
#pragma unroll
        for (int k = 0; k < 32; ++k) { const int i = 32 * seg + k, c = dir == 0 ? i : NCHB - 1 - i; f[k] = *(const f32x2*)(fg + (size_t)c * 256); }
        float sr = 0.f, si = 0.f;
#pragma unroll
        for (int k = 0; k < 32; ++k) { const float nr = lr * sr - li * si + f[k].x, ni = lr * si + li * sr + f[k].y; sr = nr; si = ni; }
        TOT[F.tid * 2] = sr; TOT[F.tid * 2 + 1] = si;
        float pr = lr, pi = li;
#pragma unroll
        for (int q = 0; q < 5; ++q) { const float nr = pr * pr - pi * pi, ni = 2.f * pr * pi; pr = nr; pi = ni; }
        __syncthreads();
        sr = 0.f; si = 0.f;
        for (int s2 = 0; s2 < seg; ++s2) { const int o = (F.tid - 64 * (seg - s2)) * 2; const float tr = TOT[o], ti = TOT[o + 1]; const float nr = pr * sr - pi * si + tr, ni = pr * si + pi * sr + ti; sr = nr; si = ni; }
#pragma unroll
        for (int k = 0; k < 32; ++k) { const int i = 32 * seg + k, c = dir == 0 ? i : NCHB - 1 - i;
            *(unsigned*)(us + (size_t)c * ROWLEN) = pk2(sr, si);
            const float nr = lr * sr - li * si + f[k].x, ni = lr * si + li * sr + f[k].y; sr = nr; si = ni; }
        __syncthreads();
    }
    VM_WAIT(); __syncthreads();
}

__global__ void __launch_bounds__(512, 2) mk_fwd(Args args) {
    extern __shared__ __attribute__((aligned(16))) unsigned char lds_raw[];
    Frame F; F.lds = (LAS unsigned char*)lds_raw; F.tid = threadIdx.x; F.lane = F.tid & 63; F.wave = __builtin_amdgcn_readfirstlane(F.tid >> 6); F.G = gridDim.x; F.bx = blockIdx.x;
    volatile LAS unsigned* MISC = (volatile LAS unsigned*)(F.lds + LDSCTL_OFF);
    for (int u = F.tid; u < (LDS_BYTES - LDSCTL_OFF) / 4; u += 512) ((LAS unsigned*)(F.lds + LDSCTL_OFF))[u] = 0u;
    __syncthreads();
    unsigned char* ws = args.ws;
    XcdBarrier bar = xcd_barrier_post((unsigned*)(ws + WS_CTL), MISC + 8);
    const int lo = args.ph_lo, hi = args.ph_hi;
#define IN(k) (lo <= (k) && (k) < hi)
#define BOTH(k) (IN(k) && IN((k) + 1))
    if (IN(0)) { p0_prologue(args, F); if (BOTH(0)) xcd_barrier(bar); }
    if (IN(1)) {
        GemmDesc g{(const char*)(ws + WS_XB), (const char*)(ws + WS_WIN), 256L * DM * 2, 0, 256L * DM * 2, 0, 128L * DM * 2, 128L * DM * 2, 128, 128, DM / BK};
        unsigned vA[2], vB[2]; voff_std(vA, DM, false); voff_std(vB, DM, true);
        StaticOrder S; S.init(MT / BM, DM / BM, F.G, F.bx);
        EpiU E{(const float*)(ws + WS_R0), (bf16_t*)(ws + WS_UPOOL), (bf16_t*)(ws + WS_USSM)};
        gemm_phase<EpiU, StaticOrder, true>(F.lds, g, vA, vB, S, E);
        if (BOTH(1)) xcd_barrier(bar);
#if defined(MK_EXTRA_BAR)
        for (int rep = 0; rep < MK_EXTRA_BAR; ++rep) xcd_barrier(bar);
#endif
    }
    if (IN(2)) {
        if (F.bx < 64) {
            GemmDesc g{(const char*)(ws + WS_USSM), (const char*)(ws + WS_WAB), 256L * ROWLEN * 2, (long)NCR * ROWLEN * 2, 0, 256L * K1 * 2, 128L * ROWLEN * 2, 128L * K1 * 2, 128, 128, K1 / BK};
            unsigned vA[2], vB[2]; voff_std(vA, ROWLEN, false); voff_std(vB, K1, false);
            OrdSsmA S{F.bx}; EpiFG E{(float*)(ws + WS_FG)};
            gemm_phase<EpiFG, OrdSsmA, true>(F.lds, g, vA, vB, S, E);
        } else { p2_side(args, F, 64); p2_pooled(args, F, 64); }
        if (BOTH(2)) xcd_barrier(bar);
    }
    if (IN(3)) {
        if (F.bx < 128) {
            OrdSsmB S{F.bx}; Unit u0; S.next(0, u0);
            p3_carries(args, F, u0.g, u0.pm);
            GemmDesc g{(const char*)(ws + WS_USSM), (const char*)(ws + WS_TB), 256L * ROWLEN * 2, (long)NCR * ROWLEN * 2, 256L * ROWLEN * 2, (long)K1 * ROWLEN * 2, 128L * ROWLEN * 2, 128L * ROWLEN * 2, 128, 128, ROWLEN / BK};
            unsigned vA[2], vB[2]; voff_std(vA, ROWLEN, false); voff_std(vB, ROWLEN, true);
            EpiZ E{(const bf16_t*)(ws + WS_USSM), args.in[12], (bf16_t*)(ws + WS_ZG)};
            gemm_phase<EpiZ, OrdSsmB, true>(F.lds, g, vA, vB, S, E);
        } else {
            GemmDesc g{(const char*)(ws + WS_POOLED), (const char*)(ws + WS_PW), 256L * DPOOL * 2, 256L * 2, 256L * 256 * 2, 0, 128L * DPOOL * 2, 128L * 256 * 2, 128, 128, 256 / BK};
            unsigned vA[2], vB[2]; voff_std(vA, DPOOL, false); voff_std(vB, 256, true);
            OrdPool S{F.bx}; EpiPool E{args.in[4], (bf16_t*)(ws + WS_YCAT), (float*)(ws + WS_SSPOOL)};
            gemm_phase<EpiPool, OrdPool, true>(F.lds, g, vA, vB, S, E);
        }
        if (BOTH(3)) xcd_barrier(bar);
    }
    if (IN(4)) {
        if (F.bx < 128) {
            constexpr long GSTR = (long)MT * 32;
            GemmDesc g{(const char*)(ws + WS_ZG), (const char*)(ws + WS_WGLU), 256L * 32, 0, 256L * DSSM * 2, 0, 128L * 32, 128L * DSSM * 2, 4 * GSTR, 128, DSSM / BK};
            unsigned vA[2], vB[2]; voff_std(vB, DSSM, true);
#pragma unroll
            for (int i = 0; i < 2; ++i) { int R, C; stage_rc(F.tid * 16 + i * 8192, R, C); vA[i] = (unsigned)(R * 32 + (C >> 4) * (int)GSTR + (C & 15) * 2); }
            OrdGlu S{F.bx}; EpiGlu E{args.in[14], (const bf16_t*)(ws + WS_ZG), (bf16_t*)(ws + WS_YCAT), (float*)(ws + WS_SSSSM)};
            gemm_phase<EpiGlu, OrdGlu, true>(F.lds, g, vA, vB, S, E);
        } else p4_side(args, F, 128);
        if (BOTH(4)) xcd_barrier(bar);
    }
    if (IN(5)) {
        StaticOrder S; S.init(MT / BM, DM / BM, F.G, F.bx); Unit u0;
        LAS f32x2* XR = (LAS f32x2*)(F.lds + XTRA_OFF);
        if (S.next(0, u0)) {
            if (F.tid < 256) { const int row = u0.pm * BM + F.tid; const float* sp = (const float*)(ws + WS_SSPOOL); const float* sm = (const float*)(ws + WS_SSSSM); float a0 = 0.f, a1 = 0.f;
#pragma unroll
                for (int s = 0; s < 8; ++s) { a0 += sp[(size_t)s * MT + row]; a1 += sm[(size_t)s * MT + row]; }
                const float rp = rsqrtf(a0 * (1.0f / DPOOL) + EPS), rsm = rsqrtf(a1 * (1.0f / DSSM) + EPS); XR[F.tid] = (f32x2){rp / rsm, rsm}; }
        }
        __syncthreads();
        GemmDesc g{(const char*)(ws + WS_YCAT), (const char*)(ws + WS_WOUT), 256L * DM * 2, 0, 256L * DM * 2, 0, 128L * DM * 2, 128L * DM * 2, 128, 128, DM / BK};
        unsigned vA[2], vB[2]; voff_std(vA, DM, false); voff_std(vB, DM, false);
        EpiOut E{args.in[0], (bf16_t*)(ws + WS_H1B), (float*)(ws + WS_SSH1), XR, {{0.f, 0.f, 0.f, 0.f}, {0.f, 0.f, 0.f, 0.f}}};
        { const int wr_ = F.wave >> 2, fr_ = F.lane & 15;
#pragma unroll
          for (int ai = 0; ai < 2; ++ai)
#pragma unroll
              for (int m = 0; m < 4; ++m) E.ratio[ai][m] = XR[ai * HALF + wr_ * 64 + m * 16 + fr_].x; }
        gemm_phase<EpiOut, StaticOrder, false>(F.lds, g, vA, vB, S, E);
        if (BOTH(5)) xcd_barrier(bar);
    }
    if (IN(6)) {
        GemmDesc g{(const char*)(ws + WS_H1B), (const char*)(ws + WS_WUP), (long)UPROWS * DM * 2, (long)PADROWS * DM * 2, 256L * DM * 2, 0, 64L * DM * 2, 128L * DM * 2, 128, 128, DM / BK};
        unsigned vA[2], vB[2]; voff_std(vB, DM, true);
#pragma unroll
        for (int i = 0; i < 2; ++i) { int R, C; stage_rc(F.tid * 16 + i * 8192, R, C); vA[i] = (unsigned)(((126 * (R >> 6) + (R & 63)) * DM + C) * 2); }
        OrdUp S; S.so.init(BATCH * UPT, DFF2 / BM, F.G, F.bx);
        EpiUp E{(const float*)(ws + WS_SSH1), args.in[20], args.in[21], (bf16_t*)(ws + WS_ACT)};
        gemm_phase<EpiUp, OrdUp, true>(F.lds, g, vA, vB, S, E);
        if (BOTH(6)) xcd_barrier(bar);
    }
    if (IN(7)) {
        GemmDesc g{(const char*)(ws + WS_ACT), (const char*)(ws + WS_WDOWN), 256L * DFF * 2, 0, 256L * DFF * 2, 0, 128L * DFF * 2, 128L * DFF * 2, 128, 128, DFF / BK};
        unsigned vA[2], vB[2]; voff_std(vA, DFF, false); voff_std(vB, DFF, false);
        StaticOrder S; S.init(MT / BM, DM / BM, F.G, F.bx);
        EpiDown E{(const bf16_t*)(ws + WS_H1B), args.out, args.in[23], (float*)(ws + WS_SSH2), &bar};
        gemm_phase<EpiDown, StaticOrder, false>(F.lds, g, vA, vB, S, E);
    }
#undef IN
#undef BOTH
}
}

__global__ void k_cvt_u(const bf16_t* __restrict__ upool, const bf16_t* __restrict__ ussm, float* __restrict__ u) {
    const int idx = blockIdx.x * blockDim.x + threadIdx.x; if (idx >= MT * DM) return;
    const int c = idx % DM, row = idx / DM; unsigned short v;
    if (c < DPOOL) v = upool[(size_t)row * DPOOL + c];
    else { const int cs = c - DPOOL, g = cs >> 4, h = cs & 15, cr = row / mk::TCH, p = row % mk::TCH; v = ussm[((size_t)(g * mk::NCR + cr)) * mk::ROWLEN + 16 * p + h]; }
    u[idx] = __builtin_bit_cast(float, (unsigned)v << 16);
}
__global__ void k_cvt_z(const bf16_t* __restrict__ zg, float* __restrict__ z) {
    const int idx = blockIdx.x * blockDim.x + threadIdx.x; if (idx >= MT * DSSM) return;
    const int c = idx % DSSM, row = idx / DSSM; const unsigned short v = zg[((size_t)(c >> 4) * MT + row) * 16 + (c & 15)];
    z[idx] = __builtin_bit_cast(float, (unsigned)v << 16);
}
__global__ void k_cvt_rows(const bf16_t* __restrict__ src, int lds_, float* __restrict__ dst, int ldd, int cols, int rows) {
    const size_t idx = (size_t)blockIdx.x * blockDim.x + threadIdx.x; if (idx >= (size_t)rows * cols) return;
    const int c = (int)(idx % cols); const size_t row = idx / cols; dst[row * ldd + c] = __builtin_bit_cast(float, (unsigned)src[row * lds_ + c] << 16);
}

#ifndef MK_CUT
#define MK_CUT 8
#endif
static void gemm(hipStream_t s, const float* A, int lda, const float* B, int ldb, float* C, int ldc, const float* R, int ldr, int M, int N, int K) {
    hipLaunchKernelGGL(k_gemm, dim3(N / 128, M / 128), dim3(256), 0, s, A, lda, B, ldb, C, ldc, R, ldr, K);
}

extern "C" void kernel_launch(void* const* d_in, const int* in_sizes, int n_in, void* d_out, int out_size, void* d_ws, size_t ws_size, hipStream_t stream) {
    static int grid = 0;
    if (grid == 0) {
        int dev = 0, cus = 0, per_cu = 0;
        if (n_in != 24 || out_size != MT * DM || ws_size < mk::WS_END) { fprintf(stderr, "kernel_launch: unexpected problem (n_in %d out %d ws %zu)\n", n_in, out_size, ws_size); grid = -1; return; }
        if (hipGetDevice(&dev) != hipSuccess || hipDeviceGetAttribute(&cus, hipDeviceAttributeMultiprocessorCount, dev) != hipSuccess) { grid = -1; return; }
        if (hipFuncSetAttribute((const void*)mk::mk_fwd, hipFuncAttributeMaxDynamicSharedMemorySize, mk::LDS_BYTES) != hipSuccess) { fprintf(stderr, "kernel_launch: hipFuncSetAttribute failed\n"); grid = -1; return; }
        if (hipOccupancyMaxActiveBlocksPerMultiprocessor(&per_cu, (const void*)mk::mk_fwd, 512, mk::LDS_BYTES) != hipSuccess || per_cu < 1) { fprintf(stderr, "kernel_launch: occupancy query says %d blocks/CU\n", per_cu); }
        (void)hipGetLastError();
        grid = cus;
        if (grid != 256) { fprintf(stderr, "kernel_launch: built for a 256-CU device, found %d CUs\n", cus); grid = -1; return; }
    }
    if (grid < 0) return;
    const float* x = (const float*)d_in[0];
    const float* pool_w = (const float*)d_in[3];   const float* pool_scale = (const float*)d_in[4];
    const float* lnar = (const float*)d_in[5];     const float* aim = (const float*)d_in[6];   const float* ldt = (const float*)d_in[7];
    const float* bre = (const float*)d_in[8];      const float* bim = (const float*)d_in[9];
    const float* cre = (const float*)d_in[10];     const float* cim = (const float*)d_in[11];
    const float* ssm_d = (const float*)d_in[12];   const float* glu_w = (const float*)d_in[13]; const float* glu_b = (const float*)d_in[14];
    const float* g_pool = (const float*)d_in[15];  const float* g_ssm = (const float*)d_in[16];
    const float* w_out = (const float*)d_in[17];   const float* g_ffn = (const float*)d_in[18];
    const float* w_up = (const float*)d_in[19];    const float* conv_w = (const float*)d_in[20]; const float* conv_b = (const float*)d_in[21];
    const float* w_down = (const float*)d_in[22];  const float* g_final = (const float*)d_in[23];
    float* out = (float*)d_out; char* ws = (char*)d_ws; const size_t MiB = 1u << 20; const int EB = 256;
    (void)x; (void)pool_w; (void)pool_scale; (void)lnar; (void)aim; (void)ldt; (void)bre; (void)bim; (void)cre; (void)cim; (void)ssm_d; (void)glu_w; (void)glu_b; (void)g_pool; (void)g_ssm; (void)w_out; (void)g_ffn; (void)w_up; (void)conv_w; (void)conv_b; (void)w_down; (void)g_final;

    (void)hipMemsetAsync(ws + mk::WS_CTL, 0, mk::CTL_ZERO_BYTES, stream);
    mk::Args a{};
    for (int i = 0; i < 24; ++i) a.in[i] = (const float*)d_in[i];
    a.out = out; a.ws = (unsigned char*)d_ws; a.ph_lo = 0; a.ph_hi = MK_CUT;
#if defined(MK_PROBE_LO)
    a.ph_lo = 0; a.ph_hi = MK_PROBE_HI; hipLaunchKernelGGL(mk::mk_fwd, dim3(grid), dim3(512), mk::LDS_BYTES, stream, a);
    for (int r = 0; r < MK_PROBE_REP; ++r) { (void)hipMemsetAsync(ws + mk::WS_CTL, 0, mk::CTL_ZERO_BYTES, stream); a.ph_lo = MK_PROBE_LO; a.ph_hi = MK_PROBE_HI; hipLaunchKernelGGL(mk::mk_fwd, dim3(grid), dim3(512), mk::LDS_BYTES, stream, a); }
    (void)hipMemsetAsync(ws + mk::WS_CTL, 0, mk::CTL_ZERO_BYTES, stream);
    a.ph_lo = MK_PROBE_HI; a.ph_hi = 8; hipLaunchKernelGGL(mk::mk_fwd, dim3(grid), dim3(512), mk::LDS_BYTES, stream, a);
#else
    hipLaunchKernelGGL(mk::mk_fwd, dim3(grid), dim3(512), mk::LDS_BYTES, stream, a);
#endif
#if MK_CUT < 8
    float* bufA = (float*)(ws + 0 * MiB); float* bufB = (float*)(ws + 64 * MiB); float* bufC = (float*)(ws + 128 * MiB); float* bufD = (float*)(ws + 192 * MiB);
    float* pooled = bufA; float* ypool = bufA + (size_t)MT * DPOOL; float* z = pooled; float* pre = bufD; float* ycat = bufB;
#if MK_CUT <= 2
    float* u = bufB;
    hipLaunchKernelGGL(k_cvt_u, dim3(MT * DM / EB), dim3(EB), 0, stream, (const bf16_t*)(ws + mk::WS_UPOOL), (const bf16_t*)(ws + mk::WS_USSM), u);
    hipLaunchKernelGGL(k_pool, dim3(MT * DPOOL / EB), dim3(EB), 0, stream, u, pooled);
    for (int gi = 0; gi < 4; ++gi) gemm(stream, pooled + gi * 128, DPOOL, pool_w + (size_t)gi * 128 * 128, 128, ypool + gi * 128, DPOOL, nullptr, 0, MT, 128, 128);
    float* y2 = bufC;
    hipLaunchKernelGGL(k_ssm_scan, dim3(2 * BATCH * NG), dim3(64), 0, stream, u, lnar, aim, ldt, bre, bim, cre, cim, y2);
    hipLaunchKernelGGL(k_ssm_post, dim3(MT * DSSM / EB), dim3(EB), 0, stream, y2, u, ssm_d, z);
    const float* pre_scale = pool_scale;
#elif MK_CUT <= 4
    hipLaunchKernelGGL(k_cvt_z, dim3(MT * DSSM / EB), dim3(EB), 0, stream, (const bf16_t*)(ws + mk::WS_ZG), z);
    hipLaunchKernelGGL(k_cvt_rows, dim3(MT * DPOOL / EB), dim3(EB), 0, stream, (const bf16_t*)(ws + mk::WS_YCAT), DM, ypool, DPOOL, DPOOL, MT);
    const float* pre_scale = nullptr;
#endif
#if MK_CUT <= 4
    gemm(stream, z, DSSM, glu_w, DSSM, pre, DSSM, nullptr, 0, MT, DSSM, DSSM);
    hipLaunchKernelGGL(k_glu, dim3(MT * DSSM / EB), dim3(EB), 0, stream, z, pre, glu_b);
#elif MK_CUT == 5
    hipLaunchKernelGGL(k_cvt_rows, dim3(MT * DPOOL / EB), dim3(EB), 0, stream, (const bf16_t*)(ws + mk::WS_YCAT), DM, ypool, DPOOL, DPOOL, MT);
    hipLaunchKernelGGL(k_cvt_rows, dim3(MT * DSSM / EB), dim3(EB), 0, stream, (const bf16_t*)(ws + mk::WS_YCAT) + DPOOL, DM, pre, DSSM, DSSM, MT);
    const float* pre_scale = nullptr;
#endif
#if MK_CUT <= 5
    hipLaunchKernelGGL(k_rmsnorm, dim3(MT / 4), dim3(256), 0, stream, ypool, DPOOL, pre_scale, g_pool, ycat, DM, DPOOL, MT);
    hipLaunchKernelGGL(k_rmsnorm, dim3(MT / 4), dim3(256), 0, stream, pre, DSSM, (const float*)nullptr, g_ssm, ycat + DPOOL, DM, DSSM, MT);
    gemm(stream, ycat, DM, w_out, DM, out, DM, x, DM, MT, DM, DM);
#endif
#if MK_CUT <= 6
    float* xn2 = bufA;
    hipLaunchKernelGGL(k_rmsnorm, dim3(MT / 4), dim3(256), 0, stream, out, DM, (const float*)nullptr, g_ffn, xn2, DM, DM, MT);
    float* up = (float*)(ws + 64 * MiB); float* act = (float*)(ws + 152 * MiB);
    for (int b = 0; b < BATCH; ++b) {
        gemm(stream, xn2 + (size_t)b * SEQ * DM, DM, w_up, DFF2, up, DFF2, nullptr, 0, SEQ, DFF2, DM);
        hipLaunchKernelGGL(k_convact, dim3(SEQ * DFF / EB), dim3(EB), 0, stream, up, conv_w, conv_b, act);
        gemm(stream, act, DFF, w_down, DM, out + (size_t)b * SEQ * DM, DM, out + (size_t)b * SEQ * DM, DM, SEQ, DM, DFF);
    }
#else
    float* actf = (float*)(ws + 0 * MiB);
    for (int b = 0; b < BATCH; ++b) {
        hipLaunchKernelGGL(k_cvt_rows, dim3(SEQ * DFF / EB), dim3(EB), 0, stream, (const bf16_t*)(ws + mk::WS_ACT) + (size_t)b * SEQ * DFF, DFF, actf, DFF, DFF, SEQ);
        gemm(stream, actf, DFF, w_down, DM, out + (size_t)b * SEQ * DM, DM, out + (size_t)b * SEQ * DM, DM, SEQ, DM, DFF);
    }
#endif
    hipLaunchKernelGGL(k_rmsnorm, dim3(MT / 4), dim3(256), 0, stream, out, DM, (const float*)nullptr, g_final, out, DM, DM, MT);
    (void)bufC;
#endif
}
```

```cpp
#define MK_CUT 8
#include <hip/hip_runtime.h>
#include <math.h>

constexpr int BATCH = 4, SEQ = 4096, DM = 1024, MT = BATCH * SEQ;
constexpr int DPOOL = 512, DSSM = 512, NG = 32, NH = 16, NS = 64;
constexpr int DFF = 2816, DFF2 = 5632;
constexpr float EPS = 1e-6f;

__global__ void k_rmsnorm(const float* x, int ldx, const float* __restrict__ pre,
                          const float* __restrict__ g, float* out, int ldo, int D, int rows) {
    const int wave = (blockIdx.x * blockDim.x + threadIdx.x) >> 6, lane = threadIdx.x & 63;
    if (wave >= rows) return;
    const float* xr = x + (size_t)wave * ldx;
    float ss = 0.f;
    for (int c = lane; c < D; c += 64) { float v = xr[c]; if (pre) v *= pre[c]; ss += v * v; }
    for (int o = 32; o; o >>= 1) ss += __shfl_xor(ss, o);
    const float inv = rsqrtf(ss / (float)D + EPS);
    float* orow = out + (size_t)wave * ldo;
    for (int c = lane; c < D; c += 64) { float v = xr[c]; if (pre) v *= pre[c]; orow[c] = v * inv * g[c]; }
}

__global__ void __launch_bounds__(256) k_gemm(const float* __restrict__ A, int lda, const float* __restrict__ B, int ldb,
                                               float* C, int ldc, const float* R, int ldr, int K) {
    __shared__ float As[16][132];
    __shared__ float Bs[16][132];
    const int tid = threadIdx.x, tx = tid & 15, ty = tid >> 4;
    const int row0 = blockIdx.y * 128, col0 = blockIdx.x * 128;
    float acc[8][8];
#pragma unroll
    for (int i = 0; i < 8; ++i)
#pragma unroll
        for (int j = 0; j < 8; ++j) acc[i][j] = 0.f;
    for (int k0 = 0; k0 < K; k0 += 16) {
#pragma unroll
        for (int p = 0; p < 2; ++p) {
            const int i = tid + p * 256, r = i >> 2, kk = (i & 3) * 4;
            const float4 v = *(const float4*)(A + (size_t)(row0 + r) * lda + k0 + kk);
            As[kk + 0][r] = v.x; As[kk + 1][r] = v.y; As[kk + 2][r] = v.z; As[kk + 3][r] = v.w;
        }
#pragma unroll
        for (int p = 0; p < 2; ++p) {
            const int i = tid + p * 256, kk = i >> 5, c = (i & 31) * 4;
            const float4 v = *(const float4*)(B + (size_t)(k0 + kk) * ldb + col0 + c);
            *(float4*)&Bs[kk][c] = v;
        }
        __syncthreads();
#pragma unroll
        for (int kk = 0; kk < 16; ++kk) {
            float a[8], b[8];
            const float4 a0 = *(const float4*)&As[kk][ty * 4], a1 = *(const float4*)&As[kk][64 + ty * 4];
            const float4 b0 = *(const float4*)&Bs[kk][tx * 4], b1 = *(const float4*)&Bs[kk][64 + tx * 4];
            a[0] = a0.x; a[1] = a0.y; a[2] = a0.z; a[3] = a0.w; a[4] = a1.x; a[5] = a1.y; a[6] = a1.z; a[7] = a1.w;
            b[0] = b0.x; b[1] = b0.y; b[2] = b0.z; b[3] = b0.w; b[4] = b1.x; b[5] = b1.y; b[6] = b1.z; b[7] = b1.w;
#pragma unroll
            for (int i = 0; i < 8; ++i)
#pragma unroll
                for (int j = 0; j < 8; ++j) acc[i][j] = fmaf(a[i], b[j], acc[i][j]);
        }
        __syncthreads();
    }
#pragma unroll
    for (int i = 0; i < 8; ++i) {
        const int r = row0 + (i < 4 ? ty * 4 + i : 64 + ty * 4 + (i - 4));
#pragma unroll
        for (int jh = 0; jh < 2; ++jh) {
            const int c = col0 + jh * 64 + tx * 4;
            float4 v = make_float4(acc[i][jh * 4 + 0], acc[i][jh * 4 + 1], acc[i][jh * 4 + 2], acc[i][jh * 4 + 3]);
            if (R) { const float4 rr = *(const float4*)(R + (size_t)r * ldr + c); v.x += rr.x; v.y += rr.y; v.z += rr.z; v.w += rr.w; }
            *(float4*)(C + (size_t)r * ldc + c) = v;
        }
    }
}

__global__ void k_pool(const float* __restrict__ u  , float* __restrict__ pooled  ) {
    const int idx = blockIdx.x * blockDim.x + threadIdx.x;
    if (idx >= MT * DPOOL) return;
    const int c = idx % DPOOL, row = idx / DPOOL, b = row / SEQ, t = row % SEQ;
    const int gi = c / 128, w = 2 << gi, half = w / 2;
    int lo = t - half, hi = t + half; if (lo < 0) lo = 0; if (hi > SEQ) hi = SEQ;
    float s = 0.f;
    for (int q = lo; q < hi; ++q) s += u[(size_t)(b * SEQ + q) * DM + c];
    pooled[idx] = s / (float)(hi - lo) - u[(size_t)row * DM + c];
}

__global__ void __launch_bounds__(64) k_ssm_scan(const float* __restrict__ u  ,
        const float* __restrict__ lnar, const float* __restrict__ aim, const float* __restrict__ ldt,
        const float* __restrict__ bre, const float* __restrict__ bim, const float* __restrict__ cre, const float* __restrict__ cim,
        float* __restrict__ y  ) {
    const int n = threadIdx.x;
    const int g = blockIdx.x % NG, b = (blockIdx.x / NG) % BATCH, dir = blockIdx.x / (NG * BATCH);
    const float dt = expf(ldt[dir * NG + g]);
    const float a_re = -expf(lnar[(dir * NG + g) * NS + n]), a_im = aim[(dir * NG + g) * NS + n];
    const float mag = expf(a_re * dt), ang = a_im * dt;
    const float lam_re = mag * cosf(ang), lam_im = mag * sinf(ang);
    const float den = a_re * a_re + a_im * a_im;
    const float f_re = ((lam_re - 1.0f) * a_re + lam_im * a_im) / den;
    const float f_im = (lam_im * a_re - (lam_re - 1.0f) * a_im) / den;
    float Br[NH], Bi[NH], Cr[NH], Ci[NH];
#pragma unroll
    for (int h = 0; h < NH; ++h) {
        Br[h] = bre[((size_t)(dir * NG + g) * NS + n) * NH + h];
        Bi[h] = bim[((size_t)(dir * NG + g) * NS + n) * NH + h];
        Cr[h] = cre[((size_t)(dir * NG + g) * NH + h) * NS + n];
        Ci[h] = cim[((size_t)(dir * NG + g) * NH + h) * NS + n];
    }
    float s_re = 0.f, s_im = 0.f;
    float* yd = y + (size_t)dir * MT * DSSM;
    for (int i = 0; i < SEQ; ++i) {
        const int t = dir ? (SEQ - 1 - i) : i;
        const float* ur = u + (size_t)(b * SEQ + t) * DM + DPOOL + g * NH;
        float bu_re = 0.f, bu_im = 0.f;
#pragma unroll
        for (int h = 0; h < NH; ++h) { const float uv = ur[h]; bu_re = fmaf(Br[h], uv, bu_re); bu_im = fmaf(Bi[h], uv, bu_im); }
        const float in_re = f_re * bu_re - f_im * bu_im, in_im = f_re * bu_im + f_im * bu_re;
        const float nr = lam_re * s_re - lam_im * s_im + in_re;
        const float ni = lam_re * s_im + lam_im * s_re + in_im;
        s_re = nr; s_im = ni;
        float mine = 0.f;
#pragma unroll
        for (int h = 0; h < NH; ++h) {
            float p = Cr[h] * s_re - Ci[h] * s_im;
#pragma unroll
            for (int o = 32; o; o >>= 1) p += __shfl_xor(p, o);
            if (n == h) mine = p;
        }
        if (n < NH) yd[(size_t)(b * SEQ + t) * DSSM + g * NH + n] = mine;
    }
}

__device__ __forceinline__ float gelu_tanh(float x) {
    const float k = 0.7978845608028654f;
    return 0.5f * x * (1.0f + tanhf(k * (x + 0.044715f * x * x * x)));
}
__device__ __forceinline__ float sigmoidf_(float x) { return 1.0f / (1.0f + expf(-x)); }

__global__ void k_ssm_post(const float* __restrict__ y2, const float* __restrict__ u, const float* __restrict__ d, float* __restrict__ z) {
    const int idx = blockIdx.x * blockDim.x + threadIdx.x;
    if (idx >= MT * DSSM) return;
    const int c = idx % DSSM, row = idx / DSSM;
    const float yv = y2[idx] + y2[(size_t)MT * DSSM + idx] + d[c] * u[(size_t)row * DM + DPOOL + c];
    z[idx] = gelu_tanh(yv);
}
__global__ void k_glu(const float* __restrict__ z, float* __restrict__ pre, const float* __restrict__ gb) {
    const int idx = blockIdx.x * blockDim.x + threadIdx.x;
    if (idx >= MT * DSSM) return;
    const int c = idx % DSSM;
    pre[idx] = z[idx] * sigmoidf_(pre[idx] + gb[c]);
}
__global__ void k_convact(const float* __restrict__ up  , const float* __restrict__ cw, const float* __restrict__ cb, float* __restrict__ act  ) {
    const int idx = blockIdx.x * blockDim.x + threadIdx.x;
    if (idx >= SEQ * DFF) return;
    const int f = idx % DFF, t = idx / DFF;
    float v = cb[f], gt = cb[DFF + f];
#pragma unroll
    for (int k = 0; k < 3; ++k) {
        const int q = t + k - 1;
        if (q >= 0 && q < SEQ) {
            v = fmaf(up[(size_t)q * DFF2 + f], cw[k * DFF2 + f], v);
            gt = fmaf(up[(size_t)q * DFF2 + DFF + f], cw[k * DFF2 + DFF + f], gt);
        }
    }
    act[idx] = v * (gt * sigmoidf_(gt));
}


#include <cstdio>
#include <cstdint>
#define LAS __attribute__((address_space(3)))
#define GAS __attribute__((address_space(1)))
typedef unsigned short bf16_t;
typedef short bf16x8 __attribute__((ext_vector_type(8)));
typedef float f32x4 __attribute__((ext_vector_type(4)));
typedef float f32x2 __attribute__((ext_vector_type(2)));
typedef unsigned u32x4 __attribute__((ext_vector_type(4)));
typedef unsigned u32x2 __attribute__((ext_vector_type(2)));

namespace mk {
constexpr int TCH = 32;
constexpr int K1 = 16 * TCH;
constexpr int ROWLEN = K1 + 256;
constexpr int NCR = MT / TCH;
constexpr int NCHB = SEQ / TCH;
constexpr int PADROWS = 4352;
constexpr int UPT = 17;
constexpr int UPROWS = 252;

constexpr size_t MiB = 1u << 20;
constexpr size_t WS_CTL = 0, CTL_ZERO_BYTES = 64 * 1024;
constexpr size_t WS_R0 = 1 * MiB;
constexpr size_t WS_SSPOOL = 2 * MiB;
constexpr size_t WS_SSSSM = WS_SSPOOL + 8 * MT * 4;
constexpr size_t WS_SSH1 = WS_SSSSM + 8 * MT * 4;
constexpr size_t WS_SSH2 = WS_SSH1 + 4 * MT * 4;
constexpr size_t WS_WIN = 8 * MiB, WS_WOUT = 10 * MiB, WS_WGLU = 12 * MiB, WS_PW = 12 * MiB + 512 * 1024;
constexpr size_t WS_WUP = 13 * MiB, WS_WDOWN = 24 * MiB;
constexpr size_t WS_WAB = 30 * MiB;
constexpr size_t WS_TB = 38 * MiB;
constexpr size_t WS_H1B = 62 * MiB;
constexpr size_t WS_XB = 96 * MiB;
constexpr size_t WS_YCAT = 96 * MiB;
constexpr size_t WS_UPOOL = 128 * MiB;
constexpr size_t WS_USSM = 144 * MiB;
constexpr size_t WS_FG = 168 * MiB;
constexpr size_t WS_POOLED = 184 * MiB;
constexpr size_t WS_ZG = 200 * MiB;
constexpr size_t WS_ACT = 96 * MiB;
constexpr size_t WS_END = 216 * MiB;

constexpr int RING_BYTES = 131072, XTRA_OFF = RING_BYTES, XTRA_BYTES = 12288, LDSCTL_OFF = XTRA_OFF + XTRA_BYTES, LDS_BYTES = 147456;

__device__ __forceinline__ unsigned f2bf(float f) { unsigned u = __builtin_bit_cast(unsigned, f); return (u + 0x7fffu + ((u >> 16) & 1u)) >> 16; }
__device__ __forceinline__ unsigned pk2(float lo, float hi) { return f2bf(lo) | (f2bf(hi) << 16); }
__device__ __forceinline__ unsigned cvt_pk_bf16(float lo, float hi) { unsigned r; asm volatile("v_cvt_pk_bf16_f32 %0, %1, %2" : "=v"(r) : "v"(lo), "v"(hi)); return r; }
__device__ __forceinline__ u32x4 pack8(f32x4 a, f32x4 b) { u32x4 w; w.x = cvt_pk_bf16(a[0], a[1]); w.y = cvt_pk_bf16(a[2], a[3]); w.z = cvt_pk_bf16(b[0], b[1]); w.w = cvt_pk_bf16(b[2], b[3]); return w; }
__device__ __forceinline__ u32x2 pack4(f32x4 a) { u32x2 w; w.x = cvt_pk_bf16(a[0], a[1]); w.y = cvt_pk_bf16(a[2], a[3]); return w; }
__device__ __forceinline__ float bflo(unsigned w) { return __builtin_bit_cast(float, w << 16); }
__device__ __forceinline__ float bfhi(unsigned w) { return __builtin_bit_cast(float, w & 0xffff0000u); }
__device__ __forceinline__ void unpack8(u32x4 w, f32x4& a, f32x4& b) { a[0] = bflo(w.x); a[1] = bfhi(w.x); a[2] = bflo(w.y); a[3] = bfhi(w.y); b[0] = bflo(w.z); b[1] = bfhi(w.z); b[2] = bflo(w.w); b[3] = bfhi(w.w); }
__device__ __forceinline__ float fast_sigmoid(float x) { return __builtin_amdgcn_rcpf(1.0f + __builtin_amdgcn_exp2f(-1.4426950408889634f * x)); }
__device__ __forceinline__ float fast_gelu_tanh(float x) {
    const float t = x * (1.0f + 0.044715f * x * x);
    return x * __builtin_amdgcn_rcpf(1.0f + __builtin_amdgcn_exp2f(-2.0f * 0.7978845608028654f * 1.4426950408889634f * t));
}
__device__ __forceinline__ float wave_sum(float v) {
#pragma unroll
    for (int o = 1; o < 64; o <<= 1) v += __shfl_xor(v, o);
    return v;
}
__device__ __forceinline__ float dpp_ror1(float v)  { return __builtin_bit_cast(float, __builtin_amdgcn_update_dpp(0, __builtin_bit_cast(int, v), 0x121, 0xf, 0xf, false)); }
__device__ __forceinline__ float dpp_ror15(float v) { return __builtin_bit_cast(float, __builtin_amdgcn_update_dpp(0, __builtin_bit_cast(int, v), 0x12F, 0xf, 0xf, false)); }
#define LDS_WAIT() asm volatile("s_waitcnt lgkmcnt(0)" ::: "memory")
#define VM_WAIT() asm volatile("s_waitcnt vmcnt(0)" ::: "memory")

#define XB_TMO      128
#define XB_XCNT(j)  (256  + 64 * (j))
#define XB_XSUB(j)  (1280 + 64 * (j))
#define XB_XGEN(j)  (2304 + 64 * (j))
#define XB_TOP      3328
#define XB_TOPGEN   3392
#define XCD_BAR_WORDS 3456
#define XB_SPIN_CAP (1u << 18)
__device__ __forceinline__ unsigned xb_ld(unsigned* p)              { return __hip_atomic_load(p, __ATOMIC_RELAXED, __HIP_MEMORY_SCOPE_AGENT); }
__device__ __forceinline__ unsigned xb_add(unsigned* p, unsigned v) { return __hip_atomic_fetch_add(p, v, __ATOMIC_RELAXED, __HIP_MEMORY_SCOPE_AGENT); }
__device__ __forceinline__ unsigned xb_xcc_id() { return (unsigned)__builtin_amdgcn_s_getreg((3 << 11) | 20) & 0xFu; }
#define XB_SPIN(cond, bar) do { unsigned _sp = 0; while (cond) { __builtin_amdgcn_s_sleep(1); \
    if ((++_sp & 255u) == 0u) { if (xb_ld(&(bar)[XB_TMO])) break; if (_sp > XB_SPIN_CAP) { atomicAdd(&(bar)[XB_TMO], 1u); break; } } } } while (0)
struct XcdBarrier { unsigned* bar; unsigned x; volatile LAS unsigned* st; };
__device__ __forceinline__ XcdBarrier xcd_barrier_post(unsigned* bar, volatile LAS unsigned* st) {
    XcdBarrier b; b.bar = bar; b.x = xb_xcc_id(); b.st = st;
    if (threadIdx.x == 0) (void)xb_add(&bar[XB_XCNT(b.x)], 1u);
    return b;
}
__device__ __forceinline__ void xcd_barrier_complete(unsigned* bar, unsigned x, unsigned& nloc, unsigned& nx) {
    const unsigned G = gridDim.x * gridDim.y * gridDim.z;
    unsigned sum, cnt, mine, sp = 0u;
    for (;;) {
        sum = 0u; cnt = 0u; mine = 0u;
#pragma unroll
        for (unsigned j = 0; j < 16; ++j) { const unsigned c = xb_ld(&bar[XB_XCNT(j)]); sum += c; cnt += (c > 0u) ? 1u : 0u; mine = (j == x) ? c : mine; }
        if (sum == G) break;
        __builtin_amdgcn_s_sleep(1);
        if ((++sp & 255u) == 0u) { if (xb_ld(&bar[XB_TMO])) break; if (sp > XB_SPIN_CAP) { atomicAdd(&bar[XB_TMO], 1u); break; } }
    }
    nloc = mine > 0u ? mine : 1u; nx = cnt > 0u ? cnt : 1u;
}
__device__ __forceinline__ void xcd_barrier(const XcdBarrier& b) {
    asm volatile("s_waitcnt vmcnt(0)" ::: "memory");
    __syncthreads();
    if (threadIdx.x == 0) {
        unsigned* bar = b.bar;
        __builtin_amdgcn_s_waitcnt(0);
        unsigned nloc = b.st[0], nx = b.st[1];
        if (nloc == 0u) { xcd_barrier_complete(bar, b.x, nloc, nx); b.st[0] = nloc; b.st[1] = nx; }
        const unsigned old = xb_add(&bar[XB_XSUB(b.x)], 1u);
        const unsigned gen = old / nloc;
        if (old + 1u == (gen + 1u) * nloc) {
            __builtin_amdgcn_fence(__ATOMIC_RELEASE, "agent");
            asm volatile("s_waitcnt vmcnt(0)" ::: "memory");
            const unsigned og = xb_add(&bar[XB_TOP], 1u);
            const unsigned tg = og / nx;
            if (og + 1u == (tg + 1u) * nx) xb_add(&bar[XB_TOPGEN], 1u);
            else XB_SPIN(xb_ld(&bar[XB_TOPGEN]) == tg, bar);
            __builtin_amdgcn_fence(__ATOMIC_ACQUIRE, "agent");
            xb_add(&bar[XB_XGEN(b.x)], 1u);
            asm volatile("s_waitcnt vmcnt(0)" ::: "memory");
        } else {
            XB_SPIN(xb_ld(&bar[XB_XGEN(b.x)]) == gen, bar);
            __builtin_amdgcn_fence(__ATOMIC_ACQUIRE, "agent");
            asm volatile("s_waitcnt vmcnt(0)" ::: "memory");
        }
    }
    __syncthreads();
}

constexpr int BM = 256, BK = 64, HALF = 128, HTB = HALF * BK * 2, STAGE_BYTES = 8 * HTB, NXCD = 8, WGM = 8;
__host__ __device__ __forceinline__ int lds_byte(int r, int c) { const int st = (r >> 4) * 2 + (c >> 5), rr = r & 15, cc = c & 31, ob = rr * 64 + cc * 2; return st * 1024 + (ob ^ (((ob >> 9) & 1) << 5)); }
__host__ __device__ __forceinline__ void stage_rc(int b, int& R, int& C) { const int st = b / 1024, sb = b % 1024, swz = sb ^ (((sb >> 9) & 1) << 5); R = (st >> 1) * 16 + swz / 64; C = (st & 1) * 32 + (swz % 64) / 2; }
__host__ __device__ __forceinline__ int perm32(int rho) { const int n = rho >> 4, i = rho & 15; return 8 * (i >> 2) + 4 * n + (i & 3); }

struct Unit { int pm, pn, g; };
struct GemmDesc { const char* A; const char* B; long a_pm, a_g, b_pn, b_g, a_h, b_h, a_k, b_k; int nt; };

struct StaticOrder {
    int nM, nN, nwg, G, c;
    __device__ void init(int nM_, int nN_, int G_, int c_) { nM = nM_; nN = nN_; nwg = nM * nN; G = G_; c = c_; }
    __device__ bool next(int i, Unit& u) const {
        const long L = (long)i * G + c; if (L >= nwg) return false;
        int wgid = (int)L; { const int q = nwg / NXCD, r = nwg % NXCD, xcd = wgid % NXCD, off = wgid / NXCD; wgid = (xcd < r ? xcd * (q + 1) : r * (q + 1) + (xcd - r) * q) + off; }
        const int nig = WGM * nN, gid = wgid / nig, fm = gid * WGM, gsz = (nM - fm) < WGM ? (nM - fm) : WGM;
        u.pm = fm + ((wgid % nig) % gsz); u.pn = (wgid % nig) / gsz; u.g = 0; return true;
    }
};

template <class Epi, class Sched, bool ALIGN_EPI>
__device__ __forceinline__ void gemm_phase(LAS unsigned char* lds, const GemmDesc g, const unsigned (&voffA)[2], const unsigned (&voffB)[2], const Sched& S, Epi& E) {
    const int tid = threadIdx.x, wid = __builtin_amdgcn_readfirstlane(tid >> 6), lane = tid & 63, wr = wid >> 2, wc = wid & 3, fr = lane & 15, fq = lane >> 4;
    const int nt = g.nt;
    const long kstepA = g.a_k, kstepB = g.b_k, hstepA = g.a_h, hstepB = g.b_h;
    const unsigned ldsw = (unsigned)wid * 1024u;
    const int aoff = lds_byte(wr * 64 + fr, fq * 8), boff = lds_byte(wc * 32 + fr, fq * 8);
#define PG8_SA(b, h) (((b) * 2 + (h)) * HTB)
#define PG8_SB(b, h) ((4 + (b) * 2 + (h)) * HTB)
#define PG8_STAGE(bufoff, gbase, voff) do { _Pragma("unroll") for (int _i = 0; _i < 2; ++_i) \
        __builtin_amdgcn_global_load_lds((const unsigned*)((const char*)(gbase) + (voff)[_i]), (LAS unsigned*)(lds + (bufoff) + ldsw + _i * 8192), 16, 0, 0); } while (0)
#define PG8_LDA(dst, b, h) do { _Pragma("unroll") for (int m = 0; m < 4; ++m) _Pragma("unroll") for (int k = 0; k < 2; ++k) dst[m][k] = *(const LAS bf16x8*)(lds + PG8_SA(b, h) + aoff + m * 2048 + k * 1024); } while (0)
#define PG8_LDB(dst, b, h) do { _Pragma("unroll") for (int n = 0; n < 2; ++n) _Pragma("unroll") for (int k = 0; k < 2; ++k) dst[n][k] = *(const LAS bf16x8*)(lds + PG8_SB(b, h) + boff + n * 2048 + k * 1024); } while (0)
#define PG8_MMA(ai, bj, At, Bt) do { __builtin_amdgcn_s_setprio(1); _Pragma("unroll") for (int m = 0; m < 4; ++m) _Pragma("unroll") for (int n = 0; n < 2; ++n) _Pragma("unroll") for (int k = 0; k < 2; ++k) \
        acc[ai][bj][m][n] = __builtin_amdgcn_mfma_f32_16x16x32_bf16(Bt[n][k], At[m][k], acc[ai][bj][m][n], 0, 0, 0); __builtin_amdgcn_s_setprio(0); } while (0)
#define PG8_WAIT_V(n) asm volatile("s_waitcnt vmcnt(" #n ")" ::: "memory")
#define PG8_WAIT_L(n) asm volatile("s_waitcnt lgkmcnt(" #n ")" ::: "memory")
#define PG8_BAR __builtin_amdgcn_s_barrier()
#define PG8_SCHED __builtin_amdgcn_sched_barrier(0)
    Unit cur, nxt; int ui = 0;
    if (!S.next(0, cur)) return;
    f32x4 acc[2][2][4][2];
#pragma unroll
    for (int a = 0; a < 2; ++a)
#pragma unroll
        for (int b = 0; b < 2; ++b)
#pragma unroll
            for (int m = 0; m < 4; ++m)
#pragma unroll
                for (int n = 0; n < 2; ++n) acc[a][b][m][n] = (f32x4){0.f, 0.f, 0.f, 0.f};
    bf16x8 At[4][2], B0[2][2], B1[2][2];
    const char* cA = g.A + (long)cur.pm * g.a_pm + (long)cur.g * g.a_g; const char* cB = g.B + (long)cur.pn * g.b_pn + (long)cur.g * g.b_g;
    PG8_STAGE(PG8_SB(0, 0), cB, voffB); PG8_STAGE(PG8_SB(0, 1), cB + hstepB, voffB); PG8_STAGE(PG8_SA(0, 0), cA, voffA); PG8_STAGE(PG8_SA(0, 1), cA + hstepA, voffA);
    if (wr == 1) PG8_BAR;
    PG8_WAIT_V(2); PG8_BAR;
    PG8_STAGE(PG8_SB(1, 0), cB + kstepB, voffB); PG8_STAGE(PG8_SA(1, 0), cA + kstepA, voffA); PG8_STAGE(PG8_SB(1, 1), cB + hstepB + kstepB, voffB);
    PG8_WAIT_V(6); PG8_BAR;
    for (;;) {
        const bool has_next = S.next(ui + 1, nxt);
        const char* nA = has_next ? g.A + (long)nxt.pm * g.a_pm + (long)nxt.g * g.a_g : cA; const char* nB = has_next ? g.B + (long)nxt.pn * g.b_pn + (long)nxt.g * g.b_g : cB;
        for (int t = 0; t < nt; t += 2) {
            const bool last = (t == nt - 2);
            const char* a1 = cA + (long)(t + 1) * kstepA;
            const char* a2 = last ? nA : cA + (long)(t + 2) * kstepA; const char* b2 = last ? nB : cB + (long)(t + 2) * kstepB;
            const char* a3 = a2 + kstepA; const char* b3 = b2 + kstepB;
            PG8_LDB(B0, 0, 0); PG8_LDB(B1, 0, 1); PG8_SCHED; PG8_LDA(At, 0, 0); PG8_STAGE(PG8_SA(1, 1), a1 + hstepA, voffA);
            PG8_WAIT_V(8); PG8_WAIT_L(0); PG8_BAR; PG8_MMA(0, 0, At, B0); PG8_MMA(0, 1, At, B1); PG8_BAR; PG8_SCHED;
            PG8_LDA(At, 0, 1); PG8_STAGE(PG8_SB(0, 0), b2, voffB); PG8_STAGE(PG8_SB(0, 1), b2 + hstepB, voffB); PG8_STAGE(PG8_SA(0, 0), a2, voffA);
            PG8_WAIT_V(8); PG8_WAIT_L(0); PG8_BAR; PG8_MMA(1, 0, At, B0); PG8_MMA(1, 1, At, B1); PG8_BAR; PG8_SCHED;
            PG8_LDB(B0, 1, 0); PG8_LDB(B1, 1, 1); PG8_SCHED; PG8_LDA(At, 1, 0); PG8_STAGE(PG8_SA(0, 1), a2 + hstepA, voffA);
            PG8_WAIT_V(8); PG8_WAIT_L(0); PG8_BAR; PG8_MMA(0, 0, At, B0); PG8_MMA(0, 1, At, B1); PG8_BAR; PG8_SCHED;
            PG8_LDA(At, 1, 1); PG8_STAGE(PG8_SB(1, 0), b3, voffB); PG8_STAGE(PG8_SB(1, 1), b3 + hstepB, voffB); PG8_STAGE(PG8_SA(1, 0), a3, voffA);
            PG8_WAIT_V(8); PG8_WAIT_L(0); PG8_BAR; PG8_MMA(1, 0, At, B0); PG8_MMA(1, 1, At, B1); PG8_BAR; PG8_SCHED;
            if constexpr (Epi::HAS_MID) { if (t + 2 == Epi::MID_T) E.mid(acc, wr, fr); }
        }
        if constexpr (ALIGN_EPI) { if (wr == 0) PG8_BAR; }
        if constexpr (!Epi::AFTER_DRAIN) { E(acc, cur, wr, wc, fr, fq); }
        if (!has_next) break;
#pragma unroll
        for (int a = 0; a < 2; ++a)
#pragma unroll
            for (int b = 0; b < 2; ++b)
#pragma unroll
                for (int m = 0; m < 4; ++m)
#pragma unroll
                    for (int n = 0; n < 2; ++n) acc[a][b][m][n] = (f32x4){0.f, 0.f, 0.f, 0.f};
        cur = nxt; cA = nA; cB = nB; ++ui;
        if constexpr (ALIGN_EPI) { if (wr == 1) PG8_BAR; }
    }
    PG8_WAIT_V(0);
    if constexpr (!ALIGN_EPI) { if (wr == 0) PG8_BAR; }
    PG8_BAR;
    if constexpr (Epi::AFTER_DRAIN) { E.fused(acc, cur, wr, wc, fr, fq, lds, wid, lane); }
#undef PG8_SA
#undef PG8_SB
#undef PG8_STAGE
#undef PG8_LDA
#undef PG8_LDB
#undef PG8_MMA
#undef PG8_WAIT_V
#undef PG8_WAIT_L
#undef PG8_BAR
#undef PG8_SCHED
}

__device__ __forceinline__ void voff_std(unsigned (&v)[2], int ld, bool perm) {
#pragma unroll
    for (int i = 0; i < 2; ++i) { int R, C; stage_rc((int)threadIdx.x * 16 + i * 8192, R, C); const int Rb = perm ? ((R & ~31) + perm32(R & 31)) : R; v[i] = (unsigned)(Rb * ld + C) * 2u; }
}

typedef f32x4 Acc[2][2][4][2];

struct EpiU {
    static constexpr bool PERM = true, AFTER_DRAIN = false, HAS_MID = false; static constexpr int MID_T = 0;
    const float* r0; bf16_t* upool; bf16_t* ussm;
    __device__ __forceinline__ void operator()(Acc& acc, const Unit& u, int wr, int wc, int fr, int fq) const {
#pragma unroll
        for (int ai = 0; ai < 2; ++ai)
#pragma unroll
            for (int m = 0; m < 4; ++m) {
                const int row = u.pm * BM + ai * HALF + wr * 64 + m * 16 + fr; const float rs = r0[row];
#pragma unroll
                for (int bj = 0; bj < 2; ++bj) {
                    const int c8 = u.pn * BM + bj * HALF + wc * 32 + 8 * fq;
                    const u32x4 w = pack8(acc[ai][bj][m][0] * rs, acc[ai][bj][m][1] * rs);
                    if (u.pn < 2) *(u32x4*)(upool + (size_t)row * DPOOL + c8) = w;
                    else { const int cs = c8 - DPOOL, gg = cs >> 4, h0 = cs & 15, cr = row / TCH, p = row % TCH;
                           *(u32x4*)(ussm + ((size_t)(gg * NCR + cr) * ROWLEN + 16 * p + h0)) = w; }
                }
            }
    }
};
struct EpiFG {
    static constexpr bool PERM = false, AFTER_DRAIN = false, HAS_MID = false; static constexpr int MID_T = 0;
    float* fg;
    __device__ __forceinline__ void operator()(Acc& acc, const Unit& u, int wr, int wc, int fr, int fq) const {
#pragma unroll
        for (int ai = 0; ai < 2; ++ai)
#pragma unroll
            for (int m = 0; m < 4; ++m) {
                const int cr = u.pm * BM + ai * HALF + wr * 64 + m * 16 + fr; float* rowp = fg + ((size_t)u.g * NCR + cr) * 256 + wc * 32 + 4 * fq;
#pragma unroll
                for (int bj = 0; bj < 2; ++bj)
#pragma unroll
                    for (int n = 0; n < 2; ++n) *(f32x4*)(rowp + bj * HALF + n * 16) = acc[ai][bj][m][n];
            }
    }
};
struct EpiZ {
    static constexpr bool PERM = true, AFTER_DRAIN = false, HAS_MID = false; static constexpr int MID_T = 0;
    const bf16_t* ussm; const float* dvec; bf16_t* zg;
    __device__ __forceinline__ void operator()(Acc& acc, const Unit& u, int wr, int wc, int fr, int fq) const {
#pragma unroll
        for (int bj = 0; bj < 2; ++bj) {
            const int c8 = u.pn * BM + bj * HALF + wc * 32 + 8 * fq;
            const f32x4 d0 = *(const f32x4*)(dvec + u.g * 16 + (c8 & 15)), d1 = *(const f32x4*)(dvec + u.g * 16 + (c8 & 15) + 4);
#pragma unroll
            for (int ai = 0; ai < 2; ++ai)
#pragma unroll
                for (int m = 0; m < 4; ++m) {
                    const int cr = u.pm * BM + ai * HALF + wr * 64 + m * 16 + fr;
                    const u32x4 uw = *(const u32x4*)(ussm + ((size_t)(u.g * NCR + cr) * ROWLEN + c8));
                    f32x4 u0, u1; unpack8(uw, u0, u1);
                    f32x4 y0 = acc[ai][bj][m][0] + d0 * u0, y1 = acc[ai][bj][m][1] + d1 * u1;
#pragma unroll
                    for (int i = 0; i < 4; ++i) { y0[i] = fast_gelu_tanh(y0[i]); y1[i] = fast_gelu_tanh(y1[i]); }
                    *(u32x4*)(zg + ((size_t)u.g * MT * 16 + (size_t)cr * K1 + c8)) = pack8(y0, y1);
                }
        }
    }
};
struct EpiPool {
    static constexpr bool PERM = true, AFTER_DRAIN = false, HAS_MID = false; static constexpr int MID_T = 0;
    const float* pscale; bf16_t* ycat; float* ss;
    __device__ __forceinline__ void operator()(Acc& acc, const Unit& u, int wr, int wc, int fr, int fq) const {
        f32x4 sc[2][2];
#pragma unroll
        for (int bj = 0; bj < 2; ++bj) { const int c8 = u.pn * BM + bj * HALF + wc * 32 + 8 * fq; sc[bj][0] = *(const f32x4*)(pscale + c8); sc[bj][1] = *(const f32x4*)(pscale + c8 + 4); }
#pragma unroll
        for (int ai = 0; ai < 2; ++ai)
#pragma unroll
            for (int m = 0; m < 4; ++m) {
                const int row = u.pm * BM + ai * HALF + wr * 64 + m * 16 + fr; float q = 0.f;
#pragma unroll
                for (int bj = 0; bj < 2; ++bj) {
                    const int c8 = u.pn * BM + bj * HALF + wc * 32 + 8 * fq;
                    const f32x4 v0 = acc[ai][bj][m][0] * sc[bj][0], v1 = acc[ai][bj][m][1] * sc[bj][1];
                    q += (v0[0] * v0[0] + v0[1] * v0[1]) + (v0[2] * v0[2] + v0[3] * v0[3]) + (v1[0] * v1[0] + v1[1] * v1[1]) + (v1[2] * v1[2] + v1[3] * v1[3]);
                    *(u32x4*)(ycat + (size_t)row * DM + c8) = pack8(v0, v1);
                }
                q += __shfl_xor(q, 16); q += __shfl_xor(q, 32);
                if (fq == 0) ss[(size_t)(u.pn * 4 + wc) * MT + row] = q;
            }
    }
};
struct EpiGlu {
    static constexpr bool PERM = true, AFTER_DRAIN = false, HAS_MID = false; static constexpr int MID_T = 0;
    const float* gb; const bf16_t* zg; bf16_t* ycat; float* ss;
    __device__ __forceinline__ void operator()(Acc& acc, const Unit& u, int wr, int wc, int fr, int fq) const {
        f32x4 bv[2][2];
#pragma unroll
        for (int bj = 0; bj < 2; ++bj) { const int c8 = u.pn * BM + bj * HALF + wc * 32 + 8 * fq; bv[bj][0] = *(const f32x4*)(gb + c8); bv[bj][1] = *(const f32x4*)(gb + c8 + 4); }
#pragma unroll
        for (int ai = 0; ai < 2; ++ai)
#pragma unroll
            for (int m = 0; m < 4; ++m) {
                const int row = u.pm * BM + ai * HALF + wr * 64 + m * 16 + fr; float q = 0.f;
#pragma unroll
                for (int bj = 0; bj < 2; ++bj) {
                    const int c8 = u.pn * BM + bj * HALF + wc * 32 + 8 * fq;
                    const u32x4 zw = *(const u32x4*)(zg + ((size_t)(c8 >> 4) * MT + row) * 16 + (c8 & 15));
                    f32x4 z0, z1; unpack8(zw, z0, z1);
                    f32x4 v0 = acc[ai][bj][m][0] + bv[bj][0], v1 = acc[ai][bj][m][1] + bv[bj][1];
#pragma unroll
                    for (int i = 0; i < 4; ++i) { v0[i] = z0[i] * fast_sigmoid(v0[i]); v1[i] = z1[i] * fast_sigmoid(v1[i]); }
                    q += (v0[0] * v0[0] + v0[1] * v0[1]) + (v0[2] * v0[2] + v0[3] * v0[3]) + (v1[0] * v1[0] + v1[1] * v1[1]) + (v1[2] * v1[2] + v1[3] * v1[3]);
                    *(u32x4*)(ycat + (size_t)row * DM + DPOOL + c8) = pack8(v0, v1);
                }
                q += __shfl_xor(q, 16); q += __shfl_xor(q, 32);
                if (fq == 0) ss[(size_t)(u.pn * 4 + wc) * MT + row] = q;
            }
    }
};
struct EpiOut {
    static constexpr bool PERM = false, AFTER_DRAIN = true, HAS_MID = true; static constexpr int MID_T = 8;
    const float* x; bf16_t* h1b; float* ss; LAS f32x2* XR; float ratio[2][4];
    __device__ __forceinline__ void mid(Acc& acc, int wr, int fr) const {
#pragma unroll
        for (int ai = 0; ai < 2; ++ai)
#pragma unroll
            for (int m = 0; m < 4; ++m) { const float ratio = this->ratio[ai][m];
#pragma unroll
                for (int bj = 0; bj < 2; ++bj)
#pragma unroll
                    for (int n = 0; n < 2; ++n) acc[ai][bj][m][n] = acc[ai][bj][m][n] * ratio; }
    }
    __device__ __forceinline__ void fused(Acc& acc, const Unit& u, int wr, int wc, int fr, int fq, LAS unsigned char* lds, int wid, int lane) const {
        LAS float* P = (LAS float*)lds;
        const int col0 = u.pn * BM + wc * 32 + 4 * fq;
#pragma unroll
        for (int ai = 0; ai < 2; ++ai)
#pragma unroll
            for (int m = 0; m < 4; ++m) {
                const int lr = ai * HALF + wr * 64 + m * 16 + fr, row = u.pm * BM + lr; const float rs = XR[lr].y; float q = 0.f;
                const size_t prow = (size_t)(row >> 12) * PADROWS + 1 + (row & 4095);
#pragma unroll
                for (int bj = 0; bj < 2; ++bj)
#pragma unroll
                    for (int n = 0; n < 2; ++n) {
                        const int c = col0 + bj * HALF + n * 16;
                        const f32x4 xv = *(const f32x4*)(x + (size_t)row * DM + c);
                        const f32x4 hv = xv + acc[ai][bj][m][n] * rs;
                        q += (hv[0] * hv[0] + hv[1] * hv[1]) + (hv[2] * hv[2] + hv[3] * hv[3]);
                        *(u32x2*)(h1b + prow * DM + c) = pack4(hv);
                    }
                q += __shfl_xor(q, 16); q += __shfl_xor(q, 32);
                if (fq == 0) P[lr * 4 + wc] = q;
            }
        LDS_WAIT(); __builtin_amdgcn_s_barrier(); asm volatile("" ::: "memory");
        const int tid = wid * 64 + lane;
        if (tid < 256) ss[(size_t)u.pn * MT + u.pm * BM + tid] = (P[tid * 4 + 0] + P[tid * 4 + 1]) + (P[tid * 4 + 2] + P[tid * 4 + 3]);
    }
};
struct EpiUp {
    static constexpr bool PERM = true, AFTER_DRAIN = false, HAS_MID = false; static constexpr int MID_T = 0;
    const float* ssh1; const float* cw; const float* cb; bf16_t* act;
    __device__ __forceinline__ void operator()(Acc& acc, const Unit& u, int wr, int wc, int fr, int fq) const {
        const int j = u.pm, b = u.g;
        int tokv[2][4];
#pragma unroll
        for (int ai = 0; ai < 2; ++ai)
#pragma unroll
            for (int m = 0; m < 4; ++m) {
                const int w = 64 * ai + 16 * m + fr, t = UPROWS * j + 126 * wr + w - 1; const bool in = (t >= 0 && t < SEQ);
                const int tok = b * SEQ + (in ? t : 0);
                const float s = (ssh1[tok] + ssh1[MT + tok]) + (ssh1[2 * MT + tok] + ssh1[3 * MT + tok]);
                const float rs = in ? rsqrtf(s * (1.0f / DM) + EPS) : 0.f;
                tokv[ai][m] = (in && w >= 1 && w <= 126) ? tok : -1;
#pragma unroll
                for (int bj = 0; bj < 2; ++bj)
#pragma unroll
                    for (int n = 0; n < 2; ++n) acc[ai][bj][m][n] = acc[ai][bj][m][n] * rs;
            }
        const int f0 = 128 * u.pn + 32 * wc + 8 * fq;
        u32x2 keep[8];
#pragma unroll
        for (int n = 0; n < 2; ++n) {
            const int fc = f0 + 4 * n;
            const f32x4 wv0 = *(const f32x4*)(cw + fc), wv1 = *(const f32x4*)(cw + DFF2 + fc), wv2 = *(const f32x4*)(cw + 2 * DFF2 + fc), bvv = *(const f32x4*)(cb + fc);
            const f32x4 wg0 = *(const f32x4*)(cw + DFF + fc), wg1 = *(const f32x4*)(cw + DFF2 + DFF + fc), wg2 = *(const f32x4*)(cw + 2 * DFF2 + DFF + fc), bgv = *(const f32x4*)(cb + DFF + fc);
#pragma unroll
            for (int gi = 0; gi < 8; ++gi) {
                const int ai = gi >> 2, m = gi & 3, pi = gi > 0 ? gi - 1 : gi, ni = gi < 7 ? gi + 1 : gi;
                const f32x4 cv = acc[ai][0][m][n], cg = acc[ai][1][m][n];
                const f32x4 pv = acc[pi >> 2][0][pi & 3][n], pg = acc[pi >> 2][1][pi & 3][n];
                const f32x4 nv = acc[ni >> 2][0][ni & 3][n], ng = acc[ni >> 2][1][ni & 3][n];
                f32x4 o;
#pragma unroll
                for (int i = 0; i < 4; ++i) {
                    const float v_prev = dpp_ror1(fr == 15 ? pv[i] : cv[i]), v_next = dpp_ror15(fr == 0 ? nv[i] : cv[i]);
                    const float g_prev = dpp_ror1(fr == 15 ? pg[i] : cg[i]), g_next = dpp_ror15(fr == 0 ? ng[i] : cg[i]);
                    const float vv = bvv[i] + wv0[i] * v_prev + wv1[i] * cv[i] + wv2[i] * v_next;
                    const float gg = bgv[i] + wg0[i] * g_prev + wg1[i] * cg[i] + wg2[i] * g_next;
                    o[i] = vv * gg * fast_sigmoid(gg);
                }
                const u32x2 pk = pack4(o);
                if (n == 0) keep[gi] = pk;
                else if (tokv[ai][m] >= 0) { u32x4 w; w.x = keep[gi].x; w.y = keep[gi].y; w.z = pk.x; w.w = pk.y; *(u32x4*)(act + (size_t)tokv[ai][m] * DFF + f0) = w; }
            }
        }
    }
};
struct EpiDown {
    static constexpr bool PERM = false, AFTER_DRAIN = true, HAS_MID = false; static constexpr int MID_T = 0;
    const bf16_t* h1b; float* out; const float* gfin; float* ss; const XcdBarrier* bar;
    __device__ __forceinline__ void fused(Acc& acc, const Unit& u, int wr, int wc, int fr, int fq, LAS unsigned char* lds, int wid, int lane) const {
        LAS float* P = (LAS float*)lds;
        LAS float* Sr = (LAS float*)(lds + 8192);
        const int col0 = u.pn * BM + wc * 32 + 4 * fq;
#pragma unroll
        for (int ai = 0; ai < 2; ++ai)
#pragma unroll
            for (int m = 0; m < 4; ++m) {
                const int lr = ai * HALF + wr * 64 + m * 16 + fr, row = u.pm * BM + lr; float q = 0.f;
                const size_t prow = (size_t)(row >> 12) * PADROWS + 1 + (row & 4095);
#pragma unroll
                for (int bj = 0; bj < 2; ++bj)
#pragma unroll
                    for (int n = 0; n < 2; ++n) {
                        const u32x2 hw = *(const u32x2*)(h1b + prow * DM + col0 + bj * HALF + n * 16);
                        const f32x4 hv = (f32x4){bflo(hw.x), bfhi(hw.x), bflo(hw.y), bfhi(hw.y)} + acc[ai][bj][m][n];
                        acc[ai][bj][m][n] = hv;
                        q += (hv[0] * hv[0] + hv[1] * hv[1]) + (hv[2] * hv[2] + hv[3] * hv[3]);
                    }
                q += __shfl_xor(q, 16); q += __shfl_xor(q, 32);
                if (fq == 0) P[lr * 4 + wc] = q;
            }
        LDS_WAIT(); __builtin_amdgcn_s_barrier(); asm volatile("" ::: "memory");
        const int tid = wid * 64 + lane;
        if (tid < 256) ss[(size_t)u.pn * MT + u.pm * BM + tid] = (P[tid * 4 + 0] + P[tid * 4 + 1]) + (P[tid * 4 + 2] + P[tid * 4 + 3]);
        xcd_barrier(*bar);
        if (tid < 256) { const int row = u.pm * BM + tid; const float s = (ss[row] + ss[MT + row]) + (ss[2 * MT + row] + ss[3 * MT + row]); Sr[tid] = rsqrtf(s * (1.0f / DM) + EPS); }
        LDS_WAIT(); __builtin_amdgcn_s_barrier(); asm volatile("" ::: "memory");
#pragma unroll
        for (int bj = 0; bj < 2; ++bj)
#pragma unroll
            for (int n = 0; n < 2; ++n) {
                const int c = col0 + bj * HALF + n * 16; const f32x4 gv = *(const f32x4*)(gfin + c);
#pragma unroll
                for (int ai = 0; ai < 2; ++ai)
#pragma unroll
                    for (int m = 0; m < 4; ++m) { const int lr = ai * HALF + wr * 64 + m * 16 + fr; const float r = Sr[lr];
                        *(f32x4*)(out + (size_t)(u.pm * BM + lr) * DM + c) = acc[ai][bj][m][n] * r * gv; }
            }
    }
};

struct OrdSsmA { int c; __device__ bool next(int i, Unit& u) const { if (i > 0 || c >= 64) return false; const int x = c & 7, k = c >> 3; u.g = x * 4 + (k >> 1); u.pm = k & 1; u.pn = 0; return true; } };
struct OrdSsmB { int c; __device__ bool next(int i, Unit& u) const { if (i > 0 || c >= 128) return false; const int x = c & 7, k = c >> 3; u.g = x * 4 + (k >> 2); u.pm = (k >> 1) & 1; u.pn = k & 1; return true; } };
struct OrdPool { int c; __device__ bool next(int i, Unit& u) const { if (i > 0 || c < 128 || c >= 256) return false; const int cc = c - 128, x = cc & 7, k = cc >> 3; u.pm = x * 8 + (k >> 1); u.pn = k & 1; u.g = u.pn; return true; } };
struct OrdGlu  { int c; __device__ bool next(int i, Unit& u) const { if (i > 0 || c >= 128) return false; const int x = c & 7, k = c >> 3; u.pm = x * 8 + (k >> 1); u.pn = k & 1; u.g = 0; return true; } };
struct OrdUp { StaticOrder so; __device__ bool next(int i, Unit& u) const { if (!so.next(i, u)) return false; u.g = u.pm / UPT; u.pm = u.pm % UPT; return true; } };

struct Args { const float* in[24]; float* out; unsigned char* ws; int ph_lo, ph_hi; };

struct Frame { LAS unsigned char* lds; int tid, lane, wave, G, bx; };

struct TrMat { const float* W; int K, N; const float* kg0; const float* kg1; int ksplit; bf16_t* WT; int map; int nitems; };
__device__ __forceinline__ void tr_load(const TrMat& m0, const TrMat& m1, int item, int lane, f32x4 (&v)[8]) {
    const bool second = item >= m0.nitems; const TrMat& m = second ? m1 : m0; const int it = second ? item - m0.nitems : item;
    const int nblk = m.N / 32, kb = it / nblk, nb = it % nblk, k0 = 64 * kb, n0 = 32 * nb, r = lane >> 3, c4 = lane & 7;
#pragma unroll
    for (int i = 0; i < 8; ++i) v[i] = *(const f32x4*)(m.W + (size_t)(k0 + 8 * i + r) * m.N + n0 + 4 * c4);
}
__device__ __forceinline__ void tr_store(const TrMat& m0, const TrMat& m1, int item, int lane, const f32x4 (&v)[8], LAS float* scr) {
    const bool second = item >= m0.nitems; const TrMat& m = second ? m1 : m0; const int it = second ? item - m0.nitems : item;
    const int nblk = m.N / 32, kb = it / nblk, nb = it % nblk, k0 = 64 * kb, n0 = 32 * nb, r = lane >> 3, c4 = lane & 7;
#pragma unroll
    for (int i = 0; i < 8; ++i) { const int kk = 8 * i + r, k = k0 + kk; float gn = 1.f; if (m.kg0) gn = (k < m.ksplit ? m.kg0[k] : m.kg1[k - m.ksplit]);
        LAS float* d = scr + kk * 33 + 4 * c4; d[0] = v[i][0] * gn; d[1] = v[i][1] * gn; d[2] = v[i][2] * gn; d[3] = v[i][3] * gn; }
    LDS_WAIT(); asm volatile("" ::: "memory");
    const int c = lane & 7;
#pragma unroll
    for (int j = 0; j < 4; ++j) { const int n = (lane >> 3) + 8 * j; const LAS float* q = scr + (8 * c) * 33 + n;
        u32x4 o; o.x = pk2(q[0 * 33], q[1 * 33]); o.y = pk2(q[2 * 33], q[3 * 33]); o.z = pk2(q[4 * 33], q[5 * 33]); o.w = pk2(q[6 * 33], q[7 * 33]);
        int nr = n0 + n;
        if (m.map == 1) { const int bj = nr / DFF, rem = nr % DFF; nr = 256 * (rem >> 7) + 128 * bj + (rem & 127); }
        *(u32x4*)(m.WT + (size_t)nr * m.K + k0 + 8 * c) = o; }
    LDS_WAIT(); asm volatile("" ::: "memory");
}
__device__ __forceinline__ void tr_run(const TrMat& m0, const TrMat& m1, int first, int stride, int lane, LAS float* scr) {
    const int total = m0.nitems + m1.nitems; f32x4 va[8], vb[8];
    int it = first; if (it < total) tr_load(m0, m1, it, lane, va);
    while (it < total) {
        const int n1 = it + stride; if (n1 < total) tr_load(m0, m1, n1, lane, vb);
        tr_store(m0, m1, it, lane, va, scr);
        if (n1 >= total) break;
        const int n2 = n1 + stride; if (n2 < total) tr_load(m0, m1, n2, lane, va);
        tr_store(m0, m1, n1, lane, vb, scr);
        it = n2;
    }
}

struct SsmLds { LAS float* Bre; LAS float* Bim; LAS float* Cre; LAS float* Cim; LAS float* PAR; LAS float* Pc; LAS float* Kl; };
__device__ __forceinline__ SsmLds ssm_lds(const Frame& F) { SsmLds L; L.Bre = (LAS float*)(F.lds); L.Bim = L.Bre + 2048; L.Cre = L.Bim + 2048; L.Cim = L.Cre + 2048; L.PAR = L.Cim + 2048; L.Pc = L.PAR + 512; L.Kl = L.Pc + 1024; return L; }
__device__ __forceinline__ void ssm_stage(const Args& a, const Frame& F, const SsmLds& L, int g) {
    const float* lnar = a.in[5]; const float* aim = a.in[6]; const float* ldt = a.in[7];
    const float* bre = a.in[8]; const float* bim = a.in[9]; const float* cre = a.in[10]; const float* cim = a.in[11];
    const int tid = F.tid;
    for (int i = tid; i < 2048; i += 512) { const int dir = i >> 10, r = i & 1023;
        L.Bre[i] = bre[((size_t)(dir * NG + g)) * 1024 + r]; L.Bim[i] = bim[((size_t)(dir * NG + g)) * 1024 + r];
        L.Cre[i] = cre[((size_t)(dir * NG + g)) * 1024 + r]; L.Cim[i] = cim[((size_t)(dir * NG + g)) * 1024 + r]; }
    if (tid < 128) { const int dir = tid >> 6, n = tid & 63;
        const float dt = expf(ldt[dir * NG + g]); const float a_re = -expf(lnar[(dir * NG + g) * NS + n]), a_im = aim[(dir * NG + g) * NS + n];
        const float mag = expf(a_re * dt), ang = a_im * dt; const float lam_re = mag * cosf(ang), lam_im = mag * sinf(ang);
        const float den = a_re * a_re + a_im * a_im;
        L.PAR[tid * 4 + 0] = a_re * dt; L.PAR[tid * 4 + 1] = ang;
        L.PAR[tid * 4 + 2] = ((lam_re - 1.0f) * a_re + lam_im * a_im) / den; L.PAR[tid * 4 + 3] = (lam_im * a_re - (lam_re - 1.0f) * a_im) / den; }
    __syncthreads();
}
__device__ __forceinline__ void ssm_build_tb(const Args& a, const Frame& F, const SsmLds& L, int g, int jq) {
    bf16_t* TB = (bf16_t*)(a.ws + WS_TB) + (size_t)g * K1 * ROWLEN;
    const int tid = F.tid;
    { const int li = tid >> 7, dn = tid & 127, lag = 4 * jq + li; const float ad = L.PAR[dn * 4 + 0], ang = L.PAR[dn * 4 + 1], fr_ = L.PAR[dn * 4 + 2], fi_ = L.PAR[dn * 4 + 3];
      const float mg = expf((float)lag * ad); float sn, cs; sincosf((float)lag * ang, &sn, &cs); const float lr = mg * cs, lim = mg * sn;
      L.Pc[(li * 128 + dn) * 2 + 0] = lr * fr_ - lim * fi_; L.Pc[(li * 128 + dn) * 2 + 1] = lr * fi_ + lim * fr_; }
    __syncthreads();
    { const int li = F.wave >> 1, dir = F.wave & 1, i16 = F.lane & 15, kq = F.lane >> 4; f32x4 kacc = {0.f, 0.f, 0.f, 0.f};
#pragma unroll 8
      for (int kk0 = 0; kk0 < 128; kk0 += 4) { const int kk = kk0 + kq, n = kk >> 1; const bool im = (kk & 1) != 0;
          const float cr_ = L.Cre[dir * 1024 + i16 * 64 + n], ci_ = L.Cim[dir * 1024 + i16 * 64 + n], pr = L.Pc[(li * 128 + dir * 64 + n) * 2], pi = L.Pc[(li * 128 + dir * 64 + n) * 2 + 1];
          const float av = im ? -(cr_ * pi + ci_ * pr) : (cr_ * pr - ci_ * pi);
          const float bv = im ? L.Bim[dir * 1024 + n * 16 + i16] : L.Bre[dir * 1024 + n * 16 + i16];
          kacc = __builtin_amdgcn_mfma_f32_16x16x4f32(av, bv, kacc, 0, 0, 0); }
#pragma unroll
      for (int r = 0; r < 4; ++r) L.Kl[li * 512 + dir * 256 + (kq * 4 + r) * 16 + i16] = kacc[r]; }
    __syncthreads();
    for (int li = 0; li < 4; ++li) {
        const int lag = 4 * jq + li; const LAS float* Kq = L.Kl + li * 512;
        if (lag == 0) {
            const int p = tid >> 4, h = tid & 15; u32x4 w0, w1; float v[16];
#pragma unroll
            for (int i = 0; i < 16; ++i) v[i] = Kq[h * 16 + i] + Kq[256 + h * 16 + i];
            w0.x = pk2(v[0], v[1]); w0.y = pk2(v[2], v[3]); w0.z = pk2(v[4], v[5]); w0.w = pk2(v[6], v[7]); w1.x = pk2(v[8], v[9]); w1.y = pk2(v[10], v[11]); w1.z = pk2(v[12], v[13]); w1.w = pk2(v[14], v[15]);
            bf16_t* dst = TB + (size_t)(16 * p + h) * ROWLEN + 16 * p; *(u32x4*)dst = w0; *(u32x4*)(dst + 8) = w1;
        } else {
            const int nb = TCH - lag;
            for (int idx = tid; idx < 2 * nb * 16; idx += 512) {
                const int dir = idx / (nb * 16), r = idx % (nb * 16), bi = r >> 4, h = r & 15;
                const int p = dir == 0 ? lag + bi : bi, q = dir == 0 ? bi : lag + bi;
                u32x4 w0, w1; float v[16];
#pragma unroll
                for (int i = 0; i < 16; ++i) v[i] = Kq[dir * 256 + h * 16 + i];
                w0.x = pk2(v[0], v[1]); w0.y = pk2(v[2], v[3]); w0.z = pk2(v[4], v[5]); w0.w = pk2(v[6], v[7]); w1.x = pk2(v[8], v[9]); w1.y = pk2(v[10], v[11]); w1.z = pk2(v[12], v[13]); w1.w = pk2(v[14], v[15]);
                bf16_t* dst = TB + (size_t)(16 * p + h) * ROWLEN + 16 * q; *(u32x4*)dst = w0; *(u32x4*)(dst + 8) = w1;
            }
        }
    }
    __syncthreads();
    { const int li = tid >> 7, dn = tid & 127, dir = dn >> 6, p = 4 * jq + li; const float ad = L.PAR[dn * 4 + 0], ang = L.PAR[dn * 4 + 1]; const float e = dir == 0 ? (float)(p + 1) : (float)(TCH - p);
      const float mg = expf(e * ad); float sn, cs; sincosf(e * ang, &sn, &cs); L.Pc[(li * 128 + dn) * 2 + 0] = mg * cs; L.Pc[(li * 128 + dn) * 2 + 1] = mg * sn; }
    __syncthreads();
    for (int li = 0; li < 4; ++li) {
        const int p = 4 * jq + li, h = tid >> 5, dir = (tid >> 4) & 1, n4 = tid & 15; float v[8];
#pragma unroll
        for (int e = 0; e < 4; ++e) { const int n = 4 * n4 + e; const float cr_ = L.Cre[dir * 1024 + h * 64 + n], ci_ = L.Cim[dir * 1024 + h * 64 + n], pr = L.Pc[(li * 128 + dir * 64 + n) * 2], pi = L.Pc[(li * 128 + dir * 64 + n) * 2 + 1];
            v[2 * e] = cr_ * pr - ci_ * pi; v[2 * e + 1] = -(cr_ * pi + ci_ * pr); }
        u32x4 w; w.x = pk2(v[0], v[1]); w.y = pk2(v[2], v[3]); w.z = pk2(v[4], v[5]); w.w = pk2(v[6], v[7]);
        *(u32x4*)(TB + (size_t)(16 * p + h) * ROWLEN + K1 + dir * 128 + 8 * n4) = w;
    }
    __syncthreads();
}
__device__ __forceinline__ void ssm_build_wab(const Args& a, const Frame& F, const SsmLds& L, int g, int jq) {
    bf16_t* WAB = (bf16_t*)(a.ws + WS_WAB) + (size_t)g * 256 * K1;
    const int tid = F.tid;
    { const int li = tid >> 7, dn = tid & 127, dir = dn >> 6, q = 4 * jq + li; const float ad = L.PAR[dn * 4 + 0], ang = L.PAR[dn * 4 + 1], fr_ = L.PAR[dn * 4 + 2], fi_ = L.PAR[dn * 4 + 3]; const float e = dir == 0 ? (float)(TCH - 1 - q) : (float)q;
      const float mg = expf(e * ad); float sn, cs; sincosf(e * ang, &sn, &cs); const float lr = mg * cs, lim = mg * sn;
      L.Pc[(li * 128 + dn) * 2 + 0] = lr * fr_ - lim * fi_; L.Pc[(li * 128 + dn) * 2 + 1] = lr * fi_ + lim * fr_; }
    __syncthreads();
#pragma unroll
    for (int half = 0; half < 2; ++half) {
        const int li = 2 * half + (tid >> 8), q = 4 * jq + li, t2 = tid & 255, dir = t2 >> 7, n = (t2 >> 1) & 63, part = t2 & 1;
        const float pr = L.Pc[(li * 128 + dir * 64 + n) * 2], pi = L.Pc[(li * 128 + dir * 64 + n) * 2 + 1]; float v[16];
#pragma unroll
        for (int i = 0; i < 16; ++i) { const float br_ = L.Bre[dir * 1024 + n * 16 + i], bi_ = L.Bim[dir * 1024 + n * 16 + i]; v[i] = part == 0 ? (pr * br_ - pi * bi_) : (pr * bi_ + pi * br_); }
        u32x4 w0, w1; w0.x = pk2(v[0], v[1]); w0.y = pk2(v[2], v[3]); w0.z = pk2(v[4], v[5]); w0.w = pk2(v[6], v[7]); w1.x = pk2(v[8], v[9]); w1.y = pk2(v[10], v[11]); w1.z = pk2(v[12], v[13]); w1.w = pk2(v[14], v[15]);
        bf16_t* dst = WAB + (size_t)(dir * 128 + 2 * n + part) * K1 + 16 * q; *(u32x4*)dst = w0; *(u32x4*)(dst + 8) = w1;
    }
    __syncthreads();
}

__device__ __forceinline__ void p0_prologue(const Args& a, const Frame& F) {
    const float* x = a.in[0];
    { const SsmLds L = ssm_lds(F);
      for (int it = F.bx; it < NG * 8; it += F.G) { ssm_stage(a, F, L, it >> 3); ssm_build_wab(a, F, L, it >> 3, it & 7); } }
    __syncthreads();
    LAS float* scr = (LAS float*)(F.lds + F.wave * 16384);
    const int gw = F.bx * 8 + F.wave, NGW = F.G * 8;
    { const TrMat m0{a.in[2], DM, DM, a.in[1], a.in[1], DM, (bf16_t*)(a.ws + WS_WIN), 0, (DM / 64) * (DM / 32)}; const TrMat m1{nullptr, 0, 32, nullptr, nullptr, 0, nullptr, 0, 0};
      tr_run(m0, m1, gw, NGW, F.lane, scr); }
    { bf16_t* PW = (bf16_t*)(a.ws + WS_PW); const float* pw = a.in[3];
      for (int idx = F.bx * 512 + F.tid; idx < 2 * 256 * 256; idx += F.G * 512) { const int pn = idx >> 16, j = (idx >> 8) & 255, k = idx & 255;
          const float v = ((j >> 7) == (k >> 7)) ? pw[((size_t)(2 * pn + (j >> 7)) * 128 + (k & 127)) * 128 + (j & 127)] : 0.f; PW[idx] = (bf16_t)f2bf(v); } }
    { bf16_t* h1b = (bf16_t*)(a.ws + WS_H1B);
      for (int idx = F.bx * 512 + F.tid; idx < BATCH * 256 * (DM / 8); idx += F.G * 512) { const int b = idx / (256 * 128), r = (idx / 128) % 256, c = idx % 128; const int prow = b * PADROWS + (r == 0 ? 0 : 4096 + r);
          *(u32x4*)(h1b + (size_t)prow * DM + 8 * c) = (u32x4){0u, 0u, 0u, 0u}; } }
    { bf16_t* xb = (bf16_t*)(a.ws + WS_XB); float* r0 = (float*)(a.ws + WS_R0);
      for (int row = gw; row < MT; row += NGW) {
          const f32x4* xr = (const f32x4*)(x + (size_t)row * DM) + F.lane; f32x4 v[4]; float s = 0.f;
#pragma unroll
          for (int j = 0; j < 4; ++j) { v[j] = xr[64 * j]; s += (v[j][0] * v[j][0] + v[j][1] * v[j][1]) + (v[j][2] * v[j][2] + v[j][3] * v[j][3]); }
          s = wave_sum(s); if (F.lane == 0) r0[row] = rsqrtf(s * (1.0f / DM) + EPS);
          u32x2* o = (u32x2*)(xb + (size_t)row * DM) + F.lane;
#pragma unroll
          for (int j = 0; j < 4; ++j) o[64 * j] = pack4(v[j]);
      } }
}

__device__ __forceinline__ void p2_side(const Args& a, const Frame& F, int first_block) {
    const int nb = F.G - first_block, sb = F.bx - first_block;
    { const SsmLds L = ssm_lds(F);
      for (int it = sb; it < NG * 8; it += nb) { ssm_stage(a, F, L, it >> 3); ssm_build_tb(a, F, L, it >> 3, it & 7); } }
    __syncthreads();
    LAS float* scr = (LAS float*)(F.lds + F.wave * 16384);
    const TrMat m0{a.in[13], DSSM, DSSM, nullptr, nullptr, 0, (bf16_t*)(a.ws + WS_WGLU), 0, (DSSM / 64) * (DSSM / 32)}; const TrMat m1{nullptr, 0, 32, nullptr, nullptr, 0, nullptr, 0, 0};
    tr_run(m0, m1, (nb - 1 - sb) * 8 + F.wave, nb * 8, F.lane, scr);
}
__device__ __forceinline__ void p3_side(const Args& a, const Frame& F, int first_block) {
    const int nb = F.G - first_block, sb = F.bx - first_block;
    LAS float* scr = (LAS float*)(F.lds + F.wave * 16384);
    const TrMat m0{a.in[17], DM, DM, a.in[15], a.in[16], DPOOL, (bf16_t*)(a.ws + WS_WOUT), 0, (DM / 64) * (DM / 32)}; const TrMat m1{nullptr, 0, 32, nullptr, nullptr, 0, nullptr, 0, 0};
    tr_run(m0, m1, sb * 8 + F.wave, nb * 8, F.lane, scr);
}
__device__ __forceinline__ void p4_side(const Args& a, const Frame& F, int first_block) {
    const int nb = F.G - first_block, sb = F.bx - first_block;
    LAS float* scr = (LAS float*)(F.lds + F.wave * 16384);
    const TrMat m0{a.in[19], DM, DFF2, a.in[18], a.in[18], DM, (bf16_t*)(a.ws + WS_WUP), 1, (DM / 64) * (DFF2 / 32)};
    const TrMat m1{a.in[22], DFF, DM, nullptr, nullptr, 0, (bf16_t*)(a.ws + WS_WDOWN), 0, (DFF / 64) * (DM / 32)};
    tr_run(m0, m1, sb * 8 + F.wave, nb * 8, F.lane, scr);
}

__device__ __forceinline__ void p2_pooled(const Args& a, const Frame& F, int first_block) {
    const bf16_t* up = (const bf16_t*)(a.ws + WS_UPOOL); bf16_t* po = (bf16_t*)(a.ws + WS_POOLED);
    const int gw = (F.bx - first_block) * 8 + F.wave, NGW = (F.G - first_block) * 8;
    const int c0 = 8 * F.lane, half = 1 << (F.lane >> 4);
    for (int row = gw; row < MT; row += NGW) {
        const int b = row / SEQ, t = row % SEQ;
        u32x4 w[16];
#pragma unroll
        for (int o = 0; o < 16; ++o) { int q = t + o - 8; q = q < 0 ? 0 : (q >= SEQ ? SEQ - 1 : q); w[o] = *(const u32x4*)(up + (size_t)(b * SEQ + q) * DPOOL + c0); }
        f32x4 s0 = {0.f, 0.f, 0.f, 0.f}, s1 = {0.f, 0.f, 0.f, 0.f}; float cnt = 0.f;
#pragma unroll
        for (int o = 0; o < 16; ++o) { const int d = o - 8, q = t + d; const float m = (d >= -half && d < half && q >= 0 && q < SEQ) ? 1.f : 0.f; f32x4 a0, a1; unpack8(w[o], a0, a1); s0 = s0 + a0 * m; s1 = s1 + a1 * m; cnt += m; }
        f32x4 c0v, c1v; unpack8(w[8], c0v, c1v);
        const float inv = 1.0f / cnt;
        *(u32x4*)(po + (size_t)row * DPOOL + c0) = pack8(s0 * inv - c0v, s1 * inv - c1v);
    }
}

__device__ __forceinline__ void p3_carries(const Args& a, const Frame& F, int g, int pm) {
    LAS float* TOT = (LAS float*)(F.lds);
    const int bs = F.tid >> 8, seg = (F.tid >> 6) & 3, n = F.tid & 63, b = 2 * pm + bs;
    for (int dir = 0; dir < 2; ++dir) {
        const float dt = expf(a.in[7][dir * NG + g]); const float a_re = -expf(a.in[5][(dir * NG + g) * NS + n]), a_im = a.in[6][(dir * NG + g) * NS + n];
        const float mg = expf((float)TCH * (a_re * dt)); float sn, cs; sincosf((float)TCH * (a_im * dt), &sn, &cs); const float lr = mg * cs, li = mg * sn;
        const float* fg = (const float*)(a.ws + WS_FG) + ((size_t)g * NCR + (size_t)b * NCHB) * 256 + dir * 128 + 2 * n;
        bf16_t* us = (bf16_t*)(a.ws + WS_USSM) + ((size_t)g * NCR + (size_t)b * NCHB) * ROWLEN + K1 + dir * 128 + 2 * n;
        f32x2 f[32];
#pragma unroll
        for (int k = 0; k < 32; ++k) { const int i = 32 * seg + k, c = dir == 0 ? i : NCHB - 1 - i; f[k] = *(const f32x2*)(fg + (size_t)c * 256); }
        float sr = 0.f, si = 0.f;
#pragma unroll
        for (int k = 0; k < 32; ++k) { const float nr = lr * sr - li * si + f[k].x, ni = lr * si + li * sr + f[k].y; sr = nr; si = ni; }
        TOT[F.tid * 2] = sr; TOT[F.tid * 2 + 1] = si;
        float pr = lr, pi = li;
#pragma unroll
        for (int q = 0; q < 5; ++q) { const float nr = pr * pr - pi * pi, ni = 2.f * pr * pi; pr = nr; pi = ni; }
        __syncthreads();
        sr = 0.f; si = 0.f;
        for (int s2 = 0; s2 < seg; ++s2) { const int o = (F.tid - 64 * (seg - s2)) * 2; const float tr = TOT[o], ti = TOT[o + 1]; const float nr = pr * sr - pi * si + tr, ni = pr * si + pi * sr + ti; sr = nr; si = ni; }
#pragma unroll
        for (int k = 0; k < 32; ++k) { const int i = 32 * seg + k, c = dir == 0 ? i : NCHB - 1 - i;
            *(unsigned*)(us + (size_t)c * ROWLEN) = pk2(sr, si);
            const float nr = lr * sr - li * si + f[k].x, ni = lr * si + li * sr + f[k].y; sr = nr; si = ni; }
        __syncthreads();
    }
    VM_WAIT(); __syncthreads();
}

__global__ void __launch_bounds__(512, 2) mk_fwd(Args args) {
    extern __shared__ __attribute__((aligned(16))) unsigned char lds_raw[];
    Frame F; F.lds = (LAS unsigned char*)lds_raw; F.tid = threadIdx.x; F.lane = F.tid & 63; F.wave = __builtin_amdgcn_readfirstlane(F.tid >> 6); F.G = gridDim.x; F.bx = blockIdx.x;
    volatile LAS unsigned* MISC = (volatile LAS unsigned*)(F.lds + LDSCTL_OFF);
    for (int u = F.tid; u < (LDS_BYTES - LDSCTL_OFF) / 4; u += 512) ((LAS unsigned*)(F.lds + LDSCTL_OFF))[u] = 0u;
    __syncthreads();
    unsigned char* ws = args.ws;
    XcdBarrier bar = xcd_barrier_post((unsigned*)(ws + WS_CTL), MISC + 8);
    const int lo = args.ph_lo, hi = args.ph_hi;
#define IN(k) (lo <= (k) && (k) < hi)
#define BOTH(k) (IN(k) && IN((k) + 1))
    if (IN(0)) { p0_prologue(args, F); if (BOTH(0)) xcd_barrier(bar); }
    if (IN(1)) {
        GemmDesc g{(const char*)(ws + WS_XB), (const char*)(ws + WS_WIN), 256L * DM * 2, 0, 256L * DM * 2, 0, 128L * DM * 2, 128L * DM * 2, 128, 128, DM / BK};
        unsigned vA[2], vB[2]; voff_std(vA, DM, false); voff_std(vB, DM, true);
        StaticOrder S; S.init(MT / BM, DM / BM, F.G, F.bx);
        EpiU E{(const float*)(ws + WS_R0), (bf16_t*)(ws + WS_UPOOL), (bf16_t*)(ws + WS_USSM)};
        gemm_phase<EpiU, StaticOrder, true>(F.lds, g, vA, vB, S, E);
        if (BOTH(1)) xcd_barrier(bar);
#if defined(MK_EXTRA_BAR)
        for (int rep = 0; rep < MK_EXTRA_BAR; ++rep) xcd_barrier(bar);
#endif
    }
    if (IN(2)) {
        if (F.bx < 64) {
            GemmDesc g{(const char*)(ws + WS_USSM), (const char*)(ws + WS_WAB), 256L * ROWLEN * 2, (long)NCR * ROWLEN * 2, 0, 256L * K1 * 2, 128L * ROWLEN * 2, 128L * K1 * 2, 128, 128, K1 / BK};
            unsigned vA[2], vB[2]; voff_std(vA, ROWLEN, false); voff_std(vB, K1, false);
            OrdSsmA S{F.bx}; EpiFG E{(float*)(ws + WS_FG)};
            gemm_phase<EpiFG, OrdSsmA, true>(F.lds, g, vA, vB, S, E);
        } else { p2_side(args, F, 64); p2_pooled(args, F, 64); }
        if (BOTH(2)) xcd_barrier(bar);
    }
    if (IN(3)) {
        if (F.bx < 128) {
            OrdSsmB S{F.bx}; Unit u0; S.next(0, u0);
            p3_carries(args, F, u0.g, u0.pm);
            GemmDesc g{(const char*)(ws + WS_USSM), (const char*)(ws + WS_TB), 256L * ROWLEN * 2, (long)NCR * ROWLEN * 2, 256L * ROWLEN * 2, (long)K1 * ROWLEN * 2, 128L * ROWLEN * 2, 128L * ROWLEN * 2, 128, 128, ROWLEN / BK};
            unsigned vA[2], vB[2]; voff_std(vA, ROWLEN, false); voff_std(vB, ROWLEN, true);
            EpiZ E{(const bf16_t*)(ws + WS_USSM), args.in[12], (bf16_t*)(ws + WS_ZG)};
            gemm_phase<EpiZ, OrdSsmB, true>(F.lds, g, vA, vB, S, E);
        } else {
            GemmDesc g{(const char*)(ws + WS_POOLED), (const char*)(ws + WS_PW), 256L * DPOOL * 2, 256L * 2, 256L * 256 * 2, 0, 128L * DPOOL * 2, 128L * 256 * 2, 128, 128, 256 / BK};
            unsigned vA[2], vB[2]; voff_std(vA, DPOOL, false); voff_std(vB, 256, true);
            OrdPool S{F.bx}; EpiPool E{args.in[4], (bf16_t*)(ws + WS_YCAT), (float*)(ws + WS_SSPOOL)};
            gemm_phase<EpiPool, OrdPool, true>(F.lds, g, vA, vB, S, E);
            p3_side(args, F, 128);
        }
        if (BOTH(3)) xcd_barrier(bar);
    }
    if (IN(4)) {
        if (F.bx < 128) {
            constexpr long GSTR = (long)MT * 32;
            GemmDesc g{(const char*)(ws + WS_ZG), (const char*)(ws + WS_WGLU), 256L * 32, 0, 256L * DSSM * 2, 0, 128L * 32, 128L * DSSM * 2, 4 * GSTR, 128, DSSM / BK};
            unsigned vA[2], vB[2]; voff_std(vB, DSSM, true);
#pragma unroll
            for (int i = 0; i < 2; ++i) { int R, C; stage_rc(F.tid * 16 + i * 8192, R, C); vA[i] = (unsigned)(R * 32 + (C >> 4) * (int)GSTR + (C & 15) * 2); }
            OrdGlu S{F.bx}; EpiGlu E{args.in[14], (const bf16_t*)(ws + WS_ZG), (bf16_t*)(ws + WS_YCAT), (float*)(ws + WS_SSSSM)};
            gemm_phase<EpiGlu, OrdGlu, true>(F.lds, g, vA, vB, S, E);
        } else p4_side(args, F, 128);
        if (BOTH(4)) xcd_barrier(bar);
    }
    if (IN(5)) {
        StaticOrder S; S.init(MT / BM, DM / BM, F.G, F.bx); Unit u0;
        LAS f32x2* XR = (LAS f32x2*)(F.lds + XTRA_OFF);
        if (S.next(0, u0)) {
            if (F.tid < 256) { const int row = u0.pm * BM + F.tid; const float* sp = (const float*)(ws + WS_SSPOOL); const float* sm = (const float*)(ws + WS_SSSSM); float a0 = 0.f, a1 = 0.f;
#pragma unroll
                for (int s = 0; s < 8; ++s) { a0 += sp[(size_t)s * MT + row]; a1 += sm[(size_t)s * MT + row]; }
                const float rp = rsqrtf(a0 * (1.0f / DPOOL) + EPS), rsm = rsqrtf(a1 * (1.0f / DSSM) + EPS); XR[F.tid] = (f32x2){rp / rsm, rsm}; }
        }
        __syncthreads();
        GemmDesc g{(const char*)(ws + WS_YCAT), (const char*)(ws + WS_WOUT), 256L * DM * 2, 0, 256L * DM * 2, 0, 128L * DM * 2, 128L * DM * 2, 128, 128, DM / BK};
        unsigned vA[2], vB[2]; voff_std(vA, DM, false); voff_std(vB, DM, false);
        EpiOut E{args.in[0], (bf16_t*)(ws + WS_H1B), (float*)(ws + WS_SSH1), XR, {{0.f, 0.f, 0.f, 0.f}, {0.f, 0.f, 0.f, 0.f}}};
        { const int wr_ = F.wave >> 2, fr_ = F.lane & 15;
#pragma unroll
          for (int ai = 0; ai < 2; ++ai)
#pragma unroll
              for (int m = 0; m < 4; ++m) E.ratio[ai][m] = XR[ai * HALF + wr_ * 64 + m * 16 + fr_].x; }
        gemm_phase<EpiOut, StaticOrder, false>(F.lds, g, vA, vB, S, E);
        if (BOTH(5)) xcd_barrier(bar);
    }
    if (IN(6)) {
        GemmDesc g{(const char*)(ws + WS_H1B), (const char*)(ws + WS_WUP), (long)UPROWS * DM * 2, (long)PADROWS * DM * 2, 256L * DM * 2, 0, 64L * DM * 2, 128L * DM * 2, 128, 128, DM / BK};
        unsigned vA[2], vB[2]; voff_std(vB, DM, true);
#pragma unroll
        for (int i = 0; i < 2; ++i) { int R, C; stage_rc(F.tid * 16 + i * 8192, R, C); vA[i] = (unsigned)(((126 * (R >> 6) + (R & 63)) * DM + C) * 2); }
        OrdUp S; S.so.init(BATCH * UPT, DFF2 / BM, F.G, F.bx);
        EpiUp E{(const float*)(ws + WS_SSH1), args.in[20], args.in[21], (bf16_t*)(ws + WS_ACT)};
        gemm_phase<EpiUp, OrdUp, true>(F.lds, g, vA, vB, S, E);
        if (BOTH(6)) xcd_barrier(bar);
    }
    if (IN(7)) {
        GemmDesc g{(const char*)(ws + WS_ACT), (const char*)(ws + WS_WDOWN), 256L * DFF * 2, 0, 256L * DFF * 2, 0, 128L * DFF * 2, 128L * DFF * 2, 128, 128, DFF / BK};
        unsigned vA[2], vB[2]; voff_std(vA, DFF, false); voff_std(vB, DFF, false);
        StaticOrder S; S.init(MT / BM, DM / BM, F.G, F.bx);
        EpiDown E{(const bf16_t*)(ws + WS_H1B), args.out, args.in[23], (float*)(ws + WS_SSH2), &bar};
        gemm_phase<EpiDown, StaticOrder, false>(F.lds, g, vA, vB, S, E);
    }
#undef IN
#undef BOTH
}
}

__global__ void k_cvt_u(const bf16_t* __restrict__ upool, const bf16_t* __restrict__ ussm, float* __restrict__ u) {
    const int idx = blockIdx.x * blockDim.x + threadIdx.x; if (idx >= MT * DM) return;
    const int c = idx % DM, row = idx / DM; unsigned short v;
    if (c < DPOOL) v = upool[(size_t)row * DPOOL + c];
    else { const int cs = c - DPOOL, g = cs >> 4, h = cs & 15, cr = row / mk::TCH, p = row % mk::TCH; v = ussm[((size_t)(g * mk::NCR + cr)) * mk::ROWLEN + 16 * p + h]; }
    u[idx] = __builtin_bit_cast(float, (unsigned)v << 16);
}
__global__ void k_cvt_z(const bf16_t* __restrict__ zg, float* __restrict__ z) {
    const int idx = blockIdx.x * blockDim.x + threadIdx.x; if (idx >= MT * DSSM) return;
    const int c = idx % DSSM, row = idx / DSSM; const unsigned short v = zg[((size_t)(c >> 4) * MT + row) * 16 + (c & 15)];
    z[idx] = __builtin_bit_cast(float, (unsigned)v << 16);
}
__global__ void k_cvt_rows(const bf16_t* __restrict__ src, int lds_, float* __restrict__ dst, int ldd, int cols, int rows) {
    const size_t idx = (size_t)blockIdx.x * blockDim.x + threadIdx.x; if (idx >= (size_t)rows * cols) return;
    const int c = (int)(idx % cols); const size_t row = idx / cols; dst[row * ldd + c] = __builtin_bit_cast(float, (unsigned)src[row * lds_ + c] << 16);
}

#ifndef MK_CUT
#define MK_CUT 8
#endif
static void gemm(hipStream_t s, const float* A, int lda, const float* B, int ldb, float* C, int ldc, const float* R, int ldr, int M, int N, int K) {
    hipLaunchKernelGGL(k_gemm, dim3(N / 128, M / 128), dim3(256), 0, s, A, lda, B, ldb, C, ldc, R, ldr, K);
}

extern "C" void kernel_launch(void* const* d_in, const int* in_sizes, int n_in, void* d_out, int out_size, void* d_ws, size_t ws_size, hipStream_t stream) {
    static int grid = 0;
    if (grid == 0) {
        int dev = 0, cus = 0, per_cu = 0;
        if (n_in != 24 || out_size != MT * DM || ws_size < mk::WS_END) { fprintf(stderr, "kernel_launch: unexpected problem (n_in %d out %d ws %zu)\n", n_in, out_size, ws_size); grid = -1; return; }
        if (hipGetDevice(&dev) != hipSuccess || hipDeviceGetAttribute(&cus, hipDeviceAttributeMultiprocessorCount, dev) != hipSuccess) { grid = -1; return; }
        if (hipFuncSetAttribute((const void*)mk::mk_fwd, hipFuncAttributeMaxDynamicSharedMemorySize, mk::LDS_BYTES) != hipSuccess) { fprintf(stderr, "kernel_launch: hipFuncSetAttribute failed\n"); grid = -1; return; }
        if (hipOccupancyMaxActiveBlocksPerMultiprocessor(&per_cu, (const void*)mk::mk_fwd, 512, mk::LDS_BYTES) != hipSuccess || per_cu < 1) { fprintf(stderr, "kernel_launch: occupancy query says %d blocks/CU\n", per_cu); }
        (void)hipGetLastError();
        grid = cus;
        if (grid != 256) { fprintf(stderr, "kernel_launch: built for a 256-CU device, found %d CUs\n", cus); grid = -1; return; }
    }
    if (grid < 0) return;
    const float* x = (const float*)d_in[0];
    const float* pool_w = (const float*)d_in[3];   const float* pool_scale = (const float*)d_in[4];
    const float* lnar = (const float*)d_in[5];     const float* aim = (const float*)d_in[6];   const float* ldt = (const float*)d_in[7];
    const float* bre = (const float*)d_in[8];      const float* bim = (const float*)d_in[9];
    const float* cre = (const float*)d_in[10];     const float* cim = (const float*)d_in[11];
    const float* ssm_d = (const float*)d_in[12];   const float* glu_w = (const float*)d_in[13]; const float* glu_b = (const float*)d_in[14];
    const float* g_pool = (const float*)d_in[15];  const float* g_ssm = (const float*)d_in[16];
    const float* w_out = (const float*)d_in[17];   const float* g_ffn = (const float*)d_in[18];
    const float* w_up = (const float*)d_in[19];    const float* conv_w = (const float*)d_in[20]; const float* conv_b = (const float*)d_in[21];
    const float* w_down = (const float*)d_in[22];  const float* g_final = (const float*)d_in[23];
    float* out = (float*)d_out; char* ws = (char*)d_ws; const size_t MiB = 1u << 20; const int EB = 256;
    (void)x; (void)pool_w; (void)pool_scale; (void)lnar; (void)aim; (void)ldt; (void)bre; (void)bim; (void)cre; (void)cim; (void)ssm_d; (void)glu_w; (void)glu_b; (void)g_pool; (void)g_ssm; (void)w_out; (void)g_ffn; (void)w_up; (void)conv_w; (void)conv_b; (void)w_down; (void)g_final;

    (void)hipMemsetAsync(ws + mk::WS_CTL, 0, mk::CTL_ZERO_BYTES, stream);
    mk::Args a{};
    for (int i = 0; i < 24; ++i) a.in[i] = (const float*)d_in[i];
    a.out = out; a.ws = (unsigned char*)d_ws; a.ph_lo = 0; a.ph_hi = MK_CUT;
#if defined(MK_PROBE_LO)
    a.ph_lo = 0; a.ph_hi = MK_PROBE_HI; hipLaunchKernelGGL(mk::mk_fwd, dim3(grid), dim3(512), mk::LDS_BYTES, stream, a);
    for (int r = 0; r < MK_PROBE_REP; ++r) { (void)hipMemsetAsync(ws + mk::WS_CTL, 0, mk::CTL_ZERO_BYTES, stream); a.ph_lo = MK_PROBE_LO; a.ph_hi = MK_PROBE_HI; hipLaunchKernelGGL(mk::mk_fwd, dim3(grid), dim3(512), mk::LDS_BYTES, stream, a); }
    (void)hipMemsetAsync(ws + mk::WS_CTL, 0, mk::CTL_ZERO_BYTES, stream);
    a.ph_lo = MK_PROBE_HI; a.ph_hi = 8; hipLaunchKernelGGL(mk::mk_fwd, dim3(grid), dim3(512), mk::LDS_BYTES, stream, a);
#else
    hipLaunchKernelGGL(mk::mk_fwd, dim3(grid), dim3(512), mk::LDS_BYTES, stream, a);
#endif
#if MK_CUT < 8
    float* bufA = (float*)(ws + 0 * MiB); float* bufB = (float*)(ws + 64 * MiB); float* bufC = (float*)(ws + 128 * MiB); float* bufD = (float*)(ws + 192 * MiB);
    float* pooled = bufA; float* ypool = bufA + (size_t)MT * DPOOL; float* z = pooled; float* pre = bufD; float* ycat = bufB;
#if MK_CUT <= 2
    float* u = bufB;
    hipLaunchKernelGGL(k_cvt_u, dim3(MT * DM / EB), dim3(EB), 0, stream, (const bf16_t*)(ws + mk::WS_UPOOL), (const bf16_t*)(ws + mk::WS_USSM), u);
    hipLaunchKernelGGL(k_pool, dim3(MT * DPOOL / EB), dim3(EB), 0, stream, u, pooled);
    for (int gi = 0; gi < 4; ++gi) gemm(stream, pooled + gi * 128, DPOOL, pool_w + (size_t)gi * 128 * 128, 128, ypool + gi * 128, DPOOL, nullptr, 0, MT, 128, 128);
    float* y2 = bufC;
    hipLaunchKernelGGL(k_ssm_scan, dim3(2 * BATCH * NG), dim3(64), 0, stream, u, lnar, aim, ldt, bre, bim, cre, cim, y2);
    hipLaunchKernelGGL(k_ssm_post, dim3(MT * DSSM / EB), dim3(EB), 0, stream, y2, u, ssm_d, z);
    const float* pre_scale = pool_scale;
#elif MK_CUT <= 4
    hipLaunchKernelGGL(k_cvt_z, dim3(MT * DSSM / EB), dim3(EB), 0, stream, (const bf16_t*)(ws + mk::WS_ZG), z);
    hipLaunchKernelGGL(k_cvt_rows, dim3(MT * DPOOL / EB), dim3(EB), 0, stream, (const bf16_t*)(ws + mk::WS_YCAT), DM, ypool, DPOOL, DPOOL, MT);
    const float* pre_scale = nullptr;
#endif
#if MK_CUT <= 4
    gemm(stream, z, DSSM, glu_w, DSSM, pre, DSSM, nullptr, 0, MT, DSSM, DSSM);
    hipLaunchKernelGGL(k_glu, dim3(MT * DSSM / EB), dim3(EB), 0, stream, z, pre, glu_b);
#elif MK_CUT == 5
    hipLaunchKernelGGL(k_cvt_rows, dim3(MT * DPOOL / EB), dim3(EB), 0, stream, (const bf16_t*)(ws + mk::WS_YCAT), DM, ypool, DPOOL, DPOOL, MT);
    hipLaunchKernelGGL(k_cvt_rows, dim3(MT * DSSM / EB), dim3(EB), 0, stream, (const bf16_t*)(ws + mk::WS_YCAT) + DPOOL, DM, pre, DSSM, DSSM, MT);
    const float* pre_scale = nullptr;
#endif
#if MK_CUT <= 5
    hipLaunchKernelGGL(k_rmsnorm, dim3(MT / 4), dim3(256), 0, stream, ypool, DPOOL, pre_scale, g_pool, ycat, DM, DPOOL, MT);
    hipLaunchKernelGGL(k_rmsnorm, dim3(MT / 4), dim3(256), 0, stream, pre, DSSM, (const float*)nullptr, g_ssm, ycat + DPOOL, DM, DSSM, MT);
    gemm(stream, ycat, DM, w_out, DM, out, DM, x, DM, MT, DM, DM);
#endif
#if MK_CUT <= 6
    float* xn2 = bufA;
    hipLaunchKernelGGL(k_rmsnorm, dim3(MT / 4), dim3(256), 0, stream, out, DM, (const float*)nullptr, g_ffn, xn2, DM, DM, MT);
    float* up = (float*)(ws + 64 * MiB); float* act = (float*)(ws + 152 * MiB);
    for (int b = 0; b < BATCH; ++b) {
        gemm(stream, xn2 + (size_t)b * SEQ * DM, DM, w_up, DFF2, up, DFF2, nullptr, 0, SEQ, DFF2, DM);
        hipLaunchKernelGGL(k_convact, dim3(SEQ * DFF / EB), dim3(EB), 0, stream, up, conv_w, conv_b, act);
        gemm(stream, act, DFF, w_down, DM, out + (size_t)b * SEQ * DM, DM, out + (size_t)b * SEQ * DM, DM, SEQ, DM, DFF);
    }
#else
    float* actf = (float*)(ws + 0 * MiB);
    for (int b = 0; b < BATCH; ++b) {
        hipLaunchKernelGGL(k_cvt_rows, dim3(SEQ * DFF / EB), dim3(EB), 0, stream, (const bf16_t*)(ws + mk::WS_ACT) + (size_t)b * SEQ * DFF, DFF, actf, DFF, DFF, SEQ);
        gemm(stream, actf, DFF, w_down, DM, out + (size_t)b * SEQ * DM, DM, out + (size_t)b * SEQ * DM, DM, SEQ, DM, DFF);
    }
#endif
    hipLaunchKernelGGL(k_rmsnorm, dim3(MT / 4), dim3(256), 0, stream, out, DM, (const float*)nullptr, g_final, out, DM, DM, MT);
    (void)bufC;
#endif
}
```

```cpp
#define MK_CUT 8
#include <hip/hip_runtime.h>
#include <math.h>

constexpr int BATCH = 4, SEQ = 4096, DM = 1024, MT = BATCH * SEQ;
constexpr int DPOOL = 512, DSSM = 512, NG = 32, NH = 16, NS = 64;
constexpr int DFF = 2816, DFF2 = 5632;
constexpr float EPS = 1e-6f;

__global__ void k_rmsnorm(const float* x, int ldx, const float* __restrict__ pre,
                          const float* __restrict__ g, float* out, int ldo, int D, int rows) {
    const int wave = (blockIdx.x * blockDim.x + threadIdx.x) >> 6, lane = threadIdx.x & 63;
    if (wave >= rows) return;
    const float* xr = x + (size_t)wave * ldx;
    float ss = 0.f;
    for (int c = lane; c < D; c += 64) { float v = xr[c]; if (pre) v *= pre[c]; ss += v * v; }
    for (int o = 32; o; o >>= 1) ss += __shfl_xor(ss, o);
    const float inv = rsqrtf(ss / (float)D + EPS);
    float* orow = out + (size_t)wave * ldo;
    for (int c = lane; c < D; c += 64) { float v = xr[c]; if (pre) v *= pre[c]; orow[c] = v * inv * g[c]; }
}

__global__ void __launch_bounds__(256) k_gemm(const float* __restrict__ A, int lda, const float* __restrict__ B, int ldb,
                                               float* C, int ldc, const float* R, int ldr, int K) {
    __shared__ float As[16][132];
    __shared__ float Bs[16][132];
    const int tid = threadIdx.x, tx = tid & 15, ty = tid >> 4;
    const int row0 = blockIdx.y * 128, col0 = blockIdx.x * 128;
    float acc[8][8];
#pragma unroll
    for (int i = 0; i < 8; ++i)
#pragma unroll
        for (int j = 0; j < 8; ++j) acc[i][j] = 0.f;
    for (int k0 = 0; k0 < K; k0 += 16) {
#pragma unroll
        for (int p = 0; p < 2; ++p) {
            const int i = tid + p * 256, r = i >> 2, kk = (i & 3) * 4;
            const float4 v = *(const float4*)(A + (size_t)(row0 + r) * lda + k0 + kk);
            As[kk + 0][r] = v.x; As[kk + 1][r] = v.y; As[kk + 2][r] = v.z; As[kk + 3][r] = v.w;
        }
#pragma unroll
        for (int p = 0; p < 2; ++p) {
            const int i = tid + p * 256, kk = i >> 5, c = (i & 31) * 4;
            const float4 v = *(const float4*)(B + (size_t)(k0 + kk) * ldb + col0 + c);
            *(float4*)&Bs[kk][c] = v;
        }
        __syncthreads();
#pragma unroll
        for (int kk = 0; kk < 16; ++kk) {
            float a[8], b[8];
            const float4 a0 = *(const float4*)&As[kk][ty * 4], a1 = *(const float4*)&As[kk][64 + ty * 4];
            const float4 b0 = *(const float4*)&Bs[kk][tx * 4], b1 = *(const float4*)&Bs[kk][64 + tx * 4];
            a[0] = a0.x; a[1] = a0.y; a[2] = a0.z; a[3] = a0.w; a[4] = a1.x; a[5] = a1.y; a[6] = a1.z; a[7] = a1.w;
            b[0] = b0.x; b[1] = b0.y; b[2] = b0.z; b[3] = b0.w; b[4] = b1.x; b[5] = b1.y; b[6] = b1.z; b[7] = b1.w;
#pragma unroll
            for (int i = 0; i < 8; ++i)
#pragma unroll
                for (int j = 0; j < 8; ++j) acc[i][j] = fmaf(a[i], b[j], acc[i][j]);
        }
        __syncthreads();
    }
#pragma unroll
    for (int i = 0; i < 8; ++i) {
        const int r = row0 + (i < 4 ? ty * 4 + i : 64 + ty * 4 + (i - 4));
#pragma unroll
        for (int jh = 0; jh < 2; ++jh) {
            const int c = col0 + jh * 64 + tx * 4;
            float4 v = make_float4(acc[i][jh * 4 + 0], acc[i][jh * 4 + 1], acc[i][jh * 4 + 2], acc[i][jh * 4 + 3]);
            if (R) { const float4 rr = *(const float4*)(R + (size_t)r * ldr + c); v.x += rr.x; v.y += rr.y; v.z += rr.z; v.w += rr.w; }
            *(float4*)(C + (size_t)r * ldc + c) = v;
        }
    }
}

__global__ void k_pool(const float* __restrict__ u  , float* __restrict__ pooled  ) {
    const int idx = blockIdx.x * blockDim.x + threadIdx.x;
    if (idx >= MT * DPOOL) return;
    const int c = idx % DPOOL, row = idx / DPOOL, b = row / SEQ, t = row % SEQ;
    const int gi = c / 128, w = 2 << gi, half = w / 2;
    int lo = t - half, hi = t + half; if (lo < 0) lo = 0; if (hi > SEQ) hi = SEQ;
    float s = 0.f;
    for (int q = lo; q < hi; ++q) s += u[(size_t)(b * SEQ + q) * DM + c];
    pooled[idx] = s / (float)(hi - lo) - u[(size_t)row * DM + c];
}

__global__ void __launch_bounds__(64) k_ssm_scan(const float* __restrict__ u  ,
        const float* __restrict__ lnar, const float* __restrict__ aim, const float* __restrict__ ldt,
        const float* __restrict__ bre, const float* __restrict__ bim, const float* __restrict__ cre, const float* __restrict__ cim,
        float* __restrict__ y  ) {
    const int n = threadIdx.x;
    const int g = blockIdx.x % NG, b = (blockIdx.x / NG) % BATCH, dir = blockIdx.x / (NG * BATCH);
    const float dt = expf(ldt[dir * NG + g]);
    const float a_re = -expf(lnar[(dir * NG + g) * NS + n]), a_im = aim[(dir * NG + g) * NS + n];
    const float mag = expf(a_re * dt), ang = a_im * dt;
    const float lam_re = mag * cosf(ang), lam_im = mag * sinf(ang);
    const float den = a_re * a_re + a_im * a_im;
    const float f_re = ((lam_re - 1.0f) * a_re + lam_im * a_im) / den;
    const float f_im = (lam_im * a_re - (lam_re - 1.0f) * a_im) / den;
    float Br[NH], Bi[NH], Cr[NH], Ci[NH];
#pragma unroll
    for (int h = 0; h < NH; ++h) {
        Br[h] = bre[((size_t)(dir * NG + g) * NS + n) * NH + h];
        Bi[h] = bim[((size_t)(dir * NG + g) * NS + n) * NH + h];
        Cr[h] = cre[((size_t)(dir * NG + g) * NH + h) * NS + n];
        Ci[h] = cim[((size_t)(dir * NG + g) * NH + h) * NS + n];
    }
    float s_re = 0.f, s_im = 0.f;
    float* yd = y + (size_t)dir * MT * DSSM;
    for (int i = 0; i < SEQ; ++i) {
        const int t = dir ? (SEQ - 1 - i) : i;
        const float* ur = u + (size_t)(b * SEQ + t) * DM + DPOOL + g * NH;
        float bu_re = 0.f, bu_im = 0.f;
#pragma unroll
        for (int h = 0; h < NH; ++h) { const float uv = ur[h]; bu_re = fmaf(Br[h], uv, bu_re); bu_im = fmaf(Bi[h], uv, bu_im); }
        const float in_re = f_re * bu_re - f_im * bu_im, in_im = f_re * bu_im + f_im * bu_re;
        const float nr = lam_re * s_re - lam_im * s_im + in_re;
        const float ni = lam_re * s_im + lam_im * s_re + in_im;
        s_re = nr; s_im = ni;
        float mine = 0.f;
#pragma unroll
        for (int h = 0; h < NH; ++h) {
            float p = Cr[h] * s_re - Ci[h] * s_im;
#pragma unroll
            for (int o = 32; o; o >>= 1) p += __shfl_xor(p, o);
            if (n == h) mine = p;
        }
        if (n < NH) yd[(size_t)(b * SEQ + t) * DSSM + g * NH + n] = mine;
    }
}

__device__ __forceinline__ float gelu_tanh(float x) {
    const float k = 0.7978845608028654f;
    return 0.5f * x * (1.0f + tanhf(k * (x + 0.044715f * x * x * x)));
}
__device__ __forceinline__ float sigmoidf_(float x) { return 1.0f / (1.0f + expf(-x)); }

__global__ void k_ssm_post(const float* __restrict__ y2, const float* __restrict__ u, const float* __restrict__ d, float* __restrict__ z) {
    const int idx = blockIdx.x * blockDim.x + threadIdx.x;
    if (idx >= MT * DSSM) return;
    const int c = idx % DSSM, row = idx / DSSM;
    const float yv = y2[idx] + y2[(size_t)MT * DSSM + idx] + d[c] * u[(size_t)row * DM + DPOOL + c];
    z[idx] = gelu_tanh(yv);
}
__global__ void k_glu(const float* __restrict__ z, float* __restrict__ pre, const float* __restrict__ gb) {
    const int idx = blockIdx.x * blockDim.x + threadIdx.x;
    if (idx >= MT * DSSM) return;
    const int c = idx % DSSM;
    pre[idx] = z[idx] * sigmoidf_(pre[idx] + gb[c]);
}
__global__ void k_convact(const float* __restrict__ up  , const float* __restrict__ cw, const float* __restrict__ cb, float* __restrict__ act  ) {
    const int idx = blockIdx.x * blockDim.x + threadIdx.x;
    if (idx >= SEQ * DFF) return;
    const int f = idx % DFF, t = idx / DFF;
    float v = cb[f], gt = cb[DFF + f];
#pragma unroll
    for (int k = 0; k < 3; ++k) {
        const int q = t + k - 1;
        if (q >= 0 && q < SEQ) {
            v = fmaf(up[(size_t)q * DFF2 + f], cw[k * DFF2 + f], v);
            gt = fmaf(up[(size_t)q * DFF2 + DFF + f], cw[k * DFF2 + DFF + f], gt);
        }
    }
    act[idx] = v * (gt * sigmoidf_(gt));
}


#include <cstdio>
#include <cstdint>
#define LAS __attribute__((address_space(3)))
#define GAS __attribute__((address_space(1)))
typedef unsigned short bf16_t;
typedef short bf16x8 __attribute__((ext_vector_type(8)));
typedef float f32x4 __attribute__((ext_vector_type(4)));
typedef float f32x2 __attribute__((ext_vector_type(2)));
typedef unsigned u32x4 __attribute__((ext_vector_type(4)));
typedef unsigned u32x2 __attribute__((ext_vector_type(2)));

namespace mk {
constexpr int TCH = 32;
constexpr int K1 = 16 * TCH;
constexpr int ROWLEN = K1 + 256;
constexpr int NCR = MT / TCH;
constexpr int NCHB = SEQ / TCH;
constexpr int PADROWS = 4352;
constexpr int UPT = 17;
constexpr int UPROWS = 252;

constexpr size_t MiB = 1u << 20;
constexpr size_t WS_CTL = 0, CTL_ZERO_BYTES = 64 * 1024;
constexpr int CW_TBCNT = 4096;
constexpr size_t WS_R0 = 1 * MiB;
constexpr size_t WS_SSPOOL = 2 * MiB;
constexpr size_t WS_SSSSM = WS_SSPOOL + 8 * MT * 4;
constexpr size_t WS_SSH1 = WS_SSSSM + 8 * MT * 4;
constexpr size_t WS_SSH2 = WS_SSH1 + 4 * MT * 4;
constexpr size_t WS_WIN = 8 * MiB, WS_WOUT = 10 * MiB, WS_WGLU = 12 * MiB, WS_PW = 12 * MiB + 512 * 1024;
constexpr size_t WS_WUP = 13 * MiB, WS_WDOWN = 24 * MiB;
constexpr size_t WS_WAB = 30 * MiB;
constexpr size_t WS_TB = 38 * MiB;
constexpr size_t WS_TBC = 40 * MiB;
constexpr size_t WS_H1B = 62 * MiB;
constexpr size_t WS_XB = 96 * MiB;
constexpr size_t WS_YCAT = 96 * MiB;
constexpr size_t WS_UPOOL = 128 * MiB;
constexpr size_t WS_USSM = 144 * MiB;
constexpr size_t WS_FG = 168 * MiB;
constexpr size_t WS_POOLED = 184 * MiB;
constexpr size_t WS_ZG = 200 * MiB;
constexpr size_t WS_ACT = 96 * MiB;
constexpr size_t WS_END = 216 * MiB;

constexpr int RING_BYTES = 131072, XTRA_OFF = RING_BYTES, XTRA_BYTES = 12288, LDSCTL_OFF = XTRA_OFF + XTRA_BYTES, LDS_BYTES = 147456;

__device__ __forceinline__ unsigned f2bf(float f) { unsigned u = __builtin_bit_cast(unsigned, f); return (u + 0x7fffu + ((u >> 16) & 1u)) >> 16; }
__device__ __forceinline__ unsigned pk2(float lo, float hi) { return f2bf(lo) | (f2bf(hi) << 16); }
__device__ __forceinline__ unsigned cvt_pk_bf16(float lo, float hi) { unsigned r; asm volatile("v_cvt_pk_bf16_f32 %0, %1, %2" : "=v"(r) : "v"(lo), "v"(hi)); return r; }
__device__ __forceinline__ u32x4 pack8(f32x4 a, f32x4 b) { u32x4 w; w.x = cvt_pk_bf16(a[0], a[1]); w.y = cvt_pk_bf16(a[2], a[3]); w.z = cvt_pk_bf16(b[0], b[1]); w.w = cvt_pk_bf16(b[2], b[3]); return w; }
__device__ __forceinline__ u32x2 pack4(f32x4 a) { u32x2 w; w.x = cvt_pk_bf16(a[0], a[1]); w.y = cvt_pk_bf16(a[2], a[3]); return w; }
__device__ __forceinline__ float bflo(unsigned w) { return __builtin_bit_cast(float, w << 16); }
__device__ __forceinline__ float bfhi(unsigned w) { return __builtin_bit_cast(float, w & 0xffff0000u); }
__device__ __forceinline__ void unpack8(u32x4 w, f32x4& a, f32x4& b) { a[0] = bflo(w.x); a[1] = bfhi(w.x); a[2] = bflo(w.y); a[3] = bfhi(w.y); b[0] = bflo(w.z); b[1] = bfhi(w.z); b[2] = bflo(w.w); b[3] = bfhi(w.w); }
__device__ __forceinline__ float fast_sigmoid(float x) { return __builtin_amdgcn_rcpf(1.0f + __builtin_amdgcn_exp2f(-1.4426950408889634f * x)); }
__device__ __forceinline__ float fast_gelu_tanh(float x) {
    const float t = x * (1.0f + 0.044715f * x * x);
    return x * __builtin_amdgcn_rcpf(1.0f + __builtin_amdgcn_exp2f(-2.0f * 0.7978845608028654f * 1.4426950408889634f * t));
}
__device__ __forceinline__ float wave_sum(float v) {
#pragma unroll
    for (int o = 1; o < 64; o <<= 1) v += __shfl_xor(v, o);
    return v;
}
__device__ __forceinline__ float dpp_ror1(float v)  { return __builtin_bit_cast(float, __builtin_amdgcn_update_dpp(0, __builtin_bit_cast(int, v), 0x121, 0xf, 0xf, false)); }
__device__ __forceinline__ float dpp_ror15(float v) { return __builtin_bit_cast(float, __builtin_amdgcn_update_dpp(0, __builtin_bit_cast(int, v), 0x12F, 0xf, 0xf, false)); }
#define LDS_WAIT() asm volatile("s_waitcnt lgkmcnt(0)" ::: "memory")
#define VM_WAIT() asm volatile("s_waitcnt vmcnt(0)" ::: "memory")

#define XB_TMO      128
#define XB_XCNT(j)  (256  + 64 * (j))
#define XB_XSUB(j)  (1280 + 64 * (j))
#define XB_XGEN(j)  (2304 + 64 * (j))
#define XB_TOP      3328
#define XB_TOPGEN   3392
#define XCD_BAR_WORDS 3456
#define XB_SPIN_CAP (1u << 18)
__device__ __forceinline__ unsigned xb_ld(unsigned* p)              { return __hip_atomic_load(p, __ATOMIC_RELAXED, __HIP_MEMORY_SCOPE_AGENT); }
__device__ __forceinline__ unsigned xb_add(unsigned* p, unsigned v) { return __hip_atomic_fetch_add(p, v, __ATOMIC_RELAXED, __HIP_MEMORY_SCOPE_AGENT); }
__device__ __forceinline__ unsigned xb_xcc_id() { return (unsigned)__builtin_amdgcn_s_getreg((3 << 11) | 20) & 0xFu; }
#define XB_SPIN(cond, bar) do { unsigned _sp = 0; while (cond) { __builtin_amdgcn_s_sleep(1); \
    if ((++_sp & 255u) == 0u) { if (xb_ld(&(bar)[XB_TMO])) break; if (_sp > XB_SPIN_CAP) { atomicAdd(&(bar)[XB_TMO], 1u); break; } } } } while (0)
struct XcdBarrier { unsigned* bar; unsigned x; volatile LAS unsigned* st; };
__device__ __forceinline__ XcdBarrier xcd_barrier_post(unsigned* bar, volatile LAS unsigned* st) {
    XcdBarrier b; b.bar = bar; b.x = xb_xcc_id(); b.st = st;
    if (threadIdx.x == 0) (void)xb_add(&bar[XB_XCNT(b.x)], 1u);
    return b;
}
__device__ __forceinline__ void xcd_barrier_complete(unsigned* bar, unsigned x, unsigned& nloc, unsigned& nx) {
    const unsigned G = gridDim.x * gridDim.y * gridDim.z;
    unsigned sum, cnt, mine, sp = 0u;
    for (;;) {
        sum = 0u; cnt = 0u; mine = 0u;
#pragma unroll
        for (unsigned j = 0; j < 16; ++j) { const unsigned c = xb_ld(&bar[XB_XCNT(j)]); sum += c; cnt += (c > 0u) ? 1u : 0u; mine = (j == x) ? c : mine; }
        if (sum == G) break;
        __builtin_amdgcn_s_sleep(1);
        if ((++sp & 255u) == 0u) { if (xb_ld(&bar[XB_TMO])) break; if (sp > XB_SPIN_CAP) { atomicAdd(&bar[XB_TMO], 1u); break; } }
    }
    nloc = mine > 0u ? mine : 1u; nx = cnt > 0u ? cnt : 1u;
}
__device__ __forceinline__ void xcd_barrier(const XcdBarrier& b) {
    asm volatile("s_waitcnt vmcnt(0)" ::: "memory");
    __syncthreads();
    if (threadIdx.x == 0) {
        unsigned* bar = b.bar;
        __builtin_amdgcn_s_waitcnt(0);
        unsigned nloc = b.st[0], nx = b.st[1];
        if (nloc == 0u) { xcd_barrier_complete(bar, b.x, nloc, nx); b.st[0] = nloc; b.st[1] = nx; }
        const unsigned old = xb_add(&bar[XB_XSUB(b.x)], 1u);
        const unsigned gen = old / nloc;
        if (old + 1u == (gen + 1u) * nloc) {
            __builtin_amdgcn_fence(__ATOMIC_RELEASE, "agent");
            asm volatile("s_waitcnt vmcnt(0)" ::: "memory");
            const unsigned og = xb_add(&bar[XB_TOP], 1u);
            const unsigned tg = og / nx;
            if (og + 1u == (tg + 1u) * nx) xb_add(&bar[XB_TOPGEN], 1u);
            else XB_SPIN(xb_ld(&bar[XB_TOPGEN]) == tg, bar);
            __builtin_amdgcn_fence(__ATOMIC_ACQUIRE, "agent");
            xb_add(&bar[XB_XGEN(b.x)], 1u);
            asm volatile("s_waitcnt vmcnt(0)" ::: "memory");
        } else {
            XB_SPIN(xb_ld(&bar[XB_XGEN(b.x)]) == gen, bar);
            __builtin_amdgcn_fence(__ATOMIC_ACQUIRE, "agent");
            asm volatile("s_waitcnt vmcnt(0)" ::: "memory");
        }
    }
    __syncthreads();
}

constexpr int BM = 256, BK = 64, HALF = 128, HTB = HALF * BK * 2, STAGE_BYTES = 8 * HTB, NXCD = 8, WGM = 8;
__host__ __device__ __forceinline__ int lds_byte(int r, int c) { const int st = (r >> 4) * 2 + (c >> 5), rr = r & 15, cc = c & 31, ob = rr * 64 + cc * 2; return st * 1024 + (ob ^ (((ob >> 9) & 1) << 5)); }
__host__ __device__ __forceinline__ void stage_rc(int b, int& R, int& C) { const int st = b / 1024, sb = b % 1024, swz = sb ^ (((sb >> 9) & 1) << 5); R = (st >> 1) * 16 + swz / 64; C = (st & 1) * 32 + (swz % 64) / 2; }
__host__ __device__ __forceinline__ int perm32(int rho) { const int n = rho >> 4, i = rho & 15; return 8 * (i >> 2) + 4 * n + (i & 3); }

struct Unit { int pm, pn, g; };
struct GemmDesc { const char* A; const char* B; long a_pm, a_g, b_pn, b_g, a_h, b_h, a_k, b_k; int nt;
                  const char* B2; long b2_pn, b2_g, b2_h, b2_k; int tsw; };

struct StaticOrder {
    int nM, nN, nwg, G, c;
    __device__ void init(int nM_, int nN_, int G_, int c_) { nM = nM_; nN = nN_; nwg = nM * nN; G = G_; c = c_; }
    __device__ bool next(int i, Unit& u) const {
        const long L = (long)i * G + c; if (L >= nwg) return false;
        int wgid = (int)L; { const int q = nwg / NXCD, r = nwg % NXCD, xcd = wgid % NXCD, off = wgid / NXCD; wgid = (xcd < r ? xcd * (q + 1) : r * (q + 1) + (xcd - r) * q) + off; }
        const int nig = WGM * nN, gid = wgid / nig, fm = gid * WGM, gsz = (nM - fm) < WGM ? (nM - fm) : WGM;
        u.pm = fm + ((wgid % nig) % gsz); u.pn = (wgid % nig) / gsz; u.g = 0; return true;
    }
};

template <class Epi, class Sched, bool ALIGN_EPI, bool SEG2 = false>
__device__ __forceinline__ void gemm_phase(LAS unsigned char* lds, const GemmDesc g, const unsigned (&voffA)[2], const unsigned (&voffB)[2], const Sched& S, Epi& E, unsigned long long* stp = nullptr, const unsigned* voffB2 = nullptr) {
    const int tid = threadIdx.x, wid = __builtin_amdgcn_readfirstlane(tid >> 6), lane = tid & 63, wr = wid >> 2, wc = wid & 3, fr = lane & 15, fq = lane >> 4;
    const int nt = g.nt;
    const long kstepA = g.a_k, kstepB = g.b_k, hstepA = g.a_h, hstepB = g.b_h;
    const unsigned ldsw = (unsigned)wid * 1024u;
    const int aoff = lds_byte(wr * 64 + fr, fq * 8), boff = lds_byte(wc * 32 + fr, fq * 8);
#define PG8_SA(b, h) (((b) * 2 + (h)) * HTB)
#define PG8_SB(b, h) ((4 + (b) * 2 + (h)) * HTB)
#define PG8_STAGE(bufoff, gbase, voff) do { _Pragma("unroll") for (int _i = 0; _i < 2; ++_i) \
        __builtin_amdgcn_global_load_lds((const unsigned*)((const char*)(gbase) + (voff)[_i]), (LAS unsigned*)(lds + (bufoff) + ldsw + _i * 8192), 16, 0, 0); } while (0)
#define PG8_LDA(dst, b, h) do { _Pragma("unroll") for (int m = 0; m < 4; ++m) _Pragma("unroll") for (int k = 0; k < 2; ++k) dst[m][k] = *(const LAS bf16x8*)(lds + PG8_SA(b, h) + aoff + m * 2048 + k * 1024); } while (0)
#define PG8_LDB(dst, b, h) do { _Pragma("unroll") for (int n = 0; n < 2; ++n) _Pragma("unroll") for (int k = 0; k < 2; ++k) dst[n][k] = *(const LAS bf16x8*)(lds + PG8_SB(b, h) + boff + n * 2048 + k * 1024); } while (0)
#define PG8_MMA(ai, bj, At, Bt) do { __builtin_amdgcn_s_setprio(1); _Pragma("unroll") for (int m = 0; m < 4; ++m) _Pragma("unroll") for (int n = 0; n < 2; ++n) _Pragma("unroll") for (int k = 0; k < 2; ++k) \
        acc[ai][bj][m][n] = __builtin_amdgcn_mfma_f32_16x16x32_bf16(Bt[n][k], At[m][k], acc[ai][bj][m][n], 0, 0, 0); __builtin_amdgcn_s_setprio(0); } while (0)
#define PG8_WAIT_V(n) asm volatile("s_waitcnt vmcnt(" #n ")" ::: "memory")
#define PG8_WAIT_L(n) asm volatile("s_waitcnt lgkmcnt(" #n ")" ::: "memory")
#define PG8_BAR __builtin_amdgcn_s_barrier()
#define PG8_SCHED __builtin_amdgcn_sched_barrier(0)
    Unit cur, nxt; int ui = 0;
    if (!S.next(0, cur)) return;
    f32x4 acc[2][2][4][2];
#pragma unroll
    for (int a = 0; a < 2; ++a)
#pragma unroll
        for (int b = 0; b < 2; ++b)
#pragma unroll
            for (int m = 0; m < 4; ++m)
#pragma unroll
                for (int n = 0; n < 2; ++n) acc[a][b][m][n] = (f32x4){0.f, 0.f, 0.f, 0.f};
    bf16x8 At[4][2], B0[2][2], B1[2][2];
    const char* cA = g.A + (long)cur.pm * g.a_pm + (long)cur.g * g.a_g; const char* cB = g.B + (long)cur.pn * g.b_pn + (long)cur.g * g.b_g;
    const char* cB2 = SEG2 ? g.B2 + (long)cur.pn * g.b2_pn + (long)cur.g * g.b2_g : nullptr;
    PG8_STAGE(PG8_SB(0, 0), cB, voffB); PG8_STAGE(PG8_SB(0, 1), cB + hstepB, voffB); PG8_STAGE(PG8_SA(0, 0), cA, voffA); PG8_STAGE(PG8_SA(0, 1), cA + hstepA, voffA);
    if (wr == 1) PG8_BAR;
    PG8_WAIT_V(2); PG8_BAR;
    PG8_STAGE(PG8_SB(1, 0), cB + kstepB, voffB); PG8_STAGE(PG8_SA(1, 0), cA + kstepA, voffA); PG8_STAGE(PG8_SB(1, 1), cB + hstepB + kstepB, voffB);
    PG8_WAIT_V(6); PG8_BAR;
    unsigned long long st_t0 = stp ? __builtin_amdgcn_s_memrealtime() : 0ull, st_loop = 0ull, st_epi = 0ull;
    for (;;) {
        const bool has_next = S.next(ui + 1, nxt);
        const char* nA = has_next ? g.A + (long)nxt.pm * g.a_pm + (long)nxt.g * g.a_g : cA; const char* nB = has_next ? g.B + (long)nxt.pn * g.b_pn + (long)nxt.g * g.b_g : cB;
        for (int t = 0; t < nt; t += 2) {
            const bool last = (t == nt - 2);
            const char* a1 = cA + (long)(t + 1) * kstepA;
            const bool sg = SEG2 && !last && (t + 2 >= g.tsw);
            const char* a2 = last ? nA : cA + (long)(t + 2) * kstepA; const char* b2 = last ? nB : (sg ? cB2 + (long)(t + 2 - g.tsw) * g.b2_k : cB + (long)(t + 2) * kstepB);
            const char* a3 = a2 + kstepA; const char* b3 = b2 + (sg ? g.b2_k : kstepB);
            const long hB = sg ? g.b2_h : hstepB;
            unsigned vbs[2]; vbs[0] = sg ? voffB2[0] : voffB[0]; vbs[1] = sg ? voffB2[1] : voffB[1];
            PG8_LDB(B0, 0, 0); PG8_LDB(B1, 0, 1); PG8_SCHED; PG8_LDA(At, 0, 0); PG8_STAGE(PG8_SA(1, 1), a1 + hstepA, voffA);
            PG8_WAIT_V(8); PG8_WAIT_L(0); PG8_BAR; PG8_MMA(0, 0, At, B0); PG8_MMA(0, 1, At, B1); PG8_BAR; PG8_SCHED;
            PG8_LDA(At, 0, 1); PG8_STAGE(PG8_SB(0, 0), b2, vbs); PG8_STAGE(PG8_SB(0, 1), b2 + hB, vbs); PG8_STAGE(PG8_SA(0, 0), a2, voffA);
            PG8_WAIT_V(8); PG8_WAIT_L(0); PG8_BAR; PG8_MMA(1, 0, At, B0); PG8_MMA(1, 1, At, B1); PG8_BAR; PG8_SCHED;
            PG8_LDB(B0, 1, 0); PG8_LDB(B1, 1, 1); PG8_SCHED; PG8_LDA(At, 1, 0); PG8_STAGE(PG8_SA(0, 1), a2 + hstepA, voffA);
            PG8_WAIT_V(8); PG8_WAIT_L(0); PG8_BAR; PG8_MMA(0, 0, At, B0); PG8_MMA(0, 1, At, B1); PG8_BAR; PG8_SCHED;
            PG8_LDA(At, 1, 1); PG8_STAGE(PG8_SB(1, 0), b3, vbs); PG8_STAGE(PG8_SB(1, 1), b3 + hB, vbs); PG8_STAGE(PG8_SA(1, 0), a3, voffA);
            PG8_WAIT_V(8); PG8_WAIT_L(0); PG8_BAR; PG8_MMA(1, 0, At, B0); PG8_MMA(1, 1, At, B1); PG8_BAR; PG8_SCHED;
            if constexpr (Epi::HAS_MID) { if (t + 2 == Epi::MID_T) E.mid(acc, wr, fr); }
        }
        if (stp) { const unsigned long long t1 = __builtin_amdgcn_s_memrealtime(); st_loop += t1 - st_t0; st_t0 = t1; }
        if constexpr (ALIGN_EPI) { if (wr == 0) PG8_BAR; }
        if constexpr (!Epi::AFTER_DRAIN) { E(acc, cur, wr, wc, fr, fq); }
        if (stp) { const unsigned long long t1 = __builtin_amdgcn_s_memrealtime(); st_epi += t1 - st_t0; st_t0 = t1; }
        if (!has_next) break;
#pragma unroll
        for (int a = 0; a < 2; ++a)
#pragma unroll
            for (int b = 0; b < 2; ++b)
#pragma unroll
                for (int m = 0; m < 4; ++m)
#pragma unroll
                    for (int n = 0; n < 2; ++n) acc[a][b][m][n] = (f32x4){0.f, 0.f, 0.f, 0.f};
        cur = nxt; cA = nA; cB = nB; ++ui; if constexpr (SEG2) cB2 = g.B2 + (long)cur.pn * g.b2_pn + (long)cur.g * g.b2_g;
        if constexpr (ALIGN_EPI) { if (wr == 1) PG8_BAR; }
    }
    PG8_WAIT_V(0);
    if constexpr (!ALIGN_EPI) { if (wr == 0) PG8_BAR; }
    PG8_BAR;
    if (stp) { const unsigned long long t1 = __builtin_amdgcn_s_memrealtime(); st_loop += t1 - st_t0; st_t0 = t1; }
    if constexpr (Epi::AFTER_DRAIN) { E.fused(acc, cur, wr, wc, fr, fq, lds, wid, lane); }
    if (stp) { const unsigned long long t1 = __builtin_amdgcn_s_memrealtime(); st_epi += t1 - st_t0; if (threadIdx.x == 0) { stp[0] = st_loop; stp[1] = st_epi; } }
#undef PG8_SA
#undef PG8_SB
#undef PG8_STAGE
#undef PG8_LDA
#undef PG8_LDB
#undef PG8_MMA
#undef PG8_WAIT_V
#undef PG8_WAIT_L
#undef PG8_BAR
#undef PG8_SCHED
}

__device__ __forceinline__ void voff_std(unsigned (&v)[2], int ld, bool perm) {
#pragma unroll
    for (int i = 0; i < 2; ++i) { int R, C; stage_rc((int)threadIdx.x * 16 + i * 8192, R, C); const int Rb = perm ? ((R & ~31) + perm32(R & 31)) : R; v[i] = (unsigned)(Rb * ld + C) * 2u; }
}

typedef f32x4 Acc[2][2][4][2];

struct EpiU {
    static constexpr bool PERM = true, AFTER_DRAIN = false, HAS_MID = false; static constexpr int MID_T = 0;
    const float* r0; bf16_t* upool; bf16_t* ussm;
    __device__ __forceinline__ void operator()(Acc& acc, const Unit& u, int wr, int wc, int fr, int fq) const {
#pragma unroll
        for (int ai = 0; ai < 2; ++ai)
#pragma unroll
            for (int m = 0; m < 4; ++m) {
                const int row = u.pm * BM + ai * HALF + wr * 64 + m * 16 + fr; const float rs = r0[row];
#pragma unroll
                for (int bj = 0; bj < 2; ++bj) {
                    const int c8 = u.pn * BM + bj * HALF + wc * 32 + 8 * fq;
                    const u32x4 w = pack8(acc[ai][bj][m][0] * rs, acc[ai][bj][m][1] * rs);
                    if (u.pn < 2) *(u32x4*)(upool + (size_t)row * DPOOL + c8) = w;
                    else { const int cs = c8 - DPOOL, gg = cs >> 4, h0 = cs & 15, cr = row / TCH, p = row % TCH;
                           *(u32x4*)(ussm + ((size_t)(gg * NCR + cr) * ROWLEN + 16 * p + h0)) = w; }
                }
            }
    }
};
struct EpiFG {
    static constexpr bool PERM = false, AFTER_DRAIN = false, HAS_MID = false; static constexpr int MID_T = 0;
    float* fg;
    __device__ __forceinline__ void operator()(Acc& acc, const Unit& u, int wr, int wc, int fr, int fq) const {
#pragma unroll
        for (int ai = 0; ai < 2; ++ai)
#pragma unroll
            for (int m = 0; m < 4; ++m) {
                const int cr = u.pm * BM + ai * HALF + wr * 64 + m * 16 + fr; float* rowp = fg + ((size_t)u.g * NCR + cr) * 256 + wc * 32 + 4 * fq;
#pragma unroll
                for (int bj = 0; bj < 2; ++bj)
#pragma unroll
                    for (int n = 0; n < 2; ++n) *(f32x4*)(rowp + bj * HALF + n * 16) = acc[ai][bj][m][n];
            }
    }
};
struct EpiZ {
    static constexpr bool PERM = true, AFTER_DRAIN = false, HAS_MID = false; static constexpr int MID_T = 0;
    const bf16_t* ussm; const float* dvec; bf16_t* zg;
    __device__ __forceinline__ void operator()(Acc& acc, const Unit& u, int wr, int wc, int fr, int fq) const {
#pragma unroll
        for (int bj = 0; bj < 2; ++bj) {
            const int c8 = u.pn * BM + bj * HALF + wc * 32 + 8 * fq;
            const f32x4 d0 = *(const f32x4*)(dvec + u.g * 16 + (c8 & 15)), d1 = *(const f32x4*)(dvec + u.g * 16 + (c8 & 15) + 4);
#pragma unroll
            for (int ai = 0; ai < 2; ++ai)
#pragma unroll
                for (int m = 0; m < 4; ++m) {
                    const int cr = u.pm * BM + ai * HALF + wr * 64 + m * 16 + fr;
                    const u32x4 uw = *(const u32x4*)(ussm + ((size_t)(u.g * NCR + cr) * ROWLEN + c8));
                    f32x4 u0, u1; unpack8(uw, u0, u1);
                    f32x4 y0 = acc[ai][bj][m][0] + d0 * u0, y1 = acc[ai][bj][m][1] + d1 * u1;
#pragma unroll
                    for (int i = 0; i < 4; ++i) { y0[i] = fast_gelu_tanh(y0[i]); y1[i] = fast_gelu_tanh(y1[i]); }
                    *(u32x4*)(zg + ((size_t)u.g * MT * 16 + (size_t)cr * K1 + c8)) = pack8(y0, y1);
                }
        }
    }
};
struct EpiPool {
    static constexpr bool PERM = true, AFTER_DRAIN = false, HAS_MID = false; static constexpr int MID_T = 0;
    const float* pscale; bf16_t* ycat; float* ss;
    __device__ __forceinline__ void operator()(Acc& acc, const Unit& u, int wr, int wc, int fr, int fq) const {
        f32x4 sc[2][2];
#pragma unroll
        for (int bj = 0; bj < 2; ++bj) { const int c8 = u.pn * BM + bj * HALF + wc * 32 + 8 * fq; sc[bj][0] = *(const f32x4*)(pscale + c8); sc[bj][1] = *(const f32x4*)(pscale + c8 + 4); }
#pragma unroll
        for (int ai = 0; ai < 2; ++ai)
#pragma unroll
            for (int m = 0; m < 4; ++m) {
                const int row = u.pm * BM + ai * HALF + wr * 64 + m * 16 + fr; float q = 0.f;
#pragma unroll
                for (int bj = 0; bj < 2; ++bj) {
                    const int c8 = u.pn * BM + bj * HALF + wc * 32 + 8 * fq;
                    const f32x4 v0 = acc[ai][bj][m][0] * sc[bj][0], v1 = acc[ai][bj][m][1] * sc[bj][1];
                    q += (v0[0] * v0[0] + v0[1] * v0[1]) + (v0[2] * v0[2] + v0[3] * v0[3]) + (v1[0] * v1[0] + v1[1] * v1[1]) + (v1[2] * v1[2] + v1[3] * v1[3]);
                    *(u32x4*)(ycat + (size_t)row * DM + c8) = pack8(v0, v1);
                }
                q += __shfl_xor(q, 16); q += __shfl_xor(q, 32);
                if (fq == 0) ss[(size_t)(u.pn * 4 + wc) * MT + row] = q;
            }
    }
};
struct EpiGlu {
    static constexpr bool PERM = true, AFTER_DRAIN = false, HAS_MID = false; static constexpr int MID_T = 0;
    const float* gb; const bf16_t* zg; bf16_t* ycat; float* ss;
    __device__ __forceinline__ void operator()(Acc& acc, const Unit& u, int wr, int wc, int fr, int fq) const {
        f32x4 bv[2][2];
#pragma unroll
        for (int bj = 0; bj < 2; ++bj) { const int c8 = u.pn * BM + bj * HALF + wc * 32 + 8 * fq; bv[bj][0] = *(const f32x4*)(gb + c8); bv[bj][1] = *(const f32x4*)(gb + c8 + 4); }
#pragma unroll
        for (int ai = 0; ai < 2; ++ai)
#pragma unroll
            for (int m = 0; m < 4; ++m) {
                const int row = u.pm * BM + ai * HALF + wr * 64 + m * 16 + fr; float q = 0.f;
#pragma unroll
                for (int bj = 0; bj < 2; ++bj) {
                    const int c8 = u.pn * BM + bj * HALF + wc * 32 + 8 * fq;
                    const u32x4 zw = *(const u32x4*)(zg + ((size_t)(c8 >> 4) * MT + row) * 16 + (c8 & 15));
                    f32x4 z0, z1; unpack8(zw, z0, z1);
                    f32x4 v0 = acc[ai][bj][m][0] + bv[bj][0], v1 = acc[ai][bj][m][1] + bv[bj][1];
#pragma unroll
                    for (int i = 0; i < 4; ++i) { v0[i] = z0[i] * fast_sigmoid(v0[i]); v1[i] = z1[i] * fast_sigmoid(v1[i]); }
                    q += (v0[0] * v0[0] + v0[1] * v0[1]) + (v0[2] * v0[2] + v0[3] * v0[3]) + (v1[0] * v1[0] + v1[1] * v1[1]) + (v1[2] * v1[2] + v1[3] * v1[3]);
                    *(u32x4*)(ycat + (size_t)row * DM + DPOOL + c8) = pack8(v0, v1);
                }
                q += __shfl_xor(q, 16); q += __shfl_xor(q, 32);
                if (fq == 0) ss[(size_t)(u.pn * 4 + wc) * MT + row] = q;
            }
    }
};
struct EpiOut {
    static constexpr bool PERM = false, AFTER_DRAIN = true, HAS_MID = true; static constexpr int MID_T = 8;
    const float* x; bf16_t* h1b; float* ss; LAS f32x2* XR; float ratio[2][4];
    __device__ __forceinline__ void mid(Acc& acc, int wr, int fr) const {
#pragma unroll
        for (int ai = 0; ai < 2; ++ai)
#pragma unroll
            for (int m = 0; m < 4; ++m) { const float ratio = this->ratio[ai][m];
#pragma unroll
                for (int bj = 0; bj < 2; ++bj)
#pragma unroll
                    for (int n = 0; n < 2; ++n) acc[ai][bj][m][n] = acc[ai][bj][m][n] * ratio; }
    }
    __device__ __forceinline__ void fused(Acc& acc, const Unit& u, int wr, int wc, int fr, int fq, LAS unsigned char* lds, int wid, int lane) const {
        LAS float* P = (LAS float*)lds;
        const int col0 = u.pn * BM + wc * 32 + 4 * fq;
#pragma unroll
        for (int ai = 0; ai < 2; ++ai)
#pragma unroll
            for (int m = 0; m < 4; ++m) {
                const int lr = ai * HALF + wr * 64 + m * 16 + fr, row = u.pm * BM + lr; const float rs = XR[lr].y; float q = 0.f;
                const size_t prow = (size_t)(row >> 12) * PADROWS + 1 + (row & 4095);
#pragma unroll
                for (int bj = 0; bj < 2; ++bj)
#pragma unroll
                    for (int n = 0; n < 2; ++n) {
                        const int c = col0 + bj * HALF + n * 16;
                        const f32x4 xv = *(const f32x4*)(x + (size_t)row * DM + c);
                        const f32x4 hv = xv + acc[ai][bj][m][n] * rs;
                        q += (hv[0] * hv[0] + hv[1] * hv[1]) + (hv[2] * hv[2] + hv[3] * hv[3]);
                        *(u32x2*)(h1b + prow * DM + c) = pack4(hv);
                    }
                q += __shfl_xor(q, 16); q += __shfl_xor(q, 32);
                if (fq == 0) P[lr * 4 + wc] = q;
            }
        LDS_WAIT(); __builtin_amdgcn_s_barrier(); asm volatile("" ::: "memory");
        const int tid = wid * 64 + lane;
        if (tid < 256) ss[(size_t)u.pn * MT + u.pm * BM + tid] = (P[tid * 4 + 0] + P[tid * 4 + 1]) + (P[tid * 4 + 2] + P[tid * 4 + 3]);
    }
};
struct EpiUp {
    static constexpr bool PERM = true, AFTER_DRAIN = false, HAS_MID = false; static constexpr int MID_T = 0;
    const float* ssh1; const float* cw; const float* cb; bf16_t* act;
    __device__ __forceinline__ void operator()(Acc& acc, const Unit& u, int wr, int wc, int fr, int fq) const {
        const int j = u.pm, b = u.g;
        int tokv[2][4];
#pragma unroll
        for (int ai = 0; ai < 2; ++ai)
#pragma unroll
            for (int m = 0; m < 4; ++m) {
                const int w = 64 * ai + 16 * m + fr, t = UPROWS * j + 126 * wr + w - 1; const bool in = (t >= 0 && t < SEQ);
                const int tok = b * SEQ + (in ? t : 0);
                const float s = (ssh1[tok] + ssh1[MT + tok]) + (ssh1[2 * MT + tok] + ssh1[3 * MT + tok]);
                const float rs = in ? rsqrtf(s * (1.0f / DM) + EPS) : 0.f;
                tokv[ai][m] = (in && w >= 1 && w <= 126) ? tok : -1;
#pragma unroll
                for (int bj = 0; bj < 2; ++bj)
#pragma unroll
                    for (int n = 0; n < 2; ++n) acc[ai][bj][m][n] = acc[ai][bj][m][n] * rs;
            }
        const int f0 = 128 * u.pn + 32 * wc + 8 * fq;
        u32x2 keep[8];
#pragma unroll
        for (int n = 0; n < 2; ++n) {
            const int fc = f0 + 4 * n;
            const f32x4 wv0 = *(const f32x4*)(cw + fc), wv1 = *(const f32x4*)(cw + DFF2 + fc), wv2 = *(const f32x4*)(cw + 2 * DFF2 + fc), bvv = *(const f32x4*)(cb + fc);
            const f32x4 wg0 = *(const f32x4*)(cw + DFF + fc), wg1 = *(const f32x4*)(cw + DFF2 + DFF + fc), wg2 = *(const f32x4*)(cw + 2 * DFF2 + DFF + fc), bgv = *(const f32x4*)(cb + DFF + fc);
#pragma unroll
            for (int gi = 0; gi < 8; ++gi) {
                const int ai = gi >> 2, m = gi & 3, pi = gi > 0 ? gi - 1 : gi, ni = gi < 7 ? gi + 1 : gi;
                const f32x4 cv = acc[ai][0][m][n], cg = acc[ai][1][m][n];
                const f32x4 pv = acc[pi >> 2][0][pi & 3][n], pg = acc[pi >> 2][1][pi & 3][n];
                const f32x4 nv = acc[ni >> 2][0][ni & 3][n], ng = acc[ni >> 2][1][ni & 3][n];
                f32x4 o;
#pragma unroll
                for (int i = 0; i < 4; ++i) {
                    const float v_prev = dpp_ror1(fr == 15 ? pv[i] : cv[i]), v_next = dpp_ror15(fr == 0 ? nv[i] : cv[i]);
                    const float g_prev = dpp_ror1(fr == 15 ? pg[i] : cg[i]), g_next = dpp_ror15(fr == 0 ? ng[i] : cg[i]);
                    const float vv = bvv[i] + wv0[i] * v_prev + wv1[i] * cv[i] + wv2[i] * v_next;
                    const float gg = bgv[i] + wg0[i] * g_prev + wg1[i] * cg[i] + wg2[i] * g_next;
                    o[i] = vv * gg * fast_sigmoid(gg);
                }
                const u32x2 pk = pack4(o);
                if (n == 0) keep[gi] = pk;
                else if (tokv[ai][m] >= 0) { u32x4 w; w.x = keep[gi].x; w.y = keep[gi].y; w.z = pk.x; w.w = pk.y; *(u32x4*)(act + (size_t)tokv[ai][m] * DFF + f0) = w; }
            }
        }
    }
};
struct EpiDown {
    static constexpr bool PERM = false, AFTER_DRAIN = true, HAS_MID = false; static constexpr int MID_T = 0;
    const bf16_t* h1b; float* out; const float* gfin; float* ss; const XcdBarrier* bar;
    __device__ __forceinline__ void fused(Acc& acc, const Unit& u, int wr, int wc, int fr, int fq, LAS unsigned char* lds, int wid, int lane) const {
        LAS float* P = (LAS float*)lds;
        LAS float* Sr = (LAS float*)(lds + 8192);
        const int col0 = u.pn * BM + wc * 32 + 4 * fq;
#pragma unroll
        for (int ai = 0; ai < 2; ++ai)
#pragma unroll
            for (int m = 0; m < 4; ++m) {
                const int lr = ai * HALF + wr * 64 + m * 16 + fr, row = u.pm * BM + lr; float q = 0.f;
                const size_t prow = (size_t)(row >> 12) * PADROWS + 1 + (row & 4095);
#pragma unroll
                for (int bj = 0; bj < 2; ++bj)
#pragma unroll
                    for (int n = 0; n < 2; ++n) {
                        const u32x2 hw = *(const u32x2*)(h1b + prow * DM + col0 + bj * HALF + n * 16);
                        const f32x4 hv = (f32x4){bflo(hw.x), bfhi(hw.x), bflo(hw.y), bfhi(hw.y)} + acc[ai][bj][m][n];
                        acc[ai][bj][m][n] = hv;
                        q += (hv[0] * hv[0] + hv[1] * hv[1]) + (hv[2] * hv[2] + hv[3] * hv[3]);
                    }
                q += __shfl_xor(q, 16); q += __shfl_xor(q, 32);
                if (fq == 0) P[lr * 4 + wc] = q;
            }
        LDS_WAIT(); __builtin_amdgcn_s_barrier(); asm volatile("" ::: "memory");
        const int tid = wid * 64 + lane;
        if (tid < 256) ss[(size_t)u.pn * MT + u.pm * BM + tid] = (P[tid * 4 + 0] + P[tid * 4 + 1]) + (P[tid * 4 + 2] + P[tid * 4 + 3]);
        xcd_barrier(*bar);
        if (tid < 256) { const int row = u.pm * BM + tid; const float s = (ss[row] + ss[MT + row]) + (ss[2 * MT + row] + ss[3 * MT + row]); Sr[tid] = rsqrtf(s * (1.0f / DM) + EPS); }
        LDS_WAIT(); __builtin_amdgcn_s_barrier(); asm volatile("" ::: "memory");
#pragma unroll
        for (int bj = 0; bj < 2; ++bj)
#pragma unroll
            for (int n = 0; n < 2; ++n) {
                const int c = col0 + bj * HALF + n * 16; const f32x4 gv = *(const f32x4*)(gfin + c);
#pragma unroll
                for (int ai = 0; ai < 2; ++ai)
#pragma unroll
                    for (int m = 0; m < 4; ++m) { const int lr = ai * HALF + wr * 64 + m * 16 + fr; const float r = Sr[lr];
                        *(f32x4*)(out + (size_t)(u.pm * BM + lr) * DM + c) = acc[ai][bj][m][n] * r * gv; }
            }
    }
};

struct OrdOne { Unit u; __device__ bool next(int i, Unit& o) const { if (i > 0) return false; o = u; return true; } };
struct OrdSsmA { int c; __device__ bool next(int i, Unit& u) const { if (i > 0 || c >= 64) return false; const int x = c & 7, k = c >> 3; u.g = x * 4 + (k >> 1); u.pm = k & 1; u.pn = 0; return true; } };
struct OrdSsmB { int c; __device__ bool next(int i, Unit& u) const { if (i > 0 || c >= 128) return false; const int x = c & 7, k = c >> 3; u.g = x * 4 + (k >> 2); u.pm = (k >> 1) & 1; u.pn = k & 1; return true; } };
struct OrdPool { int c; __device__ bool next(int i, Unit& u) const { if (i > 0 || c < 128 || c >= 256) return false; const int cc = c - 128, x = cc & 7, k = cc >> 3; u.pm = x * 8 + (k >> 1); u.pn = k & 1; u.g = u.pn; return true; } };
struct OrdGlu  { int c; __device__ bool next(int i, Unit& u) const { if (i > 0 || c >= 128) return false; const int x = c & 7, k = c >> 3; u.pm = x * 8 + (k >> 1); u.pn = k & 1; u.g = 0; return true; } };
struct OrdUp { StaticOrder so; __device__ bool next(int i, Unit& u) const { if (!so.next(i, u)) return false; u.g = u.pm / UPT; u.pm = u.pm % UPT; return true; } };

constexpr size_t WS_STAMP = 4 * MiB;
#if defined(MK_STAMP)
#define ST(k) do { if (threadIdx.x == 0) ((unsigned long long*)(args.ws + WS_STAMP))[blockIdx.x * 64 + (k)] = __builtin_amdgcn_s_memrealtime(); } while (0)
#define GP_STAMP(base) ((unsigned long long*)(args.ws + WS_STAMP) + blockIdx.x * 64 + (base))
#else
#define ST(k) do { } while (0)
#define GP_STAMP(base) ((unsigned long long*)nullptr)
#endif
struct Args { const float* in[24]; float* out; unsigned char* ws; int ph_lo, ph_hi; };

struct Frame { LAS unsigned char* lds; int tid, lane, wave, G, bx; };

struct TrMat { const float* W; int K, N; const float* kg0; const float* kg1; int ksplit; bf16_t* WT; int map; int nitems; };
__device__ __forceinline__ void tr_load(const TrMat& m0, const TrMat& m1, int item, int lane, f32x4 (&v)[8]) {
    const bool second = item >= m0.nitems; const TrMat& m = second ? m1 : m0; const int it = second ? item - m0.nitems : item;
    const int nblk = m.N / 32, kb = it / nblk, nb = it % nblk, k0 = 64 * kb, n0 = 32 * nb, r = lane >> 3, c4 = lane & 7;
#pragma unroll
    for (int i = 0; i < 8; ++i) v[i] = *(const f32x4*)(m.W + (size_t)(k0 + 8 * i + r) * m.N + n0 + 4 * c4);
}
__device__ __forceinline__ void tr_store(const TrMat& m0, const TrMat& m1, int item, int lane, const f32x4 (&v)[8], LAS float* scr) {
    const bool second = item >= m0.nitems; const TrMat& m = second ? m1 : m0; const int it = second ? item - m0.nitems : item;
    const int nblk = m.N / 32, kb = it / nblk, nb = it % nblk, k0 = 64 * kb, n0 = 32 * nb, r = lane >> 3, c4 = lane & 7;
#pragma unroll
    for (int i = 0; i < 8; ++i) { const int kk = 8 * i + r, k = k0 + kk; float gn = 1.f; if (m.kg0) gn = (k < m.ksplit ? m.kg0[k] : m.kg1[k - m.ksplit]);
        LAS float* d = scr + kk * 33 + 4 * c4; d[0] = v[i][0] * gn; d[1] = v[i][1] * gn; d[2] = v[i][2] * gn; d[3] = v[i][3] * gn; }
    LDS_WAIT(); asm volatile("" ::: "memory");
    const int c = lane & 7;
#pragma unroll
    for (int j = 0; j < 4; ++j) { const int n = (lane >> 3) + 8 * j; const LAS float* q = scr + (8 * c) * 33 + n;
        u32x4 o; o.x = pk2(q[0 * 33], q[1 * 33]); o.y = pk2(q[2 * 33], q[3 * 33]); o.z = pk2(q[4 * 33], q[5 * 33]); o.w = pk2(q[6 * 33], q[7 * 33]);
        int nr = n0 + n;
        if (m.map == 1) { const int bj = nr / DFF, rem = nr % DFF; nr = 256 * (rem >> 7) + 128 * bj + (rem & 127); }
        *(u32x4*)(m.WT + (size_t)nr * m.K + k0 + 8 * c) = o; }
    LDS_WAIT(); asm volatile("" ::: "memory");
}
__device__ __forceinline__ void tr_run(const TrMat& m0, const TrMat& m1, int first, int stride, int lane, LAS float* scr) {
    const int total = m0.nitems + m1.nitems; f32x4 va[8], vb[8];
    int it = first; if (it < total) tr_load(m0, m1, it, lane, va);
    while (it < total) {
        const int n1 = it + stride; if (n1 < total) tr_load(m0, m1, n1, lane, vb);
        tr_store(m0, m1, it, lane, va, scr);
        if (n1 >= total) break;
        const int n2 = n1 + stride; if (n2 < total) tr_load(m0, m1, n2, lane, va);
        tr_store(m0, m1, n1, lane, vb, scr);
        it = n2;
    }
}

struct SsmLds { LAS float* Bre; LAS float* Bim; LAS float* Cre; LAS float* Cim; LAS float* PAR; LAS float* Pc; LAS float* Kl; };
__device__ __forceinline__ SsmLds ssm_lds(const Frame& F) { SsmLds L; L.Bre = (LAS float*)(F.lds); L.Bim = L.Bre + 2048; L.Cre = L.Bim + 2048; L.Cim = L.Cre + 2048; L.PAR = L.Cim + 2048; L.Pc = L.PAR + 512; L.Kl = L.Pc + 1024; return L; }
__device__ __forceinline__ void ssm_stage(const Args& a, const Frame& F, const SsmLds& L, int g) {
    const float* lnar = a.in[5]; const float* aim = a.in[6]; const float* ldt = a.in[7];
    const float* bre = a.in[8]; const float* bim = a.in[9]; const float* cre = a.in[10]; const float* cim = a.in[11];
    const int tid = F.tid;
    for (int i = tid; i < 2048; i += 512) { const int dir = i >> 10, r = i & 1023;
        L.Bre[i] = bre[((size_t)(dir * NG + g)) * 1024 + r]; L.Bim[i] = bim[((size_t)(dir * NG + g)) * 1024 + r];
        L.Cre[i] = cre[((size_t)(dir * NG + g)) * 1024 + r]; L.Cim[i] = cim[((size_t)(dir * NG + g)) * 1024 + r]; }
    if (tid < 128) { const int dir = tid >> 6, n = tid & 63;
        const float dt = expf(ldt[dir * NG + g]); const float a_re = -expf(lnar[(dir * NG + g) * NS + n]), a_im = aim[(dir * NG + g) * NS + n];
        const float mag = expf(a_re * dt), ang = a_im * dt; const float lam_re = mag * cosf(ang), lam_im = mag * sinf(ang);
        const float den = a_re * a_re + a_im * a_im;
        L.PAR[tid * 4 + 0] = a_re * dt; L.PAR[tid * 4 + 1] = ang;
        L.PAR[tid * 4 + 2] = ((lam_re - 1.0f) * a_re + lam_im * a_im) / den; L.PAR[tid * 4 + 3] = (lam_im * a_re - (lam_re - 1.0f) * a_im) / den; }
    __syncthreads();
}
__device__ __forceinline__ void ssm_build_tb(const Args& a, const Frame& F, const SsmLds& L, int g, int lag0, int nl) {
    bf16_t* KC = (bf16_t*)(a.ws + WS_TB) + (size_t)g * 64 * 256;
    bf16_t* TBC = (bf16_t*)(a.ws + WS_TBC) + (size_t)g * K1 * 256;
    const int tid = F.tid;
    { const int li = tid >> 7, dn = tid & 127, lag = lag0 + li; const float ad = L.PAR[dn * 4 + 0], ang = L.PAR[dn * 4 + 1], fr_ = L.PAR[dn * 4 + 2], fi_ = L.PAR[dn * 4 + 3];
      const float mg = expf((float)lag * ad); float sn, cs; sincosf((float)lag * ang, &sn, &cs); const float lr = mg * cs, lim = mg * sn;
      L.Pc[(li * 128 + dn) * 2 + 0] = lr * fr_ - lim * fi_; L.Pc[(li * 128 + dn) * 2 + 1] = lr * fi_ + lim * fr_; }
    __syncthreads();
    { const int li = F.wave >> 1, dir = F.wave & 1, i16 = F.lane & 15, kq = F.lane >> 4; f32x4 kacc = {0.f, 0.f, 0.f, 0.f};
#pragma unroll 8
      for (int kk0 = 0; kk0 < 128; kk0 += 4) { const int kk = kk0 + kq, n = kk >> 1; const bool im = (kk & 1) != 0;
          const float cr_ = L.Cre[dir * 1024 + i16 * 64 + n], ci_ = L.Cim[dir * 1024 + i16 * 64 + n], pr = L.Pc[(li * 128 + dir * 64 + n) * 2], pi = L.Pc[(li * 128 + dir * 64 + n) * 2 + 1];
          const float av = im ? -(cr_ * pi + ci_ * pr) : (cr_ * pr - ci_ * pi);
          const float bv = im ? L.Bim[dir * 1024 + n * 16 + i16] : L.Bre[dir * 1024 + n * 16 + i16];
          kacc = __builtin_amdgcn_mfma_f32_16x16x4f32(av, bv, kacc, 0, 0, 0); }
#pragma unroll
      for (int r = 0; r < 4; ++r) L.Kl[li * 512 + dir * 256 + (kq * 4 + r) * 16 + i16] = kacc[r]; }
    __syncthreads();
    { const int li = tid >> 7, dir = (tid >> 6) & 1, e4 = tid & 63, lag = lag0 + li;
      if (li < nl && !(lag == 0 && dir == 1)) {
          f32x4 v = *(const LAS f32x4*)(L.Kl + li * 512 + dir * 256 + 4 * e4);
          if (lag == 0) v = v + *(const LAS f32x4*)(L.Kl + li * 512 + 256 + 4 * e4);
          const int d = dir == 0 ? 31 + lag : 31 - lag; u32x2 w; w.x = pk2(v[0], v[1]); w.y = pk2(v[2], v[3]);
          *(u32x2*)(KC + (size_t)d * 256 + 4 * e4) = w; } }
    __syncthreads();
    { const int li = tid >> 7, dn = tid & 127, dir = dn >> 6, p = lag0 + li; const float ad = L.PAR[dn * 4 + 0], ang = L.PAR[dn * 4 + 1]; const float e = dir == 0 ? (float)(p + 1) : (float)(TCH - p);
      const float mg = expf(e * ad); float sn, cs; sincosf(e * ang, &sn, &cs); L.Pc[(li * 128 + dn) * 2 + 0] = mg * cs; L.Pc[(li * 128 + dn) * 2 + 1] = mg * sn; }
    __syncthreads();
    for (int li = 0; li < nl; ++li) {
        const int p = lag0 + li, h = tid >> 5, dir = (tid >> 4) & 1, n4 = tid & 15; float v[8];
#pragma unroll
        for (int e = 0; e < 4; ++e) { const int n = 4 * n4 + e; const float cr_ = L.Cre[dir * 1024 + h * 64 + n], ci_ = L.Cim[dir * 1024 + h * 64 + n], pr = L.Pc[(li * 128 + dir * 64 + n) * 2], pi = L.Pc[(li * 128 + dir * 64 + n) * 2 + 1];
            v[2 * e] = cr_ * pr - ci_ * pi; v[2 * e + 1] = -(cr_ * pi + ci_ * pr); }
        u32x4 w; w.x = pk2(v[0], v[1]); w.y = pk2(v[2], v[3]); w.z = pk2(v[4], v[5]); w.w = pk2(v[6], v[7]);
        *(u32x4*)(TBC + (size_t)(16 * p + h) * 256 + dir * 128 + 8 * n4) = w;
    }
    __syncthreads();
}
__device__ __forceinline__ void ssm_build_wab(const Args& a, const Frame& F, const SsmLds& L, int g, int jq) {
    bf16_t* WAB = (bf16_t*)(a.ws + WS_WAB) + (size_t)g * 256 * K1;
    const int tid = F.tid;
    { const int li = tid >> 7, dn = tid & 127, dir = dn >> 6, q = 4 * jq + li; const float ad = L.PAR[dn * 4 + 0], ang = L.PAR[dn * 4 + 1], fr_ = L.PAR[dn * 4 + 2], fi_ = L.PAR[dn * 4 + 3]; const float e = dir == 0 ? (float)(TCH - 1 - q) : (float)q;
      const float mg = expf(e * ad); float sn, cs; sincosf(e * ang, &sn, &cs); const float lr = mg * cs, lim = mg * sn;
      L.Pc[(li * 128 + dn) * 2 + 0] = lr * fr_ - lim * fi_; L.Pc[(li * 128 + dn) * 2 + 1] = lr * fi_ + lim * fr_; }
    __syncthreads();
#pragma unroll
    for (int half = 0; half < 2; ++half) {
        const int li = 2 * half + (tid >> 8), q = 4 * jq + li, t2 = tid & 255, dir = t2 >> 7, n = (t2 >> 1) & 63, part = t2 & 1;
        const float pr = L.Pc[(li * 128 + dir * 64 + n) * 2], pi = L.Pc[(li * 128 + dir * 64 + n) * 2 + 1]; float v[16];
#pragma unroll
        for (int i = 0; i < 16; ++i) { const float br_ = L.Bre[dir * 1024 + n * 16 + i], bi_ = L.Bim[dir * 1024 + n * 16 + i]; v[i] = part == 0 ? (pr * br_ - pi * bi_) : (pr * bi_ + pi * br_); }
        u32x4 w0, w1; w0.x = pk2(v[0], v[1]); w0.y = pk2(v[2], v[3]); w0.z = pk2(v[4], v[5]); w0.w = pk2(v[6], v[7]); w1.x = pk2(v[8], v[9]); w1.y = pk2(v[10], v[11]); w1.z = pk2(v[12], v[13]); w1.w = pk2(v[14], v[15]);
        bf16_t* dst = WAB + (size_t)(dir * 128 + 2 * n + part) * K1 + 16 * q; *(u32x4*)dst = w0; *(u32x4*)(dst + 8) = w1;
    }
    __syncthreads();
}

__device__ __forceinline__ void p0_prologue(const Args& a, const Frame& F) {
    const float* x = a.in[0];
    { const SsmLds L = ssm_lds(F);
      for (int it = F.bx; it < NG * 8; it += F.G) { ssm_stage(a, F, L, it >> 3); ssm_build_wab(a, F, L, it >> 3, it & 7); } }
    __syncthreads();
    LAS float* scr = (LAS float*)(F.lds + F.wave * 16384);
    const int gw = F.bx * 8 + F.wave, NGW = F.G * 8;
    { const TrMat m0{a.in[2], DM, DM, a.in[1], a.in[1], DM, (bf16_t*)(a.ws + WS_WIN), 0, (DM / 64) * (DM / 32)}; const TrMat m1{nullptr, 0, 32, nullptr, nullptr, 0, nullptr, 0, 0};
      tr_run(m0, m1, gw, NGW, F.lane, scr); }
    { bf16_t* PW = (bf16_t*)(a.ws + WS_PW); const float* pw = a.in[3];
      for (int idx = F.bx * 512 + F.tid; idx < 2 * 256 * 256; idx += F.G * 512) { const int pn = idx >> 16, j = (idx >> 8) & 255, k = idx & 255;
          const float v = ((j >> 7) == (k >> 7)) ? pw[((size_t)(2 * pn + (j >> 7)) * 128 + (k & 127)) * 128 + (j & 127)] : 0.f; PW[idx] = (bf16_t)f2bf(v); } }
    { bf16_t* h1b = (bf16_t*)(a.ws + WS_H1B);
      for (int idx = F.bx * 512 + F.tid; idx < BATCH * 256 * (DM / 8); idx += F.G * 512) { const int b = idx / (256 * 128), r = (idx / 128) % 256, c = idx % 128; const int prow = b * PADROWS + (r == 0 ? 0 : 4096 + r);
          *(u32x4*)(h1b + (size_t)prow * DM + 8 * c) = (u32x4){0u, 0u, 0u, 0u}; } }
    { bf16_t* xb = (bf16_t*)(a.ws + WS_XB); float* r0 = (float*)(a.ws + WS_R0);
      for (int row = gw; row < MT; row += NGW) {
          const f32x4* xr = (const f32x4*)(x + (size_t)row * DM) + F.lane; f32x4 v[4]; float s = 0.f;
#pragma unroll
          for (int j = 0; j < 4; ++j) { v[j] = xr[64 * j]; s += (v[j][0] * v[j][0] + v[j][1] * v[j][1]) + (v[j][2] * v[j][2] + v[j][3] * v[j][3]); }
          s = wave_sum(s); if (F.lane == 0) r0[row] = rsqrtf(s * (1.0f / DM) + EPS);
          u32x2* o = (u32x2*)(xb + (size_t)row * DM) + F.lane;
#pragma unroll
          for (int j = 0; j < 4; ++j) o[64 * j] = pack4(v[j]);
      } }
}

__device__ __forceinline__ void p2_side(const Args& a, const Frame& F, int first_block) {
    const int nb = F.G - first_block, sb = F.bx - first_block;
    { const SsmLds L = ssm_lds(F);
      int id = (sb * (NG * TCH)) / nb; const int id_end = ((sb + 1) * (NG * TCH)) / nb; int staged = -1;
      while (id < id_end) {
          const int g = id / TCH, lag0 = id % TCH; int nl = TCH - lag0; if (nl > 4) nl = 4; if (nl > id_end - id) nl = id_end - id;
          if (g != staged) { ssm_stage(a, F, L, g); staged = g; }
          ssm_build_tb(a, F, L, g, lag0, nl); id += nl;
      } }
    __syncthreads();
    LAS float* scr = (LAS float*)(F.lds + F.wave * 16384);
    const TrMat m0{a.in[13], DSSM, DSSM, nullptr, nullptr, 0, (bf16_t*)(a.ws + WS_WGLU), 0, (DSSM / 64) * (DSSM / 32)}; const TrMat m1{nullptr, 0, 32, nullptr, nullptr, 0, nullptr, 0, 0};
    tr_run(m0, m1, sb * 8 + F.wave, nb * 8, F.lane, scr);
}
__device__ __forceinline__ void ssm_side(const Args& a, const Frame& F, int first_block) {
    const int nb = F.G - first_block, sb = F.bx - first_block;
    { const SsmLds L = ssm_lds(F);
      const int g = sb >> 2, lag0 = (sb & 3) * 8;
#if defined(MK_STAMP)
#define STS(k) do { if (F.tid == 0) ((unsigned long long*)(a.ws + WS_STAMP))[blockIdx.x * 64 + (k)] = __builtin_amdgcn_s_memrealtime(); } while (0)
#else
#define STS(k) do { } while (0)
#endif
      ssm_stage(a, F, L, g); STS(45); ssm_build_tb(a, F, L, g, lag0, 4); STS(46); ssm_build_tb(a, F, L, g, lag0 + 4, 4); STS(47);
      VM_WAIT(); __syncthreads();
      if (F.tid == 0) { __builtin_amdgcn_fence(__ATOMIC_RELEASE, "agent"); asm volatile("s_waitcnt vmcnt(0)" ::: "memory");
          __hip_atomic_fetch_add((unsigned*)(a.ws + WS_CTL) + CW_TBCNT + 64 * g, 8u, __ATOMIC_RELAXED, __HIP_MEMORY_SCOPE_AGENT); } }
    __syncthreads();
#if defined(MK_STAMP)
    if (F.tid == 0) ((unsigned long long*)(a.ws + WS_STAMP))[blockIdx.x * 64 + 43] = __builtin_amdgcn_s_memrealtime();
#endif
    LAS float* scr = (LAS float*)(F.lds + F.wave * 16384);
    const TrMat m0{a.in[17], DM, DM, a.in[15], a.in[16], DPOOL, (bf16_t*)(a.ws + WS_WOUT), 0, (DM / 64) * (DM / 32)};
    const TrMat m1{a.in[13], DSSM, DSSM, nullptr, nullptr, 0, (bf16_t*)(a.ws + WS_WGLU), 0, (DSSM / 64) * (DSSM / 32)};
    tr_run(m0, m1, sb * 8 + F.wave, nb * 8, F.lane, scr);
}
__device__ __forceinline__ void tb_wait(const Args& a, const Frame& F, int g) {
    if (F.tid == 0) { unsigned* cnt = (unsigned*)(a.ws + WS_CTL) + CW_TBCNT + 64 * g; unsigned sp = 0;
        while (__hip_atomic_load(cnt, __ATOMIC_RELAXED, __HIP_MEMORY_SCOPE_AGENT) < (unsigned)TCH) { __builtin_amdgcn_s_sleep(2); if (++sp > (1u << 20)) break; }
        __builtin_amdgcn_fence(__ATOMIC_ACQUIRE, "agent"); asm volatile("s_waitcnt vmcnt(0)" ::: "memory"); }
    __syncthreads();
}
__device__ __forceinline__ void p3_side(const Args& a, const Frame& F, int first_block) {
    const int nb = F.G - first_block, sb = F.bx - first_block;
    LAS float* scr = (LAS float*)(F.lds + F.wave * 16384);
    const TrMat m0{a.in[17], DM, DM, a.in[15], a.in[16], DPOOL, (bf16_t*)(a.ws + WS_WOUT), 0, (DM / 64) * (DM / 32)}; const TrMat m1{nullptr, 0, 32, nullptr, nullptr, 0, nullptr, 0, 0};
    tr_run(m0, m1, sb * 8 + F.wave, nb * 8, F.lane, scr);
}
__device__ __forceinline__ void p4_side(const Args& a, const Frame& F, int first_block) {
    const int nb = F.G - first_block, sb = F.bx - first_block;
    LAS float* scr = (LAS float*)(F.lds + F.wave * 16384);
    const TrMat m0{a.in[19], DM, DFF2, a.in[18], a.in[18], DM, (bf16_t*)(a.ws + WS_WUP), 1, (DM / 64) * (DFF2 / 32)};
    const TrMat m1{a.in[22], DFF, DM, nullptr, nullptr, 0, (bf16_t*)(a.ws + WS_WDOWN), 0, (DFF / 64) * (DM / 32)};
    tr_run(m0, m1, sb * 8 + F.wave, nb * 8, F.lane, scr);
}

__device__ __forceinline__ void p2_pooled(const Args& a, const Frame& F, int first_block) {
    const bf16_t* up = (const bf16_t*)(a.ws + WS_UPOOL); bf16_t* po = (bf16_t*)(a.ws + WS_POOLED);
    const int gw = (F.bx - first_block) * 8 + F.wave, NGW = (F.G - first_block) * 8;
    const int c0 = 8 * F.lane, half = 1 << (F.lane >> 4);
    for (int blk = gw; blk < MT / 8; blk += NGW) {
        const int row0 = blk * 8, b = row0 / SEQ, t0 = row0 % SEQ;
        u32x4 w[23];
#pragma unroll
        for (int o = 0; o < 23; ++o) { int q = t0 + o - 8; q = q < 0 ? 0 : (q >= SEQ ? SEQ - 1 : q); w[o] = *(const u32x4*)(up + (size_t)(b * SEQ + q) * DPOOL + c0); }
#pragma unroll
        for (int r = 0; r < 8; ++r) {
            f32x4 s0 = {0.f, 0.f, 0.f, 0.f}, s1 = {0.f, 0.f, 0.f, 0.f}; float cnt = 0.f;
#pragma unroll
            for (int d = -8; d < 8; ++d) { const int q = t0 + r + d; const float m = (d >= -half && d < half && q >= 0 && q < SEQ) ? 1.f : 0.f; f32x4 a0, a1; unpack8(w[r + d + 8], a0, a1); s0 = s0 + a0 * m; s1 = s1 + a1 * m; cnt += m; }
            f32x4 c0v, c1v; unpack8(w[r + 8], c0v, c1v);
            const float inv = __builtin_amdgcn_rcpf(cnt);
            *(u32x4*)(po + (size_t)(row0 + r) * DPOOL + c0) = pack8(s0 * inv - c0v, s1 * inv - c1v);
        }
    }
}

__device__ __forceinline__ void p3_carries(const Args& a, const Frame& F, int g, int pm) {
    LAS float* TOT = (LAS float*)(F.lds);
    const int bs = F.tid >> 8, seg = (F.tid >> 6) & 3, n = F.tid & 63, b = 2 * pm + bs;
    for (int dir = 0; dir < 2; ++dir) {
        const float dt = expf(a.in[7][dir * NG + g]); const float a_re = -expf(a.in[5][(dir * NG + g) * NS + n]), a_im = a.in[6][(dir * NG + g) * NS + n];
        const float mg = expf((float)TCH * (a_re * dt)); float sn, cs; sincosf((float)TCH * (a_im * dt), &sn, &cs); const float lr = mg * cs, li = mg * sn;
        const float* fg = (const float*)(a.ws + WS_FG) + ((size_t)g * NCR + (size_t)b * NCHB) * 256 + dir * 128 + 2 * n;
        bf16_t* us = (bf16_t*)(a.ws + WS_USSM) + ((size_t)g * NCR + (size_t)b * NCHB) * ROWLEN + K1 + dir * 128 + 2 * n;
        f32x2 f[32];
#pragma unroll
        for (int k = 0; k < 32; ++k) { const int i = 32 * seg + k, c = dir == 0 ? i : NCHB - 1 - i; f[k] = *(const f32x2*)(fg + (size_t)c * 256); }
        float sr = 0.f, si = 0.f;
#pragma unroll
        for (int k = 0; k < 32; ++k) { const float nr = lr * sr - li * si + f[k].x, ni = lr * si + li * sr + f[k].y; sr = nr; si = ni; }
        TOT[F.tid * 2] = sr; TOT[F.tid * 2 + 1] = si;
        float pr = lr, pi = li;
#pragma unroll
        for (int q = 0; q < 5; ++q) { const float nr = pr * pr - pi * pi, ni = 2.f * pr * pi; pr = nr; pi = ni; }
        __syncthreads();
        sr = 0.f; si = 0.f;
        for (int s2 = 0; s2 < seg; ++s2) { const int o = (F.tid - 64 * (seg - s2)) * 2; const float tr = TOT[o], ti = TOT[o + 1]; const float nr = pr * sr - pi * si + tr, ni = pr * si + pi * sr + ti; sr = nr; si = ni; }
#pragma unroll
        for (int k = 0; k < 32; ++k) { const int i = 32 * seg + k, c = dir == 0 ? i : NCHB - 1 - i;
            *(unsigned*)(us + (size_t)c * ROWLEN) = pk2(sr, si);
            const float nr = lr * sr - li * si + f[k].x, ni = lr * si + li * sr + f[k].y; sr = nr; si = ni; }
        __syncthreads();
    }
    VM_WAIT(); __syncthreads();
}

__global__ void __launch_bounds__(512, 2) mk_fwd(Args args) {
    extern __shared__ __attribute__((aligned(16))) unsigned char lds_raw[];
    Frame F; F.lds = (LAS unsigned char*)lds_raw; F.tid = threadIdx.x; F.lane = F.tid & 63; F.wave = __builtin_amdgcn_readfirstlane(F.tid >> 6); F.G = gridDim.x; F.bx = blockIdx.x;
    volatile LAS unsigned* MISC = (volatile LAS unsigned*)(F.lds + LDSCTL_OFF);
    for (int u = F.tid; u < (LDS_BYTES - LDSCTL_OFF) / 4; u += 512) ((LAS unsigned*)(F.lds + LDSCTL_OFF))[u] = 0u;
    __syncthreads();
    unsigned char* ws = args.ws;
    XcdBarrier bar = xcd_barrier_post((unsigned*)(ws + WS_CTL), MISC + 8);
    const int lo = args.ph_lo, hi = args.ph_hi;
#define IN(k) (lo <= (k) && (k) < hi)
#define BOTH(k) (IN(k) && IN((k) == 2 ? 4 : (k) + 1))
    if (IN(0)) { ST(0); p0_prologue(args, F); ST(1); if (BOTH(0)) xcd_barrier(bar); }
    if (IN(1)) { ST(2);
        GemmDesc g{(const char*)(ws + WS_XB), (const char*)(ws + WS_WIN), 256L * DM * 2, 0, 256L * DM * 2, 0, 128L * DM * 2, 128L * DM * 2, 128, 128, DM / BK};
        unsigned vA[2], vB[2]; voff_std(vA, DM, false); voff_std(vB, DM, true);
        StaticOrder S; S.init(MT / BM, DM / BM, F.G, F.bx);
        EpiU E{(const float*)(ws + WS_R0), (bf16_t*)(ws + WS_UPOOL), (bf16_t*)(ws + WS_USSM)};
        gemm_phase<EpiU, StaticOrder, true>(F.lds, g, vA, vB, S, E, GP_STAMP(22));
        ST(3);
        if (BOTH(1)) xcd_barrier(bar);
#if defined(MK_EXTRA_BAR)
        for (int rep = 0; rep < MK_EXTRA_BAR; ++rep) xcd_barrier(bar);
#endif
    }
    if (IN(2)) { ST(4);
        if (F.bx < 128) {
            OrdSsmB S0{F.bx}; Unit u0; S0.next(0, u0);
            { GemmDesc g{(const char*)(ws + WS_USSM), (const char*)(ws + WS_WAB), 256L * ROWLEN * 2, (long)NCR * ROWLEN * 2, 0, 256L * K1 * 2, 128L * ROWLEN * 2, 128L * K1 * 2, 128, 128, K1 / BK};
              unsigned vA[2], vB[2]; voff_std(vA, ROWLEN, false); voff_std(vB, K1, false);
              OrdOne S{Unit{u0.pm, 0, u0.g}}; EpiFG E{(float*)(ws + WS_FG)};
              gemm_phase<EpiFG, OrdOne, true>(F.lds, g, vA, vB, S, E, GP_STAMP(24)); }
            VM_WAIT(); __syncthreads(); ST(40);
            p3_carries(args, F, u0.g, u0.pm); ST(41);
            tb_wait(args, F, u0.g); ST(42);
            { GemmDesc g{(const char*)(ws + WS_USSM), (const char*)(ws + WS_TB), 256L * ROWLEN * 2, (long)NCR * ROWLEN * 2, 16L * 512, 64L * 512, 128L * ROWLEN * 2, 8L * 512, 128, -4L * 512, ROWLEN / BK,
                         (const char*)(ws + WS_TBC), 256L * 512, (long)K1 * 512, 128L * 512, 128, K1 / BK};
              unsigned vA[2], vB[2], vB2[2]; voff_std(vA, ROWLEN, false); voff_std(vB2, 256, true);
#pragma unroll
              for (int i = 0; i < 2; ++i) { int R, C; stage_rc(F.tid * 16 + i * 8192, R, C); const int Rb = (R & ~31) + perm32(R & 31);
                  vB[i] = (unsigned)((((Rb >> 4) - (C >> 4) + 31) * 256 + (Rb & 15) * 16 + (C & 15)) * 2); }
              asm volatile("" : "+v"(vA[0]), "+v"(vA[1]), "+v"(vB[0]), "+v"(vB[1]), "+v"(vB2[0]), "+v"(vB2[1]));
              OrdOne S{u0}; EpiZ E{(const bf16_t*)(ws + WS_USSM), args.in[12], (bf16_t*)(ws + WS_ZG)};
              gemm_phase<EpiZ, OrdOne, true, true>(F.lds, g, vA, vB, S, E, GP_STAMP(26), vB2); }
        } else { ssm_side(args, F, 128); ST(44); p2_pooled(args, F, 128); }
        ST(5);
        if (BOTH(2)) xcd_barrier(bar);
    }
    if (IN(4)) { ST(8);
        if (F.bx < 128) {
            constexpr long GSTR = (long)MT * 32;
            GemmDesc g{(const char*)(ws + WS_ZG), (const char*)(ws + WS_WGLU), 256L * 32, 0, 256L * DSSM * 2, 0, 128L * 32, 128L * DSSM * 2, 4 * GSTR, 128, DSSM / BK};
            unsigned vA[2], vB[2]; voff_std(vB, DSSM, true);
#pragma unroll
            for (int i = 0; i < 2; ++i) { int R, C; stage_rc(F.tid * 16 + i * 8192, R, C); vA[i] = (unsigned)(R * 32 + (C >> 4) * (int)GSTR + (C & 15) * 2); }
            OrdGlu S{F.bx}; EpiGlu E{args.in[14], (const bf16_t*)(ws + WS_ZG), (bf16_t*)(ws + WS_YCAT), (float*)(ws + WS_SSSSM)};
            gemm_phase<EpiGlu, OrdGlu, true>(F.lds, g, vA, vB, S, E, GP_STAMP(28));
        } else {
            GemmDesc g{(const char*)(ws + WS_POOLED), (const char*)(ws + WS_PW), 256L * DPOOL * 2, 256L * 2, 256L * 256 * 2, 0, 128L * DPOOL * 2, 128L * 256 * 2, 128, 128, 256 / BK};
            unsigned vA[2], vB[2]; voff_std(vA, DPOOL, false); voff_std(vB, 256, true);
            OrdPool S{F.bx}; EpiPool E{args.in[4], (bf16_t*)(ws + WS_YCAT), (float*)(ws + WS_SSPOOL)};
            gemm_phase<EpiPool, OrdPool, true>(F.lds, g, vA, vB, S, E, GP_STAMP(36));

            __syncthreads();
            p4_side(args, F, 128);
        }
        ST(9);
        if (BOTH(4)) xcd_barrier(bar);
    }
    if (IN(5)) { ST(10);
        StaticOrder S; S.init(MT / BM, DM / BM, F.G, F.bx); Unit u0;
        LAS f32x2* XR = (LAS f32x2*)(F.lds + XTRA_OFF);
        if (S.next(0, u0)) {
            if (F.tid < 256) { const int row = u0.pm * BM + F.tid; const float* sp = (const float*)(ws + WS_SSPOOL); const float* sm = (const float*)(ws + WS_SSSSM); float a0 = 0.f, a1 = 0.f;
#pragma unroll
                for (int s = 0; s < 8; ++s) { a0 += sp[(size_t)s * MT + row]; a1 += sm[(size_t)s * MT + row]; }
                const float rp = rsqrtf(a0 * (1.0f / DPOOL) + EPS), rsm = rsqrtf(a1 * (1.0f / DSSM) + EPS); XR[F.tid] = (f32x2){rp / rsm, rsm}; }
        }
        __syncthreads();
        GemmDesc g{(const char*)(ws + WS_YCAT), (const char*)(ws + WS_WOUT), 256L * DM * 2, 0, 256L * DM * 2, 0, 128L * DM * 2, 128L * DM * 2, 128, 128, DM / BK};
        unsigned vA[2], vB[2]; voff_std(vA, DM, false); voff_std(vB, DM, false);
        EpiOut E{args.in[0], (bf16_t*)(ws + WS_H1B), (float*)(ws + WS_SSH1), XR, {{0.f, 0.f, 0.f, 0.f}, {0.f, 0.f, 0.f, 0.f}}};
        { const int wr_ = F.wave >> 2, fr_ = F.lane & 15;
#pragma unroll
          for (int ai = 0; ai < 2; ++ai)
#pragma unroll
              for (int m = 0; m < 4; ++m) E.ratio[ai][m] = XR[ai * HALF + wr_ * 64 + m * 16 + fr_].x; }
        gemm_phase<EpiOut, StaticOrder, false>(F.lds, g, vA, vB, S, E, GP_STAMP(30));
        ST(11);
        if (BOTH(5)) xcd_barrier(bar);
    }
    if (IN(6)) { ST(12);
        GemmDesc g{(const char*)(ws + WS_H1B), (const char*)(ws + WS_WUP), (long)UPROWS * DM * 2, (long)PADROWS * DM * 2, 256L * DM * 2, 0, 64L * DM * 2, 128L * DM * 2, 128, 128, DM / BK};
        unsigned vA[2], vB[2]; voff_std(vB, DM, true);
#pragma unroll
        for (int i = 0; i < 2; ++i) { int R, C; stage_rc(F.tid * 16 + i * 8192, R, C); vA[i] = (unsigned)(((126 * (R >> 6) + (R & 63)) * DM + C) * 2); }
        OrdUp S; S.so.init(BATCH * UPT, DFF2 / BM, F.G, F.bx);
        EpiUp E{(const float*)(ws + WS_SSH1), args.in[20], args.in[21], (bf16_t*)(ws + WS_ACT)};
        gemm_phase<EpiUp, OrdUp, true>(F.lds, g, vA, vB, S, E, GP_STAMP(32));
        ST(13);
        if (BOTH(6)) xcd_barrier(bar);
    }
    if (IN(7)) { ST(14);
        GemmDesc g{(const char*)(ws + WS_ACT), (const char*)(ws + WS_WDOWN), 256L * DFF * 2, 0, 256L * DFF * 2, 0, 128L * DFF * 2, 128L * DFF * 2, 128, 128, DFF / BK};
        unsigned vA[2], vB[2]; voff_std(vA, DFF, false); voff_std(vB, DFF, false);
        StaticOrder S; S.init(MT / BM, DM / BM, F.G, F.bx);
        EpiDown E{(const bf16_t*)(ws + WS_H1B), args.out, args.in[23], (float*)(ws + WS_SSH2), &bar};
        gemm_phase<EpiDown, StaticOrder, false>(F.lds, g, vA, vB, S, E, GP_STAMP(34)); ST(15);
    }
#undef IN
#undef BOTH
}
}

__global__ void k_cvt_u(const bf16_t* __restrict__ upool, const bf16_t* __restrict__ ussm, float* __restrict__ u) {
    const int idx = blockIdx.x * blockDim.x + threadIdx.x; if (idx >= MT * DM) return;
    const int c = idx % DM, row = idx / DM; unsigned short v;
    if (c < DPOOL) v = upool[(size_t)row * DPOOL + c];
    else { const int cs = c - DPOOL, g = cs >> 4, h = cs & 15, cr = row / mk::TCH, p = row % mk::TCH; v = ussm[((size_t)(g * mk::NCR + cr)) * mk::ROWLEN + 16 * p + h]; }
    u[idx] = __builtin_bit_cast(float, (unsigned)v << 16);
}
__global__ void k_cvt_z(const bf16_t* __restrict__ zg, float* __restrict__ z) {
    const int idx = blockIdx.x * blockDim.x + threadIdx.x; if (idx >= MT * DSSM) return;
    const int c = idx % DSSM, row = idx / DSSM; const unsigned short v = zg[((size_t)(c >> 4) * MT + row) * 16 + (c & 15)];
    z[idx] = __builtin_bit_cast(float, (unsigned)v << 16);
}
__global__ void k_cvt_rows(const bf16_t* __restrict__ src, int lds_, float* __restrict__ dst, int ldd, int cols, int rows) {
    const size_t idx = (size_t)blockIdx.x * blockDim.x + threadIdx.x; if (idx >= (size_t)rows * cols) return;
    const int c = (int)(idx % cols); const size_t row = idx / cols; dst[row * ldd + c] = __builtin_bit_cast(float, (unsigned)src[row * lds_ + c] << 16);
}

#if defined(MK_STAMP)
__device__ float stamp_sel(const unsigned long long* st, int ia, int ib, int b0, int b1, int mode) {
    double acc = mode == 1 ? 1e30 : 0.0;
    for (int b = b0; b < b1; ++b) { const double d = (double)(long long)(st[b * 64 + ib] - (ia < 0 ? 0ull : st[b * 64 + ia])) * 0.01;
        if (mode == 0) acc = d > acc ? d : acc; else if (mode == 1) acc = d < acc ? d : acc; else acc += d / (b1 - b0); }
    return (float)acc;
}
__global__ void k_stamp_report(const unsigned long long* st, float* out, int a_ia, int a_ib, int a_b0, int a_b1, int a_mode, float scale) {
    if (blockIdx.x == 0 && threadIdx.x == 0) out[0] += stamp_sel(st, a_ia, a_ib, a_b0, a_b1, a_mode) * scale;
}
#endif

#ifndef MK_CUT
#define MK_CUT 8
#endif
static void gemm(hipStream_t s, const float* A, int lda, const float* B, int ldb, float* C, int ldc, const float* R, int ldr, int M, int N, int K) {
    hipLaunchKernelGGL(k_gemm, dim3(N / 128, M / 128), dim3(256), 0, s, A, lda, B, ldb, C, ldc, R, ldr, K);
}

extern "C" void kernel_launch(void* const* d_in, const int* in_sizes, int n_in, void* d_out, int out_size, void* d_ws, size_t ws_size, hipStream_t stream) {
    static int grid = 0;
    if (grid == 0) {
        int dev = 0, cus = 0, per_cu = 0;
        if (n_in != 24 || out_size != MT * DM || ws_size < mk::WS_END) { fprintf(stderr, "kernel_launch: unexpected problem (n_in %d out %d ws %zu)\n", n_in, out_size, ws_size); grid = -1; return; }
        if (hipGetDevice(&dev) != hipSuccess || hipDeviceGetAttribute(&cus, hipDeviceAttributeMultiprocessorCount, dev) != hipSuccess) { grid = -1; return; }
        if (hipFuncSetAttribute((const void*)mk::mk_fwd, hipFuncAttributeMaxDynamicSharedMemorySize, mk::LDS_BYTES) != hipSuccess) { fprintf(stderr, "kernel_launch: hipFuncSetAttribute failed\n"); grid = -1; return; }
        if (hipOccupancyMaxActiveBlocksPerMultiprocessor(&per_cu, (const void*)mk::mk_fwd, 512, mk::LDS_BYTES) != hipSuccess || per_cu < 1) { fprintf(stderr, "kernel_launch: occupancy query says %d blocks/CU\n", per_cu); }
        (void)hipGetLastError();
        grid = cus;
        if (grid != 256) { fprintf(stderr, "kernel_launch: built for a 256-CU device, found %d CUs\n", cus); grid = -1; return; }
    }
    if (grid < 0) return;
    const float* x = (const float*)d_in[0];
    const float* pool_w = (const float*)d_in[3];   const float* pool_scale = (const float*)d_in[4];
    const float* lnar = (const float*)d_in[5];     const float* aim = (const float*)d_in[6];   const float* ldt = (const float*)d_in[7];
    const float* bre = (const float*)d_in[8];      const float* bim = (const float*)d_in[9];
    const float* cre = (const float*)d_in[10];     const float* cim = (const float*)d_in[11];
    const float* ssm_d = (const float*)d_in[12];   const float* glu_w = (const float*)d_in[13]; const float* glu_b = (const float*)d_in[14];
    const float* g_pool = (const float*)d_in[15];  const float* g_ssm = (const float*)d_in[16];
    const float* w_out = (const float*)d_in[17];   const float* g_ffn = (const float*)d_in[18];
    const float* w_up = (const float*)d_in[19];    const float* conv_w = (const float*)d_in[20]; const float* conv_b = (const float*)d_in[21];
    const float* w_down = (const float*)d_in[22];  const float* g_final = (const float*)d_in[23];
    float* out = (float*)d_out; char* ws = (char*)d_ws; const size_t MiB = 1u << 20; const int EB = 256;
    (void)x; (void)pool_w; (void)pool_scale; (void)lnar; (void)aim; (void)ldt; (void)bre; (void)bim; (void)cre; (void)cim; (void)ssm_d; (void)glu_w; (void)glu_b; (void)g_pool; (void)g_ssm; (void)w_out; (void)g_ffn; (void)w_up; (void)conv_w; (void)conv_b; (void)w_down; (void)g_final;

    (void)hipMemsetAsync(ws + mk::WS_CTL, 0, mk::CTL_ZERO_BYTES, stream);
    mk::Args a{};
    for (int i = 0; i < 24; ++i) a.in[i] = (const float*)d_in[i];
    a.out = out; a.ws = (unsigned char*)d_ws; a.ph_lo = 0; a.ph_hi = MK_CUT;
#if defined(MK_PROBE_LO)
    a.ph_lo = 0; a.ph_hi = MK_PROBE_HI; hipLaunchKernelGGL(mk::mk_fwd, dim3(grid), dim3(512), mk::LDS_BYTES, stream, a);
    for (int r = 0; r < MK_PROBE_REP; ++r) { (void)hipMemsetAsync(ws + mk::WS_CTL, 0, mk::CTL_ZERO_BYTES, stream); a.ph_lo = MK_PROBE_LO; a.ph_hi = MK_PROBE_HI; hipLaunchKernelGGL(mk::mk_fwd, dim3(grid), dim3(512), mk::LDS_BYTES, stream, a); }
    (void)hipMemsetAsync(ws + mk::WS_CTL, 0, mk::CTL_ZERO_BYTES, stream);
    a.ph_lo = MK_PROBE_HI; a.ph_hi = 8; hipLaunchKernelGGL(mk::mk_fwd, dim3(grid), dim3(512), mk::LDS_BYTES, stream, a);
#else
    hipLaunchKernelGGL(mk::mk_fwd, dim3(grid), dim3(512), mk::LDS_BYTES, stream, a);
#endif
#if defined(MK_STAMP)
    hipLaunchKernelGGL(k_stamp_report, dim3(1), dim3(64), 0, stream, (const unsigned long long*)(ws + mk::WS_STAMP), out, MK_STAMP_A);
#endif
#if MK_CUT < 8
    float* bufA = (float*)(ws + 0 * MiB); float* bufB = (float*)(ws + 64 * MiB); float* bufC = (float*)(ws + 128 * MiB); float* bufD = (float*)(ws + 192 * MiB);
    float* pooled = bufA; float* ypool = bufA + (size_t)MT * DPOOL; float* z = pooled; float* pre = bufD; float* ycat = bufB;
#if MK_CUT <= 2
    float* u = bufB;
    hipLaunchKernelGGL(k_cvt_u, dim3(MT * DM / EB), dim3(EB), 0, stream, (const bf16_t*)(ws + mk::WS_UPOOL), (const bf16_t*)(ws + mk::WS_USSM), u);
    hipLaunchKernelGGL(k_pool, dim3(MT * DPOOL / EB), dim3(EB), 0, stream, u, pooled);
    for (int gi = 0; gi < 4; ++gi) gemm(stream, pooled + gi * 128, DPOOL, pool_w + (size_t)gi * 128 * 128, 128, ypool + gi * 128, DPOOL, nullptr, 0, MT, 128, 128);
    float* y2 = bufC;
    hipLaunchKernelGGL(k_ssm_scan, dim3(2 * BATCH * NG), dim3(64), 0, stream, u, lnar, aim, ldt, bre, bim, cre, cim, y2);
    hipLaunchKernelGGL(k_ssm_post, dim3(MT * DSSM / EB), dim3(EB), 0, stream, y2, u, ssm_d, z);
    const float* pre_scale = pool_scale;
#elif MK_CUT <= 4
    hipLaunchKernelGGL(k_cvt_z, dim3(MT * DSSM / EB), dim3(EB), 0, stream, (const bf16_t*)(ws + mk::WS_ZG), z);
    hipLaunchKernelGGL(k_cvt_rows, dim3(MT * DPOOL / EB), dim3(EB), 0, stream, (const bf16_t*)(ws + mk::WS_YCAT), DM, ypool, DPOOL, DPOOL, MT);
    const float* pre_scale = nullptr;
#endif
#if MK_CUT <= 4
    gemm(stream, z, DSSM, glu_w, DSSM, pre, DSSM, nullptr, 0, MT, DSSM, DSSM);
    hipLaunchKernelGGL(k_glu, dim3(MT * DSSM / EB), dim3(EB), 0, stream, z, pre, glu_b);
#elif MK_CUT == 5
    hipLaunchKernelGGL(k_cvt_rows, dim3(MT * DPOOL / EB), dim3(EB), 0, stream, (const bf16_t*)(ws + mk::WS_YCAT), DM, ypool, DPOOL, DPOOL, MT);
    hipLaunchKernelGGL(k_cvt_rows, dim3(MT * DSSM / EB), dim3(EB), 0, stream, (const bf16_t*)(ws + mk::WS_YCAT) + DPOOL, DM, pre, DSSM, DSSM, MT);
    const float* pre_scale = nullptr;
#endif
#if MK_CUT <= 5
    hipLaunchKernelGGL(k_rmsnorm, dim3(MT / 4), dim3(256), 0, stream, ypool, DPOOL, pre_scale, g_pool, ycat, DM, DPOOL, MT);
    hipLaunchKernelGGL(k_rmsnorm, dim3(MT / 4), dim3(256), 0, stream, pre, DSSM, (const float*)nullptr, g_ssm, ycat + DPOOL, DM, DSSM, MT);
    gemm(stream, ycat, DM, w_out, DM, out, DM, x, DM, MT, DM, DM);
#endif
#if MK_CUT <= 6
    float* xn2 = bufA;
    hipLaunchKernelGGL(k_rmsnorm, dim3(MT / 4), dim3(256), 0, stream, out, DM, (const float*)nullptr, g_ffn, xn2, DM, DM, MT);
    float* up = (float*)(ws + 64 * MiB); float* act = (float*)(ws + 152 * MiB);
    for (int b = 0; b < BATCH; ++b) {
        gemm(stream, xn2 + (size_t)b * SEQ * DM, DM, w_up, DFF2, up, DFF2, nullptr, 0, SEQ, DFF2, DM);
        hipLaunchKernelGGL(k_convact, dim3(SEQ * DFF / EB), dim3(EB), 0, stream, up, conv_w, conv_b, act);
        gemm(stream, act, DFF, w_down, DM, out + (size_t)b * SEQ * DM, DM, out + (size_t)b * SEQ * DM, DM, SEQ, DM, DFF);
    }
#else
    float* actf = (float*)(ws + 0 * MiB);
    for (int b = 0; b < BATCH; ++b) {
        hipLaunchKernelGGL(k_cvt_rows, dim3(SEQ * DFF / EB), dim3(EB), 0, stream, (const bf16_t*)(ws + mk::WS_ACT) + (size_t)b * SEQ * DFF, DFF, actf, DFF, DFF, SEQ);
        gemm(stream, actf, DFF, w_down, DM, out + (size_t)b * SEQ * DM, DM, out + (size_t)b * SEQ * DM, DM, SEQ, DM, DFF);
    }
#endif
    hipLaunchKernelGGL(k_rmsnorm, dim3(MT / 4), dim3(256), 0, stream, out, DM, (const float*)nullptr, g_final, out, DM, DM, MT);
    (void)bufC;
#endif
}
```

```cpp
#define MK_CUT 8
#include <hip/hip_runtime.h>
#include <math.h>

constexpr int BATCH = 4, SEQ = 4096, DM = 1024, MT = BATCH * SEQ;
constexpr int DPOOL = 512, DSSM = 512, NG = 32, NH = 16, NS = 64;
constexpr int DFF = 2816, DFF2 = 5632;
constexpr float EPS = 1e-6f;

__global__ void k_rmsnorm(const float* x, int ldx, const float* __restrict__ pre,
                          const float* __restrict__ g, float* out, int ldo, int D, int rows) {
    const int wave = (blockIdx.x * blockDim.x + threadIdx.x) >> 6, lane = threadIdx.x & 63;
    if (wave >= rows) return;
    const float* xr = x + (size_t)wave * ldx;
    float ss = 0.f;
    for (int c = lane; c < D; c += 64) { float v = xr[c]; if (pre) v *= pre[c]; ss += v * v; }
    for (int o = 32; o; o >>= 1) ss += __shfl_xor(ss, o);
    const float inv = rsqrtf(ss / (float)D + EPS);
    float* orow = out + (size_t)wave * ldo;
    for (int c = lane; c < D; c += 64) { float v = xr[c]; if (pre) v *= pre[c]; orow[c] = v * inv * g[c]; }
}

__global__ void __launch_bounds__(256) k_gemm(const float* __restrict__ A, int lda, const float* __restrict__ B, int ldb,
                                               float* C, int ldc, const float* R, int ldr, int K) {
    __shared__ float As[16][132];
    __shared__ float Bs[16][132];
    const int tid = threadIdx.x, tx = tid & 15, ty = tid >> 4;
    const int row0 = blockIdx.y * 128, col0 = blockIdx.x * 128;
    float acc[8][8];
#pragma unroll
    for (int i = 0; i < 8; ++i)
#pragma unroll
        for (int j = 0; j < 8; ++j) acc[i][j] = 0.f;
    for (int k0 = 0; k0 < K; k0 += 16) {
#pragma unroll
        for (int p = 0; p < 2; ++p) {
            const int i = tid + p * 256, r = i >> 2, kk = (i & 3) * 4;
            const float4 v = *(const float4*)(A + (size_t)(row0 + r) * lda + k0 + kk);
            As[kk + 0][r] = v.x; As[kk + 1][r] = v.y; As[kk + 2][r] = v.z; As[kk + 3][r] = v.w;
        }
#pragma unroll
        for (int p = 0; p < 2; ++p) {
            const int i = tid + p * 256, kk = i >> 5, c = (i & 31) * 4;
            const float4 v = *(const float4*)(B + (size_t)(k0 + kk) * ldb + col0 + c);
            *(float4*)&Bs[kk][c] = v;
        }
        __syncthreads();
#pragma unroll
        for (int kk = 0; kk < 16; ++kk) {
            float a[8], b[8];
            const float4 a0 = *(const float4*)&As[kk][ty * 4], a1 = *(const float4*)&As[kk][64 + ty * 4];
            const float4 b0 = *(const float4*)&Bs[kk][tx * 4], b1 = *(const float4*)&Bs[kk][64 + tx * 4];
            a[0] = a0.x; a[1] = a0.y; a[2] = a0.z; a[3] = a0.w; a[4] = a1.x; a[5] = a1.y; a[6] = a1.z; a[7] = a1.w;
            b[0] = b0.x; b[1] = b0.y; b[2] = b0.z; b[3] = b0.w; b[4] = b1.x; b[5] = b1.y; b[6] = b1.z; b[7] = b1.w;
#pragma unroll
            for (int i = 0; i < 8; ++i)
#pragma unroll
                for (int j = 0; j < 8; ++j) acc[i][j] = fmaf(a[i], b[j], acc[i][j]);
        }
        __syncthreads();
    }
#pragma unroll
    for (int i = 0; i < 8; ++i) {
        const int r = row0 + (i < 4 ? ty * 4 + i : 64 + ty * 4 + (i - 4));
#pragma unroll
        for (int jh = 0; jh < 2; ++jh) {
            const int c = col0 + jh * 64 + tx * 4;
            float4 v = make_float4(acc[i][jh * 4 + 0], acc[i][jh * 4 + 1], acc[i][jh * 4 + 2], acc[i][jh * 4 + 3]);
            if (R) { const float4 rr = *(const float4*)(R + (size_t)r * ldr + c); v.x += rr.x; v.y += rr.y; v.z += rr.z; v.w += rr.w; }
            *(float4*)(C + (size_t)r * ldc + c) = v;
        }
    }
}

__global__ void k_pool(const float* __restrict__ u  , float* __restrict__ pooled  ) {
    const int idx = blockIdx.x * blockDim.x + threadIdx.x;
    if (idx >= MT * DPOOL) return;
    const int c = idx % DPOOL, row = idx / DPOOL, b = row / SEQ, t = row % SEQ;
    const int gi = c / 128, w = 2 << gi, half = w / 2;
    int lo = t - half, hi = t + half; if (lo < 0) lo = 0; if (hi > SEQ) hi = SEQ;
    float s = 0.f;
    for (int q = lo; q < hi; ++q) s += u[(size_t)(b * SEQ + q) * DM + c];
    pooled[idx] = s / (float)(hi - lo) - u[(size_t)row * DM + c];
}

__global__ void __launch_bounds__(64) k_ssm_scan(const float* __restrict__ u  ,
        const float* __restrict__ lnar, const float* __restrict__ aim, const float* __restrict__ ldt,
        const float* __restrict__ bre, const float* __restrict__ bim, const float* __restrict__ cre, const float* __restrict__ cim,
        float* __restrict__ y  ) {
    const int n = threadIdx.x;
    const int g = blockIdx.x % NG, b = (blockIdx.x / NG) % BATCH, dir = blockIdx.x / (NG * BATCH);
    const float dt = expf(ldt[dir * NG + g]);
    const float a_re = -expf(lnar[(dir * NG + g) * NS + n]), a_im = aim[(dir * NG + g) * NS + n];
    const float mag = expf(a_re * dt), ang = a_im * dt;
    const float lam_re = mag * cosf(ang), lam_im = mag * sinf(ang);
    const float den = a_re * a_re + a_im * a_im;
    const float f_re = ((lam_re - 1.0f) * a_re + lam_im * a_im) / den;
    const float f_im = (lam_im * a_re - (lam_re - 1.0f) * a_im) / den;
    float Br[NH], Bi[NH], Cr[NH], Ci[NH];
#pragma unroll
    for (int h = 0; h < NH; ++h) {
        Br[h] = bre[((size_t)(dir * NG + g) * NS + n) * NH + h];
        Bi[h] = bim[((size_t)(dir * NG + g) * NS + n) * NH + h];
        Cr[h] = cre[((size_t)(dir * NG + g) * NH + h) * NS + n];
        Ci[h] = cim[((size_t)(dir * NG + g) * NH + h) * NS + n];
    }
    float s_re = 0.f, s_im = 0.f;
    float* yd = y + (size_t)dir * MT * DSSM;
    for (int i = 0; i < SEQ; ++i) {
        const int t = dir ? (SEQ - 1 - i) : i;
        const float* ur = u + (size_t)(b * SEQ + t) * DM + DPOOL + g * NH;
        float bu_re = 0.f, bu_im = 0.f;
#pragma unroll
        for (int h = 0; h < NH; ++h) { const float uv = ur[h]; bu_re = fmaf(Br[h], uv, bu_re); bu_im = fmaf(Bi[h], uv, bu_im); }
        const float in_re = f_re * bu_re - f_im * bu_im, in_im = f_re * bu_im + f_im * bu_re;
        const float nr = lam_re * s_re - lam_im * s_im + in_re;
        const float ni = lam_re * s_im + lam_im * s_re + in_im;
        s_re = nr; s_im = ni;
        float mine = 0.f;
#pragma unroll
        for (int h = 0; h < NH; ++h) {
            float p = Cr[h] * s_re - Ci[h] * s_im;
#pragma unroll
            for (int o = 32; o; o >>= 1) p += __shfl_xor(p, o);
            if (n == h) mine = p;
        }
        if (n < NH) yd[(size_t)(b * SEQ + t) * DSSM + g * NH + n] = mine;
    }
}

__device__ __forceinline__ float gelu_tanh(float x) {
    const float k = 0.7978845608028654f;
    return 0.5f * x * (1.0f + tanhf(k * (x + 0.044715f * x * x * x)));
}
__device__ __forceinline__ float sigmoidf_(float x) { return 1.0f / (1.0f + expf(-x)); }

__global__ void k_ssm_post(const float* __restrict__ y2, const float* __restrict__ u, const float* __restrict__ d, float* __restrict__ z) {
    const int idx = blockIdx.x * blockDim.x + threadIdx.x;
    if (idx >= MT * DSSM) return;
    const int c = idx % DSSM, row = idx / DSSM;
    const float yv = y2[idx] + y2[(size_t)MT * DSSM + idx] + d[c] * u[(size_t)row * DM + DPOOL + c];
    z[idx] = gelu_tanh(yv);
}
__global__ void k_glu(const float* __restrict__ z, float* __restrict__ pre, const float* __restrict__ gb) {
    const int idx = blockIdx.x * blockDim.x + threadIdx.x;
    if (idx >= MT * DSSM) return;
    const int c = idx % DSSM;
    pre[idx] = z[idx] * sigmoidf_(pre[idx] + gb[c]);
}
__global__ void k_convact(const float* __restrict__ up  , const float* __restrict__ cw, const float* __restrict__ cb, float* __restrict__ act  ) {
    const int idx = blockIdx.x * blockDim.x + threadIdx.x;
    if (idx >= SEQ * DFF) return;
    const int f = idx % DFF, t = idx / DFF;
    float v = cb[f], gt = cb[DFF + f];
#pragma unroll
    for (int k = 0; k < 3; ++k) {
        const int q = t + k - 1;
        if (q >= 0 && q < SEQ) {
            v = fmaf(up[(size_t)q * DFF2 + f], cw[k * DFF2 + f], v);
            gt = fmaf(up[(size_t)q * DFF2 + DFF + f], cw[k * DFF2 + DFF + f], gt);
        }
    }
    act[idx] = v * (gt * sigmoidf_(gt));
}


#include <cstdio>
#include <cstdint>
#define LAS __attribute__((address_space(3)))
#define GAS __attribute__((address_space(1)))
typedef unsigned short bf16_t;
typedef short bf16x8 __attribute__((ext_vector_type(8)));
typedef float f32x4 __attribute__((ext_vector_type(4)));
typedef float f32x2 __attribute__((ext_vector_type(2)));
typedef unsigned u32x4 __attribute__((ext_vector_type(4)));
typedef unsigned u32x2 __attribute__((ext_vector_type(2)));

namespace mk {
constexpr int TCH = 32;
constexpr int K1 = 16 * TCH;
constexpr int ROWLEN = K1 + 256;
constexpr int NCR = MT / TCH;
constexpr int NCHB = SEQ / TCH;
constexpr int PADROWS = 4352;
constexpr int UPT = 17;
constexpr int UPROWS = 252;

constexpr size_t MiB = 1u << 20;
constexpr size_t WS_CTL = 0, CTL_ZERO_BYTES = 64 * 1024;
constexpr int CW_TBCNT = 4096;
constexpr size_t WS_R0 = 1 * MiB;
constexpr size_t WS_SSPOOL = 2 * MiB;
constexpr size_t WS_SSSSM = WS_SSPOOL + 8 * MT * 4;
constexpr size_t WS_SSH1 = WS_SSSSM + 8 * MT * 4;
constexpr size_t WS_SSH2 = WS_SSH1 + 4 * MT * 4;
constexpr size_t WS_WIN = 8 * MiB, WS_WOUT = 10 * MiB, WS_WGLU = 12 * MiB, WS_PW = 12 * MiB + 512 * 1024;
constexpr size_t WS_WUP = 13 * MiB, WS_WDOWN = 24 * MiB;
constexpr size_t WS_WAB = 30 * MiB;
constexpr size_t WS_TB = 38 * MiB;
constexpr size_t WS_TBC = 40 * MiB;
constexpr size_t WS_H1B = 62 * MiB;
constexpr size_t WS_XB = 96 * MiB;
constexpr size_t WS_YCAT = 96 * MiB;
constexpr size_t WS_UPOOL = 128 * MiB;
constexpr size_t WS_USSM = 144 * MiB;
constexpr size_t WS_FG = 168 * MiB;
constexpr size_t WS_POOLED = 184 * MiB;
constexpr size_t WS_ZG = 200 * MiB;
constexpr size_t WS_ACT = 96 * MiB;
constexpr size_t WS_END = 216 * MiB;

constexpr int RING_BYTES = 131072, XTRA_OFF = RING_BYTES, XTRA_BYTES = 12288, LDSCTL_OFF = XTRA_OFF + XTRA_BYTES, LDS_BYTES = 147456;

__device__ __forceinline__ unsigned f2bf(float f) { unsigned u = __builtin_bit_cast(unsigned, f); return (u + 0x7fffu + ((u >> 16) & 1u)) >> 16; }
__device__ __forceinline__ unsigned pk2(float lo, float hi) { return f2bf(lo) | (f2bf(hi) << 16); }
__device__ __forceinline__ unsigned cvt_pk_bf16(float lo, float hi) { unsigned r; asm volatile("v_cvt_pk_bf16_f32 %0, %1, %2" : "=v"(r) : "v"(lo), "v"(hi)); return r; }
__device__ __forceinline__ u32x4 pack8(f32x4 a, f32x4 b) { u32x4 w; w.x = cvt_pk_bf16(a[0], a[1]); w.y = cvt_pk_bf16(a[2], a[3]); w.z = cvt_pk_bf16(b[0], b[1]); w.w = cvt_pk_bf16(b[2], b[3]); return w; }
__device__ __forceinline__ u32x2 pack4(f32x4 a) { u32x2 w; w.x = cvt_pk_bf16(a[0], a[1]); w.y = cvt_pk_bf16(a[2], a[3]); return w; }
__device__ __forceinline__ float bflo(unsigned w) { return __builtin_bit_cast(float, w << 16); }
__device__ __forceinline__ float bfhi(unsigned w) { return __builtin_bit_cast(float, w & 0xffff0000u); }
__device__ __forceinline__ void unpack8(u32x4 w, f32x4& a, f32x4& b) { a[0] = bflo(w.x); a[1] = bfhi(w.x); a[2] = bflo(w.y); a[3] = bfhi(w.y); b[0] = bflo(w.z); b[1] = bfhi(w.z); b[2] = bflo(w.w); b[3] = bfhi(w.w); }
__device__ __forceinline__ float fast_sigmoid(float x) { return __builtin_amdgcn_rcpf(1.0f + __builtin_amdgcn_exp2f(-1.4426950408889634f * x)); }
__device__ __forceinline__ float fast_gelu_tanh(float x) {
    const float t = x * (1.0f + 0.044715f * x * x);
    return x * __builtin_amdgcn_rcpf(1.0f + __builtin_amdgcn_exp2f(-2.0f * 0.7978845608028654f * 1.4426950408889634f * t));
}
__device__ __forceinline__ float wave_sum(float v) {
#pragma unroll
    for (int o = 1; o < 64; o <<= 1) v += __shfl_xor(v, o);
    return v;
}
__device__ __forceinline__ float dpp_ror1(float v)  { return __builtin_bit_cast(float, __builtin_amdgcn_update_dpp(0, __builtin_bit_cast(int, v), 0x121, 0xf, 0xf, false)); }
__device__ __forceinline__ float dpp_ror15(float v) { return __builtin_bit_cast(float, __builtin_amdgcn_update_dpp(0, __builtin_bit_cast(int, v), 0x12F, 0xf, 0xf, false)); }
__device__ __forceinline__ int lane_id_fresh() { int l; asm volatile("v_mbcnt_lo_u32_b32 %0, -1, 0\n\tv_mbcnt_hi_u32_b32 %0, -1, %0" : "=v"(l)); return l; }
#define LDS_WAIT() asm volatile("s_waitcnt lgkmcnt(0)" ::: "memory")
#define VM_WAIT() asm volatile("s_waitcnt vmcnt(0)" ::: "memory")

#define XB_TMO      128
#define XB_XCNT(j)  (256  + 64 * (j))
#define XB_XSUB(j)  (1280 + 64 * (j))
#define XB_XGEN(j)  (2304 + 64 * (j))
#define XB_TOP      3328
#define XB_TOPGEN   3392
#define XCD_BAR_WORDS 3456
#define XB_SPIN_CAP (1u << 18)
__device__ __forceinline__ unsigned xb_ld(unsigned* p)              { return __hip_atomic_load(p, __ATOMIC_RELAXED, __HIP_MEMORY_SCOPE_AGENT); }
__device__ __forceinline__ unsigned xb_add(unsigned* p, unsigned v) { return __hip_atomic_fetch_add(p, v, __ATOMIC_RELAXED, __HIP_MEMORY_SCOPE_AGENT); }
__device__ __forceinline__ unsigned xb_xcc_id() { return (unsigned)__builtin_amdgcn_s_getreg((3 << 11) | 20) & 0xFu; }
#define XB_SPIN(cond, bar) do { unsigned _sp = 0; while (cond) { __builtin_amdgcn_s_sleep(1); \
    if ((++_sp & 255u) == 0u) { if (xb_ld(&(bar)[XB_TMO])) break; if (_sp > XB_SPIN_CAP) { atomicAdd(&(bar)[XB_TMO], 1u); break; } } } } while (0)
struct XcdBarrier { unsigned* bar; unsigned x; volatile LAS unsigned* st; };
__device__ __forceinline__ XcdBarrier xcd_barrier_post(unsigned* bar, volatile LAS unsigned* st) {
    XcdBarrier b; b.bar = bar; b.x = xb_xcc_id(); b.st = st;
    if (threadIdx.x == 0) (void)xb_add(&bar[XB_XCNT(b.x)], 1u);
    return b;
}
__device__ __forceinline__ void xcd_barrier_complete(unsigned* bar, unsigned x, unsigned& nloc, unsigned& nx) {
    const unsigned G = gridDim.x * gridDim.y * gridDim.z;
    unsigned sum, cnt, mine, sp = 0u;
    for (;;) {
        sum = 0u; cnt = 0u; mine = 0u;
#pragma unroll
        for (unsigned j = 0; j < 16; ++j) { const unsigned c = xb_ld(&bar[XB_XCNT(j)]); sum += c; cnt += (c > 0u) ? 1u : 0u; mine = (j == x) ? c : mine; }
        if (sum == G) break;
        __builtin_amdgcn_s_sleep(1);
        if ((++sp & 255u) == 0u) { if (xb_ld(&bar[XB_TMO])) break; if (sp > XB_SPIN_CAP) { atomicAdd(&bar[XB_TMO], 1u); break; } }
    }
    nloc = mine > 0u ? mine : 1u; nx = cnt > 0u ? cnt : 1u;
}
__device__ __forceinline__ void xcd_barrier(const XcdBarrier& b, int tid) {
    asm volatile("s_waitcnt vmcnt(0)" ::: "memory");
    __syncthreads();
    if (tid == 0) {
        unsigned* bar = b.bar;
        __builtin_amdgcn_s_waitcnt(0);
        unsigned nloc = b.st[0], nx = b.st[1];
        if (nloc == 0u) { xcd_barrier_complete(bar, b.x, nloc, nx); b.st[0] = nloc; b.st[1] = nx; }
        const unsigned old = xb_add(&bar[XB_XSUB(b.x)], 1u);
        const unsigned gen = old / nloc;
        if (old + 1u == (gen + 1u) * nloc) {
            __builtin_amdgcn_fence(__ATOMIC_RELEASE, "agent");
            asm volatile("s_waitcnt vmcnt(0)" ::: "memory");
            const unsigned og = xb_add(&bar[XB_TOP], 1u);
            const unsigned tg = og / nx;
            if (og + 1u == (tg + 1u) * nx) xb_add(&bar[XB_TOPGEN], 1u);
            else XB_SPIN(xb_ld(&bar[XB_TOPGEN]) == tg, bar);
            __builtin_amdgcn_fence(__ATOMIC_ACQUIRE, "agent");
            xb_add(&bar[XB_XGEN(b.x)], 1u);
            asm volatile("s_waitcnt vmcnt(0)" ::: "memory");
        } else {
            XB_SPIN(xb_ld(&bar[XB_XGEN(b.x)]) == gen, bar);
            __builtin_amdgcn_fence(__ATOMIC_ACQUIRE, "agent");
            asm volatile("s_waitcnt vmcnt(0)" ::: "memory");
        }
    }
    __syncthreads();
}

constexpr int BM = 256, BK = 64, HALF = 128, HTB = HALF * BK * 2, STAGE_BYTES = 8 * HTB, NXCD = 8, WGM = 8;
__host__ __device__ __forceinline__ int lds_byte(int r, int c) { const int st = (r >> 4) * 2 + (c >> 5), rr = r & 15, cc = c & 31, ob = rr * 64 + cc * 2; return st * 1024 + (ob ^ (((ob >> 9) & 1) << 5)); }
__host__ __device__ __forceinline__ void stage_rc(int b, int& R, int& C) { const int st = b / 1024, sb = b % 1024, swz = sb ^ (((sb >> 9) & 1) << 5); R = (st >> 1) * 16 + swz / 64; C = (st & 1) * 32 + (swz % 64) / 2; }
__host__ __device__ __forceinline__ int perm32(int rho) { const int n = rho >> 4, i = rho & 15; return 8 * (i >> 2) + 4 * n + (i & 3); }

struct Unit { int pm, pn, g; };
struct GemmDesc { const char* A; const char* B; long a_pm, a_g, b_pn, b_g, a_h, b_h, a_k, b_k; int nt;
                  const char* B2; long b2_pn, b2_g, b2_h, b2_k; int tsw; };

struct StaticOrder {
    int nM, nN, nwg, G, c;
    __device__ void init(int nM_, int nN_, int G_, int c_) { nM = nM_; nN = nN_; nwg = nM * nN; G = G_; c = c_; }
    __device__ bool next(int i, Unit& u) const {
        const long L = (long)i * G + c; if (L >= nwg) return false;
        int wgid = (int)L; { const int q = nwg / NXCD, r = nwg % NXCD, xcd = wgid % NXCD, off = wgid / NXCD; wgid = (xcd < r ? xcd * (q + 1) : r * (q + 1) + (xcd - r) * q) + off; }
        const int nig = WGM * nN, gid = wgid / nig, fm = gid * WGM, gsz = (nM - fm) < WGM ? (nM - fm) : WGM;
        u.pm = fm + ((wgid % nig) % gsz); u.pn = (wgid % nig) / gsz; u.g = 0; return true;
    }
};

template <class Epi, class Sched, bool ALIGN_EPI, bool SEG2 = false>
__device__ __forceinline__ void gemm_phase(LAS unsigned char* lds, const GemmDesc g, const unsigned (&voffA)[2], const unsigned (&voffB)[2], const Sched& S, Epi& E, int tid, unsigned long long* stp = nullptr, const unsigned* voffB2 = nullptr) {
    const int wid = __builtin_amdgcn_readfirstlane(tid >> 6), lane = tid & 63, wr = wid >> 2, wc = wid & 3, fr = lane & 15, fq = lane >> 4;
    const int nt = g.nt;
    const long kstepA = g.a_k, kstepB = g.b_k, hstepA = g.a_h, hstepB = g.b_h;
    const unsigned ldsw = (unsigned)wid * 1024u;
    const int aoff = lds_byte(wr * 64 + fr, fq * 8), boff = lds_byte(wc * 32 + fr, fq * 8);
#define PG8_SA(b, h) (((b) * 2 + (h)) * HTB)
#define PG8_SB(b, h) ((4 + (b) * 2 + (h)) * HTB)
#define PG8_STAGE(bufoff, gbase, voff) do { const char* _gb = (const char*)(gbase); asm volatile("" : "+s"(_gb));   _Pragma("unroll") for (int _i = 0; _i < 2; ++_i) \
        __builtin_amdgcn_global_load_lds((const unsigned*)(_gb + (voff)[_i]), (LAS unsigned*)(lds + (bufoff) + ldsw + _i * 8192), 16, 0, 0); } while (0)
#define PG8_LDA(dst, b, h) do { _Pragma("unroll") for (int m = 0; m < 4; ++m) _Pragma("unroll") for (int k = 0; k < 2; ++k) dst[m][k] = *(const LAS bf16x8*)(lds + PG8_SA(b, h) + aoff + m * 2048 + k * 1024); } while (0)
#define PG8_LDB(dst, b, h) do { _Pragma("unroll") for (int n = 0; n < 2; ++n) _Pragma("unroll") for (int k = 0; k < 2; ++k) dst[n][k] = *(const LAS bf16x8*)(lds + PG8_SB(b, h) + boff + n * 2048 + k * 1024); } while (0)
#define PG8_MMA(ai, bj, At, Bt) do { __builtin_amdgcn_s_setprio(1); _Pragma("unroll") for (int m = 0; m < 4; ++m) _Pragma("unroll") for (int n = 0; n < 2; ++n) _Pragma("unroll") for (int k = 0; k < 2; ++k) \
        acc[ai][bj][m][n] = __builtin_amdgcn_mfma_f32_16x16x32_bf16(Bt[n][k], At[m][k], acc[ai][bj][m][n], 0, 0, 0); __builtin_amdgcn_s_setprio(0); } while (0)
#define PG8_WAIT_V(n) asm volatile("s_waitcnt vmcnt(" #n ")" ::: "memory")
#define PG8_WAIT_L(n) asm volatile("s_waitcnt lgkmcnt(" #n ")" ::: "memory")
#define PG8_BAR __builtin_amdgcn_s_barrier()
#define PG8_SCHED __builtin_amdgcn_sched_barrier(0)
    Unit cur, nxt; int ui = 0;
    if (!S.next(0, cur)) return;
    f32x4 acc[2][2][4][2];
#pragma unroll
    for (int a = 0; a < 2; ++a)
#pragma unroll
        for (int b = 0; b < 2; ++b)
#pragma unroll
            for (int m = 0; m < 4; ++m)
#pragma unroll
                for (int n = 0; n < 2; ++n) acc[a][b][m][n] = (f32x4){0.f, 0.f, 0.f, 0.f};
    bf16x8 At[4][2], B0[2][2], B1[2][2];
    const char* cA = g.A + (long)cur.pm * g.a_pm + (long)cur.g * g.a_g; const char* cB = g.B + (long)cur.pn * g.b_pn + (long)cur.g * g.b_g;
    const char* cB2 = SEG2 ? g.B2 + (long)cur.pn * g.b2_pn + (long)cur.g * g.b2_g : nullptr;
    PG8_STAGE(PG8_SB(0, 0), cB, voffB); PG8_STAGE(PG8_SB(0, 1), cB + hstepB, voffB); PG8_STAGE(PG8_SA(0, 0), cA, voffA); PG8_STAGE(PG8_SA(0, 1), cA + hstepA, voffA);
    if (wr == 1) PG8_BAR;
    PG8_WAIT_V(2); PG8_BAR;
    PG8_STAGE(PG8_SB(1, 0), cB + kstepB, voffB); PG8_STAGE(PG8_SA(1, 0), cA + kstepA, voffA); PG8_STAGE(PG8_SB(1, 1), cB + hstepB + kstepB, voffB);
    PG8_WAIT_V(6); PG8_BAR;
    unsigned long long st_t0 = stp ? __builtin_amdgcn_s_memrealtime() : 0ull, st_loop = 0ull, st_epi = 0ull;
    for (;;) {
        const bool has_next = S.next(ui + 1, nxt);
        const char* nA = has_next ? g.A + (long)nxt.pm * g.a_pm + (long)nxt.g * g.a_g : cA; const char* nB = has_next ? g.B + (long)nxt.pn * g.b_pn + (long)nxt.g * g.b_g : cB;
        for (int t = 0; t < nt; t += 2) {
            const bool last = (t == nt - 2);
            const char* a1 = cA + (long)(t + 1) * kstepA;
            const bool sg = SEG2 && !last && (t + 2 >= g.tsw);
            const char* a2 = last ? nA : cA + (long)(t + 2) * kstepA; const char* b2 = last ? nB : (sg ? cB2 + (long)(t + 2 - g.tsw) * g.b2_k : cB + (long)(t + 2) * kstepB);
            const char* a3 = a2 + kstepA; const char* b3 = b2 + (sg ? g.b2_k : kstepB);
            const long hB = sg ? g.b2_h : hstepB;
            unsigned vbs[2]; vbs[0] = sg ? voffB2[0] : voffB[0]; vbs[1] = sg ? voffB2[1] : voffB[1];
            PG8_LDB(B0, 0, 0); PG8_LDB(B1, 0, 1); PG8_SCHED; PG8_LDA(At, 0, 0); PG8_STAGE(PG8_SA(1, 1), a1 + hstepA, voffA);
            PG8_WAIT_V(8); PG8_WAIT_L(0); PG8_BAR; PG8_MMA(0, 0, At, B0); PG8_MMA(0, 1, At, B1); PG8_BAR; PG8_SCHED;
            PG8_LDA(At, 0, 1); PG8_STAGE(PG8_SB(0, 0), b2, vbs); PG8_STAGE(PG8_SB(0, 1), b2 + hB, vbs); PG8_STAGE(PG8_SA(0, 0), a2, voffA);
            PG8_WAIT_V(8); PG8_WAIT_L(0); PG8_BAR; PG8_MMA(1, 0, At, B0); PG8_MMA(1, 1, At, B1); PG8_BAR; PG8_SCHED;
            PG8_LDB(B0, 1, 0); PG8_LDB(B1, 1, 1); PG8_SCHED; PG8_LDA(At, 1, 0); PG8_STAGE(PG8_SA(0, 1), a2 + hstepA, voffA);
            PG8_WAIT_V(8); PG8_WAIT_L(0); PG8_BAR; PG8_MMA(0, 0, At, B0); PG8_MMA(0, 1, At, B1); PG8_BAR; PG8_SCHED;
            PG8_LDA(At, 1, 1); PG8_STAGE(PG8_SB(1, 0), b3, vbs); PG8_STAGE(PG8_SB(1, 1), b3 + hB, vbs); PG8_STAGE(PG8_SA(1, 0), a3, voffA);
            PG8_WAIT_V(8); PG8_WAIT_L(0); PG8_BAR; PG8_MMA(1, 0, At, B0); PG8_MMA(1, 1, At, B1); PG8_BAR; PG8_SCHED;
            if constexpr (Epi::HAS_MID) { if (t + 2 == Epi::MID_T) E.mid(acc, wr, fr); }
        }
        if (stp) { const unsigned long long t1 = __builtin_amdgcn_s_memrealtime(); st_loop += t1 - st_t0; st_t0 = t1; }
        if constexpr (ALIGN_EPI) { if (wr == 0) PG8_BAR; }
        if constexpr (!Epi::AFTER_DRAIN) { E(acc, cur, wr, wc, fr, fq); }
        if (stp) { const unsigned long long t1 = __builtin_amdgcn_s_memrealtime(); st_epi += t1 - st_t0; st_t0 = t1; }
        if (!has_next) break;
#pragma unroll
        for (int a = 0; a < 2; ++a)
#pragma unroll
            for (int b = 0; b < 2; ++b)
#pragma unroll
                for (int m = 0; m < 4; ++m)
#pragma unroll
                    for (int n = 0; n < 2; ++n) acc[a][b][m][n] = (f32x4){0.f, 0.f, 0.f, 0.f};
        cur = nxt; cA = nA; cB = nB; ++ui; if constexpr (SEG2) cB2 = g.B2 + (long)cur.pn * g.b2_pn + (long)cur.g * g.b2_g;
        if constexpr (ALIGN_EPI) { if (wr == 1) PG8_BAR; }
    }
    PG8_WAIT_V(0);
    if constexpr (!ALIGN_EPI) { if (wr == 0) PG8_BAR; }
    PG8_BAR;
    if (stp) { const unsigned long long t1 = __builtin_amdgcn_s_memrealtime(); st_loop += t1 - st_t0; st_t0 = t1; }
    if constexpr (Epi::AFTER_DRAIN) { E.fused(acc, cur, wr, wc, fr, fq, lds, wid, lane); }
    if (stp) { const unsigned long long t1 = __builtin_amdgcn_s_memrealtime(); st_epi += t1 - st_t0; if (tid == 0) { stp[0] = st_loop; stp[1] = st_epi; } }
#undef PG8_SA
#undef PG8_SB
#undef PG8_STAGE
#undef PG8_LDA
#undef PG8_LDB
#undef PG8_MMA
#undef PG8_WAIT_V
#undef PG8_WAIT_L
#undef PG8_BAR
#undef PG8_SCHED
}

__device__ __forceinline__ void voff_std(unsigned (&v)[2], int ld, bool perm, int tid) {
#pragma unroll
    for (int i = 0; i < 2; ++i) { int R, C; stage_rc(tid * 16 + i * 8192, R, C); const int Rb = perm ? ((R & ~31) + perm32(R & 31)) : R; v[i] = (unsigned)(Rb * ld + C) * 2u; }
}

typedef f32x4 Acc[2][2][4][2];

struct EpiU {
    static constexpr bool PERM = true, AFTER_DRAIN = false, HAS_MID = false; static constexpr int MID_T = 0;
    const float* r0; bf16_t* upool; bf16_t* ussm;
    __device__ __forceinline__ void operator()(Acc& acc, const Unit& u, int wr, int wc, int fr, int fq) const {
#pragma unroll
        for (int ai = 0; ai < 2; ++ai)
#pragma unroll
            for (int m = 0; m < 4; ++m) {
                const int row = u.pm * BM + ai * HALF + wr * 64 + m * 16 + fr; const float rs = r0[row];
#pragma unroll
                for (int bj = 0; bj < 2; ++bj) {
                    const int c8 = u.pn * BM + bj * HALF + wc * 32 + 8 * fq;
                    const u32x4 w = pack8(acc[ai][bj][m][0] * rs, acc[ai][bj][m][1] * rs);
                    if (u.pn < 2) *(u32x4*)(upool + (size_t)row * DPOOL + c8) = w;
                    else { const int cs = c8 - DPOOL, gg = cs >> 4, h0 = cs & 15, cr = row / TCH, p = row % TCH;
                           *(u32x4*)(ussm + ((size_t)(gg * NCR + cr) * ROWLEN + 16 * p + h0)) = w; }
                }
            }
    }
};
struct EpiFG {
    static constexpr bool PERM = false, AFTER_DRAIN = false, HAS_MID = false; static constexpr int MID_T = 0;
    float* fg;
    __device__ __forceinline__ void operator()(Acc& acc, const Unit& u, int wr, int wc, int fr, int fq) const {
#pragma unroll
        for (int ai = 0; ai < 2; ++ai)
#pragma unroll
            for (int m = 0; m < 4; ++m) {
                const int cr = u.pm * BM + ai * HALF + wr * 64 + m * 16 + fr; float* rowp = fg + ((size_t)u.g * NCR + cr) * 256 + wc * 32 + 4 * fq;
#pragma unroll
                for (int bj = 0; bj < 2; ++bj)
#pragma unroll
                    for (int n = 0; n < 2; ++n) *(f32x4*)(rowp + bj * HALF + n * 16) = acc[ai][bj][m][n];
            }
    }
};
struct EpiZ {
    static constexpr bool PERM = true, AFTER_DRAIN = false, HAS_MID = false; static constexpr int MID_T = 0;
    const bf16_t* ussm; const float* dvec; bf16_t* zg;
    __device__ __forceinline__ void operator()(Acc& acc, const Unit& u, int wr, int wc, int fr, int fq) const {
#pragma unroll
        for (int bj = 0; bj < 2; ++bj) {
            const int c8 = u.pn * BM + bj * HALF + wc * 32 + 8 * fq;
            const f32x4 d0 = *(const f32x4*)(dvec + u.g * 16 + (c8 & 15)), d1 = *(const f32x4*)(dvec + u.g * 16 + (c8 & 15) + 4);
#pragma unroll
            for (int ai = 0; ai < 2; ++ai)
#pragma unroll
                for (int m = 0; m < 4; ++m) {
                    const int cr = u.pm * BM + ai * HALF + wr * 64 + m * 16 + fr;
                    const u32x4 uw = *(const u32x4*)(ussm + ((size_t)(u.g * NCR + cr) * ROWLEN + c8));
                    f32x4 u0, u1; unpack8(uw, u0, u1);
                    f32x4 y0 = acc[ai][bj][m][0] + d0 * u0, y1 = acc[ai][bj][m][1] + d1 * u1;
#pragma unroll
                    for (int i = 0; i < 4; ++i) { y0[i] = fast_gelu_tanh(y0[i]); y1[i] = fast_gelu_tanh(y1[i]); }
                    *(u32x4*)(zg + ((size_t)u.g * MT * 16 + (size_t)cr * K1 + c8)) = pack8(y0, y1);
                }
        }
    }
};
struct EpiPool {
    static constexpr bool PERM = true, AFTER_DRAIN = false, HAS_MID = false; static constexpr int MID_T = 0;
    const float* pscale; bf16_t* ycat; float* ss;
    __device__ __forceinline__ void operator()(Acc& acc, const Unit& u, int wr, int wc, int fr, int fq) const {
        f32x4 sc[2][2];
#pragma unroll
        for (int bj = 0; bj < 2; ++bj) { const int c8 = u.pn * BM + bj * HALF + wc * 32 + 8 * fq; sc[bj][0] = *(const f32x4*)(pscale + c8); sc[bj][1] = *(const f32x4*)(pscale + c8 + 4); }
#pragma unroll
        for (int ai = 0; ai < 2; ++ai)
#pragma unroll
            for (int m = 0; m < 4; ++m) {
                const int row = u.pm * BM + ai * HALF + wr * 64 + m * 16 + fr; float q = 0.f;
#pragma unroll
                for (int bj = 0; bj < 2; ++bj) {
                    const int c8 = u.pn * BM + bj * HALF + wc * 32 + 8 * fq;
                    const f32x4 v0 = acc[ai][bj][m][0] * sc[bj][0], v1 = acc[ai][bj][m][1] * sc[bj][1];
                    q += (v0[0] * v0[0] + v0[1] * v0[1]) + (v0[2] * v0[2] + v0[3] * v0[3]) + (v1[0] * v1[0] + v1[1] * v1[1]) + (v1[2] * v1[2] + v1[3] * v1[3]);
                    *(u32x4*)(ycat + (size_t)row * DM + c8) = pack8(v0, v1);
                }
                q += __shfl_xor(q, 16); q += __shfl_xor(q, 32);
                if (fq == 0) ss[(size_t)(u.pn * 4 + wc) * MT + row] = q;
            }
    }
};
struct EpiGlu {
    static constexpr bool PERM = true, AFTER_DRAIN = false, HAS_MID = false; static constexpr int MID_T = 0;
    const float* gb; const bf16_t* zg; bf16_t* ycat; float* ss;
    __device__ __forceinline__ void operator()(Acc& acc, const Unit& u, int wr, int wc, int fr, int fq) const {
        f32x4 bv[2][2];
#pragma unroll
        for (int bj = 0; bj < 2; ++bj) { const int c8 = u.pn * BM + bj * HALF + wc * 32 + 8 * fq; bv[bj][0] = *(const f32x4*)(gb + c8); bv[bj][1] = *(const f32x4*)(gb + c8 + 4); }
#pragma unroll
        for (int ai = 0; ai < 2; ++ai)
#pragma unroll
            for (int m = 0; m < 4; ++m) {
                const int row = u.pm * BM + ai * HALF + wr * 64 + m * 16 + fr; float q = 0.f;
#pragma unroll
                for (int bj = 0; bj < 2; ++bj) {
                    const int c8 = u.pn * BM + bj * HALF + wc * 32 + 8 * fq;
                    const u32x4 zw = *(const u32x4*)(zg + ((size_t)(c8 >> 4) * MT + row) * 16 + (c8 & 15));
                    f32x4 z0, z1; unpack8(zw, z0, z1);
                    f32x4 v0 = acc[ai][bj][m][0] + bv[bj][0], v1 = acc[ai][bj][m][1] + bv[bj][1];
#pragma unroll
                    for (int i = 0; i < 4; ++i) { v0[i] = z0[i] * fast_sigmoid(v0[i]); v1[i] = z1[i] * fast_sigmoid(v1[i]); }
                    q += (v0[0] * v0[0] + v0[1] * v0[1]) + (v0[2] * v0[2] + v0[3] * v0[3]) + (v1[0] * v1[0] + v1[1] * v1[1]) + (v1[2] * v1[2] + v1[3] * v1[3]);
                    *(u32x4*)(ycat + (size_t)row * DM + DPOOL + c8) = pack8(v0, v1);
                }
                q += __shfl_xor(q, 16); q += __shfl_xor(q, 32);
                if (fq == 0) ss[(size_t)(u.pn * 4 + wc) * MT + row] = q;
            }
    }
};
struct EpiOut {
    static constexpr bool PERM = true, AFTER_DRAIN = true, HAS_MID = true; static constexpr int MID_T = 8;
    const float* x; bf16_t* h1b; float* ss; LAS f32x2* XR; float ratio[2][4];
    __device__ __forceinline__ void mid(Acc& acc, int wr, int fr) const {
#pragma unroll
        for (int ai = 0; ai < 2; ++ai)
#pragma unroll
            for (int m = 0; m < 4; ++m) { const float ratio = this->ratio[ai][m];
#pragma unroll
                for (int bj = 0; bj < 2; ++bj)
#pragma unroll
                    for (int n = 0; n < 2; ++n) acc[ai][bj][m][n] = acc[ai][bj][m][n] * ratio; }
    }
    __device__ __forceinline__ void fused(Acc& acc, const Unit& u, int wr, int wc, int fr, int fq, LAS unsigned char* lds, int wid, int lane) const {
        LAS float* P = (LAS float*)lds;
        const int col0 = u.pn * BM + wc * 32 + 8 * fq;
#pragma unroll
        for (int ai = 0; ai < 2; ++ai)
#pragma unroll
            for (int m = 0; m < 4; ++m) {
                const int lr = ai * HALF + wr * 64 + m * 16 + fr, row = u.pm * BM + lr; const float rs = XR[lr].y; float q = 0.f;
                const size_t prow = (size_t)(row >> 12) * PADROWS + 1 + (row & 4095);
#pragma unroll
                for (int bj = 0; bj < 2; ++bj) {
                    const int c = col0 + bj * HALF;
                    const f32x4 h0 = *(const f32x4*)(x + (size_t)row * DM + c) + acc[ai][bj][m][0] * rs, h1v = *(const f32x4*)(x + (size_t)row * DM + c + 4) + acc[ai][bj][m][1] * rs;
                    q += (h0[0] * h0[0] + h0[1] * h0[1]) + (h0[2] * h0[2] + h0[3] * h0[3]) + (h1v[0] * h1v[0] + h1v[1] * h1v[1]) + (h1v[2] * h1v[2] + h1v[3] * h1v[3]);
                    *(u32x4*)(h1b + prow * DM + c) = pack8(h0, h1v);
                }
                q += __shfl_xor(q, 16); q += __shfl_xor(q, 32);
                if (fq == 0) P[lr * 4 + wc] = q;
            }
        LDS_WAIT(); __builtin_amdgcn_s_barrier(); asm volatile("" ::: "memory");
        const int tid = wid * 64 + lane;
        if (tid < 256) ss[(size_t)u.pn * MT + u.pm * BM + tid] = (P[tid * 4 + 0] + P[tid * 4 + 1]) + (P[tid * 4 + 2] + P[tid * 4 + 3]);
    }
};
struct EpiUp {
    static constexpr bool PERM = true, AFTER_DRAIN = false, HAS_MID = false; static constexpr int MID_T = 0;
    const float* ssh1; const float* cw; const float* cb; bf16_t* act;
    __device__ __forceinline__ void operator()(Acc& acc, const Unit& u, int wr, int wc, int fr, int fq) const {
        const int j = u.pm, b = u.g;
#pragma unroll
        for (int ai = 0; ai < 2; ++ai)
#pragma unroll
            for (int m = 0; m < 4; ++m) {
                const int w = 64 * ai + 16 * m + fr, t = UPROWS * j + 126 * wr + w - 1; const bool in = (t >= 0 && t < SEQ);
                const int tok = b * SEQ + (in ? t : 0);
                const float s = (ssh1[tok] + ssh1[MT + tok]) + (ssh1[2 * MT + tok] + ssh1[3 * MT + tok]);
                const float rs = in ? rsqrtf(s * (1.0f / DM) + EPS) : 0.f;
#pragma unroll
                for (int bj = 0; bj < 2; ++bj)
#pragma unroll
                    for (int n = 0; n < 2; ++n) acc[ai][bj][m][n] = acc[ai][bj][m][n] * rs;
            }
        const int f0 = 128 * u.pn + 32 * wc + 8 * fq;
        u32x2 keep[8];
#pragma unroll
        for (int n = 0; n < 2; ++n) {
            const int fc = f0 + 4 * n;
            const f32x4 wv0 = *(const f32x4*)(cw + fc), wv1 = *(const f32x4*)(cw + DFF2 + fc), wv2 = *(const f32x4*)(cw + 2 * DFF2 + fc), bvv = *(const f32x4*)(cb + fc);
            const f32x4 wg0 = *(const f32x4*)(cw + DFF + fc), wg1 = *(const f32x4*)(cw + DFF2 + DFF + fc), wg2 = *(const f32x4*)(cw + 2 * DFF2 + DFF + fc), bgv = *(const f32x4*)(cb + DFF + fc);
#pragma unroll
            for (int gi = 0; gi < 8; ++gi) {
                const int ai = gi >> 2, m = gi & 3, pi = gi > 0 ? gi - 1 : gi, ni = gi < 7 ? gi + 1 : gi;
                const f32x4 cv = acc[ai][0][m][n], cg = acc[ai][1][m][n];
                const f32x4 pv = acc[pi >> 2][0][pi & 3][n], pg = acc[pi >> 2][1][pi & 3][n];
                const f32x4 nv = acc[ni >> 2][0][ni & 3][n], ng = acc[ni >> 2][1][ni & 3][n];
                f32x4 o;
#pragma unroll
                for (int i = 0; i < 4; ++i) {
                    const float v_prev = dpp_ror1(fr == 15 ? pv[i] : cv[i]), v_next = dpp_ror15(fr == 0 ? nv[i] : cv[i]);
                    const float g_prev = dpp_ror1(fr == 15 ? pg[i] : cg[i]), g_next = dpp_ror15(fr == 0 ? ng[i] : cg[i]);
                    const float vv = bvv[i] + wv0[i] * v_prev + wv1[i] * cv[i] + wv2[i] * v_next;
                    const float gg = bgv[i] + wg0[i] * g_prev + wg1[i] * cg[i] + wg2[i] * g_next;
                    o[i] = vv * gg * fast_sigmoid(gg);
                }
                const u32x2 pk = pack4(o);
                if (n == 0) keep[gi] = pk;
                else { const int w = 64 * ai + 16 * m + fr, t = UPROWS * j + 126 * wr + w - 1;
                       if (t >= 0 && t < SEQ && w >= 1 && w <= 126) { u32x4 wv; wv.x = keep[gi].x; wv.y = keep[gi].y; wv.z = pk.x; wv.w = pk.y; *(u32x4*)(act + (size_t)(b * SEQ + t) * DFF + f0) = wv; } }
            }
        }
    }
};
struct EpiDown {
    static constexpr bool PERM = true, AFTER_DRAIN = true, HAS_MID = false; static constexpr int MID_T = 0;
    const bf16_t* h1b; float* out; const float* gfin; float* ss; const XcdBarrier* bar;
    __device__ __forceinline__ void fused(Acc& acc, const Unit& u, int wr, int wc, int fr, int fq, LAS unsigned char* lds, int wid, int lane) const {
        LAS float* P = (LAS float*)lds;
        LAS float* Sr = (LAS float*)(lds + 8192);
        const int col0 = u.pn * BM + wc * 32 + 8 * fq;
#pragma unroll
        for (int ai = 0; ai < 2; ++ai)
#pragma unroll
            for (int m = 0; m < 4; ++m) {
                const int lr = ai * HALF + wr * 64 + m * 16 + fr, row = u.pm * BM + lr; float q = 0.f;
                const size_t prow = (size_t)(row >> 12) * PADROWS + 1 + (row & 4095);
#pragma unroll
                for (int bj = 0; bj < 2; ++bj) {
                    f32x4 b0, b1; unpack8(*(const u32x4*)(h1b + prow * DM + col0 + bj * HALF), b0, b1);
                    const f32x4 h0 = b0 + acc[ai][bj][m][0], h1v = b1 + acc[ai][bj][m][1];
                    acc[ai][bj][m][0] = h0; acc[ai][bj][m][1] = h1v;
                    q += (h0[0] * h0[0] + h0[1] * h0[1]) + (h0[2] * h0[2] + h0[3] * h0[3]) + (h1v[0] * h1v[0] + h1v[1] * h1v[1]) + (h1v[2] * h1v[2] + h1v[3] * h1v[3]);
                }
                q += __shfl_xor(q, 16); q += __shfl_xor(q, 32);
                if (fq == 0) P[lr * 4 + wc] = q;
            }
        LDS_WAIT(); __builtin_amdgcn_s_barrier(); asm volatile("" ::: "memory");
        const int tid = wid * 64 + lane;
        if (tid < 256) ss[(size_t)u.pn * MT + u.pm * BM + tid] = (P[tid * 4 + 0] + P[tid * 4 + 1]) + (P[tid * 4 + 2] + P[tid * 4 + 3]);
        xcd_barrier(*bar, tid);
        if (tid < 256) { const int row = u.pm * BM + tid; const float s = (ss[row] + ss[MT + row]) + (ss[2 * MT + row] + ss[3 * MT + row]); Sr[tid] = rsqrtf(s * (1.0f / DM) + EPS); }
        LDS_WAIT(); __builtin_amdgcn_s_barrier(); asm volatile("" ::: "memory");
#pragma unroll
        for (int bj = 0; bj < 2; ++bj) {
            const int c = col0 + bj * HALF; const f32x4 g0 = *(const f32x4*)(gfin + c), g1 = *(const f32x4*)(gfin + c + 4);
#pragma unroll
            for (int ai = 0; ai < 2; ++ai)
#pragma unroll
                for (int m = 0; m < 4; ++m) { const int lr = ai * HALF + wr * 64 + m * 16 + fr; const float r = Sr[lr]; float* o = out + (size_t)(u.pm * BM + lr) * DM + c;
                    *(f32x4*)o = acc[ai][bj][m][0] * r * g0; *(f32x4*)(o + 4) = acc[ai][bj][m][1] * r * g1; }
        }
    }
};

struct OrdOne { Unit u; __device__ bool next(int i, Unit& o) const { if (i > 0) return false; o = u; return true; } };
struct OrdSsmA { int c; __device__ bool next(int i, Unit& u) const { if (i > 0 || c >= 64) return false; const int x = c & 7, k = c >> 3; u.g = x * 4 + (k >> 1); u.pm = k & 1; u.pn = 0; return true; } };
struct OrdSsmB { int c; __device__ bool next(int i, Unit& u) const { if (i > 0 || c >= 128) return false; const int x = c & 7, k = c >> 3; u.g = x * 4 + (k >> 2); u.pm = (k >> 1) & 1; u.pn = k & 1; return true; } };
struct OrdPool { int c; __device__ bool next(int i, Unit& u) const { if (i > 0 || c < 128 || c >= 256) return false; const int cc = c - 128, x = cc & 7, k = cc >> 3; u.pm = x * 8 + (k >> 1); u.pn = k & 1; u.g = u.pn; return true; } };
struct OrdGlu  { int c; __device__ bool next(int i, Unit& u) const { if (i > 0 || c >= 128) return false; const int x = c & 7, k = c >> 3; u.pm = x * 8 + (k >> 1); u.pn = k & 1; u.g = 0; return true; } };
struct OrdUp { StaticOrder so; __device__ bool next(int i, Unit& u) const { if (!so.next(i, u)) return false; u.g = u.pm / UPT; u.pm = u.pm % UPT; return true; } };

constexpr size_t WS_STAMP = 4 * MiB;
#if defined(MK_STAMP)
#define ST(k) do { if (F.tid == 0) ((unsigned long long*)(args.ws + WS_STAMP))[blockIdx.x * 64 + (k)] = __builtin_amdgcn_s_memrealtime(); } while (0)
#define GP_STAMP(base) ((unsigned long long*)(args.ws + WS_STAMP) + blockIdx.x * 64 + (base))
#else
#define ST(k) do { } while (0)
#define GP_STAMP(base) ((unsigned long long*)nullptr)
#endif
struct Args { const float* in[24]; float* out; unsigned char* ws; int ph_lo, ph_hi; };

struct Frame { LAS unsigned char* lds; int tid, lane, wave, G, bx; };

struct TrMat { const float* W; int K, N; const float* kg0; const float* kg1; int ksplit; bf16_t* WT; int map; int nitems; };
__device__ __forceinline__ void tr_load(const TrMat& m0, const TrMat& m1, int item, int lane, f32x4 (&v)[8]) {
    const bool second = item >= m0.nitems; const TrMat& m = second ? m1 : m0; const int it = second ? item - m0.nitems : item;
    const int nblk = m.N / 32, kb = it / nblk, nb = it % nblk, k0 = 64 * kb, n0 = 32 * nb, r = lane >> 3, c4 = lane & 7;
#pragma unroll
    for (int i = 0; i < 8; ++i) v[i] = *(const f32x4*)(m.W + (size_t)(k0 + 8 * i + r) * m.N + n0 + 4 * c4);
}
__device__ __forceinline__ void tr_store(const TrMat& m0, const TrMat& m1, int item, int lane, const f32x4 (&v)[8], LAS float* scr) {
    const bool second = item >= m0.nitems; const TrMat& m = second ? m1 : m0; const int it = second ? item - m0.nitems : item;
    const int nblk = m.N / 32, kb = it / nblk, nb = it % nblk, k0 = 64 * kb, n0 = 32 * nb, r = lane >> 3, c4 = lane & 7;
#pragma unroll
    for (int i = 0; i < 8; ++i) { const int kk = 8 * i + r, k = k0 + kk; float gn = 1.f; if (m.kg0) gn = (k < m.ksplit ? m.kg0[k] : m.kg1[k - m.ksplit]);
        LAS float* d = scr + kk * 33 + 4 * c4; d[0] = v[i][0] * gn; d[1] = v[i][1] * gn; d[2] = v[i][2] * gn; d[3] = v[i][3] * gn; }
    LDS_WAIT(); asm volatile("" ::: "memory");
    const int c = lane & 7;
#pragma unroll
    for (int j = 0; j < 4; ++j) { const int n = (lane >> 3) + 8 * j; const LAS float* q = scr + (8 * c) * 33 + n;
        u32x4 o; o.x = pk2(q[0 * 33], q[1 * 33]); o.y = pk2(q[2 * 33], q[3 * 33]); o.z = pk2(q[4 * 33], q[5 * 33]); o.w = pk2(q[6 * 33], q[7 * 33]);
        int nr = n0 + n;
        if (m.map == 1) { const int bj = nr / DFF, rem = nr % DFF; nr = 256 * (rem >> 7) + 128 * bj + (rem & 127); }
        *(u32x4*)(m.WT + (size_t)nr * m.K + k0 + 8 * c) = o; }
    LDS_WAIT(); asm volatile("" ::: "memory");
}
__device__ __forceinline__ void tr_run(const TrMat& m0, const TrMat& m1, int first, int stride, int lane, LAS float* scr) {
    const int total = m0.nitems + m1.nitems; f32x4 va[8], vb[8];
    int it = first; if (it < total) tr_load(m0, m1, it, lane, va);
    while (it < total) {
        const int n1 = it + stride; if (n1 < total) tr_load(m0, m1, n1, lane, vb);
        tr_store(m0, m1, it, lane, va, scr);
        if (n1 >= total) break;
        const int n2 = n1 + stride; if (n2 < total) tr_load(m0, m1, n2, lane, va);
        tr_store(m0, m1, n1, lane, vb, scr);
        it = n2;
    }
}

struct SsmLds { LAS float* Bre; LAS float* Bim; LAS float* Cre; LAS float* Cim; LAS float* PAR; LAS float* Pc; LAS float* Kl; };
__device__ __forceinline__ SsmLds ssm_lds(const Frame& F) { SsmLds L; L.Bre = (LAS float*)(F.lds); L.Bim = L.Bre + 2048; L.Cre = L.Bim + 2048; L.Cim = L.Cre + 2048; L.PAR = L.Cim + 2048; L.Pc = L.PAR + 512; L.Kl = L.Pc + 1024; return L; }
__device__ __forceinline__ void ssm_stage(const Args& a, const Frame& F, const SsmLds& L, int g) {
    const float* lnar = a.in[5]; const float* aim = a.in[6]; const float* ldt = a.in[7];
    const float* bre = a.in[8]; const float* bim = a.in[9]; const float* cre = a.in[10]; const float* cim = a.in[11];
    const int tid = F.tid;
    for (int i = tid; i < 2048; i += 512) { const int dir = i >> 10, r = i & 1023;
        L.Bre[i] = bre[((size_t)(dir * NG + g)) * 1024 + r]; L.Bim[i] = bim[((size_t)(dir * NG + g)) * 1024 + r];
        L.Cre[i] = cre[((size_t)(dir * NG + g)) * 1024 + r]; L.Cim[i] = cim[((size_t)(dir * NG + g)) * 1024 + r]; }
    if (tid < 128) { const int dir = tid >> 6, n = tid & 63;
        const float dt = expf(ldt[dir * NG + g]); const float a_re = -expf(lnar[(dir * NG + g) * NS + n]), a_im = aim[(dir * NG + g) * NS + n];
        const float mag = expf(a_re * dt), ang = a_im * dt; const float lam_re = mag * cosf(ang), lam_im = mag * sinf(ang);
        const float den = a_re * a_re + a_im * a_im;
        L.PAR[tid * 4 + 0] = a_re * dt; L.PAR[tid * 4 + 1] = ang;
        L.PAR[tid * 4 + 2] = ((lam_re - 1.0f) * a_re + lam_im * a_im) / den; L.PAR[tid * 4 + 3] = (lam_im * a_re - (lam_re - 1.0f) * a_im) / den; }
    __syncthreads();
}
__device__ __forceinline__ void ssm_build_tb(const Args& a, const Frame& F, const SsmLds& L, int g, int lag0, int nl) {
    bf16_t* KC = (bf16_t*)(a.ws + WS_TB) + (size_t)g * 64 * 256;
    bf16_t* TBC = (bf16_t*)(a.ws + WS_TBC) + (size_t)g * K1 * 256;
    const int tid = F.tid;
    { const int li = tid >> 7, dn = tid & 127, lag = lag0 + li; const float ad = L.PAR[dn * 4 + 0], ang = L.PAR[dn * 4 + 1], fr_ = L.PAR[dn * 4 + 2], fi_ = L.PAR[dn * 4 + 3];
      const float mg = expf((float)lag * ad); float sn, cs; sincosf((float)lag * ang, &sn, &cs); const float lr = mg * cs, lim = mg * sn;
      L.Pc[(li * 128 + dn) * 2 + 0] = lr * fr_ - lim * fi_; L.Pc[(li * 128 + dn) * 2 + 1] = lr * fi_ + lim * fr_; }
    __syncthreads();
    { const int li = F.wave >> 1, dir = F.wave & 1, i16 = F.lane & 15, kq = F.lane >> 4; f32x4 kacc = {0.f, 0.f, 0.f, 0.f};
#pragma unroll 8
      for (int kk0 = 0; kk0 < 128; kk0 += 4) { const int kk = kk0 + kq, n = kk >> 1; const bool im = (kk & 1) != 0;
          const float cr_ = L.Cre[dir * 1024 + i16 * 64 + n], ci_ = L.Cim[dir * 1024 + i16 * 64 + n], pr = L.Pc[(li * 128 + dir * 64 + n) * 2], pi = L.Pc[(li * 128 + dir * 64 + n) * 2 + 1];
          const float av = im ? -(cr_ * pi + ci_ * pr) : (cr_ * pr - ci_ * pi);
          const float bv = im ? L.Bim[dir * 1024 + n * 16 + i16] : L.Bre[dir * 1024 + n * 16 + i16];
          kacc = __builtin_amdgcn_mfma_f32_16x16x4f32(av, bv, kacc, 0, 0, 0); }
#pragma unroll
      for (int r = 0; r < 4; ++r) L.Kl[li * 512 + dir * 256 + (kq * 4 + r) * 16 + i16] = kacc[r]; }
    __syncthreads();
    { const int li = tid >> 7, dir = (tid >> 6) & 1, e4 = tid & 63, lag = lag0 + li;
      if (li < nl && !(lag == 0 && dir == 1)) {
          f32x4 v = *(const LAS f32x4*)(L.Kl + li * 512 + dir * 256 + 4 * e4);
          if (lag == 0) v = v + *(const LAS f32x4*)(L.Kl + li * 512 + 256 + 4 * e4);
          const int d = dir == 0 ? 31 + lag : 31 - lag; u32x2 w; w.x = pk2(v[0], v[1]); w.y = pk2(v[2], v[3]);
          *(u32x2*)(KC + (size_t)d * 256 + 4 * e4) = w; } }
    __syncthreads();
    { const int li = tid >> 7, dn = tid & 127, dir = dn >> 6, p = lag0 + li; const float ad = L.PAR[dn * 4 + 0], ang = L.PAR[dn * 4 + 1]; const float e = dir == 0 ? (float)(p + 1) : (float)(TCH - p);
      const float mg = expf(e * ad); float sn, cs; sincosf(e * ang, &sn, &cs); L.Pc[(li * 128 + dn) * 2 + 0] = mg * cs; L.Pc[(li * 128 + dn) * 2 + 1] = mg * sn; }
    __syncthreads();
    for (int li = 0; li < nl; ++li) {
        const int p = lag0 + li, h = tid >> 5, dir = (tid >> 4) & 1, n4 = tid & 15; float v[8];
#pragma unroll
        for (int e = 0; e < 4; ++e) { const int n = 4 * n4 + e; const float cr_ = L.Cre[dir * 1024 + h * 64 + n], ci_ = L.Cim[dir * 1024 + h * 64 + n], pr = L.Pc[(li * 128 + dir * 64 + n) * 2], pi = L.Pc[(li * 128 + dir * 64 + n) * 2 + 1];
            v[2 * e] = cr_ * pr - ci_ * pi; v[2 * e + 1] = -(cr_ * pi + ci_ * pr); }
        u32x4 w; w.x = pk2(v[0], v[1]); w.y = pk2(v[2], v[3]); w.z = pk2(v[4], v[5]); w.w = pk2(v[6], v[7]);
        *(u32x4*)(TBC + (size_t)(16 * p + h) * 256 + dir * 128 + 8 * n4) = w;
    }
    __syncthreads();
}
__device__ __forceinline__ void ssm_build_wab(const Args& a, const Frame& F, const SsmLds& L, int g, int jq) {
    bf16_t* WAB = (bf16_t*)(a.ws + WS_WAB) + (size_t)g * 256 * K1;
    const int tid = F.tid;
    { const int li = tid >> 7, dn = tid & 127, dir = dn >> 6, q = 4 * jq + li; const float ad = L.PAR[dn * 4 + 0], ang = L.PAR[dn * 4 + 1], fr_ = L.PAR[dn * 4 + 2], fi_ = L.PAR[dn * 4 + 3]; const float e = dir == 0 ? (float)(TCH - 1 - q) : (float)q;
      const float mg = expf(e * ad); float sn, cs; sincosf(e * ang, &sn, &cs); const float lr = mg * cs, lim = mg * sn;
      L.Pc[(li * 128 + dn) * 2 + 0] = lr * fr_ - lim * fi_; L.Pc[(li * 128 + dn) * 2 + 1] = lr * fi_ + lim * fr_; }
    __syncthreads();
#pragma unroll
    for (int half = 0; half < 2; ++half) {
        const int li = 2 * half + (tid >> 8), q = 4 * jq + li, t2 = tid & 255, dir = t2 >> 7, n = (t2 >> 1) & 63, part = t2 & 1;
        const float pr = L.Pc[(li * 128 + dir * 64 + n) * 2], pi = L.Pc[(li * 128 + dir * 64 + n) * 2 + 1]; float v[16];
#pragma unroll
        for (int i = 0; i < 16; ++i) { const float br_ = L.Bre[dir * 1024 + n * 16 + i], bi_ = L.Bim[dir * 1024 + n * 16 + i]; v[i] = part == 0 ? (pr * br_ - pi * bi_) : (pr * bi_ + pi * br_); }
        u32x4 w0, w1; w0.x = pk2(v[0], v[1]); w0.y = pk2(v[2], v[3]); w0.z = pk2(v[4], v[5]); w0.w = pk2(v[6], v[7]); w1.x = pk2(v[8], v[9]); w1.y = pk2(v[10], v[11]); w1.z = pk2(v[12], v[13]); w1.w = pk2(v[14], v[15]);
        bf16_t* dst = WAB + (size_t)(dir * 128 + 2 * n + part) * K1 + 16 * q; *(u32x4*)dst = w0; *(u32x4*)(dst + 8) = w1;
    }
    __syncthreads();
}

__device__ __forceinline__ void p0_prologue(const Args& a, const Frame& F) {
    const float* x = a.in[0];
    { const SsmLds L = ssm_lds(F);
      for (int it = F.bx; it < NG * 8; it += F.G) { ssm_stage(a, F, L, it >> 3); ssm_build_wab(a, F, L, it >> 3, it & 7); } }
    __syncthreads();
    LAS float* scr = (LAS float*)(F.lds + F.wave * 16384);
    const int gw = F.bx * 8 + F.wave, NGW = F.G * 8;
    { const TrMat m0{a.in[2], DM, DM, a.in[1], a.in[1], DM, (bf16_t*)(a.ws + WS_WIN), 0, (DM / 64) * (DM / 32)}; const TrMat m1{nullptr, 0, 32, nullptr, nullptr, 0, nullptr, 0, 0};
      tr_run(m0, m1, gw, NGW, F.lane, scr); }
    { bf16_t* PW = (bf16_t*)(a.ws + WS_PW); const float* pw = a.in[3];
      for (int idx = F.bx * 512 + F.tid; idx < 2 * 256 * 256; idx += F.G * 512) { const int pn = idx >> 16, j = (idx >> 8) & 255, k = idx & 255;
          const float v = ((j >> 7) == (k >> 7)) ? pw[((size_t)(2 * pn + (j >> 7)) * 128 + (k & 127)) * 128 + (j & 127)] : 0.f; PW[idx] = (bf16_t)f2bf(v); } }
    { bf16_t* h1b = (bf16_t*)(a.ws + WS_H1B);
      for (int idx = F.bx * 512 + F.tid; idx < BATCH * 256 * (DM / 8); idx += F.G * 512) { const int b = idx / (256 * 128), r = (idx / 128) % 256, c = idx % 128; const int prow = b * PADROWS + (r == 0 ? 0 : 4096 + r);
          *(u32x4*)(h1b + (size_t)prow * DM + 8 * c) = (u32x4){0u, 0u, 0u, 0u}; } }
    { bf16_t* xb = (bf16_t*)(a.ws + WS_XB); float* r0 = (float*)(a.ws + WS_R0);
      for (int row = gw; row < MT; row += NGW) {
          const f32x4* xr = (const f32x4*)(x + (size_t)row * DM) + F.lane; f32x4 v[4]; float s = 0.f;
#pragma unroll
          for (int j = 0; j < 4; ++j) { v[j] = xr[64 * j]; s += (v[j][0] * v[j][0] + v[j][1] * v[j][1]) + (v[j][2] * v[j][2] + v[j][3] * v[j][3]); }
          s = wave_sum(s); if (F.lane == 0) r0[row] = rsqrtf(s * (1.0f / DM) + EPS);
          u32x2* o = (u32x2*)(xb + (size_t)row * DM) + F.lane;
#pragma unroll
          for (int j = 0; j < 4; ++j) o[64 * j] = pack4(v[j]);
      } }
}

__device__ __forceinline__ void p2_side(const Args& a, const Frame& F, int first_block) {
    const int nb = F.G - first_block, sb = F.bx - first_block;
    { const SsmLds L = ssm_lds(F);
      int id = (sb * (NG * TCH)) / nb; const int id_end = ((sb + 1) * (NG * TCH)) / nb; int staged = -1;
      while (id < id_end) {
          const int g = id / TCH, lag0 = id % TCH; int nl = TCH - lag0; if (nl > 4) nl = 4; if (nl > id_end - id) nl = id_end - id;
          if (g != staged) { ssm_stage(a, F, L, g); staged = g; }
          ssm_build_tb(a, F, L, g, lag0, nl); id += nl;
      } }
    __syncthreads();
    LAS float* scr = (LAS float*)(F.lds + F.wave * 16384);
    const TrMat m0{a.in[13], DSSM, DSSM, nullptr, nullptr, 0, (bf16_t*)(a.ws + WS_WGLU), 0, (DSSM / 64) * (DSSM / 32)}; const TrMat m1{nullptr, 0, 32, nullptr, nullptr, 0, nullptr, 0, 0};
    tr_run(m0, m1, sb * 8 + F.wave, nb * 8, F.lane, scr);
}
__device__ __forceinline__ void ssm_side(const Args& a, const Frame& F, int first_block) {
    const int nb = F.G - first_block, sb = F.bx - first_block;
    { const SsmLds L = ssm_lds(F);
      const int g = sb >> 2, lag0 = (sb & 3) * 8;
#if defined(MK_STAMP)
#define STS(k) do { if (F.tid == 0) ((unsigned long long*)(a.ws + WS_STAMP))[blockIdx.x * 64 + (k)] = __builtin_amdgcn_s_memrealtime(); } while (0)
#else
#define STS(k) do { } while (0)
#endif
      ssm_stage(a, F, L, g); STS(45); ssm_build_tb(a, F, L, g, lag0, 4); STS(46); ssm_build_tb(a, F, L, g, lag0 + 4, 4); STS(47);
      VM_WAIT(); __syncthreads();
      if (F.tid == 0) { __builtin_amdgcn_fence(__ATOMIC_RELEASE, "agent"); asm volatile("s_waitcnt vmcnt(0)" ::: "memory");
          __hip_atomic_fetch_add((unsigned*)(a.ws + WS_CTL) + CW_TBCNT + 64 * g, 8u, __ATOMIC_RELAXED, __HIP_MEMORY_SCOPE_AGENT); } }
    __syncthreads();
#if defined(MK_STAMP)
    if (F.tid == 0) ((unsigned long long*)(a.ws + WS_STAMP))[blockIdx.x * 64 + 43] = __builtin_amdgcn_s_memrealtime();
#endif
    LAS float* scr = (LAS float*)(F.lds + F.wave * 16384);
    const TrMat m0{a.in[17], DM, DM, a.in[15], a.in[16], DPOOL, (bf16_t*)(a.ws + WS_WOUT), 0, (DM / 64) * (DM / 32)};
    const TrMat m1{a.in[13], DSSM, DSSM, nullptr, nullptr, 0, (bf16_t*)(a.ws + WS_WGLU), 0, (DSSM / 64) * (DSSM / 32)};
    tr_run(m0, m1, sb * 8 + F.wave, nb * 8, F.lane, scr);
    const TrMat m2{a.in[22], DFF, DM, nullptr, nullptr, 0, (bf16_t*)(a.ws + WS_WDOWN), 0, (DFF / 64) * (DM / 32)}; const TrMat m3{nullptr, 0, 32, nullptr, nullptr, 0, nullptr, 0, 0};
    tr_run(m2, m3, sb * 8 + F.wave, nb * 8, F.lane, scr);
}
__device__ __forceinline__ void tb_wait(const Args& a, const Frame& F, int g) {
    if (F.tid == 0) { unsigned* cnt = (unsigned*)(a.ws + WS_CTL) + CW_TBCNT + 64 * g; unsigned sp = 0;
        while (__hip_atomic_load(cnt, __ATOMIC_RELAXED, __HIP_MEMORY_SCOPE_AGENT) < (unsigned)TCH) { __builtin_amdgcn_s_sleep(2); if (++sp > (1u << 20)) break; }
        __builtin_amdgcn_fence(__ATOMIC_ACQUIRE, "agent"); asm volatile("s_waitcnt vmcnt(0)" ::: "memory"); }
    __syncthreads();
}
__device__ __forceinline__ void p3_side(const Args& a, const Frame& F, int first_block) {
    const int nb = F.G - first_block, sb = F.bx - first_block;
    LAS float* scr = (LAS float*)(F.lds + F.wave * 16384);
    const TrMat m0{a.in[17], DM, DM, a.in[15], a.in[16], DPOOL, (bf16_t*)(a.ws + WS_WOUT), 0, (DM / 64) * (DM / 32)}; const TrMat m1{nullptr, 0, 32, nullptr, nullptr, 0, nullptr, 0, 0};
    tr_run(m0, m1, sb * 8 + F.wave, nb * 8, F.lane, scr);
}
__device__ __forceinline__ void p4_side(const Args& a, const Frame& F, int first_block) {
    const int nb = F.G - first_block, sb = F.bx - first_block;
    LAS float* scr = (LAS float*)(F.lds + F.wave * 16384);
    const TrMat m0{a.in[19], DM, DFF2, a.in[18], a.in[18], DM, (bf16_t*)(a.ws + WS_WUP), 1, (DM / 64) * (DFF2 / 32)};
    const TrMat m1{nullptr, 0, 32, nullptr, nullptr, 0, nullptr, 0, 0};
    tr_run(m0, m1, sb * 8 + F.wave, nb * 8, F.lane, scr);
}

__device__ __forceinline__ void p2_pooled(const Args& a, const Frame& F, int first_block) {
    const bf16_t* up = (const bf16_t*)(a.ws + WS_UPOOL); bf16_t* po = (bf16_t*)(a.ws + WS_POOLED);
    const int gw = (F.bx - first_block) * 8 + F.wave, NGW = (F.G - first_block) * 8;
    const int c0 = 8 * F.lane, half = 1 << (F.lane >> 4);
    for (int blk = gw; blk < MT / 4; blk += NGW) {
        const int row0 = blk * 4, b = row0 / SEQ, t0 = row0 % SEQ;
        u32x4 w[19];
#pragma unroll
        for (int o = 0; o < 19; ++o) { int q = t0 + o - 8; q = q < 0 ? 0 : (q >= SEQ ? SEQ - 1 : q); w[o] = *(const u32x4*)(up + (size_t)(b * SEQ + q) * DPOOL + c0); }
#pragma unroll
        for (int r = 0; r < 4; ++r) {
            f32x4 s0 = {0.f, 0.f, 0.f, 0.f}, s1 = {0.f, 0.f, 0.f, 0.f}; float cnt = 0.f;
#pragma unroll
            for (int d = -8; d < 8; ++d) { const int q = t0 + r + d; const float m = (d >= -half && d < half && q >= 0 && q < SEQ) ? 1.f : 0.f; f32x4 a0, a1; unpack8(w[r + d + 8], a0, a1); s0 = s0 + a0 * m; s1 = s1 + a1 * m; cnt += m; }
            f32x4 c0v, c1v; unpack8(w[r + 8], c0v, c1v);
            const float inv = __builtin_amdgcn_rcpf(cnt);
            *(u32x4*)(po + (size_t)(row0 + r) * DPOOL + c0) = pack8(s0 * inv - c0v, s1 * inv - c1v);
        }
    }
}

__device__ __forceinline__ void p3_carries(const Args& a, const Frame& F, int g, int pm) {
    LAS float* TOT = (LAS float*)(F.lds);
    const int bs = F.tid >> 8, seg = (F.tid >> 6) & 3, n = F.tid & 63, b = 2 * pm + bs;
    for (int dir = 0; dir < 2; ++dir) {
        const float dt = expf(a.in[7][dir * NG + g]); const float a_re = -expf(a.in[5][(dir * NG + g) * NS + n]), a_im = a.in[6][(dir * NG + g) * NS + n];
        const float mg = expf((float)TCH * (a_re * dt)); float sn, cs; sincosf((float)TCH * (a_im * dt), &sn, &cs); const float lr = mg * cs, li = mg * sn;
        const float* fg = (const float*)(a.ws + WS_FG) + ((size_t)g * NCR + (size_t)b * NCHB) * 256 + dir * 128 + 2 * n;
        bf16_t* us = (bf16_t*)(a.ws + WS_USSM) + ((size_t)g * NCR + (size_t)b * NCHB) * ROWLEN + K1 + dir * 128 + 2 * n;
        f32x2 f[32];
#pragma unroll
        for (int k = 0; k < 32; ++k) { const int i = 32 * seg + k, c = dir == 0 ? i : NCHB - 1 - i; f[k] = *(const f32x2*)(fg + (size_t)c * 256); }
        float sr = 0.f, si = 0.f;
#pragma unroll
        for (int k = 0; k < 32; ++k) { const float nr = lr * sr - li * si + f[k].x, ni = lr * si + li * sr + f[k].y; sr = nr; si = ni; }
        TOT[F.tid * 2] = sr; TOT[F.tid * 2 + 1] = si;
        float pr = lr, pi = li;
#pragma unroll
        for (int q = 0; q < 5; ++q) { const float nr = pr * pr - pi * pi, ni = 2.f * pr * pi; pr = nr; pi = ni; }
        __syncthreads();
        sr = 0.f; si = 0.f;
        for (int s2 = 0; s2 < seg; ++s2) { const int o = (F.tid - 64 * (seg - s2)) * 2; const float tr = TOT[o], ti = TOT[o + 1]; const float nr = pr * sr - pi * si + tr, ni = pr * si + pi * sr + ti; sr = nr; si = ni; }
#pragma unroll
        for (int k = 0; k < 32; ++k) { const int i = 32 * seg + k, c = dir == 0 ? i : NCHB - 1 - i;
            *(unsigned*)(us + (size_t)c * ROWLEN) = pk2(sr, si);
            const float nr = lr * sr - li * si + f[k].x, ni = lr * si + li * sr + f[k].y; sr = nr; si = ni; }
        __syncthreads();
    }
    VM_WAIT(); __syncthreads();
}

__global__ void __launch_bounds__(512, 2) mk_fwd(Args args) {
    extern __shared__ __attribute__((aligned(16))) unsigned char lds_raw[];
    Frame F; F.lds = (LAS unsigned char*)lds_raw; F.tid = threadIdx.x; F.lane = F.tid & 63; F.wave = __builtin_amdgcn_readfirstlane(F.tid >> 6); F.G = gridDim.x; F.bx = blockIdx.x;
    volatile LAS unsigned* MISC = (volatile LAS unsigned*)(F.lds + LDSCTL_OFF);
    for (int u = F.tid; u < (LDS_BYTES - LDSCTL_OFF) / 4; u += 512) ((LAS unsigned*)(F.lds + LDSCTL_OFF))[u] = 0u;
    __syncthreads();
    unsigned char* ws = args.ws;
    XcdBarrier bar = xcd_barrier_post((unsigned*)(ws + WS_CTL), MISC + 8);
    const int lo = args.ph_lo, hi = args.ph_hi;
#define IN(k) (lo <= (k) && (k) < hi)
#define BOTH(k) (IN(k) && IN((k) == 2 ? 4 : (k) + 1))
    if (IN(0)) { ST(0); p0_prologue(args, F); ST(1); if (BOTH(0)) xcd_barrier(bar, F.tid); }
    if (IN(1)) { F.lane = lane_id_fresh(); F.tid = F.wave * 64 + F.lane; ST(2);
        GemmDesc g{(const char*)(ws + WS_XB), (const char*)(ws + WS_WIN), 256L * DM * 2, 0, 256L * DM * 2, 0, 128L * DM * 2, 128L * DM * 2, 128, 128, DM / BK};
        unsigned vA[2], vB[2]; voff_std(vA, DM, false, F.tid); voff_std(vB, DM, true, F.tid);
        StaticOrder S; S.init(MT / BM, DM / BM, F.G, F.bx);
        EpiU E{(const float*)(ws + WS_R0), (bf16_t*)(ws + WS_UPOOL), (bf16_t*)(ws + WS_USSM)};
        gemm_phase<EpiU, StaticOrder, true>(F.lds, g, vA, vB, S, E, F.tid, GP_STAMP(22));
        ST(3);
        if (BOTH(1)) xcd_barrier(bar, F.tid);
#if defined(MK_EXTRA_BAR)
        for (int rep = 0; rep < MK_EXTRA_BAR; ++rep) xcd_barrier(bar, F.tid);
#endif
    }
    if (IN(2)) { F.lane = lane_id_fresh(); F.tid = F.wave * 64 + F.lane; ST(4);
        if (F.bx < 128) {
            OrdSsmB S0{F.bx}; Unit u0; S0.next(0, u0);
            { GemmDesc g{(const char*)(ws + WS_USSM), (const char*)(ws + WS_WAB), 256L * ROWLEN * 2, (long)NCR * ROWLEN * 2, 0, 256L * K1 * 2, 128L * ROWLEN * 2, 128L * K1 * 2, 128, 128, K1 / BK};
              unsigned vA[2], vB[2]; voff_std(vA, ROWLEN, false, F.tid); voff_std(vB, K1, false, F.tid);
              OrdOne S{Unit{u0.pm, 0, u0.g}}; EpiFG E{(float*)(ws + WS_FG)};
              gemm_phase<EpiFG, OrdOne, true>(F.lds, g, vA, vB, S, E, F.tid, GP_STAMP(24)); }
            VM_WAIT(); __syncthreads(); ST(40);
            F.lane = lane_id_fresh(); F.tid = F.wave * 64 + F.lane;
            p3_carries(args, F, u0.g, u0.pm); ST(41);
            tb_wait(args, F, u0.g); ST(42);
            F.lane = lane_id_fresh(); F.tid = F.wave * 64 + F.lane;
            { GemmDesc g{(const char*)(ws + WS_USSM), (const char*)(ws + WS_TB), 256L * ROWLEN * 2, (long)NCR * ROWLEN * 2, 16L * 512, 64L * 512, 128L * ROWLEN * 2, 8L * 512, 128, -4L * 512, ROWLEN / BK,
                         (const char*)(ws + WS_TBC), 256L * 512, (long)K1 * 512, 128L * 512, 128, K1 / BK};
              unsigned vA[2], vB[2], vB2[2]; voff_std(vA, ROWLEN, false, F.tid); voff_std(vB2, 256, true, F.tid);
#pragma unroll
              for (int i = 0; i < 2; ++i) { int R, C; stage_rc(F.tid * 16 + i * 8192, R, C); const int Rb = (R & ~31) + perm32(R & 31);
                  vB[i] = (unsigned)((((Rb >> 4) - (C >> 4) + 31) * 256 + (Rb & 15) * 16 + (C & 15)) * 2); }
              asm volatile("" : "+v"(vA[0]), "+v"(vA[1]), "+v"(vB[0]), "+v"(vB[1]), "+v"(vB2[0]), "+v"(vB2[1]));
              OrdOne S{u0}; EpiZ E{(const bf16_t*)(ws + WS_USSM), args.in[12], (bf16_t*)(ws + WS_ZG)};
              gemm_phase<EpiZ, OrdOne, true, true>(F.lds, g, vA, vB, S, E, F.tid, GP_STAMP(26), vB2); }
        } else { ssm_side(args, F, 128); ST(44); p2_pooled(args, F, 128); }
        ST(5);
        if (BOTH(2)) xcd_barrier(bar, F.tid);
    }
    if (IN(4)) { F.lane = lane_id_fresh(); F.tid = F.wave * 64 + F.lane; ST(8);
        if (F.bx < 128) {
            constexpr long GSTR = (long)MT * 32;
            GemmDesc g{(const char*)(ws + WS_ZG), (const char*)(ws + WS_WGLU), 256L * 32, 0, 256L * DSSM * 2, 0, 128L * 32, 128L * DSSM * 2, 4 * GSTR, 128, DSSM / BK};
            unsigned vA[2], vB[2]; voff_std(vB, DSSM, true, F.tid);
#pragma unroll
            for (int i = 0; i < 2; ++i) { int R, C; stage_rc(F.tid * 16 + i * 8192, R, C); vA[i] = (unsigned)(R * 32 + (C >> 4) * (int)GSTR + (C & 15) * 2); }
            OrdGlu S{F.bx}; EpiGlu E{args.in[14], (const bf16_t*)(ws + WS_ZG), (bf16_t*)(ws + WS_YCAT), (float*)(ws + WS_SSSSM)};
            gemm_phase<EpiGlu, OrdGlu, true>(F.lds, g, vA, vB, S, E, F.tid, GP_STAMP(28));
        } else {
            GemmDesc g{(const char*)(ws + WS_POOLED), (const char*)(ws + WS_PW), 256L * DPOOL * 2, 256L * 2, 256L * 256 * 2, 0, 128L * DPOOL * 2, 128L * 256 * 2, 128, 128, 256 / BK};
            unsigned vA[2], vB[2]; voff_std(vA, DPOOL, false, F.tid); voff_std(vB, 256, true, F.tid);
            OrdPool S{F.bx}; EpiPool E{args.in[4], (bf16_t*)(ws + WS_YCAT), (float*)(ws + WS_SSPOOL)};
            gemm_phase<EpiPool, OrdPool, true>(F.lds, g, vA, vB, S, E, F.tid, GP_STAMP(36));

            __syncthreads();
            p4_side(args, F, 128);
        }
        ST(9);
        if (BOTH(4)) xcd_barrier(bar, F.tid);
    }
    if (IN(5)) { F.lane = lane_id_fresh(); F.tid = F.wave * 64 + F.lane; ST(10);
        StaticOrder S; S.init(MT / BM, DM / BM, F.G, F.bx); Unit u0;
        LAS f32x2* XR = (LAS f32x2*)(F.lds + XTRA_OFF);
        if (S.next(0, u0)) {
            if (F.tid < 256) { const int row = u0.pm * BM + F.tid; const float* sp = (const float*)(ws + WS_SSPOOL); const float* sm = (const float*)(ws + WS_SSSSM); float a0 = 0.f, a1 = 0.f;
#pragma unroll
                for (int s = 0; s < 8; ++s) { a0 += sp[(size_t)s * MT + row]; a1 += sm[(size_t)s * MT + row]; }
                const float rp = rsqrtf(a0 * (1.0f / DPOOL) + EPS), rsm = rsqrtf(a1 * (1.0f / DSSM) + EPS); XR[F.tid] = (f32x2){rp / rsm, rsm}; }
        }
        __syncthreads();
        GemmDesc g{(const char*)(ws + WS_YCAT), (const char*)(ws + WS_WOUT), 256L * DM * 2, 0, 256L * DM * 2, 0, 128L * DM * 2, 128L * DM * 2, 128, 128, DM / BK};
        unsigned vA[2], vB[2]; voff_std(vA, DM, false, F.tid); voff_std(vB, DM, true, F.tid);
        EpiOut E{args.in[0], (bf16_t*)(ws + WS_H1B), (float*)(ws + WS_SSH1), XR, {{0.f, 0.f, 0.f, 0.f}, {0.f, 0.f, 0.f, 0.f}}};
        { const int wr_ = F.wave >> 2, fr_ = F.lane & 15;
#pragma unroll
          for (int ai = 0; ai < 2; ++ai)
#pragma unroll
              for (int m = 0; m < 4; ++m) E.ratio[ai][m] = XR[ai * HALF + wr_ * 64 + m * 16 + fr_].x; }
        gemm_phase<EpiOut, StaticOrder, false>(F.lds, g, vA, vB, S, E, F.tid, GP_STAMP(30));
        ST(11);
        if (BOTH(5)) xcd_barrier(bar, F.tid);
    }
    if (IN(6)) { F.lane = lane_id_fresh(); F.tid = F.wave * 64 + F.lane; ST(12);
        GemmDesc g{(const char*)(ws + WS_H1B), (const char*)(ws + WS_WUP), (long)UPROWS * DM * 2, (long)PADROWS * DM * 2, 256L * DM * 2, 0, 64L * DM * 2, 128L * DM * 2, 128, 128, DM / BK};
        unsigned vA[2], vB[2]; voff_std(vB, DM, true, F.tid);
#pragma unroll
        for (int i = 0; i < 2; ++i) { int R, C; stage_rc(F.tid * 16 + i * 8192, R, C); vA[i] = (unsigned)(((126 * (R >> 6) + (R & 63)) * DM + C) * 2); }
        OrdUp S; S.so.init(BATCH * UPT, DFF2 / BM, F.G, F.bx);
        EpiUp E{(const float*)(ws + WS_SSH1), args.in[20], args.in[21], (bf16_t*)(ws + WS_ACT)};
        gemm_phase<EpiUp, OrdUp, true>(F.lds, g, vA, vB, S, E, F.tid, GP_STAMP(32));
        ST(13);
        if (BOTH(6)) xcd_barrier(bar, F.tid);
    }
    if (IN(7)) { F.lane = lane_id_fresh(); F.tid = F.wave * 64 + F.lane; ST(14);
        GemmDesc g{(const char*)(ws + WS_ACT), (const char*)(ws + WS_WDOWN), 256L * DFF * 2, 0, 256L * DFF * 2, 0, 128L * DFF * 2, 128L * DFF * 2, 128, 128, DFF / BK};
        unsigned vA[2], vB[2]; voff_std(vA, DFF, false, F.tid); voff_std(vB, DFF, true, F.tid);
        StaticOrder S; S.init(MT / BM, DM / BM, F.G, F.bx);
        EpiDown E{(const bf16_t*)(ws + WS_H1B), args.out, args.in[23], (float*)(ws + WS_SSH2), &bar};
        gemm_phase<EpiDown, StaticOrder, false>(F.lds, g, vA, vB, S, E, F.tid, GP_STAMP(34)); ST(15);
    }
#undef IN
#undef BOTH
}
}

__global__ void k_cvt_u(const bf16_t* __restrict__ upool, const bf16_t* __restrict__ ussm, float* __restrict__ u) {
    const int idx = blockIdx.x * blockDim.x + threadIdx.x; if (idx >= MT * DM) return;
    const int c = idx % DM, row = idx / DM; unsigned short v;
    if (c < DPOOL) v = upool[(size_t)row * DPOOL + c];
    else { const int cs = c - DPOOL, g = cs >> 4, h = cs & 15, cr = row / mk::TCH, p = row % mk::TCH; v = ussm[((size_t)(g * mk::NCR + cr)) * mk::ROWLEN + 16 * p + h]; }
    u[idx] = __builtin_bit_cast(float, (unsigned)v << 16);
}
__global__ void k_cvt_z(const bf16_t* __restrict__ zg, float* __restrict__ z) {
    const int idx = blockIdx.x * blockDim.x + threadIdx.x; if (idx >= MT * DSSM) return;
    const int c = idx % DSSM, row = idx / DSSM; const unsigned short v = zg[((size_t)(c >> 4) * MT + row) * 16 + (c & 15)];
    z[idx] = __builtin_bit_cast(float, (unsigned)v << 16);
}
__global__ void k_cvt_rows(const bf16_t* __restrict__ src, int lds_, float* __restrict__ dst, int ldd, int cols, int rows) {
    const size_t idx = (size_t)blockIdx.x * blockDim.x + threadIdx.x; if (idx >= (size_t)rows * cols) return;
    const int c = (int)(idx % cols); const size_t row = idx / cols; dst[row * ldd + c] = __builtin_bit_cast(float, (unsigned)src[row * lds_ + c] << 16);
}

#if defined(MK_STAMP)
__device__ float stamp_sel(const unsigned long long* st, int ia, int ib, int b0, int b1, int mode) {
    double acc = mode == 1 ? 1e30 : 0.0;
    for (int b = b0; b < b1; ++b) { const double d = (double)(long long)(st[b * 64 + ib] - (ia < 0 ? 0ull : st[b * 64 + ia])) * 0.01;
        if (mode == 0) acc = d > acc ? d : acc; else if (mode == 1) acc = d < acc ? d : acc; else acc += d / (b1 - b0); }
    return (float)acc;
}
__global__ void k_stamp_report(const unsigned long long* st, float* out, int a_ia, int a_ib, int a_b0, int a_b1, int a_mode, float scale) {
    if (blockIdx.x == 0 && threadIdx.x == 0) out[0] += stamp_sel(st, a_ia, a_ib, a_b0, a_b1, a_mode) * scale;
}
#endif

#ifndef MK_CUT
#define MK_CUT 8
#endif
static void gemm(hipStream_t s, const float* A, int lda, const float* B, int ldb, float* C, int ldc, const float* R, int ldr, int M, int N, int K) {
    hipLaunchKernelGGL(k_gemm, dim3(N / 128, M / 128), dim3(256), 0, s, A, lda, B, ldb, C, ldc, R, ldr, K);
}

extern "C" void kernel_launch(void* const* d_in, const int* in_sizes, int n_in, void* d_out, int out_size, void* d_ws, size_t ws_size, hipStream_t stream) {
    static int grid = 0;
    if (grid == 0) {
        int dev = 0, cus = 0, per_cu = 0;
        if (n_in != 24 || out_size != MT * DM || ws_size < mk::WS_END) { fprintf(stderr, "kernel_launch: unexpected problem (n_in %d out %d ws %zu)\n", n_in, out_size, ws_size); grid = -1; return; }
        if (hipGetDevice(&dev) != hipSuccess || hipDeviceGetAttribute(&cus, hipDeviceAttributeMultiprocessorCount, dev) != hipSuccess) { grid = -1; return; }
        if (hipFuncSetAttribute((const void*)mk::mk_fwd, hipFuncAttributeMaxDynamicSharedMemorySize, mk::LDS_BYTES) != hipSuccess) { fprintf(stderr, "kernel_launch: hipFuncSetAttribute failed\n"); grid = -1; return; }
        if (hipOccupancyMaxActiveBlocksPerMultiprocessor(&per_cu, (const void*)mk::mk_fwd, 512, mk::LDS_BYTES) != hipSuccess || per_cu < 1) { fprintf(stderr, "kernel_launch: occupancy query says %d blocks/CU\n", per_cu); }
        (void)hipGetLastError();
        grid = cus;
        if (grid != 256) { fprintf(stderr, "kernel_launch: built for a 256-CU device, found %d CUs\n", cus); grid = -1; return; }
    }
    if (grid < 0) return;
    const float* x = (const float*)d_in[0];
    const float* pool_w = (const float*)d_in[3];   const float* pool_scale = (const float*)d_in[4];
    const float* lnar = (const float*)d_in[5];     const float* aim = (const float*)d_in[6];   const float* ldt = (const float*)d_in[7];
    const float* bre = (const float*)d_in[8];      const float* bim = (const float*)d_in[9];
    const float* cre = (const float*)d_in[10];     const float* cim = (const float*)d_in[11];
    const float* ssm_d = (const float*)d_in[12];   const float* glu_w = (const float*)d_in[13]; const float* glu_b = (const float*)d_in[14];
    const float* g_pool = (const float*)d_in[15];  const float* g_ssm = (const float*)d_in[16];
    const float* w_out = (const float*)d_in[17];   const float* g_ffn = (const float*)d_in[18];
    const float* w_up = (const float*)d_in[19];    const float* conv_w = (const float*)d_in[20]; const float* conv_b = (const float*)d_in[21];
    const float* w_down = (const float*)d_in[22];  const float* g_final = (const float*)d_in[23];
    float* out = (float*)d_out; char* ws = (char*)d_ws; const size_t MiB = 1u << 20; const int EB = 256;
    (void)x; (void)pool_w; (void)pool_scale; (void)lnar; (void)aim; (void)ldt; (void)bre; (void)bim; (void)cre; (void)cim; (void)ssm_d; (void)glu_w; (void)glu_b; (void)g_pool; (void)g_ssm; (void)w_out; (void)g_ffn; (void)w_up; (void)conv_w; (void)conv_b; (void)w_down; (void)g_final;

    (void)hipMemsetAsync(ws + mk::WS_CTL, 0, mk::CTL_ZERO_BYTES, stream);
    mk::Args a{};
    for (int i = 0; i < 24; ++i) a.in[i] = (const float*)d_in[i];
    a.out = out; a.ws = (unsigned char*)d_ws; a.ph_lo = 0; a.ph_hi = MK_CUT;
#if defined(MK_PROBE_LO)
    a.ph_lo = 0; a.ph_hi = MK_PROBE_HI; hipLaunchKernelGGL(mk::mk_fwd, dim3(grid), dim3(512), mk::LDS_BYTES, stream, a);
    for (int r = 0; r < MK_PROBE_REP; ++r) { (void)hipMemsetAsync(ws + mk::WS_CTL, 0, mk::CTL_ZERO_BYTES, stream); a.ph_lo = MK_PROBE_LO; a.ph_hi = MK_PROBE_HI; hipLaunchKernelGGL(mk::mk_fwd, dim3(grid), dim3(512), mk::LDS_BYTES, stream, a); }
    (void)hipMemsetAsync(ws + mk::WS_CTL, 0, mk::CTL_ZERO_BYTES, stream);
    a.ph_lo = MK_PROBE_HI; a.ph_hi = 8; hipLaunchKernelGGL(mk::mk_fwd, dim3(grid), dim3(512), mk::LDS_BYTES, stream, a);
#else
    hipLaunchKernelGGL(mk::mk_fwd, dim3(grid), dim3(512), mk::LDS_BYTES, stream, a);
#endif
#if defined(MK_STAMP)
    hipLaunchKernelGGL(k_stamp_report, dim3(1), dim3(64), 0, stream, (const unsigned long long*)(ws + mk::WS_STAMP), out, MK_STAMP_A);
#endif
#if MK_CUT < 8
    float* bufA = (float*)(ws + 0 * MiB); float* bufB = (float*)(ws + 64 * MiB); float* bufC = (float*)(ws + 128 * MiB); float* bufD = (float*)(ws + 192 * MiB);
    float* pooled = bufA; float* ypool = bufA + (size_t)MT * DPOOL; float* z = pooled; float* pre = bufD; float* ycat = bufB;
#if MK_CUT <= 2
    float* u = bufB;
    hipLaunchKernelGGL(k_cvt_u, dim3(MT * DM / EB), dim3(EB), 0, stream, (const bf16_t*)(ws + mk::WS_UPOOL), (const bf16_t*)(ws + mk::WS_USSM), u);
    hipLaunchKernelGGL(k_pool, dim3(MT * DPOOL / EB), dim3(EB), 0, stream, u, pooled);
    for (int gi = 0; gi < 4; ++gi) gemm(stream, pooled + gi * 128, DPOOL, pool_w + (size_t)gi * 128 * 128, 128, ypool + gi * 128, DPOOL, nullptr, 0, MT, 128, 128);
    float* y2 = bufC;
    hipLaunchKernelGGL(k_ssm_scan, dim3(2 * BATCH * NG), dim3(64), 0, stream, u, lnar, aim, ldt, bre, bim, cre, cim, y2);
    hipLaunchKernelGGL(k_ssm_post, dim3(MT * DSSM / EB), dim3(EB), 0, stream, y2, u, ssm_d, z);
    const float* pre_scale = pool_scale;
#elif MK_CUT <= 4
    hipLaunchKernelGGL(k_cvt_z, dim3(MT * DSSM / EB), dim3(EB), 0, stream, (const bf16_t*)(ws + mk::WS_ZG), z);
    hipLaunchKernelGGL(k_cvt_rows, dim3(MT * DPOOL / EB), dim3(EB), 0, stream, (const bf16_t*)(ws + mk::WS_YCAT), DM, ypool, DPOOL, DPOOL, MT);
    const float* pre_scale = nullptr;
#endif
#if MK_CUT <= 4
    gemm(stream, z, DSSM, glu_w, DSSM, pre, DSSM, nullptr, 0, MT, DSSM, DSSM);
    hipLaunchKernelGGL(k_glu, dim3(MT * DSSM / EB), dim3(EB), 0, stream, z, pre, glu_b);
#elif MK_CUT == 5
    hipLaunchKernelGGL(k_cvt_rows, dim3(MT * DPOOL / EB), dim3(EB), 0, stream, (const bf16_t*)(ws + mk::WS_YCAT), DM, ypool, DPOOL, DPOOL, MT);
    hipLaunchKernelGGL(k_cvt_rows, dim3(MT * DSSM / EB), dim3(EB), 0, stream, (const bf16_t*)(ws + mk::WS_YCAT) + DPOOL, DM, pre, DSSM, DSSM, MT);
    const float* pre_scale = nullptr;
#endif
#if MK_CUT <= 5
    hipLaunchKernelGGL(k_rmsnorm, dim3(MT / 4), dim3(256), 0, stream, ypool, DPOOL, pre_scale, g_pool, ycat, DM, DPOOL, MT);
    hipLaunchKernelGGL(k_rmsnorm, dim3(MT / 4), dim3(256), 0, stream, pre, DSSM, (const float*)nullptr, g_ssm, ycat + DPOOL, DM, DSSM, MT);
    gemm(stream, ycat, DM, w_out, DM, out, DM, x, DM, MT, DM, DM);
#endif
#if MK_CUT <= 6
    float* xn2 = bufA;
    hipLaunchKernelGGL(k_rmsnorm, dim3(MT / 4), dim3(256), 0, stream, out, DM, (const float*)nullptr, g_ffn, xn2, DM, DM, MT);
    float* up = (float*)(ws + 64 * MiB); float* act = (float*)(ws + 152 * MiB);
    for (int b = 0; b < BATCH; ++b) {
        gemm(stream, xn2 + (size_t)b * SEQ * DM, DM, w_up, DFF2, up, DFF2, nullptr, 0, SEQ, DFF2, DM);
        hipLaunchKernelGGL(k_convact, dim3(SEQ * DFF / EB), dim3(EB), 0, stream, up, conv_w, conv_b, act);
        gemm(stream, act, DFF, w_down, DM, out + (size_t)b * SEQ * DM, DM, out + (size_t)b * SEQ * DM, DM, SEQ, DM, DFF);
    }
#else
    float* actf = (float*)(ws + 0 * MiB);
    for (int b = 0; b < BATCH; ++b) {
        hipLaunchKernelGGL(k_cvt_rows, dim3(SEQ * DFF / EB), dim3(EB), 0, stream, (const bf16_t*)(ws + mk::WS_ACT) + (size_t)b * SEQ * DFF, DFF, actf, DFF, DFF, SEQ);
        gemm(stream, actf, DFF, w_down, DM, out + (size_t)b * SEQ * DM, DM, out + (size_t)b * SEQ * DM, DM, SEQ, DM, DFF);
    }
#endif
    hipLaunchKernelGGL(k_rmsnorm, dim3(MT / 4), dim3(256), 0, stream, out, DM, (const float*)nullptr, g_final, out, DM, DM, MT);
    (void)bufC;
#endif
}
```

```cpp
#define MK_CUT 8
#include <hip/hip_runtime.h>
#include <math.h>

constexpr int BATCH = 4, SEQ = 4096, DM = 1024, MT = BATCH * SEQ;
constexpr int DPOOL = 512, DSSM = 512, NG = 32, NH = 16, NS = 64;
constexpr int DFF = 2816, DFF2 = 5632;
constexpr float EPS = 1e-6f;

__global__ void k_rmsnorm(const float* x, int ldx, const float* __restrict__ pre,
                          const float* __restrict__ g, float* out, int ldo, int D, int rows) {
    const int wave = (blockIdx.x * blockDim.x + threadIdx.x) >> 6, lane = threadIdx.x & 63;
    if (wave >= rows) return;
    const float* xr = x + (size_t)wave * ldx;
    float ss = 0.f;
    for (int c = lane; c < D; c += 64) { float v = xr[c]; if (pre) v *= pre[c]; ss += v * v; }
    for (int o = 32; o; o >>= 1) ss += __shfl_xor(ss, o);
    const float inv = rsqrtf(ss / (float)D + EPS);
    float* orow = out + (size_t)wave * ldo;
    for (int c = lane; c < D; c += 64) { float v = xr[c]; if (pre) v *= pre[c]; orow[c] = v * inv * g[c]; }
}

__global__ void __launch_bounds__(256) k_gemm(const float* __restrict__ A, int lda, const float* __restrict__ B, int ldb,
                                               float* C, int ldc, const float* R, int ldr, int K) {
    __shared__ float As[16][132];
    __shared__ float Bs[16][132];
    const int tid = threadIdx.x, tx = tid & 15, ty = tid >> 4;
    const int row0 = blockIdx.y * 128, col0 = blockIdx.x * 128;
    float acc[8][8];
#pragma unroll
    for (int i = 0; i < 8; ++i)
#pragma unroll
        for (int j = 0; j < 8; ++j) acc[i][j] = 0.f;
    for (int k0 = 0; k0 < K; k0 += 16) {
#pragma unroll
        for (int p = 0; p < 2; ++p) {
            const int i = tid + p * 256, r = i >> 2, kk = (i & 3) * 4;
            const float4 v = *(const float4*)(A + (size_t)(row0 + r) * lda + k0 + kk);
            As[kk + 0][r] = v.x; As[kk + 1][r] = v.y; As[kk + 2][r] = v.z; As[kk + 3][r] = v.w;
        }
#pragma unroll
        for (int p = 0; p < 2; ++p) {
            const int i = tid + p * 256, kk = i >> 5, c = (i & 31) * 4;
            const float4 v = *(const float4*)(B + (size_t)(k0 + kk) * ldb + col0 + c);
            *(float4*)&Bs[kk][c] = v;
        }
        __syncthreads();
#pragma unroll
        for (int kk = 0; kk < 16; ++kk) {
            float a[8], b[8];
            const float4 a0 = *(const float4*)&As[kk][ty * 4], a1 = *(const float4*)&As[kk][64 + ty * 4];
            const float4 b0 = *(const float4*)&Bs[kk][tx * 4], b1 = *(const float4*)&Bs[kk][64 + tx * 4];
            a[0] = a0.x; a[1] = a0.y; a[2] = a0.z; a[3] = a0.w; a[4] = a1.x; a[5] = a1.y; a[6] = a1.z; a[7] = a1.w;
            b[0] = b0.x; b[1] = b0.y; b[2] = b0.z; b[3] = b0.w; b[4] = b1.x; b[5] = b1.y; b[6] = b1.z; b[7] = b1.w;
#pragma unroll
            for (int i = 0; i < 8; ++i)
#pragma unroll
                for (int j = 0; j < 8; ++j) acc[i][j] = fmaf(a[i], b[j], acc[i][j]);
        }
        __syncthreads();
    }
#pragma unroll
    for (int i = 0; i < 8; ++i) {
        const int r = row0 + (i < 4 ? ty * 4 + i : 64 + ty * 4 + (i - 4));
#pragma unroll
        for (int jh = 0; jh < 2; ++jh) {
            const int c = col0 + jh * 64 + tx * 4;
            float4 v = make_float4(acc[i][jh * 4 + 0], acc[i][jh * 4 + 1], acc[i][jh * 4 + 2], acc[i][jh * 4 + 3]);
            if (R) { const float4 rr = *(const float4*)(R + (size_t)r * ldr + c); v.x += rr.x; v.y += rr.y; v.z += rr.z; v.w += rr.w; }
            *(float4*)(C + (size_t)r * ldc + c) = v;
        }
    }
}

__global__ void k_pool(const float* __restrict__ u  , float* __restrict__ pooled  ) {
    const int idx = blockIdx.x * blockDim.x + threadIdx.x;
    if (idx >= MT * DPOOL) return;
    const int c = idx % DPOOL, row = idx / DPOOL, b = row / SEQ, t = row % SEQ;
    const int gi = c / 128, w = 2 << gi, half = w / 2;
    int lo = t - half, hi = t + half; if (lo < 0) lo = 0; if (hi > SEQ) hi = SEQ;
    float s = 0.f;
    for (int q = lo; q < hi; ++q) s += u[(size_t)(b * SEQ + q) * DM + c];
    pooled[idx] = s / (float)(hi - lo) - u[(size_t)row * DM + c];
}

__global__ void __launch_bounds__(64) k_ssm_scan(const float* __restrict__ u  ,
        const float* __restrict__ lnar, const float* __restrict__ aim, const float* __restrict__ ldt,
        const float* __restrict__ bre, const float* __restrict__ bim, const float* __restrict__ cre, const float* __restrict__ cim,
        float* __restrict__ y  ) {
    const int n = threadIdx.x;
    const int g = blockIdx.x % NG, b = (blockIdx.x / NG) % BATCH, dir = blockIdx.x / (NG * BATCH);
    const float dt = expf(ldt[dir * NG + g]);
    const float a_re = -expf(lnar[(dir * NG + g) * NS + n]), a_im = aim[(dir * NG + g) * NS + n];
    const float mag = expf(a_re * dt), ang = a_im * dt;
    const float lam_re = mag * cosf(ang), lam_im = mag * sinf(ang);
    const float den = a_re * a_re + a_im * a_im;
    const float f_re = ((lam_re - 1.0f) * a_re + lam_im * a_im) / den;
    const float f_im = (lam_im * a_re - (lam_re - 1.0f) * a_im) / den;
    float Br[NH], Bi[NH], Cr[NH], Ci[NH];
#pragma unroll
    for (int h = 0; h < NH; ++h) {
        Br[h] = bre[((size_t)(dir * NG + g) * NS + n) * NH + h];
        Bi[h] = bim[((size_t)(dir * NG + g) * NS + n) * NH + h];
        Cr[h] = cre[((size_t)(dir * NG + g) * NH + h) * NS + n];
        Ci[h] = cim[((size_t)(dir * NG + g) * NH + h) * NS + n];
    }
    float s_re = 0.f, s_im = 0.f;
    float* yd = y + (size_t)dir * MT * DSSM;
    for (int i = 0; i < SEQ; ++i) {
        const int t = dir ? (SEQ - 1 - i) : i;
        const float* ur = u + (size_t)(b * SEQ + t) * DM + DPOOL + g * NH;
        float bu_re = 0.f, bu_im = 0.f;
#pragma unroll
        for (int h = 0; h < NH; ++h) { const float uv = ur[h]; bu_re = fmaf(Br[h], uv, bu_re); bu_im = fmaf(Bi[h], uv, bu_im); }
        const float in_re = f_re * bu_re - f_im * bu_im, in_im = f_re * bu_im + f_im * bu_re;
        const float nr = lam_re * s_re - lam_im * s_im + in_re;
        const float ni = lam_re * s_im + lam_im * s_re + in_im;
        s_re = nr; s_im = ni;
        float mine = 0.f;
#pragma unroll
        for (int h = 0; h < NH; ++h) {
            float p = Cr[h] * s_re - Ci[h] * s_im;
#pragma unroll
            for (int o = 32; o; o >>= 1) p += __shfl_xor(p, o);
            if (n == h) mine = p;
        }
        if (n < NH) yd[(size_t)(b * SEQ + t) * DSSM + g * NH + n] = mine;
    }
}

__device__ __forceinline__ float gelu_tanh(float x) {
    const float k = 0.7978845608028654f;
    return 0.5f * x * (1.0f + tanhf(k * (x + 0.044715f * x * x * x)));
}
__device__ __forceinline__ float sigmoidf_(float x) { return 1.0f / (1.0f + expf(-x)); }

__global__ void k_ssm_post(const float* __restrict__ y2, const float* __restrict__ u, const float* __restrict__ d, float* __restrict__ z) {
    const int idx = blockIdx.x * blockDim.x + threadIdx.x;
    if (idx >= MT * DSSM) return;
    const int c = idx % DSSM, row = idx / DSSM;
    const float yv = y2[idx] + y2[(size_t)MT * DSSM + idx] + d[c] * u[(size_t)row * DM + DPOOL + c];
    z[idx] = gelu_tanh(yv);
}
__global__ void k_glu(const float* __restrict__ z, float* __restrict__ pre, const float* __restrict__ gb) {
    const int idx = blockIdx.x * blockDim.x + threadIdx.x;
    if (idx >= MT * DSSM) return;
    const int c = idx % DSSM;
    pre[idx] = z[idx] * sigmoidf_(pre[idx] + gb[c]);
}
__global__ void k_convact(const float* __restrict__ up  , const float* __restrict__ cw, const float* __restrict__ cb, float* __restrict__ act  ) {
    const int idx = blockIdx.x * blockDim.x + threadIdx.x;
    if (idx >= SEQ * DFF) return;
    const int f = idx % DFF, t = idx / DFF;
    float v = cb[f], gt = cb[DFF + f];
#pragma unroll
    for (int k = 0; k < 3; ++k) {
        const int q = t + k - 1;
        if (q >= 0 && q < SEQ) {
            v = fmaf(up[(size_t)q * DFF2 + f], cw[k * DFF2 + f], v);
            gt = fmaf(up[(size_t)q * DFF2 + DFF + f], cw[k * DFF2 + DFF + f], gt);
        }
    }
    act[idx] = v * (gt * sigmoidf_(gt));
}


#include <cstdio>
#include <cstdint>
#define LAS __attribute__((address_space(3)))
#define GAS __attribute__((address_space(1)))
typedef unsigned short bf16_t;
typedef short bf16x8 __attribute__((ext_vector_type(8)));
typedef float f32x4 __attribute__((ext_vector_type(4)));
typedef float f32x2 __attribute__((ext_vector_type(2)));
typedef unsigned u32x4 __attribute__((ext_vector_type(4)));
typedef unsigned u32x2 __attribute__((ext_vector_type(2)));

namespace mk {
constexpr int TCH = 32;
constexpr int K1 = 16 * TCH;
constexpr int ROWLEN = K1 + 256;
constexpr int NCR = MT / TCH;
constexpr int NCHB = SEQ / TCH;
constexpr int PADROWS = 4352;
constexpr int UPT = 17;
constexpr int UPROWS = 252;

constexpr size_t MiB = 1u << 20;
constexpr size_t WS_CTL = 0, CTL_ZERO_BYTES = 64 * 1024;
constexpr int CW_TBCNT = 4096;
constexpr size_t WS_R0 = 1 * MiB;
constexpr size_t WS_SSPOOL = 2 * MiB;
constexpr size_t WS_SSSSM = WS_SSPOOL + 8 * MT * 4;
constexpr size_t WS_SSH1 = WS_SSSSM + 8 * MT * 4;
constexpr size_t WS_SSH2 = WS_SSH1 + 4 * MT * 4;
constexpr size_t WS_WIN = 8 * MiB, WS_WOUT = 10 * MiB, WS_WGLU = 12 * MiB, WS_PW = 12 * MiB + 512 * 1024;
constexpr size_t WS_WUP = 13 * MiB, WS_WDOWN = 24 * MiB;
constexpr size_t WS_WAB = 30 * MiB;
constexpr size_t WS_TB = 38 * MiB;
constexpr size_t WS_TBC = 40 * MiB;
constexpr size_t WS_H1B = 62 * MiB;
constexpr size_t WS_XB = 96 * MiB;
constexpr size_t WS_YCAT = 96 * MiB;
constexpr size_t WS_UPOOL = 128 * MiB;
constexpr size_t WS_USSM = 144 * MiB;
constexpr size_t WS_FG = 168 * MiB;
constexpr size_t WS_POOLED = 184 * MiB;
constexpr size_t WS_ZG = 200 * MiB;
constexpr size_t WS_ACT = 96 * MiB;
constexpr size_t WS_END = 216 * MiB;

constexpr int RING_BYTES = 131072, XTRA_OFF = RING_BYTES, XTRA_BYTES = 12288, LDSCTL_OFF = XTRA_OFF + XTRA_BYTES, LDS_BYTES = 147456;

__device__ __forceinline__ unsigned f2bf(float f) { unsigned u = __builtin_bit_cast(unsigned, f); return (u + 0x7fffu + ((u >> 16) & 1u)) >> 16; }
__device__ __forceinline__ unsigned pk2(float lo, float hi) { return f2bf(lo) | (f2bf(hi) << 16); }
__device__ __forceinline__ unsigned cvt_pk_bf16(float lo, float hi) { unsigned r; asm volatile("v_cvt_pk_bf16_f32 %0, %1, %2" : "=v"(r) : "v"(lo), "v"(hi)); return r; }
__device__ __forceinline__ u32x4 pack8(f32x4 a, f32x4 b) { u32x4 w; w.x = cvt_pk_bf16(a[0], a[1]); w.y = cvt_pk_bf16(a[2], a[3]); w.z = cvt_pk_bf16(b[0], b[1]); w.w = cvt_pk_bf16(b[2], b[3]); return w; }
__device__ __forceinline__ u32x2 pack4(f32x4 a) { u32x2 w; w.x = cvt_pk_bf16(a[0], a[1]); w.y = cvt_pk_bf16(a[2], a[3]); return w; }
__device__ __forceinline__ float bflo(unsigned w) { return __builtin_bit_cast(float, w << 16); }
__device__ __forceinline__ float bfhi(unsigned w) { return __builtin_bit_cast(float, w & 0xffff0000u); }
__device__ __forceinline__ void unpack8(u32x4 w, f32x4& a, f32x4& b) { a[0] = bflo(w.x); a[1] = bfhi(w.x); a[2] = bflo(w.y); a[3] = bfhi(w.y); b[0] = bflo(w.z); b[1] = bfhi(w.z); b[2] = bflo(w.w); b[3] = bfhi(w.w); }
__device__ __forceinline__ float fast_sigmoid(float x) { return __builtin_amdgcn_rcpf(1.0f + __builtin_amdgcn_exp2f(-1.4426950408889634f * x)); }
__device__ __forceinline__ float fast_gelu_tanh(float x) {
    const float t = x * (1.0f + 0.044715f * x * x);
    return x * __builtin_amdgcn_rcpf(1.0f + __builtin_amdgcn_exp2f(-2.0f * 0.7978845608028654f * 1.4426950408889634f * t));
}
__device__ __forceinline__ float wave_sum(float v) {
#pragma unroll
    for (int o = 1; o < 64; o <<= 1) v += __shfl_xor(v, o);
    return v;
}
__device__ __forceinline__ float dpp_ror1(float v)  { return __builtin_bit_cast(float, __builtin_amdgcn_update_dpp(0, __builtin_bit_cast(int, v), 0x121, 0xf, 0xf, false)); }
__device__ __forceinline__ float dpp_ror15(float v) { return __builtin_bit_cast(float, __builtin_amdgcn_update_dpp(0, __builtin_bit_cast(int, v), 0x12F, 0xf, 0xf, false)); }
__device__ __forceinline__ int lane_id_fresh() { int l; asm volatile("v_mbcnt_lo_u32_b32 %0, -1, 0\n\tv_mbcnt_hi_u32_b32 %0, -1, %0" : "=v"(l)); return l; }
#define LDS_WAIT() asm volatile("s_waitcnt lgkmcnt(0)" ::: "memory")
#define VM_WAIT() asm volatile("s_waitcnt vmcnt(0)" ::: "memory")

#define XB_TMO      128
#define XB_XCNT(j)  (256  + 64 * (j))
#define XB_XSUB(j)  (1280 + 64 * (j))
#define XB_XGEN(j)  (2304 + 64 * (j))
#define XB_TOP      3328
#define XB_TOPGEN   3392
#define XCD_BAR_WORDS 3456
#define XB_SPIN_CAP (1u << 18)
__device__ __forceinline__ unsigned xb_ld(unsigned* p)              { return __hip_atomic_load(p, __ATOMIC_RELAXED, __HIP_MEMORY_SCOPE_AGENT); }
__device__ __forceinline__ unsigned xb_add(unsigned* p, unsigned v) { return __hip_atomic_fetch_add(p, v, __ATOMIC_RELAXED, __HIP_MEMORY_SCOPE_AGENT); }
__device__ __forceinline__ unsigned xb_xcc_id() { return (unsigned)__builtin_amdgcn_s_getreg((3 << 11) | 20) & 0xFu; }
#define XB_SPIN(cond, bar) do { unsigned _sp = 0; while (cond) { __builtin_amdgcn_s_sleep(1); \
    if ((++_sp & 255u) == 0u) { if (xb_ld(&(bar)[XB_TMO])) break; if (_sp > XB_SPIN_CAP) { atomicAdd(&(bar)[XB_TMO], 1u); break; } } } } while (0)
struct XcdBarrier { unsigned* bar; unsigned x; volatile LAS unsigned* st; };
__device__ __forceinline__ XcdBarrier xcd_barrier_post(unsigned* bar, volatile LAS unsigned* st) {
    XcdBarrier b; b.bar = bar; b.x = xb_xcc_id(); b.st = st;
    if (threadIdx.x == 0) (void)xb_add(&bar[XB_XCNT(b.x)], 1u);
    return b;
}
__device__ __forceinline__ void xcd_barrier_complete(unsigned* bar, unsigned x, unsigned& nloc, unsigned& nx) {
    const unsigned G = gridDim.x * gridDim.y * gridDim.z;
    unsigned sum, cnt, mine, sp = 0u;
    for (;;) {
        sum = 0u; cnt = 0u; mine = 0u;
#pragma unroll
        for (unsigned j = 0; j < 16; ++j) { const unsigned c = xb_ld(&bar[XB_XCNT(j)]); sum += c; cnt += (c > 0u) ? 1u : 0u; mine = (j == x) ? c : mine; }
        if (sum == G) break;
        __builtin_amdgcn_s_sleep(1);
        if ((++sp & 255u) == 0u) { if (xb_ld(&bar[XB_TMO])) break; if (sp > XB_SPIN_CAP) { atomicAdd(&bar[XB_TMO], 1u); break; } }
    }
    nloc = mine > 0u ? mine : 1u; nx = cnt > 0u ? cnt : 1u;
}
__device__ __forceinline__ void xcd_barrier(const XcdBarrier& b, int tid) {
    asm volatile("s_waitcnt vmcnt(0)" ::: "memory");
    __syncthreads();
    if (tid == 0) {
        unsigned* bar = b.bar;
        __builtin_amdgcn_s_waitcnt(0);
        unsigned nloc = b.st[0], nx = b.st[1];
        if (nloc == 0u) { xcd_barrier_complete(bar, b.x, nloc, nx); b.st[0] = nloc; b.st[1] = nx; }
        const unsigned old = xb_add(&bar[XB_XSUB(b.x)], 1u);
        const unsigned gen = old / nloc;
        if (old + 1u == (gen + 1u) * nloc) {
            __builtin_amdgcn_fence(__ATOMIC_RELEASE, "agent");
            asm volatile("s_waitcnt vmcnt(0)" ::: "memory");
            const unsigned og = xb_add(&bar[XB_TOP], 1u);
            const unsigned tg = og / nx;
            if (og + 1u == (tg + 1u) * nx) xb_add(&bar[XB_TOPGEN], 1u);
            else XB_SPIN(xb_ld(&bar[XB_TOPGEN]) == tg, bar);
            __builtin_amdgcn_fence(__ATOMIC_ACQUIRE, "agent");
            xb_add(&bar[XB_XGEN(b.x)], 1u);
            asm volatile("s_waitcnt vmcnt(0)" ::: "memory");
        } else {
            XB_SPIN(xb_ld(&bar[XB_XGEN(b.x)]) == gen, bar);
            __builtin_amdgcn_fence(__ATOMIC_ACQUIRE, "agent");
            asm volatile("s_waitcnt vmcnt(0)" ::: "memory");
        }
    }
    __syncthreads();
}

constexpr int BM = 256, BK = 64, HALF = 128, HTB = HALF * BK * 2, STAGE_BYTES = 8 * HTB, NXCD = 8, WGM = 8;
__host__ __device__ __forceinline__ int lds_byte(int r, int c) { const int st = (r >> 4) * 2 + (c >> 5), rr = r & 15, cc = c & 31, ob = rr * 64 + cc * 2; return st * 1024 + (ob ^ (((ob >> 9) & 1) << 5)); }
__host__ __device__ __forceinline__ void stage_rc(int b, int& R, int& C) { const int st = b / 1024, sb = b % 1024, swz = sb ^ (((sb >> 9) & 1) << 5); R = (st >> 1) * 16 + swz / 64; C = (st & 1) * 32 + (swz % 64) / 2; }
__host__ __device__ __forceinline__ int perm32(int rho) { const int n = rho >> 4, i = rho & 15; return 8 * (i >> 2) + 4 * n + (i & 3); }

struct Unit { int pm, pn, g, aux; };
struct GemmDesc { const char* A; const char* B; long a_pm, a_g, b_pn, b_g, a_h, b_h, a_k, b_k; int nt;
                  const char* B2; long b2_pn, b2_g, b2_h, b2_k; int tsw; };

struct StaticOrder {
    int nM, nN, nwg, G, c;
    __device__ void init(int nM_, int nN_, int G_, int c_) { nM = nM_; nN = nN_; nwg = nM * nN; G = G_; c = c_; }
    __device__ bool next(int i, Unit& u) const {
        const long L = (long)i * G + c; if (L >= nwg) return false;
        int wgid = (int)L; { const int q = nwg / NXCD, r = nwg % NXCD, xcd = wgid % NXCD, off = wgid / NXCD; wgid = (xcd < r ? xcd * (q + 1) : r * (q + 1) + (xcd - r) * q) + off; }
        const int nig = WGM * nN, gid = wgid / nig, fm = gid * WGM, gsz = (nM - fm) < WGM ? (nM - fm) : WGM;
        u.pm = fm + ((wgid % nig) % gsz); u.pn = (wgid % nig) / gsz; u.g = 0; u.aux = 0; return true;
    }
};

template <class Epi, class Sched, bool ALIGN_EPI, bool SEG2 = false>
__device__ __forceinline__ void gemm_phase(LAS unsigned char* lds, const GemmDesc g, const unsigned (&voffA)[2], const unsigned (&voffB)[2], const Sched& S, Epi& E, int tid, unsigned long long* stp = nullptr, const unsigned* voffB2 = nullptr) {
    const int wid = __builtin_amdgcn_readfirstlane(tid >> 6), lane = tid & 63, wr = wid >> 2, wc = wid & 3, fr = lane & 15, fq = lane >> 4;
    const int nt = g.nt;
    const long kstepA = g.a_k, kstepB = g.b_k, hstepA = g.a_h, hstepB = g.b_h;
    const unsigned ldsw = (unsigned)wid * 1024u;
    const int aoff = lds_byte(wr * 64 + fr, fq * 8), boff = lds_byte(wc * 32 + fr, fq * 8);
#define PG8_SA(b, h) (((b) * 2 + (h)) * HTB)
#define PG8_SB(b, h) ((4 + (b) * 2 + (h)) * HTB)
#define PG8_STAGE(bufoff, gbase, voff) do { const char* _gb = (const char*)(gbase); asm volatile("" : "+s"(_gb));   _Pragma("unroll") for (int _i = 0; _i < 2; ++_i) \
        __builtin_amdgcn_global_load_lds((const unsigned*)(_gb + (voff)[_i]), (LAS unsigned*)(lds + (bufoff) + ldsw + _i * 8192), 16, 0, 0); } while (0)
#define PG8_LDA(dst, b, h) do { _Pragma("unroll") for (int m = 0; m < 4; ++m) _Pragma("unroll") for (int k = 0; k < 2; ++k) dst[m][k] = *(const LAS bf16x8*)(lds + PG8_SA(b, h) + aoff + m * 2048 + k * 1024); } while (0)
#define PG8_LDB(dst, b, h) do { _Pragma("unroll") for (int n = 0; n < 2; ++n) _Pragma("unroll") for (int k = 0; k < 2; ++k) dst[n][k] = *(const LAS bf16x8*)(lds + PG8_SB(b, h) + boff + n * 2048 + k * 1024); } while (0)
#define PG8_MMA(ai, bj, At, Bt) do { __builtin_amdgcn_s_setprio(1); _Pragma("unroll") for (int m = 0; m < 4; ++m) _Pragma("unroll") for (int n = 0; n < 2; ++n) _Pragma("unroll") for (int k = 0; k < 2; ++k) \
        acc[ai][bj][m][n] = __builtin_amdgcn_mfma_f32_16x16x32_bf16(Bt[n][k], At[m][k], acc[ai][bj][m][n], 0, 0, 0); __builtin_amdgcn_s_setprio(0); } while (0)
#define PG8_WAIT_V(n) asm volatile("s_waitcnt vmcnt(" #n ")" ::: "memory")
#define PG8_WAIT_L(n) asm volatile("s_waitcnt lgkmcnt(" #n ")" ::: "memory")
#define PG8_BAR __builtin_amdgcn_s_barrier()
#define PG8_SCHED __builtin_amdgcn_sched_barrier(0)
    Unit cur, nxt; int ui = 0;
    if (!S.next(0, cur)) return;
    f32x4 acc[2][2][4][2];
#pragma unroll
    for (int a = 0; a < 2; ++a)
#pragma unroll
        for (int b = 0; b < 2; ++b)
#pragma unroll
            for (int m = 0; m < 4; ++m)
#pragma unroll
                for (int n = 0; n < 2; ++n) acc[a][b][m][n] = (f32x4){0.f, 0.f, 0.f, 0.f};
    bf16x8 At[4][2], B0[2][2], B1[2][2];
    const char* cA = g.A + (long)cur.pm * g.a_pm + (long)cur.g * g.a_g; const char* cB = g.B + (long)cur.pn * g.b_pn + (long)cur.g * g.b_g;
    const char* cB2 = SEG2 ? g.B2 + (long)cur.pn * g.b2_pn + (long)cur.g * g.b2_g : nullptr;
    PG8_STAGE(PG8_SB(0, 0), cB, voffB); PG8_STAGE(PG8_SB(0, 1), cB + hstepB, voffB); PG8_STAGE(PG8_SA(0, 0), cA, voffA); PG8_STAGE(PG8_SA(0, 1), cA + hstepA, voffA);
    if (wr == 1) PG8_BAR;
    PG8_WAIT_V(2); PG8_BAR;
    PG8_STAGE(PG8_SB(1, 0), cB + kstepB, voffB); PG8_STAGE(PG8_SA(1, 0), cA + kstepA, voffA); PG8_STAGE(PG8_SB(1, 1), cB + hstepB + kstepB, voffB);
    PG8_WAIT_V(6); PG8_BAR;
    unsigned long long st_t0 = stp ? __builtin_amdgcn_s_memrealtime() : 0ull, st_loop = 0ull, st_epi = 0ull;
    for (;;) {
        const bool has_next = S.next(ui + 1, nxt);
        const char* nA = has_next ? g.A + (long)nxt.pm * g.a_pm + (long)nxt.g * g.a_g : cA; const char* nB = has_next ? g.B + (long)nxt.pn * g.b_pn + (long)nxt.g * g.b_g : cB;
        for (int t = 0; t < nt; t += 2) {
            const bool last = (t == nt - 2);
            const char* a1 = cA + (long)(t + 1) * kstepA;
            const bool sg = SEG2 && !last && (t + 2 >= g.tsw);
            const char* a2 = last ? nA : cA + (long)(t + 2) * kstepA; const char* b2 = last ? nB : (sg ? cB2 + (long)(t + 2 - g.tsw) * g.b2_k : cB + (long)(t + 2) * kstepB);
            const char* a3 = a2 + kstepA; const char* b3 = b2 + (sg ? g.b2_k : kstepB);
            const long hB = sg ? g.b2_h : hstepB;
            unsigned vbs[2]; vbs[0] = sg ? voffB2[0] : voffB[0]; vbs[1] = sg ? voffB2[1] : voffB[1];
            PG8_LDB(B0, 0, 0); PG8_LDB(B1, 0, 1); PG8_SCHED; PG8_LDA(At, 0, 0); PG8_STAGE(PG8_SA(1, 1), a1 + hstepA, voffA);
            PG8_WAIT_V(8); PG8_WAIT_L(0); PG8_BAR; PG8_MMA(0, 0, At, B0); PG8_MMA(0, 1, At, B1); PG8_BAR; PG8_SCHED;
            PG8_LDA(At, 0, 1); PG8_STAGE(PG8_SB(0, 0), b2, vbs); PG8_STAGE(PG8_SB(0, 1), b2 + hB, vbs); PG8_STAGE(PG8_SA(0, 0), a2, voffA);
            PG8_WAIT_V(8); PG8_WAIT_L(0); PG8_BAR; PG8_MMA(1, 0, At, B0); PG8_MMA(1, 1, At, B1); PG8_BAR; PG8_SCHED;
            PG8_LDB(B0, 1, 0); PG8_LDB(B1, 1, 1); PG8_SCHED; PG8_LDA(At, 1, 0); PG8_STAGE(PG8_SA(0, 1), a2 + hstepA, voffA);
            PG8_WAIT_V(8); PG8_WAIT_L(0); PG8_BAR; PG8_MMA(0, 0, At, B0); PG8_MMA(0, 1, At, B1); PG8_BAR; PG8_SCHED;
            PG8_LDA(At, 1, 1); PG8_STAGE(PG8_SB(1, 0), b3, vbs); PG8_STAGE(PG8_SB(1, 1), b3 + hB, vbs); PG8_STAGE(PG8_SA(1, 0), a3, voffA);
            PG8_WAIT_V(8); PG8_WAIT_L(0); PG8_BAR; PG8_MMA(1, 0, At, B0); PG8_MMA(1, 1, At, B1); PG8_BAR; PG8_SCHED;
            if constexpr (Epi::HAS_MID) { if (t + 2 == Epi::MID_T) E.mid(acc, wr, fr); }
        }
        if (stp) { const unsigned long long t1 = __builtin_amdgcn_s_memrealtime(); st_loop += t1 - st_t0; st_t0 = t1; }
        if constexpr (ALIGN_EPI) { if (wr == 0) PG8_BAR; }
        if constexpr (!Epi::AFTER_DRAIN) { E(acc, cur, wr, wc, fr, fq); }
        if (stp) { const unsigned long long t1 = __builtin_amdgcn_s_memrealtime(); st_epi += t1 - st_t0; st_t0 = t1; }
        if (!has_next) break;
#pragma unroll
        for (int a = 0; a < 2; ++a)
#pragma unroll
            for (int b = 0; b < 2; ++b)
#pragma unroll
                for (int m = 0; m < 4; ++m)
#pragma unroll
                    for (int n = 0; n < 2; ++n) acc[a][b][m][n] = (f32x4){0.f, 0.f, 0.f, 0.f};
        cur = nxt; cA = nA; cB = nB; ++ui; if constexpr (SEG2) cB2 = g.B2 + (long)cur.pn * g.b2_pn + (long)cur.g * g.b2_g;
        if constexpr (ALIGN_EPI) { if (wr == 1) PG8_BAR; }
    }
    PG8_WAIT_V(0);
    if constexpr (!ALIGN_EPI) { if (wr == 0) PG8_BAR; }
    PG8_BAR;
    if (stp) { const unsigned long long t1 = __builtin_amdgcn_s_memrealtime(); st_loop += t1 - st_t0; st_t0 = t1; }
    if constexpr (Epi::AFTER_DRAIN) { E.fused(acc, cur, wr, wc, fr, fq, lds, wid, lane); }
    if (stp) { const unsigned long long t1 = __builtin_amdgcn_s_memrealtime(); st_epi += t1 - st_t0; if (tid == 0) { stp[0] = st_loop; stp[1] = st_epi; } }
#undef PG8_SA
#undef PG8_SB
#undef PG8_STAGE
#undef PG8_LDA
#undef PG8_LDB
#undef PG8_MMA
#undef PG8_WAIT_V
#undef PG8_WAIT_L
#undef PG8_BAR
#undef PG8_SCHED
}

__device__ __forceinline__ void voff_std(unsigned (&v)[2], int ld, bool perm, int tid) {
#pragma unroll
    for (int i = 0; i < 2; ++i) { int R, C; stage_rc(tid * 16 + i * 8192, R, C); const int Rb = perm ? ((R & ~31) + perm32(R & 31)) : R; v[i] = (unsigned)(Rb * ld + C) * 2u; }
}

typedef f32x4 Acc[2][2][4][2];

struct EpiU {
    static constexpr bool PERM = true, AFTER_DRAIN = false, HAS_MID = false; static constexpr int MID_T = 0;
    const float* r0; bf16_t* upool; bf16_t* ussm;
    __device__ __forceinline__ void operator()(Acc& acc, const Unit& u, int wr, int wc, int fr, int fq) const {
#pragma unroll
        for (int ai = 0; ai < 2; ++ai)
#pragma unroll
            for (int m = 0; m < 4; ++m) {
                const int row = u.pm * BM + ai * HALF + wr * 64 + m * 16 + fr; const float rs = r0[row];
#pragma unroll
                for (int bj = 0; bj < 2; ++bj) {
                    const int c8 = u.pn * BM + bj * HALF + wc * 32 + 8 * fq;
                    const u32x4 w = pack8(acc[ai][bj][m][0] * rs, acc[ai][bj][m][1] * rs);
                    if (u.pn < 2) *(u32x4*)(upool + (size_t)row * DPOOL + c8) = w;
                    else { const int cs = c8 - DPOOL, gg = cs >> 4, h0 = cs & 15, cr = row / TCH, p = row % TCH;
                           *(u32x4*)(ussm + ((size_t)(gg * NCR + cr) * ROWLEN + 16 * p + h0)) = w; }
                }
            }
    }
};
struct EpiFG {
    static constexpr bool PERM = false, AFTER_DRAIN = false, HAS_MID = false; static constexpr int MID_T = 0;
    float* fg;
    __device__ __forceinline__ void operator()(Acc& acc, const Unit& u, int wr, int wc, int fr, int fq) const {
#pragma unroll
        for (int ai = 0; ai < 2; ++ai)
#pragma unroll
            for (int m = 0; m < 4; ++m) {
                const int cr = u.pm * BM + ai * HALF + wr * 64 + m * 16 + fr; float* rowp = fg + ((size_t)u.g * NCR + cr) * 256 + wc * 32 + 4 * fq;
#pragma unroll
                for (int bj = 0; bj < 2; ++bj)
#pragma unroll
                    for (int n = 0; n < 2; ++n) *(f32x4*)(rowp + bj * HALF + n * 16) = acc[ai][bj][m][n];
            }
    }
};
struct EpiZ {
    static constexpr bool PERM = true, AFTER_DRAIN = false, HAS_MID = false; static constexpr int MID_T = 0;
    const bf16_t* ussm; const float* dvec; bf16_t* zg;
    __device__ __forceinline__ void operator()(Acc& acc, const Unit& u, int wr, int wc, int fr, int fq) const {
#pragma unroll
        for (int bj = 0; bj < 2; ++bj) {
            const int c8 = u.pn * BM + bj * HALF + wc * 32 + 8 * fq;
            const f32x4 d0 = *(const f32x4*)(dvec + u.g * 16 + (c8 & 15)), d1 = *(const f32x4*)(dvec + u.g * 16 + (c8 & 15) + 4);
#pragma unroll
            for (int ai = 0; ai < 2; ++ai)
#pragma unroll
                for (int m = 0; m < 4; ++m) {
                    const int cr = u.pm * BM + ai * HALF + wr * 64 + m * 16 + fr;
                    const u32x4 uw = *(const u32x4*)(ussm + ((size_t)(u.g * NCR + cr) * ROWLEN + c8));
                    f32x4 u0, u1; unpack8(uw, u0, u1);
                    f32x4 y0 = acc[ai][bj][m][0] + d0 * u0, y1 = acc[ai][bj][m][1] + d1 * u1;
#pragma unroll
                    for (int i = 0; i < 4; ++i) { y0[i] = fast_gelu_tanh(y0[i]); y1[i] = fast_gelu_tanh(y1[i]); }
                    *(u32x4*)(zg + ((size_t)u.g * MT * 16 + (size_t)cr * K1 + c8)) = pack8(y0, y1);
                }
        }
    }
};
struct EpiPool {
    static constexpr bool PERM = true, AFTER_DRAIN = false, HAS_MID = false; static constexpr int MID_T = 0;
    const float* pscale; bf16_t* ycat; float* ss;
    __device__ __forceinline__ void operator()(Acc& acc, const Unit& u, int wr, int wc, int fr, int fq) const {
        f32x4 sc[2][2];
#pragma unroll
        for (int bj = 0; bj < 2; ++bj) { const int c8 = u.pn * BM + bj * HALF + wc * 32 + 8 * fq; sc[bj][0] = *(const f32x4*)(pscale + c8); sc[bj][1] = *(const f32x4*)(pscale + c8 + 4); }
#pragma unroll
        for (int ai = 0; ai < 2; ++ai)
#pragma unroll
            for (int m = 0; m < 4; ++m) {
                const int row = u.pm * BM + ai * HALF + wr * 64 + m * 16 + fr; float q = 0.f;
#pragma unroll
                for (int bj = 0; bj < 2; ++bj) {
                    const int c8 = u.pn * BM + bj * HALF + wc * 32 + 8 * fq;
                    const f32x4 v0 = acc[ai][bj][m][0] * sc[bj][0], v1 = acc[ai][bj][m][1] * sc[bj][1];
                    q += (v0[0] * v0[0] + v0[1] * v0[1]) + (v0[2] * v0[2] + v0[3] * v0[3]) + (v1[0] * v1[0] + v1[1] * v1[1]) + (v1[2] * v1[2] + v1[3] * v1[3]);
                    *(u32x4*)(ycat + (size_t)row * DM + c8) = pack8(v0, v1);
                }
                q += __shfl_xor(q, 16); q += __shfl_xor(q, 32);
                if (fq == 0) ss[(size_t)(u.pn * 4 + wc) * MT + row] = q;
            }
    }
};
struct EpiGlu {
    static constexpr bool PERM = true, AFTER_DRAIN = false, HAS_MID = false; static constexpr int MID_T = 0;
    const float* gb; const bf16_t* zg; bf16_t* ycat; float* ss;
    __device__ __forceinline__ void operator()(Acc& acc, const Unit& u, int wr, int wc, int fr, int fq) const {
        f32x4 bv[2][2];
#pragma unroll
        for (int bj = 0; bj < 2; ++bj) { const int c8 = u.pn * BM + bj * HALF + wc * 32 + 8 * fq; bv[bj][0] = *(const f32x4*)(gb + c8); bv[bj][1] = *(const f32x4*)(gb + c8 + 4); }
#pragma unroll
        for (int ai = 0; ai < 2; ++ai)
#pragma unroll
            for (int m = 0; m < 4; ++m) {
                const int row = u.pm * BM + ai * HALF + wr * 64 + m * 16 + fr; float q = 0.f;
#pragma unroll
                for (int bj = 0; bj < 2; ++bj) {
                    const int c8 = u.pn * BM + bj * HALF + wc * 32 + 8 * fq;
                    const u32x4 zw = *(const u32x4*)(zg + ((size_t)(c8 >> 4) * MT + row) * 16 + (c8 & 15));
                    f32x4 z0, z1; unpack8(zw, z0, z1);
                    f32x4 v0 = acc[ai][bj][m][0] + bv[bj][0], v1 = acc[ai][bj][m][1] + bv[bj][1];
#pragma unroll
                    for (int i = 0; i < 4; ++i) { v0[i] = z0[i] * fast_sigmoid(v0[i]); v1[i] = z1[i] * fast_sigmoid(v1[i]); }
                    q += (v0[0] * v0[0] + v0[1] * v0[1]) + (v0[2] * v0[2] + v0[3] * v0[3]) + (v1[0] * v1[0] + v1[1] * v1[1]) + (v1[2] * v1[2] + v1[3] * v1[3]);
                    *(u32x4*)(ycat + (size_t)row * DM + DPOOL + c8) = pack8(v0, v1);
                }
                q += __shfl_xor(q, 16); q += __shfl_xor(q, 32);
                if (fq == 0) ss[(size_t)(u.pn * 4 + wc) * MT + row] = q;
            }
    }
};
struct EpiOut {
    static constexpr bool PERM = true, AFTER_DRAIN = true, HAS_MID = true; static constexpr int MID_T = 8;
    const float* x; bf16_t* h1b; float* ss; LAS f32x2* XR; float ratio[2][4];
    __device__ __forceinline__ void mid(Acc& acc, int wr, int fr) const {
#pragma unroll
        for (int ai = 0; ai < 2; ++ai)
#pragma unroll
            for (int m = 0; m < 4; ++m) { const float ratio = this->ratio[ai][m];
#pragma unroll
                for (int bj = 0; bj < 2; ++bj)
#pragma unroll
                    for (int n = 0; n < 2; ++n) acc[ai][bj][m][n] = acc[ai][bj][m][n] * ratio; }
    }
    __device__ __forceinline__ void fused(Acc& acc, const Unit& u, int wr, int wc, int fr, int fq, LAS unsigned char* lds, int wid, int lane) const {
        LAS float* P = (LAS float*)lds;
        const int col0 = u.pn * BM + wc * 32 + 8 * fq;
#pragma unroll
        for (int ai = 0; ai < 2; ++ai)
#pragma unroll
            for (int m = 0; m < 4; ++m) {
                const int lr = ai * HALF + wr * 64 + m * 16 + fr, row = u.pm * BM + lr; const float rs = XR[lr].y; float q = 0.f;
                const size_t prow = (size_t)(row >> 12) * PADROWS + 1 + (row & 4095);
#pragma unroll
                for (int bj = 0; bj < 2; ++bj) {
                    const int c = col0 + bj * HALF;
                    const f32x4 h0 = *(const f32x4*)(x + (size_t)row * DM + c) + acc[ai][bj][m][0] * rs, h1v = *(const f32x4*)(x + (size_t)row * DM + c + 4) + acc[ai][bj][m][1] * rs;
                    q += (h0[0] * h0[0] + h0[1] * h0[1]) + (h0[2] * h0[2] + h0[3] * h0[3]) + (h1v[0] * h1v[0] + h1v[1] * h1v[1]) + (h1v[2] * h1v[2] + h1v[3] * h1v[3]);
                    *(u32x4*)(h1b + prow * DM + c) = pack8(h0, h1v);
                }
                q += __shfl_xor(q, 16); q += __shfl_xor(q, 32);
                if (fq == 0) P[lr * 4 + wc] = q;
            }
        LDS_WAIT(); __builtin_amdgcn_s_barrier(); asm volatile("" ::: "memory");
        const int tid = wid * 64 + lane;
        if (tid < 256) ss[(size_t)u.pn * MT + u.pm * BM + tid] = (P[tid * 4 + 0] + P[tid * 4 + 1]) + (P[tid * 4 + 2] + P[tid * 4 + 3]);
    }
};
struct EpiUp {
    static constexpr bool PERM = true, AFTER_DRAIN = false, HAS_MID = false; static constexpr int MID_T = 0;
    const LAS float* rsl; const float* cw; const float* cb; bf16_t* act;
    __device__ __forceinline__ void operator()(Acc& acc, const Unit& u, int wr, int wc, int fr, int fq) const {
        const int j = u.pm, b = u.g;
#pragma unroll
        for (int ai = 0; ai < 2; ++ai)
#pragma unroll
            for (int m = 0; m < 4; ++m) {
                const float rs = rsl[u.aux * 256 + 126 * wr + 64 * ai + 16 * m + fr];
#pragma unroll
                for (int bj = 0; bj < 2; ++bj)
#pragma unroll
                    for (int n = 0; n < 2; ++n) acc[ai][bj][m][n] = acc[ai][bj][m][n] * rs;
            }
        const int f0 = 128 * u.pn + 32 * wc + 8 * fq;
        u32x2 keep[8];
#pragma unroll
        for (int n = 0; n < 2; ++n) {
            const int fc = f0 + 4 * n;
            const f32x4 wv0 = *(const f32x4*)(cw + fc), wv1 = *(const f32x4*)(cw + DFF2 + fc), wv2 = *(const f32x4*)(cw + 2 * DFF2 + fc), bvv = *(const f32x4*)(cb + fc);
            const f32x4 wg0 = *(const f32x4*)(cw + DFF + fc), wg1 = *(const f32x4*)(cw + DFF2 + DFF + fc), wg2 = *(const f32x4*)(cw + 2 * DFF2 + DFF + fc), bgv = *(const f32x4*)(cb + DFF + fc);
#pragma unroll
            for (int gi = 0; gi < 8; ++gi) {
                const int ai = gi >> 2, m = gi & 3, pi = gi > 0 ? gi - 1 : gi, ni = gi < 7 ? gi + 1 : gi;
                const f32x4 cv = acc[ai][0][m][n], cg = acc[ai][1][m][n];
                const f32x4 pv = acc[pi >> 2][0][pi & 3][n], pg = acc[pi >> 2][1][pi & 3][n];
                const f32x4 nv = acc[ni >> 2][0][ni & 3][n], ng = acc[ni >> 2][1][ni & 3][n];
                f32x4 o;
#pragma unroll
                for (int i = 0; i < 4; ++i) {
#if defined(ABL_DPP)
                    const float v_prev = pv[i], v_next = nv[i], g_prev = pg[i], g_next = ng[i];
#else
                    const float v_prev = dpp_ror1(fr == 15 ? pv[i] : cv[i]), v_next = dpp_ror15(fr == 0 ? nv[i] : cv[i]);
                    const float g_prev = dpp_ror1(fr == 15 ? pg[i] : cg[i]), g_next = dpp_ror15(fr == 0 ? ng[i] : cg[i]);
#endif
                    const float vv = bvv[i] + wv0[i] * v_prev + wv1[i] * cv[i] + wv2[i] * v_next;
                    const float gg = bgv[i] + wg0[i] * g_prev + wg1[i] * cg[i] + wg2[i] * g_next;
#if defined(ABL_SILU)
                    o[i] = vv * gg;
#else
                    o[i] = vv * gg * fast_sigmoid(gg);
#endif
                }
                const u32x2 pk = pack4(o);
                if (n == 0) keep[gi] = pk;
                else { const int w = 64 * ai + 16 * m + fr, t = UPROWS * j + 126 * wr + w - 1;
                       if (t >= 0 && t < SEQ && w >= 1 && w <= 126) { u32x4 wv; wv.x = keep[gi].x; wv.y = keep[gi].y; wv.z = pk.x; wv.w = pk.y; *(u32x4*)(act + (size_t)(b * SEQ + t) * DFF + f0) = wv; } }
            }
        }
    }
};
struct EpiDown {
    static constexpr bool PERM = true, AFTER_DRAIN = true, HAS_MID = false; static constexpr int MID_T = 0;
    const bf16_t* h1b; float* out; const float* gfin; float* ss; const XcdBarrier* bar;
    __device__ __forceinline__ void fused(Acc& acc, const Unit& u, int wr, int wc, int fr, int fq, LAS unsigned char* lds, int wid, int lane) const {
        LAS float* P = (LAS float*)lds;
        LAS float* Sr = (LAS float*)(lds + 8192);
        const int col0 = u.pn * BM + wc * 32 + 8 * fq;
#pragma unroll
        for (int ai = 0; ai < 2; ++ai)
#pragma unroll
            for (int m = 0; m < 4; ++m) {
                const int lr = ai * HALF + wr * 64 + m * 16 + fr, row = u.pm * BM + lr; float q = 0.f;
                const size_t prow = (size_t)(row >> 12) * PADROWS + 1 + (row & 4095);
#pragma unroll
                for (int bj = 0; bj < 2; ++bj) {
                    f32x4 b0, b1; unpack8(*(const u32x4*)(h1b + prow * DM + col0 + bj * HALF), b0, b1);
                    const f32x4 h0 = b0 + acc[ai][bj][m][0], h1v = b1 + acc[ai][bj][m][1];
                    acc[ai][bj][m][0] = h0; acc[ai][bj][m][1] = h1v;
                    q += (h0[0] * h0[0] + h0[1] * h0[1]) + (h0[2] * h0[2] + h0[3] * h0[3]) + (h1v[0] * h1v[0] + h1v[1] * h1v[1]) + (h1v[2] * h1v[2] + h1v[3] * h1v[3]);
                }
                q += __shfl_xor(q, 16); q += __shfl_xor(q, 32);
                if (fq == 0) P[lr * 4 + wc] = q;
            }
        LDS_WAIT(); __builtin_amdgcn_s_barrier(); asm volatile("" ::: "memory");
        const int tid = wid * 64 + lane;
        if (tid < 256) ss[(size_t)u.pn * MT + u.pm * BM + tid] = (P[tid * 4 + 0] + P[tid * 4 + 1]) + (P[tid * 4 + 2] + P[tid * 4 + 3]);
        xcd_barrier(*bar, tid);
        if (tid < 256) { const int row = u.pm * BM + tid; const float s = (ss[row] + ss[MT + row]) + (ss[2 * MT + row] + ss[3 * MT + row]); Sr[tid] = rsqrtf(s * (1.0f / DM) + EPS); }
        LDS_WAIT(); __builtin_amdgcn_s_barrier(); asm volatile("" ::: "memory");
#pragma unroll
        for (int bj = 0; bj < 2; ++bj) {
            const int c = col0 + bj * HALF; const f32x4 g0 = *(const f32x4*)(gfin + c), g1 = *(const f32x4*)(gfin + c + 4);
#pragma unroll
            for (int ai = 0; ai < 2; ++ai)
#pragma unroll
                for (int m = 0; m < 4; ++m) { const int lr = ai * HALF + wr * 64 + m * 16 + fr; const float r = Sr[lr]; float* o = out + (size_t)(u.pm * BM + lr) * DM + c;
                    *(f32x4*)o = acc[ai][bj][m][0] * r * g0; *(f32x4*)(o + 4) = acc[ai][bj][m][1] * r * g1; }
        }
    }
};

struct OrdOne { Unit u; __device__ bool next(int i, Unit& o) const { if (i > 0) return false; o = u; return true; } };
struct OrdSsmA { int c; __device__ bool next(int i, Unit& u) const { if (i > 0 || c >= 64) return false; const int x = c & 7, k = c >> 3; u.g = x * 4 + (k >> 1); u.pm = k & 1; u.pn = 0; u.aux = 0; return true; } };
struct OrdSsmB { int c; __device__ bool next(int i, Unit& u) const { if (i > 0 || c >= 128) return false; const int x = c & 7, k = c >> 3; u.g = x * 4 + (k >> 2); u.pm = (k >> 1) & 1; u.pn = k & 1; u.aux = 0; return true; } };
struct OrdPool { int c; __device__ bool next(int i, Unit& u) const { if (i > 0 || c < 128 || c >= 256) return false; const int cc = c - 128, x = cc & 7, k = cc >> 3; u.pm = x * 8 + (k >> 1); u.pn = k & 1; u.g = u.pn; u.aux = 0; return true; } };
struct OrdGlu  { int c; __device__ bool next(int i, Unit& u) const { if (i > 0 || c >= 128) return false; const int x = c & 7, k = c >> 3; u.pm = x * 8 + (k >> 1); u.pn = k & 1; u.g = 0; u.aux = 0; return true; } };
struct OrdUp { StaticOrder so; __device__ bool next(int i, Unit& u) const { if (!so.next(i, u)) return false; u.g = u.pm / UPT; u.pm = u.pm % UPT; u.aux = i; return true; } };

constexpr size_t WS_STAMP = 4 * MiB;
#if defined(MK_STAMP)
#define ST(k) do { if (F.tid == 0) ((unsigned long long*)(args.ws + WS_STAMP))[blockIdx.x * 64 + (k)] = __builtin_amdgcn_s_memrealtime(); } while (0)
#define GP_STAMP(base) ((unsigned long long*)(args.ws + WS_STAMP) + blockIdx.x * 64 + (base))
#else
#define ST(k) do { } while (0)
#define GP_STAMP(base) ((unsigned long long*)nullptr)
#endif
struct Args { const float* in[24]; float* out; unsigned char* ws; int ph_lo, ph_hi; };

struct Frame { LAS unsigned char* lds; int tid, lane, wave, G, bx; };

struct TrMat { const float* W; int K, N; const float* kg0; const float* kg1; int ksplit; bf16_t* WT; int map; int nitems; };
__device__ __forceinline__ void tr_load(const TrMat& m0, const TrMat& m1, int item, int lane, f32x4 (&v)[8]) {
    const bool second = item >= m0.nitems; const TrMat& m = second ? m1 : m0; const int it = second ? item - m0.nitems : item;
    const int nblk = m.N / 32, kb = it / nblk, nb = it % nblk, k0 = 64 * kb, n0 = 32 * nb, r = lane >> 3, c4 = lane & 7;
#pragma unroll
    for (int i = 0; i < 8; ++i) v[i] = *(const f32x4*)(m.W + (size_t)(k0 + 8 * i + r) * m.N + n0 + 4 * c4);
}
__device__ __forceinline__ void tr_store(const TrMat& m0, const TrMat& m1, int item, int lane, const f32x4 (&v)[8], LAS float* scr) {
    const bool second = item >= m0.nitems; const TrMat& m = second ? m1 : m0; const int it = second ? item - m0.nitems : item;
    const int nblk = m.N / 32, kb = it / nblk, nb = it % nblk, k0 = 64 * kb, n0 = 32 * nb, r = lane >> 3, c4 = lane & 7;
#pragma unroll
    for (int i = 0; i < 8; ++i) { const int kk = 8 * i + r, k = k0 + kk; float gn = 1.f; if (m.kg0) gn = (k < m.ksplit ? m.kg0[k] : m.kg1[k - m.ksplit]);
        LAS float* d = scr + kk * 33 + 4 * c4; d[0] = v[i][0] * gn; d[1] = v[i][1] * gn; d[2] = v[i][2] * gn; d[3] = v[i][3] * gn; }
    LDS_WAIT(); asm volatile("" ::: "memory");
    const int c = lane & 7;
#pragma unroll
    for (int j = 0; j < 4; ++j) { const int n = (lane >> 3) + 8 * j; const LAS float* q = scr + (8 * c) * 33 + n;
        u32x4 o; o.x = pk2(q[0 * 33], q[1 * 33]); o.y = pk2(q[2 * 33], q[3 * 33]); o.z = pk2(q[4 * 33], q[5 * 33]); o.w = pk2(q[6 * 33], q[7 * 33]);
        int nr = n0 + n;
        if (m.map == 1) { const int bj = nr / DFF, rem = nr % DFF; nr = 256 * (rem >> 7) + 128 * bj + (rem & 127); }
        *(u32x4*)(m.WT + (size_t)nr * m.K + k0 + 8 * c) = o; }
    LDS_WAIT(); asm volatile("" ::: "memory");
}
__device__ __forceinline__ void tr_run(const TrMat& m0, const TrMat& m1, int first, int stride, int lane, LAS float* scr) {
    const int total = m0.nitems + m1.nitems; f32x4 va[8], vb[8];
    int it = first; if (it < total) tr_load(m0, m1, it, lane, va);
    while (it < total) {
        const int n1 = it + stride; if (n1 < total) tr_load(m0, m1, n1, lane, vb);
        tr_store(m0, m1, it, lane, va, scr);
        if (n1 >= total) break;
        const int n2 = n1 + stride; if (n2 < total) tr_load(m0, m1, n2, lane, va);
        tr_store(m0, m1, n1, lane, vb, scr);
        it = n2;
    }
}

struct SsmLds { LAS float* Bre; LAS float* Bim; LAS float* Cre; LAS float* Cim; LAS float* PAR; LAS float* Pc; LAS float* Kl; };
__device__ __forceinline__ SsmLds ssm_lds(const Frame& F) { SsmLds L; L.Bre = (LAS float*)(F.lds); L.Bim = L.Bre + 2048; L.Cre = L.Bim + 2048; L.Cim = L.Cre + 2048; L.PAR = L.Cim + 2048; L.Pc = L.PAR + 512; L.Kl = L.Pc + 1024; return L; }
__device__ __forceinline__ void ssm_stage(const Args& a, const Frame& F, const SsmLds& L, int g) {
    const float* lnar = a.in[5]; const float* aim = a.in[6]; const float* ldt = a.in[7];
    const float* bre = a.in[8]; const float* bim = a.in[9]; const float* cre = a.in[10]; const float* cim = a.in[11];
    const int tid = F.tid;
    for (int i = tid; i < 2048; i += 512) { const int dir = i >> 10, r = i & 1023;
        L.Bre[i] = bre[((size_t)(dir * NG + g)) * 1024 + r]; L.Bim[i] = bim[((size_t)(dir * NG + g)) * 1024 + r];
        L.Cre[i] = cre[((size_t)(dir * NG + g)) * 1024 + r]; L.Cim[i] = cim[((size_t)(dir * NG + g)) * 1024 + r]; }
    if (tid < 128) { const int dir = tid >> 6, n = tid & 63;
        const float dt = expf(ldt[dir * NG + g]); const float a_re = -expf(lnar[(dir * NG + g) * NS + n]), a_im = aim[(dir * NG + g) * NS + n];
        const float mag = expf(a_re * dt), ang = a_im * dt; const float lam_re = mag * cosf(ang), lam_im = mag * sinf(ang);
        const float den = a_re * a_re + a_im * a_im;
        L.PAR[tid * 4 + 0] = a_re * dt; L.PAR[tid * 4 + 1] = ang;
        L.PAR[tid * 4 + 2] = ((lam_re - 1.0f) * a_re + lam_im * a_im) / den; L.PAR[tid * 4 + 3] = (lam_im * a_re - (lam_re - 1.0f) * a_im) / den; }
    __syncthreads();
}
__device__ __forceinline__ void ssm_build_tb(const Args& a, const Frame& F, const SsmLds& L, int g, int lag0, int nl) {
    bf16_t* KC = (bf16_t*)(a.ws + WS_TB) + (size_t)g * 64 * 256;
    bf16_t* TBC = (bf16_t*)(a.ws + WS_TBC) + (size_t)g * K1 * 256;
    const int tid = F.tid;
    { const int li = tid >> 7, dn = tid & 127, lag = lag0 + li; const float ad = L.PAR[dn * 4 + 0], ang = L.PAR[dn * 4 + 1], fr_ = L.PAR[dn * 4 + 2], fi_ = L.PAR[dn * 4 + 3];
      const float mg = expf((float)lag * ad); float sn, cs; sincosf((float)lag * ang, &sn, &cs); const float lr = mg * cs, lim = mg * sn;
      L.Pc[(li * 128 + dn) * 2 + 0] = lr * fr_ - lim * fi_; L.Pc[(li * 128 + dn) * 2 + 1] = lr * fi_ + lim * fr_; }
    __syncthreads();
    { const int li = F.wave >> 1, dir = F.wave & 1, i16 = F.lane & 15, kq = F.lane >> 4; f32x4 kacc = {0.f, 0.f, 0.f, 0.f};
#pragma unroll 8
      for (int kk0 = 0; kk0 < 128; kk0 += 4) { const int kk = kk0 + kq, n = kk >> 1; const bool im = (kk & 1) != 0;
          const float cr_ = L.Cre[dir * 1024 + i16 * 64 + n], ci_ = L.Cim[dir * 1024 + i16 * 64 + n], pr = L.Pc[(li * 128 + dir * 64 + n) * 2], pi = L.Pc[(li * 128 + dir * 64 + n) * 2 + 1];
          const float av = im ? -(cr_ * pi + ci_ * pr) : (cr_ * pr - ci_ * pi);
          const float bv = im ? L.Bim[dir * 1024 + n * 16 + i16] : L.Bre[dir * 1024 + n * 16 + i16];
          kacc = __builtin_amdgcn_mfma_f32_16x16x4f32(av, bv, kacc, 0, 0, 0); }
#pragma unroll
      for (int r = 0; r < 4; ++r) L.Kl[li * 512 + dir * 256 + (kq * 4 + r) * 16 + i16] = kacc[r]; }
    __syncthreads();
    { const int li = tid >> 7, dir = (tid >> 6) & 1, e4 = tid & 63, lag = lag0 + li;
      if (li < nl && !(lag == 0 && dir == 1)) {
          f32x4 v = *(const LAS f32x4*)(L.Kl + li * 512 + dir * 256 + 4 * e4);
          if (lag == 0) v = v + *(const LAS f32x4*)(L.Kl + li * 512 + 256 + 4 * e4);
          const int d = dir == 0 ? 31 + lag : 31 - lag; u32x2 w; w.x = pk2(v[0], v[1]); w.y = pk2(v[2], v[3]);
          *(u32x2*)(KC + (size_t)d * 256 + 4 * e4) = w; } }
    __syncthreads();
    { const int li = tid >> 7, dn = tid & 127, dir = dn >> 6, p = lag0 + li; const float ad = L.PAR[dn * 4 + 0], ang = L.PAR[dn * 4 + 1]; const float e = dir == 0 ? (float)(p + 1) : (float)(TCH - p);
      const float mg = expf(e * ad); float sn, cs; sincosf(e * ang, &sn, &cs); L.Pc[(li * 128 + dn) * 2 + 0] = mg * cs; L.Pc[(li * 128 + dn) * 2 + 1] = mg * sn; }
    __syncthreads();
    for (int li = 0; li < nl; ++li) {
        const int p = lag0 + li, h = tid >> 5, dir = (tid >> 4) & 1, n4 = tid & 15; float v[8];
#pragma unroll
        for (int e = 0; e < 4; ++e) { const int n = 4 * n4 + e; const float cr_ = L.Cre[dir * 1024 + h * 64 + n], ci_ = L.Cim[dir * 1024 + h * 64 + n], pr = L.Pc[(li * 128 + dir * 64 + n) * 2], pi = L.Pc[(li * 128 + dir * 64 + n) * 2 + 1];
            v[2 * e] = cr_ * pr - ci_ * pi; v[2 * e + 1] = -(cr_ * pi + ci_ * pr); }
        u32x4 w; w.x = pk2(v[0], v[1]); w.y = pk2(v[2], v[3]); w.z = pk2(v[4], v[5]); w.w = pk2(v[6], v[7]);
        *(u32x4*)(TBC + (size_t)(16 * p + h) * 256 + dir * 128 + 8 * n4) = w;
    }
    __syncthreads();
}
__device__ __forceinline__ void ssm_build_wab(const Args& a, const Frame& F, const SsmLds& L, int g, int jq) {
    bf16_t* WAB = (bf16_t*)(a.ws + WS_WAB) + (size_t)g * 256 * K1;
    const int tid = F.tid;
    { const int li = tid >> 7, dn = tid & 127, dir = dn >> 6, q = 4 * jq + li; const float ad = L.PAR[dn * 4 + 0], ang = L.PAR[dn * 4 + 1], fr_ = L.PAR[dn * 4 + 2], fi_ = L.PAR[dn * 4 + 3]; const float e = dir == 0 ? (float)(TCH - 1 - q) : (float)q;
      const float mg = expf(e * ad); float sn, cs; sincosf(e * ang, &sn, &cs); const float lr = mg * cs, lim = mg * sn;
      L.Pc[(li * 128 + dn) * 2 + 0] = lr * fr_ - lim * fi_; L.Pc[(li * 128 + dn) * 2 + 1] = lr * fi_ + lim * fr_; }
    __syncthreads();
#pragma unroll
    for (int half = 0; half < 2; ++half) {
        const int li = 2 * half + (tid >> 8), q = 4 * jq + li, t2 = tid & 255, dir = t2 >> 7, n = (t2 >> 1) & 63, part = t2 & 1;
        const float pr = L.Pc[(li * 128 + dir * 64 + n) * 2], pi = L.Pc[(li * 128 + dir * 64 + n) * 2 + 1]; float v[16];
#pragma unroll
        for (int i = 0; i < 16; ++i) { const float br_ = L.Bre[dir * 1024 + n * 16 + i], bi_ = L.Bim[dir * 1024 + n * 16 + i]; v[i] = part == 0 ? (pr * br_ - pi * bi_) : (pr * bi_ + pi * br_); }
        u32x4 w0, w1; w0.x = pk2(v[0], v[1]); w0.y = pk2(v[2], v[3]); w0.z = pk2(v[4], v[5]); w0.w = pk2(v[6], v[7]); w1.x = pk2(v[8], v[9]); w1.y = pk2(v[10], v[11]); w1.z = pk2(v[12], v[13]); w1.w = pk2(v[14], v[15]);
        bf16_t* dst = WAB + (size_t)(dir * 128 + 2 * n + part) * K1 + 16 * q; *(u32x4*)dst = w0; *(u32x4*)(dst + 8) = w1;
    }
    __syncthreads();
}

__device__ __forceinline__ void p0_prologue(const Args& a, const Frame& F) {
    const float* x = a.in[0];
    { const SsmLds L = ssm_lds(F);
      for (int it = F.bx; it < NG * 8; it += F.G) { ssm_stage(a, F, L, it >> 3); ssm_build_wab(a, F, L, it >> 3, it & 7); } }
    __syncthreads();
    LAS float* scr = (LAS float*)(F.lds + F.wave * 16384);
    const int gw = F.bx * 8 + F.wave, NGW = F.G * 8;
    { const TrMat m0{a.in[2], DM, DM, a.in[1], a.in[1], DM, (bf16_t*)(a.ws + WS_WIN), 0, (DM / 64) * (DM / 32)}; const TrMat m1{nullptr, 0, 32, nullptr, nullptr, 0, nullptr, 0, 0};
      tr_run(m0, m1, gw, NGW, F.lane, scr); }
    { bf16_t* PW = (bf16_t*)(a.ws + WS_PW); const float* pw = a.in[3];
      for (int idx = F.bx * 512 + F.tid; idx < 2 * 256 * 256; idx += F.G * 512) { const int pn = idx >> 16, j = (idx >> 8) & 255, k = idx & 255;
          const float v = ((j >> 7) == (k >> 7)) ? pw[((size_t)(2 * pn + (j >> 7)) * 128 + (k & 127)) * 128 + (j & 127)] : 0.f; PW[idx] = (bf16_t)f2bf(v); } }
    { bf16_t* h1b = (bf16_t*)(a.ws + WS_H1B);
      for (int idx = F.bx * 512 + F.tid; idx < BATCH * 256 * (DM / 8); idx += F.G * 512) { const int b = idx / (256 * 128), r = (idx / 128) % 256, c = idx % 128; const int prow = b * PADROWS + (r == 0 ? 0 : 4096 + r);
          *(u32x4*)(h1b + (size_t)prow * DM + 8 * c) = (u32x4){0u, 0u, 0u, 0u}; } }
    { bf16_t* xb = (bf16_t*)(a.ws + WS_XB); float* r0 = (float*)(a.ws + WS_R0);
      for (int row = gw; row < MT; row += NGW) {
          const f32x4* xr = (const f32x4*)(x + (size_t)row * DM) + F.lane; f32x4 v[4]; float s = 0.f;
#pragma unroll
          for (int j = 0; j < 4; ++j) { v[j] = xr[64 * j]; s += (v[j][0] * v[j][0] + v[j][1] * v[j][1]) + (v[j][2] * v[j][2] + v[j][3] * v[j][3]); }
          s = wave_sum(s); if (F.lane == 0) r0[row] = rsqrtf(s * (1.0f / DM) + EPS);
          u32x2* o = (u32x2*)(xb + (size_t)row * DM) + F.lane;
#pragma unroll
          for (int j = 0; j < 4; ++j) o[64 * j] = pack4(v[j]);
      } }
}

__device__ __forceinline__ void p2_side(const Args& a, const Frame& F, int first_block) {
    const int nb = F.G - first_block, sb = F.bx - first_block;
    { const SsmLds L = ssm_lds(F);
      int id = (sb * (NG * TCH)) / nb; const int id_end = ((sb + 1) * (NG * TCH)) / nb; int staged = -1;
      while (id < id_end) {
          const int g = id / TCH, lag0 = id % TCH; int nl = TCH - lag0; if (nl > 4) nl = 4; if (nl > id_end - id) nl = id_end - id;
          if (g != staged) { ssm_stage(a, F, L, g); staged = g; }
          ssm_build_tb(a, F, L, g, lag0, nl); id += nl;
      } }
    __syncthreads();
    LAS float* scr = (LAS float*)(F.lds + F.wave * 16384);
    const TrMat m0{a.in[13], DSSM, DSSM, nullptr, nullptr, 0, (bf16_t*)(a.ws + WS_WGLU), 0, (DSSM / 64) * (DSSM / 32)}; const TrMat m1{nullptr, 0, 32, nullptr, nullptr, 0, nullptr, 0, 0};
    tr_run(m0, m1, sb * 8 + F.wave, nb * 8, F.lane, scr);
}
__device__ __forceinline__ void ssm_side(const Args& a, const Frame& F, int first_block) {
    const int nb = F.G - first_block, sb = F.bx - first_block;
    { const SsmLds L = ssm_lds(F);
      const int g = sb >> 2, lag0 = (sb & 3) * 8;
#if defined(MK_STAMP)
#define STS(k) do { if (F.tid == 0) ((unsigned long long*)(a.ws + WS_STAMP))[blockIdx.x * 64 + (k)] = __builtin_amdgcn_s_memrealtime(); } while (0)
#else
#define STS(k) do { } while (0)
#endif
      ssm_stage(a, F, L, g); STS(45); ssm_build_tb(a, F, L, g, lag0, 4); STS(46); ssm_build_tb(a, F, L, g, lag0 + 4, 4); STS(47);
      VM_WAIT(); __syncthreads();
      if (F.tid == 0) { __builtin_amdgcn_fence(__ATOMIC_RELEASE, "agent"); asm volatile("s_waitcnt vmcnt(0)" ::: "memory");
          __hip_atomic_fetch_add((unsigned*)(a.ws + WS_CTL) + CW_TBCNT + 64 * g, 8u, __ATOMIC_RELAXED, __HIP_MEMORY_SCOPE_AGENT); } }
    __syncthreads();
#if defined(MK_STAMP)
    if (F.tid == 0) ((unsigned long long*)(a.ws + WS_STAMP))[blockIdx.x * 64 + 43] = __builtin_amdgcn_s_memrealtime();
#endif
    LAS float* scr = (LAS float*)(F.lds + F.wave * 16384);
    const TrMat m0{a.in[17], DM, DM, a.in[15], a.in[16], DPOOL, (bf16_t*)(a.ws + WS_WOUT), 0, (DM / 64) * (DM / 32)};
    const TrMat m1{a.in[13], DSSM, DSSM, nullptr, nullptr, 0, (bf16_t*)(a.ws + WS_WGLU), 0, (DSSM / 64) * (DSSM / 32)};
    tr_run(m0, m1, sb * 8 + F.wave, nb * 8, F.lane, scr);
    const TrMat m2{a.in[22], DFF, DM, nullptr, nullptr, 0, (bf16_t*)(a.ws + WS_WDOWN), 0, (DFF / 64) * (DM / 32)}; const TrMat m3{nullptr, 0, 32, nullptr, nullptr, 0, nullptr, 0, 0};
    tr_run(m2, m3, sb * 8 + F.wave, nb * 8, F.lane, scr);
}
__device__ __forceinline__ void tb_wait(const Args& a, const Frame& F, int g) {
    if (F.tid == 0) { unsigned* cnt = (unsigned*)(a.ws + WS_CTL) + CW_TBCNT + 64 * g; unsigned sp = 0;
        while (__hip_atomic_load(cnt, __ATOMIC_RELAXED, __HIP_MEMORY_SCOPE_AGENT) < (unsigned)TCH) { __builtin_amdgcn_s_sleep(2); if (++sp > (1u << 20)) break; }
        __builtin_amdgcn_fence(__ATOMIC_ACQUIRE, "agent"); asm volatile("s_waitcnt vmcnt(0)" ::: "memory"); }
    __syncthreads();
}
__device__ __forceinline__ void p3_side(const Args& a, const Frame& F, int first_block) {
    const int nb = F.G - first_block, sb = F.bx - first_block;
    LAS float* scr = (LAS float*)(F.lds + F.wave * 16384);
    const TrMat m0{a.in[17], DM, DM, a.in[15], a.in[16], DPOOL, (bf16_t*)(a.ws + WS_WOUT), 0, (DM / 64) * (DM / 32)}; const TrMat m1{nullptr, 0, 32, nullptr, nullptr, 0, nullptr, 0, 0};
    tr_run(m0, m1, sb * 8 + F.wave, nb * 8, F.lane, scr);
}
__device__ __forceinline__ void p4_side(const Args& a, const Frame& F, int first_block) {
    const int nb = F.G - first_block, sb = F.bx - first_block;
    LAS float* scr = (LAS float*)(F.lds + F.wave * 16384);
    const TrMat m0{a.in[19], DM, DFF2, a.in[18], a.in[18], DM, (bf16_t*)(a.ws + WS_WUP), 1, (DM / 64) * (DFF2 / 32)};
    const TrMat m1{nullptr, 0, 32, nullptr, nullptr, 0, nullptr, 0, 0};
    tr_run(m0, m1, sb * 8 + F.wave, nb * 8, F.lane, scr);
}

__device__ __forceinline__ void p2_pooled(const Args& a, const Frame& F, int first_block) {
    const bf16_t* up = (const bf16_t*)(a.ws + WS_UPOOL); bf16_t* po = (bf16_t*)(a.ws + WS_POOLED);
    const int gw = (F.bx - first_block) * 8 + F.wave, NGW = (F.G - first_block) * 8;
    const int c0 = 8 * F.lane, half = 1 << (F.lane >> 4);
    for (int blk = gw; blk < MT / 4; blk += NGW) {
        const int row0 = blk * 4, b = row0 / SEQ, t0 = row0 % SEQ;
        u32x4 w[19];
#pragma unroll
        for (int o = 0; o < 19; ++o) { int q = t0 + o - 8; q = q < 0 ? 0 : (q >= SEQ ? SEQ - 1 : q); w[o] = *(const u32x4*)(up + (size_t)(b * SEQ + q) * DPOOL + c0); }
#pragma unroll
        for (int r = 0; r < 4; ++r) {
            f32x4 s0 = {0.f, 0.f, 0.f, 0.f}, s1 = {0.f, 0.f, 0.f, 0.f}; float cnt = 0.f;
#pragma unroll
            for (int d = -8; d < 8; ++d) { const int q = t0 + r + d; const float m = (d >= -half && d < half && q >= 0 && q < SEQ) ? 1.f : 0.f; f32x4 a0, a1; unpack8(w[r + d + 8], a0, a1); s0 = s0 + a0 * m; s1 = s1 + a1 * m; cnt += m; }
            f32x4 c0v, c1v; unpack8(w[r + 8], c0v, c1v);
            const float inv = __builtin_amdgcn_rcpf(cnt);
            *(u32x4*)(po + (size_t)(row0 + r) * DPOOL + c0) = pack8(s0 * inv - c0v, s1 * inv - c1v);
        }
    }
}

__device__ __forceinline__ void p3_carries(const Args& a, const Frame& F, int g, int pm) {
    LAS float* TOT = (LAS float*)(F.lds);
    const int bs = F.tid >> 8, seg = (F.tid >> 6) & 3, n = F.tid & 63, b = 2 * pm + bs;
    for (int dir = 0; dir < 2; ++dir) {
        const float dt = expf(a.in[7][dir * NG + g]); const float a_re = -expf(a.in[5][(dir * NG + g) * NS + n]), a_im = a.in[6][(dir * NG + g) * NS + n];
        const float mg = expf((float)TCH * (a_re * dt)); float sn, cs; sincosf((float)TCH * (a_im * dt), &sn, &cs); const float lr = mg * cs, li = mg * sn;
        const float* fg = (const float*)(a.ws + WS_FG) + ((size_t)g * NCR + (size_t)b * NCHB) * 256 + dir * 128 + 2 * n;
        bf16_t* us = (bf16_t*)(a.ws + WS_USSM) + ((size_t)g * NCR + (size_t)b * NCHB) * ROWLEN + K1 + dir * 128 + 2 * n;
        f32x2 f[32];
#pragma unroll
        for (int k = 0; k < 32; ++k) { const int i = 32 * seg + k, c = dir == 0 ? i : NCHB - 1 - i; f[k] = *(const f32x2*)(fg + (size_t)c * 256); }
        float sr = 0.f, si = 0.f;
#pragma unroll
        for (int k = 0; k < 32; ++k) { const float nr = lr * sr - li * si + f[k].x, ni = lr * si + li * sr + f[k].y; sr = nr; si = ni; }
        TOT[F.tid * 2] = sr; TOT[F.tid * 2 + 1] = si;
        float pr = lr, pi = li;
#pragma unroll
        for (int q = 0; q < 5; ++q) { const float nr = pr * pr - pi * pi, ni = 2.f * pr * pi; pr = nr; pi = ni; }
        __syncthreads();
        sr = 0.f; si = 0.f;
        for (int s2 = 0; s2 < seg; ++s2) { const int o = (F.tid - 64 * (seg - s2)) * 2; const float tr = TOT[o], ti = TOT[o + 1]; const float nr = pr * sr - pi * si + tr, ni = pr * si + pi * sr + ti; sr = nr; si = ni; }
#pragma unroll
        for (int k = 0; k < 32; ++k) { const int i = 32 * seg + k, c = dir == 0 ? i : NCHB - 1 - i;
            *(unsigned*)(us + (size_t)c * ROWLEN) = pk2(sr, si);
            const float nr = lr * sr - li * si + f[k].x, ni = lr * si + li * sr + f[k].y; sr = nr; si = ni; }
        __syncthreads();
    }
    VM_WAIT(); __syncthreads();
}

__global__ void __launch_bounds__(512, 2) mk_fwd(Args args) {
    extern __shared__ __attribute__((aligned(16))) unsigned char lds_raw[];
    Frame F; F.lds = (LAS unsigned char*)lds_raw; F.tid = threadIdx.x; F.lane = F.tid & 63; F.wave = __builtin_amdgcn_readfirstlane(F.tid >> 6); F.G = gridDim.x; F.bx = blockIdx.x;
    volatile LAS unsigned* MISC = (volatile LAS unsigned*)(F.lds + LDSCTL_OFF);
    for (int u = F.tid; u < (LDS_BYTES - LDSCTL_OFF) / 4; u += 512) ((LAS unsigned*)(F.lds + LDSCTL_OFF))[u] = 0u;
    __syncthreads();
    unsigned char* ws = args.ws;
    XcdBarrier bar = xcd_barrier_post((unsigned*)(ws + WS_CTL), MISC + 8);
    const int lo = args.ph_lo, hi = args.ph_hi;
#define IN(k) (lo <= (k) && (k) < hi)
#define BOTH(k) (IN(k) && IN((k) == 2 ? 4 : (k) + 1))
    if (IN(0)) { ST(0); p0_prologue(args, F); ST(1); if (BOTH(0)) xcd_barrier(bar, F.tid); }
    if (IN(1)) { F.lane = lane_id_fresh(); F.tid = F.wave * 64 + F.lane; ST(2);
        GemmDesc g{(const char*)(ws + WS_XB), (const char*)(ws + WS_WIN), 256L * DM * 2, 0, 256L * DM * 2, 0, 128L * DM * 2, 128L * DM * 2, 128, 128, DM / BK};
        unsigned vA[2], vB[2]; voff_std(vA, DM, false, F.tid); voff_std(vB, DM, true, F.tid);
        StaticOrder S; S.init(MT / BM, DM / BM, F.G, F.bx);
        EpiU E{(const float*)(ws + WS_R0), (bf16_t*)(ws + WS_UPOOL), (bf16_t*)(ws + WS_USSM)};
        gemm_phase<EpiU, StaticOrder, true>(F.lds, g, vA, vB, S, E, F.tid, GP_STAMP(22));
        ST(3);
        if (BOTH(1)) xcd_barrier(bar, F.tid);
#if defined(MK_EXTRA_BAR)
        for (int rep = 0; rep < MK_EXTRA_BAR; ++rep) xcd_barrier(bar, F.tid);
#endif
    }
    if (IN(2)) { F.lane = lane_id_fresh(); F.tid = F.wave * 64 + F.lane; ST(4);
        if (F.bx < 128) {
            OrdSsmB S0{F.bx}; Unit u0; S0.next(0, u0);
            { GemmDesc g{(const char*)(ws + WS_USSM), (const char*)(ws + WS_WAB), 256L * ROWLEN * 2, (long)NCR * ROWLEN * 2, 0, 256L * K1 * 2, 128L * ROWLEN * 2, 128L * K1 * 2, 128, 128, K1 / BK};
              unsigned vA[2], vB[2]; voff_std(vA, ROWLEN, false, F.tid); voff_std(vB, K1, false, F.tid);
              OrdOne S{Unit{u0.pm, 0, u0.g, 0}}; EpiFG E{(float*)(ws + WS_FG)};
              gemm_phase<EpiFG, OrdOne, true>(F.lds, g, vA, vB, S, E, F.tid, GP_STAMP(24)); }
            VM_WAIT(); __syncthreads(); ST(40);
            F.lane = lane_id_fresh(); F.tid = F.wave * 64 + F.lane;
            p3_carries(args, F, u0.g, u0.pm); ST(41);
            tb_wait(args, F, u0.g); ST(42);
            F.lane = lane_id_fresh(); F.tid = F.wave * 64 + F.lane;
            { GemmDesc g{(const char*)(ws + WS_USSM), (const char*)(ws + WS_TB), 256L * ROWLEN * 2, (long)NCR * ROWLEN * 2, 16L * 512, 64L * 512, 128L * ROWLEN * 2, 8L * 512, 128, -4L * 512, ROWLEN / BK,
                         (const char*)(ws + WS_TBC), 256L * 512, (long)K1 * 512, 128L * 512, 128, K1 / BK};
              unsigned vA[2], vB[2], vB2[2]; voff_std(vA, ROWLEN, false, F.tid); voff_std(vB2, 256, true, F.tid);
#pragma unroll
              for (int i = 0; i < 2; ++i) { int R, C; stage_rc(F.tid * 16 + i * 8192, R, C); const int Rb = (R & ~31) + perm32(R & 31);
                  vB[i] = (unsigned)((((Rb >> 4) - (C >> 4) + 31) * 256 + (Rb & 15) * 16 + (C & 15)) * 2); }
              asm volatile("" : "+v"(vA[0]), "+v"(vA[1]), "+v"(vB[0]), "+v"(vB[1]), "+v"(vB2[0]), "+v"(vB2[1]));
              OrdOne S{u0}; EpiZ E{(const bf16_t*)(ws + WS_USSM), args.in[12], (bf16_t*)(ws + WS_ZG)};
              gemm_phase<EpiZ, OrdOne, true, true>(F.lds, g, vA, vB, S, E, F.tid, GP_STAMP(26), vB2); }
        } else { ssm_side(args, F, 128); ST(44); p2_pooled(args, F, 128); }
        ST(5);
        if (BOTH(2)) xcd_barrier(bar, F.tid);
    }
    if (IN(4)) { F.lane = lane_id_fresh(); F.tid = F.wave * 64 + F.lane; ST(8);
        if (F.bx < 128) {
            constexpr long GSTR = (long)MT * 32;
            GemmDesc g{(const char*)(ws + WS_ZG), (const char*)(ws + WS_WGLU), 256L * 32, 0, 256L * DSSM * 2, 0, 128L * 32, 128L * DSSM * 2, 4 * GSTR, 128, DSSM / BK};
            unsigned vA[2], vB[2]; voff_std(vB, DSSM, true, F.tid);
#pragma unroll
            for (int i = 0; i < 2; ++i) { int R, C; stage_rc(F.tid * 16 + i * 8192, R, C); vA[i] = (unsigned)(R * 32 + (C >> 4) * (int)GSTR + (C & 15) * 2); }
            OrdGlu S{F.bx}; EpiGlu E{args.in[14], (const bf16_t*)(ws + WS_ZG), (bf16_t*)(ws + WS_YCAT), (float*)(ws + WS_SSSSM)};
            gemm_phase<EpiGlu, OrdGlu, true>(F.lds, g, vA, vB, S, E, F.tid, GP_STAMP(28));
        } else {
            GemmDesc g{(const char*)(ws + WS_POOLED), (const char*)(ws + WS_PW), 256L * DPOOL * 2, 256L * 2, 256L * 256 * 2, 0, 128L * DPOOL * 2, 128L * 256 * 2, 128, 128, 256 / BK};
            unsigned vA[2], vB[2]; voff_std(vA, DPOOL, false, F.tid); voff_std(vB, 256, true, F.tid);
            OrdPool S{F.bx}; EpiPool E{args.in[4], (bf16_t*)(ws + WS_YCAT), (float*)(ws + WS_SSPOOL)};
            gemm_phase<EpiPool, OrdPool, true>(F.lds, g, vA, vB, S, E, F.tid, GP_STAMP(36));

            __syncthreads();
            p4_side(args, F, 128);
        }
        ST(9);
        if (BOTH(4)) xcd_barrier(bar, F.tid);
    }
    if (IN(5)) { F.lane = lane_id_fresh(); F.tid = F.wave * 64 + F.lane; ST(10);
        StaticOrder S; S.init(MT / BM, DM / BM, F.G, F.bx); Unit u0;
        LAS f32x2* XR = (LAS f32x2*)(F.lds + XTRA_OFF);
        if (S.next(0, u0)) {
            if (F.tid < 256) { const int row = u0.pm * BM + F.tid; const float* sp = (const float*)(ws + WS_SSPOOL); const float* sm = (const float*)(ws + WS_SSSSM); float a0 = 0.f, a1 = 0.f;
#pragma unroll
                for (int s = 0; s < 8; ++s) { a0 += sp[(size_t)s * MT + row]; a1 += sm[(size_t)s * MT + row]; }
                const float rp = rsqrtf(a0 * (1.0f / DPOOL) + EPS), rsm = rsqrtf(a1 * (1.0f / DSSM) + EPS); XR[F.tid] = (f32x2){rp / rsm, rsm}; }
        }
        __syncthreads();
        GemmDesc g{(const char*)(ws + WS_YCAT), (const char*)(ws + WS_WOUT), 256L * DM * 2, 0, 256L * DM * 2, 0, 128L * DM * 2, 128L * DM * 2, 128, 128, DM / BK};
        unsigned vA[2], vB[2]; voff_std(vA, DM, false, F.tid); voff_std(vB, DM, true, F.tid);
        EpiOut E{args.in[0], (bf16_t*)(ws + WS_H1B), (float*)(ws + WS_SSH1), XR, {{0.f, 0.f, 0.f, 0.f}, {0.f, 0.f, 0.f, 0.f}}};
        { const int wr_ = F.wave >> 2, fr_ = F.lane & 15;
#pragma unroll
          for (int ai = 0; ai < 2; ++ai)
#pragma unroll
              for (int m = 0; m < 4; ++m) E.ratio[ai][m] = XR[ai * HALF + wr_ * 64 + m * 16 + fr_].x; }
        gemm_phase<EpiOut, StaticOrder, false>(F.lds, g, vA, vB, S, E, F.tid, GP_STAMP(30));
        ST(11);
        if (BOTH(5)) xcd_barrier(bar, F.tid);
    }
    if (IN(6)) { F.lane = lane_id_fresh(); F.tid = F.wave * 64 + F.lane; ST(12);
        GemmDesc g{(const char*)(ws + WS_H1B), (const char*)(ws + WS_WUP), (long)UPROWS * DM * 2, (long)PADROWS * DM * 2, 256L * DM * 2, 0, 64L * DM * 2, 128L * DM * 2, 128, 128, DM / BK};
        unsigned vA[2], vB[2]; voff_std(vB, DM, true, F.tid);
#pragma unroll
        for (int i = 0; i < 2; ++i) { int R, C; stage_rc(F.tid * 16 + i * 8192, R, C); vA[i] = (unsigned)(((126 * (R >> 6) + (R & 63)) * DM + C) * 2); }
        OrdUp S; S.so.init(BATCH * UPT, DFF2 / BM, F.G, F.bx);
        LAS float* RSL = (LAS float*)(F.lds + XTRA_OFF);
        if (F.tid < 256) { const float* ssh1 = (const float*)(ws + WS_SSH1);
#pragma unroll
            for (int i = 0; i < 6; ++i) { Unit uu; if (S.next(i, uu)) { const int t = UPROWS * uu.pm + F.tid - 1; const bool in = (t >= 0 && t < SEQ && F.tid < 254); const int tok = uu.g * SEQ + (in ? t : 0);
                const float sq = (ssh1[tok] + ssh1[MT + tok]) + (ssh1[2 * MT + tok] + ssh1[3 * MT + tok]); RSL[i * 256 + F.tid] = in ? rsqrtf(sq * (1.0f / DM) + EPS) : 0.f; } } }
        __syncthreads();
        EpiUp E{RSL, args.in[20], args.in[21], (bf16_t*)(ws + WS_ACT)};
        gemm_phase<EpiUp, OrdUp, true>(F.lds, g, vA, vB, S, E, F.tid, GP_STAMP(32));
        ST(13);
        if (BOTH(6)) xcd_barrier(bar, F.tid);
    }
    if (IN(7)) { F.lane = lane_id_fresh(); F.tid = F.wave * 64 + F.lane; ST(14);
        GemmDesc g{(const char*)(ws + WS_ACT), (const char*)(ws + WS_WDOWN), 256L * DFF * 2, 0, 256L * DFF * 2, 0, 128L * DFF * 2, 128L * DFF * 2, 128, 128, DFF / BK};
        unsigned vA[2], vB[2]; voff_std(vA, DFF, false, F.tid); voff_std(vB, DFF, true, F.tid);
        StaticOrder S; S.init(MT / BM, DM / BM, F.G, F.bx);
        EpiDown E{(const bf16_t*)(ws + WS_H1B), args.out, args.in[23], (float*)(ws + WS_SSH2), &bar};
        gemm_phase<EpiDown, StaticOrder, false>(F.lds, g, vA, vB, S, E, F.tid, GP_STAMP(34)); ST(15);
    }
#undef IN
#undef BOTH
}
}

__global__ void k_cvt_u(const bf16_t* __restrict__ upool, const bf16_t* __restrict__ ussm, float* __restrict__ u) {
    const int idx = blockIdx.x * blockDim.x + threadIdx.x; if (idx >= MT * DM) return;
    const int c = idx % DM, row = idx / DM; unsigned short v;
    if (c < DPOOL) v = upool[(size_t)row * DPOOL + c];
    else { const int cs = c - DPOOL, g = cs >> 4, h = cs & 15, cr = row / mk::TCH, p = row % mk::TCH; v = ussm[((size_t)(g * mk::NCR + cr)) * mk::ROWLEN + 16 * p + h]; }
    u[idx] = __builtin_bit_cast(float, (unsigned)v << 16);
}
__global__ void k_cvt_z(const bf16_t* __restrict__ zg, float* __restrict__ z) {
    const int idx = blockIdx.x * blockDim.x + threadIdx.x; if (idx >= MT * DSSM) return;
    const int c = idx % DSSM, row = idx / DSSM; const unsigned short v = zg[((size_t)(c >> 4) * MT + row) * 16 + (c & 15)];
    z[idx] = __builtin_bit_cast(float, (unsigned)v << 16);
}
__global__ void k_cvt_rows(const bf16_t* __restrict__ src, int lds_, float* __restrict__ dst, int ldd, int cols, int rows) {
    const size_t idx = (size_t)blockIdx.x * blockDim.x + threadIdx.x; if (idx >= (size_t)rows * cols) return;
    const int c = (int)(idx % cols); const size_t row = idx / cols; dst[row * ldd + c] = __builtin_bit_cast(float, (unsigned)src[row * lds_ + c] << 16);
}

#if defined(MK_STAMP)
__device__ float stamp_sel(const unsigned long long* st, int ia, int ib, int b0, int b1, int mode) {
    double acc = mode == 1 ? 1e30 : 0.0;
    for (int b = b0; b < b1; ++b) { const double d = (double)(long long)(st[b * 64 + ib] - (ia < 0 ? 0ull : st[b * 64 + ia])) * 0.01;
        if (mode == 0) acc = d > acc ? d : acc; else if (mode == 1) acc = d < acc ? d : acc; else acc += d / (b1 - b0); }
    return (float)acc;
}
__global__ void k_stamp_report(const unsigned long long* st, float* out, int a_ia, int a_ib, int a_b0, int a_b1, int a_mode, float scale) {
    if (blockIdx.x == 0 && threadIdx.x == 0) out[0] += stamp_sel(st, a_ia, a_ib, a_b0, a_b1, a_mode) * scale;
}
#endif

#ifndef MK_CUT
#define MK_CUT 8
#endif
static void gemm(hipStream_t s, const float* A, int lda, const float* B, int ldb, float* C, int ldc, const float* R, int ldr, int M, int N, int K) {
    hipLaunchKernelGGL(k_gemm, dim3(N / 128, M / 128), dim3(256), 0, s, A, lda, B, ldb, C, ldc, R, ldr, K);
}

extern "C" void kernel_launch(void* const* d_in, const int* in_sizes, int n_in, void* d_out, int out_size, void* d_ws, size_t ws_size, hipStream_t stream) {
    static int grid = 0;
    if (grid == 0) {
        int dev = 0, cus = 0, per_cu = 0;
        if (n_in != 24 || out_size != MT * DM || ws_size < mk::WS_END) { fprintf(stderr, "kernel_launch: unexpected problem (n_in %d out %d ws %zu)\n", n_in, out_size, ws_size); grid = -1; return; }
        if (hipGetDevice(&dev) != hipSuccess || hipDeviceGetAttribute(&cus, hipDeviceAttributeMultiprocessorCount, dev) != hipSuccess) { grid = -1; return; }
        if (hipFuncSetAttribute((const void*)mk::mk_fwd, hipFuncAttributeMaxDynamicSharedMemorySize, mk::LDS_BYTES) != hipSuccess) { fprintf(stderr, "kernel_launch: hipFuncSetAttribute failed\n"); grid = -1; return; }
        if (hipOccupancyMaxActiveBlocksPerMultiprocessor(&per_cu, (const void*)mk::mk_fwd, 512, mk::LDS_BYTES) != hipSuccess || per_cu < 1) { fprintf(stderr, "kernel_launch: occupancy query says %d blocks/CU\n", per_cu); }
        (void)hipGetLastError();
        grid = cus;
        if (grid != 256) { fprintf(stderr, "kernel_launch: built for a 256-CU device, found %d CUs\n", cus); grid = -1; return; }
    }
    if (grid < 0) return;
    const float* x = (const float*)d_in[0];
    const float* pool_w = (const float*)d_in[3];   const float* pool_scale = (const float*)d_in[4];
    const float* lnar = (const float*)d_in[5];     const float* aim = (const float*)d_in[6];   const float* ldt = (const float*)d_in[7];
    const float* bre = (const float*)d_in[8];      const float* bim = (const float*)d_in[9];
    const float* cre = (const float*)d_in[10];     const float* cim = (const float*)d_in[11];
    const float* ssm_d = (const float*)d_in[12];   const float* glu_w = (const float*)d_in[13]; const float* glu_b = (const float*)d_in[14];
    const float* g_pool = (const float*)d_in[15];  const float* g_ssm = (const float*)d_in[16];
    const float* w_out = (const float*)d_in[17];   const float* g_ffn = (const float*)d_in[18];
    const float* w_up = (const float*)d_in[19];    const float* conv_w = (const float*)d_in[20]; const float* conv_b = (const float*)d_in[21];
    const float* w_down = (const float*)d_in[22];  const float* g_final = (const float*)d_in[23];
    float* out = (float*)d_out; char* ws = (char*)d_ws; const size_t MiB = 1u << 20; const int EB = 256;
    (void)x; (void)pool_w; (void)pool_scale; (void)lnar; (void)aim; (void)ldt; (void)bre; (void)bim; (void)cre; (void)cim; (void)ssm_d; (void)glu_w; (void)glu_b; (void)g_pool; (void)g_ssm; (void)w_out; (void)g_ffn; (void)w_up; (void)conv_w; (void)conv_b; (void)w_down; (void)g_final;

    (void)hipMemsetAsync(ws + mk::WS_CTL, 0, mk::CTL_ZERO_BYTES, stream);
    mk::Args a{};
    for (int i = 0; i < 24; ++i) a.in[i] = (const float*)d_in[i];
    a.out = out; a.ws = (unsigned char*)d_ws; a.ph_lo = 0; a.ph_hi = MK_CUT;
#if defined(MK_PROBE_LO)
    a.ph_lo = 0; a.ph_hi = MK_PROBE_HI; hipLaunchKernelGGL(mk::mk_fwd, dim3(grid), dim3(512), mk::LDS_BYTES, stream, a);
    for (int r = 0; r < MK_PROBE_REP; ++r) { (void)hipMemsetAsync(ws + mk::WS_CTL, 0, mk::CTL_ZERO_BYTES, stream); a.ph_lo = MK_PROBE_LO; a.ph_hi = MK_PROBE_HI; hipLaunchKernelGGL(mk::mk_fwd, dim3(grid), dim3(512), mk::LDS_BYTES, stream, a); }
    (void)hipMemsetAsync(ws + mk::WS_CTL, 0, mk::CTL_ZERO_BYTES, stream);
    a.ph_lo = MK_PROBE_HI; a.ph_hi = 8; hipLaunchKernelGGL(mk::mk_fwd, dim3(grid), dim3(512), mk::LDS_BYTES, stream, a);
#else
    hipLaunchKernelGGL(mk::mk_fwd, dim3(grid), dim3(512), mk::LDS_BYTES, stream, a);
#endif
#if defined(MK_STAMP)
    hipLaunchKernelGGL(k_stamp_report, dim3(1), dim3(64), 0, stream, (const unsigned long long*)(ws + mk::WS_STAMP), out, MK_STAMP_A);
#endif
#if MK_CUT < 8
    float* bufA = (float*)(ws + 0 * MiB); float* bufB = (float*)(ws + 64 * MiB); float* bufC = (float*)(ws + 128 * MiB); float* bufD = (float*)(ws + 192 * MiB);
    float* pooled = bufA; float* ypool = bufA + (size_t)MT * DPOOL; float* z = pooled; float* pre = bufD; float* ycat = bufB;
#if MK_CUT <= 2
    float* u = bufB;
    hipLaunchKernelGGL(k_cvt_u, dim3(MT * DM / EB), dim3(EB), 0, stream, (const bf16_t*)(ws + mk::WS_UPOOL), (const bf16_t*)(ws + mk::WS_USSM), u);
    hipLaunchKernelGGL(k_pool, dim3(MT * DPOOL / EB), dim3(EB), 0, stream, u, pooled);
    for (int gi = 0; gi < 4; ++gi) gemm(stream, pooled + gi * 128, DPOOL, pool_w + (size_t)gi * 128 * 128, 128, ypool + gi * 128, DPOOL, nullptr, 0, MT, 128, 128);
    float* y2 = bufC;
    hipLaunchKernelGGL(k_ssm_scan, dim3(2 * BATCH * NG), dim3(64), 0, stream, u, lnar, aim, ldt, bre, bim, cre, cim, y2);
    hipLaunchKernelGGL(k_ssm_post, dim3(MT * DSSM / EB), dim3(EB), 0, stream, y2, u, ssm_d, z);
    const float* pre_scale = pool_scale;
#elif MK_CUT <= 4
    hipLaunchKernelGGL(k_cvt_z, dim3(MT * DSSM / EB), dim3(EB), 0, stream, (const bf16_t*)(ws + mk::WS_ZG), z);
    hipLaunchKernelGGL(k_cvt_rows, dim3(MT * DPOOL / EB), dim3(EB), 0, stream, (const bf16_t*)(ws + mk::WS_YCAT), DM, ypool, DPOOL, DPOOL, MT);
    const float* pre_scale = nullptr;
#endif
#if MK_CUT <= 4
    gemm(stream, z, DSSM, glu_w, DSSM, pre, DSSM, nullptr, 0, MT, DSSM, DSSM);
    hipLaunchKernelGGL(k_glu, dim3(MT * DSSM / EB), dim3(EB), 0, stream, z, pre, glu_b);
#elif MK_CUT == 5
    hipLaunchKernelGGL(k_cvt_rows, dim3(MT * DPOOL / EB), dim3(EB), 0, stream, (const bf16_t*)(ws + mk::WS_YCAT), DM, ypool, DPOOL, DPOOL, MT);
    hipLaunchKernelGGL(k_cvt_rows, dim3(MT * DSSM / EB), dim3(EB), 0, stream, (const bf16_t*)(ws + mk::WS_YCAT) + DPOOL, DM, pre, DSSM, DSSM, MT);
    const float* pre_scale = nullptr;
#endif
#if MK_CUT <= 5
    hipLaunchKernelGGL(k_rmsnorm, dim3(MT / 4), dim3(256), 0, stream, ypool, DPOOL, pre_scale, g_pool, ycat, DM, DPOOL, MT);
    hipLaunchKernelGGL(k_rmsnorm, dim3(MT / 4), dim3(256), 0, stream, pre, DSSM, (const float*)nullptr, g_ssm, ycat + DPOOL, DM, DSSM, MT);
    gemm(stream, ycat, DM, w_out, DM, out, DM, x, DM, MT, DM, DM);
#endif
#if MK_CUT <= 6
    float* xn2 = bufA;
    hipLaunchKernelGGL(k_rmsnorm, dim3(MT / 4), dim3(256), 0, stream, out, DM, (const float*)nullptr, g_ffn, xn2, DM, DM, MT);
    float* up = (float*)(ws + 64 * MiB); float* act = (float*)(ws + 152 * MiB);
    for (int b = 0; b < BATCH; ++b) {
        gemm(stream, xn2 + (size_t)b * SEQ * DM, DM, w_up, DFF2, up, DFF2, nullptr, 0, SEQ, DFF2, DM);
        hipLaunchKernelGGL(k_convact, dim3(SEQ * DFF / EB), dim3(EB), 0, stream, up, conv_w, conv_b, act);
        gemm(stream, act, DFF, w_down, DM, out + (size_t)b * SEQ * DM, DM, out + (size_t)b * SEQ * DM, DM, SEQ, DM, DFF);
    }
#else
    float* actf = (float*)(ws + 0 * MiB);
    for (int b = 0; b < BATCH; ++b) {
        hipLaunchKernelGGL(k_cvt_rows, dim3(SEQ * DFF / EB), dim3(EB), 0, stream, (const bf16_t*)(ws + mk::WS_ACT) + (size_t)b * SEQ * DFF, DFF, actf, DFF, DFF, SEQ);
        gemm(stream, actf, DFF, w_down, DM, out + (size_t)b * SEQ * DM, DM, out + (size_t)b * SEQ * DM, DM, SEQ, DM, DFF);
    }
#endif
    hipLaunchKernelGGL(k_rmsnorm, dim3(MT / 4), dim3(256), 0, stream, out, DM, (const float*)nullptr, g_final, out, DM, DM, MT);
    (void)bufC;
#endif
}
```

```cpp
#define MK_CUT 8
#include <hip/hip_runtime.h>
#include <math.h>

constexpr int BATCH = 4, SEQ = 4096, DM = 1024, MT = BATCH * SEQ;
constexpr int DPOOL = 512, DSSM = 512, NG = 32, NH = 16, NS = 64;
constexpr int DFF = 2816, DFF2 = 5632;
constexpr float EPS = 1e-6f;

__global__ void k_rmsnorm(const float* x, int ldx, const float* __restrict__ pre,
                          const float* __restrict__ g, float* out, int ldo, int D, int rows) {
    const int wave = (blockIdx.x * blockDim.x + threadIdx.x) >> 6, lane = threadIdx.x & 63;
    if (wave >= rows) return;
    const float* xr = x + (size_t)wave * ldx;
    float ss = 0.f;
    for (int c = lane; c < D; c += 64) { float v = xr[c]; if (pre) v *= pre[c]; ss += v * v; }
    for (int o = 32; o; o >>= 1) ss += __shfl_xor(ss, o);
    const float inv = rsqrtf(ss / (float)D + EPS);
    float* orow = out + (size_t)wave * ldo;
    for (int c = lane; c < D; c += 64) { float v = xr[c]; if (pre) v *= pre[c]; orow[c] = v * inv * g[c]; }
}

__global__ void __launch_bounds__(256) k_gemm(const float* __restrict__ A, int lda, const float* __restrict__ B, int ldb,
                                               float* C, int ldc, const float* R, int ldr, int K) {
    __shared__ float As[16][132];
    __shared__ float Bs[16][132];
    const int tid = threadIdx.x, tx = tid & 15, ty = tid >> 4;
    const int row0 = blockIdx.y * 128, col0 = blockIdx.x * 128;
    float acc[8][8];
#pragma unroll
    for (int i = 0; i < 8; ++i)
#pragma unroll
        for (int j = 0; j < 8; ++j) acc[i][j] = 0.f;
    for (int k0 = 0; k0 < K; k0 += 16) {
#pragma unroll
        for (int p = 0; p < 2; ++p) {
            const int i = tid + p * 256, r = i >> 2, kk = (i & 3) * 4;
            const float4 v = *(const float4*)(A + (size_t)(row0 + r) * lda + k0 + kk);
            As[kk + 0][r] = v.x; As[kk + 1][r] = v.y; As[kk + 2][r] = v.z; As[kk + 3][r] = v.w;
        }
#pragma unroll
        for (int p = 0; p < 2; ++p) {
            const int i = tid + p * 256, kk = i >> 5, c = (i & 31) * 4;
            const float4 v = *(const float4*)(B + (size_t)(k0 + kk) * ldb + col0 + c);
            *(float4*)&Bs[kk][c] = v;
        }
        __syncthreads();
#pragma unroll
        for (int kk = 0; kk < 16; ++kk) {
            float a[8], b[8];
            const float4 a0 = *(const float4*)&As[kk][ty * 4], a1 = *(const float4*)&As[kk][64 + ty * 4];
            const float4 b0 = *(const float4*)&Bs[kk][tx * 4], b1 = *(const float4*)&Bs[kk][64 + tx * 4];
            a[0] = a0.x; a[1] = a0.y; a[2] = a0.z; a[3] = a0.w; a[4] = a1.x; a[5] = a1.y; a[6] = a1.z; a[7] = a1.w;
            b[0] = b0.x; b[1] = b0.y; b[2] = b0.z; b[3] = b0.w; b[4] = b1.x; b[5] = b1.y; b[6] = b1.z; b[7] = b1.w;
#pragma unroll
            for (int i = 0; i < 8; ++i)
#pragma unroll
                for (int j = 0; j < 8; ++j) acc[i][j] = fmaf(a[i], b[j], acc[i][j]);
        }
        __syncthreads();
    }
#pragma unroll
    for (int i = 0; i < 8; ++i) {
        const int r = row0 + (i < 4 ? ty * 4 + i : 64 + ty * 4 + (i - 4));
#pragma unroll
        for (int jh = 0; jh < 2; ++jh) {
            const int c = col0 + jh * 64 + tx * 4;
            float4 v = make_float4(acc[i][jh * 4 + 0], acc[i][jh * 4 + 1], acc[i][jh * 4 + 2], acc[i][jh * 4 + 3]);
            if (R) { const float4 rr = *(const float4*)(R + (size_t)r * ldr + c); v.x += rr.x; v.y += rr.y; v.z += rr.z; v.w += rr.w; }
            *(float4*)(C + (size_t)r * ldc + c) = v;
        }
    }
}

__global__ void k_pool(const float* __restrict__ u  , float* __restrict__ pooled  ) {
    const int idx = blockIdx.x * blockDim.x + threadIdx.x;
    if (idx >= MT * DPOOL) return;
    const int c = idx % DPOOL, row = idx / DPOOL, b = row / SEQ, t = row % SEQ;
    const int gi = c / 128, w = 2 << gi, half = w / 2;
    int lo = t - half, hi = t + half; if (lo < 0) lo = 0; if (hi > SEQ) hi = SEQ;
    float s = 0.f;
    for (int q = lo; q < hi; ++q) s += u[(size_t)(b * SEQ + q) * DM + c];
    pooled[idx] = s / (float)(hi - lo) - u[(size_t)row * DM + c];
}

__global__ void __launch_bounds__(64) k_ssm_scan(const float* __restrict__ u  ,
        const float* __restrict__ lnar, const float* __restrict__ aim, const float* __restrict__ ldt,
        const float* __restrict__ bre, const float* __restrict__ bim, const float* __restrict__ cre, const float* __restrict__ cim,
        float* __restrict__ y  ) {
    const int n = threadIdx.x;
    const int g = blockIdx.x % NG, b = (blockIdx.x / NG) % BATCH, dir = blockIdx.x / (NG * BATCH);
    const float dt = expf(ldt[dir * NG + g]);
    const float a_re = -expf(lnar[(dir * NG + g) * NS + n]), a_im = aim[(dir * NG + g) * NS + n];
    const float mag = expf(a_re * dt), ang = a_im * dt;
    const float lam_re = mag * cosf(ang), lam_im = mag * sinf(ang);
    const float den = a_re * a_re + a_im * a_im;
    const float f_re = ((lam_re - 1.0f) * a_re + lam_im * a_im) / den;
    const float f_im = (lam_im * a_re - (lam_re - 1.0f) * a_im) / den;
    float Br[NH], Bi[NH], Cr[NH], Ci[NH];
#pragma unroll
    for (int h = 0; h < NH; ++h) {
        Br[h] = bre[((size_t)(dir * NG + g) * NS + n) * NH + h];
        Bi[h] = bim[((size_t)(dir * NG + g) * NS + n) * NH + h];
        Cr[h] = cre[((size_t)(dir * NG + g) * NH + h) * NS + n];
        Ci[h] = cim[((size_t)(dir * NG + g) * NH + h) * NS + n];
    }
    float s_re = 0.f, s_im = 0.f;
    float* yd = y + (size_t)dir * MT * DSSM;
    for (int i = 0; i < SEQ; ++i) {
        const int t = dir ? (SEQ - 1 - i) : i;
        const float* ur = u + (size_t)(b * SEQ + t) * DM + DPOOL + g * NH;
        float bu_re = 0.f, bu_im = 0.f;
#pragma unroll
        for (int h = 0; h < NH; ++h) { const float uv = ur[h]; bu_re = fmaf(Br[h], uv, bu_re); bu_im = fmaf(Bi[h], uv, bu_im); }
        const float in_re = f_re * bu_re - f_im * bu_im, in_im = f_re * bu_im + f_im * bu_re;
        const float nr = lam_re * s_re - lam_im * s_im + in_re;
        const float ni = lam_re * s_im + lam_im * s_re + in_im;
        s_re = nr; s_im = ni;
        float mine = 0.f;
#pragma unroll
        for (int h = 0; h < NH; ++h) {
            float p = Cr[h] * s_re - Ci[h] * s_im;
#pragma unroll
            for (int o = 32; o; o >>= 1) p += __shfl_xor(p, o);
            if (n == h) mine = p;
        }
        if (n < NH) yd[(size_t)(b * SEQ + t) * DSSM + g * NH + n] = mine;
    }
}

__device__ __forceinline__ float gelu_tanh(float x) {
    const float k = 0.7978845608028654f;
    return 0.5f * x * (1.0f + tanhf(k * (x + 0.044715f * x * x * x)));
}
__device__ __forceinline__ float sigmoidf_(float x) { return 1.0f / (1.0f + expf(-x)); }

__global__ void k_ssm_post(const float* __restrict__ y2, const float* __restrict__ u, const float* __restrict__ d, float* __restrict__ z) {
    const int idx = blockIdx.x * blockDim.x + threadIdx.x;
    if (idx >= MT * DSSM) return;
    const int c = idx % DSSM, row = idx / DSSM;
    const float yv = y2[idx] + y2[(size_t)MT * DSSM + idx] + d[c] * u[(size_t)row * DM + DPOOL + c];
    z[idx] = gelu_tanh(yv);
}
__global__ void k_glu(const float* __restrict__ z, float* __restrict__ pre, const float* __restrict__ gb) {
    const int idx = blockIdx.x * blockDim.x + threadIdx.x;
    if (idx >= MT * DSSM) return;
    const int c = idx % DSSM;
    pre[idx] = z[idx] * sigmoidf_(pre[idx] + gb[c]);
}
__global__ void k_convact(const float* __restrict__ up  , const float* __restrict__ cw, const float* __restrict__ cb, float* __restrict__ act  ) {
    const int idx = blockIdx.x * blockDim.x + threadIdx.x;
    if (idx >= SEQ * DFF) return;
    const int f = idx % DFF, t = idx / DFF;
    float v = cb[f], gt = cb[DFF + f];
#pragma unroll
    for (int k = 0; k < 3; ++k) {
        const int q = t + k - 1;
        if (q >= 0 && q < SEQ) {
            v = fmaf(up[(size_t)q * DFF2 + f], cw[k * DFF2 + f], v);
            gt = fmaf(up[(size_t)q * DFF2 + DFF + f], cw[k * DFF2 + DFF + f], gt);
        }
    }
    act[idx] = v * (gt * sigmoidf_(gt));
}


#include <cstdio>
#include <cstdint>
#define LAS __attribute__((address_space(3)))
#define GAS __attribute__((address_space(1)))
typedef unsigned short bf16_t;
typedef short bf16x8 __attribute__((ext_vector_type(8)));
typedef float f32x4 __attribute__((ext_vector_type(4)));
typedef float f32x2 __attribute__((ext_vector_type(2)));
typedef unsigned u32x4 __attribute__((ext_vector_type(4)));
typedef unsigned u32x2 __attribute__((ext_vector_type(2)));

namespace mk {
constexpr int TCH = 16;
constexpr int K1 = 16 * TCH;
constexpr int ROWLEN = K1 + 256;
constexpr int NCR = MT / TCH;
constexpr int NCHB = SEQ / TCH;
constexpr int PADROWS = 4352;
constexpr int UPT = 17;
constexpr int UPROWS = 252;

constexpr size_t MiB = 1u << 20;
constexpr size_t WS_CTL = 0, CTL_ZERO_BYTES = 64 * 1024;
constexpr int CW_TBCNT = 4096;
constexpr size_t WS_R0 = 1 * MiB;
constexpr size_t WS_SSPOOL = 2 * MiB;
constexpr size_t WS_SSSSM = WS_SSPOOL + 8 * MT * 4;
constexpr size_t WS_SSH1 = WS_SSSSM + 8 * MT * 4;
constexpr size_t WS_SSH2 = WS_SSH1 + 4 * MT * 4;
constexpr size_t WS_LAMT = 6 * MiB;
constexpr size_t WS_WIN = 8 * MiB, WS_WOUT = 10 * MiB, WS_WGLU = 12 * MiB, WS_PW = 12 * MiB + 512 * 1024;
constexpr size_t WS_WUP = 13 * MiB, WS_WDOWN = 24 * MiB;
constexpr size_t WS_WAB = 30 * MiB;
constexpr size_t WS_TB = 38 * MiB;
constexpr size_t WS_TBC = 40 * MiB;
constexpr size_t WS_H1B = 62 * MiB;
constexpr size_t WS_XB = 96 * MiB;
constexpr size_t WS_YCAT = 96 * MiB;
constexpr size_t WS_UPOOL = 128 * MiB;
constexpr size_t WS_USSM = 144 * MiB;
constexpr size_t WS_FG = 176 * MiB;
constexpr size_t WS_POOLED = 208 * MiB;
constexpr size_t WS_ZG = 224 * MiB;
constexpr size_t WS_ACT = 96 * MiB;
constexpr size_t WS_END = 240 * MiB;

constexpr int RING_BYTES = 131072, XTRA_OFF = RING_BYTES, XTRA_BYTES = 12288, LDSCTL_OFF = XTRA_OFF + XTRA_BYTES, LDS_BYTES = 147456;

__device__ __forceinline__ unsigned f2bf(float f) { unsigned u = __builtin_bit_cast(unsigned, f); return (u + 0x7fffu + ((u >> 16) & 1u)) >> 16; }
__device__ __forceinline__ unsigned pk2(float lo, float hi) { return f2bf(lo) | (f2bf(hi) << 16); }
__device__ __forceinline__ unsigned cvt_pk_bf16(float lo, float hi) { unsigned r; asm volatile("v_cvt_pk_bf16_f32 %0, %1, %2" : "=v"(r) : "v"(lo), "v"(hi)); return r; }
__device__ __forceinline__ u32x4 pack8(f32x4 a, f32x4 b) { u32x4 w; w.x = cvt_pk_bf16(a[0], a[1]); w.y = cvt_pk_bf16(a[2], a[3]); w.z = cvt_pk_bf16(b[0], b[1]); w.w = cvt_pk_bf16(b[2], b[3]); return w; }
__device__ __forceinline__ u32x2 pack4(f32x4 a) { u32x2 w; w.x = cvt_pk_bf16(a[0], a[1]); w.y = cvt_pk_bf16(a[2], a[3]); return w; }
__device__ __forceinline__ float bflo(unsigned w) { return __builtin_bit_cast(float, w << 16); }
__device__ __forceinline__ float bfhi(unsigned w) { return __builtin_bit_cast(float, w & 0xffff0000u); }
__device__ __forceinline__ void unpack8(u32x4 w, f32x4& a, f32x4& b) { a[0] = bflo(w.x); a[1] = bfhi(w.x); a[2] = bflo(w.y); a[3] = bfhi(w.y); b[0] = bflo(w.z); b[1] = bfhi(w.z); b[2] = bflo(w.w); b[3] = bfhi(w.w); }
__device__ __forceinline__ float fast_sigmoid(float x) { return __builtin_amdgcn_rcpf(1.0f + __builtin_amdgcn_exp2f(-1.4426950408889634f * x)); }
__device__ __forceinline__ float fast_gelu_tanh(float x) {
    const float t = x * (1.0f + 0.044715f * x * x);
    return x * __builtin_amdgcn_rcpf(1.0f + __builtin_amdgcn_exp2f(-2.0f * 0.7978845608028654f * 1.4426950408889634f * t));
}
__device__ __forceinline__ float wave_sum(float v) {
#pragma unroll
    for (int o = 1; o < 64; o <<= 1) v += __shfl_xor(v, o);
    return v;
}
__device__ __forceinline__ float dpp_ror1(float v)  { return __builtin_bit_cast(float, __builtin_amdgcn_update_dpp(0, __builtin_bit_cast(int, v), 0x121, 0xf, 0xf, false)); }
__device__ __forceinline__ float dpp_ror15(float v) { return __builtin_bit_cast(float, __builtin_amdgcn_update_dpp(0, __builtin_bit_cast(int, v), 0x12F, 0xf, 0xf, false)); }
__device__ __forceinline__ int lane_id_fresh() { int l; asm volatile("v_mbcnt_lo_u32_b32 %0, -1, 0\n\tv_mbcnt_hi_u32_b32 %0, -1, %0" : "=v"(l)); return l; }
#define LDS_WAIT() asm volatile("s_waitcnt lgkmcnt(0)" ::: "memory")
#define VM_WAIT() asm volatile("s_waitcnt vmcnt(0)" ::: "memory")

#define XB_TMO      128
#define XB_XCNT(j)  (256  + 64 * (j))
#define XB_XSUB(j)  (1280 + 64 * (j))
#define XB_XGEN(j)  (2304 + 64 * (j))
#define XB_TOP      3328
#define XB_TOPGEN   3392
#define XCD_BAR_WORDS 3456
#define XB_SPIN_CAP (1u << 18)
__device__ __forceinline__ unsigned xb_ld(unsigned* p)              { return __hip_atomic_load(p, __ATOMIC_RELAXED, __HIP_MEMORY_SCOPE_AGENT); }
__device__ __forceinline__ unsigned xb_add(unsigned* p, unsigned v) { return __hip_atomic_fetch_add(p, v, __ATOMIC_RELAXED, __HIP_MEMORY_SCOPE_AGENT); }
__device__ __forceinline__ unsigned xb_xcc_id() { return (unsigned)__builtin_amdgcn_s_getreg((3 << 11) | 20) & 0xFu; }
#define XB_SPIN(cond, bar) do { unsigned _sp = 0; while (cond) { __builtin_amdgcn_s_sleep(1); \
    if ((++_sp & 255u) == 0u) { if (xb_ld(&(bar)[XB_TMO])) break; if (_sp > XB_SPIN_CAP) { atomicAdd(&(bar)[XB_TMO], 1u); break; } } } } while (0)
struct XcdBarrier { unsigned* bar; unsigned x; volatile LAS unsigned* st; };
__device__ __forceinline__ XcdBarrier xcd_barrier_post(unsigned* bar, volatile LAS unsigned* st) {
    XcdBarrier b; b.bar = bar; b.x = xb_xcc_id(); b.st = st;
    if (threadIdx.x == 0) (void)xb_add(&bar[XB_XCNT(b.x)], 1u);
    return b;
}
__device__ __forceinline__ void xcd_barrier_complete(unsigned* bar, unsigned x, unsigned& nloc, unsigned& nx) {
    const unsigned G = gridDim.x * gridDim.y * gridDim.z;
    unsigned sum, cnt, mine, sp = 0u;
    for (;;) {
        sum = 0u; cnt = 0u; mine = 0u;
#pragma unroll
        for (unsigned j = 0; j < 16; ++j) { const unsigned c = xb_ld(&bar[XB_XCNT(j)]); sum += c; cnt += (c > 0u) ? 1u : 0u; mine = (j == x) ? c : mine; }
        if (sum == G) break;
        __builtin_amdgcn_s_sleep(1);
        if ((++sp & 255u) == 0u) { if (xb_ld(&bar[XB_TMO])) break; if (sp > XB_SPIN_CAP) { atomicAdd(&bar[XB_TMO], 1u); break; } }
    }
    nloc = mine > 0u ? mine : 1u; nx = cnt > 0u ? cnt : 1u;
}
__device__ __forceinline__ void xcd_barrier(const XcdBarrier& b, int tid) {
    asm volatile("s_waitcnt vmcnt(0)" ::: "memory");
    __syncthreads();
    if (tid == 0) {
        unsigned* bar = b.bar;
        __builtin_amdgcn_s_waitcnt(0);
        unsigned nloc = b.st[0], nx = b.st[1];
        if (nloc == 0u) { xcd_barrier_complete(bar, b.x, nloc, nx); b.st[0] = nloc; b.st[1] = nx; }
        const unsigned old = xb_add(&bar[XB_XSUB(b.x)], 1u);
        const unsigned gen = old / nloc;
        if (old + 1u == (gen + 1u) * nloc) {
            __builtin_amdgcn_fence(__ATOMIC_RELEASE, "agent");
            asm volatile("s_waitcnt vmcnt(0)" ::: "memory");
            const unsigned og = xb_add(&bar[XB_TOP], 1u);
            const unsigned tg = og / nx;
            if (og + 1u == (tg + 1u) * nx) xb_add(&bar[XB_TOPGEN], 1u);
            else XB_SPIN(xb_ld(&bar[XB_TOPGEN]) == tg, bar);
            __builtin_amdgcn_fence(__ATOMIC_ACQUIRE, "agent");
            xb_add(&bar[XB_XGEN(b.x)], 1u);
            asm volatile("s_waitcnt vmcnt(0)" ::: "memory");
        } else {
            XB_SPIN(xb_ld(&bar[XB_XGEN(b.x)]) == gen, bar);
            __builtin_amdgcn_fence(__ATOMIC_ACQUIRE, "agent");
            asm volatile("s_waitcnt vmcnt(0)" ::: "memory");
        }
    }
    __syncthreads();
}

#ifndef EXP_WGM
#define EXP_WGM 8
#endif
constexpr int BM = 256, BK = 64, HALF = 128, HTB = HALF * BK * 2, STAGE_BYTES = 8 * HTB, NXCD = 8, WGM = EXP_WGM;
__host__ __device__ __forceinline__ int lds_byte(int r, int c) { const int st = (r >> 4) * 2 + (c >> 5), rr = r & 15, cc = c & 31, ob = rr * 64 + cc * 2; return st * 1024 + (ob ^ (((ob >> 9) & 1) << 5)); }
__host__ __device__ __forceinline__ void stage_rc(int b, int& R, int& C) { const int st = b / 1024, sb = b % 1024, swz = sb ^ (((sb >> 9) & 1) << 5); R = (st >> 1) * 16 + swz / 64; C = (st & 1) * 32 + (swz % 64) / 2; }
__host__ __device__ __forceinline__ int perm32(int rho) { const int n = rho >> 4, i = rho & 15; return 8 * (i >> 2) + 4 * n + (i & 3); }

struct Unit { int pm, pn, g, aux; };
struct GemmDesc { const char* A; const char* B; long a_pm, a_g, b_pn, b_g, a_h, b_h, a_k, b_k; int nt;
                  const char* B2; long b2_pn, b2_g, b2_h, b2_k; int tsw; };

struct StaticOrder {
    int nM, nN, nwg, G, c;
    __device__ void init(int nM_, int nN_, int G_, int c_) { nM = nM_; nN = nN_; nwg = nM * nN; G = G_; c = c_; }
    __device__ bool next(int i, Unit& u) const {
        const long L = (long)i * G + c; if (L >= nwg) return false;
        int wgid = (int)L; { const int q = nwg / NXCD, r = nwg % NXCD, xcd = wgid % NXCD, off = wgid / NXCD; wgid = (xcd < r ? xcd * (q + 1) : r * (q + 1) + (xcd - r) * q) + off; }
        const int nig = WGM * nN, gid = wgid / nig, fm = gid * WGM, gsz = (nM - fm) < WGM ? (nM - fm) : WGM;
        u.pm = fm + ((wgid % nig) % gsz); u.pn = (wgid % nig) / gsz; u.g = 0; u.aux = 0; return true;
    }
};

template <class Epi, class Sched, bool ALIGN_EPI, bool SEG2 = false>
__device__ __forceinline__ void gemm_phase(LAS unsigned char* lds, const GemmDesc g, const unsigned (&voffA)[2], const unsigned (&voffB)[2], const Sched& S, Epi& E, int tid, unsigned long long* stp = nullptr, const unsigned* voffB2 = nullptr) {
    const int wid = __builtin_amdgcn_readfirstlane(tid >> 6), lane = tid & 63, wr = wid >> 2, wc = wid & 3, fr = lane & 15, fq = lane >> 4;
    const int nt = g.nt;
    const long kstepA = g.a_k, kstepB = g.b_k, hstepA = g.a_h, hstepB = g.b_h;
    const unsigned ldsw = (unsigned)wid * 1024u;
    const int aoff = lds_byte(wr * 64 + fr, fq * 8), boff = lds_byte(wc * 32 + fr, fq * 8);
#define PG8_SA(b, h) (((b) * 2 + (h)) * HTB)
#define PG8_SB(b, h) ((4 + (b) * 2 + (h)) * HTB)
#define PG8_STAGE(bufoff, gbase, voff) do { const char* _gb = (const char*)(gbase); asm volatile("" : "+s"(_gb));   _Pragma("unroll") for (int _i = 0; _i < 2; ++_i) \
        __builtin_amdgcn_global_load_lds((const unsigned*)(_gb + (voff)[_i]), (LAS unsigned*)(lds + (bufoff) + ldsw + _i * 8192), 16, 0, 0); } while (0)
#define PG8_LDA(dst, b, h) do { _Pragma("unroll") for (int m = 0; m < 4; ++m) _Pragma("unroll") for (int k = 0; k < 2; ++k) dst[m][k] = *(const LAS bf16x8*)(lds + PG8_SA(b, h) + aoff + m * 2048 + k * 1024); } while (0)
#define PG8_LDB(dst, b, h) do { _Pragma("unroll") for (int n = 0; n < 2; ++n) _Pragma("unroll") for (int k = 0; k < 2; ++k) dst[n][k] = *(const LAS bf16x8*)(lds + PG8_SB(b, h) + boff + n * 2048 + k * 1024); } while (0)
#define PG8_MMA(ai, bj, At, Bt) do { __builtin_amdgcn_s_setprio(1); _Pragma("unroll") for (int m = 0; m < 4; ++m) _Pragma("unroll") for (int n = 0; n < 2; ++n) _Pragma("unroll") for (int k = 0; k < 2; ++k) \
        acc[ai][bj][m][n] = __builtin_amdgcn_mfma_f32_16x16x32_bf16(Bt[n][k], At[m][k], acc[ai][bj][m][n], 0, 0, 0); __builtin_amdgcn_s_setprio(0); } while (0)
#define PG8_WAIT_V(n) asm volatile("s_waitcnt vmcnt(" #n ")" ::: "memory")
#define PG8_WAIT_L(n) asm volatile("s_waitcnt lgkmcnt(" #n ")" ::: "memory")
#define PG8_BAR __builtin_amdgcn_s_barrier()
#define PG8_SCHED __builtin_amdgcn_sched_barrier(0)
    Unit cur, nxt; int ui = 0;
    if (!S.next(0, cur)) return;
    f32x4 acc[2][2][4][2];
#pragma unroll
    for (int a = 0; a < 2; ++a)
#pragma unroll
        for (int b = 0; b < 2; ++b)
#pragma unroll
            for (int m = 0; m < 4; ++m)
#pragma unroll
                for (int n = 0; n < 2; ++n) acc[a][b][m][n] = (f32x4){0.f, 0.f, 0.f, 0.f};
    bf16x8 At[4][2], B0[2][2], B1[2][2];
    const char* cA = g.A + (long)cur.pm * g.a_pm + (long)cur.g * g.a_g; const char* cB = g.B + (long)cur.pn * g.b_pn + (long)cur.g * g.b_g;
    const char* cB2 = SEG2 ? g.B2 + (long)cur.pn * g.b2_pn + (long)cur.g * g.b2_g : nullptr;
    PG8_STAGE(PG8_SB(0, 0), cB, voffB); PG8_STAGE(PG8_SB(0, 1), cB + hstepB, voffB); PG8_STAGE(PG8_SA(0, 0), cA, voffA); PG8_STAGE(PG8_SA(0, 1), cA + hstepA, voffA);
    if (wr == 1) PG8_BAR;
    PG8_WAIT_V(2); PG8_BAR;
    PG8_STAGE(PG8_SB(1, 0), cB + kstepB, voffB); PG8_STAGE(PG8_SA(1, 0), cA + kstepA, voffA); PG8_STAGE(PG8_SB(1, 1), cB + hstepB + kstepB, voffB);
    PG8_WAIT_V(6); PG8_BAR;
    unsigned long long st_t0 = stp ? __builtin_amdgcn_s_memrealtime() : 0ull, st_loop = 0ull, st_epi = 0ull;
    for (;;) {
        const bool has_next = S.next(ui + 1, nxt);
        const char* nA = has_next ? g.A + (long)nxt.pm * g.a_pm + (long)nxt.g * g.a_g : cA; const char* nB = has_next ? g.B + (long)nxt.pn * g.b_pn + (long)nxt.g * g.b_g : cB;
        for (int t = 0; t < nt; t += 2) {
            const bool last = (t == nt - 2);
            const char* a1 = cA + (long)(t + 1) * kstepA;
            const bool sg = SEG2 && !last && (t + 2 >= g.tsw);
            const char* a2 = last ? nA : cA + (long)(t + 2) * kstepA; const char* b2 = last ? nB : (sg ? cB2 + (long)(t + 2 - g.tsw) * g.b2_k : cB + (long)(t + 2) * kstepB);
            const char* a3 = a2 + kstepA; const char* b3 = b2 + (sg ? g.b2_k : kstepB);
            const long hB = sg ? g.b2_h : hstepB;
            unsigned vbs[2]; vbs[0] = sg ? voffB2[0] : voffB[0]; vbs[1] = sg ? voffB2[1] : voffB[1];
            PG8_LDB(B0, 0, 0); PG8_LDB(B1, 0, 1); PG8_SCHED; PG8_LDA(At, 0, 0); PG8_STAGE(PG8_SA(1, 1), a1 + hstepA, voffA);
            PG8_WAIT_V(8); PG8_WAIT_L(0); PG8_BAR; PG8_MMA(0, 0, At, B0); PG8_MMA(0, 1, At, B1); PG8_BAR; PG8_SCHED;
            PG8_LDA(At, 0, 1); PG8_STAGE(PG8_SB(0, 0), b2, vbs); PG8_STAGE(PG8_SB(0, 1), b2 + hB, vbs); PG8_STAGE(PG8_SA(0, 0), a2, voffA);
            PG8_WAIT_V(8); PG8_WAIT_L(0); PG8_BAR; PG8_MMA(1, 0, At, B0); PG8_MMA(1, 1, At, B1); PG8_BAR; PG8_SCHED;
            PG8_LDB(B0, 1, 0); PG8_LDB(B1, 1, 1); PG8_SCHED; PG8_LDA(At, 1, 0); PG8_STAGE(PG8_SA(0, 1), a2 + hstepA, voffA);
            PG8_WAIT_V(8); PG8_WAIT_L(0); PG8_BAR; PG8_MMA(0, 0, At, B0); PG8_MMA(0, 1, At, B1); PG8_BAR; PG8_SCHED;
            PG8_LDA(At, 1, 1); PG8_STAGE(PG8_SB(1, 0), b3, vbs); PG8_STAGE(PG8_SB(1, 1), b3 + hB, vbs); PG8_STAGE(PG8_SA(1, 0), a3, voffA);
            PG8_WAIT_V(8); PG8_WAIT_L(0); PG8_BAR; PG8_MMA(1, 0, At, B0); PG8_MMA(1, 1, At, B1); PG8_BAR; PG8_SCHED;
            if constexpr (Epi::HAS_MID) { if (t + 2 == Epi::MID_T) E.mid(acc, wr, fr); }
        }
        if (stp) { const unsigned long long t1 = __builtin_amdgcn_s_memrealtime(); st_loop += t1 - st_t0; st_t0 = t1; }
        if constexpr (ALIGN_EPI) { if (wr == 0) PG8_BAR; }
        if constexpr (!Epi::AFTER_DRAIN) { E(acc, cur, wr, wc, fr, fq); }
        if (stp) { const unsigned long long t1 = __builtin_amdgcn_s_memrealtime(); st_epi += t1 - st_t0; st_t0 = t1; }
        if (!has_next) break;
#pragma unroll
        for (int a = 0; a < 2; ++a)
#pragma unroll
            for (int b = 0; b < 2; ++b)
#pragma unroll
                for (int m = 0; m < 4; ++m)
#pragma unroll
                    for (int n = 0; n < 2; ++n) acc[a][b][m][n] = (f32x4){0.f, 0.f, 0.f, 0.f};
        cur = nxt; cA = nA; cB = nB; ++ui; if constexpr (SEG2) cB2 = g.B2 + (long)cur.pn * g.b2_pn + (long)cur.g * g.b2_g;
        if constexpr (ALIGN_EPI) { if (wr == 1) PG8_BAR; }
    }
    PG8_WAIT_V(0);
    if constexpr (!ALIGN_EPI) { if (wr == 0) PG8_BAR; }
    PG8_BAR;
    if (stp) { const unsigned long long t1 = __builtin_amdgcn_s_memrealtime(); st_loop += t1 - st_t0; st_t0 = t1; }
    if constexpr (Epi::AFTER_DRAIN) { E.fused(acc, cur, wr, wc, fr, fq, lds, wid, lane); }
    if (stp) { const unsigned long long t1 = __builtin_amdgcn_s_memrealtime(); st_epi += t1 - st_t0; if (tid == 0) { stp[0] = st_loop; stp[1] = st_epi; } }
#undef PG8_SA
#undef PG8_SB
#undef PG8_STAGE
#undef PG8_LDA
#undef PG8_LDB
#undef PG8_MMA
#undef PG8_WAIT_V
#undef PG8_WAIT_L
#undef PG8_BAR
#undef PG8_SCHED
}

__device__ __forceinline__ void voff_std(unsigned (&v)[2], int ld, bool perm, int tid) {
#pragma unroll
    for (int i = 0; i < 2; ++i) { int R, C; stage_rc(tid * 16 + i * 8192, R, C); const int Rb = perm ? ((R & ~31) + perm32(R & 31)) : R; v[i] = (unsigned)(Rb * ld + C) * 2u; }
}

typedef f32x4 Acc[2][2][4][2];

struct EpiU {
    static constexpr bool PERM = true, AFTER_DRAIN = false, HAS_MID = false; static constexpr int MID_T = 0;
    const float* r0; bf16_t* upool; bf16_t* ussm;
    __device__ __forceinline__ void operator()(Acc& acc, const Unit& u, int wr, int wc, int fr, int fq) const {
#pragma unroll
        for (int ai = 0; ai < 2; ++ai)
#pragma unroll
            for (int m = 0; m < 4; ++m) {
                const int row = u.pm * BM + ai * HALF + wr * 64 + m * 16 + fr; const float rs = r0[row];
#pragma unroll
                for (int bj = 0; bj < 2; ++bj) {
                    const int c8 = u.pn * BM + bj * HALF + wc * 32 + 8 * fq;
                    const u32x4 w = pack8(acc[ai][bj][m][0] * rs, acc[ai][bj][m][1] * rs);
                    if (u.pn < 2) *(u32x4*)(upool + (size_t)row * DPOOL + c8) = w;
                    else { const int cs = c8 - DPOOL, gg = cs >> 4, h0 = cs & 15, cr = row / TCH, p = row % TCH;
                           *(u32x4*)(ussm + ((size_t)(gg * NCR + cr) * ROWLEN + 16 * p + h0)) = w; }
                }
            }
    }
};
struct EpiFG {
    static constexpr bool PERM = false, AFTER_DRAIN = false, HAS_MID = false; static constexpr int MID_T = 0;
    float* fg;
    __device__ __forceinline__ void operator()(Acc& acc, const Unit& u, int wr, int wc, int fr, int fq) const {
#pragma unroll
        for (int ai = 0; ai < 2; ++ai)
#pragma unroll
            for (int m = 0; m < 4; ++m) {
                const int cr = u.pm * BM + ai * HALF + wr * 64 + m * 16 + fr; float* rowp = fg + ((size_t)u.g * NCR + cr) * 256 + wc * 32 + 4 * fq;
#pragma unroll
                for (int bj = 0; bj < 2; ++bj)
#pragma unroll
                    for (int n = 0; n < 2; ++n) *(f32x4*)(rowp + bj * HALF + n * 16) = acc[ai][bj][m][n];
            }
    }
};
struct cf { float r, i; };
__device__ __forceinline__ cf cmul(cf a, cf b) { return cf{a.r * b.r - a.i * b.i, a.r * b.i + a.i * b.r}; }
__device__ __forceinline__ cf cmad(cf a, cf b, cf c) { return cf{a.r * b.r - a.i * b.i + c.r, a.r * b.i + a.i * b.r + c.i}; }
template <int CTRL> __device__ __forceinline__ float dppz(float v) { return __builtin_bit_cast(float, __builtin_amdgcn_update_dpp(0, __builtin_bit_cast(int, v), CTRL, 0xf, 0xf, true)); }
template <int CTRL> __device__ __forceinline__ cf cdpp(cf v) { return cf{dppz<CTRL>(v.r), dppz<CTRL>(v.i)}; }
struct EpiScan {
    static constexpr bool PERM = false, AFTER_DRAIN = true, HAS_MID = false; static constexpr int MID_T = 0;
    const float* lamT; bf16_t* ussm;
    __device__ __forceinline__ void fused(Acc& acc, const Unit& u, int wr, int wc, int fr, int fq, LAS unsigned char* lds, int wid, int lane) const {
        LAS float* SEG = (LAS float*)lds;
        cf X[2][2][2][2];
        LAS unsigned char* CIM = lds + 8192;
#pragma unroll
        for (int bj = 0; bj < 2; ++bj)
#pragma unroll
            for (int np = 0; np < 2; ++np) {
                const int n0 = 16 * wc + 8 * np + 2 * fq;
                const f32x4 l4 = *(const f32x4*)(lamT + ((size_t)(bj * NG + u.g) * NS + n0) * 2);
#pragma unroll
                for (int e = 0; e < 2; ++e) {
                    const cf lam{l4[2 * e], l4[2 * e + 1]};
                    const cf l2 = cmul(lam, lam), M1 = cmul(l2, l2), M2 = cmul(M1, M1), M4 = cmul(M2, M2), M8 = cmul(M4, M4);
#pragma unroll
                    for (int ai = 0; ai < 2; ++ai) {
                        cf T;
                        if (bj == 0) { T = cf{acc[ai][bj][0][np][2 * e], acc[ai][bj][0][np][2 * e + 1]};
#pragma unroll
                            for (int m = 1; m < 4; ++m) T = cmad(lam, T, cf{acc[ai][bj][m][np][2 * e], acc[ai][bj][m][np][2 * e + 1]});
                            T = cmad(M1, cdpp<0x111>(T), T); T = cmad(M2, cdpp<0x112>(T), T); T = cmad(M4, cdpp<0x114>(T), T); T = cmad(M8, cdpp<0x118>(T), T);
                            X[bj][ai][np][e] = cdpp<0x111>(T);
                            if (fr == 15) *(LAS f32x2*)(SEG + ((bj * 4 + 2 * ai + wr) * 64 + n0 + e) * 2) = (f32x2){T.r, T.i};
                        } else {       T = cf{acc[ai][bj][3][np][2 * e], acc[ai][bj][3][np][2 * e + 1]};
#pragma unroll
                            for (int m = 2; m >= 0; --m) T = cmad(lam, T, cf{acc[ai][bj][m][np][2 * e], acc[ai][bj][m][np][2 * e + 1]});
                            T = cmad(M1, cdpp<0x101>(T), T); T = cmad(M2, cdpp<0x102>(T), T); T = cmad(M4, cdpp<0x104>(T), T); T = cmad(M8, cdpp<0x108>(T), T);
                            X[bj][ai][np][e] = cdpp<0x101>(T);
                            if (fr == 0) *(LAS f32x2*)(SEG + ((bj * 4 + 2 * ai + wr) * 64 + n0 + e) * 2) = (f32x2){T.r, T.i};
                        }
                    }
                }
            }
        LDS_WAIT(); __builtin_amdgcn_s_barrier(); asm volatile("" ::: "memory");
#pragma unroll
        for (int bj = 0; bj < 2; ++bj)
#pragma unroll
            for (int np = 0; np < 2; ++np) {
                const int n0 = 16 * wc + 8 * np + 2 * fq;
                const f32x4 l4 = *(const f32x4*)(lamT + ((size_t)(bj * NG + u.g) * NS + n0) * 2);
                cf C[2][4][2];
#pragma unroll
                for (int e = 0; e < 2; ++e) {
                    const cf lam{l4[2 * e], l4[2 * e + 1]};
                    const cf l2 = cmul(lam, lam), M1 = cmul(l2, l2), M2 = cmul(M1, M1), M4 = cmul(M2, M2), M8 = cmul(M4, M4), Q = cmul(M8, M8);
                    const int ex = bj == 0 ? fr : 15 - fr;
                    cf Mx{1.f, 0.f};
                    if (ex & 1) Mx = cmul(Mx, M1); if (ex & 2) Mx = cmul(Mx, M2); if (ex & 4) Mx = cmul(Mx, M4); if (ex & 8) Mx = cmul(Mx, M8);
#pragma unroll
                    for (int ai = 0; ai < 2; ++ai) {
                        const int sg = 2 * ai + wr; cf G{0.f, 0.f};
                        if (bj == 0) {
#pragma unroll
                            for (int sp = 0; sp < 3; ++sp) if (sp < sg) { const f32x2 t = *(const LAS f32x2*)(SEG + ((bj * 4 + sp) * 64 + n0 + e) * 2); G = cmad(Q, G, cf{t.x, t.y}); }
                            cf c = cmad(Mx, G, X[bj][ai][np][e]); C[ai][0][e] = c;
#pragma unroll
                            for (int m = 1; m < 4; ++m) { c = cmad(lam, c, cf{acc[ai][bj][m - 1][np][2 * e], acc[ai][bj][m - 1][np][2 * e + 1]}); C[ai][m][e] = c; }
                        } else {
#pragma unroll
                            for (int sp = 3; sp > 0; --sp) if (sp > sg) { const f32x2 t = *(const LAS f32x2*)(SEG + ((bj * 4 + sp) * 64 + n0 + e) * 2); G = cmad(Q, G, cf{t.x, t.y}); }
                            cf c = cmad(Mx, G, X[bj][ai][np][e]); C[ai][3][e] = c;
#pragma unroll
                            for (int m = 2; m >= 0; --m) { c = cmad(lam, c, cf{acc[ai][bj][m + 1][np][2 * e], acc[ai][bj][m + 1][np][2 * e + 1]}); C[ai][m][e] = c; }
                        }
                    }
                }
#pragma unroll
                for (int ai = 0; ai < 2; ++ai)
#pragma unroll
                    for (int m = 0; m < 4; ++m) { const int c = 128 * ai + 64 * wr + 4 * fr + m;
                        u32x2 w; w.x = cvt_pk_bf16(C[ai][m][0].r, C[ai][m][0].i); w.y = cvt_pk_bf16(C[ai][m][1].r, C[ai][m][1].i);
                        *(LAS u32x2*)(CIM + c * 520 + (bj * 128 + 2 * n0) * 2) = w; }
            }
        LDS_WAIT(); __builtin_amdgcn_s_barrier(); asm volatile("" ::: "memory");
#pragma unroll 8
        for (int r = wid; r < 256; r += 8)
            *(u32x2*)(ussm + ((size_t)(u.g * NCR + u.pm * NCHB + r) * ROWLEN + K1) + 4 * lane) = *(const LAS u32x2*)(CIM + r * 520 + 8 * lane);
    }
};
struct EpiZ {
    static constexpr bool PERM = true, AFTER_DRAIN = false, HAS_MID = false; static constexpr int MID_T = 0;
    const bf16_t* ussm; const float* dvec; bf16_t* zg;
    __device__ __forceinline__ void operator()(Acc& acc, const Unit& u, int wr, int wc, int fr, int fq) const {
#pragma unroll
        for (int bj = 0; bj < 2; ++bj) {
            const int c8 = u.pn * BM + bj * HALF + wc * 32 + 8 * fq;
            const f32x4 d0 = *(const f32x4*)(dvec + u.g * 16 + (c8 & 15)), d1 = *(const f32x4*)(dvec + u.g * 16 + (c8 & 15) + 4);
#pragma unroll
            for (int ai = 0; ai < 2; ++ai)
#pragma unroll
                for (int m = 0; m < 4; ++m) {
                    const int cr = u.pm * BM + ai * HALF + wr * 64 + m * 16 + fr;
                    const u32x4 uw = *(const u32x4*)(ussm + ((size_t)(u.g * NCR + cr) * ROWLEN + c8));
                    f32x4 u0, u1; unpack8(uw, u0, u1);
                    f32x4 y0 = acc[ai][bj][m][0] + d0 * u0, y1 = acc[ai][bj][m][1] + d1 * u1;
#pragma unroll
                    for (int i = 0; i < 4; ++i) { y0[i] = fast_gelu_tanh(y0[i]); y1[i] = fast_gelu_tanh(y1[i]); }
                    *(u32x4*)(zg + ((size_t)u.g * MT * 16 + (size_t)cr * K1 + c8)) = pack8(y0, y1);
                }
        }
    }
};
struct EpiPool {
    static constexpr bool PERM = true, AFTER_DRAIN = false, HAS_MID = false; static constexpr int MID_T = 0;
    const float* pscale; bf16_t* ycat; float* ss;
    __device__ __forceinline__ void operator()(Acc& acc, const Unit& u, int wr, int wc, int fr, int fq) const {
        f32x4 sc[2][2];
#pragma unroll
        for (int bj = 0; bj < 2; ++bj) { const int c8 = u.pn * BM + bj * HALF + wc * 32 + 8 * fq; sc[bj][0] = *(const f32x4*)(pscale + c8); sc[bj][1] = *(const f32x4*)(pscale + c8 + 4); }
#pragma unroll
        for (int ai = 0; ai < 2; ++ai)
#pragma unroll
            for (int m = 0; m < 4; ++m) {
                const int row = u.pm * BM + ai * HALF + wr * 64 + m * 16 + fr; float q = 0.f;
#pragma unroll
                for (int bj = 0; bj < 2; ++bj) {
                    const int c8 = u.pn * BM + bj * HALF + wc * 32 + 8 * fq;
                    const f32x4 v0 = acc[ai][bj][m][0] * sc[bj][0], v1 = acc[ai][bj][m][1] * sc[bj][1];
                    q += (v0[0] * v0[0] + v0[1] * v0[1]) + (v0[2] * v0[2] + v0[3] * v0[3]) + (v1[0] * v1[0] + v1[1] * v1[1]) + (v1[2] * v1[2] + v1[3] * v1[3]);
                    *(u32x4*)(ycat + (size_t)row * DM + c8) = pack8(v0, v1);
                }
                q += __shfl_xor(q, 16); q += __shfl_xor(q, 32);
                if (fq == 0) ss[(size_t)(u.pn * 4 + wc) * MT + row] = q;
            }
    }
};
struct EpiGlu {
    static constexpr bool PERM = true, AFTER_DRAIN = false, HAS_MID = false; static constexpr int MID_T = 0;
    const float* gb; const bf16_t* zg; bf16_t* ycat; float* ss;
    __device__ __forceinline__ void operator()(Acc& acc, const Unit& u, int wr, int wc, int fr, int fq) const {
        f32x4 bv[2][2];
#pragma unroll
        for (int bj = 0; bj < 2; ++bj) { const int c8 = u.pn * BM + bj * HALF + wc * 32 + 8 * fq; bv[bj][0] = *(const f32x4*)(gb + c8); bv[bj][1] = *(const f32x4*)(gb + c8 + 4); }
#pragma unroll
        for (int ai = 0; ai < 2; ++ai)
#pragma unroll
            for (int m = 0; m < 4; ++m) {
                const int row = u.pm * BM + ai * HALF + wr * 64 + m * 16 + fr; float q = 0.f;
#pragma unroll
                for (int bj = 0; bj < 2; ++bj) {
                    const int c8 = u.pn * BM + bj * HALF + wc * 32 + 8 * fq;
                    const u32x4 zw = *(const u32x4*)(zg + ((size_t)(c8 >> 4) * MT + row) * 16 + (c8 & 15));
                    f32x4 z0, z1; unpack8(zw, z0, z1);
                    f32x4 v0 = acc[ai][bj][m][0] + bv[bj][0], v1 = acc[ai][bj][m][1] + bv[bj][1];
#pragma unroll
                    for (int i = 0; i < 4; ++i) { v0[i] = z0[i] * fast_sigmoid(v0[i]); v1[i] = z1[i] * fast_sigmoid(v1[i]); }
                    q += (v0[0] * v0[0] + v0[1] * v0[1]) + (v0[2] * v0[2] + v0[3] * v0[3]) + (v1[0] * v1[0] + v1[1] * v1[1]) + (v1[2] * v1[2] + v1[3] * v1[3]);
                    *(u32x4*)(ycat + (size_t)row * DM + DPOOL + c8) = pack8(v0, v1);
                }
                q += __shfl_xor(q, 16); q += __shfl_xor(q, 32);
                if (fq == 0) ss[(size_t)(u.pn * 4 + wc) * MT + row] = q;
            }
    }
};
struct EpiOut {
    static constexpr bool PERM = true, AFTER_DRAIN = true, HAS_MID = true; static constexpr int MID_T = 8;
    const float* x; bf16_t* h1b; float* ss; LAS f32x2* XR; float ratio[2][4];
    __device__ __forceinline__ void mid(Acc& acc, int wr, int fr) const {
#pragma unroll
        for (int ai = 0; ai < 2; ++ai)
#pragma unroll
            for (int m = 0; m < 4; ++m) { const float ratio = this->ratio[ai][m];
#pragma unroll
                for (int bj = 0; bj < 2; ++bj)
#pragma unroll
                    for (int n = 0; n < 2; ++n) acc[ai][bj][m][n] = acc[ai][bj][m][n] * ratio; }
    }
    __device__ __forceinline__ void fused(Acc& acc, const Unit& u, int wr, int wc, int fr, int fq, LAS unsigned char* lds, int wid, int lane) const {
        LAS float* P = (LAS float*)lds;
        const int col0 = u.pn * BM + wc * 32 + 8 * fq;
#pragma unroll
        for (int ai = 0; ai < 2; ++ai)
#pragma unroll
            for (int m = 0; m < 4; ++m) {
                const int lr = ai * HALF + wr * 64 + m * 16 + fr, row = u.pm * BM + lr; const float rs = XR[lr].y; float q = 0.f;
                const size_t prow = (size_t)(row >> 12) * PADROWS + 1 + (row & 4095);
#pragma unroll
                for (int bj = 0; bj < 2; ++bj) {
                    const int c = col0 + bj * HALF;
                    const f32x4 h0 = *(const f32x4*)(x + (size_t)row * DM + c) + acc[ai][bj][m][0] * rs, h1v = *(const f32x4*)(x + (size_t)row * DM + c + 4) + acc[ai][bj][m][1] * rs;
                    q += (h0[0] * h0[0] + h0[1] * h0[1]) + (h0[2] * h0[2] + h0[3] * h0[3]) + (h1v[0] * h1v[0] + h1v[1] * h1v[1]) + (h1v[2] * h1v[2] + h1v[3] * h1v[3]);
                    *(u32x4*)(h1b + prow * DM + c) = pack8(h0, h1v);
                }
                q += __shfl_xor(q, 16); q += __shfl_xor(q, 32);
                if (fq == 0) P[lr * 4 + wc] = q;
            }
        LDS_WAIT(); __builtin_amdgcn_s_barrier(); asm volatile("" ::: "memory");
        const int tid = wid * 64 + lane;
        if (tid < 256) ss[(size_t)u.pn * MT + u.pm * BM + tid] = (P[tid * 4 + 0] + P[tid * 4 + 1]) + (P[tid * 4 + 2] + P[tid * 4 + 3]);
    }
};
struct EpiUp {
    static constexpr bool PERM = true, AFTER_DRAIN = false, HAS_MID = false; static constexpr int MID_T = 0;
    const LAS float* rsl; const float* cw; const float* cb; bf16_t* act;
    __device__ __forceinline__ void operator()(Acc& acc, const Unit& u, int wr, int wc, int fr, int fq) const {
        const int j = u.pm, b = u.g;
#pragma unroll
        for (int ai = 0; ai < 2; ++ai)
#pragma unroll
            for (int m = 0; m < 4; ++m) {
                const float rs = rsl[u.aux * 256 + 126 * wr + 64 * ai + 16 * m + fr];
#pragma unroll
                for (int bj = 0; bj < 2; ++bj)
#pragma unroll
                    for (int n = 0; n < 2; ++n) acc[ai][bj][m][n] = acc[ai][bj][m][n] * rs;
            }
        const int f0 = 128 * u.pn + 32 * wc + 8 * fq;
        u32x2 keep[8];
#pragma unroll
        for (int n = 0; n < 2; ++n) {
            const int fc = f0 + 4 * n;
            const f32x4 wv0 = *(const f32x4*)(cw + fc), wv1 = *(const f32x4*)(cw + DFF2 + fc), wv2 = *(const f32x4*)(cw + 2 * DFF2 + fc), bvv = *(const f32x4*)(cb + fc);
            const f32x4 wg0 = *(const f32x4*)(cw + DFF + fc), wg1 = *(const f32x4*)(cw + DFF2 + DFF + fc), wg2 = *(const f32x4*)(cw + 2 * DFF2 + DFF + fc), bgv = *(const f32x4*)(cb + DFF + fc);
#pragma unroll
            for (int gi = 0; gi < 8; ++gi) {
                const int ai = gi >> 2, m = gi & 3, pi = gi > 0 ? gi - 1 : gi, ni = gi < 7 ? gi + 1 : gi;
                const f32x4 cv = acc[ai][0][m][n], cg = acc[ai][1][m][n];
                const f32x4 pv = acc[pi >> 2][0][pi & 3][n], pg = acc[pi >> 2][1][pi & 3][n];
                const f32x4 nv = acc[ni >> 2][0][ni & 3][n], ng = acc[ni >> 2][1][ni & 3][n];
                f32x4 o;
#pragma unroll
                for (int i = 0; i < 4; ++i) {
#if defined(ABL_DPP)
                    const float v_prev = pv[i], v_next = nv[i], g_prev = pg[i], g_next = ng[i];
#else
                    const float v_prev = dpp_ror1(fr == 15 ? pv[i] : cv[i]), v_next = dpp_ror15(fr == 0 ? nv[i] : cv[i]);
                    const float g_prev = dpp_ror1(fr == 15 ? pg[i] : cg[i]), g_next = dpp_ror15(fr == 0 ? ng[i] : cg[i]);
#endif
                    const float vv = bvv[i] + wv0[i] * v_prev + wv1[i] * cv[i] + wv2[i] * v_next;
                    const float gg = bgv[i] + wg0[i] * g_prev + wg1[i] * cg[i] + wg2[i] * g_next;
#if defined(ABL_SILU)
                    o[i] = vv * gg;
#else
                    o[i] = vv * gg * fast_sigmoid(gg);
#endif
                }
                const u32x2 pk = pack4(o);
                if (n == 0) keep[gi] = pk;
                else { const int w = 64 * ai + 16 * m + fr, t = UPROWS * j + 126 * wr + w - 1;
                       if (t >= 0 && t < SEQ && w >= 1 && w <= 126) { u32x4 wv; wv.x = keep[gi].x; wv.y = keep[gi].y; wv.z = pk.x; wv.w = pk.y; *(u32x4*)(act + (size_t)(b * SEQ + t) * DFF + f0) = wv; } }
            }
        }
    }
};
struct EpiDown {
    static constexpr bool PERM = true, AFTER_DRAIN = true, HAS_MID = false; static constexpr int MID_T = 0;
    const bf16_t* h1b; float* out; const float* gfin; float* ss; const XcdBarrier* bar;
    __device__ __forceinline__ void fused(Acc& acc, const Unit& u, int wr, int wc, int fr, int fq, LAS unsigned char* lds, int wid, int lane) const {
        LAS float* P = (LAS float*)lds;
        LAS float* Sr = (LAS float*)(lds + 8192);
        const int col0 = u.pn * BM + wc * 32 + 8 * fq;
#pragma unroll
        for (int ai = 0; ai < 2; ++ai)
#pragma unroll
            for (int m = 0; m < 4; ++m) {
                const int lr = ai * HALF + wr * 64 + m * 16 + fr, row = u.pm * BM + lr; float q = 0.f;
                const size_t prow = (size_t)(row >> 12) * PADROWS + 1 + (row & 4095);
#pragma unroll
                for (int bj = 0; bj < 2; ++bj) {
                    f32x4 b0, b1; unpack8(*(const u32x4*)(h1b + prow * DM + col0 + bj * HALF), b0, b1);
                    const f32x4 h0 = b0 + acc[ai][bj][m][0], h1v = b1 + acc[ai][bj][m][1];
                    acc[ai][bj][m][0] = h0; acc[ai][bj][m][1] = h1v;
                    q += (h0[0] * h0[0] + h0[1] * h0[1]) + (h0[2] * h0[2] + h0[3] * h0[3]) + (h1v[0] * h1v[0] + h1v[1] * h1v[1]) + (h1v[2] * h1v[2] + h1v[3] * h1v[3]);
                }
                q += __shfl_xor(q, 16); q += __shfl_xor(q, 32);
                if (fq == 0) P[lr * 4 + wc] = q;
            }
        LDS_WAIT(); __builtin_amdgcn_s_barrier(); asm volatile("" ::: "memory");
        const int tid = wid * 64 + lane;
        if (tid < 256) ss[(size_t)u.pn * MT + u.pm * BM + tid] = (P[tid * 4 + 0] + P[tid * 4 + 1]) + (P[tid * 4 + 2] + P[tid * 4 + 3]);
        xcd_barrier(*bar, tid);
        if (tid < 256) { const int row = u.pm * BM + tid; const float s = (ss[row] + ss[MT + row]) + (ss[2 * MT + row] + ss[3 * MT + row]); Sr[tid] = rsqrtf(s * (1.0f / DM) + EPS); }
        LDS_WAIT(); __builtin_amdgcn_s_barrier(); asm volatile("" ::: "memory");
#pragma unroll
        for (int bj = 0; bj < 2; ++bj) {
            const int c = col0 + bj * HALF; const f32x4 g0 = *(const f32x4*)(gfin + c), g1 = *(const f32x4*)(gfin + c + 4);
#pragma unroll
            for (int ai = 0; ai < 2; ++ai)
#pragma unroll
                for (int m = 0; m < 4; ++m) { const int lr = ai * HALF + wr * 64 + m * 16 + fr; const float r = Sr[lr]; float* o = out + (size_t)(u.pm * BM + lr) * DM + c;
                    *(f32x4*)o = acc[ai][bj][m][0] * r * g0; *(f32x4*)(o + 4) = acc[ai][bj][m][1] * r * g1; }
        }
    }
};

struct OrdOne { Unit u; __device__ bool next(int i, Unit& o) const { if (i > 0) return false; o = u; return true; } };
struct OrdSsmA { int c; __device__ bool next(int i, Unit& u) const { if (i > 0 || c >= 64) return false; const int x = c & 7, k = c >> 3; u.g = x * 4 + (k >> 1); u.pm = k & 1; u.pn = 0; u.aux = 0; return true; } };
struct OrdSsmB { int c; __device__ bool next(int i, Unit& u) const { if (i > 0 || c >= 128) return false; const int x = c & 7, k = c >> 3; u.g = x * 4 + (k >> 2); u.pm = k & 3; u.pn = 0; u.aux = 0; return true; } };
struct OrdPool { int c; __device__ bool next(int i, Unit& u) const { if (i > 0 || c < 128 || c >= 256) return false; const int cc = c - 128, x = cc & 7, k = cc >> 3; u.pm = x * 8 + (k >> 1); u.pn = k & 1; u.g = u.pn; u.aux = 0; return true; } };
struct OrdGlu  { int c; __device__ bool next(int i, Unit& u) const { if (i > 0 || c >= 128) return false; const int x = c & 7, k = c >> 3; u.pm = x * 8 + (k >> 1); u.pn = k & 1; u.g = 0; u.aux = 0; return true; } };
struct OrdUp { StaticOrder so; __device__ bool next(int i, Unit& u) const { if (!so.next(i, u)) return false; u.g = u.pm / UPT; u.pm = u.pm % UPT; u.aux = i; return true; } };

constexpr size_t WS_STAMP = 4 * MiB;
#if defined(MK_STAMP)
#define ST(k) do { if (F.tid == 0) ((unsigned long long*)(args.ws + WS_STAMP))[blockIdx.x * 64 + (k)] = __builtin_amdgcn_s_memrealtime(); } while (0)
#define GP_STAMP(base) ((unsigned long long*)(args.ws + WS_STAMP) + blockIdx.x * 64 + (base))
#define STC(k) do { if (F.tid == 0) ((unsigned long long*)(args.ws + WS_STAMP))[blockIdx.x * 64 + (k)] = __builtin_amdgcn_s_memtime(); } while (0)
#else
#define STC(k) do { } while (0)
#define ST(k) do { } while (0)
#define GP_STAMP(base) ((unsigned long long*)nullptr)
#endif
struct Args { const float* in[24]; float* out; unsigned char* ws; int ph_lo, ph_hi; };

struct Frame { LAS unsigned char* lds; int tid, lane, wave, G, bx; };

struct TrMat { const float* W; int K, N; const float* kg0; const float* kg1; int ksplit; bf16_t* WT; int map; int nitems; };
__device__ __forceinline__ void tr_load(const TrMat& m0, const TrMat& m1, int item, int lane, f32x4 (&v)[8]) {
    const bool second = item >= m0.nitems; const TrMat& m = second ? m1 : m0; const int it = second ? item - m0.nitems : item;
    const int nblk = m.N / 32, kb = it / nblk, nb = it % nblk, k0 = 64 * kb, n0 = 32 * nb, r = lane >> 3, c4 = lane & 7;
#pragma unroll
    for (int i = 0; i < 8; ++i) v[i] = *(const f32x4*)(m.W + (size_t)(k0 + 8 * i + r) * m.N + n0 + 4 * c4);
}
__device__ __forceinline__ void tr_store(const TrMat& m0, const TrMat& m1, int item, int lane, const f32x4 (&v)[8], LAS float* scr) {
    const bool second = item >= m0.nitems; const TrMat& m = second ? m1 : m0; const int it = second ? item - m0.nitems : item;
    const int nblk = m.N / 32, kb = it / nblk, nb = it % nblk, k0 = 64 * kb, n0 = 32 * nb, r = lane >> 3, c4 = lane & 7;
#pragma unroll
    for (int i = 0; i < 8; ++i) { const int kk = 8 * i + r, k = k0 + kk; float gn = 1.f; if (m.kg0) gn = (k < m.ksplit ? m.kg0[k] : m.kg1[k - m.ksplit]);
        LAS float* d = scr + kk * 33 + 4 * c4; d[0] = v[i][0] * gn; d[1] = v[i][1] * gn; d[2] = v[i][2] * gn; d[3] = v[i][3] * gn; }
    LDS_WAIT(); asm volatile("" ::: "memory");
    const int c = lane & 7;
#pragma unroll
    for (int j = 0; j < 4; ++j) { const int n = (lane >> 3) + 8 * j; const LAS float* q = scr + (8 * c) * 33 + n;
        u32x4 o; o.x = pk2(q[0 * 33], q[1 * 33]); o.y = pk2(q[2 * 33], q[3 * 33]); o.z = pk2(q[4 * 33], q[5 * 33]); o.w = pk2(q[6 * 33], q[7 * 33]);
        int nr = n0 + n;
        if (m.map == 1) { const int bj = nr / DFF, rem = nr % DFF; nr = 256 * (rem >> 7) + 128 * bj + (rem & 127); }
        *(u32x4*)(m.WT + (size_t)nr * m.K + k0 + 8 * c) = o; }
    LDS_WAIT(); asm volatile("" ::: "memory");
}
__device__ __forceinline__ void tr_run(const TrMat& m0, const TrMat& m1, int first, int stride, int lane, LAS float* scr) {
    const int total = m0.nitems + m1.nitems; f32x4 va[8], vb[8];
    int it = first; if (it < total) tr_load(m0, m1, it, lane, va);
    while (it < total) {
        const int n1 = it + stride; if (n1 < total) tr_load(m0, m1, n1, lane, vb);
        tr_store(m0, m1, it, lane, va, scr);
        if (n1 >= total) break;
        const int n2 = n1 + stride; if (n2 < total) tr_load(m0, m1, n2, lane, va);
        tr_store(m0, m1, n1, lane, vb, scr);
        it = n2;
    }
}

struct SsmLds { LAS float* Bre; LAS float* Bim; LAS float* Cre; LAS float* Cim; LAS float* PAR; LAS float* Pc; LAS float* Kl; };
__device__ __forceinline__ SsmLds ssm_lds(const Frame& F) { SsmLds L; L.Bre = (LAS float*)(F.lds); L.Bim = L.Bre + 2048; L.Cre = L.Bim + 2048; L.Cim = L.Cre + 2048; L.PAR = L.Cim + 2048; L.Pc = L.PAR + 512; L.Kl = L.Pc + 1024; return L; }
__device__ __forceinline__ void ssm_stage(const Args& a, const Frame& F, const SsmLds& L, int g) {
    const float* lnar = a.in[5]; const float* aim = a.in[6]; const float* ldt = a.in[7];
    const float* bre = a.in[8]; const float* bim = a.in[9]; const float* cre = a.in[10]; const float* cim = a.in[11];
    const int tid = F.tid;
    for (int i = tid; i < 2048; i += 512) { const int dir = i >> 10, r = i & 1023;
        L.Bre[i] = bre[((size_t)(dir * NG + g)) * 1024 + r]; L.Bim[i] = bim[((size_t)(dir * NG + g)) * 1024 + r];
        L.Cre[i] = cre[((size_t)(dir * NG + g)) * 1024 + r]; L.Cim[i] = cim[((size_t)(dir * NG + g)) * 1024 + r]; }
    if (tid < 128) { const int dir = tid >> 6, n = tid & 63;
        const float dt = expf(ldt[dir * NG + g]); const float a_re = -expf(lnar[(dir * NG + g) * NS + n]), a_im = aim[(dir * NG + g) * NS + n];
        const float mag = expf(a_re * dt), ang = a_im * dt; const float lam_re = mag * cosf(ang), lam_im = mag * sinf(ang);
        const float den = a_re * a_re + a_im * a_im;
        L.PAR[tid * 4 + 0] = a_re * dt; L.PAR[tid * 4 + 1] = ang;
        L.PAR[tid * 4 + 2] = ((lam_re - 1.0f) * a_re + lam_im * a_im) / den; L.PAR[tid * 4 + 3] = (lam_im * a_re - (lam_re - 1.0f) * a_im) / den; }
    __syncthreads();
}
__device__ __forceinline__ void ssm_build_tb(const Args& a, const Frame& F, const SsmLds& L, int g, int lag0, int nl) {
    bf16_t* KC = (bf16_t*)(a.ws + WS_TB) + (size_t)g * (2 * TCH) * 256;
    bf16_t* TBC = (bf16_t*)(a.ws + WS_TBC) + (size_t)g * K1 * 256;
    const int tid = F.tid;
    { const int li = tid >> 7, dn = tid & 127, lag = lag0 + li; const float ad = L.PAR[dn * 4 + 0], ang = L.PAR[dn * 4 + 1], fr_ = L.PAR[dn * 4 + 2], fi_ = L.PAR[dn * 4 + 3];
      const float mg = expf((float)lag * ad); float sn, cs; sincosf((float)lag * ang, &sn, &cs); const float lr = mg * cs, lim = mg * sn;
      L.Pc[(li * 128 + dn) * 2 + 0] = lr * fr_ - lim * fi_; L.Pc[(li * 128 + dn) * 2 + 1] = lr * fi_ + lim * fr_; }
    __syncthreads();
    { const int li = F.wave >> 1, dir = F.wave & 1, i16 = F.lane & 15, kq = F.lane >> 4; f32x4 kacc = {0.f, 0.f, 0.f, 0.f};
#pragma unroll 8
      for (int kk0 = 0; kk0 < 128; kk0 += 4) { const int kk = kk0 + kq, n = kk >> 1; const bool im = (kk & 1) != 0;
          const float cr_ = L.Cre[dir * 1024 + i16 * 64 + n], ci_ = L.Cim[dir * 1024 + i16 * 64 + n], pr = L.Pc[(li * 128 + dir * 64 + n) * 2], pi = L.Pc[(li * 128 + dir * 64 + n) * 2 + 1];
          const float av = im ? -(cr_ * pi + ci_ * pr) : (cr_ * pr - ci_ * pi);
          const float bv = im ? L.Bim[dir * 1024 + n * 16 + i16] : L.Bre[dir * 1024 + n * 16 + i16];
          kacc = __builtin_amdgcn_mfma_f32_16x16x4f32(av, bv, kacc, 0, 0, 0); }
#pragma unroll
      for (int r = 0; r < 4; ++r) L.Kl[li * 512 + dir * 256 + (kq * 4 + r) * 16 + i16] = kacc[r]; }
    __syncthreads();
    { const int li = tid >> 7, dir = (tid >> 6) & 1, e4 = tid & 63, lag = lag0 + li;
      if (li < nl && !(lag == 0 && dir == 1)) {
          f32x4 v = *(const LAS f32x4*)(L.Kl + li * 512 + dir * 256 + 4 * e4);
          if (lag == 0) v = v + *(const LAS f32x4*)(L.Kl + li * 512 + 256 + 4 * e4);
          const int d = dir == 0 ? (TCH - 1) + lag : (TCH - 1) - lag; u32x2 w; w.x = pk2(v[0], v[1]); w.y = pk2(v[2], v[3]);
          *(u32x2*)(KC + (size_t)d * 256 + 4 * e4) = w; } }
    __syncthreads();
    { const int li = tid >> 7, dn = tid & 127, dir = dn >> 6, p = lag0 + li; const float ad = L.PAR[dn * 4 + 0], ang = L.PAR[dn * 4 + 1]; const float e = dir == 0 ? (float)(p + 1) : (float)(TCH - p);
      const float mg = expf(e * ad); float sn, cs; sincosf(e * ang, &sn, &cs); L.Pc[(li * 128 + dn) * 2 + 0] = mg * cs; L.Pc[(li * 128 + dn) * 2 + 1] = mg * sn; }
    __syncthreads();
    for (int li = 0; li < nl; ++li) {
        const int p = lag0 + li, h = tid >> 5, dir = (tid >> 4) & 1, n4 = tid & 15; float v[8];
#pragma unroll
        for (int e = 0; e < 4; ++e) { const int n = 4 * n4 + e; const float cr_ = L.Cre[dir * 1024 + h * 64 + n], ci_ = L.Cim[dir * 1024 + h * 64 + n], pr = L.Pc[(li * 128 + dir * 64 + n) * 2], pi = L.Pc[(li * 128 + dir * 64 + n) * 2 + 1];
            v[2 * e] = cr_ * pr - ci_ * pi; v[2 * e + 1] = -(cr_ * pi + ci_ * pr); }
        u32x4 w; w.x = pk2(v[0], v[1]); w.y = pk2(v[2], v[3]); w.z = pk2(v[4], v[5]); w.w = pk2(v[6], v[7]);
        *(u32x4*)(TBC + (size_t)(16 * p + h) * 256 + dir * 128 + 8 * n4) = w;
    }
    __syncthreads();
}
__device__ __forceinline__ void ssm_build_wab(const Args& a, const Frame& F, const SsmLds& L, int g, int jq) {
    bf16_t* WAB = (bf16_t*)(a.ws + WS_WAB) + (size_t)g * 256 * K1;
    const int tid = F.tid;
    if (jq == 0 && tid < 128) { const int dir = tid >> 6, n = tid & 63; const float ad = L.PAR[tid * 4 + 0], ang = L.PAR[tid * 4 + 1];
        const float mg = expf((float)TCH * ad); float sn, cs; sincosf((float)TCH * ang, &sn, &cs); *(f32x2*)((float*)(a.ws + WS_LAMT) + ((size_t)(dir * NG + g) * NS + n) * 2) = (f32x2){mg * cs, mg * sn}; }
    { const int li = tid >> 7, dn = tid & 127, dir = dn >> 6, q = 4 * jq + li; const float ad = L.PAR[dn * 4 + 0], ang = L.PAR[dn * 4 + 1], fr_ = L.PAR[dn * 4 + 2], fi_ = L.PAR[dn * 4 + 3]; const float e = dir == 0 ? (float)(TCH - 1 - q) : (float)q;
      const float mg = expf(e * ad); float sn, cs; sincosf(e * ang, &sn, &cs); const float lr = mg * cs, lim = mg * sn;
      L.Pc[(li * 128 + dn) * 2 + 0] = lr * fr_ - lim * fi_; L.Pc[(li * 128 + dn) * 2 + 1] = lr * fi_ + lim * fr_; }
    __syncthreads();
#pragma unroll
    for (int half = 0; half < 2; ++half) {
        const int li = 2 * half + (tid >> 8), q = 4 * jq + li, t2 = tid & 255, dir = t2 >> 7, n = (t2 >> 1) & 63, part = t2 & 1;
        const float pr = L.Pc[(li * 128 + dir * 64 + n) * 2], pi = L.Pc[(li * 128 + dir * 64 + n) * 2 + 1]; float v[16];
#pragma unroll
        for (int i = 0; i < 16; ++i) { const float br_ = L.Bre[dir * 1024 + n * 16 + i], bi_ = L.Bim[dir * 1024 + n * 16 + i]; v[i] = part == 0 ? (pr * br_ - pi * bi_) : (pr * bi_ + pi * br_); }
        u32x4 w0, w1; w0.x = pk2(v[0], v[1]); w0.y = pk2(v[2], v[3]); w0.z = pk2(v[4], v[5]); w0.w = pk2(v[6], v[7]); w1.x = pk2(v[8], v[9]); w1.y = pk2(v[10], v[11]); w1.z = pk2(v[12], v[13]); w1.w = pk2(v[14], v[15]);
        bf16_t* dst = WAB + (size_t)(dir * 128 + 2 * n + part) * K1 + 16 * q; *(u32x4*)dst = w0; *(u32x4*)(dst + 8) = w1;
    }
    __syncthreads();
}

__device__ __forceinline__ void p0_prologue(const Args& a, const Frame& F) {
    const float* x = a.in[0];
    { const SsmLds L = ssm_lds(F);
      for (int it = F.bx; it < NG * (TCH / 4); it += F.G) { ssm_stage(a, F, L, it / (TCH / 4)); ssm_build_wab(a, F, L, it / (TCH / 4), it % (TCH / 4)); } }
    __syncthreads();
    LAS float* scr = (LAS float*)(F.lds + F.wave * 16384);
    const int gw = F.bx * 8 + F.wave, NGW = F.G * 8;
    { const TrMat m0{a.in[2], DM, DM, a.in[1], a.in[1], DM, (bf16_t*)(a.ws + WS_WIN), 0, (DM / 64) * (DM / 32)}; const TrMat m1{nullptr, 0, 32, nullptr, nullptr, 0, nullptr, 0, 0};
      tr_run(m0, m1, gw, NGW, F.lane, scr); }
    { bf16_t* PW = (bf16_t*)(a.ws + WS_PW); const float* pw = a.in[3];
      for (int idx = F.bx * 512 + F.tid; idx < 2 * 256 * 256; idx += F.G * 512) { const int pn = idx >> 16, j = (idx >> 8) & 255, k = idx & 255;
          const float v = ((j >> 7) == (k >> 7)) ? pw[((size_t)(2 * pn + (j >> 7)) * 128 + (k & 127)) * 128 + (j & 127)] : 0.f; PW[idx] = (bf16_t)f2bf(v); } }
    { bf16_t* h1b = (bf16_t*)(a.ws + WS_H1B);
      for (int idx = F.bx * 512 + F.tid; idx < BATCH * 256 * (DM / 8); idx += F.G * 512) { const int b = idx / (256 * 128), r = (idx / 128) % 256, c = idx % 128; const int prow = b * PADROWS + (r == 0 ? 0 : 4096 + r);
          *(u32x4*)(h1b + (size_t)prow * DM + 8 * c) = (u32x4){0u, 0u, 0u, 0u}; } }
    { bf16_t* xb = (bf16_t*)(a.ws + WS_XB); float* r0 = (float*)(a.ws + WS_R0);
      for (int row = gw; row < MT; row += NGW) {
          const f32x4* xr = (const f32x4*)(x + (size_t)row * DM) + F.lane; f32x4 v[4]; float s = 0.f;
#pragma unroll
          for (int j = 0; j < 4; ++j) { v[j] = xr[64 * j]; s += (v[j][0] * v[j][0] + v[j][1] * v[j][1]) + (v[j][2] * v[j][2] + v[j][3] * v[j][3]); }
          s = wave_sum(s); if (F.lane == 0) r0[row] = rsqrtf(s * (1.0f / DM) + EPS);
          u32x2* o = (u32x2*)(xb + (size_t)row * DM) + F.lane;
#pragma unroll
          for (int j = 0; j < 4; ++j) o[64 * j] = pack4(v[j]);
      } }
}

__device__ __forceinline__ void p2_side(const Args& a, const Frame& F, int first_block) {
    const int nb = F.G - first_block, sb = F.bx - first_block;
    { const SsmLds L = ssm_lds(F);
      int id = (sb * (NG * TCH)) / nb; const int id_end = ((sb + 1) * (NG * TCH)) / nb; int staged = -1;
      while (id < id_end) {
          const int g = id / TCH, lag0 = id % TCH; int nl = TCH - lag0; if (nl > 4) nl = 4; if (nl > id_end - id) nl = id_end - id;
          if (g != staged) { ssm_stage(a, F, L, g); staged = g; }
          ssm_build_tb(a, F, L, g, lag0, nl); id += nl;
      } }
    __syncthreads();
    LAS float* scr = (LAS float*)(F.lds + F.wave * 16384);
    const TrMat m0{a.in[13], DSSM, DSSM, nullptr, nullptr, 0, (bf16_t*)(a.ws + WS_WGLU), 0, (DSSM / 64) * (DSSM / 32)}; const TrMat m1{nullptr, 0, 32, nullptr, nullptr, 0, nullptr, 0, 0};
    tr_run(m0, m1, sb * 8 + F.wave, nb * 8, F.lane, scr);
}
__device__ __forceinline__ void ssm_side(const Args& a, const Frame& F, int first_block) {
    const int nb = F.G - first_block, sb = F.bx - first_block;
    { const SsmLds L = ssm_lds(F);
      const int g = sb >> 2, lag0 = (sb & 3) * 4;
#if defined(MK_STAMP)
#define STS(k) do { if (F.tid == 0) ((unsigned long long*)(a.ws + WS_STAMP))[blockIdx.x * 64 + (k)] = __builtin_amdgcn_s_memrealtime(); } while (0)
#else
#define STS(k) do { } while (0)
#endif
      ssm_stage(a, F, L, g); STS(45); ssm_build_tb(a, F, L, g, lag0, 4); STS(46);
      VM_WAIT(); __syncthreads();
      if (F.tid == 0) { __builtin_amdgcn_fence(__ATOMIC_RELEASE, "agent"); asm volatile("s_waitcnt vmcnt(0)" ::: "memory");
          __hip_atomic_fetch_add((unsigned*)(a.ws + WS_CTL) + CW_TBCNT + 64 * g, 4u, __ATOMIC_RELAXED, __HIP_MEMORY_SCOPE_AGENT); } }
    __syncthreads();
#if defined(MK_STAMP)
    if (F.tid == 0) ((unsigned long long*)(a.ws + WS_STAMP))[blockIdx.x * 64 + 43] = __builtin_amdgcn_s_memrealtime();
#endif
    LAS float* scr = (LAS float*)(F.lds + F.wave * 16384);
    const TrMat m0{a.in[17], DM, DM, a.in[15], a.in[16], DPOOL, (bf16_t*)(a.ws + WS_WOUT), 0, (DM / 64) * (DM / 32)};
    const TrMat m1{a.in[13], DSSM, DSSM, nullptr, nullptr, 0, (bf16_t*)(a.ws + WS_WGLU), 0, (DSSM / 64) * (DSSM / 32)};
    tr_run(m0, m1, sb * 8 + F.wave, nb * 8, F.lane, scr);
    const TrMat m2{a.in[22], DFF, DM, nullptr, nullptr, 0, (bf16_t*)(a.ws + WS_WDOWN), 0, (DFF / 64) * (DM / 32)}; const TrMat m3{nullptr, 0, 32, nullptr, nullptr, 0, nullptr, 0, 0};
    tr_run(m2, m3, sb * 8 + F.wave, nb * 8, F.lane, scr);
}
__device__ __forceinline__ void tb_wait(const Args& a, const Frame& F, int g) {
    if (F.tid == 0) { unsigned* cnt = (unsigned*)(a.ws + WS_CTL) + CW_TBCNT + 64 * g; unsigned sp = 0;
        while (__hip_atomic_load(cnt, __ATOMIC_RELAXED, __HIP_MEMORY_SCOPE_AGENT) < (unsigned)TCH) { __builtin_amdgcn_s_sleep(2); if (++sp > (1u << 20)) break; }
        __builtin_amdgcn_fence(__ATOMIC_ACQUIRE, "agent"); asm volatile("s_waitcnt vmcnt(0)" ::: "memory"); }
    __syncthreads();
}
__device__ __forceinline__ void p3_side(const Args& a, const Frame& F, int first_block) {
    const int nb = F.G - first_block, sb = F.bx - first_block;
    LAS float* scr = (LAS float*)(F.lds + F.wave * 16384);
    const TrMat m0{a.in[17], DM, DM, a.in[15], a.in[16], DPOOL, (bf16_t*)(a.ws + WS_WOUT), 0, (DM / 64) * (DM / 32)}; const TrMat m1{nullptr, 0, 32, nullptr, nullptr, 0, nullptr, 0, 0};
    tr_run(m0, m1, sb * 8 + F.wave, nb * 8, F.lane, scr);
}
__device__ __forceinline__ void p4_side(const Args& a, const Frame& F, int first_block) {
    const int nb = F.G - first_block, sb = F.bx - first_block;
    LAS float* scr = (LAS float*)(F.lds + F.wave * 16384);
    const TrMat m0{a.in[19], DM, DFF2, a.in[18], a.in[18], DM, (bf16_t*)(a.ws + WS_WUP), 1, (DM / 64) * (DFF2 / 32)};
    const TrMat m1{nullptr, 0, 32, nullptr, nullptr, 0, nullptr, 0, 0};
    tr_run(m0, m1, sb * 8 + F.wave, nb * 8, F.lane, scr);
}

__device__ __forceinline__ void p2_pooled(const Args& a, const Frame& F, int first_block) {
    const bf16_t* up = (const bf16_t*)(a.ws + WS_UPOOL); bf16_t* po = (bf16_t*)(a.ws + WS_POOLED);
    const int gw = (F.bx - first_block) * 8 + F.wave, NGW = (F.G - first_block) * 8;
    const int c0 = 8 * F.lane, half = 1 << (F.lane >> 4);
    for (int blk = gw; blk < MT / 4; blk += NGW) {
        const int row0 = blk * 4, b = row0 / SEQ, t0 = row0 % SEQ;
        u32x4 w[19];
#pragma unroll
        for (int o = 0; o < 19; ++o) { int q = t0 + o - 8; q = q < 0 ? 0 : (q >= SEQ ? SEQ - 1 : q); w[o] = *(const u32x4*)(up + (size_t)(b * SEQ + q) * DPOOL + c0); }
#pragma unroll
        for (int r = 0; r < 4; ++r) {
            f32x4 s0 = {0.f, 0.f, 0.f, 0.f}, s1 = {0.f, 0.f, 0.f, 0.f}; float cnt = 0.f;
#pragma unroll
            for (int d = -8; d < 8; ++d) { const int q = t0 + r + d; const float m = (d >= -half && d < half && q >= 0 && q < SEQ) ? 1.f : 0.f; f32x4 a0, a1; unpack8(w[r + d + 8], a0, a1); s0 = s0 + a0 * m; s1 = s1 + a1 * m; cnt += m; }
            f32x4 c0v, c1v; unpack8(w[r + 8], c0v, c1v);
            const float inv = __builtin_amdgcn_rcpf(cnt);
            *(u32x4*)(po + (size_t)(row0 + r) * DPOOL + c0) = pack8(s0 * inv - c0v, s1 * inv - c1v);
        }
    }
}

__device__ __forceinline__ void p3_carries(const Args& a, const Frame& F, int g, int b) {
    static_assert(NCHB == 256, "8 segments of 32 chunks");
    LAS float* TOT = (LAS float*)(F.lds);
    const int seg = F.tid >> 6, n = F.tid & 63;
    for (int dir = 0; dir < 2; ++dir) {
        const float dt = expf(a.in[7][dir * NG + g]); const float a_re = -expf(a.in[5][(dir * NG + g) * NS + n]), a_im = a.in[6][(dir * NG + g) * NS + n];
        const float mg = expf((float)TCH * (a_re * dt)); float sn, cs; sincosf((float)TCH * (a_im * dt), &sn, &cs); const float lr = mg * cs, li = mg * sn;
        const float* fg = (const float*)(a.ws + WS_FG) + ((size_t)g * NCR + (size_t)b * NCHB) * 256 + dir * 128 + 2 * n;
        bf16_t* us = (bf16_t*)(a.ws + WS_USSM) + ((size_t)g * NCR + (size_t)b * NCHB) * ROWLEN + K1 + dir * 128 + 2 * n;
        f32x2 f[32];
#pragma unroll
        for (int k = 0; k < 32; ++k) { const int i = 32 * seg + k, c = dir == 0 ? i : NCHB - 1 - i; f[k] = *(const f32x2*)(fg + (size_t)c * 256); }
        float sr = 0.f, si = 0.f;
#pragma unroll
        for (int k = 0; k < 32; ++k) { const float nr = lr * sr - li * si + f[k].x, ni = lr * si + li * sr + f[k].y; sr = nr; si = ni; }
        TOT[F.tid * 2] = sr; TOT[F.tid * 2 + 1] = si;
        float pr = lr, pi = li;
#pragma unroll
        for (int q = 0; q < 5; ++q) { const float nr = pr * pr - pi * pi, ni = 2.f * pr * pi; pr = nr; pi = ni; }
        __syncthreads();
        sr = 0.f; si = 0.f;
        for (int s2 = 0; s2 < seg; ++s2) { const int o = (s2 * 64 + n) * 2; const float tr = TOT[o], ti = TOT[o + 1]; const float nr = pr * sr - pi * si + tr, ni = pr * si + pi * sr + ti; sr = nr; si = ni; }
#pragma unroll
        for (int k = 0; k < 32; ++k) { const int i = 32 * seg + k, c = dir == 0 ? i : NCHB - 1 - i;
            *(unsigned*)(us + (size_t)c * ROWLEN) = pk2(sr, si);
            const float nr = lr * sr - li * si + f[k].x, ni = lr * si + li * sr + f[k].y; sr = nr; si = ni; }
        __syncthreads();
    }
    VM_WAIT(); __syncthreads();
}

__global__ void __launch_bounds__(512, 2) mk_fwd(Args args) {
    extern __shared__ __attribute__((aligned(16))) unsigned char lds_raw[];
    Frame F; F.lds = (LAS unsigned char*)lds_raw; F.tid = threadIdx.x; F.lane = F.tid & 63; F.wave = __builtin_amdgcn_readfirstlane(F.tid >> 6); F.G = gridDim.x; F.bx = blockIdx.x;
    volatile LAS unsigned* MISC = (volatile LAS unsigned*)(F.lds + LDSCTL_OFF);
    for (int u = F.tid; u < (LDS_BYTES - LDSCTL_OFF) / 4; u += 512) ((LAS unsigned*)(F.lds + LDSCTL_OFF))[u] = 0u;
    __syncthreads();
    unsigned char* ws = args.ws;
    XcdBarrier bar = xcd_barrier_post((unsigned*)(ws + WS_CTL), MISC + 8);
    const int lo = args.ph_lo, hi = args.ph_hi;
#define IN(k) (lo <= (k) && (k) < hi)
#define BOTH(k) (IN(k) && IN((k) == 2 ? 4 : (k) + 1))
    if (IN(0)) { ST(0); p0_prologue(args, F); ST(1); if (BOTH(0)) xcd_barrier(bar, F.tid); }
    if (IN(1)) { F.lane = lane_id_fresh(); F.tid = F.wave * 64 + F.lane; ST(2);
        GemmDesc g{(const char*)(ws + WS_XB), (const char*)(ws + WS_WIN), 256L * DM * 2, 0, 256L * DM * 2, 0, 128L * DM * 2, 128L * DM * 2, 128, 128, DM / BK};
        unsigned vA[2], vB[2]; voff_std(vA, DM, false, F.tid); voff_std(vB, DM, true, F.tid);
        StaticOrder S; S.init(MT / BM, DM / BM, F.G, F.bx);
        EpiU E{(const float*)(ws + WS_R0), (bf16_t*)(ws + WS_UPOOL), (bf16_t*)(ws + WS_USSM)};
        gemm_phase<EpiU, StaticOrder, true>(F.lds, g, vA, vB, S, E, F.tid, GP_STAMP(22));
        ST(3);
        if (BOTH(1)) xcd_barrier(bar, F.tid);
#if defined(MK_EXTRA_BAR)
        for (int rep = 0; rep < MK_EXTRA_BAR; ++rep) xcd_barrier(bar, F.tid);
#endif
    }
    if (IN(2)) { F.lane = lane_id_fresh(); F.tid = F.wave * 64 + F.lane; ST(4);
        if (F.bx < 128) {
            OrdSsmB S0{F.bx}; Unit u0; S0.next(0, u0);
            { GemmDesc g{(const char*)(ws + WS_USSM), (const char*)(ws + WS_WAB), 256L * ROWLEN * 2, (long)NCR * ROWLEN * 2, 0, 256L * K1 * 2, 128L * ROWLEN * 2, 128L * K1 * 2, 128, 128, K1 / BK};
              unsigned vA[2], vB[2]; voff_std(vB, K1, false, F.tid);
#pragma unroll
              for (int i = 0; i < 2; ++i) { int R, C; stage_rc(F.tid * 16 + i * 8192, R, C);
                  vA[i] = (unsigned)(((64 * (R >> 6) + 4 * (R & 15) + ((R >> 4) & 3)) * ROWLEN + C) * 2); }
              OrdOne S{u0}; EpiScan E{(const float*)(ws + WS_LAMT), (bf16_t*)(ws + WS_USSM)};
              gemm_phase<EpiScan, OrdOne, false>(F.lds, g, vA, vB, S, E, F.tid, GP_STAMP(24)); }
            VM_WAIT(); __syncthreads(); ST(40); ST(41);
            tb_wait(args, F, u0.g); ST(42);
            F.lane = lane_id_fresh(); F.tid = F.wave * 64 + F.lane;
            { GemmDesc g{(const char*)(ws + WS_USSM), (const char*)(ws + WS_TB), 256L * ROWLEN * 2, (long)NCR * ROWLEN * 2, 0, (2L * TCH) * 512, 128L * ROWLEN * 2, 8L * 512, 128, -4L * 512, ROWLEN / BK,
                         (const char*)(ws + WS_TBC), 0, (long)K1 * 512, 128L * 512, 128, K1 / BK};
              unsigned vA[2], vB[2], vB2[2]; voff_std(vA, ROWLEN, false, F.tid); voff_std(vB2, 256, true, F.tid);
#pragma unroll
              for (int i = 0; i < 2; ++i) { int R, C; stage_rc(F.tid * 16 + i * 8192, R, C); const int Rb = (R & ~31) + perm32(R & 31);
                  vB[i] = (unsigned)((((Rb >> 4) - (C >> 4) + (TCH - 1)) * 256 + (Rb & 15) * 16 + (C & 15)) * 2); }
              asm volatile("" : "+v"(vA[0]), "+v"(vA[1]), "+v"(vB[0]), "+v"(vB[1]), "+v"(vB2[0]), "+v"(vB2[1]));
              OrdOne S{u0}; EpiZ E{(const bf16_t*)(ws + WS_USSM), args.in[12], (bf16_t*)(ws + WS_ZG)};
              gemm_phase<EpiZ, OrdOne, true, true>(F.lds, g, vA, vB, S, E, F.tid, GP_STAMP(26), vB2); }
        } else { ssm_side(args, F, 128); ST(44); p2_pooled(args, F, 128); }
        ST(5);
        if (BOTH(2)) xcd_barrier(bar, F.tid);
    }
    if (IN(4)) { F.lane = lane_id_fresh(); F.tid = F.wave * 64 + F.lane; ST(8);
        if (F.bx < 128) {
            constexpr long GSTR = (long)MT * 32;
            GemmDesc g{(const char*)(ws + WS_ZG), (const char*)(ws + WS_WGLU), 256L * 32, 0, 256L * DSSM * 2, 0, 128L * 32, 128L * DSSM * 2, 4 * GSTR, 128, DSSM / BK};
            unsigned vA[2], vB[2]; voff_std(vB, DSSM, true, F.tid);
#pragma unroll
            for (int i = 0; i < 2; ++i) { int R, C; stage_rc(F.tid * 16 + i * 8192, R, C); vA[i] = (unsigned)(R * 32 + (C >> 4) * (int)GSTR + (C & 15) * 2); }
            OrdGlu S{F.bx}; EpiGlu E{args.in[14], (const bf16_t*)(ws + WS_ZG), (bf16_t*)(ws + WS_YCAT), (float*)(ws + WS_SSSSM)};
            gemm_phase<EpiGlu, OrdGlu, true>(F.lds, g, vA, vB, S, E, F.tid, GP_STAMP(28));
        } else {
            GemmDesc g{(const char*)(ws + WS_POOLED), (const char*)(ws + WS_PW), 256L * DPOOL * 2, 256L * 2, 256L * 256 * 2, 0, 128L * DPOOL * 2, 128L * 256 * 2, 128, 128, 256 / BK};
            unsigned vA[2], vB[2]; voff_std(vA, DPOOL, false, F.tid); voff_std(vB, 256, true, F.tid);
            OrdPool S{F.bx}; EpiPool E{args.in[4], (bf16_t*)(ws + WS_YCAT), (float*)(ws + WS_SSPOOL)};
            gemm_phase<EpiPool, OrdPool, true>(F.lds, g, vA, vB, S, E, F.tid, GP_STAMP(36));

            __syncthreads();
            p4_side(args, F, 128);
        }
        ST(9);
        if (BOTH(4)) xcd_barrier(bar, F.tid);
    }
    if (IN(5)) { F.lane = lane_id_fresh(); F.tid = F.wave * 64 + F.lane; ST(10);
        StaticOrder S; S.init(MT / BM, DM / BM, F.G, F.bx); Unit u0;
        LAS f32x2* XR = (LAS f32x2*)(F.lds + XTRA_OFF);
        if (S.next(0, u0)) {
            if (F.tid < 256) { const int row = u0.pm * BM + F.tid; const float* sp = (const float*)(ws + WS_SSPOOL); const float* sm = (const float*)(ws + WS_SSSSM); float a0 = 0.f, a1 = 0.f;
#pragma unroll
                for (int s = 0; s < 8; ++s) { a0 += sp[(size_t)s * MT + row]; a1 += sm[(size_t)s * MT + row]; }
                const float rp = rsqrtf(a0 * (1.0f / DPOOL) + EPS), rsm = rsqrtf(a1 * (1.0f / DSSM) + EPS); XR[F.tid] = (f32x2){rp / rsm, rsm}; }
        }
        __syncthreads();
        GemmDesc g{(const char*)(ws + WS_YCAT), (const char*)(ws + WS_WOUT), 256L * DM * 2, 0, 256L * DM * 2, 0, 128L * DM * 2, 128L * DM * 2, 128, 128, DM / BK};
        unsigned vA[2], vB[2]; voff_std(vA, DM, false, F.tid); voff_std(vB, DM, true, F.tid);
        EpiOut E{args.in[0], (bf16_t*)(ws + WS_H1B), (float*)(ws + WS_SSH1), XR, {{0.f, 0.f, 0.f, 0.f}, {0.f, 0.f, 0.f, 0.f}}};
        { const int wr_ = F.wave >> 2, fr_ = F.lane & 15;
#pragma unroll
          for (int ai = 0; ai < 2; ++ai)
#pragma unroll
              for (int m = 0; m < 4; ++m) E.ratio[ai][m] = XR[ai * HALF + wr_ * 64 + m * 16 + fr_].x; }
        gemm_phase<EpiOut, StaticOrder, false>(F.lds, g, vA, vB, S, E, F.tid, GP_STAMP(30));
        ST(11);
        if (BOTH(5)) xcd_barrier(bar, F.tid);
    }
    if (IN(6)) { F.lane = lane_id_fresh(); F.tid = F.wave * 64 + F.lane; ST(12);
        GemmDesc g{(const char*)(ws + WS_H1B), (const char*)(ws + WS_WUP), (long)UPROWS * DM * 2, (long)PADROWS * DM * 2, 256L * DM * 2, 0, 64L * DM * 2, 128L * DM * 2, 128, 128, DM / BK};
        unsigned vA[2], vB[2]; voff_std(vB, DM, true, F.tid);
#pragma unroll
        for (int i = 0; i < 2; ++i) { int R, C; stage_rc(F.tid * 16 + i * 8192, R, C); vA[i] = (unsigned)(((126 * (R >> 6) + (R & 63)) * DM + C) * 2); }
        OrdUp S; S.so.init(BATCH * UPT, DFF2 / BM, F.G, F.bx);
        LAS float* RSL = (LAS float*)(F.lds + XTRA_OFF);
        if (F.tid < 256) { const float* ssh1 = (const float*)(ws + WS_SSH1);
#pragma unroll
            for (int i = 0; i < 6; ++i) { Unit uu; if (S.next(i, uu)) { const int t = UPROWS * uu.pm + F.tid - 1; const bool in = (t >= 0 && t < SEQ && F.tid < 254); const int tok = uu.g * SEQ + (in ? t : 0);
                const float sq = (ssh1[tok] + ssh1[MT + tok]) + (ssh1[2 * MT + tok] + ssh1[3 * MT + tok]); RSL[i * 256 + F.tid] = in ? rsqrtf(sq * (1.0f / DM) + EPS) : 0.f; } } }
        __syncthreads();
        EpiUp E{RSL, args.in[20], args.in[21], (bf16_t*)(ws + WS_ACT)};
        STC(50); ST(52);
#if defined(EXP_P6_NOALIGN)
        gemm_phase<EpiUp, OrdUp, false>(F.lds, g, vA, vB, S, E, F.tid, GP_STAMP(32));
#else
        gemm_phase<EpiUp, OrdUp, true>(F.lds, g, vA, vB, S, E, F.tid, GP_STAMP(32));
#endif
        STC(51); ST(53);
        ST(13);
        if (BOTH(6)) xcd_barrier(bar, F.tid);
    }
    if (IN(7)) { F.lane = lane_id_fresh(); F.tid = F.wave * 64 + F.lane; ST(14);
        GemmDesc g{(const char*)(ws + WS_ACT), (const char*)(ws + WS_WDOWN), 256L * DFF * 2, 0, 256L * DFF * 2, 0, 128L * DFF * 2, 128L * DFF * 2, 128, 128, DFF / BK};
        unsigned vA[2], vB[2]; voff_std(vA, DFF, false, F.tid); voff_std(vB, DFF, true, F.tid);
        StaticOrder S; S.init(MT / BM, DM / BM, F.G, F.bx);
        EpiDown E{(const bf16_t*)(ws + WS_H1B), args.out, args.in[23], (float*)(ws + WS_SSH2), &bar};
        STC(54); ST(56);
        gemm_phase<EpiDown, StaticOrder, false>(F.lds, g, vA, vB, S, E, F.tid, GP_STAMP(34)); ST(15); STC(55); ST(57);
    }
#undef IN
#undef BOTH
}
}

__global__ void k_cvt_u(const bf16_t* __restrict__ upool, const bf16_t* __restrict__ ussm, float* __restrict__ u) {
    const int idx = blockIdx.x * blockDim.x + threadIdx.x; if (idx >= MT * DM) return;
    const int c = idx % DM, row = idx / DM; unsigned short v;
    if (c < DPOOL) v = upool[(size_t)row * DPOOL + c];
    else { const int cs = c - DPOOL, g = cs >> 4, h = cs & 15, cr = row / mk::TCH, p = row % mk::TCH; v = ussm[((size_t)(g * mk::NCR + cr)) * mk::ROWLEN + 16 * p + h]; }
    u[idx] = __builtin_bit_cast(float, (unsigned)v << 16);
}
__global__ void k_cvt_z(const bf16_t* __restrict__ zg, float* __restrict__ z) {
    const int idx = blockIdx.x * blockDim.x + threadIdx.x; if (idx >= MT * DSSM) return;
    const int c = idx % DSSM, row = idx / DSSM; const unsigned short v = zg[((size_t)(c >> 4) * MT + row) * 16 + (c & 15)];
    z[idx] = __builtin_bit_cast(float, (unsigned)v << 16);
}
__global__ void k_cvt_rows(const bf16_t* __restrict__ src, int lds_, float* __restrict__ dst, int ldd, int cols, int rows) {
    const size_t idx = (size_t)blockIdx.x * blockDim.x + threadIdx.x; if (idx >= (size_t)rows * cols) return;
    const int c = (int)(idx % cols); const size_t row = idx / cols; dst[row * ldd + c] = __builtin_bit_cast(float, (unsigned)src[row * lds_ + c] << 16);
}

#if defined(MK_STAMP)
__device__ float stamp_sel(const unsigned long long* st, int ia, int ib, int b0, int b1, int mode) {
    double acc = mode == 1 ? 1e30 : 0.0;
    for (int b = b0; b < b1; ++b) { const double d = (double)(long long)(st[b * 64 + ib] - (ia < 0 ? 0ull : st[b * 64 + ia])) * 0.01;
        if (mode == 3) { const double cyc = (double)(long long)(st[b * 64 + ib] - st[b * 64 + ia]), tk = (double)(long long)(st[b * 64 + ib + 2] - st[b * 64 + ia + 2]); acc += (cyc / tk) * 0.1 / (b1 - b0); }
        else if (mode == 0) acc = d > acc ? d : acc; else if (mode == 1) acc = d < acc ? d : acc; else acc += d / (b1 - b0); }
    return (float)acc;
}
__global__ void k_stamp_report(const unsigned long long* st, float* out, int a_ia, int a_ib, int a_b0, int a_b1, int a_mode, float scale) {
    if (blockIdx.x == 0 && threadIdx.x == 0) out[0] += stamp_sel(st, a_ia, a_ib, a_b0, a_b1, a_mode) * scale;
}
#endif

#ifndef MK_CUT
#define MK_CUT 8
#endif
static void gemm(hipStream_t s, const float* A, int lda, const float* B, int ldb, float* C, int ldc, const float* R, int ldr, int M, int N, int K) {
    hipLaunchKernelGGL(k_gemm, dim3(N / 128, M / 128), dim3(256), 0, s, A, lda, B, ldb, C, ldc, R, ldr, K);
}

extern "C" void kernel_launch(void* const* d_in, const int* in_sizes, int n_in, void* d_out, int out_size, void* d_ws, size_t ws_size, hipStream_t stream) {
    static int grid = 0;
    if (grid == 0) {
        int dev = 0, cus = 0, per_cu = 0;
        if (n_in != 24 || out_size != MT * DM || ws_size < mk::WS_END) { fprintf(stderr, "kernel_launch: unexpected problem (n_in %d out %d ws %zu)\n", n_in, out_size, ws_size); grid = -1; return; }
        if (hipGetDevice(&dev) != hipSuccess || hipDeviceGetAttribute(&cus, hipDeviceAttributeMultiprocessorCount, dev) != hipSuccess) { grid = -1; return; }
        if (hipFuncSetAttribute((const void*)mk::mk_fwd, hipFuncAttributeMaxDynamicSharedMemorySize, mk::LDS_BYTES) != hipSuccess) { fprintf(stderr, "kernel_launch: hipFuncSetAttribute failed\n"); grid = -1; return; }
        if (hipOccupancyMaxActiveBlocksPerMultiprocessor(&per_cu, (const void*)mk::mk_fwd, 512, mk::LDS_BYTES) != hipSuccess || per_cu < 1) { fprintf(stderr, "kernel_launch: occupancy query says %d blocks/CU\n", per_cu); }
        (void)hipGetLastError();
        grid = cus;
        if (grid != 256) { fprintf(stderr, "kernel_launch: built for a 256-CU device, found %d CUs\n", cus); grid = -1; return; }
    }
    if (grid < 0) return;
    const float* x = (const float*)d_in[0];
    const float* pool_w = (const float*)d_in[3];   const float* pool_scale = (const float*)d_in[4];
    const float* lnar = (const float*)d_in[5];     const float* aim = (const float*)d_in[6];   const float* ldt = (const float*)d_in[7];
    const float* bre = (const float*)d_in[8];      const float* bim = (const float*)d_in[9];
    const float* cre = (const float*)d_in[10];     const float* cim = (const float*)d_in[11];
    const float* ssm_d = (const float*)d_in[12];   const float* glu_w = (const float*)d_in[13]; const float* glu_b = (const float*)d_in[14];
    const float* g_pool = (const float*)d_in[15];  const float* g_ssm = (const float*)d_in[16];
    const float* w_out = (const float*)d_in[17];   const float* g_ffn = (const float*)d_in[18];
    const float* w_up = (const float*)d_in[19];    const float* conv_w = (const float*)d_in[20]; const float* conv_b = (const float*)d_in[21];
    const float* w_down = (const float*)d_in[22];  const float* g_final = (const float*)d_in[23];
    float* out = (float*)d_out; char* ws = (char*)d_ws; const size_t MiB = 1u << 20; const int EB = 256;
    (void)x; (void)pool_w; (void)pool_scale; (void)lnar; (void)aim; (void)ldt; (void)bre; (void)bim; (void)cre; (void)cim; (void)ssm_d; (void)glu_w; (void)glu_b; (void)g_pool; (void)g_ssm; (void)w_out; (void)g_ffn; (void)w_up; (void)conv_w; (void)conv_b; (void)w_down; (void)g_final;

    (void)hipMemsetAsync(ws + mk::WS_CTL, 0, mk::CTL_ZERO_BYTES, stream);
#if defined(MK_EXTRA_MEMSET)
    for (int r = 0; r < MK_EXTRA_MEMSET; ++r) (void)hipMemsetAsync(ws + 5 * MiB + r * 65536, 0, 65536, stream);
#endif
    mk::Args a{};
    for (int i = 0; i < 24; ++i) a.in[i] = (const float*)d_in[i];
    a.out = out; a.ws = (unsigned char*)d_ws; a.ph_lo = 0; a.ph_hi = MK_CUT;
#if defined(MK_PROBE_LO)
    a.ph_lo = 0; a.ph_hi = MK_PROBE_HI; hipLaunchKernelGGL(mk::mk_fwd, dim3(grid), dim3(512), mk::LDS_BYTES, stream, a);
    for (int r = 0; r < MK_PROBE_REP; ++r) { (void)hipMemsetAsync(ws + mk::WS_CTL, 0, mk::CTL_ZERO_BYTES, stream); a.ph_lo = MK_PROBE_LO; a.ph_hi = MK_PROBE_HI; hipLaunchKernelGGL(mk::mk_fwd, dim3(grid), dim3(512), mk::LDS_BYTES, stream, a); }
    (void)hipMemsetAsync(ws + mk::WS_CTL, 0, mk::CTL_ZERO_BYTES, stream);
    a.ph_lo = MK_PROBE_HI; a.ph_hi = 8; hipLaunchKernelGGL(mk::mk_fwd, dim3(grid), dim3(512), mk::LDS_BYTES, stream, a);
#else
    hipLaunchKernelGGL(mk::mk_fwd, dim3(grid), dim3(512), mk::LDS_BYTES, stream, a);
#endif
#if defined(MK_STAMP)
    hipLaunchKernelGGL(k_stamp_report, dim3(1), dim3(64), 0, stream, (const unsigned long long*)(ws + mk::WS_STAMP), out, MK_STAMP_A);
#endif
#if MK_CUT < 8
    float* bufA = (float*)(ws + 0 * MiB); float* bufB = (float*)(ws + 64 * MiB); float* bufC = (float*)(ws + 128 * MiB); float* bufD = (float*)(ws + 192 * MiB);
    float* pooled = bufA; float* ypool = bufA + (size_t)MT * DPOOL; float* z = pooled; float* pre = bufD; float* ycat = bufB;
#if MK_CUT <= 2
    float* u = bufB;
    hipLaunchKernelGGL(k_cvt_u, dim3(MT * DM / EB), dim3(EB), 0, stream, (const bf16_t*)(ws + mk::WS_UPOOL), (const bf16_t*)(ws + mk::WS_USSM), u);
    hipLaunchKernelGGL(k_pool, dim3(MT * DPOOL / EB), dim3(EB), 0, stream, u, pooled);
    for (int gi = 0; gi < 4; ++gi) gemm(stream, pooled + gi * 128, DPOOL, pool_w + (size_t)gi * 128 * 128, 128, ypool + gi * 128, DPOOL, nullptr, 0, MT, 128, 128);
    float* y2 = bufC;
    hipLaunchKernelGGL(k_ssm_scan, dim3(2 * BATCH * NG), dim3(64), 0, stream, u, lnar, aim, ldt, bre, bim, cre, cim, y2);
    hipLaunchKernelGGL(k_ssm_post, dim3(MT * DSSM / EB), dim3(EB), 0, stream, y2, u, ssm_d, z);
    const float* pre_scale = pool_scale;
#elif MK_CUT <= 4
    hipLaunchKernelGGL(k_cvt_z, dim3(MT * DSSM / EB), dim3(EB), 0, stream, (const bf16_t*)(ws + mk::WS_ZG), z);
    hipLaunchKernelGGL(k_cvt_rows, dim3(MT * DPOOL / EB), dim3(EB), 0, stream, (const bf16_t*)(ws + mk::WS_YCAT), DM, ypool, DPOOL, DPOOL, MT);
    const float* pre_scale = nullptr;
#endif
#if MK_CUT <= 4
    gemm(stream, z, DSSM, glu_w, DSSM, pre, DSSM, nullptr, 0, MT, DSSM, DSSM);
    hipLaunchKernelGGL(k_glu, dim3(MT * DSSM / EB), dim3(EB), 0, stream, z, pre, glu_b);
#elif MK_CUT == 5
    hipLaunchKernelGGL(k_cvt_rows, dim3(MT * DPOOL / EB), dim3(EB), 0, stream, (const bf16_t*)(ws + mk::WS_YCAT), DM, ypool, DPOOL, DPOOL, MT);
    hipLaunchKernelGGL(k_cvt_rows, dim3(MT * DSSM / EB), dim3(EB), 0, stream, (const bf16_t*)(ws + mk::WS_YCAT) + DPOOL, DM, pre, DSSM, DSSM, MT);
    const float* pre_scale = nullptr;
#endif
#if MK_CUT <= 5
    hipLaunchKernelGGL(k_rmsnorm, dim3(MT / 4), dim3(256), 0, stream, ypool, DPOOL, pre_scale, g_pool, ycat, DM, DPOOL, MT);
    hipLaunchKernelGGL(k_rmsnorm, dim3(MT / 4), dim3(256), 0, stream, pre, DSSM, (const float*)nullptr, g_ssm, ycat + DPOOL, DM, DSSM, MT);
    gemm(stream, ycat, DM, w_out, DM, out, DM, x, DM, MT, DM, DM);
#endif
#if MK_CUT <= 6
    float* xn2 = bufA;
    hipLaunchKernelGGL(k_rmsnorm, dim3(MT / 4), dim3(256), 0, stream, out, DM, (const float*)nullptr, g_ffn, xn2, DM, DM, MT);
    float* up = (float*)(ws + 64 * MiB); float* act = (float*)(ws + 152 * MiB);
    for (int b = 0; b < BATCH; ++b) {
        gemm(stream, xn2 + (size_t)b * SEQ * DM, DM, w_up, DFF2, up, DFF2, nullptr, 0, SEQ, DFF2, DM);
        hipLaunchKernelGGL(k_convact, dim3(SEQ * DFF / EB), dim3(EB), 0, stream, up, conv_w, conv_b, act);
        gemm(stream, act, DFF, w_down, DM, out + (size_t)b * SEQ * DM, DM, out + (size_t)b * SEQ * DM, DM, SEQ, DM, DFF);
    }
#else
    float* actf = (float*)(ws + 0 * MiB);
    for (int b = 0; b < BATCH; ++b) {
        hipLaunchKernelGGL(k_cvt_rows, dim3(SEQ * DFF / EB), dim3(EB), 0, stream, (const bf16_t*)(ws + mk::WS_ACT) + (size_t)b * SEQ * DFF, DFF, actf, DFF, DFF, SEQ);
        gemm(stream, actf, DFF, w_down, DM, out + (size_t)b * SEQ * DM, DM, out + (size_t)b * SEQ * DM, DM, SEQ, DM, DFF);
    }
#endif
    hipLaunchKernelGGL(k_rmsnorm, dim3(MT / 4), dim3(256), 0, stream, out, DM, (const float*)nullptr, g_final, out, DM, DM, MT);
    (void)bufC;
#endif
}
```

```cpp
#define MK_CUT 8
#include <hip/hip_runtime.h>
#include <math.h>

constexpr int BATCH = 4, SEQ = 4096, DM = 1024, MT = BATCH * SEQ;
constexpr int DPOOL = 512, DSSM = 512, NG = 32, NH = 16, NS = 64;
constexpr int DFF = 2816, DFF2 = 5632;
constexpr float EPS = 1e-6f;

__global__ void k_rmsnorm(const float* x, int ldx, const float* __restrict__ pre,
                          const float* __restrict__ g, float* out, int ldo, int D, int rows) {
    const int wave = (blockIdx.x * blockDim.x + threadIdx.x) >> 6, lane = threadIdx.x & 63;
    if (wave >= rows) return;
    const float* xr = x + (size_t)wave * ldx;
    float ss = 0.f;
    for (int c = lane; c < D; c += 64) { float v = xr[c]; if (pre) v *= pre[c]; ss += v * v; }
    for (int o = 32; o; o >>= 1) ss += __shfl_xor(ss, o);
    const float inv = rsqrtf(ss / (float)D + EPS);
    float* orow = out + (size_t)wave * ldo;
    for (int c = lane; c < D; c += 64) { float v = xr[c]; if (pre) v *= pre[c]; orow[c] = v * inv * g[c]; }
}

__global__ void __launch_bounds__(256) k_gemm(const float* __restrict__ A, int lda, const float* __restrict__ B, int ldb,
                                               float* C, int ldc, const float* R, int ldr, int K) {
    __shared__ float As[16][132];
    __shared__ float Bs[16][132];
    const int tid = threadIdx.x, tx = tid & 15, ty = tid >> 4;
    const int row0 = blockIdx.y * 128, col0 = blockIdx.x * 128;
    float acc[8][8];
#pragma unroll
    for (int i = 0; i < 8; ++i)
#pragma unroll
        for (int j = 0; j < 8; ++j) acc[i][j] = 0.f;
    for (int k0 = 0; k0 < K; k0 += 16) {
#pragma unroll
        for (int p = 0; p < 2; ++p) {
            const int i = tid + p * 256, r = i >> 2, kk = (i & 3) * 4;
            const float4 v = *(const float4*)(A + (size_t)(row0 + r) * lda + k0 + kk);
            As[kk + 0][r] = v.x; As[kk + 1][r] = v.y; As[kk + 2][r] = v.z; As[kk + 3][r] = v.w;
        }
#pragma unroll
        for (int p = 0; p < 2; ++p) {
            const int i = tid + p * 256, kk = i >> 5, c = (i & 31) * 4;
            const float4 v = *(const float4*)(B + (size_t)(k0 + kk) * ldb + col0 + c);
            *(float4*)&Bs[kk][c] = v;
        }
        __syncthreads();
#pragma unroll
        for (int kk = 0; kk < 16; ++kk) {
            float a[8], b[8];
            const float4 a0 = *(const float4*)&As[kk][ty * 4], a1 = *(const float4*)&As[kk][64 + ty * 4];
            const float4 b0 = *(const float4*)&Bs[kk][tx * 4], b1 = *(const float4*)&Bs[kk][64 + tx * 4];
            a[0] = a0.x; a[1] = a0.y; a[2] = a0.z; a[3] = a0.w; a[4] = a1.x; a[5] = a1.y; a[6] = a1.z; a[7] = a1.w;
            b[0] = b0.x; b[1] = b0.y; b[2] = b0.z; b[3] = b0.w; b[4] = b1.x; b[5] = b1.y; b[6] = b1.z; b[7] = b1.w;
#pragma unroll
            for (int i = 0; i < 8; ++i)
#pragma unroll
                for (int j = 0; j < 8; ++j) acc[i][j] = fmaf(a[i], b[j], acc[i][j]);
        }
        __syncthreads();
    }
#pragma unroll
    for (int i = 0; i < 8; ++i) {
        const int r = row0 + (i < 4 ? ty * 4 + i : 64 + ty * 4 + (i - 4));
#pragma unroll
        for (int jh = 0; jh < 2; ++jh) {
            const int c = col0 + jh * 64 + tx * 4;
            float4 v = make_float4(acc[i][jh * 4 + 0], acc[i][jh * 4 + 1], acc[i][jh * 4 + 2], acc[i][jh * 4 + 3]);
            if (R) { const float4 rr = *(const float4*)(R + (size_t)r * ldr + c); v.x += rr.x; v.y += rr.y; v.z += rr.z; v.w += rr.w; }
            *(float4*)(C + (size_t)r * ldc + c) = v;
        }
    }
}

__global__ void k_pool(const float* __restrict__ u  , float* __restrict__ pooled  ) {
    const int idx = blockIdx.x * blockDim.x + threadIdx.x;
    if (idx >= MT * DPOOL) return;
    const int c = idx % DPOOL, row = idx / DPOOL, b = row / SEQ, t = row % SEQ;
    const int gi = c / 128, w = 2 << gi, half = w / 2;
    int lo = t - half, hi = t + half; if (lo < 0) lo = 0; if (hi > SEQ) hi = SEQ;
    float s = 0.f;
    for (int q = lo; q < hi; ++q) s += u[(size_t)(b * SEQ + q) * DM + c];
    pooled[idx] = s / (float)(hi - lo) - u[(size_t)row * DM + c];
}

__global__ void __launch_bounds__(64) k_ssm_scan(const float* __restrict__ u  ,
        const float* __restrict__ lnar, const float* __restrict__ aim, const float* __restrict__ ldt,
        const float* __restrict__ bre, const float* __restrict__ bim, const float* __restrict__ cre, const float* __restrict__ cim,
        float* __restrict__ y  ) {
    const int n = threadIdx.x;
    const int g = blockIdx.x % NG, b = (blockIdx.x / NG) % BATCH, dir = blockIdx.x / (NG * BATCH);
    const float dt = expf(ldt[dir * NG + g]);
    const float a_re = -expf(lnar[(dir * NG + g) * NS + n]), a_im = aim[(dir * NG + g) * NS + n];
    const float mag = expf(a_re * dt), ang = a_im * dt;
    const float lam_re = mag * cosf(ang), lam_im = mag * sinf(ang);
    const float den = a_re * a_re + a_im * a_im;
    const float f_re = ((lam_re - 1.0f) * a_re + lam_im * a_im) / den;
    const float f_im = (lam_im * a_re - (lam_re - 1.0f) * a_im) / den;
    float Br[NH], Bi[NH], Cr[NH], Ci[NH];
#pragma unroll
    for (int h = 0; h < NH; ++h) {
        Br[h] = bre[((size_t)(dir * NG + g) * NS + n) * NH + h];
        Bi[h] = bim[((size_t)(dir * NG + g) * NS + n) * NH + h];
        Cr[h] = cre[((size_t)(dir * NG + g) * NH + h) * NS + n];
        Ci[h] = cim[((size_t)(dir * NG + g) * NH + h) * NS + n];
    }
    float s_re = 0.f, s_im = 0.f;
    float* yd = y + (size_t)dir * MT * DSSM;
    for (int i = 0; i < SEQ; ++i) {
        const int t = dir ? (SEQ - 1 - i) : i;
        const float* ur = u + (size_t)(b * SEQ + t) * DM + DPOOL + g * NH;
        float bu_re = 0.f, bu_im = 0.f;
#pragma unroll
        for (int h = 0; h < NH; ++h) { const float uv = ur[h]; bu_re = fmaf(Br[h], uv, bu_re); bu_im = fmaf(Bi[h], uv, bu_im); }
        const float in_re = f_re * bu_re - f_im * bu_im, in_im = f_re * bu_im + f_im * bu_re;
        const float nr = lam_re * s_re - lam_im * s_im + in_re;
        const float ni = lam_re * s_im + lam_im * s_re + in_im;
        s_re = nr; s_im = ni;
        float mine = 0.f;
#pragma unroll
        for (int h = 0; h < NH; ++h) {
            float p = Cr[h] * s_re - Ci[h] * s_im;
#pragma unroll
            for (int o = 32; o; o >>= 1) p += __shfl_xor(p, o);
            if (n == h) mine = p;
        }
        if (n < NH) yd[(size_t)(b * SEQ + t) * DSSM + g * NH + n] = mine;
    }
}

__device__ __forceinline__ float gelu_tanh(float x) {
    const float k = 0.7978845608028654f;
    return 0.5f * x * (1.0f + tanhf(k * (x + 0.044715f * x * x * x)));
}
__device__ __forceinline__ float sigmoidf_(float x) { return 1.0f / (1.0f + expf(-x)); }

__global__ void k_ssm_post(const float* __restrict__ y2, const float* __restrict__ u, const float* __restrict__ d, float* __restrict__ z) {
    const int idx = blockIdx.x * blockDim.x + threadIdx.x;
    if (idx >= MT * DSSM) return;
    const int c = idx % DSSM, row = idx / DSSM;
    const float yv = y2[idx] + y2[(size_t)MT * DSSM + idx] + d[c] * u[(size_t)row * DM + DPOOL + c];
    z[idx] = gelu_tanh(yv);
}
__global__ void k_glu(const float* __restrict__ z, float* __restrict__ pre, const float* __restrict__ gb) {
    const int idx = blockIdx.x * blockDim.x + threadIdx.x;
    if (idx >= MT * DSSM) return;
    const int c = idx % DSSM;
    pre[idx] = z[idx] * sigmoidf_(pre[idx] + gb[c]);
}
__global__ void k_convact(const float* __restrict__ up  , const float* __restrict__ cw, const float* __restrict__ cb, float* __restrict__ act  ) {
    const int idx = blockIdx.x * blockDim.x + threadIdx.x;
    if (idx >= SEQ * DFF) return;
    const int f = idx % DFF, t = idx / DFF;
    float v = cb[f], gt = cb[DFF + f];
#pragma unroll
    for (int k = 0; k < 3; ++k) {
        const int q = t + k - 1;
        if (q >= 0 && q < SEQ) {
            v = fmaf(up[(size_t)q * DFF2 + f], cw[k * DFF2 + f], v);
            gt = fmaf(up[(size_t)q * DFF2 + DFF + f], cw[k * DFF2 + DFF + f], gt);
        }
    }
    act[idx] = v * (gt * sigmoidf_(gt));
}


#include <cstdio>
#include <cstdint>
#define LAS __attribute__((address_space(3)))
#define GAS __attribute__((address_space(1)))
typedef unsigned short bf16_t;
typedef short bf16x8 __attribute__((ext_vector_type(8)));
typedef float f32x4 __attribute__((ext_vector_type(4)));
typedef float f32x2 __attribute__((ext_vector_type(2)));
typedef unsigned u32x4 __attribute__((ext_vector_type(4)));
typedef unsigned u32x2 __attribute__((ext_vector_type(2)));

namespace mk {
constexpr int TCH = 16;
constexpr int K1 = 16 * TCH;
constexpr int ROWLEN = K1 + 256;
constexpr int NCR = MT / TCH;
constexpr int NCHB = SEQ / TCH;
constexpr int PADROWS = 4352;
constexpr int UPT = 17;
constexpr int UPROWS = 252;

constexpr size_t MiB = 1u << 20;
constexpr size_t WS_CTL = 0, CTL_ZERO_BYTES = 64 * 1024;
constexpr int CW_TBCNT = 4096;
constexpr size_t WS_R0 = 1 * MiB;
constexpr size_t WS_SSPOOL = 2 * MiB;
constexpr size_t WS_SSSSM = WS_SSPOOL + 8 * MT * 4;
constexpr size_t WS_SSH1 = WS_SSSSM + 8 * MT * 4;
constexpr size_t WS_SSH2 = WS_SSH1 + 4 * MT * 4;
constexpr size_t WS_LAMT = 6 * MiB;
constexpr size_t WS_WIN = 8 * MiB, WS_WOUT = 10 * MiB, WS_WGLU = 12 * MiB, WS_PW = 12 * MiB + 512 * 1024;
constexpr size_t WS_WUP = 13 * MiB, WS_WDOWN = 24 * MiB;
constexpr size_t WS_WAB = 30 * MiB;
constexpr size_t WS_TB = 38 * MiB;
constexpr size_t WS_TBC = 40 * MiB;
constexpr size_t WS_H1B = 62 * MiB;
constexpr size_t WS_XB = 96 * MiB;
constexpr size_t WS_YCAT = 96 * MiB;
constexpr size_t WS_UPOOL = 128 * MiB;
constexpr size_t WS_USSM = 144 * MiB;
constexpr size_t WS_FG = 176 * MiB;
constexpr size_t WS_POOLED = 208 * MiB;
constexpr size_t WS_ZG = 224 * MiB;
constexpr size_t WS_ACT = 96 * MiB;
constexpr size_t WS_END = 240 * MiB;

constexpr int RING_BYTES = 131072, XTRA_OFF = RING_BYTES, XTRA_BYTES = 12288, LDSCTL_OFF = XTRA_OFF + XTRA_BYTES, LDS_BYTES = 147456;

__device__ __forceinline__ unsigned f2bf(float f) { unsigned u = __builtin_bit_cast(unsigned, f); return (u + 0x7fffu + ((u >> 16) & 1u)) >> 16; }
__device__ __forceinline__ unsigned pk2(float lo, float hi) { return f2bf(lo) | (f2bf(hi) << 16); }
__device__ __forceinline__ unsigned cvt_pk_bf16(float lo, float hi) { unsigned r; asm volatile("v_cvt_pk_bf16_f32 %0, %1, %2" : "=v"(r) : "v"(lo), "v"(hi)); return r; }
__device__ __forceinline__ u32x4 pack8(f32x4 a, f32x4 b) { u32x4 w; w.x = cvt_pk_bf16(a[0], a[1]); w.y = cvt_pk_bf16(a[2], a[3]); w.z = cvt_pk_bf16(b[0], b[1]); w.w = cvt_pk_bf16(b[2], b[3]); return w; }
__device__ __forceinline__ u32x2 pack4(f32x4 a) { u32x2 w; w.x = cvt_pk_bf16(a[0], a[1]); w.y = cvt_pk_bf16(a[2], a[3]); return w; }
__device__ __forceinline__ float bflo(unsigned w) { return __builtin_bit_cast(float, w << 16); }
__device__ __forceinline__ float bfhi(unsigned w) { return __builtin_bit_cast(float, w & 0xffff0000u); }
__device__ __forceinline__ void unpack8(u32x4 w, f32x4& a, f32x4& b) { a[0] = bflo(w.x); a[1] = bfhi(w.x); a[2] = bflo(w.y); a[3] = bfhi(w.y); b[0] = bflo(w.z); b[1] = bfhi(w.z); b[2] = bflo(w.w); b[3] = bfhi(w.w); }
__device__ __forceinline__ float fast_sigmoid(float x) { return __builtin_amdgcn_rcpf(1.0f + __builtin_amdgcn_exp2f(-1.4426950408889634f * x)); }
__device__ __forceinline__ float fast_gelu_tanh(float x) {
    const float t = x * (1.0f + 0.044715f * x * x);
    return x * __builtin_amdgcn_rcpf(1.0f + __builtin_amdgcn_exp2f(-2.0f * 0.7978845608028654f * 1.4426950408889634f * t));
}
__device__ __forceinline__ float wave_sum(float v) {
#pragma unroll
    for (int o = 1; o < 64; o <<= 1) v += __shfl_xor(v, o);
    return v;
}
__device__ __forceinline__ float dpp_ror1(float v)  { return __builtin_bit_cast(float, __builtin_amdgcn_update_dpp(0, __builtin_bit_cast(int, v), 0x121, 0xf, 0xf, false)); }
__device__ __forceinline__ float dpp_ror15(float v) { return __builtin_bit_cast(float, __builtin_amdgcn_update_dpp(0, __builtin_bit_cast(int, v), 0x12F, 0xf, 0xf, false)); }
__device__ __forceinline__ int lane_id_fresh() { int l; asm volatile("v_mbcnt_lo_u32_b32 %0, -1, 0\n\tv_mbcnt_hi_u32_b32 %0, -1, %0" : "=v"(l)); return l; }
#define LDS_WAIT() asm volatile("s_waitcnt lgkmcnt(0)" ::: "memory")
#define VM_WAIT() asm volatile("s_waitcnt vmcnt(0)" ::: "memory")

#define XB_TMO      128
#define XB_XCNT(j)  (256  + 64 * (j))
#define XB_XSUB(j)  (1280 + 64 * (j))
#define XB_XGEN(j)  (2304 + 64 * (j))
#define XB_TOP      3328
#define XB_TOPGEN   3392
#define XCD_BAR_WORDS 3456
#define XB_SPIN_CAP (1u << 18)
__device__ __forceinline__ unsigned xb_ld(unsigned* p)              { return __hip_atomic_load(p, __ATOMIC_RELAXED, __HIP_MEMORY_SCOPE_AGENT); }
__device__ __forceinline__ unsigned xb_add(unsigned* p, unsigned v) { return __hip_atomic_fetch_add(p, v, __ATOMIC_RELAXED, __HIP_MEMORY_SCOPE_AGENT); }
__device__ __forceinline__ unsigned xb_xcc_id() { return (unsigned)__builtin_amdgcn_s_getreg((3 << 11) | 20) & 0xFu; }
#define XB_SPIN(cond, bar) do { unsigned _sp = 0; while (cond) { __builtin_amdgcn_s_sleep(1); \
    if ((++_sp & 255u) == 0u) { if (xb_ld(&(bar)[XB_TMO])) break; if (_sp > XB_SPIN_CAP) { atomicAdd(&(bar)[XB_TMO], 1u); break; } } } } while (0)
struct XcdBarrier { unsigned* bar; unsigned x; volatile LAS unsigned* st; };
__device__ __forceinline__ XcdBarrier xcd_barrier_post(unsigned* bar, volatile LAS unsigned* st) {
    XcdBarrier b; b.bar = bar; b.x = xb_xcc_id(); b.st = st;
    if (threadIdx.x == 0) (void)xb_add(&bar[XB_XCNT(b.x)], 1u);
    return b;
}
__device__ __forceinline__ void xcd_barrier_complete(unsigned* bar, unsigned x, unsigned& nloc, unsigned& nx) {
    const unsigned G = gridDim.x * gridDim.y * gridDim.z;
    unsigned sum, cnt, mine, sp = 0u;
    for (;;) {
        sum = 0u; cnt = 0u; mine = 0u;
#pragma unroll
        for (unsigned j = 0; j < 16; ++j) { const unsigned c = xb_ld(&bar[XB_XCNT(j)]); sum += c; cnt += (c > 0u) ? 1u : 0u; mine = (j == x) ? c : mine; }
        if (sum == G) break;
        __builtin_amdgcn_s_sleep(1);
        if ((++sp & 255u) == 0u) { if (xb_ld(&bar[XB_TMO])) break; if (sp > XB_SPIN_CAP) { atomicAdd(&bar[XB_TMO], 1u); break; } }
    }
    nloc = mine > 0u ? mine : 1u; nx = cnt > 0u ? cnt : 1u;
}
__device__ __forceinline__ void xcd_barrier(const XcdBarrier& b, int tid) {
    asm volatile("s_waitcnt vmcnt(0)" ::: "memory");
    __syncthreads();
    if (tid == 0) {
        unsigned* bar = b.bar;
        __builtin_amdgcn_s_waitcnt(0);
        unsigned nloc = b.st[0], nx = b.st[1];
        if (nloc == 0u) { xcd_barrier_complete(bar, b.x, nloc, nx); b.st[0] = nloc; b.st[1] = nx; }
        const unsigned old = xb_add(&bar[XB_XSUB(b.x)], 1u);
        const unsigned gen = old / nloc;
        if (old + 1u == (gen + 1u) * nloc) {
            __builtin_amdgcn_fence(__ATOMIC_RELEASE, "agent");
            asm volatile("s_waitcnt vmcnt(0)" ::: "memory");
            const unsigned og = xb_add(&bar[XB_TOP], 1u);
            const unsigned tg = og / nx;
            if (og + 1u == (tg + 1u) * nx) xb_add(&bar[XB_TOPGEN], 1u);
            else XB_SPIN(xb_ld(&bar[XB_TOPGEN]) == tg, bar);
            __builtin_amdgcn_fence(__ATOMIC_ACQUIRE, "agent");
            xb_add(&bar[XB_XGEN(b.x)], 1u);
            asm volatile("s_waitcnt vmcnt(0)" ::: "memory");
        } else {
            XB_SPIN(xb_ld(&bar[XB_XGEN(b.x)]) == gen, bar);
            __builtin_amdgcn_fence(__ATOMIC_ACQUIRE, "agent");
            asm volatile("s_waitcnt vmcnt(0)" ::: "memory");
        }
    }
    __syncthreads();
}

#ifndef EXP_WGM
#define EXP_WGM 8
#endif
constexpr int BM = 256, BK = 64, HALF = 128, HTB = HALF * BK * 2, STAGE_BYTES = 8 * HTB, NXCD = 8, WGM = EXP_WGM;
__host__ __device__ __forceinline__ int lds_byte(int r, int c) { const int st = (r >> 4) * 2 + (c >> 5), rr = r & 15, cc = c & 31, ob = rr * 64 + cc * 2; return st * 1024 + (ob ^ (((ob >> 9) & 1) << 5)); }
__host__ __device__ __forceinline__ void stage_rc(int b, int& R, int& C) { const int st = b / 1024, sb = b % 1024, swz = sb ^ (((sb >> 9) & 1) << 5); R = (st >> 1) * 16 + swz / 64; C = (st & 1) * 32 + (swz % 64) / 2; }
__host__ __device__ __forceinline__ int perm32(int rho) { const int n = rho >> 4, i = rho & 15; return 8 * (i >> 2) + 4 * n + (i & 3); }

struct Unit { int pm, pn, g, aux; };
struct GemmDesc { const char* A; const char* B; long a_pm, a_g, b_pn, b_g, a_h, b_h, a_k, b_k; int nt;
                  const char* B2; long b2_pn, b2_g, b2_h, b2_k; int tsw; };

struct StaticOrder {
    int nM, nN, nwg, G, c;
    __device__ void init(int nM_, int nN_, int G_, int c_) { nM = nM_; nN = nN_; nwg = nM * nN; G = G_; c = c_; }
    __device__ bool next(int i, Unit& u) const {
        const long L = (long)i * G + c; if (L >= nwg) return false;
        int wgid = (int)L; { const int q = nwg / NXCD, r = nwg % NXCD, xcd = wgid % NXCD, off = wgid / NXCD; wgid = (xcd < r ? xcd * (q + 1) : r * (q + 1) + (xcd - r) * q) + off; }
        const int nig = WGM * nN, gid = wgid / nig, fm = gid * WGM, gsz = (nM - fm) < WGM ? (nM - fm) : WGM;
        u.pm = fm + ((wgid % nig) % gsz); u.pn = (wgid % nig) / gsz; u.g = 0; u.aux = 0; return true;
    }
};

template <class Epi, class Sched, bool ALIGN_EPI, bool SEG2 = false>
__device__ __forceinline__ void gemm_phase(LAS unsigned char* lds, const GemmDesc g, const unsigned (&voffA)[2], const unsigned (&voffB)[2], const Sched& S, Epi& E, int tid, unsigned long long* stp = nullptr, const unsigned* voffB2 = nullptr) {
    const int wid = __builtin_amdgcn_readfirstlane(tid >> 6), lane = tid & 63, wr = wid >> 2, wc = wid & 3, fr = lane & 15, fq = lane >> 4;
    const int nt = g.nt;
    const long kstepA = g.a_k, kstepB = g.b_k, hstepA = g.a_h, hstepB = g.b_h;
    const unsigned ldsw = (unsigned)wid * 1024u;
    const int aoff = lds_byte(wr * 64 + fr, fq * 8), boff = lds_byte(wc * 32 + fr, fq * 8);
#define PG8_SA(b, h) (((b) * 2 + (h)) * HTB)
#define PG8_SB(b, h) ((4 + (b) * 2 + (h)) * HTB)
#define PG8_STAGE(bufoff, gbase, voff) do { const char* _gb = (const char*)(gbase); asm volatile("" : "+s"(_gb));   _Pragma("unroll") for (int _i = 0; _i < 2; ++_i) \
        __builtin_amdgcn_global_load_lds((const unsigned*)(_gb + (voff)[_i]), (LAS unsigned*)(lds + (bufoff) + ldsw + _i * 8192), 16, 0, 0); } while (0)
#define PG8_LDA(dst, b, h) do { _Pragma("unroll") for (int m = 0; m < 4; ++m) _Pragma("unroll") for (int k = 0; k < 2; ++k) dst[m][k] = *(const LAS bf16x8*)(lds + PG8_SA(b, h) + aoff + m * 2048 + k * 1024); } while (0)
#define PG8_LDB(dst, b, h) do { _Pragma("unroll") for (int n = 0; n < 2; ++n) _Pragma("unroll") for (int k = 0; k < 2; ++k) dst[n][k] = *(const LAS bf16x8*)(lds + PG8_SB(b, h) + boff + n * 2048 + k * 1024); } while (0)
#define PG8_MMA(ai, bj, At, Bt) do { __builtin_amdgcn_s_setprio(1); _Pragma("unroll") for (int m = 0; m < 4; ++m) _Pragma("unroll") for (int n = 0; n < 2; ++n) _Pragma("unroll") for (int k = 0; k < 2; ++k) \
        acc[ai][bj][m][n] = __builtin_amdgcn_mfma_f32_16x16x32_bf16(Bt[n][k], At[m][k], acc[ai][bj][m][n], 0, 0, 0); __builtin_amdgcn_s_setprio(0); } while (0)
#define PG8_WAIT_V(n) asm volatile("s_waitcnt vmcnt(" #n ")" ::: "memory")
#define PG8_WAIT_L(n) asm volatile("s_waitcnt lgkmcnt(" #n ")" ::: "memory")
#define PG8_BAR __builtin_amdgcn_s_barrier()
#define PG8_SCHED __builtin_amdgcn_sched_barrier(0)
    Unit cur, nxt; int ui = 0;
    if (!S.next(0, cur)) return;
    f32x4 acc[2][2][4][2];
#pragma unroll
    for (int a = 0; a < 2; ++a)
#pragma unroll
        for (int b = 0; b < 2; ++b)
#pragma unroll
            for (int m = 0; m < 4; ++m)
#pragma unroll
                for (int n = 0; n < 2; ++n) acc[a][b][m][n] = (f32x4){0.f, 0.f, 0.f, 0.f};
    bf16x8 At[4][2], B0[2][2], B1[2][2];
    const char* cA = g.A + (long)cur.pm * g.a_pm + (long)cur.g * g.a_g; const char* cB = g.B + (long)cur.pn * g.b_pn + (long)cur.g * g.b_g;
    const char* cB2 = SEG2 ? g.B2 + (long)cur.pn * g.b2_pn + (long)cur.g * g.b2_g : nullptr;
    PG8_STAGE(PG8_SB(0, 0), cB, voffB); PG8_STAGE(PG8_SB(0, 1), cB + hstepB, voffB); PG8_STAGE(PG8_SA(0, 0), cA, voffA); PG8_STAGE(PG8_SA(0, 1), cA + hstepA, voffA);
    if (wr == 1) PG8_BAR;
    PG8_WAIT_V(2); PG8_BAR;
    PG8_STAGE(PG8_SB(1, 0), cB + kstepB, voffB); PG8_STAGE(PG8_SA(1, 0), cA + kstepA, voffA); PG8_STAGE(PG8_SB(1, 1), cB + hstepB + kstepB, voffB);
    PG8_WAIT_V(6); PG8_BAR;
    unsigned long long st_t0 = stp ? __builtin_amdgcn_s_memrealtime() : 0ull, st_loop = 0ull, st_epi = 0ull;
    for (;;) {
        const bool has_next = S.next(ui + 1, nxt);
        const char* nA = has_next ? g.A + (long)nxt.pm * g.a_pm + (long)nxt.g * g.a_g : cA; const char* nB = has_next ? g.B + (long)nxt.pn * g.b_pn + (long)nxt.g * g.b_g : cB;
        for (int t = 0; t < nt; t += 2) {
            const bool last = (t == nt - 2);
            const char* a1 = cA + (long)(t + 1) * kstepA;
            const bool sg = SEG2 && !last && (t + 2 >= g.tsw);
            const char* a2 = last ? nA : cA + (long)(t + 2) * kstepA; const char* b2 = last ? nB : (sg ? cB2 + (long)(t + 2 - g.tsw) * g.b2_k : cB + (long)(t + 2) * kstepB);
            const char* a3 = a2 + kstepA; const char* b3 = b2 + (sg ? g.b2_k : kstepB);
            const long hB = sg ? g.b2_h : hstepB;
            unsigned vbs[2]; vbs[0] = sg ? voffB2[0] : voffB[0]; vbs[1] = sg ? voffB2[1] : voffB[1];
            PG8_LDB(B0, 0, 0); PG8_LDB(B1, 0, 1); PG8_SCHED; PG8_LDA(At, 0, 0); PG8_STAGE(PG8_SA(1, 1), a1 + hstepA, voffA);
            PG8_WAIT_V(8); PG8_WAIT_L(0); PG8_BAR; PG8_MMA(0, 0, At, B0); PG8_MMA(0, 1, At, B1); PG8_BAR; PG8_SCHED;
            PG8_LDA(At, 0, 1); PG8_STAGE(PG8_SB(0, 0), b2, vbs); PG8_STAGE(PG8_SB(0, 1), b2 + hB, vbs); PG8_STAGE(PG8_SA(0, 0), a2, voffA);
            PG8_WAIT_V(8); PG8_WAIT_L(0); PG8_BAR; PG8_MMA(1, 0, At, B0); PG8_MMA(1, 1, At, B1); PG8_BAR; PG8_SCHED;
            PG8_LDB(B0, 1, 0); PG8_LDB(B1, 1, 1); PG8_SCHED; PG8_LDA(At, 1, 0); PG8_STAGE(PG8_SA(0, 1), a2 + hstepA, voffA);
            PG8_WAIT_V(8); PG8_WAIT_L(0); PG8_BAR; PG8_MMA(0, 0, At, B0); PG8_MMA(0, 1, At, B1); PG8_BAR; PG8_SCHED;
            PG8_LDA(At, 1, 1); PG8_STAGE(PG8_SB(1, 0), b3, vbs); PG8_STAGE(PG8_SB(1, 1), b3 + hB, vbs); PG8_STAGE(PG8_SA(1, 0), a3, voffA);
            PG8_WAIT_V(8); PG8_WAIT_L(0); PG8_BAR; PG8_MMA(1, 0, At, B0); PG8_MMA(1, 1, At, B1); PG8_BAR; PG8_SCHED;
            if constexpr (Epi::HAS_MID) { if (t + 2 == Epi::MID_T) E.mid(acc, wr, fr); }
        }
        if (stp) { const unsigned long long t1 = __builtin_amdgcn_s_memrealtime(); st_loop += t1 - st_t0; st_t0 = t1; }
        if constexpr (ALIGN_EPI) { if (wr == 0) PG8_BAR; }
        if constexpr (!Epi::AFTER_DRAIN) { E(acc, cur, wr, wc, fr, fq); }
        if (stp) { const unsigned long long t1 = __builtin_amdgcn_s_memrealtime(); st_epi += t1 - st_t0; st_t0 = t1; }
        if (!has_next) break;
#pragma unroll
        for (int a = 0; a < 2; ++a)
#pragma unroll
            for (int b = 0; b < 2; ++b)
#pragma unroll
                for (int m = 0; m < 4; ++m)
#pragma unroll
                    for (int n = 0; n < 2; ++n) acc[a][b][m][n] = (f32x4){0.f, 0.f, 0.f, 0.f};
        cur = nxt; cA = nA; cB = nB; ++ui; if constexpr (SEG2) cB2 = g.B2 + (long)cur.pn * g.b2_pn + (long)cur.g * g.b2_g;
        if constexpr (ALIGN_EPI) { if (wr == 1) PG8_BAR; }
    }
    PG8_WAIT_V(0);
    if constexpr (!ALIGN_EPI) { if (wr == 0) PG8_BAR; }
    PG8_BAR;
    if (stp) { const unsigned long long t1 = __builtin_amdgcn_s_memrealtime(); st_loop += t1 - st_t0; st_t0 = t1; }
    if constexpr (Epi::AFTER_DRAIN) { E.fused(acc, cur, wr, wc, fr, fq, lds, wid, lane); }
    if (stp) { const unsigned long long t1 = __builtin_amdgcn_s_memrealtime(); st_epi += t1 - st_t0; if (tid == 0) { stp[0] = st_loop; stp[1] = st_epi; } }
#undef PG8_SA
#undef PG8_SB
#undef PG8_STAGE
#undef PG8_LDA
#undef PG8_LDB
#undef PG8_MMA
#undef PG8_WAIT_V
#undef PG8_WAIT_L
#undef PG8_BAR
#undef PG8_SCHED
}

__device__ __forceinline__ void voff_std(unsigned (&v)[2], int ld, bool perm, int tid) {
#pragma unroll
    for (int i = 0; i < 2; ++i) { int R, C; stage_rc(tid * 16 + i * 8192, R, C); const int Rb = perm ? ((R & ~31) + perm32(R & 31)) : R; v[i] = (unsigned)(Rb * ld + C) * 2u; }
}

typedef f32x4 Acc[2][2][4][2];

struct EpiU {
    static constexpr bool PERM = true, AFTER_DRAIN = false, HAS_MID = false; static constexpr int MID_T = 0;
    const float* r0; bf16_t* upool; bf16_t* ussm;
    __device__ __forceinline__ void operator()(Acc& acc, const Unit& u, int wr, int wc, int fr, int fq) const {
#pragma unroll
        for (int ai = 0; ai < 2; ++ai)
#pragma unroll
            for (int m = 0; m < 4; ++m) {
                const int row = u.pm * BM + ai * HALF + wr * 64 + m * 16 + fr; const float rs = r0[row];
#pragma unroll
                for (int bj = 0; bj < 2; ++bj) {
                    const int c8 = u.pn * BM + bj * HALF + wc * 32 + 8 * fq;
                    const u32x4 w = pack8(acc[ai][bj][m][0] * rs, acc[ai][bj][m][1] * rs);
                    if (u.pn < 2) *(u32x4*)(upool + (size_t)row * DPOOL + c8) = w;
                    else { const int cs = c8 - DPOOL, gg = cs >> 4, h0 = cs & 15, cr = row / TCH, p = row % TCH;
                           *(u32x4*)(ussm + ((size_t)(gg * NCR + cr) * ROWLEN + 16 * p + h0)) = w; }
                }
            }
    }
};
struct EpiFG {
    static constexpr bool PERM = false, AFTER_DRAIN = false, HAS_MID = false; static constexpr int MID_T = 0;
    float* fg;
    __device__ __forceinline__ void operator()(Acc& acc, const Unit& u, int wr, int wc, int fr, int fq) const {
#pragma unroll
        for (int ai = 0; ai < 2; ++ai)
#pragma unroll
            for (int m = 0; m < 4; ++m) {
                const int cr = u.pm * BM + ai * HALF + wr * 64 + m * 16 + fr; float* rowp = fg + ((size_t)u.g * NCR + cr) * 256 + wc * 32 + 4 * fq;
#pragma unroll
                for (int bj = 0; bj < 2; ++bj)
#pragma unroll
                    for (int n = 0; n < 2; ++n) *(f32x4*)(rowp + bj * HALF + n * 16) = acc[ai][bj][m][n];
            }
    }
};
struct cf { float r, i; };
__device__ __forceinline__ cf cmul(cf a, cf b) { return cf{a.r * b.r - a.i * b.i, a.r * b.i + a.i * b.r}; }
__device__ __forceinline__ cf cmad(cf a, cf b, cf c) { return cf{a.r * b.r - a.i * b.i + c.r, a.r * b.i + a.i * b.r + c.i}; }
template <int CTRL> __device__ __forceinline__ float dppz(float v) { return __builtin_bit_cast(float, __builtin_amdgcn_update_dpp(0, __builtin_bit_cast(int, v), CTRL, 0xf, 0xf, true)); }
template <int CTRL> __device__ __forceinline__ cf cdpp(cf v) { return cf{dppz<CTRL>(v.r), dppz<CTRL>(v.i)}; }
struct EpiScan {
    static constexpr bool PERM = false, AFTER_DRAIN = true, HAS_MID = false; static constexpr int MID_T = 0;
    const float* lamT; bf16_t* ussm;
    __device__ __forceinline__ void fused(Acc& acc, const Unit& u, int wr, int wc, int fr, int fq, LAS unsigned char* lds, int wid, int lane) const {
        LAS float* SEG = (LAS float*)lds;
        cf X[2][2][2][2];
        LAS unsigned char* CIM = lds + 8192;
#pragma unroll
        for (int bj = 0; bj < 2; ++bj)
#pragma unroll
            for (int np = 0; np < 2; ++np) {
                const int n0 = 16 * wc + 8 * np + 2 * fq;
                const f32x4 l4 = *(const f32x4*)(lamT + ((size_t)(bj * NG + u.g) * NS + n0) * 2);
#pragma unroll
                for (int e = 0; e < 2; ++e) {
                    const cf lam{l4[2 * e], l4[2 * e + 1]};
                    const cf l2 = cmul(lam, lam), M1 = cmul(l2, l2), M2 = cmul(M1, M1), M4 = cmul(M2, M2), M8 = cmul(M4, M4);
#pragma unroll
                    for (int ai = 0; ai < 2; ++ai) {
                        cf T;
                        if (bj == 0) { T = cf{acc[ai][bj][0][np][2 * e], acc[ai][bj][0][np][2 * e + 1]};
#pragma unroll
                            for (int m = 1; m < 4; ++m) T = cmad(lam, T, cf{acc[ai][bj][m][np][2 * e], acc[ai][bj][m][np][2 * e + 1]});
                            T = cmad(M1, cdpp<0x111>(T), T); T = cmad(M2, cdpp<0x112>(T), T); T = cmad(M4, cdpp<0x114>(T), T); T = cmad(M8, cdpp<0x118>(T), T);
                            X[bj][ai][np][e] = cdpp<0x111>(T);
                            if (fr == 15) *(LAS f32x2*)(SEG + ((bj * 4 + 2 * ai + wr) * 64 + n0 + e) * 2) = (f32x2){T.r, T.i};
                        } else {       T = cf{acc[ai][bj][3][np][2 * e], acc[ai][bj][3][np][2 * e + 1]};
#pragma unroll
                            for (int m = 2; m >= 0; --m) T = cmad(lam, T, cf{acc[ai][bj][m][np][2 * e], acc[ai][bj][m][np][2 * e + 1]});
                            T = cmad(M1, cdpp<0x101>(T), T); T = cmad(M2, cdpp<0x102>(T), T); T = cmad(M4, cdpp<0x104>(T), T); T = cmad(M8, cdpp<0x108>(T), T);
                            X[bj][ai][np][e] = cdpp<0x101>(T);
                            if (fr == 0) *(LAS f32x2*)(SEG + ((bj * 4 + 2 * ai + wr) * 64 + n0 + e) * 2) = (f32x2){T.r, T.i};
                        }
                    }
                }
            }
        LDS_WAIT(); __builtin_amdgcn_s_barrier(); asm volatile("" ::: "memory");
#pragma unroll
        for (int bj = 0; bj < 2; ++bj)
#pragma unroll
            for (int np = 0; np < 2; ++np) {
                const int n0 = 16 * wc + 8 * np + 2 * fq;
                const f32x4 l4 = *(const f32x4*)(lamT + ((size_t)(bj * NG + u.g) * NS + n0) * 2);
                cf C[2][4][2];
#pragma unroll
                for (int e = 0; e < 2; ++e) {
                    const cf lam{l4[2 * e], l4[2 * e + 1]};
                    const cf l2 = cmul(lam, lam), M1 = cmul(l2, l2), M2 = cmul(M1, M1), M4 = cmul(M2, M2), M8 = cmul(M4, M4), Q = cmul(M8, M8);
                    const int ex = bj == 0 ? fr : 15 - fr;
                    cf Mx{1.f, 0.f};
                    if (ex & 1) Mx = cmul(Mx, M1); if (ex & 2) Mx = cmul(Mx, M2); if (ex & 4) Mx = cmul(Mx, M4); if (ex & 8) Mx = cmul(Mx, M8);
#pragma unroll
                    for (int ai = 0; ai < 2; ++ai) {
                        const int sg = 2 * ai + wr; cf G{0.f, 0.f};
                        if (bj == 0) {
#pragma unroll
                            for (int sp = 0; sp < 3; ++sp) if (sp < sg) { const f32x2 t = *(const LAS f32x2*)(SEG + ((bj * 4 + sp) * 64 + n0 + e) * 2); G = cmad(Q, G, cf{t.x, t.y}); }
                            cf c = cmad(Mx, G, X[bj][ai][np][e]); C[ai][0][e] = c;
#pragma unroll
                            for (int m = 1; m < 4; ++m) { c = cmad(lam, c, cf{acc[ai][bj][m - 1][np][2 * e], acc[ai][bj][m - 1][np][2 * e + 1]}); C[ai][m][e] = c; }
                        } else {
#pragma unroll
                            for (int sp = 3; sp > 0; --sp) if (sp > sg) { const f32x2 t = *(const LAS f32x2*)(SEG + ((bj * 4 + sp) * 64 + n0 + e) * 2); G = cmad(Q, G, cf{t.x, t.y}); }
                            cf c = cmad(Mx, G, X[bj][ai][np][e]); C[ai][3][e] = c;
#pragma unroll
                            for (int m = 2; m >= 0; --m) { c = cmad(lam, c, cf{acc[ai][bj][m + 1][np][2 * e], acc[ai][bj][m + 1][np][2 * e + 1]}); C[ai][m][e] = c; }
                        }
                    }
                }
#pragma unroll
                for (int ai = 0; ai < 2; ++ai)
#pragma unroll
                    for (int m = 0; m < 4; ++m) { const int c = 128 * ai + 64 * wr + 4 * fr + m;
                        u32x2 w; w.x = cvt_pk_bf16(C[ai][m][0].r, C[ai][m][0].i); w.y = cvt_pk_bf16(C[ai][m][1].r, C[ai][m][1].i);
                        *(LAS u32x2*)(CIM + c * 520 + (bj * 128 + 2 * n0) * 2) = w; }
            }
        LDS_WAIT(); __builtin_amdgcn_s_barrier(); asm volatile("" ::: "memory");
#pragma unroll 8
        for (int r = wid; r < 256; r += 8)
            *(u32x2*)(ussm + ((size_t)(u.g * NCR + u.pm * NCHB + r) * ROWLEN + K1) + 4 * lane) = *(const LAS u32x2*)(CIM + r * 520 + 8 * lane);
    }
};
struct EpiZ {
    static constexpr bool PERM = true, AFTER_DRAIN = false, HAS_MID = false; static constexpr int MID_T = 0;
    const bf16_t* ussm; const float* dvec; bf16_t* zg;
    __device__ __forceinline__ void operator()(Acc& acc, const Unit& u, int wr, int wc, int fr, int fq) const {
#pragma unroll
        for (int bj = 0; bj < 2; ++bj) {
            const int c8 = u.pn * BM + bj * HALF + wc * 32 + 8 * fq;
            const f32x4 d0 = *(const f32x4*)(dvec + u.g * 16 + (c8 & 15)), d1 = *(const f32x4*)(dvec + u.g * 16 + (c8 & 15) + 4);
#pragma unroll
            for (int ai = 0; ai < 2; ++ai)
#pragma unroll
                for (int m = 0; m < 4; ++m) {
                    const int cr = u.pm * BM + ai * HALF + wr * 64 + m * 16 + fr;
                    const u32x4 uw = *(const u32x4*)(ussm + ((size_t)(u.g * NCR + cr) * ROWLEN + c8));
                    f32x4 u0, u1; unpack8(uw, u0, u1);
                    f32x4 y0 = acc[ai][bj][m][0] + d0 * u0, y1 = acc[ai][bj][m][1] + d1 * u1;
#pragma unroll
                    for (int i = 0; i < 4; ++i) { y0[i] = fast_gelu_tanh(y0[i]); y1[i] = fast_gelu_tanh(y1[i]); }
                    *(u32x4*)(zg + ((size_t)u.g * MT * 16 + (size_t)cr * K1 + c8)) = pack8(y0, y1);
                }
        }
    }
};
struct EpiPool {
    static constexpr bool PERM = true, AFTER_DRAIN = false, HAS_MID = false; static constexpr int MID_T = 0;
    const float* pscale; bf16_t* ycat; float* ss;
    __device__ __forceinline__ void operator()(Acc& acc, const Unit& u, int wr, int wc, int fr, int fq) const {
        f32x4 sc[2][2];
#pragma unroll
        for (int bj = 0; bj < 2; ++bj) { const int c8 = u.pn * BM + bj * HALF + wc * 32 + 8 * fq; sc[bj][0] = *(const f32x4*)(pscale + c8); sc[bj][1] = *(const f32x4*)(pscale + c8 + 4); }
#pragma unroll
        for (int ai = 0; ai < 2; ++ai)
#pragma unroll
            for (int m = 0; m < 4; ++m) {
                const int row = u.pm * BM + ai * HALF + wr * 64 + m * 16 + fr; float q = 0.f;
#pragma unroll
                for (int bj = 0; bj < 2; ++bj) {
                    const int c8 = u.pn * BM + bj * HALF + wc * 32 + 8 * fq;
                    const f32x4 v0 = acc[ai][bj][m][0] * sc[bj][0], v1 = acc[ai][bj][m][1] * sc[bj][1];
                    q += (v0[0] * v0[0] + v0[1] * v0[1]) + (v0[2] * v0[2] + v0[3] * v0[3]) + (v1[0] * v1[0] + v1[1] * v1[1]) + (v1[2] * v1[2] + v1[3] * v1[3]);
                    *(u32x4*)(ycat + (size_t)row * DM + c8) = pack8(v0, v1);
                }
                q += __shfl_xor(q, 16); q += __shfl_xor(q, 32);
                if (fq == 0) ss[(size_t)(u.pn * 4 + wc) * MT + row] = q;
            }
    }
};
struct EpiGlu {
    static constexpr bool PERM = true, AFTER_DRAIN = false, HAS_MID = false; static constexpr int MID_T = 0;
    const float* gb; const bf16_t* zg; bf16_t* ycat; float* ss;
    __device__ __forceinline__ void operator()(Acc& acc, const Unit& u, int wr, int wc, int fr, int fq) const {
        f32x4 bv[2][2];
#pragma unroll
        for (int bj = 0; bj < 2; ++bj) { const int c8 = u.pn * BM + bj * HALF + wc * 32 + 8 * fq; bv[bj][0] = *(const f32x4*)(gb + c8); bv[bj][1] = *(const f32x4*)(gb + c8 + 4); }
#pragma unroll
        for (int ai = 0; ai < 2; ++ai)
#pragma unroll
            for (int m = 0; m < 4; ++m) {
                const int row = u.pm * BM + ai * HALF + wr * 64 + m * 16 + fr; float q = 0.f;
#pragma unroll
                for (int bj = 0; bj < 2; ++bj) {
                    const int c8 = u.pn * BM + bj * HALF + wc * 32 + 8 * fq;
                    const u32x4 zw = *(const u32x4*)(zg + ((size_t)(c8 >> 4) * MT + row) * 16 + (c8 & 15));
                    f32x4 z0, z1; unpack8(zw, z0, z1);
                    f32x4 v0 = acc[ai][bj][m][0] + bv[bj][0], v1 = acc[ai][bj][m][1] + bv[bj][1];
#pragma unroll
                    for (int i = 0; i < 4; ++i) { v0[i] = z0[i] * fast_sigmoid(v0[i]); v1[i] = z1[i] * fast_sigmoid(v1[i]); }
                    q += (v0[0] * v0[0] + v0[1] * v0[1]) + (v0[2] * v0[2] + v0[3] * v0[3]) + (v1[0] * v1[0] + v1[1] * v1[1]) + (v1[2] * v1[2] + v1[3] * v1[3]);
                    *(u32x4*)(ycat + (size_t)row * DM + DPOOL + c8) = pack8(v0, v1);
                }
                q += __shfl_xor(q, 16); q += __shfl_xor(q, 32);
                if (fq == 0) ss[(size_t)(u.pn * 4 + wc) * MT + row] = q;
            }
    }
};
struct EpiOut {
    static constexpr bool PERM = true, AFTER_DRAIN = true, HAS_MID = true; static constexpr int MID_T = 8;
    const float* x; bf16_t* h1b; float* ss; LAS f32x2* XR; float ratio[2][4];
    __device__ __forceinline__ void mid(Acc& acc, int wr, int fr) const {
#pragma unroll
        for (int ai = 0; ai < 2; ++ai)
#pragma unroll
            for (int m = 0; m < 4; ++m) { const float ratio = this->ratio[ai][m];
#pragma unroll
                for (int bj = 0; bj < 2; ++bj)
#pragma unroll
                    for (int n = 0; n < 2; ++n) acc[ai][bj][m][n] = acc[ai][bj][m][n] * ratio; }
    }
    __device__ __forceinline__ void fused(Acc& acc, const Unit& u, int wr, int wc, int fr, int fq, LAS unsigned char* lds, int wid, int lane) const {
        LAS float* P = (LAS float*)lds;
        const int col0 = u.pn * BM + wc * 32 + 8 * fq;
#pragma unroll
        for (int ai = 0; ai < 2; ++ai)
#pragma unroll
            for (int m = 0; m < 4; ++m) {
                const int lr = ai * HALF + wr * 64 + m * 16 + fr, row = u.pm * BM + lr; const float rs = XR[lr].y; float q = 0.f;
                const size_t prow = (size_t)(row >> 12) * PADROWS + 1 + (row & 4095);
#pragma unroll
                for (int bj = 0; bj < 2; ++bj) {
                    const int c = col0 + bj * HALF;
                    const f32x4 h0 = *(const f32x4*)(x + (size_t)row * DM + c) + acc[ai][bj][m][0] * rs, h1v = *(const f32x4*)(x + (size_t)row * DM + c + 4) + acc[ai][bj][m][1] * rs;
                    q += (h0[0] * h0[0] + h0[1] * h0[1]) + (h0[2] * h0[2] + h0[3] * h0[3]) + (h1v[0] * h1v[0] + h1v[1] * h1v[1]) + (h1v[2] * h1v[2] + h1v[3] * h1v[3]);
                    *(u32x4*)(h1b + prow * DM + c) = pack8(h0, h1v);
                }
                q += __shfl_xor(q, 16); q += __shfl_xor(q, 32);
                if (fq == 0) P[lr * 4 + wc] = q;
            }
        LDS_WAIT(); __builtin_amdgcn_s_barrier(); asm volatile("" ::: "memory");
        const int tid = wid * 64 + lane;
        if (tid < 256) ss[(size_t)u.pn * MT + u.pm * BM + tid] = (P[tid * 4 + 0] + P[tid * 4 + 1]) + (P[tid * 4 + 2] + P[tid * 4 + 3]);
    }
};
struct EpiUp {
    static constexpr bool PERM = true, AFTER_DRAIN = false, HAS_MID = false; static constexpr int MID_T = 0;
    const LAS float* rsl; const float* cw; const float* cb; bf16_t* act;
    __device__ __forceinline__ void operator()(Acc& acc, const Unit& u, int wr, int wc, int fr, int fq) const {
        const int j = u.pm, b = u.g;
#pragma unroll
        for (int ai = 0; ai < 2; ++ai)
#pragma unroll
            for (int m = 0; m < 4; ++m) {
                const float rs = rsl[u.aux * 256 + 126 * wr + 64 * ai + 4 * fr + m];
#pragma unroll
                for (int bj = 0; bj < 2; ++bj)
#pragma unroll
                    for (int n = 0; n < 2; ++n) acc[ai][bj][m][n] = acc[ai][bj][m][n] * rs;
            }
        const int f0 = 128 * u.pn + 32 * wc + 8 * fq;
        u32x2 keep[8];
#pragma unroll
        for (int n = 0; n < 2; ++n) {
            const int fc = f0 + 4 * n;
            const f32x4 wv0 = *(const f32x4*)(cw + fc), wv1 = *(const f32x4*)(cw + DFF2 + fc), wv2 = *(const f32x4*)(cw + 2 * DFF2 + fc), bvv = *(const f32x4*)(cb + fc);
            const f32x4 wg0 = *(const f32x4*)(cw + DFF + fc), wg1 = *(const f32x4*)(cw + DFF2 + DFF + fc), wg2 = *(const f32x4*)(cw + 2 * DFF2 + DFF + fc), bgv = *(const f32x4*)(cb + DFF + fc);
#pragma unroll
            for (int ai = 0; ai < 2; ++ai) {
                f32x4 pv, pg, nv, ng;
#pragma unroll
                for (int i = 0; i < 4; ++i) {
                    pv[i] = dpp_ror1(fr == 15 ? acc[ai ^ 1][0][3][n][i] : acc[ai][0][3][n][i]); pg[i] = dpp_ror1(fr == 15 ? acc[ai ^ 1][1][3][n][i] : acc[ai][1][3][n][i]);
                    nv[i] = dpp_ror15(fr == 0 ? acc[ai ^ 1][0][0][n][i] : acc[ai][0][0][n][i]); ng[i] = dpp_ror15(fr == 0 ? acc[ai ^ 1][1][0][n][i] : acc[ai][1][0][n][i]);
                }
#pragma unroll
                for (int m = 0; m < 4; ++m) {
                    const f32x4 cv = acc[ai][0][m][n], cg = acc[ai][1][m][n];
                    const f32x4 v_prev = m > 0 ? acc[ai][0][m - 1][n] : pv, g_prev = m > 0 ? acc[ai][1][m - 1][n] : pg;
                    const f32x4 v_next = m < 3 ? acc[ai][0][m + 1][n] : nv, g_next = m < 3 ? acc[ai][1][m + 1][n] : ng;
                    f32x4 o;
#pragma unroll
                    for (int i = 0; i < 4; ++i) {
                        const float vv = bvv[i] + wv0[i] * v_prev[i] + wv1[i] * cv[i] + wv2[i] * v_next[i];
                        const float gg = bgv[i] + wg0[i] * g_prev[i] + wg1[i] * cg[i] + wg2[i] * g_next[i];
                        o[i] = vv * gg * fast_sigmoid(gg);
                    }
                    const u32x2 pk = pack4(o); const int gi = ai * 4 + m;
                    if (n == 0) keep[gi] = pk;
                    else { const int w = 64 * ai + 4 * fr + m, t = UPROWS * j + 126 * wr + w - 1;
                           if (t >= 0 && t < SEQ && w >= 1 && w <= 126) { u32x4 wv; wv.x = keep[gi].x; wv.y = keep[gi].y; wv.z = pk.x; wv.w = pk.y; *(u32x4*)(act + (size_t)(b * SEQ + t) * DFF + f0) = wv; } }
                }
            }
        }
    }
};
struct EpiDown {
    static constexpr bool PERM = true, AFTER_DRAIN = true, HAS_MID = false; static constexpr int MID_T = 0;
    const bf16_t* h1b; float* out; const float* gfin; float* ss; const XcdBarrier* bar;
    __device__ __forceinline__ void fused(Acc& acc, const Unit& u, int wr, int wc, int fr, int fq, LAS unsigned char* lds, int wid, int lane) const {
        LAS float* P = (LAS float*)lds;
        LAS float* Sr = (LAS float*)(lds + 8192);
        const int col0 = u.pn * BM + wc * 32 + 8 * fq;
#pragma unroll
        for (int ai = 0; ai < 2; ++ai)
#pragma unroll
            for (int m = 0; m < 4; ++m) {
                const int lr = ai * HALF + wr * 64 + m * 16 + fr, row = u.pm * BM + lr; float q = 0.f;
                const size_t prow = (size_t)(row >> 12) * PADROWS + 1 + (row & 4095);
#pragma unroll
                for (int bj = 0; bj < 2; ++bj) {
                    f32x4 b0, b1; unpack8(*(const u32x4*)(h1b + prow * DM + col0 + bj * HALF), b0, b1);
                    const f32x4 h0 = b0 + acc[ai][bj][m][0], h1v = b1 + acc[ai][bj][m][1];
                    acc[ai][bj][m][0] = h0; acc[ai][bj][m][1] = h1v;
                    q += (h0[0] * h0[0] + h0[1] * h0[1]) + (h0[2] * h0[2] + h0[3] * h0[3]) + (h1v[0] * h1v[0] + h1v[1] * h1v[1]) + (h1v[2] * h1v[2] + h1v[3] * h1v[3]);
                }
                q += __shfl_xor(q, 16); q += __shfl_xor(q, 32);
                if (fq == 0) P[lr * 4 + wc] = q;
            }
        LDS_WAIT(); __builtin_amdgcn_s_barrier(); asm volatile("" ::: "memory");
        const int tid = wid * 64 + lane;
        if (tid < 256) ss[(size_t)u.pn * MT + u.pm * BM + tid] = (P[tid * 4 + 0] + P[tid * 4 + 1]) + (P[tid * 4 + 2] + P[tid * 4 + 3]);
        xcd_barrier(*bar, tid);
        if (tid < 256) { const int row = u.pm * BM + tid; const float s = (ss[row] + ss[MT + row]) + (ss[2 * MT + row] + ss[3 * MT + row]); Sr[tid] = rsqrtf(s * (1.0f / DM) + EPS); }
        LDS_WAIT(); __builtin_amdgcn_s_barrier(); asm volatile("" ::: "memory");
#pragma unroll
        for (int bj = 0; bj < 2; ++bj) {
            const int c = col0 + bj * HALF; const f32x4 g0 = *(const f32x4*)(gfin + c), g1 = *(const f32x4*)(gfin + c + 4);
#pragma unroll
            for (int ai = 0; ai < 2; ++ai)
#pragma unroll
                for (int m = 0; m < 4; ++m) { const int lr = ai * HALF + wr * 64 + m * 16 + fr; const float r = Sr[lr]; float* o = out + (size_t)(u.pm * BM + lr) * DM + c;
                    *(f32x4*)o = acc[ai][bj][m][0] * r * g0; *(f32x4*)(o + 4) = acc[ai][bj][m][1] * r * g1; }
        }
    }
};

struct OrdOne { Unit u; __device__ bool next(int i, Unit& o) const { if (i > 0) return false; o = u; return true; } };
struct OrdSsmA { int c; __device__ bool next(int i, Unit& u) const { if (i > 0 || c >= 64) return false; const int x = c & 7, k = c >> 3; u.g = x * 4 + (k >> 1); u.pm = k & 1; u.pn = 0; u.aux = 0; return true; } };
struct OrdSsmB { int c; __device__ bool next(int i, Unit& u) const { if (i > 0 || c >= 128) return false; const int x = c & 7, k = c >> 3; u.g = x * 4 + (k >> 2); u.pm = k & 3; u.pn = 0; u.aux = 0; return true; } };
struct OrdPool { int c; __device__ bool next(int i, Unit& u) const { if (i > 0 || c < 128 || c >= 256) return false; const int cc = c - 128, x = cc & 7, k = cc >> 3; u.pm = x * 8 + (k >> 1); u.pn = k & 1; u.g = u.pn; u.aux = 0; return true; } };
struct OrdGlu  { int c; __device__ bool next(int i, Unit& u) const { if (i > 0 || c >= 128) return false; const int x = c & 7, k = c >> 3; u.pm = x * 8 + (k >> 1); u.pn = k & 1; u.g = 0; u.aux = 0; return true; } };
struct OrdUp { StaticOrder so; __device__ bool next(int i, Unit& u) const { if (!so.next(i, u)) return false; u.g = u.pm / UPT; u.pm = u.pm % UPT; u.aux = i; return true; } };

constexpr size_t WS_STAMP = 4 * MiB;
#if defined(MK_STAMP)
#define ST(k) do { if (F.tid == 0) ((unsigned long long*)(args.ws + WS_STAMP))[blockIdx.x * 64 + (k)] = __builtin_amdgcn_s_memrealtime(); } while (0)
#define GP_STAMP(base) ((unsigned long long*)(args.ws + WS_STAMP) + blockIdx.x * 64 + (base))
#define STC(k) do { if (F.tid == 0) ((unsigned long long*)(args.ws + WS_STAMP))[blockIdx.x * 64 + (k)] = __builtin_amdgcn_s_memtime(); } while (0)
#else
#define STC(k) do { } while (0)
#define ST(k) do { } while (0)
#define GP_STAMP(base) ((unsigned long long*)nullptr)
#endif
struct Args { const float* in[24]; float* out; unsigned char* ws; int ph_lo, ph_hi; };

struct Frame { LAS unsigned char* lds; int tid, lane, wave, G, bx; };

struct TrMat { const float* W; int K, N; const float* kg0; const float* kg1; int ksplit; bf16_t* WT; int map; int nitems; };
__device__ __forceinline__ void tr_load(const TrMat& m0, const TrMat& m1, int item, int lane, f32x4 (&v)[8]) {
    const bool second = item >= m0.nitems; const TrMat& m = second ? m1 : m0; const int it = second ? item - m0.nitems : item;
    const int nblk = m.N / 32, kb = it / nblk, nb = it % nblk, k0 = 64 * kb, n0 = 32 * nb, r = lane >> 3, c4 = lane & 7;
#pragma unroll
    for (int i = 0; i < 8; ++i) v[i] = *(const f32x4*)(m.W + (size_t)(k0 + 8 * i + r) * m.N + n0 + 4 * c4);
}
__device__ __forceinline__ void tr_store(const TrMat& m0, const TrMat& m1, int item, int lane, const f32x4 (&v)[8], LAS float* scr) {
    const bool second = item >= m0.nitems; const TrMat& m = second ? m1 : m0; const int it = second ? item - m0.nitems : item;
    const int nblk = m.N / 32, kb = it / nblk, nb = it % nblk, k0 = 64 * kb, n0 = 32 * nb, r = lane >> 3, c4 = lane & 7;
#pragma unroll
    for (int i = 0; i < 8; ++i) { const int kk = 8 * i + r, k = k0 + kk; float gn = 1.f; if (m.kg0) gn = (k < m.ksplit ? m.kg0[k] : m.kg1[k - m.ksplit]);
        LAS float* d = scr + kk * 33 + 4 * c4; d[0] = v[i][0] * gn; d[1] = v[i][1] * gn; d[2] = v[i][2] * gn; d[3] = v[i][3] * gn; }
    LDS_WAIT(); asm volatile("" ::: "memory");
    const int c = lane & 7;
#pragma unroll
    for (int j = 0; j < 4; ++j) { const int n = (lane >> 3) + 8 * j; const LAS float* q = scr + (8 * c) * 33 + n;
        u32x4 o; o.x = pk2(q[0 * 33], q[1 * 33]); o.y = pk2(q[2 * 33], q[3 * 33]); o.z = pk2(q[4 * 33], q[5 * 33]); o.w = pk2(q[6 * 33], q[7 * 33]);
        int nr = n0 + n;
        if (m.map == 1) { const int bj = nr / DFF, rem = nr % DFF; nr = 256 * (rem >> 7) + 128 * bj + (rem & 127); }
        *(u32x4*)(m.WT + (size_t)nr * m.K + k0 + 8 * c) = o; }
    LDS_WAIT(); asm volatile("" ::: "memory");
}
__device__ __forceinline__ void tr_run(const TrMat& m0, const TrMat& m1, int first, int stride, int lane, LAS float* scr) {
    const int total = m0.nitems + m1.nitems; f32x4 va[8], vb[8];
    int it = first; if (it < total) tr_load(m0, m1, it, lane, va);
    while (it < total) {
        const int n1 = it + stride; if (n1 < total) tr_load(m0, m1, n1, lane, vb);
        tr_store(m0, m1, it, lane, va, scr);
        if (n1 >= total) break;
        const int n2 = n1 + stride; if (n2 < total) tr_load(m0, m1, n2, lane, va);
        tr_store(m0, m1, n1, lane, vb, scr);
        it = n2;
    }
}

struct SsmLds { LAS float* Bre; LAS float* Bim; LAS float* Cre; LAS float* Cim; LAS float* PAR; LAS float* Pc; LAS float* Kl; };
__device__ __forceinline__ SsmLds ssm_lds(const Frame& F) { SsmLds L; L.Bre = (LAS float*)(F.lds); L.Bim = L.Bre + 2048; L.Cre = L.Bim + 2048; L.Cim = L.Cre + 2048; L.PAR = L.Cim + 2048; L.Pc = L.PAR + 512; L.Kl = L.Pc + 1024; return L; }
__device__ __forceinline__ void ssm_stage(const Args& a, const Frame& F, const SsmLds& L, int g) {
    const float* lnar = a.in[5]; const float* aim = a.in[6]; const float* ldt = a.in[7];
    const float* bre = a.in[8]; const float* bim = a.in[9]; const float* cre = a.in[10]; const float* cim = a.in[11];
    const int tid = F.tid;
    for (int i = tid; i < 2048; i += 512) { const int dir = i >> 10, r = i & 1023;
        L.Bre[i] = bre[((size_t)(dir * NG + g)) * 1024 + r]; L.Bim[i] = bim[((size_t)(dir * NG + g)) * 1024 + r];
        L.Cre[i] = cre[((size_t)(dir * NG + g)) * 1024 + r]; L.Cim[i] = cim[((size_t)(dir * NG + g)) * 1024 + r]; }
    if (tid < 128) { const int dir = tid >> 6, n = tid & 63;
        const float dt = expf(ldt[dir * NG + g]); const float a_re = -expf(lnar[(dir * NG + g) * NS + n]), a_im = aim[(dir * NG + g) * NS + n];
        const float mag = expf(a_re * dt), ang = a_im * dt; const float lam_re = mag * cosf(ang), lam_im = mag * sinf(ang);
        const float den = a_re * a_re + a_im * a_im;
        L.PAR[tid * 4 + 0] = a_re * dt; L.PAR[tid * 4 + 1] = ang;
        L.PAR[tid * 4 + 2] = ((lam_re - 1.0f) * a_re + lam_im * a_im) / den; L.PAR[tid * 4 + 3] = (lam_im * a_re - (lam_re - 1.0f) * a_im) / den; }
    __syncthreads();
}
__device__ __forceinline__ void ssm_build_tb(const Args& a, const Frame& F, const SsmLds& L, int g, int lag0, int nl) {
    bf16_t* KC = (bf16_t*)(a.ws + WS_TB) + (size_t)g * (2 * TCH) * 256;
    bf16_t* TBC = (bf16_t*)(a.ws + WS_TBC) + (size_t)g * K1 * 256;
    const int tid = F.tid;
    { const int li = tid >> 7, dn = tid & 127, lag = lag0 + li; const float ad = L.PAR[dn * 4 + 0], ang = L.PAR[dn * 4 + 1], fr_ = L.PAR[dn * 4 + 2], fi_ = L.PAR[dn * 4 + 3];
      const float mg = expf((float)lag * ad); float sn, cs; sincosf((float)lag * ang, &sn, &cs); const float lr = mg * cs, lim = mg * sn;
      L.Pc[(li * 128 + dn) * 2 + 0] = lr * fr_ - lim * fi_; L.Pc[(li * 128 + dn) * 2 + 1] = lr * fi_ + lim * fr_; }
    __syncthreads();
    { const int li = F.wave >> 1, dir = F.wave & 1, i16 = F.lane & 15, kq = F.lane >> 4; f32x4 kacc = {0.f, 0.f, 0.f, 0.f};
#pragma unroll 8
      for (int kk0 = 0; kk0 < 128; kk0 += 4) { const int kk = kk0 + kq, n = kk >> 1; const bool im = (kk & 1) != 0;
          const float cr_ = L.Cre[dir * 1024 + i16 * 64 + n], ci_ = L.Cim[dir * 1024 + i16 * 64 + n], pr = L.Pc[(li * 128 + dir * 64 + n) * 2], pi = L.Pc[(li * 128 + dir * 64 + n) * 2 + 1];
          const float av = im ? -(cr_ * pi + ci_ * pr) : (cr_ * pr - ci_ * pi);
          const float bv = im ? L.Bim[dir * 1024 + n * 16 + i16] : L.Bre[dir * 1024 + n * 16 + i16];
          kacc = __builtin_amdgcn_mfma_f32_16x16x4f32(av, bv, kacc, 0, 0, 0); }
#pragma unroll
      for (int r = 0; r < 4; ++r) L.Kl[li * 512 + dir * 256 + (kq * 4 + r) * 16 + i16] = kacc[r]; }
    __syncthreads();
    { const int li = tid >> 7, dir = (tid >> 6) & 1, e4 = tid & 63, lag = lag0 + li;
      if (li < nl && !(lag == 0 && dir == 1)) {
          f32x4 v = *(const LAS f32x4*)(L.Kl + li * 512 + dir * 256 + 4 * e4);
          if (lag == 0) v = v + *(const LAS f32x4*)(L.Kl + li * 512 + 256 + 4 * e4);
          const int d = dir == 0 ? (TCH - 1) + lag : (TCH - 1) - lag; u32x2 w; w.x = pk2(v[0], v[1]); w.y = pk2(v[2], v[3]);
          *(u32x2*)(KC + (size_t)d * 256 + 4 * e4) = w; } }
    __syncthreads();
    { const int li = tid >> 7, dn = tid & 127, dir = dn >> 6, p = lag0 + li; const float ad = L.PAR[dn * 4 + 0], ang = L.PAR[dn * 4 + 1]; const float e = dir == 0 ? (float)(p + 1) : (float)(TCH - p);
      const float mg = expf(e * ad); float sn, cs; sincosf(e * ang, &sn, &cs); L.Pc[(li * 128 + dn) * 2 + 0] = mg * cs; L.Pc[(li * 128 + dn) * 2 + 1] = mg * sn; }
    __syncthreads();
    for (int li = 0; li < nl; ++li) {
        const int p = lag0 + li, h = tid >> 5, dir = (tid >> 4) & 1, n4 = tid & 15; float v[8];
#pragma unroll
        for (int e = 0; e < 4; ++e) { const int n = 4 * n4 + e; const float cr_ = L.Cre[dir * 1024 + h * 64 + n], ci_ = L.Cim[dir * 1024 + h * 64 + n], pr = L.Pc[(li * 128 + dir * 64 + n) * 2], pi = L.Pc[(li * 128 + dir * 64 + n) * 2 + 1];
            v[2 * e] = cr_ * pr - ci_ * pi; v[2 * e + 1] = -(cr_ * pi + ci_ * pr); }
        u32x4 w; w.x = pk2(v[0], v[1]); w.y = pk2(v[2], v[3]); w.z = pk2(v[4], v[5]); w.w = pk2(v[6], v[7]);
        *(u32x4*)(TBC + (size_t)(16 * p + h) * 256 + dir * 128 + 8 * n4) = w;
    }
    __syncthreads();
}
__device__ __forceinline__ void ssm_build_wab(const Args& a, const Frame& F, const SsmLds& L, int g, int jq) {
    bf16_t* WAB = (bf16_t*)(a.ws + WS_WAB) + (size_t)g * 256 * K1;
    const int tid = F.tid;
    if (jq == 0 && tid < 128) { const int dir = tid >> 6, n = tid & 63; const float ad = L.PAR[tid * 4 + 0], ang = L.PAR[tid * 4 + 1];
        const float mg = expf((float)TCH * ad); float sn, cs; sincosf((float)TCH * ang, &sn, &cs); *(f32x2*)((float*)(a.ws + WS_LAMT) + ((size_t)(dir * NG + g) * NS + n) * 2) = (f32x2){mg * cs, mg * sn}; }
    { const int li = tid >> 7, dn = tid & 127, dir = dn >> 6, q = 4 * jq + li; const float ad = L.PAR[dn * 4 + 0], ang = L.PAR[dn * 4 + 1], fr_ = L.PAR[dn * 4 + 2], fi_ = L.PAR[dn * 4 + 3]; const float e = dir == 0 ? (float)(TCH - 1 - q) : (float)q;
      const float mg = expf(e * ad); float sn, cs; sincosf(e * ang, &sn, &cs); const float lr = mg * cs, lim = mg * sn;
      L.Pc[(li * 128 + dn) * 2 + 0] = lr * fr_ - lim * fi_; L.Pc[(li * 128 + dn) * 2 + 1] = lr * fi_ + lim * fr_; }
    __syncthreads();
#pragma unroll
    for (int half = 0; half < 2; ++half) {
        const int li = 2 * half + (tid >> 8), q = 4 * jq + li, t2 = tid & 255, dir = t2 >> 7, n = (t2 >> 1) & 63, part = t2 & 1;
        const float pr = L.Pc[(li * 128 + dir * 64 + n) * 2], pi = L.Pc[(li * 128 + dir * 64 + n) * 2 + 1]; float v[16];
#pragma unroll
        for (int i = 0; i < 16; ++i) { const float br_ = L.Bre[dir * 1024 + n * 16 + i], bi_ = L.Bim[dir * 1024 + n * 16 + i]; v[i] = part == 0 ? (pr * br_ - pi * bi_) : (pr * bi_ + pi * br_); }
        u32x4 w0, w1; w0.x = pk2(v[0], v[1]); w0.y = pk2(v[2], v[3]); w0.z = pk2(v[4], v[5]); w0.w = pk2(v[6], v[7]); w1.x = pk2(v[8], v[9]); w1.y = pk2(v[10], v[11]); w1.z = pk2(v[12], v[13]); w1.w = pk2(v[14], v[15]);
        bf16_t* dst = WAB + (size_t)(dir * 128 + 2 * n + part) * K1 + 16 * q; *(u32x4*)dst = w0; *(u32x4*)(dst + 8) = w1;
    }
    __syncthreads();
}

__device__ __forceinline__ void p0_prologue(const Args& a, const Frame& F) {
    const float* x = a.in[0];
    { const SsmLds L = ssm_lds(F);
      for (int it = F.bx; it < NG * (TCH / 4); it += F.G) { ssm_stage(a, F, L, it / (TCH / 4)); ssm_build_wab(a, F, L, it / (TCH / 4), it % (TCH / 4)); } }
    __syncthreads();
    LAS float* scr = (LAS float*)(F.lds + F.wave * 16384);
    const int gw = F.bx * 8 + F.wave, NGW = F.G * 8;
    { const TrMat m0{a.in[2], DM, DM, a.in[1], a.in[1], DM, (bf16_t*)(a.ws + WS_WIN), 0, (DM / 64) * (DM / 32)}; const TrMat m1{nullptr, 0, 32, nullptr, nullptr, 0, nullptr, 0, 0};
      tr_run(m0, m1, gw, NGW, F.lane, scr); }
    { bf16_t* PW = (bf16_t*)(a.ws + WS_PW); const float* pw = a.in[3];
      for (int idx = F.bx * 512 + F.tid; idx < 2 * 256 * 256; idx += F.G * 512) { const int pn = idx >> 16, j = (idx >> 8) & 255, k = idx & 255;
          const float v = ((j >> 7) == (k >> 7)) ? pw[((size_t)(2 * pn + (j >> 7)) * 128 + (k & 127)) * 128 + (j & 127)] : 0.f; PW[idx] = (bf16_t)f2bf(v); } }
    { bf16_t* h1b = (bf16_t*)(a.ws + WS_H1B);
      for (int idx = F.bx * 512 + F.tid; idx < BATCH * 256 * (DM / 8); idx += F.G * 512) { const int b = idx / (256 * 128), r = (idx / 128) % 256, c = idx % 128; const int prow = b * PADROWS + (r == 0 ? 0 : 4096 + r);
          *(u32x4*)(h1b + (size_t)prow * DM + 8 * c) = (u32x4){0u, 0u, 0u, 0u}; } }
    { bf16_t* xb = (bf16_t*)(a.ws + WS_XB); float* r0 = (float*)(a.ws + WS_R0);
      for (int row = gw; row < MT; row += NGW) {
          const f32x4* xr = (const f32x4*)(x + (size_t)row * DM) + F.lane; f32x4 v[4]; float s = 0.f;
#pragma unroll
          for (int j = 0; j < 4; ++j) { v[j] = xr[64 * j]; s += (v[j][0] * v[j][0] + v[j][1] * v[j][1]) + (v[j][2] * v[j][2] + v[j][3] * v[j][3]); }
          s = wave_sum(s); if (F.lane == 0) r0[row] = rsqrtf(s * (1.0f / DM) + EPS);
          u32x2* o = (u32x2*)(xb + (size_t)row * DM) + F.lane;
#pragma unroll
          for (int j = 0; j < 4; ++j) o[64 * j] = pack4(v[j]);
      } }
}

__device__ __forceinline__ void p2_side(const Args& a, const Frame& F, int first_block) {
    const int nb = F.G - first_block, sb = F.bx - first_block;
    { const SsmLds L = ssm_lds(F);
      int id = (sb * (NG * TCH)) / nb; const int id_end = ((sb + 1) * (NG * TCH)) / nb; int staged = -1;
      while (id < id_end) {
          const int g = id / TCH, lag0 = id % TCH; int nl = TCH - lag0; if (nl > 4) nl = 4; if (nl > id_end - id) nl = id_end - id;
          if (g != staged) { ssm_stage(a, F, L, g); staged = g; }
          ssm_build_tb(a, F, L, g, lag0, nl); id += nl;
      } }
    __syncthreads();
    LAS float* scr = (LAS float*)(F.lds + F.wave * 16384);
    const TrMat m0{a.in[13], DSSM, DSSM, nullptr, nullptr, 0, (bf16_t*)(a.ws + WS_WGLU), 0, (DSSM / 64) * (DSSM / 32)}; const TrMat m1{nullptr, 0, 32, nullptr, nullptr, 0, nullptr, 0, 0};
    tr_run(m0, m1, sb * 8 + F.wave, nb * 8, F.lane, scr);
}
__device__ __forceinline__ void ssm_side(const Args& a, const Frame& F, int first_block) {
    const int nb = F.G - first_block, sb = F.bx - first_block;
    { const SsmLds L = ssm_lds(F);
      const int g = sb >> 2, lag0 = (sb & 3) * 4;
#if defined(MK_STAMP)
#define STS(k) do { if (F.tid == 0) ((unsigned long long*)(a.ws + WS_STAMP))[blockIdx.x * 64 + (k)] = __builtin_amdgcn_s_memrealtime(); } while (0)
#else
#define STS(k) do { } while (0)
#endif
      ssm_stage(a, F, L, g); STS(45); ssm_build_tb(a, F, L, g, lag0, 4); STS(46);
      VM_WAIT(); __syncthreads();
      if (F.tid == 0) { __builtin_amdgcn_fence(__ATOMIC_RELEASE, "agent"); asm volatile("s_waitcnt vmcnt(0)" ::: "memory");
          __hip_atomic_fetch_add((unsigned*)(a.ws + WS_CTL) + CW_TBCNT + 64 * g, 4u, __ATOMIC_RELAXED, __HIP_MEMORY_SCOPE_AGENT); } }
    __syncthreads();
#if defined(MK_STAMP)
    if (F.tid == 0) ((unsigned long long*)(a.ws + WS_STAMP))[blockIdx.x * 64 + 43] = __builtin_amdgcn_s_memrealtime();
#endif
    LAS float* scr = (LAS float*)(F.lds + F.wave * 16384);
    const TrMat m0{a.in[17], DM, DM, a.in[15], a.in[16], DPOOL, (bf16_t*)(a.ws + WS_WOUT), 0, (DM / 64) * (DM / 32)};
    const TrMat m1{a.in[13], DSSM, DSSM, nullptr, nullptr, 0, (bf16_t*)(a.ws + WS_WGLU), 0, (DSSM / 64) * (DSSM / 32)};
    tr_run(m0, m1, sb * 8 + F.wave, nb * 8, F.lane, scr);
    const TrMat m2{a.in[22], DFF, DM, nullptr, nullptr, 0, (bf16_t*)(a.ws + WS_WDOWN), 0, (DFF / 64) * (DM / 32)}; const TrMat m3{nullptr, 0, 32, nullptr, nullptr, 0, nullptr, 0, 0};
    tr_run(m2, m3, sb * 8 + F.wave, nb * 8, F.lane, scr);
}
__device__ __forceinline__ void tb_wait(const Args& a, const Frame& F, int g) {
    if (F.tid == 0) { unsigned* cnt = (unsigned*)(a.ws + WS_CTL) + CW_TBCNT + 64 * g; unsigned sp = 0;
        while (__hip_atomic_load(cnt, __ATOMIC_RELAXED, __HIP_MEMORY_SCOPE_AGENT) < (unsigned)TCH) { __builtin_amdgcn_s_sleep(2); if (++sp > (1u << 20)) break; }
        __builtin_amdgcn_fence(__ATOMIC_ACQUIRE, "agent"); asm volatile("s_waitcnt vmcnt(0)" ::: "memory"); }
    __syncthreads();
}
__device__ __forceinline__ void p3_side(const Args& a, const Frame& F, int first_block) {
    const int nb = F.G - first_block, sb = F.bx - first_block;
    LAS float* scr = (LAS float*)(F.lds + F.wave * 16384);
    const TrMat m0{a.in[17], DM, DM, a.in[15], a.in[16], DPOOL, (bf16_t*)(a.ws + WS_WOUT), 0, (DM / 64) * (DM / 32)}; const TrMat m1{nullptr, 0, 32, nullptr, nullptr, 0, nullptr, 0, 0};
    tr_run(m0, m1, sb * 8 + F.wave, nb * 8, F.lane, scr);
}
__device__ __forceinline__ void p4_side(const Args& a, const Frame& F, int first_block) {
    const int nb = F.G - first_block, sb = F.bx - first_block;
    LAS float* scr = (LAS float*)(F.lds + F.wave * 16384);
    const TrMat m0{a.in[19], DM, DFF2, a.in[18], a.in[18], DM, (bf16_t*)(a.ws + WS_WUP), 1, (DM / 64) * (DFF2 / 32)};
    const TrMat m1{nullptr, 0, 32, nullptr, nullptr, 0, nullptr, 0, 0};
    tr_run(m0, m1, sb * 8 + F.wave, nb * 8, F.lane, scr);
}

__device__ __forceinline__ void p2_pooled(const Args& a, const Frame& F, int first_block) {
    const bf16_t* up = (const bf16_t*)(a.ws + WS_UPOOL); bf16_t* po = (bf16_t*)(a.ws + WS_POOLED);
    const int gw = (F.bx - first_block) * 8 + F.wave, NGW = (F.G - first_block) * 8;
    const int c0 = 8 * F.lane, half = 1 << (F.lane >> 4);
    for (int blk = gw; blk < MT / 4; blk += NGW) {
        const int row0 = blk * 4, b = row0 / SEQ, t0 = row0 % SEQ;
        u32x4 w[19];
#pragma unroll
        for (int o = 0; o < 19; ++o) { int q = t0 + o - 8; q = q < 0 ? 0 : (q >= SEQ ? SEQ - 1 : q); w[o] = *(const u32x4*)(up + (size_t)(b * SEQ + q) * DPOOL + c0); }
#pragma unroll
        for (int r = 0; r < 4; ++r) {
            f32x4 s0 = {0.f, 0.f, 0.f, 0.f}, s1 = {0.f, 0.f, 0.f, 0.f}; float cnt = 0.f;
#pragma unroll
            for (int d = -8; d < 8; ++d) { const int q = t0 + r + d; const float m = (d >= -half && d < half && q >= 0 && q < SEQ) ? 1.f : 0.f; f32x4 a0, a1; unpack8(w[r + d + 8], a0, a1); s0 = s0 + a0 * m; s1 = s1 + a1 * m; cnt += m; }
            f32x4 c0v, c1v; unpack8(w[r + 8], c0v, c1v);
            const float inv = __builtin_amdgcn_rcpf(cnt);
            *(u32x4*)(po + (size_t)(row0 + r) * DPOOL + c0) = pack8(s0 * inv - c0v, s1 * inv - c1v);
        }
    }
}

__device__ __forceinline__ void p3_carries(const Args& a, const Frame& F, int g, int b) {
    static_assert(NCHB == 256, "8 segments of 32 chunks");
    LAS float* TOT = (LAS float*)(F.lds);
    const int seg = F.tid >> 6, n = F.tid & 63;
    for (int dir = 0; dir < 2; ++dir) {
        const float dt = expf(a.in[7][dir * NG + g]); const float a_re = -expf(a.in[5][(dir * NG + g) * NS + n]), a_im = a.in[6][(dir * NG + g) * NS + n];
        const float mg = expf((float)TCH * (a_re * dt)); float sn, cs; sincosf((float)TCH * (a_im * dt), &sn, &cs); const float lr = mg * cs, li = mg * sn;
        const float* fg = (const float*)(a.ws + WS_FG) + ((size_t)g * NCR + (size_t)b * NCHB) * 256 + dir * 128 + 2 * n;
        bf16_t* us = (bf16_t*)(a.ws + WS_USSM) + ((size_t)g * NCR + (size_t)b * NCHB) * ROWLEN + K1 + dir * 128 + 2 * n;
        f32x2 f[32];
#pragma unroll
        for (int k = 0; k < 32; ++k) { const int i = 32 * seg + k, c = dir == 0 ? i : NCHB - 1 - i; f[k] = *(const f32x2*)(fg + (size_t)c * 256); }
        float sr = 0.f, si = 0.f;
#pragma unroll
        for (int k = 0; k < 32; ++k) { const float nr = lr * sr - li * si + f[k].x, ni = lr * si + li * sr + f[k].y; sr = nr; si = ni; }
        TOT[F.tid * 2] = sr; TOT[F.tid * 2 + 1] = si;
        float pr = lr, pi = li;
#pragma unroll
        for (int q = 0; q < 5; ++q) { const float nr = pr * pr - pi * pi, ni = 2.f * pr * pi; pr = nr; pi = ni; }
        __syncthreads();
        sr = 0.f; si = 0.f;
        for (int s2 = 0; s2 < seg; ++s2) { const int o = (s2 * 64 + n) * 2; const float tr = TOT[o], ti = TOT[o + 1]; const float nr = pr * sr - pi * si + tr, ni = pr * si + pi * sr + ti; sr = nr; si = ni; }
#pragma unroll
        for (int k = 0; k < 32; ++k) { const int i = 32 * seg + k, c = dir == 0 ? i : NCHB - 1 - i;
            *(unsigned*)(us + (size_t)c * ROWLEN) = pk2(sr, si);
            const float nr = lr * sr - li * si + f[k].x, ni = lr * si + li * sr + f[k].y; sr = nr; si = ni; }
        __syncthreads();
    }
    VM_WAIT(); __syncthreads();
}

__global__ void __launch_bounds__(512, 2) mk_fwd(Args args) {
    extern __shared__ __attribute__((aligned(16))) unsigned char lds_raw[];
    Frame F; F.lds = (LAS unsigned char*)lds_raw; F.tid = threadIdx.x; F.lane = F.tid & 63; F.wave = __builtin_amdgcn_readfirstlane(F.tid >> 6); F.G = gridDim.x; F.bx = blockIdx.x;
    volatile LAS unsigned* MISC = (volatile LAS unsigned*)(F.lds + LDSCTL_OFF);
    for (int u = F.tid; u < (LDS_BYTES - LDSCTL_OFF) / 4; u += 512) ((LAS unsigned*)(F.lds + LDSCTL_OFF))[u] = 0u;
    __syncthreads();
    unsigned char* ws = args.ws;
    XcdBarrier bar = xcd_barrier_post((unsigned*)(ws + WS_CTL), MISC + 8);
    const int lo = args.ph_lo, hi = args.ph_hi;
#define IN(k) (lo <= (k) && (k) < hi)
#define BOTH(k) (IN(k) && IN((k) == 2 ? 4 : (k) + 1))
    if (IN(0)) { ST(0); p0_prologue(args, F); ST(1); if (BOTH(0)) xcd_barrier(bar, F.tid); }
    if (IN(1)) { F.lane = lane_id_fresh(); F.tid = F.wave * 64 + F.lane; ST(2);
        GemmDesc g{(const char*)(ws + WS_XB), (const char*)(ws + WS_WIN), 256L * DM * 2, 0, 256L * DM * 2, 0, 128L * DM * 2, 128L * DM * 2, 128, 128, DM / BK};
        unsigned vA[2], vB[2]; voff_std(vA, DM, false, F.tid); voff_std(vB, DM, true, F.tid);
        StaticOrder S; S.init(MT / BM, DM / BM, F.G, F.bx);
        EpiU E{(const float*)(ws + WS_R0), (bf16_t*)(ws + WS_UPOOL), (bf16_t*)(ws + WS_USSM)};
        gemm_phase<EpiU, StaticOrder, true>(F.lds, g, vA, vB, S, E, F.tid, GP_STAMP(22));
        ST(3);
        if (BOTH(1)) xcd_barrier(bar, F.tid);
#if defined(MK_EXTRA_BAR)
        for (int rep = 0; rep < MK_EXTRA_BAR; ++rep) xcd_barrier(bar, F.tid);
#endif
    }
    if (IN(2)) { F.lane = lane_id_fresh(); F.tid = F.wave * 64 + F.lane; ST(4);
        if (F.bx < 128) {
            OrdSsmB S0{F.bx}; Unit u0; S0.next(0, u0);
            { GemmDesc g{(const char*)(ws + WS_USSM), (const char*)(ws + WS_WAB), 256L * ROWLEN * 2, (long)NCR * ROWLEN * 2, 0, 256L * K1 * 2, 128L * ROWLEN * 2, 128L * K1 * 2, 128, 128, K1 / BK};
              unsigned vA[2], vB[2]; voff_std(vB, K1, false, F.tid);
#pragma unroll
              for (int i = 0; i < 2; ++i) { int R, C; stage_rc(F.tid * 16 + i * 8192, R, C);
                  vA[i] = (unsigned)(((64 * (R >> 6) + 4 * (R & 15) + ((R >> 4) & 3)) * ROWLEN + C) * 2); }
              OrdOne S{u0}; EpiScan E{(const float*)(ws + WS_LAMT), (bf16_t*)(ws + WS_USSM)};
              gemm_phase<EpiScan, OrdOne, false>(F.lds, g, vA, vB, S, E, F.tid, GP_STAMP(24)); }
            VM_WAIT(); __syncthreads(); ST(40); ST(41);
            tb_wait(args, F, u0.g); ST(42);
            F.lane = lane_id_fresh(); F.tid = F.wave * 64 + F.lane;
            { GemmDesc g{(const char*)(ws + WS_USSM), (const char*)(ws + WS_TB), 256L * ROWLEN * 2, (long)NCR * ROWLEN * 2, 0, (2L * TCH) * 512, 128L * ROWLEN * 2, 8L * 512, 128, -4L * 512, ROWLEN / BK,
                         (const char*)(ws + WS_TBC), 0, (long)K1 * 512, 128L * 512, 128, K1 / BK};
              unsigned vA[2], vB[2], vB2[2]; voff_std(vA, ROWLEN, false, F.tid); voff_std(vB2, 256, true, F.tid);
#pragma unroll
              for (int i = 0; i < 2; ++i) { int R, C; stage_rc(F.tid * 16 + i * 8192, R, C); const int Rb = (R & ~31) + perm32(R & 31);
                  vB[i] = (unsigned)((((Rb >> 4) - (C >> 4) + (TCH - 1)) * 256 + (Rb & 15) * 16 + (C & 15)) * 2); }
              asm volatile("" : "+v"(vA[0]), "+v"(vA[1]), "+v"(vB[0]), "+v"(vB[1]), "+v"(vB2[0]), "+v"(vB2[1]));
              OrdOne S{u0}; EpiZ E{(const bf16_t*)(ws + WS_USSM), args.in[12], (bf16_t*)(ws + WS_ZG)};
              gemm_phase<EpiZ, OrdOne, true, true>(F.lds, g, vA, vB, S, E, F.tid, GP_STAMP(26), vB2); }
        } else { ssm_side(args, F, 128); ST(44); p2_pooled(args, F, 128); }
        ST(5);
        if (BOTH(2)) xcd_barrier(bar, F.tid);
    }
    if (IN(4)) { F.lane = lane_id_fresh(); F.tid = F.wave * 64 + F.lane; ST(8);
        if (F.bx < 128) {
            constexpr long GSTR = (long)MT * 32;
            GemmDesc g{(const char*)(ws + WS_ZG), (const char*)(ws + WS_WGLU), 256L * 32, 0, 256L * DSSM * 2, 0, 128L * 32, 128L * DSSM * 2, 4 * GSTR, 128, DSSM / BK};
            unsigned vA[2], vB[2]; voff_std(vB, DSSM, true, F.tid);
#pragma unroll
            for (int i = 0; i < 2; ++i) { int R, C; stage_rc(F.tid * 16 + i * 8192, R, C); vA[i] = (unsigned)(R * 32 + (C >> 4) * (int)GSTR + (C & 15) * 2); }
            OrdGlu S{F.bx}; EpiGlu E{args.in[14], (const bf16_t*)(ws + WS_ZG), (bf16_t*)(ws + WS_YCAT), (float*)(ws + WS_SSSSM)};
            gemm_phase<EpiGlu, OrdGlu, true>(F.lds, g, vA, vB, S, E, F.tid, GP_STAMP(28));
        } else {
            GemmDesc g{(const char*)(ws + WS_POOLED), (const char*)(ws + WS_PW), 256L * DPOOL * 2, 256L * 2, 256L * 256 * 2, 0, 128L * DPOOL * 2, 128L * 256 * 2, 128, 128, 256 / BK};
            unsigned vA[2], vB[2]; voff_std(vA, DPOOL, false, F.tid); voff_std(vB, 256, true, F.tid);
            OrdPool S{F.bx}; EpiPool E{args.in[4], (bf16_t*)(ws + WS_YCAT), (float*)(ws + WS_SSPOOL)};
            gemm_phase<EpiPool, OrdPool, true>(F.lds, g, vA, vB, S, E, F.tid, GP_STAMP(36));

            __syncthreads();
            p4_side(args, F, 128);
        }
        ST(9);
        if (BOTH(4)) xcd_barrier(bar, F.tid);
    }
    if (IN(5)) { F.lane = lane_id_fresh(); F.tid = F.wave * 64 + F.lane; ST(10);
        StaticOrder S; S.init(MT / BM, DM / BM, F.G, F.bx); Unit u0;
        LAS f32x2* XR = (LAS f32x2*)(F.lds + XTRA_OFF);
        if (S.next(0, u0)) {
            if (F.tid < 256) { const int row = u0.pm * BM + F.tid; const float* sp = (const float*)(ws + WS_SSPOOL); const float* sm = (const float*)(ws + WS_SSSSM); float a0 = 0.f, a1 = 0.f;
#pragma unroll
                for (int s = 0; s < 8; ++s) { a0 += sp[(size_t)s * MT + row]; a1 += sm[(size_t)s * MT + row]; }
                const float rp = rsqrtf(a0 * (1.0f / DPOOL) + EPS), rsm = rsqrtf(a1 * (1.0f / DSSM) + EPS); XR[F.tid] = (f32x2){rp / rsm, rsm}; }
        }
        __syncthreads();
        GemmDesc g{(const char*)(ws + WS_YCAT), (const char*)(ws + WS_WOUT), 256L * DM * 2, 0, 256L * DM * 2, 0, 128L * DM * 2, 128L * DM * 2, 128, 128, DM / BK};
        unsigned vA[2], vB[2]; voff_std(vA, DM, false, F.tid); voff_std(vB, DM, true, F.tid);
        EpiOut E{args.in[0], (bf16_t*)(ws + WS_H1B), (float*)(ws + WS_SSH1), XR, {{0.f, 0.f, 0.f, 0.f}, {0.f, 0.f, 0.f, 0.f}}};
        { const int wr_ = F.wave >> 2, fr_ = F.lane & 15;
#pragma unroll
          for (int ai = 0; ai < 2; ++ai)
#pragma unroll
              for (int m = 0; m < 4; ++m) E.ratio[ai][m] = XR[ai * HALF + wr_ * 64 + m * 16 + fr_].x; }
        gemm_phase<EpiOut, StaticOrder, false>(F.lds, g, vA, vB, S, E, F.tid, GP_STAMP(30));
        ST(11);
        if (BOTH(5)) xcd_barrier(bar, F.tid);
    }
    if (IN(6)) { F.lane = lane_id_fresh(); F.tid = F.wave * 64 + F.lane; ST(12);
        GemmDesc g{(const char*)(ws + WS_H1B), (const char*)(ws + WS_WUP), (long)UPROWS * DM * 2, (long)PADROWS * DM * 2, 256L * DM * 2, 0, 64L * DM * 2, 128L * DM * 2, 128, 128, DM / BK};
        unsigned vA[2], vB[2]; voff_std(vB, DM, true, F.tid);
#pragma unroll
        for (int i = 0; i < 2; ++i) { int R, C; stage_rc(F.tid * 16 + i * 8192, R, C); vA[i] = (unsigned)(((126 * (R >> 6) + 4 * (R & 15) + ((R >> 4) & 3)) * DM + C) * 2); }
        OrdUp S; S.so.init(BATCH * UPT, DFF2 / BM, F.G, F.bx);
        LAS float* RSL = (LAS float*)(F.lds + XTRA_OFF);
        if (F.tid < 256) { const float* ssh1 = (const float*)(ws + WS_SSH1);
#pragma unroll
            for (int i = 0; i < 6; ++i) { Unit uu; if (S.next(i, uu)) { const int t = UPROWS * uu.pm + F.tid - 1; const bool in = (t >= 0 && t < SEQ && F.tid < 254); const int tok = uu.g * SEQ + (in ? t : 0);
                const float sq = (ssh1[tok] + ssh1[MT + tok]) + (ssh1[2 * MT + tok] + ssh1[3 * MT + tok]); RSL[i * 256 + F.tid] = in ? rsqrtf(sq * (1.0f / DM) + EPS) : 0.f; } } }
        __syncthreads();
        EpiUp E{RSL, args.in[20], args.in[21], (bf16_t*)(ws + WS_ACT)};
        STC(50); ST(52);
#if defined(EXP_P6_NOALIGN)
        gemm_phase<EpiUp, OrdUp, false>(F.lds, g, vA, vB, S, E, F.tid, GP_STAMP(32));
#else
        gemm_phase<EpiUp, OrdUp, true>(F.lds, g, vA, vB, S, E, F.tid, GP_STAMP(32));
#endif
        STC(51); ST(53);
        ST(13);
        if (BOTH(6)) xcd_barrier(bar, F.tid);
    }
    if (IN(7)) { F.lane = lane_id_fresh(); F.tid = F.wave * 64 + F.lane; ST(14);
        GemmDesc g{(const char*)(ws + WS_ACT), (const char*)(ws + WS_WDOWN), 256L * DFF * 2, 0, 256L * DFF * 2, 0, 128L * DFF * 2, 128L * DFF * 2, 128, 128, DFF / BK};
        unsigned vA[2], vB[2]; voff_std(vA, DFF, false, F.tid); voff_std(vB, DFF, true, F.tid);
        StaticOrder S; S.init(MT / BM, DM / BM, F.G, F.bx);
        EpiDown E{(const bf16_t*)(ws + WS_H1B), args.out, args.in[23], (float*)(ws + WS_SSH2), &bar};
        STC(54); ST(56);
        gemm_phase<EpiDown, StaticOrder, false>(F.lds, g, vA, vB, S, E, F.tid, GP_STAMP(34)); ST(15); STC(55); ST(57);
    }
#undef IN
#undef BOTH
}
}

__global__ void k_cvt_u(const bf16_t* __restrict__ upool, const bf16_t* __restrict__ ussm, float* __restrict__ u) {
    const int idx = blockIdx.x * blockDim.x + threadIdx.x; if (idx >= MT * DM) return;
    const int c = idx % DM, row = idx / DM; unsigned short v;
    if (c < DPOOL) v = upool[(size_t)row * DPOOL + c];
    else { const int cs = c - DPOOL, g = cs >> 4, h = cs & 15, cr = row / mk::TCH, p = row % mk::TCH; v = ussm[((size_t)(g * mk::NCR + cr)) * mk::ROWLEN + 16 * p + h]; }
    u[idx] = __builtin_bit_cast(float, (unsigned)v << 16);
}
__global__ void k_cvt_z(const bf16_t* __restrict__ zg, float* __restrict__ z) {
    const int idx = blockIdx.x * blockDim.x + threadIdx.x; if (idx >= MT * DSSM) return;
    const int c = idx % DSSM, row = idx / DSSM; const unsigned short v = zg[((size_t)(c >> 4) * MT + row) * 16 + (c & 15)];
    z[idx] = __builtin_bit_cast(float, (unsigned)v << 16);
}
__global__ void k_cvt_rows(const bf16_t* __restrict__ src, int lds_, float* __restrict__ dst, int ldd, int cols, int rows) {
    const size_t idx = (size_t)blockIdx.x * blockDim.x + threadIdx.x; if (idx >= (size_t)rows * cols) return;
    const int c = (int)(idx % cols); const size_t row = idx / cols; dst[row * ldd + c] = __builtin_bit_cast(float, (unsigned)src[row * lds_ + c] << 16);
}

#if defined(MK_STAMP)
__device__ float stamp_sel(const unsigned long long* st, int ia, int ib, int b0, int b1, int mode) {
    double acc = mode == 1 ? 1e30 : 0.0;
    for (int b = b0; b < b1; ++b) { const double d = (double)(long long)(st[b * 64 + ib] - (ia < 0 ? 0ull : st[b * 64 + ia])) * 0.01;
        if (mode == 3) { const double cyc = (double)(long long)(st[b * 64 + ib] - st[b * 64 + ia]), tk = (double)(long long)(st[b * 64 + ib + 2] - st[b * 64 + ia + 2]); acc += (cyc / tk) * 0.1 / (b1 - b0); }
        else if (mode == 0) acc = d > acc ? d : acc; else if (mode == 1) acc = d < acc ? d : acc; else acc += d / (b1 - b0); }
    return (float)acc;
}
__global__ void k_stamp_report(const unsigned long long* st, float* out, int a_ia, int a_ib, int a_b0, int a_b1, int a_mode, float scale) {
    if (blockIdx.x == 0 && threadIdx.x == 0) out[0] += stamp_sel(st, a_ia, a_ib, a_b0, a_b1, a_mode) * scale;
}
#endif

#ifndef MK_CUT
#define MK_CUT 8
#endif
static void gemm(hipStream_t s, const float* A, int lda, const float* B, int ldb, float* C, int ldc, const float* R, int ldr, int M, int N, int K) {
    hipLaunchKernelGGL(k_gemm, dim3(N / 128, M / 128), dim3(256), 0, s, A, lda, B, ldb, C, ldc, R, ldr, K);
}

extern "C" void kernel_launch(void* const* d_in, const int* in_sizes, int n_in, void* d_out, int out_size, void* d_ws, size_t ws_size, hipStream_t stream) {
    static int grid = 0;
    if (grid == 0) {
        int dev = 0, cus = 0, per_cu = 0;
        if (n_in != 24 || out_size != MT * DM || ws_size < mk::WS_END) { fprintf(stderr, "kernel_launch: unexpected problem (n_in %d out %d ws %zu)\n", n_in, out_size, ws_size); grid = -1; return; }
        if (hipGetDevice(&dev) != hipSuccess || hipDeviceGetAttribute(&cus, hipDeviceAttributeMultiprocessorCount, dev) != hipSuccess) { grid = -1; return; }
        if (hipFuncSetAttribute((const void*)mk::mk_fwd, hipFuncAttributeMaxDynamicSharedMemorySize, mk::LDS_BYTES) != hipSuccess) { fprintf(stderr, "kernel_launch: hipFuncSetAttribute failed\n"); grid = -1; return; }
        if (hipOccupancyMaxActiveBlocksPerMultiprocessor(&per_cu, (const void*)mk::mk_fwd, 512, mk::LDS_BYTES) != hipSuccess || per_cu < 1) { fprintf(stderr, "kernel_launch: occupancy query says %d blocks/CU\n", per_cu); }
        (void)hipGetLastError();
        grid = cus;
        if (grid != 256) { fprintf(stderr, "kernel_launch: built for a 256-CU device, found %d CUs\n", cus); grid = -1; return; }
    }
    if (grid < 0) return;
    const float* x = (const float*)d_in[0];
    const float* pool_w = (const float*)d_in[3];   const float* pool_scale = (const float*)d_in[4];
    const float* lnar = (const float*)d_in[5];     const float* aim = (const float*)d_in[6];   const float* ldt = (const float*)d_in[7];
    const float* bre = (const float*)d_in[8];      const float* bim = (const float*)d_in[9];
    const float* cre = (const float*)d_in[10];     const float* cim = (const float*)d_in[11];
    const float* ssm_d = (const float*)d_in[12];   const float* glu_w = (const float*)d_in[13]; const float* glu_b = (const float*)d_in[14];
    const float* g_pool = (const float*)d_in[15];  const float* g_ssm = (const float*)d_in[16];
    const float* w_out = (const float*)d_in[17];   const float* g_ffn = (const float*)d_in[18];
    const float* w_up = (const float*)d_in[19];    const float* conv_w = (const float*)d_in[20]; const float* conv_b = (const float*)d_in[21];
    const float* w_down = (const float*)d_in[22];  const float* g_final = (const float*)d_in[23];
    float* out = (float*)d_out; char* ws = (char*)d_ws; const size_t MiB = 1u << 20; const int EB = 256;
    (void)x; (void)pool_w; (void)pool_scale; (void)lnar; (void)aim; (void)ldt; (void)bre; (void)bim; (void)cre; (void)cim; (void)ssm_d; (void)glu_w; (void)glu_b; (void)g_pool; (void)g_ssm; (void)w_out; (void)g_ffn; (void)w_up; (void)conv_w; (void)conv_b; (void)w_down; (void)g_final;

    (void)hipMemsetAsync(ws + mk::WS_CTL, 0, mk::CTL_ZERO_BYTES, stream);
#if defined(MK_EXTRA_MEMSET)
    for (int r = 0; r < MK_EXTRA_MEMSET; ++r) (void)hipMemsetAsync(ws + 5 * MiB + r * 65536, 0, 65536, stream);
#endif
    mk::Args a{};
    for (int i = 0; i < 24; ++i) a.in[i] = (const float*)d_in[i];
    a.out = out; a.ws = (unsigned char*)d_ws; a.ph_lo = 0; a.ph_hi = MK_CUT;
#if defined(MK_PROBE_LO)
    a.ph_lo = 0; a.ph_hi = MK_PROBE_HI; hipLaunchKernelGGL(mk::mk_fwd, dim3(grid), dim3(512), mk::LDS_BYTES, stream, a);
    for (int r = 0; r < MK_PROBE_REP; ++r) { (void)hipMemsetAsync(ws + mk::WS_CTL, 0, mk::CTL_ZERO_BYTES, stream); a.ph_lo = MK_PROBE_LO; a.ph_hi = MK_PROBE_HI; hipLaunchKernelGGL(mk::mk_fwd, dim3(grid), dim3(512), mk::LDS_BYTES, stream, a); }
    (void)hipMemsetAsync(ws + mk::WS_CTL, 0, mk::CTL_ZERO_BYTES, stream);
    a.ph_lo = MK_PROBE_HI; a.ph_hi = 8; hipLaunchKernelGGL(mk::mk_fwd, dim3(grid), dim3(512), mk::LDS_BYTES, stream, a);
#else
    hipLaunchKernelGGL(mk::mk_fwd, dim3(grid), dim3(512), mk::LDS_BYTES, stream, a);
#endif
#if defined(MK_STAMP)
    hipLaunchKernelGGL(k_stamp_report, dim3(1), dim3(64), 0, stream, (const unsigned long long*)(ws + mk::WS_STAMP), out, MK_STAMP_A);
#endif
#if MK_CUT < 8
    float* bufA = (float*)(ws + 0 * MiB); float* bufB = (float*)(ws + 64 * MiB); float* bufC = (float*)(ws + 128 * MiB); float* bufD = (float*)(ws + 192 * MiB);
    float* pooled = bufA; float* ypool = bufA + (size_t)MT * DPOOL; float* z = pooled; float* pre = bufD; float* ycat = bufB;
#if MK_CUT <= 2
    float* u = bufB;
    hipLaunchKernelGGL(k_cvt_u, dim3(MT * DM / EB), dim3(EB), 0, stream, (const bf16_t*)(ws + mk::WS_UPOOL), (const bf16_t*)(ws + mk::WS_USSM), u);
    hipLaunchKernelGGL(k_pool, dim3(MT * DPOOL / EB), dim3(EB), 0, stream, u, pooled);
    for (int gi = 0; gi < 4; ++gi) gemm(stream, pooled + gi * 128, DPOOL, pool_w + (size_t)gi * 128 * 128, 128, ypool + gi * 128, DPOOL, nullptr, 0, MT, 128, 128);
    float* y2 = bufC;
    hipLaunchKernelGGL(k_ssm_scan, dim3(2 * BATCH * NG), dim3(64), 0, stream, u, lnar, aim, ldt, bre, bim, cre, cim, y2);
    hipLaunchKernelGGL(k_ssm_post, dim3(MT * DSSM / EB), dim3(EB), 0, stream, y2, u, ssm_d, z);
    const float* pre_scale = pool_scale;
#elif MK_CUT <= 4
    hipLaunchKernelGGL(k_cvt_z, dim3(MT * DSSM / EB), dim3(EB), 0, stream, (const bf16_t*)(ws + mk::WS_ZG), z);
    hipLaunchKernelGGL(k_cvt_rows, dim3(MT * DPOOL / EB), dim3(EB), 0, stream, (const bf16_t*)(ws + mk::WS_YCAT), DM, ypool, DPOOL, DPOOL, MT);
    const float* pre_scale = nullptr;
#endif
#if MK_CUT <= 4
    gemm(stream, z, DSSM, glu_w, DSSM, pre, DSSM, nullptr, 0, MT, DSSM, DSSM);
    hipLaunchKernelGGL(k_glu, dim3(MT * DSSM / EB), dim3(EB), 0, stream, z, pre, glu_b);
#elif MK_CUT == 5
    hipLaunchKernelGGL(k_cvt_rows, dim3(MT * DPOOL / EB), dim3(EB), 0, stream, (const bf16_t*)(ws + mk::WS_YCAT), DM, ypool, DPOOL, DPOOL, MT);
    hipLaunchKernelGGL(k_cvt_rows, dim3(MT * DSSM / EB), dim3(EB), 0, stream, (const bf16_t*)(ws + mk::WS_YCAT) + DPOOL, DM, pre, DSSM, DSSM, MT);
    const float* pre_scale = nullptr;
#endif
#if MK_CUT <= 5
    hipLaunchKernelGGL(k_rmsnorm, dim3(MT / 4), dim3(256), 0, stream, ypool, DPOOL, pre_scale, g_pool, ycat, DM, DPOOL, MT);
    hipLaunchKernelGGL(k_rmsnorm, dim3(MT / 4), dim3(256), 0, stream, pre, DSSM, (const float*)nullptr, g_ssm, ycat + DPOOL, DM, DSSM, MT);
    gemm(stream, ycat, DM, w_out, DM, out, DM, x, DM, MT, DM, DM);
#endif
#if MK_CUT <= 6
    float* xn2 = bufA;
    hipLaunchKernelGGL(k_rmsnorm, dim3(MT / 4), dim3(256), 0, stream, out, DM, (const float*)nullptr, g_ffn, xn2, DM, DM, MT);
    float* up = (float*)(ws + 64 * MiB); float* act = (float*)(ws + 152 * MiB);
    for (int b = 0; b < BATCH; ++b) {
        gemm(stream, xn2 + (size_t)b * SEQ * DM, DM, w_up, DFF2, up, DFF2, nullptr, 0, SEQ, DFF2, DM);
        hipLaunchKernelGGL(k_convact, dim3(SEQ * DFF / EB), dim3(EB), 0, stream, up, conv_w, conv_b, act);
        gemm(stream, act, DFF, w_down, DM, out + (size_t)b * SEQ * DM, DM, out + (size_t)b * SEQ * DM, DM, SEQ, DM, DFF);
    }
#else
    float* actf = (float*)(ws + 0 * MiB);
    for (int b = 0; b < BATCH; ++b) {
        hipLaunchKernelGGL(k_cvt_rows, dim3(SEQ * DFF / EB), dim3(EB), 0, stream, (const bf16_t*)(ws + mk::WS_ACT) + (size_t)b * SEQ * DFF, DFF, actf, DFF, DFF, SEQ);
        gemm(stream, actf, DFF, w_down, DM, out + (size_t)b * SEQ * DM, DM, out + (size_t)b * SEQ * DM, DM, SEQ, DM, DFF);
    }
#endif
    hipLaunchKernelGGL(k_rmsnorm, dim3(MT / 4), dim3(256), 0, stream, out, DM, (const float*)nullptr, g_final, out, DM, DM, MT);
    (void)bufC;
#endif
}
```

```cpp
#define MK_CUT 8
#include <hip/hip_runtime.h>
#include <math.h>

constexpr int BATCH = 4, SEQ = 4096, DM = 1024, MT = BATCH * SEQ;
constexpr int DPOOL = 512, DSSM = 512, NG = 32, NH = 16, NS = 64;
constexpr int DFF = 2816, DFF2 = 5632;
constexpr float EPS = 1e-6f;

__global__ void k_rmsnorm(const float* x, int ldx, const float* __restrict__ pre,
                          const float* __restrict__ g, float* out, int ldo, int D, int rows) {
    const int wave = (blockIdx.x * blockDim.x + threadIdx.x) >> 6, lane = threadIdx.x & 63;
    if (wave >= rows) return;
    const float* xr = x + (size_t)wave * ldx;
    float ss = 0.f;
    for (int c = lane; c < D; c += 64) { float v = xr[c]; if (pre) v *= pre[c]; ss += v * v; }
    for (int o = 32; o; o >>= 1) ss += __shfl_xor(ss, o);
    const float inv = rsqrtf(ss / (float)D + EPS);
    float* orow = out + (size_t)wave * ldo;
    for (int c = lane; c < D; c += 64) { float v = xr[c]; if (pre) v *= pre[c]; orow[c] = v * inv * g[c]; }
}

__global__ void __launch_bounds__(256) k_gemm(const float* __restrict__ A, int lda, const float* __restrict__ B, int ldb,
                                               float* C, int ldc, const float* R, int ldr, int K) {
    __shared__ float As[16][132];
    __shared__ float Bs[16][132];
    const int tid = threadIdx.x, tx = tid & 15, ty = tid >> 4;
    const int row0 = blockIdx.y * 128, col0 = blockIdx.x * 128;
    float acc[8][8];
#pragma unroll
    for (int i = 0; i < 8; ++i)
#pragma unroll
        for (int j = 0; j < 8; ++j) acc[i][j] = 0.f;
    for (int k0 = 0; k0 < K; k0 += 16) {
#pragma unroll
        for (int p = 0; p < 2; ++p) {
            const int i = tid + p * 256, r = i >> 2, kk = (i & 3) * 4;
            const float4 v = *(const float4*)(A + (size_t)(row0 + r) * lda + k0 + kk);
            As[kk + 0][r] = v.x; As[kk + 1][r] = v.y; As[kk + 2][r] = v.z; As[kk + 3][r] = v.w;
        }
#pragma unroll
        for (int p = 0; p < 2; ++p) {
            const int i = tid + p * 256, kk = i >> 5, c = (i & 31) * 4;
            const float4 v = *(const float4*)(B + (size_t)(k0 + kk) * ldb + col0 + c);
            *(float4*)&Bs[kk][c] = v;
        }
        __syncthreads();
#pragma unroll
        for (int kk = 0; kk < 16; ++kk) {
            float a[8], b[8];
            const float4 a0 = *(const float4*)&As[kk][ty * 4], a1 = *(const float4*)&As[kk][64 + ty * 4];
            const float4 b0 = *(const float4*)&Bs[kk][tx * 4], b1 = *(const float4*)&Bs[kk][64 + tx * 4];
            a[0] = a0.x; a[1] = a0.y; a[2] = a0.z; a[3] = a0.w; a[4] = a1.x; a[5] = a1.y; a[6] = a1.z; a[7] = a1.w;
            b[0] = b0.x; b[1] = b0.y; b[2] = b0.z; b[3] = b0.w; b[4] = b1.x; b[5] = b1.y; b[6] = b1.z; b[7] = b1.w;
#pragma unroll
            for (int i = 0; i < 8; ++i)
#pragma unroll
                for (int j = 0; j < 8; ++j) acc[i][j] = fmaf(a[i], b[j], acc[i][j]);
        }
        __syncthreads();
    }
#pragma unroll
    for (int i = 0; i < 8; ++i) {
        const int r = row0 + (i < 4 ? ty * 4 + i : 64 + ty * 4 + (i - 4));
#pragma unroll
        for (int jh = 0; jh < 2; ++jh) {
            const int c = col0 + jh * 64 + tx * 4;
            float4 v = make_float4(acc[i][jh * 4 + 0], acc[i][jh * 4 + 1], acc[i][jh * 4 + 2], acc[i][jh * 4 + 3]);
            if (R) { const float4 rr = *(const float4*)(R + (size_t)r * ldr + c); v.x += rr.x; v.y += rr.y; v.z += rr.z; v.w += rr.w; }
            *(float4*)(C + (size_t)r * ldc + c) = v;
        }
    }
}

__global__ void k_pool(const float* __restrict__ u  , float* __restrict__ pooled  ) {
    const int idx = blockIdx.x * blockDim.x + threadIdx.x;
    if (idx >= MT * DPOOL) return;
    const int c = idx % DPOOL, row = idx / DPOOL, b = row / SEQ, t = row % SEQ;
    const int gi = c / 128, w = 2 << gi, half = w / 2;
    int lo = t - half, hi = t + half; if (lo < 0) lo = 0; if (hi > SEQ) hi = SEQ;
    float s = 0.f;
    for (int q = lo; q < hi; ++q) s += u[(size_t)(b * SEQ + q) * DM + c];
    pooled[idx] = s / (float)(hi - lo) - u[(size_t)row * DM + c];
}

__global__ void __launch_bounds__(64) k_ssm_scan(const float* __restrict__ u  ,
        const float* __restrict__ lnar, const float* __restrict__ aim, const float* __restrict__ ldt,
        const float* __restrict__ bre, const float* __restrict__ bim, const float* __restrict__ cre, const float* __restrict__ cim,
        float* __restrict__ y  ) {
    const int n = threadIdx.x;
    const int g = blockIdx.x % NG, b = (blockIdx.x / NG) % BATCH, dir = blockIdx.x / (NG * BATCH);
    const float dt = expf(ldt[dir * NG + g]);
    const float a_re = -expf(lnar[(dir * NG + g) * NS + n]), a_im = aim[(dir * NG + g) * NS + n];
    const float mag = expf(a_re * dt), ang = a_im * dt;
    const float lam_re = mag * cosf(ang), lam_im = mag * sinf(ang);
    const float den = a_re * a_re + a_im * a_im;
    const float f_re = ((lam_re - 1.0f) * a_re + lam_im * a_im) / den;
    const float f_im = (lam_im * a_re - (lam_re - 1.0f) * a_im) / den;
    float Br[NH], Bi[NH], Cr[NH], Ci[NH];
#pragma unroll
    for (int h = 0; h < NH; ++h) {
        Br[h] = bre[((size_t)(dir * NG + g) * NS + n) * NH + h];
        Bi[h] = bim[((size_t)(dir * NG + g) * NS + n) * NH + h];
        Cr[h] = cre[((size_t)(dir * NG + g) * NH + h) * NS + n];
        Ci[h] = cim[((size_t)(dir * NG + g) * NH + h) * NS + n];
    }
    float s_re = 0.f, s_im = 0.f;
    float* yd = y + (size_t)dir * MT * DSSM;
    for (int i = 0; i < SEQ; ++i) {
        const int t = dir ? (SEQ - 1 - i) : i;
        const float* ur = u + (size_t)(b * SEQ + t) * DM + DPOOL + g * NH;
        float bu_re = 0.f, bu_im = 0.f;
#pragma unroll
        for (int h = 0; h < NH; ++h) { const float uv = ur[h]; bu_re = fmaf(Br[h], uv, bu_re); bu_im = fmaf(Bi[h], uv, bu_im); }
        const float in_re = f_re * bu_re - f_im * bu_im, in_im = f_re * bu_im + f_im * bu_re;
        const float nr = lam_re * s_re - lam_im * s_im + in_re;
        const float ni = lam_re * s_im + lam_im * s_re + in_im;
        s_re = nr; s_im = ni;
        float mine = 0.f;
#pragma unroll
        for (int h = 0; h < NH; ++h) {
            float p = Cr[h] * s_re - Ci[h] * s_im;
#pragma unroll
            for (int o = 32; o; o >>= 1) p += __shfl_xor(p, o);
            if (n == h) mine = p;
        }
        if (n < NH) yd[(size_t)(b * SEQ + t) * DSSM + g * NH + n] = mine;
    }
}

__device__ __forceinline__ float gelu_tanh(float x) {
    const float k = 0.7978845608028654f;
    return 0.5f * x * (1.0f + tanhf(k * (x + 0.044715f * x * x * x)));
}
__device__ __forceinline__ float sigmoidf_(float x) { return 1.0f / (1.0f + expf(-x)); }

__global__ void k_ssm_post(const float* __restrict__ y2, const float* __restrict__ u, const float* __restrict__ d, float* __restrict__ z) {
    const int idx = blockIdx.x * blockDim.x + threadIdx.x;
    if (idx >= MT * DSSM) return;
    const int c = idx % DSSM, row = idx / DSSM;
    const float yv = y2[idx] + y2[(size_t)MT * DSSM + idx] + d[c] * u[(size_t)row * DM + DPOOL + c];
    z[idx] = gelu_tanh(yv);
}
__global__ void k_glu(const float* __restrict__ z, float* __restrict__ pre, const float* __restrict__ gb) {
    const int idx = blockIdx.x * blockDim.x + threadIdx.x;
    if (idx >= MT * DSSM) return;
    const int c = idx % DSSM;
    pre[idx] = z[idx] * sigmoidf_(pre[idx] + gb[c]);
}
__global__ void k_convact(const float* __restrict__ up  , const float* __restrict__ cw, const float* __restrict__ cb, float* __restrict__ act  ) {
    const int idx = blockIdx.x * blockDim.x + threadIdx.x;
    if (idx >= SEQ * DFF) return;
    const int f = idx % DFF, t = idx / DFF;
    float v = cb[f], gt = cb[DFF + f];
#pragma unroll
    for (int k = 0; k < 3; ++k) {
        const int q = t + k - 1;
        if (q >= 0 && q < SEQ) {
            v = fmaf(up[(size_t)q * DFF2 + f], cw[k * DFF2 + f], v);
            gt = fmaf(up[(size_t)q * DFF2 + DFF + f], cw[k * DFF2 + DFF + f], gt);
        }
    }
    act[idx] = v * (gt * sigmoidf_(gt));
}


#include <cstdio>
#include <cstdint>
#define LAS __attribute__((address_space(3)))
#define GAS __attribute__((address_space(1)))
typedef unsigned short bf16_t;
typedef short bf16x8 __attribute__((ext_vector_type(8)));
typedef float f32x4 __attribute__((ext_vector_type(4)));
typedef float f32x2 __attribute__((ext_vector_type(2)));
typedef unsigned u32x4 __attribute__((ext_vector_type(4)));
typedef unsigned u32x2 __attribute__((ext_vector_type(2)));

namespace mk {
constexpr int TCH = 16;
constexpr int K1 = 16 * TCH;
constexpr int ROWLEN = K1 + 256;
constexpr int NCR = MT / TCH;
constexpr int NCHB = SEQ / TCH;
constexpr int PADROWS = 4352;
constexpr int UPT = 17;
constexpr int UPROWS = 252;

constexpr size_t MiB = 1u << 20;
constexpr size_t WS_CTL = 0, CTL_ZERO_BYTES = 64 * 1024;
constexpr int CW_TBCNT = 4096;
constexpr size_t WS_R0 = 1 * MiB;
constexpr size_t WS_SSPOOL = 2 * MiB;
constexpr size_t WS_SSSSM = WS_SSPOOL + 8 * MT * 4;
constexpr size_t WS_SSH1 = WS_SSSSM + 8 * MT * 4;
constexpr size_t WS_SSH2 = WS_SSH1 + 4 * MT * 4;
constexpr size_t WS_LAMT = 6 * MiB;
constexpr size_t WS_WIN = 8 * MiB, WS_WOUT = 10 * MiB, WS_WGLU = 12 * MiB, WS_PW = 12 * MiB + 512 * 1024;
constexpr size_t WS_WUP = 13 * MiB, WS_WDOWN = 24 * MiB;
constexpr size_t WS_WAB = 30 * MiB;
constexpr size_t WS_TB = 38 * MiB;
constexpr size_t WS_TBC = 40 * MiB;
constexpr size_t WS_H1B = 62 * MiB;
constexpr size_t WS_XB = 96 * MiB;
constexpr size_t WS_YCAT = 128 * MiB;
constexpr size_t WS_UPOOL = 128 * MiB;
constexpr size_t WS_USSM = 144 * MiB;
constexpr size_t WS_FG = 176 * MiB;
constexpr size_t WS_POOLED = 208 * MiB;
constexpr size_t WS_ZG = 224 * MiB;
constexpr size_t WS_ACT = 96 * MiB;
constexpr size_t WS_END = 240 * MiB;

constexpr int RING_BYTES = 131072, XTRA_OFF = RING_BYTES, XTRA_BYTES = 12288, LDSCTL_OFF = XTRA_OFF + XTRA_BYTES, LDS_BYTES = 147456;

__device__ __forceinline__ unsigned f2bf(float f) { unsigned u = __builtin_bit_cast(unsigned, f); return (u + 0x7fffu + ((u >> 16) & 1u)) >> 16; }
__device__ __forceinline__ unsigned pk2(float lo, float hi) { return f2bf(lo) | (f2bf(hi) << 16); }
__device__ __forceinline__ unsigned cvt_pk_bf16(float lo, float hi) { unsigned r; asm volatile("v_cvt_pk_bf16_f32 %0, %1, %2" : "=v"(r) : "v"(lo), "v"(hi)); return r; }
__device__ __forceinline__ u32x4 pack8(f32x4 a, f32x4 b) { u32x4 w; w.x = cvt_pk_bf16(a[0], a[1]); w.y = cvt_pk_bf16(a[2], a[3]); w.z = cvt_pk_bf16(b[0], b[1]); w.w = cvt_pk_bf16(b[2], b[3]); return w; }
__device__ __forceinline__ u32x2 pack4(f32x4 a) { u32x2 w; w.x = cvt_pk_bf16(a[0], a[1]); w.y = cvt_pk_bf16(a[2], a[3]); return w; }
__device__ __forceinline__ float bflo(unsigned w) { return __builtin_bit_cast(float, w << 16); }
__device__ __forceinline__ float bfhi(unsigned w) { return __builtin_bit_cast(float, w & 0xffff0000u); }
__device__ __forceinline__ void unpack8(u32x4 w, f32x4& a, f32x4& b) { a[0] = bflo(w.x); a[1] = bfhi(w.x); a[2] = bflo(w.y); a[3] = bfhi(w.y); b[0] = bflo(w.z); b[1] = bfhi(w.z); b[2] = bflo(w.w); b[3] = bfhi(w.w); }
__device__ __forceinline__ float fast_sigmoid(float x) { return __builtin_amdgcn_rcpf(1.0f + __builtin_amdgcn_exp2f(-1.4426950408889634f * x)); }
__device__ __forceinline__ float fast_gelu_tanh(float x) {
    const float t = x * (1.0f + 0.044715f * x * x);
    return x * __builtin_amdgcn_rcpf(1.0f + __builtin_amdgcn_exp2f(-2.0f * 0.7978845608028654f * 1.4426950408889634f * t));
}
__device__ __forceinline__ float wave_sum(float v) {
#pragma unroll
    for (int o = 1; o < 64; o <<= 1) v += __shfl_xor(v, o);
    return v;
}
__device__ __forceinline__ float dpp_ror1(float v)  { return __builtin_bit_cast(float, __builtin_amdgcn_update_dpp(0, __builtin_bit_cast(int, v), 0x121, 0xf, 0xf, false)); }
__device__ __forceinline__ float dpp_ror15(float v) { return __builtin_bit_cast(float, __builtin_amdgcn_update_dpp(0, __builtin_bit_cast(int, v), 0x12F, 0xf, 0xf, false)); }
__device__ __forceinline__ int lane_id_fresh() { int l; asm volatile("v_mbcnt_lo_u32_b32 %0, -1, 0\n\tv_mbcnt_hi_u32_b32 %0, -1, %0" : "=v"(l)); return l; }
#define LDS_WAIT() asm volatile("s_waitcnt lgkmcnt(0)" ::: "memory")
#define VM_WAIT() asm volatile("s_waitcnt vmcnt(0)" ::: "memory")

#define XB_TMO      128
#define XB_XCNT(j)  (256  + 64 * (j))
#define XB_XSUB(j)  (1280 + 64 * (j))
#define XB_XGEN(j)  (2304 + 64 * (j))
#define XB_TOP      3328
#define XB_TOPGEN   3392
#define XCD_BAR_WORDS 3456
#define XB_SPIN_CAP (1u << 18)
__device__ __forceinline__ unsigned xb_ld(unsigned* p)              { return __hip_atomic_load(p, __ATOMIC_RELAXED, __HIP_MEMORY_SCOPE_AGENT); }
__device__ __forceinline__ unsigned xb_add(unsigned* p, unsigned v) { return __hip_atomic_fetch_add(p, v, __ATOMIC_RELAXED, __HIP_MEMORY_SCOPE_AGENT); }
__device__ __forceinline__ unsigned xb_xcc_id() { return (unsigned)__builtin_amdgcn_s_getreg((3 << 11) | 20) & 0xFu; }
#define XB_SPIN(cond, bar) do { unsigned _sp = 0; while (cond) { __builtin_amdgcn_s_sleep(1); \
    if ((++_sp & 255u) == 0u) { if (xb_ld(&(bar)[XB_TMO])) break; if (_sp > XB_SPIN_CAP) { atomicAdd(&(bar)[XB_TMO], 1u); break; } } } } while (0)
struct XcdBarrier { unsigned* bar; unsigned x; volatile LAS unsigned* st; };
__device__ __forceinline__ XcdBarrier xcd_barrier_post(unsigned* bar, volatile LAS unsigned* st) {
    XcdBarrier b; b.bar = bar; b.x = xb_xcc_id(); b.st = st;
    if (threadIdx.x == 0) (void)xb_add(&bar[XB_XCNT(b.x)], 1u);
    return b;
}
__device__ __forceinline__ void xcd_barrier_complete(unsigned* bar, unsigned x, unsigned& nloc, unsigned& nx) {
    const unsigned G = gridDim.x * gridDim.y * gridDim.z;
    unsigned sum, cnt, mine, sp = 0u;
    for (;;) {
        sum = 0u; cnt = 0u; mine = 0u;
#pragma unroll
        for (unsigned j = 0; j < 16; ++j) { const unsigned c = xb_ld(&bar[XB_XCNT(j)]); sum += c; cnt += (c > 0u) ? 1u : 0u; mine = (j == x) ? c : mine; }
        if (sum == G) break;
        __builtin_amdgcn_s_sleep(1);
        if ((++sp & 255u) == 0u) { if (xb_ld(&bar[XB_TMO])) break; if (sp > XB_SPIN_CAP) { atomicAdd(&bar[XB_TMO], 1u); break; } }
    }
    nloc = mine > 0u ? mine : 1u; nx = cnt > 0u ? cnt : 1u;
}
__device__ __forceinline__ void xcd_barrier(const XcdBarrier& b, int tid) {
    asm volatile("s_waitcnt vmcnt(0)" ::: "memory");
    __syncthreads();
    if (tid == 0) {
        unsigned* bar = b.bar;
        __builtin_amdgcn_s_waitcnt(0);
        unsigned nloc = b.st[0], nx = b.st[1];
        if (nloc == 0u) { xcd_barrier_complete(bar, b.x, nloc, nx); b.st[0] = nloc; b.st[1] = nx; }
        const unsigned old = xb_add(&bar[XB_XSUB(b.x)], 1u);
        const unsigned gen = old / nloc;
        if (old + 1u == (gen + 1u) * nloc) {
            __builtin_amdgcn_fence(__ATOMIC_RELEASE, "agent");
            asm volatile("s_waitcnt vmcnt(0)" ::: "memory");
            const unsigned og = xb_add(&bar[XB_TOP], 1u);
            const unsigned tg = og / nx;
            if (og + 1u == (tg + 1u) * nx) xb_add(&bar[XB_TOPGEN], 1u);
            else XB_SPIN(xb_ld(&bar[XB_TOPGEN]) == tg, bar);
            __builtin_amdgcn_fence(__ATOMIC_ACQUIRE, "agent");
            xb_add(&bar[XB_XGEN(b.x)], 1u);
            asm volatile("s_waitcnt vmcnt(0)" ::: "memory");
        } else {
            XB_SPIN(xb_ld(&bar[XB_XGEN(b.x)]) == gen, bar);
            __builtin_amdgcn_fence(__ATOMIC_ACQUIRE, "agent");
            asm volatile("s_waitcnt vmcnt(0)" ::: "memory");
        }
    }
    __syncthreads();
}

#ifndef EXP_WGM
#define EXP_WGM 8
#endif
constexpr int BM = 256, BK = 64, HALF = 128, HTB = HALF * BK * 2, STAGE_BYTES = 8 * HTB, NXCD = 8, WGM = EXP_WGM;
__host__ __device__ __forceinline__ int lds_byte(int r, int c) { const int st = (r >> 4) * 2 + (c >> 5), rr = r & 15, cc = c & 31, ob = rr * 64 + cc * 2; return st * 1024 + (ob ^ (((ob >> 9) & 1) << 5)); }
__host__ __device__ __forceinline__ void stage_rc(int b, int& R, int& C) { const int st = b / 1024, sb = b % 1024, swz = sb ^ (((sb >> 9) & 1) << 5); R = (st >> 1) * 16 + swz / 64; C = (st & 1) * 32 + (swz % 64) / 2; }
__host__ __device__ __forceinline__ int perm32(int rho) { const int n = rho >> 4, i = rho & 15; return 8 * (i >> 2) + 4 * n + (i & 3); }

struct Unit { int pm, pn, g, aux; };
struct GemmDesc { const char* A; const char* B; long a_pm, a_g, b_pn, b_g, a_h, b_h, a_k, b_k; int nt;
                  const char* B2; long b2_pn, b2_g, b2_h, b2_k; int tsw; };

struct StaticOrder {
    int nM, nN, nwg, G, c;
    __device__ void init(int nM_, int nN_, int G_, int c_) { nM = nM_; nN = nN_; nwg = nM * nN; G = G_; c = c_; }
    __device__ bool next(int i, Unit& u) const {
        const long L = (long)i * G + c; if (L >= nwg) return false;
        int wgid = (int)L; { const int q = nwg / NXCD, r = nwg % NXCD, xcd = wgid % NXCD, off = wgid / NXCD; wgid = (xcd < r ? xcd * (q + 1) : r * (q + 1) + (xcd - r) * q) + off; }
        const int nig = WGM * nN, gid = wgid / nig, fm = gid * WGM, gsz = (nM - fm) < WGM ? (nM - fm) : WGM;
        u.pm = fm + ((wgid % nig) % gsz); u.pn = (wgid % nig) / gsz; u.g = 0; u.aux = 0; return true;
    }
};

template <class Epi, class Sched, bool ALIGN_EPI, bool SEG2 = false>
__device__ __forceinline__ void gemm_phase(LAS unsigned char* lds, const GemmDesc g, const unsigned (&voffA)[2], const unsigned (&voffB)[2], const Sched& S, Epi& E, int tid, unsigned long long* stp = nullptr, const unsigned* voffB2 = nullptr) {
    const int wid = __builtin_amdgcn_readfirstlane(tid >> 6), lane = tid & 63, wr = wid >> 2, wc = wid & 3, fr = lane & 15, fq = lane >> 4;
    const int nt = g.nt;
    const long kstepA = g.a_k, kstepB = g.b_k, hstepA = g.a_h, hstepB = g.b_h;
    const unsigned ldsw = (unsigned)wid * 1024u;
    const int aoff = lds_byte(wr * 64 + fr, fq * 8), boff = lds_byte(wc * 32 + fr, fq * 8);
#define PG8_SA(b, h) (((b) * 2 + (h)) * HTB)
#define PG8_SB(b, h) ((4 + (b) * 2 + (h)) * HTB)
#define PG8_STAGE(bufoff, gbase, voff) do { const char* _gb = (const char*)(gbase); asm volatile("" : "+s"(_gb));   _Pragma("unroll") for (int _i = 0; _i < 2; ++_i) \
        __builtin_amdgcn_global_load_lds((const unsigned*)(_gb + (voff)[_i]), (LAS unsigned*)(lds + (bufoff) + ldsw + _i * 8192), 16, 0, 0); } while (0)
#define PG8_LDA(dst, b, h) do { _Pragma("unroll") for (int m = 0; m < 4; ++m) _Pragma("unroll") for (int k = 0; k < 2; ++k) dst[m][k] = *(const LAS bf16x8*)(lds + PG8_SA(b, h) + aoff + m * 2048 + k * 1024); } while (0)
#define PG8_LDB(dst, b, h) do { _Pragma("unroll") for (int n = 0; n < 2; ++n) _Pragma("unroll") for (int k = 0; k < 2; ++k) dst[n][k] = *(const LAS bf16x8*)(lds + PG8_SB(b, h) + boff + n * 2048 + k * 1024); } while (0)
#define PG8_MMA(ai, bj, At, Bt) do { __builtin_amdgcn_s_setprio(1); _Pragma("unroll") for (int m = 0; m < 4; ++m) _Pragma("unroll") for (int n = 0; n < 2; ++n) _Pragma("unroll") for (int k = 0; k < 2; ++k) \
        acc[ai][bj][m][n] = __builtin_amdgcn_mfma_f32_16x16x32_bf16(Bt[n][k], At[m][k], acc[ai][bj][m][n], 0, 0, 0); __builtin_amdgcn_s_setprio(0); } while (0)
#define PG8_WAIT_V(n) asm volatile("s_waitcnt vmcnt(" #n ")" ::: "memory")
#define PG8_WAIT_L(n) asm volatile("s_waitcnt lgkmcnt(" #n ")" ::: "memory")
#define PG8_BAR __builtin_amdgcn_s_barrier()
#define PG8_SCHED __builtin_amdgcn_sched_barrier(0)
    Unit cur, nxt; int ui = 0;
    if (!S.next(0, cur)) return;
    f32x4 acc[2][2][4][2];
#pragma unroll
    for (int a = 0; a < 2; ++a)
#pragma unroll
        for (int b = 0; b < 2; ++b)
#pragma unroll
            for (int m = 0; m < 4; ++m)
#pragma unroll
                for (int n = 0; n < 2; ++n) acc[a][b][m][n] = (f32x4){0.f, 0.f, 0.f, 0.f};
    bf16x8 At[4][2], B0[2][2], B1[2][2];
    const char* cA = g.A + (long)cur.pm * g.a_pm + (long)cur.g * g.a_g; const char* cB = g.B + (long)cur.pn * g.b_pn + (long)cur.g * g.b_g;
    const char* cB2 = SEG2 ? g.B2 + (long)cur.pn * g.b2_pn + (long)cur.g * g.b2_g : nullptr;
    PG8_STAGE(PG8_SB(0, 0), cB, voffB); PG8_STAGE(PG8_SB(0, 1), cB + hstepB, voffB); PG8_STAGE(PG8_SA(0, 0), cA, voffA); PG8_STAGE(PG8_SA(0, 1), cA + hstepA, voffA);
    if (wr == 1) PG8_BAR;
    PG8_WAIT_V(2); PG8_BAR;
    PG8_STAGE(PG8_SB(1, 0), cB + kstepB, voffB); PG8_STAGE(PG8_SA(1, 0), cA + kstepA, voffA); PG8_STAGE(PG8_SB(1, 1), cB + hstepB + kstepB, voffB);
    PG8_WAIT_V(6); PG8_BAR;
    unsigned long long st_t0 = stp ? __builtin_amdgcn_s_memrealtime() : 0ull, st_loop = 0ull, st_epi = 0ull;
    for (;;) {
        const bool has_next = S.next(ui + 1, nxt);
        const char* nA = has_next ? g.A + (long)nxt.pm * g.a_pm + (long)nxt.g * g.a_g : cA; const char* nB = has_next ? g.B + (long)nxt.pn * g.b_pn + (long)nxt.g * g.b_g : cB;
        for (int t = 0; t < nt; t += 2) {
            const bool last = (t == nt - 2);
            const char* a1 = cA + (long)(t + 1) * kstepA;
            const bool sg = SEG2 && !last && (t + 2 >= g.tsw);
            const char* a2 = last ? nA : cA + (long)(t + 2) * kstepA; const char* b2 = last ? nB : (sg ? cB2 + (long)(t + 2 - g.tsw) * g.b2_k : cB + (long)(t + 2) * kstepB);
            const char* a3 = a2 + kstepA; const char* b3 = b2 + (sg ? g.b2_k : kstepB);
            const long hB = sg ? g.b2_h : hstepB;
            unsigned vbs[2]; vbs[0] = sg ? voffB2[0] : voffB[0]; vbs[1] = sg ? voffB2[1] : voffB[1];
            PG8_LDB(B0, 0, 0); PG8_LDB(B1, 0, 1); PG8_SCHED; PG8_LDA(At, 0, 0); PG8_STAGE(PG8_SA(1, 1), a1 + hstepA, voffA);
            PG8_WAIT_V(8); PG8_WAIT_L(0); PG8_BAR; PG8_MMA(0, 0, At, B0); PG8_MMA(0, 1, At, B1); PG8_BAR; PG8_SCHED;
            PG8_LDA(At, 0, 1); PG8_STAGE(PG8_SB(0, 0), b2, vbs); PG8_STAGE(PG8_SB(0, 1), b2 + hB, vbs); PG8_STAGE(PG8_SA(0, 0), a2, voffA);
            PG8_WAIT_V(8); PG8_WAIT_L(0); PG8_BAR; PG8_MMA(1, 0, At, B0); PG8_MMA(1, 1, At, B1); PG8_BAR; PG8_SCHED;
            PG8_LDB(B0, 1, 0); PG8_LDB(B1, 1, 1); PG8_SCHED; PG8_LDA(At, 1, 0); PG8_STAGE(PG8_SA(0, 1), a2 + hstepA, voffA);
            PG8_WAIT_V(8); PG8_WAIT_L(0); PG8_BAR; PG8_MMA(0, 0, At, B0); PG8_MMA(0, 1, At, B1); PG8_BAR; PG8_SCHED;
            PG8_LDA(At, 1, 1); PG8_STAGE(PG8_SB(1, 0), b3, vbs); PG8_STAGE(PG8_SB(1, 1), b3 + hB, vbs); PG8_STAGE(PG8_SA(1, 0), a3, voffA);
            PG8_WAIT_V(8); PG8_WAIT_L(0); PG8_BAR; PG8_MMA(1, 0, At, B0); PG8_MMA(1, 1, At, B1); PG8_BAR; PG8_SCHED;
            if constexpr (Epi::HAS_MID) { if (t + 2 == Epi::MID_T) E.mid(acc, wr, fr); }
        }
        if (stp) { const unsigned long long t1 = __builtin_amdgcn_s_memrealtime(); st_loop += t1 - st_t0; st_t0 = t1; }
        if constexpr (ALIGN_EPI) { if (wr == 0) PG8_BAR; }
        if constexpr (!Epi::AFTER_DRAIN) { E(acc, cur, wr, wc, fr, fq); }
        if (stp) { const unsigned long long t1 = __builtin_amdgcn_s_memrealtime(); st_epi += t1 - st_t0; st_t0 = t1; }
        if (!has_next) break;
#pragma unroll
        for (int a = 0; a < 2; ++a)
#pragma unroll
            for (int b = 0; b < 2; ++b)
#pragma unroll
                for (int m = 0; m < 4; ++m)
#pragma unroll
                    for (int n = 0; n < 2; ++n) acc[a][b][m][n] = (f32x4){0.f, 0.f, 0.f, 0.f};
        cur = nxt; cA = nA; cB = nB; ++ui; if constexpr (SEG2) cB2 = g.B2 + (long)cur.pn * g.b2_pn + (long)cur.g * g.b2_g;
        if constexpr (ALIGN_EPI) { if (wr == 1) PG8_BAR; }
    }
    PG8_WAIT_V(0);
    if constexpr (!ALIGN_EPI) { if (wr == 0) PG8_BAR; }
    PG8_BAR;
    if (stp) { const unsigned long long t1 = __builtin_amdgcn_s_memrealtime(); st_loop += t1 - st_t0; st_t0 = t1; }
    if constexpr (Epi::AFTER_DRAIN) { E.fused(acc, cur, wr, wc, fr, fq, lds, wid, lane); }
    if (stp) { const unsigned long long t1 = __builtin_amdgcn_s_memrealtime(); st_epi += t1 - st_t0; if (tid == 0) { stp[0] = st_loop; stp[1] = st_epi; } }
#undef PG8_SA
#undef PG8_SB
#undef PG8_STAGE
#undef PG8_LDA
#undef PG8_LDB
#undef PG8_MMA
#undef PG8_WAIT_V
#undef PG8_WAIT_L
#undef PG8_BAR
#undef PG8_SCHED
}

__device__ __forceinline__ void voff_std(unsigned (&v)[2], int ld, bool perm, int tid) {
#pragma unroll
    for (int i = 0; i < 2; ++i) { int R, C; stage_rc(tid * 16 + i * 8192, R, C); const int Rb = perm ? ((R & ~31) + perm32(R & 31)) : R; v[i] = (unsigned)(Rb * ld + C) * 2u; }
}

typedef f32x4 Acc[2][2][4][2];

struct EpiU {
    static constexpr bool PERM = true, AFTER_DRAIN = false, HAS_MID = false; static constexpr int MID_T = 0;
    const float* r0; bf16_t* upool; bf16_t* ussm;
    __device__ __forceinline__ void operator()(Acc& acc, const Unit& u, int wr, int wc, int fr, int fq) const {
#pragma unroll
        for (int ai = 0; ai < 2; ++ai)
#pragma unroll
            for (int m = 0; m < 4; ++m) {
                const int row = u.pm * BM + ai * HALF + wr * 64 + m * 16 + fr; const float rs = r0[row];
#pragma unroll
                for (int bj = 0; bj < 2; ++bj) {
                    const int c8 = u.pn * BM + bj * HALF + wc * 32 + 8 * fq;
                    const u32x4 w = pack8(acc[ai][bj][m][0] * rs, acc[ai][bj][m][1] * rs);
                    if (u.pn < 2) *(u32x4*)(upool + (size_t)row * DPOOL + c8) = w;
                    else { const int cs = c8 - DPOOL, gg = cs >> 4, h0 = cs & 15, cr = row / TCH, p = row % TCH;
                           *(u32x4*)(ussm + ((size_t)(gg * NCR + cr) * ROWLEN + 16 * p + h0)) = w; }
                }
            }
    }
};
struct EpiFG {
    static constexpr bool PERM = false, AFTER_DRAIN = false, HAS_MID = false; static constexpr int MID_T = 0;
    float* fg;
    __device__ __forceinline__ void operator()(Acc& acc, const Unit& u, int wr, int wc, int fr, int fq) const {
#pragma unroll
        for (int ai = 0; ai < 2; ++ai)
#pragma unroll
            for (int m = 0; m < 4; ++m) {
                const int cr = u.pm * BM + ai * HALF + wr * 64 + m * 16 + fr; float* rowp = fg + ((size_t)u.g * NCR + cr) * 256 + wc * 32 + 4 * fq;
#pragma unroll
                for (int bj = 0; bj < 2; ++bj)
#pragma unroll
                    for (int n = 0; n < 2; ++n) *(f32x4*)(rowp + bj * HALF + n * 16) = acc[ai][bj][m][n];
            }
    }
};
struct cf { float r, i; };
__device__ __forceinline__ cf cmul(cf a, cf b) { return cf{a.r * b.r - a.i * b.i, a.r * b.i + a.i * b.r}; }
__device__ __forceinline__ cf cmad(cf a, cf b, cf c) { return cf{a.r * b.r - a.i * b.i + c.r, a.r * b.i + a.i * b.r + c.i}; }
template <int CTRL> __device__ __forceinline__ float dppz(float v) { return __builtin_bit_cast(float, __builtin_amdgcn_update_dpp(0, __builtin_bit_cast(int, v), CTRL, 0xf, 0xf, true)); }
template <int CTRL> __device__ __forceinline__ cf cdpp(cf v) { return cf{dppz<CTRL>(v.r), dppz<CTRL>(v.i)}; }
struct EpiScan {
    static constexpr bool PERM = false, AFTER_DRAIN = true, HAS_MID = false; static constexpr int MID_T = 0;
    const float* lamT; bf16_t* ussm;
    __device__ __forceinline__ void fused(Acc& acc, const Unit& u, int wr, int wc, int fr, int fq, LAS unsigned char* lds, int wid, int lane) const {
        LAS float* SEG = (LAS float*)lds;
        cf X[2][2][2][2];
        LAS unsigned char* CIM = lds + 8192;
#pragma unroll
        for (int bj = 0; bj < 2; ++bj)
#pragma unroll
            for (int np = 0; np < 2; ++np) {
                const int n0 = 16 * wc + 8 * np + 2 * fq;
                const f32x4 l4 = *(const f32x4*)(lamT + ((size_t)(bj * NG + u.g) * NS + n0) * 2);
#pragma unroll
                for (int e = 0; e < 2; ++e) {
                    const cf lam{l4[2 * e], l4[2 * e + 1]};
                    const cf l2 = cmul(lam, lam), M1 = cmul(l2, l2), M2 = cmul(M1, M1), M4 = cmul(M2, M2), M8 = cmul(M4, M4);
#pragma unroll
                    for (int ai = 0; ai < 2; ++ai) {
                        cf T;
                        if (bj == 0) { T = cf{acc[ai][bj][0][np][2 * e], acc[ai][bj][0][np][2 * e + 1]};
#pragma unroll
                            for (int m = 1; m < 4; ++m) T = cmad(lam, T, cf{acc[ai][bj][m][np][2 * e], acc[ai][bj][m][np][2 * e + 1]});
                            T = cmad(M1, cdpp<0x111>(T), T); T = cmad(M2, cdpp<0x112>(T), T); T = cmad(M4, cdpp<0x114>(T), T); T = cmad(M8, cdpp<0x118>(T), T);
                            X[bj][ai][np][e] = cdpp<0x111>(T);
                            if (fr == 15) *(LAS f32x2*)(SEG + ((bj * 4 + 2 * ai + wr) * 64 + n0 + e) * 2) = (f32x2){T.r, T.i};
                        } else {       T = cf{acc[ai][bj][3][np][2 * e], acc[ai][bj][3][np][2 * e + 1]};
#pragma unroll
                            for (int m = 2; m >= 0; --m) T = cmad(lam, T, cf{acc[ai][bj][m][np][2 * e], acc[ai][bj][m][np][2 * e + 1]});
                            T = cmad(M1, cdpp<0x101>(T), T); T = cmad(M2, cdpp<0x102>(T), T); T = cmad(M4, cdpp<0x104>(T), T); T = cmad(M8, cdpp<0x108>(T), T);
                            X[bj][ai][np][e] = cdpp<0x101>(T);
                            if (fr == 0) *(LAS f32x2*)(SEG + ((bj * 4 + 2 * ai + wr) * 64 + n0 + e) * 2) = (f32x2){T.r, T.i};
                        }
                    }
                }
            }
        LDS_WAIT(); __builtin_amdgcn_s_barrier(); asm volatile("" ::: "memory");
#pragma unroll
        for (int bj = 0; bj < 2; ++bj)
#pragma unroll
            for (int np = 0; np < 2; ++np) {
                const int n0 = 16 * wc + 8 * np + 2 * fq;
                const f32x4 l4 = *(const f32x4*)(lamT + ((size_t)(bj * NG + u.g) * NS + n0) * 2);
                cf C[2][4][2];
#pragma unroll
                for (int e = 0; e < 2; ++e) {
                    const cf lam{l4[2 * e], l4[2 * e + 1]};
                    const cf l2 = cmul(lam, lam), M1 = cmul(l2, l2), M2 = cmul(M1, M1), M4 = cmul(M2, M2), M8 = cmul(M4, M4), Q = cmul(M8, M8);
                    const int ex = bj == 0 ? fr : 15 - fr;
                    cf Mx{1.f, 0.f};
                    if (ex & 1) Mx = cmul(Mx, M1); if (ex & 2) Mx = cmul(Mx, M2); if (ex & 4) Mx = cmul(Mx, M4); if (ex & 8) Mx = cmul(Mx, M8);
#pragma unroll
                    for (int ai = 0; ai < 2; ++ai) {
                        const int sg = 2 * ai + wr; cf G{0.f, 0.f};
                        if (bj == 0) {
#pragma unroll
                            for (int sp = 0; sp < 3; ++sp) if (sp < sg) { const f32x2 t = *(const LAS f32x2*)(SEG + ((bj * 4 + sp) * 64 + n0 + e) * 2); G = cmad(Q, G, cf{t.x, t.y}); }
                            cf c = cmad(Mx, G, X[bj][ai][np][e]); C[ai][0][e] = c;
#pragma unroll
                            for (int m = 1; m < 4; ++m) { c = cmad(lam, c, cf{acc[ai][bj][m - 1][np][2 * e], acc[ai][bj][m - 1][np][2 * e + 1]}); C[ai][m][e] = c; }
                        } else {
#pragma unroll
                            for (int sp = 3; sp > 0; --sp) if (sp > sg) { const f32x2 t = *(const LAS f32x2*)(SEG + ((bj * 4 + sp) * 64 + n0 + e) * 2); G = cmad(Q, G, cf{t.x, t.y}); }
                            cf c = cmad(Mx, G, X[bj][ai][np][e]); C[ai][3][e] = c;
#pragma unroll
                            for (int m = 2; m >= 0; --m) { c = cmad(lam, c, cf{acc[ai][bj][m + 1][np][2 * e], acc[ai][bj][m + 1][np][2 * e + 1]}); C[ai][m][e] = c; }
                        }
                    }
                }
#pragma unroll
                for (int ai = 0; ai < 2; ++ai)
#pragma unroll
                    for (int m = 0; m < 4; ++m) { const int c = 128 * ai + 64 * wr + 4 * fr + m;
                        u32x2 w; w.x = cvt_pk_bf16(C[ai][m][0].r, C[ai][m][0].i); w.y = cvt_pk_bf16(C[ai][m][1].r, C[ai][m][1].i);
                        *(LAS u32x2*)(CIM + c * 520 + (bj * 128 + 2 * n0) * 2) = w; }
            }
        LDS_WAIT(); __builtin_amdgcn_s_barrier(); asm volatile("" ::: "memory");
#pragma unroll 8
        for (int r = wid; r < 256; r += 8)
            *(u32x2*)(ussm + ((size_t)(u.g * NCR + u.pm * NCHB + r) * ROWLEN + K1) + 4 * lane) = *(const LAS u32x2*)(CIM + r * 520 + 8 * lane);
    }
};
struct EpiZ {
    static constexpr bool PERM = true, AFTER_DRAIN = false, HAS_MID = false; static constexpr int MID_T = 0;
    const bf16_t* ussm; const float* dvec; bf16_t* zg;
    __device__ __forceinline__ void operator()(Acc& acc, const Unit& u, int wr, int wc, int fr, int fq) const {
#pragma unroll
        for (int bj = 0; bj < 2; ++bj) {
            const int c8 = u.pn * BM + bj * HALF + wc * 32 + 8 * fq;
            const f32x4 d0 = *(const f32x4*)(dvec + u.g * 16 + (c8 & 15)), d1 = *(const f32x4*)(dvec + u.g * 16 + (c8 & 15) + 4);
#pragma unroll
            for (int ai = 0; ai < 2; ++ai)
#pragma unroll
                for (int m = 0; m < 4; ++m) {
                    const int cr = u.pm * BM + ai * HALF + wr * 64 + m * 16 + fr;
                    const u32x4 uw = *(const u32x4*)(ussm + ((size_t)(u.g * NCR + cr) * ROWLEN + c8));
                    f32x4 u0, u1; unpack8(uw, u0, u1);
                    f32x4 y0 = acc[ai][bj][m][0] + d0 * u0, y1 = acc[ai][bj][m][1] + d1 * u1;
#pragma unroll
                    for (int i = 0; i < 4; ++i) { y0[i] = fast_gelu_tanh(y0[i]); y1[i] = fast_gelu_tanh(y1[i]); }
                    *(u32x4*)(zg + ((size_t)u.g * MT * 16 + (size_t)cr * K1 + c8)) = pack8(y0, y1);
                }
        }
    }
};
struct EpiPool {
    static constexpr bool PERM = true, AFTER_DRAIN = false, HAS_MID = false; static constexpr int MID_T = 0;
    const float* pscale; bf16_t* ycat; float* ss;
    __device__ __forceinline__ void operator()(Acc& acc, const Unit& u, int wr, int wc, int fr, int fq) const {
        f32x4 sc[2][2];
#pragma unroll
        for (int bj = 0; bj < 2; ++bj) { const int c8 = u.pn * BM + bj * HALF + wc * 32 + 8 * fq; sc[bj][0] = *(const f32x4*)(pscale + c8); sc[bj][1] = *(const f32x4*)(pscale + c8 + 4); }
#pragma unroll
        for (int ai = 0; ai < 2; ++ai)
#pragma unroll
            for (int m = 0; m < 4; ++m) {
                const int row = u.pm * BM + ai * HALF + wr * 64 + m * 16 + fr; float q = 0.f;
#pragma unroll
                for (int bj = 0; bj < 2; ++bj) {
                    const int c8 = u.pn * BM + bj * HALF + wc * 32 + 8 * fq;
                    const f32x4 v0 = acc[ai][bj][m][0] * sc[bj][0], v1 = acc[ai][bj][m][1] * sc[bj][1];
                    q += (v0[0] * v0[0] + v0[1] * v0[1]) + (v0[2] * v0[2] + v0[3] * v0[3]) + (v1[0] * v1[0] + v1[1] * v1[1]) + (v1[2] * v1[2] + v1[3] * v1[3]);
                    *(u32x4*)(ycat + (size_t)row * DM + c8) = pack8(v0, v1);
                }
                q += __shfl_xor(q, 16); q += __shfl_xor(q, 32);
                if (fq == 0) ss[(size_t)(u.pn * 4 + wc) * MT + row] = q;
            }
    }
};
struct EpiGlu {
    static constexpr bool PERM = true, AFTER_DRAIN = false, HAS_MID = false; static constexpr int MID_T = 0;
    const float* gb; const bf16_t* zg; bf16_t* ycat; float* ss;
    __device__ __forceinline__ void operator()(Acc& acc, const Unit& u, int wr, int wc, int fr, int fq) const {
        f32x4 bv[2][2];
#pragma unroll
        for (int bj = 0; bj < 2; ++bj) { const int c8 = u.pn * BM + bj * HALF + wc * 32 + 8 * fq; bv[bj][0] = *(const f32x4*)(gb + c8); bv[bj][1] = *(const f32x4*)(gb + c8 + 4); }
#pragma unroll
        for (int ai = 0; ai < 2; ++ai)
#pragma unroll
            for (int m = 0; m < 4; ++m) {
                const int row = u.pm * BM + ai * HALF + wr * 64 + m * 16 + fr; float q = 0.f;
#pragma unroll
                for (int bj = 0; bj < 2; ++bj) {
                    const int c8 = u.pn * BM + bj * HALF + wc * 32 + 8 * fq;
                    const u32x4 zw = *(const u32x4*)(zg + ((size_t)(c8 >> 4) * MT + row) * 16 + (c8 & 15));
                    f32x4 z0, z1; unpack8(zw, z0, z1);
                    f32x4 v0 = acc[ai][bj][m][0] + bv[bj][0], v1 = acc[ai][bj][m][1] + bv[bj][1];
#pragma unroll
                    for (int i = 0; i < 4; ++i) { v0[i] = z0[i] * fast_sigmoid(v0[i]); v1[i] = z1[i] * fast_sigmoid(v1[i]); }
                    q += (v0[0] * v0[0] + v0[1] * v0[1]) + (v0[2] * v0[2] + v0[3] * v0[3]) + (v1[0] * v1[0] + v1[1] * v1[1]) + (v1[2] * v1[2] + v1[3] * v1[3]);
                    *(u32x4*)(ycat + (size_t)row * DM + DPOOL + c8) = pack8(v0, v1);
                }
                q += __shfl_xor(q, 16); q += __shfl_xor(q, 32);
                if (fq == 0) ss[(size_t)(u.pn * 4 + wc) * MT + row] = q;
            }
    }
};
struct EpiOut {
    static constexpr bool PERM = true, AFTER_DRAIN = true, HAS_MID = true; static constexpr int MID_T = 8;
    const bf16_t* xb; bf16_t* h1b; float* ss; LAS f32x2* XR; float ratio[2][4];
    __device__ __forceinline__ void mid(Acc& acc, int wr, int fr) const {
#pragma unroll
        for (int ai = 0; ai < 2; ++ai)
#pragma unroll
            for (int m = 0; m < 4; ++m) { const float ratio = this->ratio[ai][m];
#pragma unroll
                for (int bj = 0; bj < 2; ++bj)
#pragma unroll
                    for (int n = 0; n < 2; ++n) acc[ai][bj][m][n] = acc[ai][bj][m][n] * ratio; }
    }
    __device__ __forceinline__ void fused(Acc& acc, const Unit& u, int wr, int wc, int fr, int fq, LAS unsigned char* lds, int wid, int lane) const {
        LAS float* P = (LAS float*)lds;
        const int col0 = u.pn * BM + wc * 32 + 8 * fq;
#pragma unroll
        for (int ai = 0; ai < 2; ++ai)
#pragma unroll
            for (int m = 0; m < 4; ++m) {
                const int lr = ai * HALF + wr * 64 + m * 16 + fr, row = u.pm * BM + lr; const float rs = XR[lr].y; float q = 0.f;
                const size_t prow = (size_t)(row >> 12) * PADROWS + 1 + (row & 4095);
#pragma unroll
                for (int bj = 0; bj < 2; ++bj) {
                    const int c = col0 + bj * HALF;
                    f32x4 x0, x1; unpack8(*(const u32x4*)(xb + (size_t)row * DM + c), x0, x1);
                    const f32x4 h0 = x0 + acc[ai][bj][m][0] * rs, h1v = x1 + acc[ai][bj][m][1] * rs;
                    q += (h0[0] * h0[0] + h0[1] * h0[1]) + (h0[2] * h0[2] + h0[3] * h0[3]) + (h1v[0] * h1v[0] + h1v[1] * h1v[1]) + (h1v[2] * h1v[2] + h1v[3] * h1v[3]);
                    *(u32x4*)(h1b + prow * DM + c) = pack8(h0, h1v);
                }
                q += __shfl_xor(q, 16); q += __shfl_xor(q, 32);
                if (fq == 0) P[lr * 4 + wc] = q;
            }
        LDS_WAIT(); __builtin_amdgcn_s_barrier(); asm volatile("" ::: "memory");
        const int tid = wid * 64 + lane;
        if (tid < 256) ss[(size_t)u.pn * MT + u.pm * BM + tid] = (P[tid * 4 + 0] + P[tid * 4 + 1]) + (P[tid * 4 + 2] + P[tid * 4 + 3]);
    }
};
struct EpiUp {
    static constexpr bool PERM = true, AFTER_DRAIN = false, HAS_MID = false; static constexpr int MID_T = 0;
    const LAS float* rsl; const float* cw; const float* cb; bf16_t* act;
    __device__ __forceinline__ void operator()(Acc& acc, const Unit& u, int wr, int wc, int fr, int fq) const {
        const int j = u.pm, b = u.g;
#pragma unroll
        for (int ai = 0; ai < 2; ++ai)
#pragma unroll
            for (int m = 0; m < 4; ++m) {
                const float rs = rsl[u.aux * 256 + 126 * wr + 64 * ai + 4 * fr + m];
#pragma unroll
                for (int bj = 0; bj < 2; ++bj)
#pragma unroll
                    for (int n = 0; n < 2; ++n) acc[ai][bj][m][n] = acc[ai][bj][m][n] * rs;
            }
        const int f0 = 128 * u.pn + 32 * wc + 8 * fq;
        u32x2 keep[8];
#pragma unroll
        for (int n = 0; n < 2; ++n) {
            const int fc = f0 + 4 * n;
            const f32x4 wv0 = *(const f32x4*)(cw + fc), wv1 = *(const f32x4*)(cw + DFF2 + fc), wv2 = *(const f32x4*)(cw + 2 * DFF2 + fc), bvv = *(const f32x4*)(cb + fc);
            const f32x4 wg0 = *(const f32x4*)(cw + DFF + fc), wg1 = *(const f32x4*)(cw + DFF2 + DFF + fc), wg2 = *(const f32x4*)(cw + 2 * DFF2 + DFF + fc), bgv = *(const f32x4*)(cb + DFF + fc);
#pragma unroll
            for (int ai = 0; ai < 2; ++ai) {
                f32x4 pv, pg, nv, ng;
#pragma unroll
                for (int i = 0; i < 4; ++i) {
                    pv[i] = dpp_ror1(fr == 15 ? acc[ai ^ 1][0][3][n][i] : acc[ai][0][3][n][i]); pg[i] = dpp_ror1(fr == 15 ? acc[ai ^ 1][1][3][n][i] : acc[ai][1][3][n][i]);
                    nv[i] = dpp_ror15(fr == 0 ? acc[ai ^ 1][0][0][n][i] : acc[ai][0][0][n][i]); ng[i] = dpp_ror15(fr == 0 ? acc[ai ^ 1][1][0][n][i] : acc[ai][1][0][n][i]);
                }
#pragma unroll
                for (int m = 0; m < 4; ++m) {
                    const f32x4 cv = acc[ai][0][m][n], cg = acc[ai][1][m][n];
                    const f32x4 v_prev = m > 0 ? acc[ai][0][m - 1][n] : pv, g_prev = m > 0 ? acc[ai][1][m - 1][n] : pg;
                    const f32x4 v_next = m < 3 ? acc[ai][0][m + 1][n] : nv, g_next = m < 3 ? acc[ai][1][m + 1][n] : ng;
                    f32x4 o;
#pragma unroll
                    for (int i = 0; i < 4; ++i) {
                        const float vv = bvv[i] + wv0[i] * v_prev[i] + wv1[i] * cv[i] + wv2[i] * v_next[i];
                        const float gg = bgv[i] + wg0[i] * g_prev[i] + wg1[i] * cg[i] + wg2[i] * g_next[i];
                        o[i] = vv * gg * fast_sigmoid(gg);
                    }
                    const u32x2 pk = pack4(o); const int gi = ai * 4 + m;
                    if (n == 0) keep[gi] = pk;
                    else { const int w = 64 * ai + 4 * fr + m, t = UPROWS * j + 126 * wr + w - 1;
                           if (t >= 0 && t < SEQ && w >= 1 && w <= 126) { u32x4 wv; wv.x = keep[gi].x; wv.y = keep[gi].y; wv.z = pk.x; wv.w = pk.y; *(u32x4*)(act + (size_t)(b * SEQ + t) * DFF + f0) = wv; } }
                }
            }
        }
    }
};
struct EpiDown {
    static constexpr bool PERM = true, AFTER_DRAIN = true, HAS_MID = false; static constexpr int MID_T = 0;
    const bf16_t* h1b; float* out; const float* gfin; float* ss; const XcdBarrier* bar;
    __device__ __forceinline__ void fused(Acc& acc, const Unit& u, int wr, int wc, int fr, int fq, LAS unsigned char* lds, int wid, int lane) const {
        LAS float* P = (LAS float*)lds;
        LAS float* Sr = (LAS float*)(lds + 8192);
        const int col0 = u.pn * BM + wc * 32 + 8 * fq;
#pragma unroll
        for (int ai = 0; ai < 2; ++ai)
#pragma unroll
            for (int m = 0; m < 4; ++m) {
                const int lr = ai * HALF + wr * 64 + m * 16 + fr, row = u.pm * BM + lr; float q = 0.f;
                const size_t prow = (size_t)(row >> 12) * PADROWS + 1 + (row & 4095);
#pragma unroll
                for (int bj = 0; bj < 2; ++bj) {
                    f32x4 b0, b1; unpack8(*(const u32x4*)(h1b + prow * DM + col0 + bj * HALF), b0, b1);
                    const f32x4 h0 = b0 + acc[ai][bj][m][0], h1v = b1 + acc[ai][bj][m][1];
                    acc[ai][bj][m][0] = h0; acc[ai][bj][m][1] = h1v;
                    q += (h0[0] * h0[0] + h0[1] * h0[1]) + (h0[2] * h0[2] + h0[3] * h0[3]) + (h1v[0] * h1v[0] + h1v[1] * h1v[1]) + (h1v[2] * h1v[2] + h1v[3] * h1v[3]);
                }
                q += __shfl_xor(q, 16); q += __shfl_xor(q, 32);
                if (fq == 0) P[lr * 4 + wc] = q;
            }
        LDS_WAIT(); __builtin_amdgcn_s_barrier(); asm volatile("" ::: "memory");
        const int tid = wid * 64 + lane;
        if (tid < 256) ss[(size_t)u.pn * MT + u.pm * BM + tid] = (P[tid * 4 + 0] + P[tid * 4 + 1]) + (P[tid * 4 + 2] + P[tid * 4 + 3]);
        xcd_barrier(*bar, tid);
        if (tid < 256) { const int row = u.pm * BM + tid; const float s = (ss[row] + ss[MT + row]) + (ss[2 * MT + row] + ss[3 * MT + row]); Sr[tid] = rsqrtf(s * (1.0f / DM) + EPS); }
        LDS_WAIT(); __builtin_amdgcn_s_barrier(); asm volatile("" ::: "memory");
#pragma unroll
        for (int bj = 0; bj < 2; ++bj) {
            const int c = col0 + bj * HALF; const f32x4 g0 = *(const f32x4*)(gfin + c), g1 = *(const f32x4*)(gfin + c + 4);
#pragma unroll
            for (int ai = 0; ai < 2; ++ai)
#pragma unroll
                for (int m = 0; m < 4; ++m) { const int lr = ai * HALF + wr * 64 + m * 16 + fr; const float r = Sr[lr]; float* o = out + (size_t)(u.pm * BM + lr) * DM + c;
                    *(f32x4*)o = acc[ai][bj][m][0] * r * g0; *(f32x4*)(o + 4) = acc[ai][bj][m][1] * r * g1; }
        }
    }
};

struct OrdOne { Unit u; __device__ bool next(int i, Unit& o) const { if (i > 0) return false; o = u; return true; } };
struct OrdSsmA { int c; __device__ bool next(int i, Unit& u) const { if (i > 0 || c >= 64) return false; const int x = c & 7, k = c >> 3; u.g = x * 4 + (k >> 1); u.pm = k & 1; u.pn = 0; u.aux = 0; return true; } };
struct OrdSsmB { int c; __device__ bool next(int i, Unit& u) const { if (i > 0 || c >= 128) return false; const int x = c & 7, k = c >> 3; u.g = x * 4 + (k >> 2); u.pm = k & 3; u.pn = 0; u.aux = 0; return true; } };
struct OrdPool { int c; __device__ bool next(int i, Unit& u) const { if (i > 0 || c < 128 || c >= 256) return false; const int cc = c - 128, x = cc & 7, k = cc >> 3; u.pm = x * 8 + (k >> 1); u.pn = k & 1; u.g = u.pn; u.aux = 0; return true; } };
struct OrdGlu  { int c; __device__ bool next(int i, Unit& u) const { if (i > 0 || c >= 128) return false; const int x = c & 7, k = c >> 3; u.pm = x * 8 + (k >> 1); u.pn = k & 1; u.g = 0; u.aux = 0; return true; } };
struct OrdUp { StaticOrder so; __device__ bool next(int i, Unit& u) const { if (!so.next(i, u)) return false; u.g = u.pm / UPT; u.pm = u.pm % UPT; u.aux = i; return true; } };

constexpr size_t WS_STAMP = 4 * MiB;
#if defined(MK_STAMP)
#define ST(k) do { if (F.tid == 0) ((unsigned long long*)(args.ws + WS_STAMP))[blockIdx.x * 64 + (k)] = __builtin_amdgcn_s_memrealtime(); } while (0)
#define GP_STAMP(base) ((unsigned long long*)(args.ws + WS_STAMP) + blockIdx.x * 64 + (base))
#define STC(k) do { if (F.tid == 0) ((unsigned long long*)(args.ws + WS_STAMP))[blockIdx.x * 64 + (k)] = __builtin_amdgcn_s_memtime(); } while (0)
#else
#define STC(k) do { } while (0)
#define ST(k) do { } while (0)
#define GP_STAMP(base) ((unsigned long long*)nullptr)
#endif
struct Args { const float* in[24]; float* out; unsigned char* ws; int ph_lo, ph_hi; };

struct Frame { LAS unsigned char* lds; int tid, lane, wave, G, bx; };

struct TrMat { const float* W; int K, N; const float* kg0; const float* kg1; int ksplit; bf16_t* WT; int map; int nitems; };
__device__ __forceinline__ void tr_load(const TrMat& m0, const TrMat& m1, int item, int lane, f32x4 (&v)[8]) {
    const bool second = item >= m0.nitems; const TrMat& m = second ? m1 : m0; const int it = second ? item - m0.nitems : item;
    const int nblk = m.N / 32, kb = it / nblk, nb = it % nblk, k0 = 64 * kb, n0 = 32 * nb, r = lane >> 3, c4 = lane & 7;
#pragma unroll
    for (int i = 0; i < 8; ++i) v[i] = *(const f32x4*)(m.W + (size_t)(k0 + 8 * i + r) * m.N + n0 + 4 * c4);
}
__device__ __forceinline__ void tr_store(const TrMat& m0, const TrMat& m1, int item, int lane, const f32x4 (&v)[8], LAS float* scr) {
    const bool second = item >= m0.nitems; const TrMat& m = second ? m1 : m0; const int it = second ? item - m0.nitems : item;
    const int nblk = m.N / 32, kb = it / nblk, nb = it % nblk, k0 = 64 * kb, n0 = 32 * nb, r = lane >> 3, c4 = lane & 7;
#pragma unroll
    for (int i = 0; i < 8; ++i) { const int kk = 8 * i + r, k = k0 + kk; float gn = 1.f; if (m.kg0) gn = (k < m.ksplit ? m.kg0[k] : m.kg1[k - m.ksplit]);
        LAS float* d = scr + kk * 33 + 4 * c4; d[0] = v[i][0] * gn; d[1] = v[i][1] * gn; d[2] = v[i][2] * gn; d[3] = v[i][3] * gn; }
    LDS_WAIT(); asm volatile("" ::: "memory");
    const int c = lane & 7;
#pragma unroll
    for (int j = 0; j < 4; ++j) { const int n = (lane >> 3) + 8 * j; const LAS float* q = scr + (8 * c) * 33 + n;
        u32x4 o; o.x = pk2(q[0 * 33], q[1 * 33]); o.y = pk2(q[2 * 33], q[3 * 33]); o.z = pk2(q[4 * 33], q[5 * 33]); o.w = pk2(q[6 * 33], q[7 * 33]);
        int nr = n0 + n;
        if (m.map == 1) { const int bj = nr / DFF, rem = nr % DFF; nr = 256 * (rem >> 7) + 128 * bj + (rem & 127); }
        *(u32x4*)(m.WT + (size_t)nr * m.K + k0 + 8 * c) = o; }
    LDS_WAIT(); asm volatile("" ::: "memory");
}
__device__ __forceinline__ void tr_run(const TrMat& m0, const TrMat& m1, int first, int stride, int lane, LAS float* scr) {
    const int total = m0.nitems + m1.nitems; f32x4 va[8], vb[8];
    int it = first; if (it < total) tr_load(m0, m1, it, lane, va);
    while (it < total) {
        const int n1 = it + stride; if (n1 < total) tr_load(m0, m1, n1, lane, vb);
        tr_store(m0, m1, it, lane, va, scr);
        if (n1 >= total) break;
        const int n2 = n1 + stride; if (n2 < total) tr_load(m0, m1, n2, lane, va);
        tr_store(m0, m1, n1, lane, vb, scr);
        it = n2;
    }
}

struct SsmLds { LAS float* Bre; LAS float* Bim; LAS float* Cre; LAS float* Cim; LAS float* PAR; LAS float* Pc; LAS float* Kl; };
__device__ __forceinline__ SsmLds ssm_lds(const Frame& F) { SsmLds L; L.Bre = (LAS float*)(F.lds); L.Bim = L.Bre + 2048; L.Cre = L.Bim + 2048; L.Cim = L.Cre + 2048; L.PAR = L.Cim + 2048; L.Pc = L.PAR + 512; L.Kl = L.Pc + 1024; return L; }
__device__ __forceinline__ void ssm_stage(const Args& a, const Frame& F, const SsmLds& L, int g) {
    const float* lnar = a.in[5]; const float* aim = a.in[6]; const float* ldt = a.in[7];
    const float* bre = a.in[8]; const float* bim = a.in[9]; const float* cre = a.in[10]; const float* cim = a.in[11];
    const int tid = F.tid;
    for (int i = tid; i < 2048; i += 512) { const int dir = i >> 10, r = i & 1023;
        L.Bre[i] = bre[((size_t)(dir * NG + g)) * 1024 + r]; L.Bim[i] = bim[((size_t)(dir * NG + g)) * 1024 + r];
        L.Cre[i] = cre[((size_t)(dir * NG + g)) * 1024 + r]; L.Cim[i] = cim[((size_t)(dir * NG + g)) * 1024 + r]; }
    if (tid < 128) { const int dir = tid >> 6, n = tid & 63;
        const float dt = expf(ldt[dir * NG + g]); const float a_re = -expf(lnar[(dir * NG + g) * NS + n]), a_im = aim[(dir * NG + g) * NS + n];
        const float mag = expf(a_re * dt), ang = a_im * dt; const float lam_re = mag * cosf(ang), lam_im = mag * sinf(ang);
        const float den = a_re * a_re + a_im * a_im;
        L.PAR[tid * 4 + 0] = a_re * dt; L.PAR[tid * 4 + 1] = ang;
        L.PAR[tid * 4 + 2] = ((lam_re - 1.0f) * a_re + lam_im * a_im) / den; L.PAR[tid * 4 + 3] = (lam_im * a_re - (lam_re - 1.0f) * a_im) / den; }
    __syncthreads();
}
__device__ __forceinline__ void ssm_build_tb(const Args& a, const Frame& F, const SsmLds& L, int g, int lag0, int nl) {
    bf16_t* KC = (bf16_t*)(a.ws + WS_TB) + (size_t)g * (2 * TCH) * 256;
    bf16_t* TBC = (bf16_t*)(a.ws + WS_TBC) + (size_t)g * K1 * 256;
    const int tid = F.tid;
    { const int li = tid >> 7, dn = tid & 127, lag = lag0 + li; const float ad = L.PAR[dn * 4 + 0], ang = L.PAR[dn * 4 + 1], fr_ = L.PAR[dn * 4 + 2], fi_ = L.PAR[dn * 4 + 3];
      const float mg = expf((float)lag * ad); float sn, cs; sincosf((float)lag * ang, &sn, &cs); const float lr = mg * cs, lim = mg * sn;
      L.Pc[(li * 128 + dn) * 2 + 0] = lr * fr_ - lim * fi_; L.Pc[(li * 128 + dn) * 2 + 1] = lr * fi_ + lim * fr_; }
    __syncthreads();
    { const int li = F.wave >> 1, dir = F.wave & 1, i16 = F.lane & 15, kq = F.lane >> 4; f32x4 kacc = {0.f, 0.f, 0.f, 0.f};
#pragma unroll 8
      for (int kk0 = 0; kk0 < 128; kk0 += 4) { const int kk = kk0 + kq, n = kk >> 1; const bool im = (kk & 1) != 0;
          const float cr_ = L.Cre[dir * 1024 + i16 * 64 + n], ci_ = L.Cim[dir * 1024 + i16 * 64 + n], pr = L.Pc[(li * 128 + dir * 64 + n) * 2], pi = L.Pc[(li * 128 + dir * 64 + n) * 2 + 1];
          const float av = im ? -(cr_ * pi + ci_ * pr) : (cr_ * pr - ci_ * pi);
          const float bv = im ? L.Bim[dir * 1024 + n * 16 + i16] : L.Bre[dir * 1024 + n * 16 + i16];
          kacc = __builtin_amdgcn_mfma_f32_16x16x4f32(av, bv, kacc, 0, 0, 0); }
#pragma unroll
      for (int r = 0; r < 4; ++r) L.Kl[li * 512 + dir * 256 + (kq * 4 + r) * 16 + i16] = kacc[r]; }
    __syncthreads();
    { const int li = tid >> 7, dir = (tid >> 6) & 1, e4 = tid & 63, lag = lag0 + li;
      if (li < nl && !(lag == 0 && dir == 1)) {
          f32x4 v = *(const LAS f32x4*)(L.Kl + li * 512 + dir * 256 + 4 * e4);
          if (lag == 0) v = v + *(const LAS f32x4*)(L.Kl + li * 512 + 256 + 4 * e4);
          const int d = dir == 0 ? (TCH - 1) + lag : (TCH - 1) - lag; u32x2 w; w.x = pk2(v[0], v[1]); w.y = pk2(v[2], v[3]);
          *(u32x2*)(KC + (size_t)d * 256 + 4 * e4) = w; } }
    __syncthreads();
    { const int li = tid >> 7, dn = tid & 127, dir = dn >> 6, p = lag0 + li; const float ad = L.PAR[dn * 4 + 0], ang = L.PAR[dn * 4 + 1]; const float e = dir == 0 ? (float)(p + 1) : (float)(TCH - p);
      const float mg = expf(e * ad); float sn, cs; sincosf(e * ang, &sn, &cs); L.Pc[(li * 128 + dn) * 2 + 0] = mg * cs; L.Pc[(li * 128 + dn) * 2 + 1] = mg * sn; }
    __syncthreads();
    for (int li = 0; li < nl; ++li) {
        const int p = lag0 + li, h = tid >> 5, dir = (tid >> 4) & 1, n4 = tid & 15; float v[8];
#pragma unroll
        for (int e = 0; e < 4; ++e) { const int n = 4 * n4 + e; const float cr_ = L.Cre[dir * 1024 + h * 64 + n], ci_ = L.Cim[dir * 1024 + h * 64 + n], pr = L.Pc[(li * 128 + dir * 64 + n) * 2], pi = L.Pc[(li * 128 + dir * 64 + n) * 2 + 1];
            v[2 * e] = cr_ * pr - ci_ * pi; v[2 * e + 1] = -(cr_ * pi + ci_ * pr); }
        u32x4 w; w.x = pk2(v[0], v[1]); w.y = pk2(v[2], v[3]); w.z = pk2(v[4], v[5]); w.w = pk2(v[6], v[7]);
        *(u32x4*)(TBC + (size_t)(16 * p + h) * 256 + dir * 128 + 8 * n4) = w;
    }
    __syncthreads();
}
__device__ __forceinline__ void ssm_build_wab(const Args& a, const Frame& F, const SsmLds& L, int g, int jq) {
    bf16_t* WAB = (bf16_t*)(a.ws + WS_WAB) + (size_t)g * 256 * K1;
    const int tid = F.tid;
    if (jq == 0 && tid < 128) { const int dir = tid >> 6, n = tid & 63; const float ad = L.PAR[tid * 4 + 0], ang = L.PAR[tid * 4 + 1];
        const float mg = expf((float)TCH * ad); float sn, cs; sincosf((float)TCH * ang, &sn, &cs); *(f32x2*)((float*)(a.ws + WS_LAMT) + ((size_t)(dir * NG + g) * NS + n) * 2) = (f32x2){mg * cs, mg * sn}; }
    { const int li = tid >> 7, dn = tid & 127, dir = dn >> 6, q = 4 * jq + li; const float ad = L.PAR[dn * 4 + 0], ang = L.PAR[dn * 4 + 1], fr_ = L.PAR[dn * 4 + 2], fi_ = L.PAR[dn * 4 + 3]; const float e = dir == 0 ? (float)(TCH - 1 - q) : (float)q;
      const float mg = expf(e * ad); float sn, cs; sincosf(e * ang, &sn, &cs); const float lr = mg * cs, lim = mg * sn;
      L.Pc[(li * 128 + dn) * 2 + 0] = lr * fr_ - lim * fi_; L.Pc[(li * 128 + dn) * 2 + 1] = lr * fi_ + lim * fr_; }
    __syncthreads();
#pragma unroll
    for (int half = 0; half < 2; ++half) {
        const int li = 2 * half + (tid >> 8), q = 4 * jq + li, t2 = tid & 255, dir = t2 >> 7, n = (t2 >> 1) & 63, part = t2 & 1;
        const float pr = L.Pc[(li * 128 + dir * 64 + n) * 2], pi = L.Pc[(li * 128 + dir * 64 + n) * 2 + 1]; float v[16];
#pragma unroll
        for (int i = 0; i < 16; ++i) { const float br_ = L.Bre[dir * 1024 + n * 16 + i], bi_ = L.Bim[dir * 1024 + n * 16 + i]; v[i] = part == 0 ? (pr * br_ - pi * bi_) : (pr * bi_ + pi * br_); }
        u32x4 w0, w1; w0.x = pk2(v[0], v[1]); w0.y = pk2(v[2], v[3]); w0.z = pk2(v[4], v[5]); w0.w = pk2(v[6], v[7]); w1.x = pk2(v[8], v[9]); w1.y = pk2(v[10], v[11]); w1.z = pk2(v[12], v[13]); w1.w = pk2(v[14], v[15]);
        bf16_t* dst = WAB + (size_t)(dir * 128 + 2 * n + part) * K1 + 16 * q; *(u32x4*)dst = w0; *(u32x4*)(dst + 8) = w1;
    }
    __syncthreads();
}

__device__ __forceinline__ void p0_prologue(const Args& a, const Frame& F) {
    const float* x = a.in[0];
    { const SsmLds L = ssm_lds(F);
      for (int it = F.bx; it < NG * (TCH / 4); it += F.G) { ssm_stage(a, F, L, it / (TCH / 4)); ssm_build_wab(a, F, L, it / (TCH / 4), it % (TCH / 4)); } }
    __syncthreads();
    LAS float* scr = (LAS float*)(F.lds + F.wave * 16384);
    const int gw = F.bx * 8 + F.wave, NGW = F.G * 8;
    { const TrMat m0{a.in[2], DM, DM, a.in[1], a.in[1], DM, (bf16_t*)(a.ws + WS_WIN), 0, (DM / 64) * (DM / 32)}; const TrMat m1{nullptr, 0, 32, nullptr, nullptr, 0, nullptr, 0, 0};
      tr_run(m0, m1, gw, NGW, F.lane, scr); }
    { bf16_t* PW = (bf16_t*)(a.ws + WS_PW); const float* pw = a.in[3];
      for (int idx = F.bx * 512 + F.tid; idx < 2 * 256 * 256; idx += F.G * 512) { const int pn = idx >> 16, j = (idx >> 8) & 255, k = idx & 255;
          const float v = ((j >> 7) == (k >> 7)) ? pw[((size_t)(2 * pn + (j >> 7)) * 128 + (k & 127)) * 128 + (j & 127)] : 0.f; PW[idx] = (bf16_t)f2bf(v); } }
    { bf16_t* h1b = (bf16_t*)(a.ws + WS_H1B);
      for (int idx = F.bx * 512 + F.tid; idx < BATCH * 256 * (DM / 8); idx += F.G * 512) { const int b = idx / (256 * 128), r = (idx / 128) % 256, c = idx % 128; const int prow = b * PADROWS + (r == 0 ? 0 : 4096 + r);
          *(u32x4*)(h1b + (size_t)prow * DM + 8 * c) = (u32x4){0u, 0u, 0u, 0u}; } }
    { bf16_t* xb = (bf16_t*)(a.ws + WS_XB); float* r0 = (float*)(a.ws + WS_R0);
      for (int row = gw; row < MT; row += NGW) {
          const f32x4* xr = (const f32x4*)(x + (size_t)row * DM) + F.lane; f32x4 v[4]; float s = 0.f;
#pragma unroll
          for (int j = 0; j < 4; ++j) { v[j] = xr[64 * j]; s += (v[j][0] * v[j][0] + v[j][1] * v[j][1]) + (v[j][2] * v[j][2] + v[j][3] * v[j][3]); }
          s = wave_sum(s); if (F.lane == 0) r0[row] = rsqrtf(s * (1.0f / DM) + EPS);
          u32x2* o = (u32x2*)(xb + (size_t)row * DM) + F.lane;
#pragma unroll
          for (int j = 0; j < 4; ++j) o[64 * j] = pack4(v[j]);
      } }
}

__device__ __forceinline__ void p2_side(const Args& a, const Frame& F, int first_block) {
    const int nb = F.G - first_block, sb = F.bx - first_block;
    { const SsmLds L = ssm_lds(F);
      int id = (sb * (NG * TCH)) / nb; const int id_end = ((sb + 1) * (NG * TCH)) / nb; int staged = -1;
      while (id < id_end) {
          const int g = id / TCH, lag0 = id % TCH; int nl = TCH - lag0; if (nl > 4) nl = 4; if (nl > id_end - id) nl = id_end - id;
          if (g != staged) { ssm_stage(a, F, L, g); staged = g; }
          ssm_build_tb(a, F, L, g, lag0, nl); id += nl;
      } }
    __syncthreads();
    LAS float* scr = (LAS float*)(F.lds + F.wave * 16384);
    const TrMat m0{a.in[13], DSSM, DSSM, nullptr, nullptr, 0, (bf16_t*)(a.ws + WS_WGLU), 0, (DSSM / 64) * (DSSM / 32)}; const TrMat m1{nullptr, 0, 32, nullptr, nullptr, 0, nullptr, 0, 0};
    tr_run(m0, m1, sb * 8 + F.wave, nb * 8, F.lane, scr);
}
__device__ __forceinline__ void ssm_side(const Args& a, const Frame& F, int first_block) {
    const int nb = F.G - first_block, sb = F.bx - first_block;
    { const SsmLds L = ssm_lds(F);
      const int g = sb >> 2, lag0 = (sb & 3) * 4;
#if defined(MK_STAMP)
#define STS(k) do { if (F.tid == 0) ((unsigned long long*)(a.ws + WS_STAMP))[blockIdx.x * 64 + (k)] = __builtin_amdgcn_s_memrealtime(); } while (0)
#else
#define STS(k) do { } while (0)
#endif
      ssm_stage(a, F, L, g); STS(45); ssm_build_tb(a, F, L, g, lag0, 4); STS(46);
      VM_WAIT(); __syncthreads();
      if (F.tid == 0) { __builtin_amdgcn_fence(__ATOMIC_RELEASE, "agent"); asm volatile("s_waitcnt vmcnt(0)" ::: "memory");
          __hip_atomic_fetch_add((unsigned*)(a.ws + WS_CTL) + CW_TBCNT + 64 * g, 4u, __ATOMIC_RELAXED, __HIP_MEMORY_SCOPE_AGENT); } }
    __syncthreads();
#if defined(MK_STAMP)
    if (F.tid == 0) ((unsigned long long*)(a.ws + WS_STAMP))[blockIdx.x * 64 + 43] = __builtin_amdgcn_s_memrealtime();
#endif
    LAS float* scr = (LAS float*)(F.lds + F.wave * 16384);
    const TrMat m0{a.in[17], DM, DM, a.in[15], a.in[16], DPOOL, (bf16_t*)(a.ws + WS_WOUT), 0, (DM / 64) * (DM / 32)};
    const TrMat m1{a.in[13], DSSM, DSSM, nullptr, nullptr, 0, (bf16_t*)(a.ws + WS_WGLU), 0, (DSSM / 64) * (DSSM / 32)};
    tr_run(m0, m1, sb * 8 + F.wave, nb * 8, F.lane, scr);
    const TrMat m2{a.in[22], DFF, DM, nullptr, nullptr, 0, (bf16_t*)(a.ws + WS_WDOWN), 0, (DFF / 64) * (DM / 32)}; const TrMat m3{nullptr, 0, 32, nullptr, nullptr, 0, nullptr, 0, 0};
    tr_run(m2, m3, sb * 8 + F.wave, nb * 8, F.lane, scr);
}
__device__ __forceinline__ void tb_wait(const Args& a, const Frame& F, int g) {
    if (F.tid == 0) { unsigned* cnt = (unsigned*)(a.ws + WS_CTL) + CW_TBCNT + 64 * g; unsigned sp = 0;
        while (__hip_atomic_load(cnt, __ATOMIC_RELAXED, __HIP_MEMORY_SCOPE_AGENT) < (unsigned)TCH) { __builtin_amdgcn_s_sleep(2); if (++sp > (1u << 20)) break; }
        __builtin_amdgcn_fence(__ATOMIC_ACQUIRE, "agent"); asm volatile("s_waitcnt vmcnt(0)" ::: "memory"); }
    __syncthreads();
}
__device__ __forceinline__ void p3_side(const Args& a, const Frame& F, int first_block) {
    const int nb = F.G - first_block, sb = F.bx - first_block;
    LAS float* scr = (LAS float*)(F.lds + F.wave * 16384);
    const TrMat m0{a.in[17], DM, DM, a.in[15], a.in[16], DPOOL, (bf16_t*)(a.ws + WS_WOUT), 0, (DM / 64) * (DM / 32)}; const TrMat m1{nullptr, 0, 32, nullptr, nullptr, 0, nullptr, 0, 0};
    tr_run(m0, m1, sb * 8 + F.wave, nb * 8, F.lane, scr);
}
__device__ __forceinline__ void p4_side(const Args& a, const Frame& F, int first_block) {
    const int nb = F.G - first_block, sb = F.bx - first_block;
    LAS float* scr = (LAS float*)(F.lds + F.wave * 16384);
    const TrMat m0{a.in[19], DM, DFF2, a.in[18], a.in[18], DM, (bf16_t*)(a.ws + WS_WUP), 1, (DM / 64) * (DFF2 / 32)};
    const TrMat m1{nullptr, 0, 32, nullptr, nullptr, 0, nullptr, 0, 0};
    tr_run(m0, m1, sb * 8 + F.wave, nb * 8, F.lane, scr);
}

__device__ __forceinline__ void p2_pooled(const Args& a, const Frame& F, int first_block) {
    const bf16_t* up = (const bf16_t*)(a.ws + WS_UPOOL); bf16_t* po = (bf16_t*)(a.ws + WS_POOLED);
    const int gw = (F.bx - first_block) * 8 + F.wave, NGW = (F.G - first_block) * 8;
    const int c0 = 8 * F.lane, half = 1 << (F.lane >> 4);
    for (int blk = gw; blk < MT / 4; blk += NGW) {
        const int row0 = blk * 4, b = row0 / SEQ, t0 = row0 % SEQ;
        u32x4 w[19];
#pragma unroll
        for (int o = 0; o < 19; ++o) { int q = t0 + o - 8; q = q < 0 ? 0 : (q >= SEQ ? SEQ - 1 : q); w[o] = *(const u32x4*)(up + (size_t)(b * SEQ + q) * DPOOL + c0); }
#pragma unroll
        for (int r = 0; r < 4; ++r) {
            f32x4 s0 = {0.f, 0.f, 0.f, 0.f}, s1 = {0.f, 0.f, 0.f, 0.f}; float cnt = 0.f;
#pragma unroll
            for (int d = -8; d < 8; ++d) { const int q = t0 + r + d; const float m = (d >= -half && d < half && q >= 0 && q < SEQ) ? 1.f : 0.f; f32x4 a0, a1; unpack8(w[r + d + 8], a0, a1); s0 = s0 + a0 * m; s1 = s1 + a1 * m; cnt += m; }
            f32x4 c0v, c1v; unpack8(w[r + 8], c0v, c1v);
            const float inv = __builtin_amdgcn_rcpf(cnt);
            *(u32x4*)(po + (size_t)(row0 + r) * DPOOL + c0) = pack8(s0 * inv - c0v, s1 * inv - c1v);
        }
    }
}

__device__ __forceinline__ void p3_carries(const Args& a, const Frame& F, int g, int b) {
    static_assert(NCHB == 256, "8 segments of 32 chunks");
    LAS float* TOT = (LAS float*)(F.lds);
    const int seg = F.tid >> 6, n = F.tid & 63;
    for (int dir = 0; dir < 2; ++dir) {
        const float dt = expf(a.in[7][dir * NG + g]); const float a_re = -expf(a.in[5][(dir * NG + g) * NS + n]), a_im = a.in[6][(dir * NG + g) * NS + n];
        const float mg = expf((float)TCH * (a_re * dt)); float sn, cs; sincosf((float)TCH * (a_im * dt), &sn, &cs); const float lr = mg * cs, li = mg * sn;
        const float* fg = (const float*)(a.ws + WS_FG) + ((size_t)g * NCR + (size_t)b * NCHB) * 256 + dir * 128 + 2 * n;
        bf16_t* us = (bf16_t*)(a.ws + WS_USSM) + ((size_t)g * NCR + (size_t)b * NCHB) * ROWLEN + K1 + dir * 128 + 2 * n;
        f32x2 f[32];
#pragma unroll
        for (int k = 0; k < 32; ++k) { const int i = 32 * seg + k, c = dir == 0 ? i : NCHB - 1 - i; f[k] = *(const f32x2*)(fg + (size_t)c * 256); }
        float sr = 0.f, si = 0.f;
#pragma unroll
        for (int k = 0; k < 32; ++k) { const float nr = lr * sr - li * si + f[k].x, ni = lr * si + li * sr + f[k].y; sr = nr; si = ni; }
        TOT[F.tid * 2] = sr; TOT[F.tid * 2 + 1] = si;
        float pr = lr, pi = li;
#pragma unroll
        for (int q = 0; q < 5; ++q) { const float nr = pr * pr - pi * pi, ni = 2.f * pr * pi; pr = nr; pi = ni; }
        __syncthreads();
        sr = 0.f; si = 0.f;
        for (int s2 = 0; s2 < seg; ++s2) { const int o = (s2 * 64 + n) * 2; const float tr = TOT[o], ti = TOT[o + 1]; const float nr = pr * sr - pi * si + tr, ni = pr * si + pi * sr + ti; sr = nr; si = ni; }
#pragma unroll
        for (int k = 0; k < 32; ++k) { const int i = 32 * seg + k, c = dir == 0 ? i : NCHB - 1 - i;
            *(unsigned*)(us + (size_t)c * ROWLEN) = pk2(sr, si);
            const float nr = lr * sr - li * si + f[k].x, ni = lr * si + li * sr + f[k].y; sr = nr; si = ni; }
        __syncthreads();
    }
    VM_WAIT(); __syncthreads();
}

__global__ void __launch_bounds__(512, 2) mk_fwd(Args args) {
    extern __shared__ __attribute__((aligned(16))) unsigned char lds_raw[];
    Frame F; F.lds = (LAS unsigned char*)lds_raw; F.tid = threadIdx.x; F.lane = F.tid & 63; F.wave = __builtin_amdgcn_readfirstlane(F.tid >> 6); F.G = gridDim.x; F.bx = blockIdx.x;
    volatile LAS unsigned* MISC = (volatile LAS unsigned*)(F.lds + LDSCTL_OFF);
    for (int u = F.tid; u < (LDS_BYTES - LDSCTL_OFF) / 4; u += 512) ((LAS unsigned*)(F.lds + LDSCTL_OFF))[u] = 0u;
    __syncthreads();
    unsigned char* ws = args.ws;
    XcdBarrier bar = xcd_barrier_post((unsigned*)(ws + WS_CTL), MISC + 8);
    const int lo = args.ph_lo, hi = args.ph_hi;
#define IN(k) (lo <= (k) && (k) < hi)
#define BOTH(k) (IN(k) && IN((k) == 2 ? 4 : (k) + 1))
    if (IN(0)) { ST(0); p0_prologue(args, F); ST(1); if (BOTH(0)) xcd_barrier(bar, F.tid); }
    if (IN(1)) { F.lane = lane_id_fresh(); F.tid = F.wave * 64 + F.lane; ST(2);
        GemmDesc g{(const char*)(ws + WS_XB), (const char*)(ws + WS_WIN), 256L * DM * 2, 0, 256L * DM * 2, 0, 128L * DM * 2, 128L * DM * 2, 128, 128, DM / BK};
        unsigned vA[2], vB[2]; voff_std(vA, DM, false, F.tid); voff_std(vB, DM, true, F.tid);
        StaticOrder S; S.init(MT / BM, DM / BM, F.G, F.bx);
        EpiU E{(const float*)(ws + WS_R0), (bf16_t*)(ws + WS_UPOOL), (bf16_t*)(ws + WS_USSM)};
        gemm_phase<EpiU, StaticOrder, true>(F.lds, g, vA, vB, S, E, F.tid, GP_STAMP(22));
        ST(3);
        if (BOTH(1)) xcd_barrier(bar, F.tid);
#if defined(MK_EXTRA_BAR)
        for (int rep = 0; rep < MK_EXTRA_BAR; ++rep) xcd_barrier(bar, F.tid);
#endif
    }
    if (IN(2)) { F.lane = lane_id_fresh(); F.tid = F.wave * 64 + F.lane; ST(4);
        if (F.bx < 128) {
            OrdSsmB S0{F.bx}; Unit u0; S0.next(0, u0);
            { GemmDesc g{(const char*)(ws + WS_USSM), (const char*)(ws + WS_WAB), 256L * ROWLEN * 2, (long)NCR * ROWLEN * 2, 0, 256L * K1 * 2, 128L * ROWLEN * 2, 128L * K1 * 2, 128, 128, K1 / BK};
              unsigned vA[2], vB[2]; voff_std(vB, K1, false, F.tid);
#pragma unroll
              for (int i = 0; i < 2; ++i) { int R, C; stage_rc(F.tid * 16 + i * 8192, R, C);
                  vA[i] = (unsigned)(((64 * (R >> 6) + 4 * (R & 15) + ((R >> 4) & 3)) * ROWLEN + C) * 2); }
              OrdOne S{u0}; EpiScan E{(const float*)(ws + WS_LAMT), (bf16_t*)(ws + WS_USSM)};
              gemm_phase<EpiScan, OrdOne, false>(F.lds, g, vA, vB, S, E, F.tid, GP_STAMP(24)); }
            VM_WAIT(); __syncthreads(); ST(40); ST(41);
            tb_wait(args, F, u0.g); ST(42);
            F.lane = lane_id_fresh(); F.tid = F.wave * 64 + F.lane;
            { GemmDesc g{(const char*)(ws + WS_USSM), (const char*)(ws + WS_TB), 256L * ROWLEN * 2, (long)NCR * ROWLEN * 2, 0, (2L * TCH) * 512, 128L * ROWLEN * 2, 8L * 512, 128, -4L * 512, ROWLEN / BK,
                         (const char*)(ws + WS_TBC), 0, (long)K1 * 512, 128L * 512, 128, K1 / BK};
              unsigned vA[2], vB[2], vB2[2]; voff_std(vA, ROWLEN, false, F.tid); voff_std(vB2, 256, true, F.tid);
#pragma unroll
              for (int i = 0; i < 2; ++i) { int R, C; stage_rc(F.tid * 16 + i * 8192, R, C); const int Rb = (R & ~31) + perm32(R & 31);
                  vB[i] = (unsigned)((((Rb >> 4) - (C >> 4) + (TCH - 1)) * 256 + (Rb & 15) * 16 + (C & 15)) * 2); }
              asm volatile("" : "+v"(vA[0]), "+v"(vA[1]), "+v"(vB[0]), "+v"(vB[1]), "+v"(vB2[0]), "+v"(vB2[1]));
              OrdOne S{u0}; EpiZ E{(const bf16_t*)(ws + WS_USSM), args.in[12], (bf16_t*)(ws + WS_ZG)};
              gemm_phase<EpiZ, OrdOne, true, true>(F.lds, g, vA, vB, S, E, F.tid, GP_STAMP(26), vB2); }
        } else { ssm_side(args, F, 128); ST(44); p2_pooled(args, F, 128); }
        ST(5);
        if (BOTH(2)) xcd_barrier(bar, F.tid);
    }
    if (IN(4)) { F.lane = lane_id_fresh(); F.tid = F.wave * 64 + F.lane; ST(8);
        if (F.bx < 128) {
            constexpr long GSTR = (long)MT * 32;
            GemmDesc g{(const char*)(ws + WS_ZG), (const char*)(ws + WS_WGLU), 256L * 32, 0, 256L * DSSM * 2, 0, 128L * 32, 128L * DSSM * 2, 4 * GSTR, 128, DSSM / BK};
            unsigned vA[2], vB[2]; voff_std(vB, DSSM, true, F.tid);
#pragma unroll
            for (int i = 0; i < 2; ++i) { int R, C; stage_rc(F.tid * 16 + i * 8192, R, C); vA[i] = (unsigned)(R * 32 + (C >> 4) * (int)GSTR + (C & 15) * 2); }
            OrdGlu S{F.bx}; EpiGlu E{args.in[14], (const bf16_t*)(ws + WS_ZG), (bf16_t*)(ws + WS_YCAT), (float*)(ws + WS_SSSSM)};
            gemm_phase<EpiGlu, OrdGlu, true>(F.lds, g, vA, vB, S, E, F.tid, GP_STAMP(28));
        } else {
            GemmDesc g{(const char*)(ws + WS_POOLED), (const char*)(ws + WS_PW), 256L * DPOOL * 2, 256L * 2, 256L * 256 * 2, 0, 128L * DPOOL * 2, 128L * 256 * 2, 128, 128, 256 / BK};
            unsigned vA[2], vB[2]; voff_std(vA, DPOOL, false, F.tid); voff_std(vB, 256, true, F.tid);
            OrdPool S{F.bx}; EpiPool E{args.in[4], (bf16_t*)(ws + WS_YCAT), (float*)(ws + WS_SSPOOL)};
            gemm_phase<EpiPool, OrdPool, true>(F.lds, g, vA, vB, S, E, F.tid, GP_STAMP(36));

            __syncthreads();
            p4_side(args, F, 128);
        }
        ST(9);
        if (BOTH(4)) xcd_barrier(bar, F.tid);
    }
    if (IN(5)) { F.lane = lane_id_fresh(); F.tid = F.wave * 64 + F.lane; ST(10);
        StaticOrder S; S.init(MT / BM, DM / BM, F.G, F.bx); Unit u0;
        LAS f32x2* XR = (LAS f32x2*)(F.lds + XTRA_OFF);
        if (S.next(0, u0)) {
            if (F.tid < 256) { const int row = u0.pm * BM + F.tid; const float* sp = (const float*)(ws + WS_SSPOOL); const float* sm = (const float*)(ws + WS_SSSSM); float a0 = 0.f, a1 = 0.f;
#pragma unroll
                for (int s = 0; s < 8; ++s) { a0 += sp[(size_t)s * MT + row]; a1 += sm[(size_t)s * MT + row]; }
                const float rp = rsqrtf(a0 * (1.0f / DPOOL) + EPS), rsm = rsqrtf(a1 * (1.0f / DSSM) + EPS); XR[F.tid] = (f32x2){rp / rsm, rsm}; }
        }
        __syncthreads();
        GemmDesc g{(const char*)(ws + WS_YCAT), (const char*)(ws + WS_WOUT), 256L * DM * 2, 0, 256L * DM * 2, 0, 128L * DM * 2, 128L * DM * 2, 128, 128, DM / BK};
        unsigned vA[2], vB[2]; voff_std(vA, DM, false, F.tid); voff_std(vB, DM, true, F.tid);
        EpiOut E{(const bf16_t*)(ws + WS_XB), (bf16_t*)(ws + WS_H1B), (float*)(ws + WS_SSH1), XR, {{0.f, 0.f, 0.f, 0.f}, {0.f, 0.f, 0.f, 0.f}}};
        { const int wr_ = F.wave >> 2, fr_ = F.lane & 15;
#pragma unroll
          for (int ai = 0; ai < 2; ++ai)
#pragma unroll
              for (int m = 0; m < 4; ++m) E.ratio[ai][m] = XR[ai * HALF + wr_ * 64 + m * 16 + fr_].x; }
        gemm_phase<EpiOut, StaticOrder, false>(F.lds, g, vA, vB, S, E, F.tid, GP_STAMP(30));
        ST(11);
        if (BOTH(5)) xcd_barrier(bar, F.tid);
    }
    if (IN(6)) { F.lane = lane_id_fresh(); F.tid = F.wave * 64 + F.lane; ST(12);
        GemmDesc g{(const char*)(ws + WS_H1B), (const char*)(ws + WS_WUP), (long)UPROWS * DM * 2, (long)PADROWS * DM * 2, 256L * DM * 2, 0, 64L * DM * 2, 128L * DM * 2, 128, 128, DM / BK};
        unsigned vA[2], vB[2]; voff_std(vB, DM, true, F.tid);
#pragma unroll
        for (int i = 0; i < 2; ++i) { int R, C; stage_rc(F.tid * 16 + i * 8192, R, C); vA[i] = (unsigned)(((126 * (R >> 6) + 4 * (R & 15) + ((R >> 4) & 3)) * DM + C) * 2); }
        OrdUp S; S.so.init(BATCH * UPT, DFF2 / BM, F.G, F.bx);
        LAS float* RSL = (LAS float*)(F.lds + XTRA_OFF);
        if (F.tid < 256) { const float* ssh1 = (const float*)(ws + WS_SSH1);
#pragma unroll
            for (int i = 0; i < 6; ++i) { Unit uu; if (S.next(i, uu)) { const int t = UPROWS * uu.pm + F.tid - 1; const bool in = (t >= 0 && t < SEQ && F.tid < 254); const int tok = uu.g * SEQ + (in ? t : 0);
                const float sq = (ssh1[tok] + ssh1[MT + tok]) + (ssh1[2 * MT + tok] + ssh1[3 * MT + tok]); RSL[i * 256 + F.tid] = in ? rsqrtf(sq * (1.0f / DM) + EPS) : 0.f; } } }
        __syncthreads();
        EpiUp E{RSL, args.in[20], args.in[21], (bf16_t*)(ws + WS_ACT)};
        STC(50); ST(52);
#if defined(EXP_P6_NOALIGN)
        gemm_phase<EpiUp, OrdUp, false>(F.lds, g, vA, vB, S, E, F.tid, GP_STAMP(32));
#else
        gemm_phase<EpiUp, OrdUp, true>(F.lds, g, vA, vB, S, E, F.tid, GP_STAMP(32));
#endif
        STC(51); ST(53);
        ST(13);
        if (BOTH(6)) xcd_barrier(bar, F.tid);
    }
    if (IN(7)) { F.lane = lane_id_fresh(); F.tid = F.wave * 64 + F.lane; ST(14);
        GemmDesc g{(const char*)(ws + WS_ACT), (const char*)(ws + WS_WDOWN), 256L * DFF * 2, 0, 256L * DFF * 2, 0, 128L * DFF * 2, 128L * DFF * 2, 128, 128, DFF / BK};
        unsigned vA[2], vB[2]; voff_std(vA, DFF, false, F.tid); voff_std(vB, DFF, true, F.tid);
        StaticOrder S; S.init(MT / BM, DM / BM, F.G, F.bx);
        EpiDown E{(const bf16_t*)(ws + WS_H1B), args.out, args.in[23], (float*)(ws + WS_SSH2), &bar};
        STC(54); ST(56);
        gemm_phase<EpiDown, StaticOrder, false>(F.lds, g, vA, vB, S, E, F.tid, GP_STAMP(34)); ST(15); STC(55); ST(57);
    }
#undef IN
#undef BOTH
}
}

__global__ void k_cvt_u(const bf16_t* __restrict__ upool, const bf16_t* __restrict__ ussm, float* __restrict__ u) {
    const int idx = blockIdx.x * blockDim.x + threadIdx.x; if (idx >= MT * DM) return;
    const int c = idx % DM, row = idx / DM; unsigned short v;
    if (c < DPOOL) v = upool[(size_t)row * DPOOL + c];
    else { const int cs = c - DPOOL, g = cs >> 4, h = cs & 15, cr = row / mk::TCH, p = row % mk::TCH; v = ussm[((size_t)(g * mk::NCR + cr)) * mk::ROWLEN + 16 * p + h]; }
    u[idx] = __builtin_bit_cast(float, (unsigned)v << 16);
}
__global__ void k_cvt_z(const bf16_t* __restrict__ zg, float* __restrict__ z) {
    const int idx = blockIdx.x * blockDim.x + threadIdx.x; if (idx >= MT * DSSM) return;
    const int c = idx % DSSM, row = idx / DSSM; const unsigned short v = zg[((size_t)(c >> 4) * MT + row) * 16 + (c & 15)];
    z[idx] = __builtin_bit_cast(float, (unsigned)v << 16);
}
__global__ void k_cvt_rows(const bf16_t* __restrict__ src, int lds_, float* __restrict__ dst, int ldd, int cols, int rows) {
    const size_t idx = (size_t)blockIdx.x * blockDim.x + threadIdx.x; if (idx >= (size_t)rows * cols) return;
    const int c = (int)(idx % cols); const size_t row = idx / cols; dst[row * ldd + c] = __builtin_bit_cast(float, (unsigned)src[row * lds_ + c] << 16);
}

#if defined(MK_STAMP)
__device__ float stamp_sel(const unsigned long long* st, int ia, int ib, int b0, int b1, int mode) {
    double acc = mode == 1 ? 1e30 : 0.0;
    for (int b = b0; b < b1; ++b) { const double d = (double)(long long)(st[b * 64 + ib] - (ia < 0 ? 0ull : st[b * 64 + ia])) * 0.01;
        if (mode == 3) { const double cyc = (double)(long long)(st[b * 64 + ib] - st[b * 64 + ia]), tk = (double)(long long)(st[b * 64 + ib + 2] - st[b * 64 + ia + 2]); acc += (cyc / tk) * 0.1 / (b1 - b0); }
        else if (mode == 0) acc = d > acc ? d : acc; else if (mode == 1) acc = d < acc ? d : acc; else acc += d / (b1 - b0); }
    return (float)acc;
}
__global__ void k_stamp_report(const unsigned long long* st, float* out, int a_ia, int a_ib, int a_b0, int a_b1, int a_mode, float scale) {
    if (blockIdx.x == 0 && threadIdx.x == 0) out[0] += stamp_sel(st, a_ia, a_ib, a_b0, a_b1, a_mode) * scale;
}
#endif

#ifndef MK_CUT
#define MK_CUT 8
#endif
static void gemm(hipStream_t s, const float* A, int lda, const float* B, int ldb, float* C, int ldc, const float* R, int ldr, int M, int N, int K) {
    hipLaunchKernelGGL(k_gemm, dim3(N / 128, M / 128), dim3(256), 0, s, A, lda, B, ldb, C, ldc, R, ldr, K);
}

extern "C" void kernel_launch(void* const* d_in, const int* in_sizes, int n_in, void* d_out, int out_size, void* d_ws, size_t ws_size, hipStream_t stream) {
    static int grid = 0;
    if (grid == 0) {
        int dev = 0, cus = 0, per_cu = 0;
        if (n_in != 24 || out_size != MT * DM || ws_size < mk::WS_END) { fprintf(stderr, "kernel_launch: unexpected problem (n_in %d out %d ws %zu)\n", n_in, out_size, ws_size); grid = -1; return; }
        if (hipGetDevice(&dev) != hipSuccess || hipDeviceGetAttribute(&cus, hipDeviceAttributeMultiprocessorCount, dev) != hipSuccess) { grid = -1; return; }
        if (hipFuncSetAttribute((const void*)mk::mk_fwd, hipFuncAttributeMaxDynamicSharedMemorySize, mk::LDS_BYTES) != hipSuccess) { fprintf(stderr, "kernel_launch: hipFuncSetAttribute failed\n"); grid = -1; return; }
        if (hipOccupancyMaxActiveBlocksPerMultiprocessor(&per_cu, (const void*)mk::mk_fwd, 512, mk::LDS_BYTES) != hipSuccess || per_cu < 1) { fprintf(stderr, "kernel_launch: occupancy query says %d blocks/CU\n", per_cu); }
        (void)hipGetLastError();
        grid = cus;
        if (grid != 256) { fprintf(stderr, "kernel_launch: built for a 256-CU device, found %d CUs\n", cus); grid = -1; return; }
    }
    if (grid < 0) return;
    const float* x = (const float*)d_in[0];
    const float* pool_w = (const float*)d_in[3];   const float* pool_scale = (const float*)d_in[4];
    const float* lnar = (const float*)d_in[5];     const float* aim = (const float*)d_in[6];   const float* ldt = (const float*)d_in[7];
    const float* bre = (const float*)d_in[8];      const float* bim = (const float*)d_in[9];
    const float* cre = (const float*)d_in[10];     const float* cim = (const float*)d_in[11];
    const float* ssm_d = (const float*)d_in[12];   const float* glu_w = (const float*)d_in[13]; const float* glu_b = (const float*)d_in[14];
    const float* g_pool = (const float*)d_in[15];  const float* g_ssm = (const float*)d_in[16];
    const float* w_out = (const float*)d_in[17];   const float* g_ffn = (const float*)d_in[18];
    const float* w_up = (const float*)d_in[19];    const float* conv_w = (const float*)d_in[20]; const float* conv_b = (const float*)d_in[21];
    const float* w_down = (const float*)d_in[22];  const float* g_final = (const float*)d_in[23];
    float* out = (float*)d_out; char* ws = (char*)d_ws; const size_t MiB = 1u << 20; const int EB = 256;
    (void)x; (void)pool_w; (void)pool_scale; (void)lnar; (void)aim; (void)ldt; (void)bre; (void)bim; (void)cre; (void)cim; (void)ssm_d; (void)glu_w; (void)glu_b; (void)g_pool; (void)g_ssm; (void)w_out; (void)g_ffn; (void)w_up; (void)conv_w; (void)conv_b; (void)w_down; (void)g_final;

    (void)hipMemsetAsync(ws + mk::WS_CTL, 0, mk::CTL_ZERO_BYTES, stream);
#if defined(MK_EXTRA_MEMSET)
    for (int r = 0; r < MK_EXTRA_MEMSET; ++r) (void)hipMemsetAsync(ws + 5 * MiB + r * 65536, 0, 65536, stream);
#endif
    mk::Args a{};
    for (int i = 0; i < 24; ++i) a.in[i] = (const float*)d_in[i];
    a.out = out; a.ws = (unsigned char*)d_ws; a.ph_lo = 0; a.ph_hi = MK_CUT;
#if defined(MK_PROBE_LO)
    a.ph_lo = 0; a.ph_hi = MK_PROBE_HI; hipLaunchKernelGGL(mk::mk_fwd, dim3(grid), dim3(512), mk::LDS_BYTES, stream, a);
    for (int r = 0; r < MK_PROBE_REP; ++r) { (void)hipMemsetAsync(ws + mk::WS_CTL, 0, mk::CTL_ZERO_BYTES, stream); a.ph_lo = MK_PROBE_LO; a.ph_hi = MK_PROBE_HI; hipLaunchKernelGGL(mk::mk_fwd, dim3(grid), dim3(512), mk::LDS_BYTES, stream, a); }
    (void)hipMemsetAsync(ws + mk::WS_CTL, 0, mk::CTL_ZERO_BYTES, stream);
    a.ph_lo = MK_PROBE_HI; a.ph_hi = 8; hipLaunchKernelGGL(mk::mk_fwd, dim3(grid), dim3(512), mk::LDS_BYTES, stream, a);
#else
    hipLaunchKernelGGL(mk::mk_fwd, dim3(grid), dim3(512), mk::LDS_BYTES, stream, a);
#endif
#if defined(MK_STAMP)
    hipLaunchKernelGGL(k_stamp_report, dim3(1), dim3(64), 0, stream, (const unsigned long long*)(ws + mk::WS_STAMP), out, MK_STAMP_A);
#endif
#if MK_CUT < 8
    float* bufA = (float*)(ws + 0 * MiB); float* bufB = (float*)(ws + 64 * MiB); float* bufC = (float*)(ws + 128 * MiB); float* bufD = (float*)(ws + 192 * MiB);
    float* pooled = bufA; float* ypool = bufA + (size_t)MT * DPOOL; float* z = pooled; float* pre = bufD; float* ycat = bufB;
#if MK_CUT <= 2
    float* u = bufB;
    hipLaunchKernelGGL(k_cvt_u, dim3(MT * DM / EB), dim3(EB), 0, stream, (const bf16_t*)(ws + mk::WS_UPOOL), (const bf16_t*)(ws + mk::WS_USSM), u);
    hipLaunchKernelGGL(k_pool, dim3(MT * DPOOL / EB), dim3(EB), 0, stream, u, pooled);
    for (int gi = 0; gi < 4; ++gi) gemm(stream, pooled + gi * 128, DPOOL, pool_w + (size_t)gi * 128 * 128, 128, ypool + gi * 128, DPOOL, nullptr, 0, MT, 128, 128);
    float* y2 = bufC;
    hipLaunchKernelGGL(k_ssm_scan, dim3(2 * BATCH * NG), dim3(64), 0, stream, u, lnar, aim, ldt, bre, bim, cre, cim, y2);
    hipLaunchKernelGGL(k_ssm_post, dim3(MT * DSSM / EB), dim3(EB), 0, stream, y2, u, ssm_d, z);
    const float* pre_scale = pool_scale;
#elif MK_CUT <= 4
    hipLaunchKernelGGL(k_cvt_z, dim3(MT * DSSM / EB), dim3(EB), 0, stream, (const bf16_t*)(ws + mk::WS_ZG), z);
    hipLaunchKernelGGL(k_cvt_rows, dim3(MT * DPOOL / EB), dim3(EB), 0, stream, (const bf16_t*)(ws + mk::WS_YCAT), DM, ypool, DPOOL, DPOOL, MT);
    const float* pre_scale = nullptr;
#endif
#if MK_CUT <= 4
    gemm(stream, z, DSSM, glu_w, DSSM, pre, DSSM, nullptr, 0, MT, DSSM, DSSM);
    hipLaunchKernelGGL(k_glu, dim3(MT * DSSM / EB), dim3(EB), 0, stream, z, pre, glu_b);
#elif MK_CUT == 5
    hipLaunchKernelGGL(k_cvt_rows, dim3(MT * DPOOL / EB), dim3(EB), 0, stream, (const bf16_t*)(ws + mk::WS_YCAT), DM, ypool, DPOOL, DPOOL, MT);
    hipLaunchKernelGGL(k_cvt_rows, dim3(MT * DSSM / EB), dim3(EB), 0, stream, (const bf16_t*)(ws + mk::WS_YCAT) + DPOOL, DM, pre, DSSM, DSSM, MT);
    const float* pre_scale = nullptr;
#endif
#if MK_CUT <= 5
    hipLaunchKernelGGL(k_rmsnorm, dim3(MT / 4), dim3(256), 0, stream, ypool, DPOOL, pre_scale, g_pool, ycat, DM, DPOOL, MT);
    hipLaunchKernelGGL(k_rmsnorm, dim3(MT / 4), dim3(256), 0, stream, pre, DSSM, (const float*)nullptr, g_ssm, ycat + DPOOL, DM, DSSM, MT);
    gemm(stream, ycat, DM, w_out, DM, out, DM, x, DM, MT, DM, DM);
#endif
#if MK_CUT <= 6
    float* xn2 = bufA;
    hipLaunchKernelGGL(k_rmsnorm, dim3(MT / 4), dim3(256), 0, stream, out, DM, (const float*)nullptr, g_ffn, xn2, DM, DM, MT);
    float* up = (float*)(ws + 64 * MiB); float* act = (float*)(ws + 152 * MiB);
    for (int b = 0; b < BATCH; ++b) {
        gemm(stream, xn2 + (size_t)b * SEQ * DM, DM, w_up, DFF2, up, DFF2, nullptr, 0, SEQ, DFF2, DM);
        hipLaunchKernelGGL(k_convact, dim3(SEQ * DFF / EB), dim3(EB), 0, stream, up, conv_w, conv_b, act);
        gemm(stream, act, DFF, w_down, DM, out + (size_t)b * SEQ * DM, DM, out + (size_t)b * SEQ * DM, DM, SEQ, DM, DFF);
    }
#else
    float* actf = (float*)(ws + 0 * MiB);
    for (int b = 0; b < BATCH; ++b) {
        hipLaunchKernelGGL(k_cvt_rows, dim3(SEQ * DFF / EB), dim3(EB), 0, stream, (const bf16_t*)(ws + mk::WS_ACT) + (size_t)b * SEQ * DFF, DFF, actf, DFF, DFF, SEQ);
        gemm(stream, actf, DFF, w_down, DM, out + (size_t)b * SEQ * DM, DM, out + (size_t)b * SEQ * DM, DM, SEQ, DM, DFF);
    }
#endif
    hipLaunchKernelGGL(k_rmsnorm, dim3(MT / 4), dim3(256), 0, stream, out, DM, (const float*)nullptr, g_final, out, DM, DM, MT);
    (void)bufC;
#endif
}
```

```cpp
#include <hip/hip_runtime.h>
#include <math.h>

constexpr int BATCH = 4, SEQ = 4096, DM = 1024, MT = BATCH * SEQ;
constexpr int DPOOL = 512, DSSM = 512, NG = 32, NH = 16, NS = 64;
constexpr int DFF = 2816, DFF2 = 5632;
constexpr float EPS = 1e-6f;

#include <cstdio>
#include <cstdint>
#define LAS __attribute__((address_space(3)))
#define GAS __attribute__((address_space(1)))
typedef unsigned short bf16_t;
typedef short bf16x8 __attribute__((ext_vector_type(8)));
typedef float f32x4 __attribute__((ext_vector_type(4)));
typedef float f32x2 __attribute__((ext_vector_type(2)));
typedef unsigned u32x4 __attribute__((ext_vector_type(4)));
typedef unsigned u32x2 __attribute__((ext_vector_type(2)));

namespace mk {
constexpr int TCH = 16;
constexpr int K1 = 16 * TCH;
constexpr int ROWLEN = K1 + 256;
constexpr int NCR = MT / TCH;
constexpr int NCHB = SEQ / TCH;
constexpr int PADROWS = 4352;
constexpr int UPT = 17;
constexpr int UPROWS = 252;

constexpr size_t MiB = 1u << 20;
constexpr size_t WS_CTL = 0, CTL_ZERO_BYTES = 64 * 1024;
constexpr int CW_TBCNT = 4096;
constexpr size_t WS_R0 = 1 * MiB;
constexpr size_t WS_SSPOOL = 2 * MiB;
constexpr size_t WS_SSSSM = WS_SSPOOL + 8 * MT * 4;
constexpr size_t WS_SSH1 = WS_SSSSM + 8 * MT * 4;
constexpr size_t WS_SSH2 = WS_SSH1 + 4 * MT * 4;
constexpr size_t WS_LAMT = 6 * MiB;
constexpr size_t WS_WIN = 8 * MiB, WS_WOUT = 10 * MiB, WS_WGLU = 12 * MiB, WS_PW = 12 * MiB + 512 * 1024;
constexpr size_t WS_WUP = 13 * MiB, WS_WDOWN = 24 * MiB;
constexpr size_t WS_WAB = 30 * MiB;
constexpr size_t WS_TB = 38 * MiB;
constexpr size_t WS_TBC = 40 * MiB;
constexpr size_t WS_H1B = 62 * MiB;
constexpr size_t WS_XB = 96 * MiB;
constexpr size_t WS_YCAT = 128 * MiB;
constexpr size_t WS_UPOOL = 128 * MiB;
constexpr size_t WS_USSM = 144 * MiB;
constexpr size_t WS_FG = 176 * MiB;
constexpr size_t WS_POOLED = 208 * MiB;
constexpr size_t WS_ZG = 224 * MiB;
constexpr size_t WS_ACT = 96 * MiB;
constexpr size_t WS_END = 240 * MiB;

constexpr int RING_BYTES = 131072, XTRA_OFF = RING_BYTES, XTRA_BYTES = 12288, LDSCTL_OFF = XTRA_OFF + XTRA_BYTES, LDS_BYTES = 147456;

__device__ __forceinline__ unsigned f2bf(float f) { unsigned u = __builtin_bit_cast(unsigned, f); return (u + 0x7fffu + ((u >> 16) & 1u)) >> 16; }
__device__ __forceinline__ unsigned pk2(float lo, float hi) { return f2bf(lo) | (f2bf(hi) << 16); }
__device__ __forceinline__ unsigned cvt_pk_bf16(float lo, float hi) { unsigned r; asm volatile("v_cvt_pk_bf16_f32 %0, %1, %2" : "=v"(r) : "v"(lo), "v"(hi)); return r; }
__device__ __forceinline__ u32x4 pack8(f32x4 a, f32x4 b) { u32x4 w; w.x = cvt_pk_bf16(a[0], a[1]); w.y = cvt_pk_bf16(a[2], a[3]); w.z = cvt_pk_bf16(b[0], b[1]); w.w = cvt_pk_bf16(b[2], b[3]); return w; }
__device__ __forceinline__ u32x2 pack4(f32x4 a) { u32x2 w; w.x = cvt_pk_bf16(a[0], a[1]); w.y = cvt_pk_bf16(a[2], a[3]); return w; }
__device__ __forceinline__ float bflo(unsigned w) { return __builtin_bit_cast(float, w << 16); }
__device__ __forceinline__ float bfhi(unsigned w) { return __builtin_bit_cast(float, w & 0xffff0000u); }
__device__ __forceinline__ void unpack8(u32x4 w, f32x4& a, f32x4& b) { a[0] = bflo(w.x); a[1] = bfhi(w.x); a[2] = bflo(w.y); a[3] = bfhi(w.y); b[0] = bflo(w.z); b[1] = bfhi(w.z); b[2] = bflo(w.w); b[3] = bfhi(w.w); }
__device__ __forceinline__ float fast_sigmoid(float x) { return __builtin_amdgcn_rcpf(1.0f + __builtin_amdgcn_exp2f(-1.4426950408889634f * x)); }
__device__ __forceinline__ float fast_gelu_tanh(float x) {
    const float t = x * (1.0f + 0.044715f * x * x);
    return x * __builtin_amdgcn_rcpf(1.0f + __builtin_amdgcn_exp2f(-2.0f * 0.7978845608028654f * 1.4426950408889634f * t));
}
__device__ __forceinline__ float wave_sum(float v) {
#pragma unroll
    for (int o = 1; o < 64; o <<= 1) v += __shfl_xor(v, o);
    return v;
}
__device__ __forceinline__ float dpp_ror1(float v)  { return __builtin_bit_cast(float, __builtin_amdgcn_update_dpp(0, __builtin_bit_cast(int, v), 0x121, 0xf, 0xf, false)); }
__device__ __forceinline__ float dpp_ror15(float v) { return __builtin_bit_cast(float, __builtin_amdgcn_update_dpp(0, __builtin_bit_cast(int, v), 0x12F, 0xf, 0xf, false)); }
__device__ __forceinline__ int lane_id_fresh() { int l; asm volatile("v_mbcnt_lo_u32_b32 %0, -1, 0\n\tv_mbcnt_hi_u32_b32 %0, -1, %0" : "=v"(l)); return l; }
__device__ __forceinline__ __amdgpu_buffer_rsrc_t wt_rsrc(void* base, unsigned bytes) { return __builtin_amdgcn_make_buffer_rsrc(base, 0, bytes, 0x00020000); }
__device__ __forceinline__ void wt_store16(__amdgpu_buffer_rsrc_t r, unsigned byte_off, u32x4 v) { __builtin_amdgcn_raw_buffer_store_b128(v, r, (int)byte_off, 0, 16); }
#define LDS_WAIT() asm volatile("s_waitcnt lgkmcnt(0)" ::: "memory")
#define VM_WAIT() asm volatile("s_waitcnt vmcnt(0)" ::: "memory")

#define XB_TMO      128
#define XB_XCNT(j)  (256  + 64 * (j))
#define XB_XSUB(j)  (1280 + 64 * (j))
#define XB_XGEN(j)  (2304 + 64 * (j))
#define XB_TOP      3328
#define XB_TOPGEN   3392
#define XCD_BAR_WORDS 3456
#define XB_SPIN_CAP (1u << 18)
__device__ __forceinline__ unsigned xb_ld(unsigned* p)              { return __hip_atomic_load(p, __ATOMIC_RELAXED, __HIP_MEMORY_SCOPE_AGENT); }
__device__ __forceinline__ unsigned xb_add(unsigned* p, unsigned v) { return __hip_atomic_fetch_add(p, v, __ATOMIC_RELAXED, __HIP_MEMORY_SCOPE_AGENT); }
__device__ __forceinline__ unsigned xb_xcc_id() { return (unsigned)__builtin_amdgcn_s_getreg((3 << 11) | 20) & 0xFu; }
#define XB_SPIN(cond, bar) do { unsigned _sp = 0; while (cond) { __builtin_amdgcn_s_sleep(1); \
    if ((++_sp & 255u) == 0u) { if (xb_ld(&(bar)[XB_TMO])) break; if (_sp > XB_SPIN_CAP) { atomicAdd(&(bar)[XB_TMO], 1u); break; } } } } while (0)
struct XcdBarrier { unsigned* bar; unsigned x; volatile LAS unsigned* st; };
__device__ __forceinline__ XcdBarrier xcd_barrier_post(unsigned* bar, volatile LAS unsigned* st) {
    XcdBarrier b; b.bar = bar; b.x = xb_xcc_id(); b.st = st;
    if (threadIdx.x == 0) (void)xb_add(&bar[XB_XCNT(b.x)], 1u);
    return b;
}
__device__ __forceinline__ void xcd_barrier_complete(unsigned* bar, unsigned x, unsigned& nloc, unsigned& nx) {
    const unsigned G = gridDim.x * gridDim.y * gridDim.z;
    unsigned sum, cnt, mine, sp = 0u;
    for (;;) {
        sum = 0u; cnt = 0u; mine = 0u;
#pragma unroll
        for (unsigned j = 0; j < 16; ++j) { const unsigned c = xb_ld(&bar[XB_XCNT(j)]); sum += c; cnt += (c > 0u) ? 1u : 0u; mine = (j == x) ? c : mine; }
        if (sum == G) break;
        __builtin_amdgcn_s_sleep(1);
        if ((++sp & 255u) == 0u) { if (xb_ld(&bar[XB_TMO])) break; if (sp > XB_SPIN_CAP) { atomicAdd(&bar[XB_TMO], 1u); break; } }
    }
    nloc = mine > 0u ? mine : 1u; nx = cnt > 0u ? cnt : 1u;
}
__device__ __forceinline__ void xcd_barrier(const XcdBarrier& b, int tid) {
    asm volatile("s_waitcnt vmcnt(0)" ::: "memory");
    __syncthreads();
    if (tid == 0) {
        unsigned* bar = b.bar;
        __builtin_amdgcn_s_waitcnt(0);
        unsigned nloc = b.st[0], nx = b.st[1];
        if (nloc == 0u) { xcd_barrier_complete(bar, b.x, nloc, nx); b.st[0] = nloc; b.st[1] = nx; }
        const unsigned old = xb_add(&bar[XB_XSUB(b.x)], 1u);
        const unsigned gen = old / nloc;
        if (old + 1u == (gen + 1u) * nloc) {
            __builtin_amdgcn_fence(__ATOMIC_RELEASE, "agent");
            asm volatile("s_waitcnt vmcnt(0)" ::: "memory");
            const unsigned og = xb_add(&bar[XB_TOP], 1u);
            const unsigned tg = og / nx;
            if (og + 1u == (tg + 1u) * nx) xb_add(&bar[XB_TOPGEN], 1u);
            else XB_SPIN(xb_ld(&bar[XB_TOPGEN]) == tg, bar);
            __builtin_amdgcn_fence(__ATOMIC_ACQUIRE, "agent");
            xb_add(&bar[XB_XGEN(b.x)], 1u);
            asm volatile("s_waitcnt vmcnt(0)" ::: "memory");
        } else {
            XB_SPIN(xb_ld(&bar[XB_XGEN(b.x)]) == gen, bar);
            __builtin_amdgcn_fence(__ATOMIC_ACQUIRE, "agent");
            asm volatile("s_waitcnt vmcnt(0)" ::: "memory");
        }
    }
    __syncthreads();
}

constexpr int BM = 256, BK = 64, HALF = 128, HTB = HALF * BK * 2, STAGE_BYTES = 8 * HTB, NXCD = 8, WGM = 8;
__host__ __device__ __forceinline__ int lds_byte(int r, int c) { const int st = (r >> 4) * 2 + (c >> 5), rr = r & 15, cc = c & 31, ob = rr * 64 + cc * 2; return st * 1024 + (ob ^ (((ob >> 9) & 1) << 5)); }
__host__ __device__ __forceinline__ void stage_rc(int b, int& R, int& C) { const int st = b / 1024, sb = b % 1024, swz = sb ^ (((sb >> 9) & 1) << 5); R = (st >> 1) * 16 + swz / 64; C = (st & 1) * 32 + (swz % 64) / 2; }
__host__ __device__ __forceinline__ int perm32(int rho) { const int n = rho >> 4, i = rho & 15; return 8 * (i >> 2) + 4 * n + (i & 3); }

struct Unit { int pm, pn, g, aux; };
struct GemmDesc { const char* A; const char* B; long a_pm, a_g, b_pn, b_g, a_h, b_h, a_k, b_k; int nt;
                  const char* B2; long b2_pn, b2_g, b2_h, b2_k; int tsw; };

struct StaticOrder {
    int nM, nN, nwg, G, c;
    __device__ void init(int nM_, int nN_, int G_, int c_) { nM = nM_; nN = nN_; nwg = nM * nN; G = G_; c = c_; }
    __device__ bool next(int i, Unit& u) const {
        const long L = (long)i * G + c; if (L >= nwg) return false;
        int wgid = (int)L; { const int q = nwg / NXCD, r = nwg % NXCD, xcd = wgid % NXCD, off = wgid / NXCD; wgid = (xcd < r ? xcd * (q + 1) : r * (q + 1) + (xcd - r) * q) + off; }
        const int nig = WGM * nN, gid = wgid / nig, fm = gid * WGM, gsz = (nM - fm) < WGM ? (nM - fm) : WGM;
        u.pm = fm + ((wgid % nig) % gsz); u.pn = (wgid % nig) / gsz; u.g = 0; u.aux = 0; return true;
    }
};

template <class Epi, class Sched, bool ALIGN_EPI, bool SEG2 = false>
__device__ __forceinline__ void gemm_phase(LAS unsigned char* lds, const GemmDesc g, const unsigned (&voffA)[2], const unsigned (&voffB)[2], const Sched& S, Epi& E, int tid, unsigned long long* stp = nullptr, const unsigned* voffB2 = nullptr) {
    const int wid = __builtin_amdgcn_readfirstlane(tid >> 6), lane = tid & 63, wr = wid >> 2, wc = wid & 3, fr = lane & 15, fq = lane >> 4;
    const int nt = g.nt;
    const long kstepA = g.a_k, kstepB = g.b_k, hstepA = g.a_h, hstepB = g.b_h;
    const unsigned ldsw = (unsigned)wid * 1024u;
    const int aoff = lds_byte(wr * 64 + fr, fq * 8), boff = lds_byte(wc * 32 + fr, fq * 8);
#define PG8_SA(b, h) (((b) * 2 + (h)) * HTB)
#define PG8_SB(b, h) ((4 + (b) * 2 + (h)) * HTB)
#define PG8_STAGE(bufoff, gbase, voff) do { const char* _gb = (const char*)(gbase); asm volatile("" : "+s"(_gb));   _Pragma("unroll") for (int _i = 0; _i < 2; ++_i) \
        __builtin_amdgcn_global_load_lds((const unsigned*)(_gb + (voff)[_i]), (LAS unsigned*)(lds + (bufoff) + ldsw + _i * 8192), 16, 0, 0); } while (0)
#define PG8_LDA(dst, b, h) do { _Pragma("unroll") for (int m = 0; m < 4; ++m) _Pragma("unroll") for (int k = 0; k < 2; ++k) dst[m][k] = *(const LAS bf16x8*)(lds + PG8_SA(b, h) + aoff + m * 2048 + k * 1024); } while (0)
#define PG8_LDB(dst, b, h) do { _Pragma("unroll") for (int n = 0; n < 2; ++n) _Pragma("unroll") for (int k = 0; k < 2; ++k) dst[n][k] = *(const LAS bf16x8*)(lds + PG8_SB(b, h) + boff + n * 2048 + k * 1024); } while (0)
#define PG8_MMA(ai, bj, At, Bt) do { __builtin_amdgcn_s_setprio(1); _Pragma("unroll") for (int m = 0; m < 4; ++m) _Pragma("unroll") for (int n = 0; n < 2; ++n) _Pragma("unroll") for (int k = 0; k < 2; ++k) \
        acc[ai][bj][m][n] = __builtin_amdgcn_mfma_f32_16x16x32_bf16(Bt[n][k], At[m][k], acc[ai][bj][m][n], 0, 0, 0); __builtin_amdgcn_s_setprio(0); } while (0)
#define PG8_WAIT_V(n) asm volatile("s_waitcnt vmcnt(" #n ")" ::: "memory")
#define PG8_WAIT_L(n) asm volatile("s_waitcnt lgkmcnt(" #n ")" ::: "memory")
#define PG8_BAR __builtin_amdgcn_s_barrier()
#define PG8_SCHED __builtin_amdgcn_sched_barrier(0)
    Unit cur, nxt; int ui = 0;
    if (!S.next(0, cur)) return;
    f32x4 acc[2][2][4][2];
#pragma unroll
    for (int a = 0; a < 2; ++a)
#pragma unroll
        for (int b = 0; b < 2; ++b)
#pragma unroll
            for (int m = 0; m < 4; ++m)
#pragma unroll
                for (int n = 0; n < 2; ++n) acc[a][b][m][n] = (f32x4){0.f, 0.f, 0.f, 0.f};
    bf16x8 At[4][2], B0[2][2], B1[2][2];
    const char* cA = g.A + (long)cur.pm * g.a_pm + (long)cur.g * g.a_g; const char* cB = g.B + (long)cur.pn * g.b_pn + (long)cur.g * g.b_g;
    const char* cB2 = SEG2 ? g.B2 + (long)cur.pn * g.b2_pn + (long)cur.g * g.b2_g : nullptr;
    PG8_STAGE(PG8_SB(0, 0), cB, voffB); PG8_STAGE(PG8_SB(0, 1), cB + hstepB, voffB); PG8_STAGE(PG8_SA(0, 0), cA, voffA); PG8_STAGE(PG8_SA(0, 1), cA + hstepA, voffA);
    if (wr == 1) PG8_BAR;
    PG8_WAIT_V(2); PG8_BAR;
    PG8_STAGE(PG8_SB(1, 0), cB + kstepB, voffB); PG8_STAGE(PG8_SA(1, 0), cA + kstepA, voffA); PG8_STAGE(PG8_SB(1, 1), cB + hstepB + kstepB, voffB);
    PG8_WAIT_V(6); PG8_BAR;
    unsigned long long st_t0 = stp ? __builtin_amdgcn_s_memrealtime() : 0ull, st_loop = 0ull, st_epi = 0ull;
    for (;;) {
        const bool has_next = S.next(ui + 1, nxt);
        const char* nA = has_next ? g.A + (long)nxt.pm * g.a_pm + (long)nxt.g * g.a_g : cA; const char* nB = has_next ? g.B + (long)nxt.pn * g.b_pn + (long)nxt.g * g.b_g : cB;
        for (int t = 0; t < nt; t += 2) {
            const bool last = (t == nt - 2);
            const char* a1 = cA + (long)(t + 1) * kstepA;
            const bool sg = SEG2 && !last && (t + 2 >= g.tsw);
            const char* a2 = last ? nA : cA + (long)(t + 2) * kstepA; const char* b2 = last ? nB : (sg ? cB2 + (long)(t + 2 - g.tsw) * g.b2_k : cB + (long)(t + 2) * kstepB);
            const char* a3 = a2 + kstepA; const char* b3 = b2 + (sg ? g.b2_k : kstepB);
            const long hB = sg ? g.b2_h : hstepB;
            unsigned vbs[2]; vbs[0] = sg ? voffB2[0] : voffB[0]; vbs[1] = sg ? voffB2[1] : voffB[1];
            PG8_LDB(B0, 0, 0); PG8_LDB(B1, 0, 1); PG8_SCHED; PG8_LDA(At, 0, 0); PG8_STAGE(PG8_SA(1, 1), a1 + hstepA, voffA);
            PG8_WAIT_V(8); PG8_WAIT_L(0); PG8_BAR; PG8_MMA(0, 0, At, B0); PG8_MMA(0, 1, At, B1); PG8_BAR; PG8_SCHED;
            PG8_LDA(At, 0, 1); PG8_STAGE(PG8_SB(0, 0), b2, vbs); PG8_STAGE(PG8_SB(0, 1), b2 + hB, vbs); PG8_STAGE(PG8_SA(0, 0), a2, voffA);
            PG8_WAIT_V(8); PG8_WAIT_L(0); PG8_BAR; PG8_MMA(1, 0, At, B0); PG8_MMA(1, 1, At, B1); PG8_BAR; PG8_SCHED;
            PG8_LDB(B0, 1, 0); PG8_LDB(B1, 1, 1); PG8_SCHED; PG8_LDA(At, 1, 0); PG8_STAGE(PG8_SA(0, 1), a2 + hstepA, voffA);
            PG8_WAIT_V(8); PG8_WAIT_L(0); PG8_BAR; PG8_MMA(0, 0, At, B0); PG8_MMA(0, 1, At, B1); PG8_BAR; PG8_SCHED;
            PG8_LDA(At, 1, 1); PG8_STAGE(PG8_SB(1, 0), b3, vbs); PG8_STAGE(PG8_SB(1, 1), b3 + hB, vbs); PG8_STAGE(PG8_SA(1, 0), a3, voffA);
            PG8_WAIT_V(8); PG8_WAIT_L(0); PG8_BAR; PG8_MMA(1, 0, At, B0); PG8_MMA(1, 1, At, B1); PG8_BAR; PG8_SCHED;
            if constexpr (Epi::HAS_MID) { if (t + 2 == Epi::MID_T) E.mid(acc, wr, fr); }
        }
        if (stp) { const unsigned long long t1 = __builtin_amdgcn_s_memrealtime(); st_loop += t1 - st_t0; st_t0 = t1; }
        if constexpr (ALIGN_EPI) { if (wr == 0) PG8_BAR; }
        if constexpr (!Epi::AFTER_DRAIN) { E(acc, cur, wr, wc, fr, fq); }
        if (stp) { const unsigned long long t1 = __builtin_amdgcn_s_memrealtime(); st_epi += t1 - st_t0; st_t0 = t1; }
        if (!has_next) break;
#pragma unroll
        for (int a = 0; a < 2; ++a)
#pragma unroll
            for (int b = 0; b < 2; ++b)
#pragma unroll
                for (int m = 0; m < 4; ++m)
#pragma unroll
                    for (int n = 0; n < 2; ++n) acc[a][b][m][n] = (f32x4){0.f, 0.f, 0.f, 0.f};
        cur = nxt; cA = nA; cB = nB; ++ui; if constexpr (SEG2) cB2 = g.B2 + (long)cur.pn * g.b2_pn + (long)cur.g * g.b2_g;
        if constexpr (ALIGN_EPI) { if (wr == 1) PG8_BAR; }
    }
    PG8_WAIT_V(0);
    if constexpr (!ALIGN_EPI) { if (wr == 0) PG8_BAR; }
    PG8_BAR;
    if (stp) { const unsigned long long t1 = __builtin_amdgcn_s_memrealtime(); st_loop += t1 - st_t0; st_t0 = t1; }
    if constexpr (Epi::AFTER_DRAIN) { E.fused(acc, cur, wr, wc, fr, fq, lds, wid, lane); }
    if (stp) { const unsigned long long t1 = __builtin_amdgcn_s_memrealtime(); st_epi += t1 - st_t0; if (tid == 0) { stp[0] = st_loop; stp[1] = st_epi; } }
#undef PG8_SA
#undef PG8_SB
#undef PG8_STAGE
#undef PG8_LDA
#undef PG8_LDB
#undef PG8_MMA
#undef PG8_WAIT_V
#undef PG8_WAIT_L
#undef PG8_BAR
#undef PG8_SCHED
}

__device__ __forceinline__ void voff_std(unsigned (&v)[2], int ld, bool perm, int tid) {
#pragma unroll
    for (int i = 0; i < 2; ++i) { int R, C; stage_rc(tid * 16 + i * 8192, R, C); const int Rb = perm ? ((R & ~31) + perm32(R & 31)) : R; v[i] = (unsigned)(Rb * ld + C) * 2u; }
}

typedef f32x4 Acc[2][2][4][2];

struct EpiU {
    static constexpr bool PERM = true, AFTER_DRAIN = false, HAS_MID = false; static constexpr int MID_T = 0;
    const float* r0; bf16_t* upool; bf16_t* ussm;
    __device__ __forceinline__ void operator()(Acc& acc, const Unit& u, int wr, int wc, int fr, int fq) const {
#pragma unroll
        for (int ai = 0; ai < 2; ++ai)
#pragma unroll
            for (int m = 0; m < 4; ++m) {
                const int row = u.pm * BM + ai * HALF + wr * 64 + m * 16 + fr; const float rs = r0[row];
#pragma unroll
                for (int bj = 0; bj < 2; ++bj) {
                    const int c8 = u.pn * BM + bj * HALF + wc * 32 + 8 * fq;
                    const u32x4 w = pack8(acc[ai][bj][m][0] * rs, acc[ai][bj][m][1] * rs);
                    if (u.pn < 2) *(u32x4*)(upool + (size_t)row * DPOOL + c8) = w;
                    else { const int cs = c8 - DPOOL, gg = cs >> 4, h0 = cs & 15, cr = row / TCH, p = row % TCH;
                           *(u32x4*)(ussm + ((size_t)(gg * NCR + cr) * ROWLEN + 16 * p + h0)) = w; }
                }
            }
    }
};
struct EpiFG {
    static constexpr bool PERM = false, AFTER_DRAIN = false, HAS_MID = false; static constexpr int MID_T = 0;
    float* fg;
    __device__ __forceinline__ void operator()(Acc& acc, const Unit& u, int wr, int wc, int fr, int fq) const {
#pragma unroll
        for (int ai = 0; ai < 2; ++ai)
#pragma unroll
            for (int m = 0; m < 4; ++m) {
                const int cr = u.pm * BM + ai * HALF + wr * 64 + m * 16 + fr; float* rowp = fg + ((size_t)u.g * NCR + cr) * 256 + wc * 32 + 4 * fq;
#pragma unroll
                for (int bj = 0; bj < 2; ++bj)
#pragma unroll
                    for (int n = 0; n < 2; ++n) *(f32x4*)(rowp + bj * HALF + n * 16) = acc[ai][bj][m][n];
            }
    }
};
struct cf { float r, i; };
__device__ __forceinline__ cf cmul(cf a, cf b) { return cf{a.r * b.r - a.i * b.i, a.r * b.i + a.i * b.r}; }
__device__ __forceinline__ cf cmad(cf a, cf b, cf c) { return cf{a.r * b.r - a.i * b.i + c.r, a.r * b.i + a.i * b.r + c.i}; }
template <int CTRL> __device__ __forceinline__ float dppz(float v) { return __builtin_bit_cast(float, __builtin_amdgcn_update_dpp(0, __builtin_bit_cast(int, v), CTRL, 0xf, 0xf, true)); }
template <int CTRL> __device__ __forceinline__ cf cdpp(cf v) { return cf{dppz<CTRL>(v.r), dppz<CTRL>(v.i)}; }
struct EpiScan {
    static constexpr bool PERM = false, AFTER_DRAIN = true, HAS_MID = false; static constexpr int MID_T = 0;
    const float* lamT; bf16_t* ussm;
    __device__ __forceinline__ void fused(Acc& acc, const Unit& u, int wr, int wc, int fr, int fq, LAS unsigned char* lds, int wid, int lane) const {
        LAS float* SEG = (LAS float*)lds;
        cf X[2][2][2][2];
        LAS unsigned char* CIM = lds + 8192;
#pragma unroll
        for (int bj = 0; bj < 2; ++bj)
#pragma unroll
            for (int np = 0; np < 2; ++np) {
                const int n0 = 16 * wc + 8 * np + 2 * fq;
                const f32x4 l4 = *(const f32x4*)(lamT + ((size_t)(bj * NG + u.g) * NS + n0) * 2);
#pragma unroll
                for (int e = 0; e < 2; ++e) {
                    const cf lam{l4[2 * e], l4[2 * e + 1]};
                    const cf l2 = cmul(lam, lam), M1 = cmul(l2, l2), M2 = cmul(M1, M1), M4 = cmul(M2, M2), M8 = cmul(M4, M4);
#pragma unroll
                    for (int ai = 0; ai < 2; ++ai) {
                        cf T;
                        if (bj == 0) { T = cf{acc[ai][bj][0][np][2 * e], acc[ai][bj][0][np][2 * e + 1]};
#pragma unroll
                            for (int m = 1; m < 4; ++m) T = cmad(lam, T, cf{acc[ai][bj][m][np][2 * e], acc[ai][bj][m][np][2 * e + 1]});
                            T = cmad(M1, cdpp<0x111>(T), T); T = cmad(M2, cdpp<0x112>(T), T); T = cmad(M4, cdpp<0x114>(T), T); T = cmad(M8, cdpp<0x118>(T), T);
                            X[bj][ai][np][e] = cdpp<0x111>(T);
                            if (fr == 15) *(LAS f32x2*)(SEG + ((bj * 4 + 2 * ai + wr) * 64 + n0 + e) * 2) = (f32x2){T.r, T.i};
                        } else {       T = cf{acc[ai][bj][3][np][2 * e], acc[ai][bj][3][np][2 * e + 1]};
#pragma unroll
                            for (int m = 2; m >= 0; --m) T = cmad(lam, T, cf{acc[ai][bj][m][np][2 * e], acc[ai][bj][m][np][2 * e + 1]});
                            T = cmad(M1, cdpp<0x101>(T), T); T = cmad(M2, cdpp<0x102>(T), T); T = cmad(M4, cdpp<0x104>(T), T); T = cmad(M8, cdpp<0x108>(T), T);
                            X[bj][ai][np][e] = cdpp<0x101>(T);
                            if (fr == 0) *(LAS f32x2*)(SEG + ((bj * 4 + 2 * ai + wr) * 64 + n0 + e) * 2) = (f32x2){T.r, T.i};
                        }
                    }
                }
            }
        LDS_WAIT(); __builtin_amdgcn_s_barrier(); asm volatile("" ::: "memory");
#pragma unroll
        for (int bj = 0; bj < 2; ++bj)
#pragma unroll
            for (int np = 0; np < 2; ++np) {
                const int n0 = 16 * wc + 8 * np + 2 * fq;
                const f32x4 l4 = *(const f32x4*)(lamT + ((size_t)(bj * NG + u.g) * NS + n0) * 2);
                cf C[2][4][2];
#pragma unroll
                for (int e = 0; e < 2; ++e) {
                    const cf lam{l4[2 * e], l4[2 * e + 1]};
                    const cf l2 = cmul(lam, lam), M1 = cmul(l2, l2), M2 = cmul(M1, M1), M4 = cmul(M2, M2), M8 = cmul(M4, M4), Q = cmul(M8, M8);
                    const int ex = bj == 0 ? fr : 15 - fr;
                    cf Mx{1.f, 0.f};
                    if (ex & 1) Mx = cmul(Mx, M1); if (ex & 2) Mx = cmul(Mx, M2); if (ex & 4) Mx = cmul(Mx, M4); if (ex & 8) Mx = cmul(Mx, M8);
#pragma unroll
                    for (int ai = 0; ai < 2; ++ai) {
                        const int sg = 2 * ai + wr; cf G{0.f, 0.f};
                        if (bj == 0) {
#pragma unroll
                            for (int sp = 0; sp < 3; ++sp) if (sp < sg) { const f32x2 t = *(const LAS f32x2*)(SEG + ((bj * 4 + sp) * 64 + n0 + e) * 2); G = cmad(Q, G, cf{t.x, t.y}); }
                            cf c = cmad(Mx, G, X[bj][ai][np][e]); C[ai][0][e] = c;
#pragma unroll
                            for (int m = 1; m < 4; ++m) { c = cmad(lam, c, cf{acc[ai][bj][m - 1][np][2 * e], acc[ai][bj][m - 1][np][2 * e + 1]}); C[ai][m][e] = c; }
                        } else {
#pragma unroll
                            for (int sp = 3; sp > 0; --sp) if (sp > sg) { const f32x2 t = *(const LAS f32x2*)(SEG + ((bj * 4 + sp) * 64 + n0 + e) * 2); G = cmad(Q, G, cf{t.x, t.y}); }
                            cf c = cmad(Mx, G, X[bj][ai][np][e]); C[ai][3][e] = c;
#pragma unroll
                            for (int m = 2; m >= 0; --m) { c = cmad(lam, c, cf{acc[ai][bj][m + 1][np][2 * e], acc[ai][bj][m + 1][np][2 * e + 1]}); C[ai][m][e] = c; }
                        }
                    }
                }
#pragma unroll
                for (int ai = 0; ai < 2; ++ai)
#pragma unroll
                    for (int m = 0; m < 4; ++m) { const int c = 128 * ai + 64 * wr + 4 * fr + m;
                        u32x2 w; w.x = cvt_pk_bf16(C[ai][m][0].r, C[ai][m][0].i); w.y = cvt_pk_bf16(C[ai][m][1].r, C[ai][m][1].i);
                        *(LAS u32x2*)(CIM + c * 520 + (bj * 128 + 2 * n0) * 2) = w; }
            }
        LDS_WAIT(); __builtin_amdgcn_s_barrier(); asm volatile("" ::: "memory");
#pragma unroll 8
        for (int r = wid; r < 256; r += 8)
            *(u32x2*)(ussm + ((size_t)(u.g * NCR + u.pm * NCHB + r) * ROWLEN + K1) + 4 * lane) = *(const LAS u32x2*)(CIM + r * 520 + 8 * lane);
    }
};
struct EpiZ {
    static constexpr bool PERM = true, AFTER_DRAIN = false, HAS_MID = false; static constexpr int MID_T = 0;
    const bf16_t* ussm; const float* dvec; bf16_t* zg;
    __device__ __forceinline__ void operator()(Acc& acc, const Unit& u, int wr, int wc, int fr, int fq) const {
#pragma unroll
        for (int bj = 0; bj < 2; ++bj) {
            const int c8 = u.pn * BM + bj * HALF + wc * 32 + 8 * fq;
            const f32x4 d0 = *(const f32x4*)(dvec + u.g * 16 + (c8 & 15)), d1 = *(const f32x4*)(dvec + u.g * 16 + (c8 & 15) + 4);
#pragma unroll
            for (int ai = 0; ai < 2; ++ai)
#pragma unroll
                for (int m = 0; m < 4; ++m) {
                    const int cr = u.pm * BM + ai * HALF + wr * 64 + m * 16 + fr;
                    const u32x4 uw = *(const u32x4*)(ussm + ((size_t)(u.g * NCR + cr) * ROWLEN + c8));
                    f32x4 u0, u1; unpack8(uw, u0, u1);
                    f32x4 y0 = acc[ai][bj][m][0] + d0 * u0, y1 = acc[ai][bj][m][1] + d1 * u1;
#pragma unroll
                    for (int i = 0; i < 4; ++i) { y0[i] = fast_gelu_tanh(y0[i]); y1[i] = fast_gelu_tanh(y1[i]); }
                    *(u32x4*)(zg + ((size_t)u.g * MT * 16 + (size_t)cr * K1 + c8)) = pack8(y0, y1);
                }
        }
    }
};
struct EpiPool {
    static constexpr bool PERM = true, AFTER_DRAIN = false, HAS_MID = false; static constexpr int MID_T = 0;
    const float* pscale; bf16_t* ycat; float* ss;
    __device__ __forceinline__ void operator()(Acc& acc, const Unit& u, int wr, int wc, int fr, int fq) const {
        f32x4 sc[2][2];
#pragma unroll
        for (int bj = 0; bj < 2; ++bj) { const int c8 = u.pn * BM + bj * HALF + wc * 32 + 8 * fq; sc[bj][0] = *(const f32x4*)(pscale + c8); sc[bj][1] = *(const f32x4*)(pscale + c8 + 4); }
#pragma unroll
        for (int ai = 0; ai < 2; ++ai)
#pragma unroll
            for (int m = 0; m < 4; ++m) {
                const int row = u.pm * BM + ai * HALF + wr * 64 + m * 16 + fr; float q = 0.f;
#pragma unroll
                for (int bj = 0; bj < 2; ++bj) {
                    const int c8 = u.pn * BM + bj * HALF + wc * 32 + 8 * fq;
                    const f32x4 v0 = acc[ai][bj][m][0] * sc[bj][0], v1 = acc[ai][bj][m][1] * sc[bj][1];
                    q += (v0[0] * v0[0] + v0[1] * v0[1]) + (v0[2] * v0[2] + v0[3] * v0[3]) + (v1[0] * v1[0] + v1[1] * v1[1]) + (v1[2] * v1[2] + v1[3] * v1[3]);
                    *(u32x4*)(ycat + (size_t)row * DM + c8) = pack8(v0, v1);
                }
                q += __shfl_xor(q, 16); q += __shfl_xor(q, 32);
                if (fq == 0) ss[(size_t)(u.pn * 4 + wc) * MT + row] = q;
            }
    }
};
struct EpiGlu {
    static constexpr bool PERM = true, AFTER_DRAIN = false, HAS_MID = false; static constexpr int MID_T = 0;
    const float* gb; const bf16_t* zg; bf16_t* ycat; float* ss;
    __device__ __forceinline__ void operator()(Acc& acc, const Unit& u, int wr, int wc, int fr, int fq) const {
        f32x4 bv[2][2];
#pragma unroll
        for (int bj = 0; bj < 2; ++bj) { const int c8 = u.pn * BM + bj * HALF + wc * 32 + 8 * fq; bv[bj][0] = *(const f32x4*)(gb + c8); bv[bj][1] = *(const f32x4*)(gb + c8 + 4); }
#pragma unroll
        for (int ai = 0; ai < 2; ++ai)
#pragma unroll
            for (int m = 0; m < 4; ++m) {
                const int row = u.pm * BM + ai * HALF + wr * 64 + m * 16 + fr; float q = 0.f;
#pragma unroll
                for (int bj = 0; bj < 2; ++bj) {
                    const int c8 = u.pn * BM + bj * HALF + wc * 32 + 8 * fq;
                    const u32x4 zw = *(const u32x4*)(zg + ((size_t)(c8 >> 4) * MT + row) * 16 + (c8 & 15));
                    f32x4 z0, z1; unpack8(zw, z0, z1);
                    f32x4 v0 = acc[ai][bj][m][0] + bv[bj][0], v1 = acc[ai][bj][m][1] + bv[bj][1];
#pragma unroll
                    for (int i = 0; i < 4; ++i) { v0[i] = z0[i] * fast_sigmoid(v0[i]); v1[i] = z1[i] * fast_sigmoid(v1[i]); }
                    q += (v0[0] * v0[0] + v0[1] * v0[1]) + (v0[2] * v0[2] + v0[3] * v0[3]) + (v1[0] * v1[0] + v1[1] * v1[1]) + (v1[2] * v1[2] + v1[3] * v1[3]);
                    *(u32x4*)(ycat + (size_t)row * DM + DPOOL + c8) = pack8(v0, v1);
                }
                q += __shfl_xor(q, 16); q += __shfl_xor(q, 32);
                if (fq == 0) ss[(size_t)(u.pn * 4 + wc) * MT + row] = q;
            }
    }
};
struct EpiOut {
    static constexpr bool PERM = true, AFTER_DRAIN = true, HAS_MID = true; static constexpr int MID_T = 8;
    const bf16_t* xb; bf16_t* h1b; float* ss; LAS f32x2* XR; float ratio[2][4];
    __device__ __forceinline__ void mid(Acc& acc, int wr, int fr) const {
#pragma unroll
        for (int ai = 0; ai < 2; ++ai)
#pragma unroll
            for (int m = 0; m < 4; ++m) { const float ratio = this->ratio[ai][m];
#pragma unroll
                for (int bj = 0; bj < 2; ++bj)
#pragma unroll
                    for (int n = 0; n < 2; ++n) acc[ai][bj][m][n] = acc[ai][bj][m][n] * ratio; }
    }
    __device__ __forceinline__ void fused(Acc& acc, const Unit& u, int wr, int wc, int fr, int fq, LAS unsigned char* lds, int wid, int lane) const {
        LAS float* P = (LAS float*)lds;
        const int col0 = u.pn * BM + wc * 32 + 8 * fq;
#pragma unroll
        for (int ai = 0; ai < 2; ++ai)
#pragma unroll
            for (int m = 0; m < 4; ++m) {
                const int lr = ai * HALF + wr * 64 + m * 16 + fr, row = u.pm * BM + lr; const float rs = XR[lr].y; float q = 0.f;
                const size_t prow = (size_t)(row >> 12) * PADROWS + 1 + (row & 4095);
#pragma unroll
                for (int bj = 0; bj < 2; ++bj) {
                    const int c = col0 + bj * HALF;
                    f32x4 x0, x1; unpack8(*(const u32x4*)(xb + (size_t)row * DM + c), x0, x1);
                    const f32x4 h0 = x0 + acc[ai][bj][m][0] * rs, h1v = x1 + acc[ai][bj][m][1] * rs;
                    q += (h0[0] * h0[0] + h0[1] * h0[1]) + (h0[2] * h0[2] + h0[3] * h0[3]) + (h1v[0] * h1v[0] + h1v[1] * h1v[1]) + (h1v[2] * h1v[2] + h1v[3] * h1v[3]);
                    *(u32x4*)(h1b + prow * DM + c) = pack8(h0, h1v);
                }
                q += __shfl_xor(q, 16); q += __shfl_xor(q, 32);
                if (fq == 0) P[lr * 4 + wc] = q;
            }
        LDS_WAIT(); __builtin_amdgcn_s_barrier(); asm volatile("" ::: "memory");
        const int tid = wid * 64 + lane;
        if (tid < 256) ss[(size_t)u.pn * MT + u.pm * BM + tid] = (P[tid * 4 + 0] + P[tid * 4 + 1]) + (P[tid * 4 + 2] + P[tid * 4 + 3]);
    }
};
struct EpiUp {
    static constexpr bool PERM = true, AFTER_DRAIN = false, HAS_MID = false; static constexpr int MID_T = 0;
    const LAS float* rsl; const float* cw; const float* cb; bf16_t* act;
    __device__ __forceinline__ void operator()(Acc& acc, const Unit& u, int wr, int wc, int fr, int fq) const {
        const int j = u.pm, b = u.g;
#pragma unroll
        for (int ai = 0; ai < 2; ++ai)
#pragma unroll
            for (int m = 0; m < 4; ++m) {
                const float rs = rsl[u.aux * 256 + 126 * wr + 64 * ai + 4 * fr + m];
#pragma unroll
                for (int bj = 0; bj < 2; ++bj)
#pragma unroll
                    for (int n = 0; n < 2; ++n) acc[ai][bj][m][n] = acc[ai][bj][m][n] * rs;
            }
        const int f0 = 128 * u.pn + 32 * wc + 8 * fq;
        u32x2 keep[8];
#pragma unroll
        for (int n = 0; n < 2; ++n) {
            const int fc = f0 + 4 * n;
            const f32x4 wv0 = *(const f32x4*)(cw + fc), wv1 = *(const f32x4*)(cw + DFF2 + fc), wv2 = *(const f32x4*)(cw + 2 * DFF2 + fc), bvv = *(const f32x4*)(cb + fc);
            const f32x4 wg0 = *(const f32x4*)(cw + DFF + fc), wg1 = *(const f32x4*)(cw + DFF2 + DFF + fc), wg2 = *(const f32x4*)(cw + 2 * DFF2 + DFF + fc), bgv = *(const f32x4*)(cb + DFF + fc);
#pragma unroll
            for (int ai = 0; ai < 2; ++ai) {
                f32x4 pv, pg, nv, ng;
#pragma unroll
                for (int i = 0; i < 4; ++i) {
                    pv[i] = dpp_ror1(fr == 15 ? acc[ai ^ 1][0][3][n][i] : acc[ai][0][3][n][i]); pg[i] = dpp_ror1(fr == 15 ? acc[ai ^ 1][1][3][n][i] : acc[ai][1][3][n][i]);
                    nv[i] = dpp_ror15(fr == 0 ? acc[ai ^ 1][0][0][n][i] : acc[ai][0][0][n][i]); ng[i] = dpp_ror15(fr == 0 ? acc[ai ^ 1][1][0][n][i] : acc[ai][1][0][n][i]);
                }
#pragma unroll
                for (int m = 0; m < 4; ++m) {
                    const f32x4 cv = acc[ai][0][m][n], cg = acc[ai][1][m][n];
                    const f32x4 v_prev = m > 0 ? acc[ai][0][m - 1][n] : pv, g_prev = m > 0 ? acc[ai][1][m - 1][n] : pg;
                    const f32x4 v_next = m < 3 ? acc[ai][0][m + 1][n] : nv, g_next = m < 3 ? acc[ai][1][m + 1][n] : ng;
                    f32x4 o;
#pragma unroll
                    for (int i = 0; i < 4; ++i) {
                        const float vv = bvv[i] + wv0[i] * v_prev[i] + wv1[i] * cv[i] + wv2[i] * v_next[i];
                        const float gg = bgv[i] + wg0[i] * g_prev[i] + wg1[i] * cg[i] + wg2[i] * g_next[i];
                        o[i] = vv * gg * fast_sigmoid(gg);
                    }
                    const u32x2 pk = pack4(o); const int gi = ai * 4 + m;
                    if (n == 0) keep[gi] = pk;
                    else { const int w = 64 * ai + 4 * fr + m, t = UPROWS * j + 126 * wr + w - 1;
                           if (t >= 0 && t < SEQ && w >= 1 && w <= 126) { u32x4 wv; wv.x = keep[gi].x; wv.y = keep[gi].y; wv.z = pk.x; wv.w = pk.y; *(u32x4*)(act + (size_t)(b * SEQ + t) * DFF + f0) = wv; } }
                }
            }
        }
    }
};
struct EpiDown {
    static constexpr bool PERM = true, AFTER_DRAIN = true, HAS_MID = false; static constexpr int MID_T = 0;
    const bf16_t* h1b; float* out; const float* gfin; float* ss; const XcdBarrier* bar;
    __device__ __forceinline__ void fused(Acc& acc, const Unit& u, int wr, int wc, int fr, int fq, LAS unsigned char* lds, int wid, int lane) const {
        LAS float* P = (LAS float*)lds;
        LAS float* Sr = (LAS float*)(lds + 8192);
        const int col0 = u.pn * BM + wc * 32 + 8 * fq;
#pragma unroll
        for (int ai = 0; ai < 2; ++ai)
#pragma unroll
            for (int m = 0; m < 4; ++m) {
                const int lr = ai * HALF + wr * 64 + m * 16 + fr, row = u.pm * BM + lr; float q = 0.f;
                const size_t prow = (size_t)(row >> 12) * PADROWS + 1 + (row & 4095);
#pragma unroll
                for (int bj = 0; bj < 2; ++bj) {
                    f32x4 b0, b1; unpack8(*(const u32x4*)(h1b + prow * DM + col0 + bj * HALF), b0, b1);
                    const f32x4 h0 = b0 + acc[ai][bj][m][0], h1v = b1 + acc[ai][bj][m][1];
                    acc[ai][bj][m][0] = h0; acc[ai][bj][m][1] = h1v;
                    q += (h0[0] * h0[0] + h0[1] * h0[1]) + (h0[2] * h0[2] + h0[3] * h0[3]) + (h1v[0] * h1v[0] + h1v[1] * h1v[1]) + (h1v[2] * h1v[2] + h1v[3] * h1v[3]);
                }
                q += __shfl_xor(q, 16); q += __shfl_xor(q, 32);
                if (fq == 0) P[lr * 4 + wc] = q;
            }
        LDS_WAIT(); __builtin_amdgcn_s_barrier(); asm volatile("" ::: "memory");
        const int tid = wid * 64 + lane;
        if (tid < 256) ss[(size_t)u.pn * MT + u.pm * BM + tid] = (P[tid * 4 + 0] + P[tid * 4 + 1]) + (P[tid * 4 + 2] + P[tid * 4 + 3]);
        xcd_barrier(*bar, tid);
        if (tid < 256) { const int row = u.pm * BM + tid; const float s = (ss[row] + ss[MT + row]) + (ss[2 * MT + row] + ss[3 * MT + row]); Sr[tid] = rsqrtf(s * (1.0f / DM) + EPS); }
        LDS_WAIT(); __builtin_amdgcn_s_barrier(); asm volatile("" ::: "memory");
#pragma unroll
        for (int bj = 0; bj < 2; ++bj) {
            const int c = col0 + bj * HALF; const f32x4 g0 = *(const f32x4*)(gfin + c), g1 = *(const f32x4*)(gfin + c + 4);
#pragma unroll
            for (int ai = 0; ai < 2; ++ai)
#pragma unroll
                for (int m = 0; m < 4; ++m) { const int lr = ai * HALF + wr * 64 + m * 16 + fr; const float r = Sr[lr]; float* o = out + (size_t)(u.pm * BM + lr) * DM + c;
                    *(f32x4*)o = acc[ai][bj][m][0] * r * g0; *(f32x4*)(o + 4) = acc[ai][bj][m][1] * r * g1; }
        }
    }
};

struct OrdOne { Unit u; __device__ bool next(int i, Unit& o) const { if (i > 0) return false; o = u; return true; } };
struct OrdSsmA { int c; __device__ bool next(int i, Unit& u) const { if (i > 0 || c >= 64) return false; const int x = c & 7, k = c >> 3; u.g = x * 4 + (k >> 1); u.pm = k & 1; u.pn = 0; u.aux = 0; return true; } };
struct OrdSsmB { int c; __device__ bool next(int i, Unit& u) const { if (i > 0 || c >= 128) return false; const int x = c & 7, k = c >> 3; u.g = x * 4 + (k >> 2); u.pm = k & 3; u.pn = 0; u.aux = 0; return true; } };
struct OrdPool { int c; __device__ bool next(int i, Unit& u) const { if (i > 0 || c < 128 || c >= 256) return false; const int cc = c - 128, x = cc & 7, k = cc >> 3; u.pm = x * 8 + (k >> 1); u.pn = k & 1; u.g = u.pn; u.aux = 0; return true; } };
struct OrdGlu  { int c; __device__ bool next(int i, Unit& u) const { if (i > 0 || c >= 128) return false; const int x = c & 7, k = c >> 3; u.pm = x * 8 + (k >> 1); u.pn = k & 1; u.g = 0; u.aux = 0; return true; } };
struct OrdUp { StaticOrder so; __device__ bool next(int i, Unit& u) const { if (!so.next(i, u)) return false; u.g = u.pm / UPT; u.pm = u.pm % UPT; u.aux = i; return true; } };

struct Args { const float* in[24]; float* out; unsigned char* ws; int ph_lo, ph_hi; };

struct Frame { LAS unsigned char* lds; int tid, lane, wave, G, bx; };

struct TrMat { const float* W; int K, N; const float* kg0; const float* kg1; int ksplit; bf16_t* WT; int map; int nitems; };
__device__ __forceinline__ void tr_load(const TrMat& m0, const TrMat& m1, int item, int lane, f32x4 (&v)[8]) {
    const bool second = item >= m0.nitems; const TrMat& m = second ? m1 : m0; const int it = second ? item - m0.nitems : item;
    const int nblk = m.N / 32, kb = it / nblk, nb = it % nblk, k0 = 64 * kb, n0 = 32 * nb, r = lane >> 3, c4 = lane & 7;
#pragma unroll
    for (int i = 0; i < 8; ++i) v[i] = *(const f32x4*)(m.W + (size_t)(k0 + 8 * i + r) * m.N + n0 + 4 * c4);
}
__device__ __forceinline__ void tr_store(const TrMat& m0, const TrMat& m1, int item, int lane, const f32x4 (&v)[8], LAS float* scr) {
    const bool second = item >= m0.nitems; const TrMat& m = second ? m1 : m0; const int it = second ? item - m0.nitems : item;
    const int nblk = m.N / 32, kb = it / nblk, nb = it % nblk, k0 = 64 * kb, n0 = 32 * nb, r = lane >> 3, c4 = lane & 7;
#pragma unroll
    for (int i = 0; i < 8; ++i) { const int kk = 8 * i + r, k = k0 + kk; float gn = 1.f; if (m.kg0) gn = (k < m.ksplit ? m.kg0[k] : m.kg1[k - m.ksplit]);
        LAS float* d = scr + kk * 33 + 4 * c4; d[0] = v[i][0] * gn; d[1] = v[i][1] * gn; d[2] = v[i][2] * gn; d[3] = v[i][3] * gn; }
    LDS_WAIT(); asm volatile("" ::: "memory");
    const int c = lane & 7;
#pragma unroll
    for (int j = 0; j < 4; ++j) { const int n = (lane >> 3) + 8 * j; const LAS float* q = scr + (8 * c) * 33 + n;
        u32x4 o; o.x = pk2(q[0 * 33], q[1 * 33]); o.y = pk2(q[2 * 33], q[3 * 33]); o.z = pk2(q[4 * 33], q[5 * 33]); o.w = pk2(q[6 * 33], q[7 * 33]);
        int nr = n0 + n;
        if (m.map == 1) { const int bj = nr / DFF, rem = nr % DFF; nr = 256 * (rem >> 7) + 128 * bj + (rem & 127); }
        *(u32x4*)(m.WT + (size_t)nr * m.K + k0 + 8 * c) = o; }
    LDS_WAIT(); asm volatile("" ::: "memory");
}
__device__ __forceinline__ void tr_run(const TrMat& m0, const TrMat& m1, int first, int stride, int lane, LAS float* scr) {
    const int total = m0.nitems + m1.nitems; f32x4 va[8], vb[8];
    int it = first; if (it < total) tr_load(m0, m1, it, lane, va);
    while (it < total) {
        const int n1 = it + stride; if (n1 < total) tr_load(m0, m1, n1, lane, vb);
        tr_store(m0, m1, it, lane, va, scr);
        if (n1 >= total) break;
        const int n2 = n1 + stride; if (n2 < total) tr_load(m0, m1, n2, lane, va);
        tr_store(m0, m1, n1, lane, vb, scr);
        it = n2;
    }
}

struct SsmLds { LAS float* Bre; LAS float* Bim; LAS float* Cre; LAS float* Cim; LAS float* PAR; LAS float* Pc; LAS float* Kl; };
__device__ __forceinline__ SsmLds ssm_lds(const Frame& F) { SsmLds L; L.Bre = (LAS float*)(F.lds); L.Bim = L.Bre + 2048; L.Cre = L.Bim + 2048; L.Cim = L.Cre + 2048; L.PAR = L.Cim + 2048; L.Pc = L.PAR + 512; L.Kl = L.Pc + 1024; return L; }
__device__ __forceinline__ void ssm_stage(const Args& a, const Frame& F, const SsmLds& L, int g) {
    const float* lnar = a.in[5]; const float* aim = a.in[6]; const float* ldt = a.in[7];
    const float* bre = a.in[8]; const float* bim = a.in[9]; const float* cre = a.in[10]; const float* cim = a.in[11];
    const int tid = F.tid;
    for (int i = tid; i < 2048; i += 512) { const int dir = i >> 10, r = i & 1023;
        L.Bre[i] = bre[((size_t)(dir * NG + g)) * 1024 + r]; L.Bim[i] = bim[((size_t)(dir * NG + g)) * 1024 + r];
        L.Cre[i] = cre[((size_t)(dir * NG + g)) * 1024 + r]; L.Cim[i] = cim[((size_t)(dir * NG + g)) * 1024 + r]; }
    if (tid < 128) { const int dir = tid >> 6, n = tid & 63;
        const float dt = expf(ldt[dir * NG + g]); const float a_re = -expf(lnar[(dir * NG + g) * NS + n]), a_im = aim[(dir * NG + g) * NS + n];
        const float mag = expf(a_re * dt), ang = a_im * dt; const float lam_re = mag * cosf(ang), lam_im = mag * sinf(ang);
        const float den = a_re * a_re + a_im * a_im;
        L.PAR[tid * 4 + 0] = a_re * dt; L.PAR[tid * 4 + 1] = ang;
        L.PAR[tid * 4 + 2] = ((lam_re - 1.0f) * a_re + lam_im * a_im) / den; L.PAR[tid * 4 + 3] = (lam_im * a_re - (lam_re - 1.0f) * a_im) / den; }
    __syncthreads();
}
__device__ __forceinline__ void ssm_build_tb(const Args& a, const Frame& F, const SsmLds& L, int g, int lag0, int nl) {
    bf16_t* KC = (bf16_t*)(a.ws + WS_TB) + (size_t)g * (2 * TCH) * 256;
    bf16_t* TBC = (bf16_t*)(a.ws + WS_TBC) + (size_t)g * K1 * 256;
    const int tid = F.tid;
    { const int li = tid >> 7, dn = tid & 127, lag = lag0 + li; const float ad = L.PAR[dn * 4 + 0], ang = L.PAR[dn * 4 + 1], fr_ = L.PAR[dn * 4 + 2], fi_ = L.PAR[dn * 4 + 3];
      const float mg = expf((float)lag * ad); float sn, cs; sincosf((float)lag * ang, &sn, &cs); const float lr = mg * cs, lim = mg * sn;
      L.Pc[(li * 128 + dn) * 2 + 0] = lr * fr_ - lim * fi_; L.Pc[(li * 128 + dn) * 2 + 1] = lr * fi_ + lim * fr_; }
    __syncthreads();
    { const int li = F.wave >> 1, dir = F.wave & 1, i16 = F.lane & 15, kq = F.lane >> 4; f32x4 kacc = {0.f, 0.f, 0.f, 0.f};
#pragma unroll 8
      for (int kk0 = 0; kk0 < 128; kk0 += 4) { const int kk = kk0 + kq, n = kk >> 1; const bool im = (kk & 1) != 0;
          const float cr_ = L.Cre[dir * 1024 + i16 * 64 + n], ci_ = L.Cim[dir * 1024 + i16 * 64 + n], pr = L.Pc[(li * 128 + dir * 64 + n) * 2], pi = L.Pc[(li * 128 + dir * 64 + n) * 2 + 1];
          const float av = im ? -(cr_ * pi + ci_ * pr) : (cr_ * pr - ci_ * pi);
          const float bv = im ? L.Bim[dir * 1024 + n * 16 + i16] : L.Bre[dir * 1024 + n * 16 + i16];
          kacc = __builtin_amdgcn_mfma_f32_16x16x4f32(av, bv, kacc, 0, 0, 0); }
#pragma unroll
      for (int r = 0; r < 4; ++r) L.Kl[li * 512 + dir * 256 + (kq * 4 + r) * 16 + i16] = kacc[r]; }
    __syncthreads();
    { const int li = tid >> 7, dir = (tid >> 6) & 1, e4 = tid & 63, lag = lag0 + li;
      if (li < nl && !(lag == 0 && dir == 1)) {
          f32x4 v = *(const LAS f32x4*)(L.Kl + li * 512 + dir * 256 + 4 * e4);
          if (lag == 0) v = v + *(const LAS f32x4*)(L.Kl + li * 512 + 256 + 4 * e4);
          const int d = dir == 0 ? (TCH - 1) + lag : (TCH - 1) - lag; u32x2 w; w.x = pk2(v[0], v[1]); w.y = pk2(v[2], v[3]);
          *(u32x2*)(KC + (size_t)d * 256 + 4 * e4) = w; } }
    __syncthreads();
    { const int li = tid >> 7, dn = tid & 127, dir = dn >> 6, p = lag0 + li; const float ad = L.PAR[dn * 4 + 0], ang = L.PAR[dn * 4 + 1]; const float e = dir == 0 ? (float)(p + 1) : (float)(TCH - p);
      const float mg = expf(e * ad); float sn, cs; sincosf(e * ang, &sn, &cs); L.Pc[(li * 128 + dn) * 2 + 0] = mg * cs; L.Pc[(li * 128 + dn) * 2 + 1] = mg * sn; }
    __syncthreads();
    for (int li = 0; li < nl; ++li) {
        const int p = lag0 + li, h = tid >> 5, dir = (tid >> 4) & 1, n4 = tid & 15; float v[8];
#pragma unroll
        for (int e = 0; e < 4; ++e) { const int n = 4 * n4 + e; const float cr_ = L.Cre[dir * 1024 + h * 64 + n], ci_ = L.Cim[dir * 1024 + h * 64 + n], pr = L.Pc[(li * 128 + dir * 64 + n) * 2], pi = L.Pc[(li * 128 + dir * 64 + n) * 2 + 1];
            v[2 * e] = cr_ * pr - ci_ * pi; v[2 * e + 1] = -(cr_ * pi + ci_ * pr); }
        u32x4 w; w.x = pk2(v[0], v[1]); w.y = pk2(v[2], v[3]); w.z = pk2(v[4], v[5]); w.w = pk2(v[6], v[7]);
        *(u32x4*)(TBC + (size_t)(16 * p + h) * 256 + dir * 128 + 8 * n4) = w;
    }
    __syncthreads();
}
__device__ __forceinline__ void ssm_build_wab(const Args& a, const Frame& F, const SsmLds& L, int g, int jq) {
    bf16_t* WAB = (bf16_t*)(a.ws + WS_WAB) + (size_t)g * 256 * K1;
    const int tid = F.tid;
    if (jq == 0 && tid < 128) { const int dir = tid >> 6, n = tid & 63; const float ad = L.PAR[tid * 4 + 0], ang = L.PAR[tid * 4 + 1];
        const float mg = expf((float)TCH * ad); float sn, cs; sincosf((float)TCH * ang, &sn, &cs); *(f32x2*)((float*)(a.ws + WS_LAMT) + ((size_t)(dir * NG + g) * NS + n) * 2) = (f32x2){mg * cs, mg * sn}; }
    { const int li = tid >> 7, dn = tid & 127, dir = dn >> 6, q = 4 * jq + li; const float ad = L.PAR[dn * 4 + 0], ang = L.PAR[dn * 4 + 1], fr_ = L.PAR[dn * 4 + 2], fi_ = L.PAR[dn * 4 + 3]; const float e = dir == 0 ? (float)(TCH - 1 - q) : (float)q;
      const float mg = expf(e * ad); float sn, cs; sincosf(e * ang, &sn, &cs); const float lr = mg * cs, lim = mg * sn;
      L.Pc[(li * 128 + dn) * 2 + 0] = lr * fr_ - lim * fi_; L.Pc[(li * 128 + dn) * 2 + 1] = lr * fi_ + lim * fr_; }
    __syncthreads();
#pragma unroll
    for (int half = 0; half < 2; ++half) {
        const int li = 2 * half + (tid >> 8), q = 4 * jq + li, t2 = tid & 255, dir = t2 >> 7, n = (t2 >> 1) & 63, part = t2 & 1;
        const float pr = L.Pc[(li * 128 + dir * 64 + n) * 2], pi = L.Pc[(li * 128 + dir * 64 + n) * 2 + 1]; float v[16];
#pragma unroll
        for (int i = 0; i < 16; ++i) { const float br_ = L.Bre[dir * 1024 + n * 16 + i], bi_ = L.Bim[dir * 1024 + n * 16 + i]; v[i] = part == 0 ? (pr * br_ - pi * bi_) : (pr * bi_ + pi * br_); }
        u32x4 w0, w1; w0.x = pk2(v[0], v[1]); w0.y = pk2(v[2], v[3]); w0.z = pk2(v[4], v[5]); w0.w = pk2(v[6], v[7]); w1.x = pk2(v[8], v[9]); w1.y = pk2(v[10], v[11]); w1.z = pk2(v[12], v[13]); w1.w = pk2(v[14], v[15]);
        bf16_t* dst = WAB + (size_t)(dir * 128 + 2 * n + part) * K1 + 16 * q; *(u32x4*)dst = w0; *(u32x4*)(dst + 8) = w1;
    }
    __syncthreads();
}

__device__ __forceinline__ void p0_prologue(const Args& a, const Frame& F) {
    const float* x = a.in[0];
    { const SsmLds L = ssm_lds(F);
      for (int it = F.bx; it < NG * (TCH / 4); it += F.G) { ssm_stage(a, F, L, it / (TCH / 4)); ssm_build_wab(a, F, L, it / (TCH / 4), it % (TCH / 4)); } }
    __syncthreads();
    LAS float* scr = (LAS float*)(F.lds + F.wave * 16384);
    const int gw = F.bx * 8 + F.wave, NGW = F.G * 8;
    { const TrMat m0{a.in[2], DM, DM, a.in[1], a.in[1], DM, (bf16_t*)(a.ws + WS_WIN), 0, (DM / 64) * (DM / 32)}; const TrMat m1{nullptr, 0, 32, nullptr, nullptr, 0, nullptr, 0, 0};
      tr_run(m0, m1, gw, NGW, F.lane, scr); }
    { bf16_t* PW = (bf16_t*)(a.ws + WS_PW); const float* pw = a.in[3];
      for (int idx = F.bx * 512 + F.tid; idx < 2 * 256 * 256; idx += F.G * 512) { const int pn = idx >> 16, j = (idx >> 8) & 255, k = idx & 255;
          const float v = ((j >> 7) == (k >> 7)) ? pw[((size_t)(2 * pn + (j >> 7)) * 128 + (k & 127)) * 128 + (j & 127)] : 0.f; PW[idx] = (bf16_t)f2bf(v); } }
    { bf16_t* h1b = (bf16_t*)(a.ws + WS_H1B);
      for (int idx = F.bx * 512 + F.tid; idx < BATCH * 256 * (DM / 8); idx += F.G * 512) { const int b = idx / (256 * 128), r = (idx / 128) % 256, c = idx % 128; const int prow = b * PADROWS + (r == 0 ? 0 : 4096 + r);
          *(u32x4*)(h1b + (size_t)prow * DM + 8 * c) = (u32x4){0u, 0u, 0u, 0u}; } }
    { bf16_t* xb = (bf16_t*)(a.ws + WS_XB); float* r0 = (float*)(a.ws + WS_R0);
      for (int row = gw; row < MT; row += NGW) {
          const f32x4* xr = (const f32x4*)(x + (size_t)row * DM) + F.lane; f32x4 v[4]; float s = 0.f;
#pragma unroll
          for (int j = 0; j < 4; ++j) { v[j] = xr[64 * j]; s += (v[j][0] * v[j][0] + v[j][1] * v[j][1]) + (v[j][2] * v[j][2] + v[j][3] * v[j][3]); }
          s = wave_sum(s); if (F.lane == 0) r0[row] = rsqrtf(s * (1.0f / DM) + EPS);
          u32x2* o = (u32x2*)(xb + (size_t)row * DM) + F.lane;
#pragma unroll
          for (int j = 0; j < 4; ++j) o[64 * j] = pack4(v[j]);
      } }
}

__device__ __forceinline__ void p2_side(const Args& a, const Frame& F, int first_block) {
    const int nb = F.G - first_block, sb = F.bx - first_block;
    { const SsmLds L = ssm_lds(F);
      int id = (sb * (NG * TCH)) / nb; const int id_end = ((sb + 1) * (NG * TCH)) / nb; int staged = -1;
      while (id < id_end) {
          const int g = id / TCH, lag0 = id % TCH; int nl = TCH - lag0; if (nl > 4) nl = 4; if (nl > id_end - id) nl = id_end - id;
          if (g != staged) { ssm_stage(a, F, L, g); staged = g; }
          ssm_build_tb(a, F, L, g, lag0, nl); id += nl;
      } }
    __syncthreads();
    LAS float* scr = (LAS float*)(F.lds + F.wave * 16384);
    const TrMat m0{a.in[13], DSSM, DSSM, nullptr, nullptr, 0, (bf16_t*)(a.ws + WS_WGLU), 0, (DSSM / 64) * (DSSM / 32)}; const TrMat m1{nullptr, 0, 32, nullptr, nullptr, 0, nullptr, 0, 0};
    tr_run(m0, m1, sb * 8 + F.wave, nb * 8, F.lane, scr);
}
__device__ __forceinline__ void ssm_side(const Args& a, const Frame& F, int first_block) {
    const int nb = F.G - first_block, sb = F.bx - first_block;
    { const SsmLds L = ssm_lds(F);
      const int g = sb >> 2, lag0 = (sb & 3) * 4;
      ssm_stage(a, F, L, g); ssm_build_tb(a, F, L, g, lag0, 4);
      VM_WAIT(); __syncthreads();
      if (F.tid == 0) { __builtin_amdgcn_fence(__ATOMIC_RELEASE, "agent"); asm volatile("s_waitcnt vmcnt(0)" ::: "memory");
          __hip_atomic_fetch_add((unsigned*)(a.ws + WS_CTL) + CW_TBCNT + 64 * g, 4u, __ATOMIC_RELAXED, __HIP_MEMORY_SCOPE_AGENT); } }
    __syncthreads();
    LAS float* scr = (LAS float*)(F.lds + F.wave * 16384);
    const TrMat m0{a.in[17], DM, DM, a.in[15], a.in[16], DPOOL, (bf16_t*)(a.ws + WS_WOUT), 0, (DM / 64) * (DM / 32)};
    const TrMat m1{a.in[13], DSSM, DSSM, nullptr, nullptr, 0, (bf16_t*)(a.ws + WS_WGLU), 0, (DSSM / 64) * (DSSM / 32)};
    tr_run(m0, m1, sb * 8 + F.wave, nb * 8, F.lane, scr);
    const TrMat m2{a.in[22], DFF, DM, nullptr, nullptr, 0, (bf16_t*)(a.ws + WS_WDOWN), 0, (DFF / 64) * (DM / 32)}; const TrMat m3{nullptr, 0, 32, nullptr, nullptr, 0, nullptr, 0, 0};
    tr_run(m2, m3, sb * 8 + F.wave, nb * 8, F.lane, scr);
}
__device__ __forceinline__ void tb_wait(const Args& a, const Frame& F, int g) {
    if (F.tid == 0) { unsigned* cnt = (unsigned*)(a.ws + WS_CTL) + CW_TBCNT + 64 * g; unsigned sp = 0;
        while (__hip_atomic_load(cnt, __ATOMIC_RELAXED, __HIP_MEMORY_SCOPE_AGENT) < (unsigned)TCH) { __builtin_amdgcn_s_sleep(2); if (++sp > (1u << 20)) break; }
        __builtin_amdgcn_fence(__ATOMIC_ACQUIRE, "agent"); asm volatile("s_waitcnt vmcnt(0)" ::: "memory"); }
    __syncthreads();
}
__device__ __forceinline__ void p3_side(const Args& a, const Frame& F, int first_block) {
    const int nb = F.G - first_block, sb = F.bx - first_block;
    LAS float* scr = (LAS float*)(F.lds + F.wave * 16384);
    const TrMat m0{a.in[17], DM, DM, a.in[15], a.in[16], DPOOL, (bf16_t*)(a.ws + WS_WOUT), 0, (DM / 64) * (DM / 32)}; const TrMat m1{nullptr, 0, 32, nullptr, nullptr, 0, nullptr, 0, 0};
    tr_run(m0, m1, sb * 8 + F.wave, nb * 8, F.lane, scr);
}
__device__ __forceinline__ void p4_side(const Args& a, const Frame& F, int first_block) {
    const int nb = F.G - first_block, sb = F.bx - first_block;
    LAS float* scr = (LAS float*)(F.lds + F.wave * 16384);
    const TrMat m0{a.in[19], DM, DFF2, a.in[18], a.in[18], DM, (bf16_t*)(a.ws + WS_WUP), 1, (DM / 64) * (DFF2 / 32)};
    const TrMat m1{nullptr, 0, 32, nullptr, nullptr, 0, nullptr, 0, 0};
    tr_run(m0, m1, sb * 8 + F.wave, nb * 8, F.lane, scr);
}

__device__ __forceinline__ void p2_pooled(const Args& a, const Frame& F, int first_block) {
    const bf16_t* up = (const bf16_t*)(a.ws + WS_UPOOL); bf16_t* po = (bf16_t*)(a.ws + WS_POOLED);
    const int gw = (F.bx - first_block) * 8 + F.wave, NGW = (F.G - first_block) * 8;
    const int c0 = 8 * F.lane, half = 1 << (F.lane >> 4);
    for (int blk = gw; blk < MT / 4; blk += NGW) {
        const int row0 = blk * 4, b = row0 / SEQ, t0 = row0 % SEQ;
        u32x4 w[19];
#pragma unroll
        for (int o = 0; o < 19; ++o) { int q = t0 + o - 8; q = q < 0 ? 0 : (q >= SEQ ? SEQ - 1 : q); w[o] = *(const u32x4*)(up + (size_t)(b * SEQ + q) * DPOOL + c0); }
#pragma unroll
        for (int r = 0; r < 4; ++r) {
            f32x4 s0 = {0.f, 0.f, 0.f, 0.f}, s1 = {0.f, 0.f, 0.f, 0.f}; float cnt = 0.f;
#pragma unroll
            for (int d = -8; d < 8; ++d) { const int q = t0 + r + d; const float m = (d >= -half && d < half && q >= 0 && q < SEQ) ? 1.f : 0.f; f32x4 a0, a1; unpack8(w[r + d + 8], a0, a1); s0 = s0 + a0 * m; s1 = s1 + a1 * m; cnt += m; }
            f32x4 c0v, c1v; unpack8(w[r + 8], c0v, c1v);
            const float inv = __builtin_amdgcn_rcpf(cnt);
            *(u32x4*)(po + (size_t)(row0 + r) * DPOOL + c0) = pack8(s0 * inv - c0v, s1 * inv - c1v);
        }
    }
}

__device__ __forceinline__ void p3_carries(const Args& a, const Frame& F, int g, int b) {
    static_assert(NCHB == 256, "8 segments of 32 chunks");
    LAS float* TOT = (LAS float*)(F.lds);
    const int seg = F.tid >> 6, n = F.tid & 63;
    for (int dir = 0; dir < 2; ++dir) {
        const float dt = expf(a.in[7][dir * NG + g]); const float a_re = -expf(a.in[5][(dir * NG + g) * NS + n]), a_im = a.in[6][(dir * NG + g) * NS + n];
        const float mg = expf((float)TCH * (a_re * dt)); float sn, cs; sincosf((float)TCH * (a_im * dt), &sn, &cs); const float lr = mg * cs, li = mg * sn;
        const float* fg = (const float*)(a.ws + WS_FG) + ((size_t)g * NCR + (size_t)b * NCHB) * 256 + dir * 128 + 2 * n;
        bf16_t* us = (bf16_t*)(a.ws + WS_USSM) + ((size_t)g * NCR + (size_t)b * NCHB) * ROWLEN + K1 + dir * 128 + 2 * n;
        f32x2 f[32];
#pragma unroll
        for (int k = 0; k < 32; ++k) { const int i = 32 * seg + k, c = dir == 0 ? i : NCHB - 1 - i; f[k] = *(const f32x2*)(fg + (size_t)c * 256); }
        float sr = 0.f, si = 0.f;
#pragma unroll
        for (int k = 0; k < 32; ++k) { const float nr = lr * sr - li * si + f[k].x, ni = lr * si + li * sr + f[k].y; sr = nr; si = ni; }
        TOT[F.tid * 2] = sr; TOT[F.tid * 2 + 1] = si;
        float pr = lr, pi = li;
#pragma unroll
        for (int q = 0; q < 5; ++q) { const float nr = pr * pr - pi * pi, ni = 2.f * pr * pi; pr = nr; pi = ni; }
        __syncthreads();
        sr = 0.f; si = 0.f;
        for (int s2 = 0; s2 < seg; ++s2) { const int o = (s2 * 64 + n) * 2; const float tr = TOT[o], ti = TOT[o + 1]; const float nr = pr * sr - pi * si + tr, ni = pr * si + pi * sr + ti; sr = nr; si = ni; }
#pragma unroll
        for (int k = 0; k < 32; ++k) { const int i = 32 * seg + k, c = dir == 0 ? i : NCHB - 1 - i;
            *(unsigned*)(us + (size_t)c * ROWLEN) = pk2(sr, si);
            const float nr = lr * sr - li * si + f[k].x, ni = lr * si + li * sr + f[k].y; sr = nr; si = ni; }
        __syncthreads();
    }
    VM_WAIT(); __syncthreads();
}

__global__ void __launch_bounds__(512, 2) mk_fwd(Args args) {
    extern __shared__ __attribute__((aligned(16))) unsigned char lds_raw[];
    Frame F; F.lds = (LAS unsigned char*)lds_raw; F.tid = threadIdx.x; F.lane = F.tid & 63; F.wave = __builtin_amdgcn_readfirstlane(F.tid >> 6); F.G = gridDim.x; F.bx = blockIdx.x;
    volatile LAS unsigned* MISC = (volatile LAS unsigned*)(F.lds + LDSCTL_OFF);
    for (int u = F.tid; u < (LDS_BYTES - LDSCTL_OFF) / 4; u += 512) ((LAS unsigned*)(F.lds + LDSCTL_OFF))[u] = 0u;
    __syncthreads();
    unsigned char* ws = args.ws;
    XcdBarrier bar = xcd_barrier_post((unsigned*)(ws + WS_CTL), MISC + 8);
    const int lo = args.ph_lo, hi = args.ph_hi;
#define IN(k) (lo <= (k) && (k) < hi)
#define BOTH(k) (IN(k) && IN((k) == 2 ? 4 : (k) + 1))
    if (IN(0)) { p0_prologue(args, F); if (BOTH(0)) xcd_barrier(bar, F.tid); }
    if (IN(1)) { F.lane = lane_id_fresh(); F.tid = F.wave * 64 + F.lane;
        GemmDesc g{(const char*)(ws + WS_XB), (const char*)(ws + WS_WIN), 256L * DM * 2, 0, 256L * DM * 2, 0, 128L * DM * 2, 128L * DM * 2, 128, 128, DM / BK};
        unsigned vA[2], vB[2]; voff_std(vA, DM, false, F.tid); voff_std(vB, DM, true, F.tid);
        StaticOrder S; S.init(MT / BM, DM / BM, F.G, F.bx);
        EpiU E{(const float*)(ws + WS_R0), (bf16_t*)(ws + WS_UPOOL), (bf16_t*)(ws + WS_USSM)};
        gemm_phase<EpiU, StaticOrder, true>(F.lds, g, vA, vB, S, E, F.tid, nullptr);
        if (BOTH(1)) xcd_barrier(bar, F.tid);
    }
    if (IN(2)) { F.lane = lane_id_fresh(); F.tid = F.wave * 64 + F.lane;
        if (F.bx < 128) {
            OrdSsmB S0{F.bx}; Unit u0; S0.next(0, u0);
            { GemmDesc g{(const char*)(ws + WS_USSM), (const char*)(ws + WS_WAB), 256L * ROWLEN * 2, (long)NCR * ROWLEN * 2, 0, 256L * K1 * 2, 128L * ROWLEN * 2, 128L * K1 * 2, 128, 128, K1 / BK};
              unsigned vA[2], vB[2]; voff_std(vB, K1, false, F.tid);
#pragma unroll
              for (int i = 0; i < 2; ++i) { int R, C; stage_rc(F.tid * 16 + i * 8192, R, C);
                  vA[i] = (unsigned)(((64 * (R >> 6) + 4 * (R & 15) + ((R >> 4) & 3)) * ROWLEN + C) * 2); }
              OrdOne S{u0}; EpiScan E{(const float*)(ws + WS_LAMT), (bf16_t*)(ws + WS_USSM)};
              gemm_phase<EpiScan, OrdOne, false>(F.lds, g, vA, vB, S, E, F.tid, nullptr); }
            VM_WAIT(); __syncthreads();
            tb_wait(args, F, u0.g);
            F.lane = lane_id_fresh(); F.tid = F.wave * 64 + F.lane;
            { GemmDesc g{(const char*)(ws + WS_USSM), (const char*)(ws + WS_TB), 256L * ROWLEN * 2, (long)NCR * ROWLEN * 2, 0, (2L * TCH) * 512, 128L * ROWLEN * 2, 8L * 512, 128, -4L * 512, ROWLEN / BK,
                         (const char*)(ws + WS_TBC), 0, (long)K1 * 512, 128L * 512, 128, K1 / BK};
              unsigned vA[2], vB[2], vB2[2]; voff_std(vA, ROWLEN, false, F.tid); voff_std(vB2, 256, true, F.tid);
#pragma unroll
              for (int i = 0; i < 2; ++i) { int R, C; stage_rc(F.tid * 16 + i * 8192, R, C); const int Rb = (R & ~31) + perm32(R & 31);
                  vB[i] = (unsigned)((((Rb >> 4) - (C >> 4) + (TCH - 1)) * 256 + (Rb & 15) * 16 + (C & 15)) * 2); }
              asm volatile("" : "+v"(vA[0]), "+v"(vA[1]), "+v"(vB[0]), "+v"(vB[1]), "+v"(vB2[0]), "+v"(vB2[1]));
              OrdOne S{u0}; EpiZ E{(const bf16_t*)(ws + WS_USSM), args.in[12], (bf16_t*)(ws + WS_ZG)};
              gemm_phase<EpiZ, OrdOne, true, true>(F.lds, g, vA, vB, S, E, F.tid, nullptr, vB2); }
        } else { ssm_side(args, F, 128); p2_pooled(args, F, 128); }
        if (BOTH(2)) xcd_barrier(bar, F.tid);
    }
    if (IN(4)) { F.lane = lane_id_fresh(); F.tid = F.wave * 64 + F.lane;
        if (F.bx < 128) {
            constexpr long GSTR = (long)MT * 32;
            GemmDesc g{(const char*)(ws + WS_ZG), (const char*)(ws + WS_WGLU), 256L * 32, 0, 256L * DSSM * 2, 0, 128L * 32, 128L * DSSM * 2, 4 * GSTR, 128, DSSM / BK};
            unsigned vA[2], vB[2]; voff_std(vB, DSSM, true, F.tid);
#pragma unroll
            for (int i = 0; i < 2; ++i) { int R, C; stage_rc(F.tid * 16 + i * 8192, R, C); vA[i] = (unsigned)(R * 32 + (C >> 4) * (int)GSTR + (C & 15) * 2); }
            OrdGlu S{F.bx}; EpiGlu E{args.in[14], (const bf16_t*)(ws + WS_ZG), (bf16_t*)(ws + WS_YCAT), (float*)(ws + WS_SSSSM)};
            gemm_phase<EpiGlu, OrdGlu, true>(F.lds, g, vA, vB, S, E, F.tid, nullptr);
        } else {
            GemmDesc g{(const char*)(ws + WS_POOLED), (const char*)(ws + WS_PW), 256L * DPOOL * 2, 256L * 2, 256L * 256 * 2, 0, 128L * DPOOL * 2, 128L * 256 * 2, 128, 128, 256 / BK};
            unsigned vA[2], vB[2]; voff_std(vA, DPOOL, false, F.tid); voff_std(vB, 256, true, F.tid);
            OrdPool S{F.bx}; EpiPool E{args.in[4], (bf16_t*)(ws + WS_YCAT), (float*)(ws + WS_SSPOOL)};
            gemm_phase<EpiPool, OrdPool, true>(F.lds, g, vA, vB, S, E, F.tid, nullptr);

            __syncthreads();
            p4_side(args, F, 128);
        }
        if (BOTH(4)) xcd_barrier(bar, F.tid);
    }
    if (IN(5)) { F.lane = lane_id_fresh(); F.tid = F.wave * 64 + F.lane;
        StaticOrder S; S.init(MT / BM, DM / BM, F.G, F.bx); Unit u0;
        LAS f32x2* XR = (LAS f32x2*)(F.lds + XTRA_OFF);
        if (S.next(0, u0)) {
            if (F.tid < 256) { const int row = u0.pm * BM + F.tid; const float* sp = (const float*)(ws + WS_SSPOOL); const float* sm = (const float*)(ws + WS_SSSSM); float a0 = 0.f, a1 = 0.f;
#pragma unroll
                for (int s = 0; s < 8; ++s) { a0 += sp[(size_t)s * MT + row]; a1 += sm[(size_t)s * MT + row]; }
                const float rp = rsqrtf(a0 * (1.0f / DPOOL) + EPS), rsm = rsqrtf(a1 * (1.0f / DSSM) + EPS); XR[F.tid] = (f32x2){rp / rsm, rsm}; }
        }
        __syncthreads();
        GemmDesc g{(const char*)(ws + WS_YCAT), (const char*)(ws + WS_WOUT), 256L * DM * 2, 0, 256L * DM * 2, 0, 128L * DM * 2, 128L * DM * 2, 128, 128, DM / BK};
        unsigned vA[2], vB[2]; voff_std(vA, DM, false, F.tid); voff_std(vB, DM, true, F.tid);
        EpiOut E{(const bf16_t*)(ws + WS_XB), (bf16_t*)(ws + WS_H1B), (float*)(ws + WS_SSH1), XR, {{0.f, 0.f, 0.f, 0.f}, {0.f, 0.f, 0.f, 0.f}}};
        { const int wr_ = F.wave >> 2, fr_ = F.lane & 15;
#pragma unroll
          for (int ai = 0; ai < 2; ++ai)
#pragma unroll
              for (int m = 0; m < 4; ++m) E.ratio[ai][m] = XR[ai * HALF + wr_ * 64 + m * 16 + fr_].x; }
        gemm_phase<EpiOut, StaticOrder, false>(F.lds, g, vA, vB, S, E, F.tid, nullptr);
        if (BOTH(5)) xcd_barrier(bar, F.tid);
    }
    if (IN(6)) { F.lane = lane_id_fresh(); F.tid = F.wave * 64 + F.lane;
        GemmDesc g{(const char*)(ws + WS_H1B), (const char*)(ws + WS_WUP), (long)UPROWS * DM * 2, (long)PADROWS * DM * 2, 256L * DM * 2, 0, 64L * DM * 2, 128L * DM * 2, 128, 128, DM / BK};
        unsigned vA[2], vB[2]; voff_std(vB, DM, true, F.tid);
#pragma unroll
        for (int i = 0; i < 2; ++i) { int R, C; stage_rc(F.tid * 16 + i * 8192, R, C); vA[i] = (unsigned)(((126 * (R >> 6) + 4 * (R & 15) + ((R >> 4) & 3)) * DM + C) * 2); }
        OrdUp S; S.so.init(BATCH * UPT, DFF2 / BM, F.G, F.bx);
        LAS float* RSL = (LAS float*)(F.lds + XTRA_OFF);
        if (F.tid < 256) { const float* ssh1 = (const float*)(ws + WS_SSH1);
#pragma unroll
            for (int i = 0; i < 6; ++i) { Unit uu; if (S.next(i, uu)) { const int t = UPROWS * uu.pm + F.tid - 1; const bool in = (t >= 0 && t < SEQ && F.tid < 254); const int tok = uu.g * SEQ + (in ? t : 0);
                const float sq = (ssh1[tok] + ssh1[MT + tok]) + (ssh1[2 * MT + tok] + ssh1[3 * MT + tok]); RSL[i * 256 + F.tid] = in ? rsqrtf(sq * (1.0f / DM) + EPS) : 0.f; } } }
        __syncthreads();
        EpiUp E{RSL, args.in[20], args.in[21], (bf16_t*)(ws + WS_ACT)};
        gemm_phase<EpiUp, OrdUp, true>(F.lds, g, vA, vB, S, E, F.tid, nullptr);
        if (BOTH(6)) xcd_barrier(bar, F.tid);
    }
    if (IN(7)) { F.lane = lane_id_fresh(); F.tid = F.wave * 64 + F.lane;
        GemmDesc g{(const char*)(ws + WS_ACT), (const char*)(ws + WS_WDOWN), 256L * DFF * 2, 0, 256L * DFF * 2, 0, 128L * DFF * 2, 128L * DFF * 2, 128, 128, DFF / BK};
        unsigned vA[2], vB[2]; voff_std(vA, DFF, false, F.tid); voff_std(vB, DFF, true, F.tid);
        StaticOrder S; S.init(MT / BM, DM / BM, F.G, F.bx);
        EpiDown E{(const bf16_t*)(ws + WS_H1B), args.out, args.in[23], (float*)(ws + WS_SSH2), &bar};
        gemm_phase<EpiDown, StaticOrder, false>(F.lds, g, vA, vB, S, E, F.tid, nullptr);
    }
#undef IN
#undef BOTH
}
}

extern "C" void kernel_launch(void* const* d_in, const int* in_sizes, int n_in, void* d_out, int out_size, void* d_ws, size_t ws_size, hipStream_t stream) {
    static int grid = 0;
    if (grid == 0) {
        int dev = 0, cus = 0, per_cu = 0;
        if (n_in != 24 || out_size != MT * DM || ws_size < mk::WS_END) { fprintf(stderr, "kernel_launch: unexpected problem (n_in %d out %d ws %zu)\n", n_in, out_size, ws_size); grid = -1; return; }
        if (hipGetDevice(&dev) != hipSuccess || hipDeviceGetAttribute(&cus, hipDeviceAttributeMultiprocessorCount, dev) != hipSuccess) { grid = -1; return; }
        if (hipFuncSetAttribute((const void*)mk::mk_fwd, hipFuncAttributeMaxDynamicSharedMemorySize, mk::LDS_BYTES) != hipSuccess) { fprintf(stderr, "kernel_launch: hipFuncSetAttribute failed\n"); grid = -1; return; }
        if (hipOccupancyMaxActiveBlocksPerMultiprocessor(&per_cu, (const void*)mk::mk_fwd, 512, mk::LDS_BYTES) != hipSuccess || per_cu < 1) { fprintf(stderr, "kernel_launch: occupancy query says %d blocks/CU; nothing launched\n", per_cu); (void)hipGetLastError(); grid = -1; return; }
        grid = cus;
        if (grid != 256) { fprintf(stderr, "kernel_launch: built for a 256-CU device, found %d CUs\n", cus); grid = -1; return; }
    }
    if (grid < 0) return;
    (void)in_sizes;
    (void)hipMemsetAsync((char*)d_ws + mk::WS_CTL, 0, mk::CTL_ZERO_BYTES, stream);
    mk::Args a{};
    for (int i = 0; i < 24; ++i) a.in[i] = (const float*)d_in[i];
    a.out = (float*)d_out; a.ws = (unsigned char*)d_ws; a.ph_lo = 0; a.ph_hi = 8;
    hipLaunchKernelGGL(mk::mk_fwd, dim3(grid), dim3(512), mk::LDS_BYTES, stream, a);
}
```

```cpp
#include <hip/hip_runtime.h>
#include <math.h>

constexpr int BATCH = 4, SEQ = 4096, DM = 1024, MT = BATCH * SEQ;
constexpr int DPOOL = 512, DSSM = 512, NG = 32, NH = 16, NS = 64;
constexpr int DFF = 2816, DFF2 = 5632;
constexpr float EPS = 1e-6f;

#include <cstdio>
#include <cstdint>
#define LAS __attribute__((address_space(3)))
#define GAS __attribute__((address_space(1)))
typedef unsigned short bf16_t;
typedef short bf16x8 __attribute__((ext_vector_type(8)));
typedef float f32x4 __attribute__((ext_vector_type(4)));
typedef float f32x2 __attribute__((ext_vector_type(2)));
typedef unsigned u32x4 __attribute__((ext_vector_type(4)));
typedef unsigned u32x2 __attribute__((ext_vector_type(2)));

namespace mk {
constexpr int TCH = 16;
constexpr int K1 = 16 * TCH;
constexpr int ROWLEN = K1 + 256;
constexpr int NCR = MT / TCH;
constexpr int NCHB = SEQ / TCH;
constexpr int PADROWS = 4352;
constexpr int UPT = 17;
constexpr int UPROWS = 252;

constexpr size_t MiB = 1u << 20;
constexpr size_t WS_CTL = 0, CTL_ZERO_BYTES = 64 * 1024;
constexpr int CW_TBCNT = 4096;
constexpr size_t WS_R0 = 1 * MiB;
constexpr size_t WS_SSPOOL = 2 * MiB;
constexpr size_t WS_SSSSM = WS_SSPOOL + 8 * MT * 4;
constexpr size_t WS_SSH1 = WS_SSSSM + 8 * MT * 4;
constexpr size_t WS_SSH2 = WS_SSH1 + 4 * MT * 4;
constexpr size_t WS_LAMT = 6 * MiB;
constexpr size_t WS_WIN = 8 * MiB, WS_WOUT = 10 * MiB, WS_WGLU = 12 * MiB, WS_PW = 12 * MiB + 512 * 1024;
constexpr size_t WS_WUP = 13 * MiB, WS_WDOWN = 24 * MiB;
constexpr size_t WS_WAB = 30 * MiB;
constexpr size_t WS_TB = 38 * MiB;
constexpr size_t WS_TBC = 40 * MiB;
constexpr size_t WS_H1B = 62 * MiB;
constexpr size_t WS_XB = 96 * MiB;
constexpr size_t WS_YCAT = 128 * MiB;
constexpr size_t WS_UPOOL = 128 * MiB;
constexpr size_t WS_USSM = 144 * MiB;
constexpr size_t WS_POOLED = 208 * MiB;
constexpr size_t WS_ZG = 224 * MiB;
constexpr size_t WS_ACT = 96 * MiB;
constexpr size_t WS_END = 240 * MiB;

constexpr int RING_BYTES = 131072, XTRA_OFF = RING_BYTES, XTRA_BYTES = 12288, LDSCTL_OFF = XTRA_OFF + XTRA_BYTES, LDS_BYTES = 147456;

__device__ __forceinline__ unsigned f2bf(float f) { unsigned u = __builtin_bit_cast(unsigned, f); return (u + 0x7fffu + ((u >> 16) & 1u)) >> 16; }
__device__ __forceinline__ unsigned pk2(float lo, float hi) { return f2bf(lo) | (f2bf(hi) << 16); }
__device__ __forceinline__ unsigned cvt_pk_bf16(float lo, float hi) { unsigned r; asm volatile("v_cvt_pk_bf16_f32 %0, %1, %2" : "=v"(r) : "v"(lo), "v"(hi)); return r; }
__device__ __forceinline__ u32x4 pack8(f32x4 a, f32x4 b) { u32x4 w; w.x = cvt_pk_bf16(a[0], a[1]); w.y = cvt_pk_bf16(a[2], a[3]); w.z = cvt_pk_bf16(b[0], b[1]); w.w = cvt_pk_bf16(b[2], b[3]); return w; }
__device__ __forceinline__ u32x2 pack4(f32x4 a) { u32x2 w; w.x = cvt_pk_bf16(a[0], a[1]); w.y = cvt_pk_bf16(a[2], a[3]); return w; }
__device__ __forceinline__ float bflo(unsigned w) { return __builtin_bit_cast(float, w << 16); }
__device__ __forceinline__ float bfhi(unsigned w) { return __builtin_bit_cast(float, w & 0xffff0000u); }
__device__ __forceinline__ void unpack8(u32x4 w, f32x4& a, f32x4& b) { a[0] = bflo(w.x); a[1] = bfhi(w.x); a[2] = bflo(w.y); a[3] = bfhi(w.y); b[0] = bflo(w.z); b[1] = bfhi(w.z); b[2] = bflo(w.w); b[3] = bfhi(w.w); }
__device__ __forceinline__ float fast_sigmoid(float x) { return __builtin_amdgcn_rcpf(1.0f + __builtin_amdgcn_exp2f(-1.4426950408889634f * x)); }
__device__ __forceinline__ float fast_gelu_tanh(float x) {
    const float t = x * (1.0f + 0.044715f * x * x);
    return x * __builtin_amdgcn_rcpf(1.0f + __builtin_amdgcn_exp2f(-2.0f * 0.7978845608028654f * 1.4426950408889634f * t));
}
__device__ __forceinline__ float wave_sum(float v) {
#pragma unroll
    for (int o = 1; o < 64; o <<= 1) v += __shfl_xor(v, o);
    return v;
}
__device__ __forceinline__ float dpp_ror1(float v)  { return __builtin_bit_cast(float, __builtin_amdgcn_update_dpp(0, __builtin_bit_cast(int, v), 0x121, 0xf, 0xf, false)); }
__device__ __forceinline__ float dpp_ror15(float v) { return __builtin_bit_cast(float, __builtin_amdgcn_update_dpp(0, __builtin_bit_cast(int, v), 0x12F, 0xf, 0xf, false)); }
__device__ __forceinline__ int lane_id_fresh() { int l; asm volatile("v_mbcnt_lo_u32_b32 %0, -1, 0\n\tv_mbcnt_hi_u32_b32 %0, -1, %0" : "=v"(l)); return l; }
#define LDS_WAIT() asm volatile("s_waitcnt lgkmcnt(0)" ::: "memory")
#define VM_WAIT() asm volatile("s_waitcnt vmcnt(0)" ::: "memory")

#define XB_TMO      128
#define XB_XCNT(j)  (256  + 64 * (j))
#define XB_XSUB(j)  (1280 + 64 * (j))
#define XB_XGEN(j)  (2304 + 64 * (j))
#define XB_TOP      3328
#define XB_TOPGEN   3392
#define XCD_BAR_WORDS 3456
#define XB_SPIN_CAP (1u << 18)
__device__ __forceinline__ unsigned xb_ld(unsigned* p)              { return __hip_atomic_load(p, __ATOMIC_RELAXED, __HIP_MEMORY_SCOPE_AGENT); }
__device__ __forceinline__ unsigned xb_add(unsigned* p, unsigned v) { return __hip_atomic_fetch_add(p, v, __ATOMIC_RELAXED, __HIP_MEMORY_SCOPE_AGENT); }
__device__ __forceinline__ unsigned xb_xcc_id() { return (unsigned)__builtin_amdgcn_s_getreg((3 << 11) | 20) & 0xFu; }
#define XB_SPIN(cond, bar) do { unsigned _sp = 0; while (cond) { __builtin_amdgcn_s_sleep(1); \
    if ((++_sp & 255u) == 0u) { if (xb_ld(&(bar)[XB_TMO])) break; if (_sp > XB_SPIN_CAP) { atomicAdd(&(bar)[XB_TMO], 1u); break; } } } } while (0)
struct XcdBarrier { unsigned* bar; unsigned x; volatile LAS unsigned* st; };
__device__ __forceinline__ XcdBarrier xcd_barrier_post(unsigned* bar, volatile LAS unsigned* st) {
    XcdBarrier b; b.bar = bar; b.x = xb_xcc_id(); b.st = st;
    if (threadIdx.x == 0) (void)xb_add(&bar[XB_XCNT(b.x)], 1u);
    return b;
}
__device__ __forceinline__ void xcd_barrier_complete(unsigned* bar, unsigned x, unsigned& nloc, unsigned& nx) {
    const unsigned G = gridDim.x * gridDim.y * gridDim.z;
    unsigned sum, cnt, mine, sp = 0u;
    for (;;) {
        sum = 0u; cnt = 0u; mine = 0u;
#pragma unroll
        for (unsigned j = 0; j < 16; ++j) { const unsigned c = xb_ld(&bar[XB_XCNT(j)]); sum += c; cnt += (c > 0u) ? 1u : 0u; mine = (j == x) ? c : mine; }
        if (sum == G) break;
        __builtin_amdgcn_s_sleep(1);
        if ((++sp & 255u) == 0u) { if (xb_ld(&bar[XB_TMO])) break; if (sp > XB_SPIN_CAP) { atomicAdd(&bar[XB_TMO], 1u); break; } }
    }
    nloc = mine > 0u ? mine : 1u; nx = cnt > 0u ? cnt : 1u;
}
__device__ __forceinline__ void xcd_barrier(const XcdBarrier& b, int tid) {
    asm volatile("s_waitcnt vmcnt(0)" ::: "memory");
    __syncthreads();
    if (tid == 0) {
        unsigned* bar = b.bar;
        __builtin_amdgcn_s_waitcnt(0);
        unsigned nloc = b.st[0], nx = b.st[1];
        if (nloc == 0u) { xcd_barrier_complete(bar, b.x, nloc, nx); b.st[0] = nloc; b.st[1] = nx; }
        const unsigned old = xb_add(&bar[XB_XSUB(b.x)], 1u);
        const unsigned gen = old / nloc;
        if (old + 1u == (gen + 1u) * nloc) {
            __builtin_amdgcn_fence(__ATOMIC_RELEASE, "agent");
            asm volatile("s_waitcnt vmcnt(0)" ::: "memory");
            const unsigned og = xb_add(&bar[XB_TOP], 1u);
            const unsigned tg = og / nx;
            if (og + 1u == (tg + 1u) * nx) xb_add(&bar[XB_TOPGEN], 1u);
            else XB_SPIN(xb_ld(&bar[XB_TOPGEN]) == tg, bar);
            __builtin_amdgcn_fence(__ATOMIC_ACQUIRE, "agent");
            xb_add(&bar[XB_XGEN(b.x)], 1u);
            asm volatile("s_waitcnt vmcnt(0)" ::: "memory");
        } else {
            XB_SPIN(xb_ld(&bar[XB_XGEN(b.x)]) == gen, bar);
            __builtin_amdgcn_fence(__ATOMIC_ACQUIRE, "agent");
            asm volatile("s_waitcnt vmcnt(0)" ::: "memory");
        }
    }
    __syncthreads();
}

constexpr int BM = 256, BK = 64, HALF = 128, HTB = HALF * BK * 2, STAGE_BYTES = 8 * HTB, NXCD = 8, WGM = 8;
__host__ __device__ __forceinline__ int lds_byte(int r, int c) { const int st = (r >> 4) * 2 + (c >> 5), rr = r & 15, cc = c & 31, ob = rr * 64 + cc * 2; return st * 1024 + (ob ^ (((ob >> 9) & 1) << 5)); }
__host__ __device__ __forceinline__ void stage_rc(int b, int& R, int& C) { const int st = b / 1024, sb = b % 1024, swz = sb ^ (((sb >> 9) & 1) << 5); R = (st >> 1) * 16 + swz / 64; C = (st & 1) * 32 + (swz % 64) / 2; }
__host__ __device__ __forceinline__ int perm32(int rho) { const int n = rho >> 4, i = rho & 15; return 8 * (i >> 2) + 4 * n + (i & 3); }

struct Unit { int pm, pn, g, aux; };
struct GemmDesc { const char* A; const char* B; long a_pm, a_g, b_pn, b_g, a_h, b_h, a_k, b_k; int nt;
                  const char* B2; long b2_pn, b2_g, b2_h, b2_k; int tsw; };

struct StaticOrder {
    int nM, nN, nwg, G, c;
    __device__ void init(int nM_, int nN_, int G_, int c_) { nM = nM_; nN = nN_; nwg = nM * nN; G = G_; c = c_; }
    __device__ bool next(int i, Unit& u) const {
        const long L = (long)i * G + c; if (L >= nwg) return false;
        int wgid = (int)L; { const int q = nwg / NXCD, r = nwg % NXCD, xcd = wgid % NXCD, off = wgid / NXCD; wgid = (xcd < r ? xcd * (q + 1) : r * (q + 1) + (xcd - r) * q) + off; }
        const int nig = WGM * nN, gid = wgid / nig, fm = gid * WGM, gsz = (nM - fm) < WGM ? (nM - fm) : WGM;
        u.pm = fm + ((wgid % nig) % gsz); u.pn = (wgid % nig) / gsz; u.g = 0; u.aux = 0; return true;
    }
};

template <class Epi, class Sched, bool ALIGN_EPI, bool SEG2 = false>
__device__ __forceinline__ void gemm_phase(LAS unsigned char* lds, const GemmDesc g, const unsigned (&voffA)[2], const unsigned (&voffB)[2], const Sched& S, Epi& E, int tid, unsigned long long* stp = nullptr, const unsigned* voffB2 = nullptr) {
    const int wid = __builtin_amdgcn_readfirstlane(tid >> 6), lane = tid & 63, wr = wid >> 2, wc = wid & 3, fr = lane & 15, fq = lane >> 4;
    const int nt = g.nt;
    const long kstepA = g.a_k, kstepB = g.b_k, hstepA = g.a_h, hstepB = g.b_h;
    const unsigned ldsw = (unsigned)wid * 1024u;
    const int aoff = lds_byte(wr * 64 + fr, fq * 8), boff = lds_byte(wc * 32 + fr, fq * 8);
#define PG8_SA(b, h) (((b) * 2 + (h)) * HTB)
#define PG8_SB(b, h) ((4 + (b) * 2 + (h)) * HTB)
#define PG8_STAGE(bufoff, gbase, voff) do { const char* _gb = (const char*)(gbase); asm volatile("" : "+s"(_gb));   _Pragma("unroll") for (int _i = 0; _i < 2; ++_i) \
        __builtin_amdgcn_global_load_lds((const unsigned*)(_gb + (voff)[_i]), (LAS unsigned*)(lds + (bufoff) + ldsw + _i * 8192), 16, 0, 0); } while (0)
#define PG8_LDA(dst, b, h) do { _Pragma("unroll") for (int m = 0; m < 4; ++m) _Pragma("unroll") for (int k = 0; k < 2; ++k) dst[m][k] = *(const LAS bf16x8*)(lds + PG8_SA(b, h) + aoff + m * 2048 + k * 1024); } while (0)
#define PG8_LDB(dst, b, h) do { _Pragma("unroll") for (int n = 0; n < 2; ++n) _Pragma("unroll") for (int k = 0; k < 2; ++k) dst[n][k] = *(const LAS bf16x8*)(lds + PG8_SB(b, h) + boff + n * 2048 + k * 1024); } while (0)
#define PG8_MMA(ai, bj, At, Bt) do { __builtin_amdgcn_s_setprio(1); _Pragma("unroll") for (int m = 0; m < 4; ++m) _Pragma("unroll") for (int n = 0; n < 2; ++n) _Pragma("unroll") for (int k = 0; k < 2; ++k) \
        acc[ai][bj][m][n] = __builtin_amdgcn_mfma_f32_16x16x32_bf16(Bt[n][k], At[m][k], acc[ai][bj][m][n], 0, 0, 0); __builtin_amdgcn_s_setprio(0); } while (0)
#define PG8_WAIT_V(n) asm volatile("s_waitcnt vmcnt(" #n ")" ::: "memory")
#define PG8_WAIT_L(n) asm volatile("s_waitcnt lgkmcnt(" #n ")" ::: "memory")
#define PG8_BAR __builtin_amdgcn_s_barrier()
#define PG8_SCHED __builtin_amdgcn_sched_barrier(0)
    Unit cur, nxt; int ui = 0;
    if (!S.next(0, cur)) return;
    f32x4 acc[2][2][4][2];
#pragma unroll
    for (int a = 0; a < 2; ++a)
#pragma unroll
        for (int b = 0; b < 2; ++b)
#pragma unroll
            for (int m = 0; m < 4; ++m)
#pragma unroll
                for (int n = 0; n < 2; ++n) acc[a][b][m][n] = (f32x4){0.f, 0.f, 0.f, 0.f};
    bf16x8 At[4][2], B0[2][2], B1[2][2];
    const char* cA = g.A + (long)cur.pm * g.a_pm + (long)cur.g * g.a_g; const char* cB = g.B + (long)cur.pn * g.b_pn + (long)cur.g * g.b_g;
    const char* cB2 = SEG2 ? g.B2 + (long)cur.pn * g.b2_pn + (long)cur.g * g.b2_g : nullptr;
    PG8_STAGE(PG8_SB(0, 0), cB, voffB); PG8_STAGE(PG8_SB(0, 1), cB + hstepB, voffB); PG8_STAGE(PG8_SA(0, 0), cA, voffA); PG8_STAGE(PG8_SA(0, 1), cA + hstepA, voffA);
    if (wr == 1) PG8_BAR;
    PG8_WAIT_V(2); PG8_BAR;
    PG8_STAGE(PG8_SB(1, 0), cB + kstepB, voffB); PG8_STAGE(PG8_SA(1, 0), cA + kstepA, voffA); PG8_STAGE(PG8_SB(1, 1), cB + hstepB + kstepB, voffB);
    PG8_WAIT_V(6); PG8_BAR;
    unsigned long long st_t0 = stp ? __builtin_amdgcn_s_memrealtime() : 0ull, st_loop = 0ull, st_epi = 0ull;
    for (;;) {
        const bool has_next = S.next(ui + 1, nxt);
        const char* nA = has_next ? g.A + (long)nxt.pm * g.a_pm + (long)nxt.g * g.a_g : cA; const char* nB = has_next ? g.B + (long)nxt.pn * g.b_pn + (long)nxt.g * g.b_g : cB;
        for (int t = 0; t < nt; t += 2) {
            const bool last = (t == nt - 2);
            const char* a1 = cA + (long)(t + 1) * kstepA;
            const bool sg = SEG2 && !last && (t + 2 >= g.tsw);
            const char* a2 = last ? nA : cA + (long)(t + 2) * kstepA; const char* b2 = last ? nB : (sg ? cB2 + (long)(t + 2 - g.tsw) * g.b2_k : cB + (long)(t + 2) * kstepB);
            const char* a3 = a2 + kstepA; const char* b3 = b2 + (sg ? g.b2_k : kstepB);
            const long hB = sg ? g.b2_h : hstepB;
            unsigned vbs[2]; vbs[0] = sg ? voffB2[0] : voffB[0]; vbs[1] = sg ? voffB2[1] : voffB[1];
            PG8_LDB(B0, 0, 0); PG8_LDB(B1, 0, 1); PG8_SCHED; PG8_LDA(At, 0, 0); PG8_STAGE(PG8_SA(1, 1), a1 + hstepA, voffA);
            PG8_WAIT_V(8); PG8_WAIT_L(0); PG8_BAR; PG8_MMA(0, 0, At, B0); PG8_MMA(0, 1, At, B1); PG8_BAR; PG8_SCHED;
            PG8_LDA(At, 0, 1); PG8_STAGE(PG8_SB(0, 0), b2, vbs); PG8_STAGE(PG8_SB(0, 1), b2 + hB, vbs); PG8_STAGE(PG8_SA(0, 0), a2, voffA);
            PG8_WAIT_V(8); PG8_WAIT_L(0); PG8_BAR; PG8_MMA(1, 0, At, B0); PG8_MMA(1, 1, At, B1); PG8_BAR; PG8_SCHED;
            PG8_LDB(B0, 1, 0); PG8_LDB(B1, 1, 1); PG8_SCHED; PG8_LDA(At, 1, 0); PG8_STAGE(PG8_SA(0, 1), a2 + hstepA, voffA);
            PG8_WAIT_V(8); PG8_WAIT_L(0); PG8_BAR; PG8_MMA(0, 0, At, B0); PG8_MMA(0, 1, At, B1); PG8_BAR; PG8_SCHED;
            PG8_LDA(At, 1, 1); PG8_STAGE(PG8_SB(1, 0), b3, vbs); PG8_STAGE(PG8_SB(1, 1), b3 + hB, vbs); PG8_STAGE(PG8_SA(1, 0), a3, voffA);
            PG8_WAIT_V(8); PG8_WAIT_L(0); PG8_BAR; PG8_MMA(1, 0, At, B0); PG8_MMA(1, 1, At, B1); PG8_BAR; PG8_SCHED;
            if constexpr (Epi::HAS_MID) { if (t + 2 == Epi::MID_T) E.mid(acc, wr, fr); }
        }
        if (stp) { const unsigned long long t1 = __builtin_amdgcn_s_memrealtime(); st_loop += t1 - st_t0; st_t0 = t1; }
        if constexpr (ALIGN_EPI) { if (wr == 0) PG8_BAR; }
        if constexpr (!Epi::AFTER_DRAIN) { E(acc, cur, wr, wc, fr, fq); }
        if (stp) { const unsigned long long t1 = __builtin_amdgcn_s_memrealtime(); st_epi += t1 - st_t0; st_t0 = t1; }
        if (!has_next) break;
#pragma unroll
        for (int a = 0; a < 2; ++a)
#pragma unroll
            for (int b = 0; b < 2; ++b)
#pragma unroll
                for (int m = 0; m < 4; ++m)
#pragma unroll
                    for (int n = 0; n < 2; ++n) acc[a][b][m][n] = (f32x4){0.f, 0.f, 0.f, 0.f};
        cur = nxt; cA = nA; cB = nB; ++ui; if constexpr (SEG2) cB2 = g.B2 + (long)cur.pn * g.b2_pn + (long)cur.g * g.b2_g;
        if constexpr (ALIGN_EPI) { if (wr == 1) PG8_BAR; }
    }
    PG8_WAIT_V(0);
    if constexpr (!ALIGN_EPI) { if (wr == 0) PG8_BAR; }
    PG8_BAR;
    if (stp) { const unsigned long long t1 = __builtin_amdgcn_s_memrealtime(); st_loop += t1 - st_t0; st_t0 = t1; }
    if constexpr (Epi::AFTER_DRAIN) { E.fused(acc, cur, wr, wc, fr, fq, lds, wid, lane); }
    if (stp) { const unsigned long long t1 = __builtin_amdgcn_s_memrealtime(); st_epi += t1 - st_t0; if (tid == 0) { stp[0] = st_loop; stp[1] = st_epi; } }
#undef PG8_SA
#undef PG8_SB
#undef PG8_STAGE
#undef PG8_LDA
#undef PG8_LDB
#undef PG8_MMA
#undef PG8_WAIT_V
#undef PG8_WAIT_L
#undef PG8_BAR
#undef PG8_SCHED
}

__device__ __forceinline__ void voff_std(unsigned (&v)[2], int ld, bool perm, int tid) {
#pragma unroll
    for (int i = 0; i < 2; ++i) { int R, C; stage_rc(tid * 16 + i * 8192, R, C); const int Rb = perm ? ((R & ~31) + perm32(R & 31)) : R; v[i] = (unsigned)(Rb * ld + C) * 2u; }
}

typedef f32x4 Acc[2][2][4][2];

struct EpiU {
    static constexpr bool PERM = true, AFTER_DRAIN = false, HAS_MID = false; static constexpr int MID_T = 0;
    const float* r0; bf16_t* upool; bf16_t* ussm;
    __device__ __forceinline__ void operator()(Acc& acc, const Unit& u, int wr, int wc, int fr, int fq) const {
#pragma unroll
        for (int ai = 0; ai < 2; ++ai)
#pragma unroll
            for (int m = 0; m < 4; ++m) {
                const int row = u.pm * BM + ai * HALF + wr * 64 + m * 16 + fr; const float rs = r0[row];
#pragma unroll
                for (int bj = 0; bj < 2; ++bj) {
                    const int c8 = u.pn * BM + bj * HALF + wc * 32 + 8 * fq;
                    const u32x4 w = pack8(acc[ai][bj][m][0] * rs, acc[ai][bj][m][1] * rs);
                    if (u.pn < 2) *(u32x4*)(upool + (size_t)row * DPOOL + c8) = w;
                    else { const int cs = c8 - DPOOL, gg = cs >> 4, h0 = cs & 15, cr = row / TCH, p = row % TCH;
                           *(u32x4*)(ussm + ((size_t)(gg * NCR + cr) * ROWLEN + 16 * p + h0)) = w; }
                }
            }
    }
};
struct cf { float r, i; };
__device__ __forceinline__ cf cmul(cf a, cf b) { return cf{a.r * b.r - a.i * b.i, a.r * b.i + a.i * b.r}; }
__device__ __forceinline__ cf cmad(cf a, cf b, cf c) { return cf{a.r * b.r - a.i * b.i + c.r, a.r * b.i + a.i * b.r + c.i}; }
template <int CTRL> __device__ __forceinline__ float dppz(float v) { return __builtin_bit_cast(float, __builtin_amdgcn_update_dpp(0, __builtin_bit_cast(int, v), CTRL, 0xf, 0xf, true)); }
template <int CTRL> __device__ __forceinline__ cf cdpp(cf v) { return cf{dppz<CTRL>(v.r), dppz<CTRL>(v.i)}; }
struct EpiScan {
    static constexpr bool PERM = false, AFTER_DRAIN = true, HAS_MID = false; static constexpr int MID_T = 0;
    const float* lamT; bf16_t* ussm;
    __device__ __forceinline__ void fused(Acc& acc, const Unit& u, int wr, int wc, int fr, int fq, LAS unsigned char* lds, int wid, int lane) const {
        LAS float* SEG = (LAS float*)lds;
        cf X[2][2][2][2];
        LAS unsigned char* CIM = lds + 8192;
#pragma unroll
        for (int bj = 0; bj < 2; ++bj)
#pragma unroll
            for (int np = 0; np < 2; ++np) {
                const int n0 = 16 * wc + 8 * np + 2 * fq;
                const f32x4 l4 = *(const f32x4*)(lamT + ((size_t)(bj * NG + u.g) * NS + n0) * 2);
#pragma unroll
                for (int e = 0; e < 2; ++e) {
                    const cf lam{l4[2 * e], l4[2 * e + 1]};
                    const cf l2 = cmul(lam, lam), M1 = cmul(l2, l2), M2 = cmul(M1, M1), M4 = cmul(M2, M2), M8 = cmul(M4, M4);
#pragma unroll
                    for (int ai = 0; ai < 2; ++ai) {
                        cf T;
                        if (bj == 0) { T = cf{acc[ai][bj][0][np][2 * e], acc[ai][bj][0][np][2 * e + 1]};
#pragma unroll
                            for (int m = 1; m < 4; ++m) T = cmad(lam, T, cf{acc[ai][bj][m][np][2 * e], acc[ai][bj][m][np][2 * e + 1]});
                            T = cmad(M1, cdpp<0x111>(T), T); T = cmad(M2, cdpp<0x112>(T), T); T = cmad(M4, cdpp<0x114>(T), T); T = cmad(M8, cdpp<0x118>(T), T);
                            X[bj][ai][np][e] = cdpp<0x111>(T);
                            if (fr == 15) *(LAS f32x2*)(SEG + ((bj * 4 + 2 * ai + wr) * 64 + n0 + e) * 2) = (f32x2){T.r, T.i};
                        } else {       T = cf{acc[ai][bj][3][np][2 * e], acc[ai][bj][3][np][2 * e + 1]};
#pragma unroll
                            for (int m = 2; m >= 0; --m) T = cmad(lam, T, cf{acc[ai][bj][m][np][2 * e], acc[ai][bj][m][np][2 * e + 1]});
                            T = cmad(M1, cdpp<0x101>(T), T); T = cmad(M2, cdpp<0x102>(T), T); T = cmad(M4, cdpp<0x104>(T), T); T = cmad(M8, cdpp<0x108>(T), T);
                            X[bj][ai][np][e] = cdpp<0x101>(T);
                            if (fr == 0) *(LAS f32x2*)(SEG + ((bj * 4 + 2 * ai + wr) * 64 + n0 + e) * 2) = (f32x2){T.r, T.i};
                        }
                    }
                }
            }
        LDS_WAIT(); __builtin_amdgcn_s_barrier(); asm volatile("" ::: "memory");
#pragma unroll
        for (int bj = 0; bj < 2; ++bj)
#pragma unroll
            for (int np = 0; np < 2; ++np) {
                const int n0 = 16 * wc + 8 * np + 2 * fq;
                const f32x4 l4 = *(const f32x4*)(lamT + ((size_t)(bj * NG + u.g) * NS + n0) * 2);
                cf C[2][4][2];
#pragma unroll
                for (int e = 0; e < 2; ++e) {
                    const cf lam{l4[2 * e], l4[2 * e + 1]};
                    const cf l2 = cmul(lam, lam), M1 = cmul(l2, l2), M2 = cmul(M1, M1), M4 = cmul(M2, M2), M8 = cmul(M4, M4), Q = cmul(M8, M8);
                    const int ex = bj == 0 ? fr : 15 - fr;
                    cf Mx{1.f, 0.f};
                    if (ex & 1) Mx = cmul(Mx, M1); if (ex & 2) Mx = cmul(Mx, M2); if (ex & 4) Mx = cmul(Mx, M4); if (ex & 8) Mx = cmul(Mx, M8);
#pragma unroll
                    for (int ai = 0; ai < 2; ++ai) {
                        const int sg = 2 * ai + wr; cf G{0.f, 0.f};
                        if (bj == 0) {
#pragma unroll
                            for (int sp = 0; sp < 3; ++sp) if (sp < sg) { const f32x2 t = *(const LAS f32x2*)(SEG + ((bj * 4 + sp) * 64 + n0 + e) * 2); G = cmad(Q, G, cf{t.x, t.y}); }
                            cf c = cmad(Mx, G, X[bj][ai][np][e]); C[ai][0][e] = c;
#pragma unroll
                            for (int m = 1; m < 4; ++m) { c = cmad(lam, c, cf{acc[ai][bj][m - 1][np][2 * e], acc[ai][bj][m - 1][np][2 * e + 1]}); C[ai][m][e] = c; }
                        } else {
#pragma unroll
                            for (int sp = 3; sp > 0; --sp) if (sp > sg) { const f32x2 t = *(const LAS f32x2*)(SEG + ((bj * 4 + sp) * 64 + n0 + e) * 2); G = cmad(Q, G, cf{t.x, t.y}); }
                            cf c = cmad(Mx, G, X[bj][ai][np][e]); C[ai][3][e] = c;
#pragma unroll
                            for (int m = 2; m >= 0; --m) { c = cmad(lam, c, cf{acc[ai][bj][m + 1][np][2 * e], acc[ai][bj][m + 1][np][2 * e + 1]}); C[ai][m][e] = c; }
                        }
                    }
                }
#pragma unroll
                for (int ai = 0; ai < 2; ++ai)
#pragma unroll
                    for (int m = 0; m < 4; ++m) { const int c = 128 * ai + 64 * wr + 4 * fr + m;
                        u32x2 w; w.x = cvt_pk_bf16(C[ai][m][0].r, C[ai][m][0].i); w.y = cvt_pk_bf16(C[ai][m][1].r, C[ai][m][1].i);
                        *(LAS u32x2*)(CIM + c * 520 + (bj * 128 + 2 * n0) * 2) = w; }
            }
        LDS_WAIT(); __builtin_amdgcn_s_barrier(); asm volatile("" ::: "memory");
#pragma unroll 8
        for (int r = wid; r < 256; r += 8)
            *(u32x2*)(ussm + ((size_t)(u.g * NCR + u.pm * NCHB + r) * ROWLEN + K1) + 4 * lane) = *(const LAS u32x2*)(CIM + r * 520 + 8 * lane);
    }
};
struct EpiZ {
    static constexpr bool PERM = true, AFTER_DRAIN = false, HAS_MID = false; static constexpr int MID_T = 0;
    const bf16_t* ussm; const float* dvec; bf16_t* zg;
    __device__ __forceinline__ void operator()(Acc& acc, const Unit& u, int wr, int wc, int fr, int fq) const {
#pragma unroll
        for (int bj = 0; bj < 2; ++bj) {
            const int c8 = u.pn * BM + bj * HALF + wc * 32 + 8 * fq;
            const f32x4 d0 = *(const f32x4*)(dvec + u.g * 16 + (c8 & 15)), d1 = *(const f32x4*)(dvec + u.g * 16 + (c8 & 15) + 4);
#pragma unroll
            for (int ai = 0; ai < 2; ++ai)
#pragma unroll
                for (int m = 0; m < 4; ++m) {
                    const int cr = u.pm * BM + ai * HALF + wr * 64 + m * 16 + fr;
                    const u32x4 uw = *(const u32x4*)(ussm + ((size_t)(u.g * NCR + cr) * ROWLEN + c8));
                    f32x4 u0, u1; unpack8(uw, u0, u1);
                    f32x4 y0 = acc[ai][bj][m][0] + d0 * u0, y1 = acc[ai][bj][m][1] + d1 * u1;
#pragma unroll
                    for (int i = 0; i < 4; ++i) { y0[i] = fast_gelu_tanh(y0[i]); y1[i] = fast_gelu_tanh(y1[i]); }
                    *(u32x4*)(zg + ((size_t)u.g * MT * 16 + (size_t)cr * K1 + c8)) = pack8(y0, y1);
                }
        }
    }
};
struct EpiPool {
    static constexpr bool PERM = true, AFTER_DRAIN = false, HAS_MID = false; static constexpr int MID_T = 0;
    const float* pscale; bf16_t* ycat; float* ss;
    __device__ __forceinline__ void operator()(Acc& acc, const Unit& u, int wr, int wc, int fr, int fq) const {
        f32x4 sc[2][2];
#pragma unroll
        for (int bj = 0; bj < 2; ++bj) { const int c8 = u.pn * BM + bj * HALF + wc * 32 + 8 * fq; sc[bj][0] = *(const f32x4*)(pscale + c8); sc[bj][1] = *(const f32x4*)(pscale + c8 + 4); }
#pragma unroll
        for (int ai = 0; ai < 2; ++ai)
#pragma unroll
            for (int m = 0; m < 4; ++m) {
                const int row = u.pm * BM + ai * HALF + wr * 64 + m * 16 + fr; float q = 0.f;
#pragma unroll
                for (int bj = 0; bj < 2; ++bj) {
                    const int c8 = u.pn * BM + bj * HALF + wc * 32 + 8 * fq;
                    const f32x4 v0 = acc[ai][bj][m][0] * sc[bj][0], v1 = acc[ai][bj][m][1] * sc[bj][1];
                    q += (v0[0] * v0[0] + v0[1] * v0[1]) + (v0[2] * v0[2] + v0[3] * v0[3]) + (v1[0] * v1[0] + v1[1] * v1[1]) + (v1[2] * v1[2] + v1[3] * v1[3]);
                    *(u32x4*)(ycat + (size_t)row * DM + c8) = pack8(v0, v1);
                }
                q += __shfl_xor(q, 16); q += __shfl_xor(q, 32);
                if (fq == 0) ss[(size_t)(u.pn * 4 + wc) * MT + row] = q;
            }
    }
};
struct EpiGlu {
    static constexpr bool PERM = true, AFTER_DRAIN = false, HAS_MID = false; static constexpr int MID_T = 0;
    const float* gb; const bf16_t* zg; bf16_t* ycat; float* ss;
    __device__ __forceinline__ void operator()(Acc& acc, const Unit& u, int wr, int wc, int fr, int fq) const {
        f32x4 bv[2][2];
#pragma unroll
        for (int bj = 0; bj < 2; ++bj) { const int c8 = u.pn * BM + bj * HALF + wc * 32 + 8 * fq; bv[bj][0] = *(const f32x4*)(gb + c8); bv[bj][1] = *(const f32x4*)(gb + c8 + 4); }
#pragma unroll
        for (int ai = 0; ai < 2; ++ai)
#pragma unroll
            for (int m = 0; m < 4; ++m) {
                const int row = u.pm * BM + ai * HALF + wr * 64 + m * 16 + fr; float q = 0.f;
#pragma unroll
                for (int bj = 0; bj < 2; ++bj) {
                    const int c8 = u.pn * BM + bj * HALF + wc * 32 + 8 * fq;
                    const u32x4 zw = *(const u32x4*)(zg + ((size_t)(c8 >> 4) * MT + row) * 16 + (c8 & 15));
                    f32x4 z0, z1; unpack8(zw, z0, z1);
                    f32x4 v0 = acc[ai][bj][m][0] + bv[bj][0], v1 = acc[ai][bj][m][1] + bv[bj][1];
#pragma unroll
                    for (int i = 0; i < 4; ++i) { v0[i] = z0[i] * fast_sigmoid(v0[i]); v1[i] = z1[i] * fast_sigmoid(v1[i]); }
                    q += (v0[0] * v0[0] + v0[1] * v0[1]) + (v0[2] * v0[2] + v0[3] * v0[3]) + (v1[0] * v1[0] + v1[1] * v1[1]) + (v1[2] * v1[2] + v1[3] * v1[3]);
                    *(u32x4*)(ycat + (size_t)row * DM + DPOOL + c8) = pack8(v0, v1);
                }
                q += __shfl_xor(q, 16); q += __shfl_xor(q, 32);
                if (fq == 0) ss[(size_t)(u.pn * 4 + wc) * MT + row] = q;
            }
    }
};
struct EpiOut {
    static constexpr bool PERM = true, AFTER_DRAIN = true, HAS_MID = true; static constexpr int MID_T = 8;
    const bf16_t* xb; bf16_t* h1b; float* ss; LAS f32x2* XR; float ratio[2][4];
    __device__ __forceinline__ void mid(Acc& acc, int wr, int fr) const {
#pragma unroll
        for (int ai = 0; ai < 2; ++ai)
#pragma unroll
            for (int m = 0; m < 4; ++m) { const float ratio = this->ratio[ai][m];
#pragma unroll
                for (int bj = 0; bj < 2; ++bj)
#pragma unroll
                    for (int n = 0; n < 2; ++n) acc[ai][bj][m][n] = acc[ai][bj][m][n] * ratio; }
    }
    __device__ __forceinline__ void fused(Acc& acc, const Unit& u, int wr, int wc, int fr, int fq, LAS unsigned char* lds, int wid, int lane) const {
        LAS float* P = (LAS float*)lds;
        const int col0 = u.pn * BM + wc * 32 + 8 * fq;
#pragma unroll
        for (int ai = 0; ai < 2; ++ai)
#pragma unroll
            for (int m = 0; m < 4; ++m) {
                const int lr = ai * HALF + wr * 64 + m * 16 + fr, row = u.pm * BM + lr; const float rs = XR[lr].y; float q = 0.f;
                const size_t prow = (size_t)(row >> 12) * PADROWS + 1 + (row & 4095);
#pragma unroll
                for (int bj = 0; bj < 2; ++bj) {
                    const int c = col0 + bj * HALF;
                    f32x4 x0, x1; unpack8(*(const u32x4*)(xb + (size_t)row * DM + c), x0, x1);
                    const f32x4 h0 = x0 + acc[ai][bj][m][0] * rs, h1v = x1 + acc[ai][bj][m][1] * rs;
                    q += (h0[0] * h0[0] + h0[1] * h0[1]) + (h0[2] * h0[2] + h0[3] * h0[3]) + (h1v[0] * h1v[0] + h1v[1] * h1v[1]) + (h1v[2] * h1v[2] + h1v[3] * h1v[3]);
                    *(u32x4*)(h1b + prow * DM + c) = pack8(h0, h1v);
                }
                q += __shfl_xor(q, 16); q += __shfl_xor(q, 32);
                if (fq == 0) P[lr * 4 + wc] = q;
            }
        LDS_WAIT(); __builtin_amdgcn_s_barrier(); asm volatile("" ::: "memory");
        const int tid = wid * 64 + lane;
        if (tid < 256) ss[(size_t)u.pn * MT + u.pm * BM + tid] = (P[tid * 4 + 0] + P[tid * 4 + 1]) + (P[tid * 4 + 2] + P[tid * 4 + 3]);
    }
};
struct EpiUp {
    static constexpr bool PERM = true, AFTER_DRAIN = false, HAS_MID = false; static constexpr int MID_T = 0;
    const LAS float* rsl; const float* cw; const float* cb; bf16_t* act;
    __device__ __forceinline__ void operator()(Acc& acc, const Unit& u, int wr, int wc, int fr, int fq) const {
        const int j = u.pm, b = u.g;
#pragma unroll
        for (int ai = 0; ai < 2; ++ai)
#pragma unroll
            for (int m = 0; m < 4; ++m) {
                const float rs = rsl[u.aux * 256 + 126 * wr + 64 * ai + 4 * fr + m];
#pragma unroll
                for (int bj = 0; bj < 2; ++bj)
#pragma unroll
                    for (int n = 0; n < 2; ++n) acc[ai][bj][m][n] = acc[ai][bj][m][n] * rs;
            }
        const int f0 = 128 * u.pn + 32 * wc + 8 * fq;
        u32x2 keep[8];
#pragma unroll
        for (int n = 0; n < 2; ++n) {
            const int fc = f0 + 4 * n;
            const f32x4 wv0 = *(const f32x4*)(cw + fc), wv1 = *(const f32x4*)(cw + DFF2 + fc), wv2 = *(const f32x4*)(cw + 2 * DFF2 + fc), bvv = *(const f32x4*)(cb + fc);
            const f32x4 wg0 = *(const f32x4*)(cw + DFF + fc), wg1 = *(const f32x4*)(cw + DFF2 + DFF + fc), wg2 = *(const f32x4*)(cw + 2 * DFF2 + DFF + fc), bgv = *(const f32x4*)(cb + DFF + fc);
#pragma unroll
            for (int ai = 0; ai < 2; ++ai) {
                f32x4 pv, pg, nv, ng;
#pragma unroll
                for (int i = 0; i < 4; ++i) {
                    pv[i] = dpp_ror1(fr == 15 ? acc[ai ^ 1][0][3][n][i] : acc[ai][0][3][n][i]); pg[i] = dpp_ror1(fr == 15 ? acc[ai ^ 1][1][3][n][i] : acc[ai][1][3][n][i]);
                    nv[i] = dpp_ror15(fr == 0 ? acc[ai ^ 1][0][0][n][i] : acc[ai][0][0][n][i]); ng[i] = dpp_ror15(fr == 0 ? acc[ai ^ 1][1][0][n][i] : acc[ai][1][0][n][i]);
                }
#pragma unroll
                for (int m = 0; m < 4; ++m) {
                    const f32x4 cv = acc[ai][0][m][n], cg = acc[ai][1][m][n];
                    const f32x4 v_prev = m > 0 ? acc[ai][0][m - 1][n] : pv, g_prev = m > 0 ? acc[ai][1][m - 1][n] : pg;
                    const f32x4 v_next = m < 3 ? acc[ai][0][m + 1][n] : nv, g_next = m < 3 ? acc[ai][1][m + 1][n] : ng;
                    f32x4 o;
#pragma unroll
                    for (int i = 0; i < 4; ++i) {
                        const float vv = bvv[i] + wv0[i] * v_prev[i] + wv1[i] * cv[i] + wv2[i] * v_next[i];
                        const float gg = bgv[i] + wg0[i] * g_prev[i] + wg1[i] * cg[i] + wg2[i] * g_next[i];
                        o[i] = vv * gg * fast_sigmoid(gg);
                    }
                    const u32x2 pk = pack4(o); const int gi = ai * 4 + m;
                    if (n == 0) keep[gi] = pk;
                    else { const int w = 64 * ai + 4 * fr + m, t = UPROWS * j + 126 * wr + w - 1;
                           if (t >= 0 && t < SEQ && w >= 1 && w <= 126) { u32x4 wv; wv.x = keep[gi].x; wv.y = keep[gi].y; wv.z = pk.x; wv.w = pk.y; *(u32x4*)(act + (size_t)(b * SEQ + t) * DFF + f0) = wv; } }
                }
            }
        }
    }
};
struct EpiDown {
    static constexpr bool PERM = true, AFTER_DRAIN = true, HAS_MID = false; static constexpr int MID_T = 0;
    const bf16_t* h1b; float* out; const float* gfin; float* ss; const XcdBarrier* bar;
    __device__ __forceinline__ void fused(Acc& acc, const Unit& u, int wr, int wc, int fr, int fq, LAS unsigned char* lds, int wid, int lane) const {
        LAS float* P = (LAS float*)lds;
        LAS float* Sr = (LAS float*)(lds + 8192);
        const int col0 = u.pn * BM + wc * 32 + 8 * fq;
#pragma unroll
        for (int ai = 0; ai < 2; ++ai)
#pragma unroll
            for (int m = 0; m < 4; ++m) {
                const int lr = ai * HALF + wr * 64 + m * 16 + fr, row = u.pm * BM + lr; float q = 0.f;
                const size_t prow = (size_t)(row >> 12) * PADROWS + 1 + (row & 4095);
#pragma unroll
                for (int bj = 0; bj < 2; ++bj) {
                    f32x4 b0, b1; unpack8(*(const u32x4*)(h1b + prow * DM + col0 + bj * HALF), b0, b1);
                    const f32x4 h0 = b0 + acc[ai][bj][m][0], h1v = b1 + acc[ai][bj][m][1];
                    acc[ai][bj][m][0] = h0; acc[ai][bj][m][1] = h1v;
                    q += (h0[0] * h0[0] + h0[1] * h0[1]) + (h0[2] * h0[2] + h0[3] * h0[3]) + (h1v[0] * h1v[0] + h1v[1] * h1v[1]) + (h1v[2] * h1v[2] + h1v[3] * h1v[3]);
                }
                q += __shfl_xor(q, 16); q += __shfl_xor(q, 32);
                if (fq == 0) P[lr * 4 + wc] = q;
            }
        LDS_WAIT(); __builtin_amdgcn_s_barrier(); asm volatile("" ::: "memory");
        const int tid = wid * 64 + lane;
        if (tid < 256) ss[(size_t)u.pn * MT + u.pm * BM + tid] = (P[tid * 4 + 0] + P[tid * 4 + 1]) + (P[tid * 4 + 2] + P[tid * 4 + 3]);
        xcd_barrier(*bar, tid);
        if (tid < 256) { const int row = u.pm * BM + tid; const float s = (ss[row] + ss[MT + row]) + (ss[2 * MT + row] + ss[3 * MT + row]); Sr[tid] = rsqrtf(s * (1.0f / DM) + EPS); }
        LDS_WAIT(); __builtin_amdgcn_s_barrier(); asm volatile("" ::: "memory");
#pragma unroll
        for (int bj = 0; bj < 2; ++bj) {
            const int c = col0 + bj * HALF; const f32x4 g0 = *(const f32x4*)(gfin + c), g1 = *(const f32x4*)(gfin + c + 4);
#pragma unroll
            for (int ai = 0; ai < 2; ++ai)
#pragma unroll
                for (int m = 0; m < 4; ++m) { const int lr = ai * HALF + wr * 64 + m * 16 + fr; const float r = Sr[lr]; float* o = out + (size_t)(u.pm * BM + lr) * DM + c;
                    *(f32x4*)o = acc[ai][bj][m][0] * r * g0; *(f32x4*)(o + 4) = acc[ai][bj][m][1] * r * g1; }
        }
    }
};

struct OrdOne { Unit u; __device__ bool next(int i, Unit& o) const { if (i > 0) return false; o = u; return true; } };
struct OrdSsmB { int c; __device__ bool next(int i, Unit& u) const { if (i > 0 || c >= 128) return false; const int x = c & 7, k = c >> 3; u.g = x * 4 + (k >> 2); u.pm = k & 3; u.pn = 0; u.aux = 0; return true; } };
struct OrdPool { int c; __device__ bool next(int i, Unit& u) const { if (i > 0 || c < 128 || c >= 256) return false; const int cc = c - 128, x = cc & 7, k = cc >> 3; u.pm = x * 8 + (k >> 1); u.pn = k & 1; u.g = u.pn; u.aux = 0; return true; } };
struct OrdGlu  { int c; __device__ bool next(int i, Unit& u) const { if (i > 0 || c >= 128) return false; const int x = c & 7, k = c >> 3; u.pm = x * 8 + (k >> 1); u.pn = k & 1; u.g = 0; u.aux = 0; return true; } };
struct OrdUp { StaticOrder so; __device__ bool next(int i, Unit& u) const { if (!so.next(i, u)) return false; u.g = u.pm / UPT; u.pm = u.pm % UPT; u.aux = i; return true; } };

struct Args { const float* in[24]; float* out; unsigned char* ws; int ph_lo, ph_hi; };

struct Frame { LAS unsigned char* lds; int tid, lane, wave, G, bx; };

struct TrMat { const float* W; int K, N; const float* kg0; const float* kg1; int ksplit; bf16_t* WT; int map; int nitems; };
__device__ __forceinline__ void tr_load(const TrMat& m0, const TrMat& m1, int item, int lane, f32x4 (&v)[8]) {
    const bool second = item >= m0.nitems; const TrMat& m = second ? m1 : m0; const int it = second ? item - m0.nitems : item;
    const int nblk = m.N / 32, kb = it / nblk, nb = it % nblk, k0 = 64 * kb, n0 = 32 * nb, r = lane >> 3, c4 = lane & 7;
#pragma unroll
    for (int i = 0; i < 8; ++i) v[i] = *(const f32x4*)(m.W + (size_t)(k0 + 8 * i + r) * m.N + n0 + 4 * c4);
}
__device__ __forceinline__ void tr_store(const TrMat& m0, const TrMat& m1, int item, int lane, const f32x4 (&v)[8], LAS float* scr) {
    const bool second = item >= m0.nitems; const TrMat& m = second ? m1 : m0; const int it = second ? item - m0.nitems : item;
    const int nblk = m.N / 32, kb = it / nblk, nb = it % nblk, k0 = 64 * kb, n0 = 32 * nb, r = lane >> 3, c4 = lane & 7;
#pragma unroll
    for (int i = 0; i < 8; ++i) { const int kk = 8 * i + r, k = k0 + kk; float gn = 1.f; if (m.kg0) gn = (k < m.ksplit ? m.kg0[k] : m.kg1[k - m.ksplit]);
        LAS float* d = scr + kk * 33 + 4 * c4; d[0] = v[i][0] * gn; d[1] = v[i][1] * gn; d[2] = v[i][2] * gn; d[3] = v[i][3] * gn; }
    LDS_WAIT(); asm volatile("" ::: "memory");
    const int c = lane & 7;
#pragma unroll
    for (int j = 0; j < 4; ++j) { const int n = (lane >> 3) + 8 * j; const LAS float* q = scr + (8 * c) * 33 + n;
        u32x4 o; o.x = pk2(q[0 * 33], q[1 * 33]); o.y = pk2(q[2 * 33], q[3 * 33]); o.z = pk2(q[4 * 33], q[5 * 33]); o.w = pk2(q[6 * 33], q[7 * 33]);
        int nr = n0 + n;
        if (m.map == 1) { const int bj = nr / DFF, rem = nr % DFF; nr = 256 * (rem >> 7) + 128 * bj + (rem & 127); }
        *(u32x4*)(m.WT + (size_t)nr * m.K + k0 + 8 * c) = o; }
    LDS_WAIT(); asm volatile("" ::: "memory");
}
__device__ __forceinline__ void tr_run(const TrMat& m0, const TrMat& m1, int first, int stride, int lane, LAS float* scr) {
    const int total = m0.nitems + m1.nitems; f32x4 va[8], vb[8];
    int it = first; if (it < total) tr_load(m0, m1, it, lane, va);
    while (it < total) {
        const int n1 = it + stride; if (n1 < total) tr_load(m0, m1, n1, lane, vb);
        tr_store(m0, m1, it, lane, va, scr);
        if (n1 >= total) break;
        const int n2 = n1 + stride; if (n2 < total) tr_load(m0, m1, n2, lane, va);
        tr_store(m0, m1, n1, lane, vb, scr);
        it = n2;
    }
}

struct SsmLds { LAS float* Bre; LAS float* Bim; LAS float* Cre; LAS float* Cim; LAS float* PAR; LAS float* Pc; LAS float* Kl; };
__device__ __forceinline__ SsmLds ssm_lds(const Frame& F) { SsmLds L; L.Bre = (LAS float*)(F.lds); L.Bim = L.Bre + 2048; L.Cre = L.Bim + 2048; L.Cim = L.Cre + 2048; L.PAR = L.Cim + 2048; L.Pc = L.PAR + 512; L.Kl = L.Pc + 1024; return L; }
__device__ __forceinline__ void ssm_stage(const Args& a, const Frame& F, const SsmLds& L, int g) {
    const float* lnar = a.in[5]; const float* aim = a.in[6]; const float* ldt = a.in[7];
    const float* bre = a.in[8]; const float* bim = a.in[9]; const float* cre = a.in[10]; const float* cim = a.in[11];
    const int tid = F.tid;
    for (int i = tid; i < 2048; i += 512) { const int dir = i >> 10, r = i & 1023;
        L.Bre[i] = bre[((size_t)(dir * NG + g)) * 1024 + r]; L.Bim[i] = bim[((size_t)(dir * NG + g)) * 1024 + r];
        L.Cre[i] = cre[((size_t)(dir * NG + g)) * 1024 + r]; L.Cim[i] = cim[((size_t)(dir * NG + g)) * 1024 + r]; }
    if (tid < 128) { const int dir = tid >> 6, n = tid & 63;
        const float dt = expf(ldt[dir * NG + g]); const float a_re = -expf(lnar[(dir * NG + g) * NS + n]), a_im = aim[(dir * NG + g) * NS + n];
        const float mag = expf(a_re * dt), ang = a_im * dt; const float lam_re = mag * cosf(ang), lam_im = mag * sinf(ang);
        const float den = a_re * a_re + a_im * a_im;
        L.PAR[tid * 4 + 0] = a_re * dt; L.PAR[tid * 4 + 1] = ang;
        L.PAR[tid * 4 + 2] = ((lam_re - 1.0f) * a_re + lam_im * a_im) / den; L.PAR[tid * 4 + 3] = (lam_im * a_re - (lam_re - 1.0f) * a_im) / den; }
    __syncthreads();
}
__device__ __forceinline__ void ssm_build_tb(const Args& a, const Frame& F, const SsmLds& L, int g, int lag0, int nl) {
    bf16_t* KC = (bf16_t*)(a.ws + WS_TB) + (size_t)g * (2 * TCH) * 256;
    bf16_t* TBC = (bf16_t*)(a.ws + WS_TBC) + (size_t)g * K1 * 256;
    const int tid = F.tid;
    { const int li = tid >> 7, dn = tid & 127, lag = lag0 + li; const float ad = L.PAR[dn * 4 + 0], ang = L.PAR[dn * 4 + 1], fr_ = L.PAR[dn * 4 + 2], fi_ = L.PAR[dn * 4 + 3];
      const float mg = expf((float)lag * ad); float sn, cs; sincosf((float)lag * ang, &sn, &cs); const float lr = mg * cs, lim = mg * sn;
      L.Pc[(li * 128 + dn) * 2 + 0] = lr * fr_ - lim * fi_; L.Pc[(li * 128 + dn) * 2 + 1] = lr * fi_ + lim * fr_; }
    __syncthreads();
    { const int li = F.wave >> 1, dir = F.wave & 1, i16 = F.lane & 15, kq = F.lane >> 4; f32x4 kacc = {0.f, 0.f, 0.f, 0.f};
#pragma unroll 8
      for (int kk0 = 0; kk0 < 128; kk0 += 4) { const int kk = kk0 + kq, n = kk >> 1; const bool im = (kk & 1) != 0;
          const float cr_ = L.Cre[dir * 1024 + i16 * 64 + n], ci_ = L.Cim[dir * 1024 + i16 * 64 + n], pr = L.Pc[(li * 128 + dir * 64 + n) * 2], pi = L.Pc[(li * 128 + dir * 64 + n) * 2 + 1];
          const float av = im ? -(cr_ * pi + ci_ * pr) : (cr_ * pr - ci_ * pi);
          const float bv = im ? L.Bim[dir * 1024 + n * 16 + i16] : L.Bre[dir * 1024 + n * 16 + i16];
          kacc = __builtin_amdgcn_mfma_f32_16x16x4f32(av, bv, kacc, 0, 0, 0); }
#pragma unroll
      for (int r = 0; r < 4; ++r) L.Kl[li * 512 + dir * 256 + (kq * 4 + r) * 16 + i16] = kacc[r]; }
    __syncthreads();
    { const int li = tid >> 7, dir = (tid >> 6) & 1, e4 = tid & 63, lag = lag0 + li;
      if (li < nl && !(lag == 0 && dir == 1)) {
          f32x4 v = *(const LAS f32x4*)(L.Kl + li * 512 + dir * 256 + 4 * e4);
          if (lag == 0) v = v + *(const LAS f32x4*)(L.Kl + li * 512 + 256 + 4 * e4);
          const int d = dir == 0 ? (TCH - 1) + lag : (TCH - 1) - lag; u32x2 w; w.x = pk2(v[0], v[1]); w.y = pk2(v[2], v[3]);
          *(u32x2*)(KC + (size_t)d * 256 + 4 * e4) = w; } }
    __syncthreads();
    { const int li = tid >> 7, dn = tid & 127, dir = dn >> 6, p = lag0 + li; const float ad = L.PAR[dn * 4 + 0], ang = L.PAR[dn * 4 + 1]; const float e = dir == 0 ? (float)(p + 1) : (float)(TCH - p);
      const float mg = expf(e * ad); float sn, cs; sincosf(e * ang, &sn, &cs); L.Pc[(li * 128 + dn) * 2 + 0] = mg * cs; L.Pc[(li * 128 + dn) * 2 + 1] = mg * sn; }
    __syncthreads();
    for (int li = 0; li < nl; ++li) {
        const int p = lag0 + li, h = tid >> 5, dir = (tid >> 4) & 1, n4 = tid & 15; float v[8];
#pragma unroll
        for (int e = 0; e < 4; ++e) { const int n = 4 * n4 + e; const float cr_ = L.Cre[dir * 1024 + h * 64 + n], ci_ = L.Cim[dir * 1024 + h * 64 + n], pr = L.Pc[(li * 128 + dir * 64 + n) * 2], pi = L.Pc[(li * 128 + dir * 64 + n) * 2 + 1];
            v[2 * e] = cr_ * pr - ci_ * pi; v[2 * e + 1] = -(cr_ * pi + ci_ * pr); }
        u32x4 w; w.x = pk2(v[0], v[1]); w.y = pk2(v[2], v[3]); w.z = pk2(v[4], v[5]); w.w = pk2(v[6], v[7]);
        *(u32x4*)(TBC + (size_t)(16 * p + h) * 256 + dir * 128 + 8 * n4) = w;
    }
    __syncthreads();
}
__device__ __forceinline__ void ssm_build_wab(const Args& a, const Frame& F, const SsmLds& L, int g, int jq) {
    bf16_t* WAB = (bf16_t*)(a.ws + WS_WAB) + (size_t)g * 256 * K1;
    const int tid = F.tid;
    if (jq == 0 && tid < 128) { const int dir = tid >> 6, n = tid & 63; const float ad = L.PAR[tid * 4 + 0], ang = L.PAR[tid * 4 + 1];
        const float mg = expf((float)TCH * ad); float sn, cs; sincosf((float)TCH * ang, &sn, &cs); *(f32x2*)((float*)(a.ws + WS_LAMT) + ((size_t)(dir * NG + g) * NS + n) * 2) = (f32x2){mg * cs, mg * sn}; }
    { const int li = tid >> 7, dn = tid & 127, dir = dn >> 6, q = 4 * jq + li; const float ad = L.PAR[dn * 4 + 0], ang = L.PAR[dn * 4 + 1], fr_ = L.PAR[dn * 4 + 2], fi_ = L.PAR[dn * 4 + 3]; const float e = dir == 0 ? (float)(TCH - 1 - q) : (float)q;
      const float mg = expf(e * ad); float sn, cs; sincosf(e * ang, &sn, &cs); const float lr = mg * cs, lim = mg * sn;
      L.Pc[(li * 128 + dn) * 2 + 0] = lr * fr_ - lim * fi_; L.Pc[(li * 128 + dn) * 2 + 1] = lr * fi_ + lim * fr_; }
    __syncthreads();
#pragma unroll
    for (int half = 0; half < 2; ++half) {
        const int li = 2 * half + (tid >> 8), q = 4 * jq + li, t2 = tid & 255, dir = t2 >> 7, n = (t2 >> 1) & 63, part = t2 & 1;
        const float pr = L.Pc[(li * 128 + dir * 64 + n) * 2], pi = L.Pc[(li * 128 + dir * 64 + n) * 2 + 1]; float v[16];
#pragma unroll
        for (int i = 0; i < 16; ++i) { const float br_ = L.Bre[dir * 1024 + n * 16 + i], bi_ = L.Bim[dir * 1024 + n * 16 + i]; v[i] = part == 0 ? (pr * br_ - pi * bi_) : (pr * bi_ + pi * br_); }
        u32x4 w0, w1; w0.x = pk2(v[0], v[1]); w0.y = pk2(v[2], v[3]); w0.z = pk2(v[4], v[5]); w0.w = pk2(v[6], v[7]); w1.x = pk2(v[8], v[9]); w1.y = pk2(v[10], v[11]); w1.z = pk2(v[12], v[13]); w1.w = pk2(v[14], v[15]);
        bf16_t* dst = WAB + (size_t)(dir * 128 + 2 * n + part) * K1 + 16 * q; *(u32x4*)dst = w0; *(u32x4*)(dst + 8) = w1;
    }
    __syncthreads();
}

__device__ __forceinline__ void p0_prologue(const Args& a, const Frame& F) {
    const float* x = a.in[0];
    { const SsmLds L = ssm_lds(F);
      for (int it = F.bx; it < NG * (TCH / 4); it += F.G) { ssm_stage(a, F, L, it / (TCH / 4)); ssm_build_wab(a, F, L, it / (TCH / 4), it % (TCH / 4)); } }
    __syncthreads();
    LAS float* scr = (LAS float*)(F.lds + F.wave * 16384);
    const int gw = F.bx * 8 + F.wave, NGW = F.G * 8;
    { const TrMat m0{a.in[2], DM, DM, a.in[1], a.in[1], DM, (bf16_t*)(a.ws + WS_WIN), 0, (DM / 64) * (DM / 32)}; const TrMat m1{nullptr, 0, 32, nullptr, nullptr, 0, nullptr, 0, 0};
      tr_run(m0, m1, gw, NGW, F.lane, scr); }
    { bf16_t* PW = (bf16_t*)(a.ws + WS_PW); const float* pw = a.in[3];
      for (int idx = F.bx * 512 + F.tid; idx < 2 * 256 * 256; idx += F.G * 512) { const int pn = idx >> 16, j = (idx >> 8) & 255, k = idx & 255;
          const float v = ((j >> 7) == (k >> 7)) ? pw[((size_t)(2 * pn + (j >> 7)) * 128 + (k & 127)) * 128 + (j & 127)] : 0.f; PW[idx] = (bf16_t)f2bf(v); } }
    { bf16_t* h1b = (bf16_t*)(a.ws + WS_H1B);
      for (int idx = F.bx * 512 + F.tid; idx < BATCH * 256 * (DM / 8); idx += F.G * 512) { const int b = idx / (256 * 128), r = (idx / 128) % 256, c = idx % 128; const int prow = b * PADROWS + (r == 0 ? 0 : 4096 + r);
          *(u32x4*)(h1b + (size_t)prow * DM + 8 * c) = (u32x4){0u, 0u, 0u, 0u}; } }
    { bf16_t* xb = (bf16_t*)(a.ws + WS_XB); float* r0 = (float*)(a.ws + WS_R0);
      for (int row = gw; row < MT; row += NGW) {
          const f32x4* xr = (const f32x4*)(x + (size_t)row * DM) + F.lane; f32x4 v[4]; float s = 0.f;
#pragma unroll
          for (int j = 0; j < 4; ++j) { v[j] = xr[64 * j]; s += (v[j][0] * v[j][0] + v[j][1] * v[j][1]) + (v[j][2] * v[j][2] + v[j][3] * v[j][3]); }
          s = wave_sum(s); if (F.lane == 0) r0[row] = rsqrtf(s * (1.0f / DM) + EPS);
          u32x2* o = (u32x2*)(xb + (size_t)row * DM) + F.lane;
#pragma unroll
          for (int j = 0; j < 4; ++j) o[64 * j] = pack4(v[j]);
      } }
}

__device__ __forceinline__ void ssm_side(const Args& a, const Frame& F, int first_block) {
    const int nb = F.G - first_block, sb = F.bx - first_block;
    { const SsmLds L = ssm_lds(F);
      const int g = sb >> 2, lag0 = (sb & 3) * 4;
      ssm_stage(a, F, L, g); ssm_build_tb(a, F, L, g, lag0, 4);
      VM_WAIT(); __syncthreads();
      if (F.tid == 0) { __builtin_amdgcn_fence(__ATOMIC_RELEASE, "agent"); asm volatile("s_waitcnt vmcnt(0)" ::: "memory");
          __hip_atomic_fetch_add((unsigned*)(a.ws + WS_CTL) + CW_TBCNT + 64 * g, 4u, __ATOMIC_RELAXED, __HIP_MEMORY_SCOPE_AGENT); } }
    __syncthreads();
    LAS float* scr = (LAS float*)(F.lds + F.wave * 16384);
    const TrMat m0{a.in[17], DM, DM, a.in[15], a.in[16], DPOOL, (bf16_t*)(a.ws + WS_WOUT), 0, (DM / 64) * (DM / 32)};
    const TrMat m1{a.in[13], DSSM, DSSM, nullptr, nullptr, 0, (bf16_t*)(a.ws + WS_WGLU), 0, (DSSM / 64) * (DSSM / 32)};
    tr_run(m0, m1, sb * 8 + F.wave, nb * 8, F.lane, scr);
    const TrMat m2{a.in[22], DFF, DM, nullptr, nullptr, 0, (bf16_t*)(a.ws + WS_WDOWN), 0, (DFF / 64) * (DM / 32)}; const TrMat m3{nullptr, 0, 32, nullptr, nullptr, 0, nullptr, 0, 0};
    tr_run(m2, m3, sb * 8 + F.wave, nb * 8, F.lane, scr);
}
__device__ __forceinline__ void tb_wait(const Args& a, const Frame& F, int g) {
    if (F.tid == 0) { unsigned* cnt = (unsigned*)(a.ws + WS_CTL) + CW_TBCNT + 64 * g; unsigned sp = 0;
        while (__hip_atomic_load(cnt, __ATOMIC_RELAXED, __HIP_MEMORY_SCOPE_AGENT) < (unsigned)TCH) { __builtin_amdgcn_s_sleep(2); if (++sp > (1u << 20)) break; }
        __builtin_amdgcn_fence(__ATOMIC_ACQUIRE, "agent"); asm volatile("s_waitcnt vmcnt(0)" ::: "memory"); }
    __syncthreads();
}
__device__ __forceinline__ void p4_side(const Args& a, const Frame& F, int first_block) {
    const int nb = F.G - first_block, sb = F.bx - first_block;
    LAS float* scr = (LAS float*)(F.lds + F.wave * 16384);
    const TrMat m0{a.in[19], DM, DFF2, a.in[18], a.in[18], DM, (bf16_t*)(a.ws + WS_WUP), 1, (DM / 64) * (DFF2 / 32)};
    const TrMat m1{nullptr, 0, 32, nullptr, nullptr, 0, nullptr, 0, 0};
    tr_run(m0, m1, sb * 8 + F.wave, nb * 8, F.lane, scr);
}

__device__ __forceinline__ void p2_pooled(const Args& a, const Frame& F, int first_block) {
    const bf16_t* up = (const bf16_t*)(a.ws + WS_UPOOL); bf16_t* po = (bf16_t*)(a.ws + WS_POOLED);
    const int gw = (F.bx - first_block) * 8 + F.wave, NGW = (F.G - first_block) * 8;
    const int c0 = 8 * F.lane, half = 1 << (F.lane >> 4);
    for (int blk = gw; blk < MT / 4; blk += NGW) {
        const int row0 = blk * 4, b = row0 / SEQ, t0 = row0 % SEQ;
        u32x4 w[19];
#pragma unroll
        for (int o = 0; o < 19; ++o) { int q = t0 + o - 8; q = q < 0 ? 0 : (q >= SEQ ? SEQ - 1 : q); w[o] = *(const u32x4*)(up + (size_t)(b * SEQ + q) * DPOOL + c0); }
#pragma unroll
        for (int r = 0; r < 4; ++r) {
            f32x4 s0 = {0.f, 0.f, 0.f, 0.f}, s1 = {0.f, 0.f, 0.f, 0.f}; float cnt = 0.f;
#pragma unroll
            for (int d = -8; d < 8; ++d) { const int q = t0 + r + d; const float m = (d >= -half && d < half && q >= 0 && q < SEQ) ? 1.f : 0.f; f32x4 a0, a1; unpack8(w[r + d + 8], a0, a1); s0 = s0 + a0 * m; s1 = s1 + a1 * m; cnt += m; }
            f32x4 c0v, c1v; unpack8(w[r + 8], c0v, c1v);
            const float inv = __builtin_amdgcn_rcpf(cnt);
            *(u32x4*)(po + (size_t)(row0 + r) * DPOOL + c0) = pack8(s0 * inv - c0v, s1 * inv - c1v);
        }
    }
}

__global__ void __launch_bounds__(512, 2) mk_fwd(Args args) {
    extern __shared__ __attribute__((aligned(16))) unsigned char lds_raw[];
    Frame F; F.lds = (LAS unsigned char*)lds_raw; F.tid = threadIdx.x; F.lane = F.tid & 63; F.wave = __builtin_amdgcn_readfirstlane(F.tid >> 6); F.G = gridDim.x; F.bx = blockIdx.x;
    volatile LAS unsigned* MISC = (volatile LAS unsigned*)(F.lds + LDSCTL_OFF);
    for (int u = F.tid; u < (LDS_BYTES - LDSCTL_OFF) / 4; u += 512) ((LAS unsigned*)(F.lds + LDSCTL_OFF))[u] = 0u;
    __syncthreads();
    unsigned char* ws = args.ws;
    XcdBarrier bar = xcd_barrier_post((unsigned*)(ws + WS_CTL), MISC + 8);
    const int lo = args.ph_lo, hi = args.ph_hi;
#define IN(k) (lo <= (k) && (k) < hi)
#define BOTH(k) (IN(k) && IN((k) == 2 ? 4 : (k) + 1))
    if (IN(0)) { p0_prologue(args, F); if (BOTH(0)) xcd_barrier(bar, F.tid); }
    if (IN(1)) { F.lane = lane_id_fresh(); F.tid = F.wave * 64 + F.lane;
        GemmDesc g{(const char*)(ws + WS_XB), (const char*)(ws + WS_WIN), 256L * DM * 2, 0, 256L * DM * 2, 0, 128L * DM * 2, 128L * DM * 2, 128, 128, DM / BK};
        unsigned vA[2], vB[2]; voff_std(vA, DM, false, F.tid); voff_std(vB, DM, true, F.tid);
        StaticOrder S; S.init(MT / BM, DM / BM, F.G, F.bx);
        EpiU E{(const float*)(ws + WS_R0), (bf16_t*)(ws + WS_UPOOL), (bf16_t*)(ws + WS_USSM)};
        gemm_phase<EpiU, StaticOrder, true>(F.lds, g, vA, vB, S, E, F.tid, nullptr);
        if (BOTH(1)) xcd_barrier(bar, F.tid);
    }
    if (IN(2)) { F.lane = lane_id_fresh(); F.tid = F.wave * 64 + F.lane;
        if (F.bx < 128) {
            OrdSsmB S0{F.bx}; Unit u0; S0.next(0, u0);
            { GemmDesc g{(const char*)(ws + WS_USSM), (const char*)(ws + WS_WAB), 256L * ROWLEN * 2, (long)NCR * ROWLEN * 2, 0, 256L * K1 * 2, 128L * ROWLEN * 2, 128L * K1 * 2, 128, 128, K1 / BK};
              unsigned vA[2], vB[2]; voff_std(vB, K1, false, F.tid);
#pragma unroll
              for (int i = 0; i < 2; ++i) { int R, C; stage_rc(F.tid * 16 + i * 8192, R, C);
                  vA[i] = (unsigned)(((64 * (R >> 6) + 4 * (R & 15) + ((R >> 4) & 3)) * ROWLEN + C) * 2); }
              OrdOne S{u0}; EpiScan E{(const float*)(ws + WS_LAMT), (bf16_t*)(ws + WS_USSM)};
              gemm_phase<EpiScan, OrdOne, false>(F.lds, g, vA, vB, S, E, F.tid, nullptr); }
            VM_WAIT(); __syncthreads();
            tb_wait(args, F, u0.g);
            F.lane = lane_id_fresh(); F.tid = F.wave * 64 + F.lane;
            { GemmDesc g{(const char*)(ws + WS_USSM), (const char*)(ws + WS_TB), 256L * ROWLEN * 2, (long)NCR * ROWLEN * 2, 0, (2L * TCH) * 512, 128L * ROWLEN * 2, 8L * 512, 128, -4L * 512, ROWLEN / BK,
                         (const char*)(ws + WS_TBC), 0, (long)K1 * 512, 128L * 512, 128, K1 / BK};
              unsigned vA[2], vB[2], vB2[2]; voff_std(vA, ROWLEN, false, F.tid); voff_std(vB2, 256, true, F.tid);
#pragma unroll
              for (int i = 0; i < 2; ++i) { int R, C; stage_rc(F.tid * 16 + i * 8192, R, C); const int Rb = (R & ~31) + perm32(R & 31);
                  vB[i] = (unsigned)((((Rb >> 4) - (C >> 4) + (TCH - 1)) * 256 + (Rb & 15) * 16 + (C & 15)) * 2); }
              asm volatile("" : "+v"(vA[0]), "+v"(vA[1]), "+v"(vB[0]), "+v"(vB[1]), "+v"(vB2[0]), "+v"(vB2[1]));
              OrdOne S{u0}; EpiZ E{(const bf16_t*)(ws + WS_USSM), args.in[12], (bf16_t*)(ws + WS_ZG)};
              gemm_phase<EpiZ, OrdOne, true, true>(F.lds, g, vA, vB, S, E, F.tid, nullptr, vB2); }
        } else { ssm_side(args, F, 128); p2_pooled(args, F, 128); }
        if (BOTH(2)) xcd_barrier(bar, F.tid);
    }
    if (IN(4)) { F.lane = lane_id_fresh(); F.tid = F.wave * 64 + F.lane;
        if (F.bx < 128) {
            constexpr long GSTR = (long)MT * 32;
            GemmDesc g{(const char*)(ws + WS_ZG), (const char*)(ws + WS_WGLU), 256L * 32, 0, 256L * DSSM * 2, 0, 128L * 32, 128L * DSSM * 2, 4 * GSTR, 128, DSSM / BK};
            unsigned vA[2], vB[2]; voff_std(vB, DSSM, true, F.tid);
#pragma unroll
            for (int i = 0; i < 2; ++i) { int R, C; stage_rc(F.tid * 16 + i * 8192, R, C); vA[i] = (unsigned)(R * 32 + (C >> 4) * (int)GSTR + (C & 15) * 2); }
            OrdGlu S{F.bx}; EpiGlu E{args.in[14], (const bf16_t*)(ws + WS_ZG), (bf16_t*)(ws + WS_YCAT), (float*)(ws + WS_SSSSM)};
            gemm_phase<EpiGlu, OrdGlu, true>(F.lds, g, vA, vB, S, E, F.tid, nullptr);
        } else {
            GemmDesc g{(const char*)(ws + WS_POOLED), (const char*)(ws + WS_PW), 256L * DPOOL * 2, 256L * 2, 256L * 256 * 2, 0, 128L * DPOOL * 2, 128L * 256 * 2, 128, 128, 256 / BK};
            unsigned vA[2], vB[2]; voff_std(vA, DPOOL, false, F.tid); voff_std(vB, 256, true, F.tid);
            OrdPool S{F.bx}; EpiPool E{args.in[4], (bf16_t*)(ws + WS_YCAT), (float*)(ws + WS_SSPOOL)};
            gemm_phase<EpiPool, OrdPool, true>(F.lds, g, vA, vB, S, E, F.tid, nullptr);

            __syncthreads();
            p4_side(args, F, 128);
        }
        if (BOTH(4)) xcd_barrier(bar, F.tid);
    }
    if (IN(5)) { F.lane = lane_id_fresh(); F.tid = F.wave * 64 + F.lane;
        StaticOrder S; S.init(MT / BM, DM / BM, F.G, F.bx); Unit u0;
        LAS f32x2* XR = (LAS f32x2*)(F.lds + XTRA_OFF);
        if (S.next(0, u0)) {
            if (F.tid < 256) { const int row = u0.pm * BM + F.tid; const float* sp = (const float*)(ws + WS_SSPOOL); const float* sm = (const float*)(ws + WS_SSSSM); float a0 = 0.f, a1 = 0.f;
#pragma unroll
                for (int s = 0; s < 8; ++s) { a0 += sp[(size_t)s * MT + row]; a1 += sm[(size_t)s * MT + row]; }
                const float rp = rsqrtf(a0 * (1.0f / DPOOL) + EPS), rsm = rsqrtf(a1 * (1.0f / DSSM) + EPS); XR[F.tid] = (f32x2){rp / rsm, rsm}; }
        }
        __syncthreads();
        GemmDesc g{(const char*)(ws + WS_YCAT), (const char*)(ws + WS_WOUT), 256L * DM * 2, 0, 256L * DM * 2, 0, 128L * DM * 2, 128L * DM * 2, 128, 128, DM / BK};
        unsigned vA[2], vB[2]; voff_std(vA, DM, false, F.tid); voff_std(vB, DM, true, F.tid);
        EpiOut E{(const bf16_t*)(ws + WS_XB), (bf16_t*)(ws + WS_H1B), (float*)(ws + WS_SSH1), XR, {{0.f, 0.f, 0.f, 0.f}, {0.f, 0.f, 0.f, 0.f}}};
        { const int wr_ = F.wave >> 2, fr_ = F.lane & 15;
#pragma unroll
          for (int ai = 0; ai < 2; ++ai)
#pragma unroll
              for (int m = 0; m < 4; ++m) E.ratio[ai][m] = XR[ai * HALF + wr_ * 64 + m * 16 + fr_].x; }
        gemm_phase<EpiOut, StaticOrder, false>(F.lds, g, vA, vB, S, E, F.tid, nullptr);
        if (BOTH(5)) xcd_barrier(bar, F.tid);
    }
    if (IN(6)) { F.lane = lane_id_fresh(); F.tid = F.wave * 64 + F.lane;
        GemmDesc g{(const char*)(ws + WS_H1B), (const char*)(ws + WS_WUP), (long)UPROWS * DM * 2, (long)PADROWS * DM * 2, 256L * DM * 2, 0, 64L * DM * 2, 128L * DM * 2, 128, 128, DM / BK};
        unsigned vA[2], vB[2]; voff_std(vB, DM, true, F.tid);
#pragma unroll
        for (int i = 0; i < 2; ++i) { int R, C; stage_rc(F.tid * 16 + i * 8192, R, C); vA[i] = (unsigned)(((126 * (R >> 6) + 4 * (R & 15) + ((R >> 4) & 3)) * DM + C) * 2); }
        OrdUp S; S.so.init(BATCH * UPT, DFF2 / BM, F.G, F.bx);
        LAS float* RSL = (LAS float*)(F.lds + XTRA_OFF);
        if (F.tid < 256) { const float* ssh1 = (const float*)(ws + WS_SSH1);
#pragma unroll
            for (int i = 0; i < 6; ++i) { Unit uu; if (S.next(i, uu)) { const int t = UPROWS * uu.pm + F.tid - 1; const bool in = (t >= 0 && t < SEQ && F.tid < 254); const int tok = uu.g * SEQ + (in ? t : 0);
                const float sq = (ssh1[tok] + ssh1[MT + tok]) + (ssh1[2 * MT + tok] + ssh1[3 * MT + tok]); RSL[i * 256 + F.tid] = in ? rsqrtf(sq * (1.0f / DM) + EPS) : 0.f; } } }
        __syncthreads();
        EpiUp E{RSL, args.in[20], args.in[21], (bf16_t*)(ws + WS_ACT)};
        gemm_phase<EpiUp, OrdUp, true>(F.lds, g, vA, vB, S, E, F.tid, nullptr);
        if (BOTH(6)) xcd_barrier(bar, F.tid);
    }
    if (IN(7)) { F.lane = lane_id_fresh(); F.tid = F.wave * 64 + F.lane;
        GemmDesc g{(const char*)(ws + WS_ACT), (const char*)(ws + WS_WDOWN), 256L * DFF * 2, 0, 256L * DFF * 2, 0, 128L * DFF * 2, 128L * DFF * 2, 128, 128, DFF / BK};
        unsigned vA[2], vB[2]; voff_std(vA, DFF, false, F.tid); voff_std(vB, DFF, true, F.tid);
        StaticOrder S; S.init(MT / BM, DM / BM, F.G, F.bx);
        EpiDown E{(const bf16_t*)(ws + WS_H1B), args.out, args.in[23], (float*)(ws + WS_SSH2), &bar};
        gemm_phase<EpiDown, StaticOrder, false>(F.lds, g, vA, vB, S, E, F.tid, nullptr);
    }
#undef IN
#undef BOTH
}
}

extern "C" void kernel_launch(void* const* d_in, const int* in_sizes, int n_in, void* d_out, int out_size, void* d_ws, size_t ws_size, hipStream_t stream) {
    static int grid = 0;
    if (grid == 0) {
        int dev = 0, cus = 0, per_cu = 0;
        if (n_in != 24 || out_size != MT * DM || ws_size < mk::WS_END) { fprintf(stderr, "kernel_launch: unexpected problem (n_in %d out %d ws %zu)\n", n_in, out_size, ws_size); grid = -1; return; }
        if (hipGetDevice(&dev) != hipSuccess || hipDeviceGetAttribute(&cus, hipDeviceAttributeMultiprocessorCount, dev) != hipSuccess) { grid = -1; return; }
        if (hipFuncSetAttribute((const void*)mk::mk_fwd, hipFuncAttributeMaxDynamicSharedMemorySize, mk::LDS_BYTES) != hipSuccess) { fprintf(stderr, "kernel_launch: hipFuncSetAttribute failed\n"); grid = -1; return; }
        if (hipOccupancyMaxActiveBlocksPerMultiprocessor(&per_cu, (const void*)mk::mk_fwd, 512, mk::LDS_BYTES) != hipSuccess || per_cu < 1) { fprintf(stderr, "kernel_launch: occupancy query says %d blocks/CU; nothing launched\n", per_cu); (void)hipGetLastError(); grid = -1; return; }
        grid = cus;
        if (grid != 256) { fprintf(stderr, "kernel_launch: built for a 256-CU device, found %d CUs\n", cus); grid = -1; return; }
    }
    if (grid < 0) return;
    (void)in_sizes;
    (void)hipMemsetAsync((char*)d_ws + mk::WS_CTL, 0, mk::CTL_ZERO_BYTES, stream);
    mk::Args a{};
    for (int i = 0; i < 24; ++i) a.in[i] = (const float*)d_in[i];
    a.out = (float*)d_out; a.ws = (unsigned char*)d_ws; a.ph_lo = 0; a.ph_hi = 8;
    hipLaunchKernelGGL(mk::mk_fwd, dim3(grid), dim3(512), mk::LDS_BYTES, stream, a);
}
```

```cpp
#include <hip/hip_runtime.h>
#include <math.h>

constexpr int BATCH = 4, SEQ = 4096, DM = 1024, MT = BATCH * SEQ;
constexpr int DPOOL = 512, DSSM = 512, NG = 32, NH = 16, NS = 64;
constexpr int DFF = 2816, DFF2 = 5632;
constexpr float EPS = 1e-6f;

#include <cstdio>
#include <cstdint>
#define LAS __attribute__((address_space(3)))
#define GAS __attribute__((address_space(1)))
typedef unsigned short bf16_t;
typedef short bf16x8 __attribute__((ext_vector_type(8)));
typedef float f32x4 __attribute__((ext_vector_type(4)));
typedef float f32x2 __attribute__((ext_vector_type(2)));
typedef unsigned u32x4 __attribute__((ext_vector_type(4)));
typedef unsigned u32x2 __attribute__((ext_vector_type(2)));

namespace mk {
constexpr int TCH = 16;
constexpr int K1 = 16 * TCH;
constexpr int ROWLEN = K1 + 256;
constexpr int NCR = MT / TCH;
constexpr int NCHB = SEQ / TCH;
constexpr int PADROWS = 4352;
constexpr int UPT = 17;
constexpr int UPROWS = 252;

constexpr size_t MiB = 1u << 20;
constexpr size_t WS_CTL = 0, CTL_ZERO_BYTES = 64 * 1024;
constexpr int CW_TBCNT = 4096;
constexpr size_t WS_R0 = 1 * MiB;
constexpr size_t WS_SSPOOL = 2 * MiB;
constexpr size_t WS_SSSSM = WS_SSPOOL + 8 * MT * 4;
constexpr size_t WS_SSH1 = WS_SSSSM + 8 * MT * 4;
constexpr size_t WS_SSH2 = WS_SSH1 + 4 * MT * 4;
constexpr size_t WS_LAMT = 6 * MiB;
constexpr size_t WS_WIN = 8 * MiB, WS_WOUT = 10 * MiB, WS_WGLU = 12 * MiB, WS_PW = 12 * MiB + 512 * 1024;
constexpr size_t WS_WUP = 13 * MiB, WS_WDOWN = 24 * MiB;
constexpr size_t WS_WAB = 30 * MiB;
constexpr size_t WS_TB = 38 * MiB;
constexpr size_t WS_TBC = 40 * MiB;
constexpr size_t WS_H1B = 62 * MiB;
constexpr size_t WS_XB = 96 * MiB;
constexpr size_t WS_YCAT = 128 * MiB;
constexpr size_t WS_UPOOL = 128 * MiB;
constexpr size_t WS_USSM = 144 * MiB;
constexpr size_t WS_POOLED = 208 * MiB;
constexpr size_t WS_ZG = 224 * MiB;
constexpr size_t WS_ACT = 96 * MiB;
constexpr size_t WS_END = 240 * MiB;

constexpr int RING_BYTES = 131072, XTRA_OFF = RING_BYTES, XTRA_BYTES = 16384, LDSCTL_OFF = XTRA_OFF + XTRA_BYTES, LDS_BYTES = 151552;

__device__ __forceinline__ unsigned f2bf(float f) { unsigned u = __builtin_bit_cast(unsigned, f); return (u + 0x7fffu + ((u >> 16) & 1u)) >> 16; }
__device__ __forceinline__ unsigned pk2(float lo, float hi) { return f2bf(lo) | (f2bf(hi) << 16); }
__device__ __forceinline__ unsigned cvt_pk_bf16(float lo, float hi) { unsigned r; asm volatile("v_cvt_pk_bf16_f32 %0, %1, %2" : "=v"(r) : "v"(lo), "v"(hi)); return r; }
__device__ __forceinline__ u32x4 pack8(f32x4 a, f32x4 b) { u32x4 w; w.x = cvt_pk_bf16(a[0], a[1]); w.y = cvt_pk_bf16(a[2], a[3]); w.z = cvt_pk_bf16(b[0], b[1]); w.w = cvt_pk_bf16(b[2], b[3]); return w; }
__device__ __forceinline__ u32x2 pack4(f32x4 a) { u32x2 w; w.x = cvt_pk_bf16(a[0], a[1]); w.y = cvt_pk_bf16(a[2], a[3]); return w; }
__device__ __forceinline__ float bflo(unsigned w) { return __builtin_bit_cast(float, w << 16); }
__device__ __forceinline__ float bfhi(unsigned w) { return __builtin_bit_cast(float, w & 0xffff0000u); }
__device__ __forceinline__ void unpack8(u32x4 w, f32x4& a, f32x4& b) { a[0] = bflo(w.x); a[1] = bfhi(w.x); a[2] = bflo(w.y); a[3] = bfhi(w.y); b[0] = bflo(w.z); b[1] = bfhi(w.z); b[2] = bflo(w.w); b[3] = bfhi(w.w); }
__device__ __forceinline__ float fast_sigmoid(float x) { return __builtin_amdgcn_rcpf(1.0f + __builtin_amdgcn_exp2f(-1.4426950408889634f * x)); }
__device__ __forceinline__ f32x4 fast_sigmoid4(f32x4 x) {
    const f32x4 t = x * -1.4426950408889634f; f32x4 e;
#pragma unroll
    for (int i = 0; i < 4; ++i) e[i] = __builtin_amdgcn_exp2f(t[i]);
    const f32x4 d = e + 1.0f; f32x4 r;
#pragma unroll
    for (int i = 0; i < 4; ++i) r[i] = __builtin_amdgcn_rcpf(d[i]);
    return r;
}
__device__ __forceinline__ float sumsq8(f32x4 a, f32x4 b) { const f32x4 s = a * a + b * b; return (s[0] + s[1]) + (s[2] + s[3]); }
__device__ __forceinline__ f32x4 fast_gelu_tanh4(f32x4 x) {
    constexpr float C = -2.0f * 0.7978845608028654f * 1.4426950408889634f;
    const f32x4 a = x * (x * x * (C * 0.044715f) + C); f32x4 e;
#pragma unroll
    for (int i = 0; i < 4; ++i) e[i] = __builtin_amdgcn_exp2f(a[i]);
    const f32x4 d = e + 1.0f; f32x4 r;
#pragma unroll
    for (int i = 0; i < 4; ++i) r[i] = __builtin_amdgcn_rcpf(d[i]);
    return x * r;
}
__device__ __forceinline__ float fast_gelu_tanh(float x) {
    const float t = x * (1.0f + 0.044715f * x * x);
    return x * __builtin_amdgcn_rcpf(1.0f + __builtin_amdgcn_exp2f(-2.0f * 0.7978845608028654f * 1.4426950408889634f * t));
}
__device__ __forceinline__ float wave_sum(float v) {
#pragma unroll
    for (int o = 1; o < 64; o <<= 1) v += __shfl_xor(v, o);
    return v;
}
__device__ __forceinline__ float dpp_ror1(float v)  { return __builtin_bit_cast(float, __builtin_amdgcn_update_dpp(0, __builtin_bit_cast(int, v), 0x121, 0xf, 0xf, false)); }
__device__ __forceinline__ float dpp_ror15(float v) { return __builtin_bit_cast(float, __builtin_amdgcn_update_dpp(0, __builtin_bit_cast(int, v), 0x12F, 0xf, 0xf, false)); }
__device__ __forceinline__ int lane_id_fresh() { int l; asm volatile("v_mbcnt_lo_u32_b32 %0, -1, 0\n\tv_mbcnt_hi_u32_b32 %0, -1, %0" : "=v"(l)); return l; }
#define LDS_WAIT() asm volatile("s_waitcnt lgkmcnt(0)" ::: "memory")
#define VM_WAIT() asm volatile("s_waitcnt vmcnt(0)" ::: "memory")
__device__ __forceinline__ void st_wt16(void* p, u32x4 v) { asm volatile("global_store_dwordx4 %0, %1, off sc1\n\ts_nop 1" :: "v"(p), "v"(v) : "memory"); }
__device__ __forceinline__ void st_wt8(void* p, u32x2 v)  { asm volatile("global_store_dwordx2 %0, %1, off sc1\n\ts_nop 1" :: "v"(p), "v"(v) : "memory"); }

#define XB_TMO      128
#define XB_XCNT(j)  (256  + 64 * (j))
#define XB_XSUB(j)  (1280 + 64 * (j))
#define XB_XGEN(j)  (2304 + 64 * (j))
#define XB_TOP      3328
#define XB_TOPGEN   3392
#define XCD_BAR_WORDS 3456
#define XB_SPIN_CAP (1u << 18)
__device__ __forceinline__ unsigned xb_ld(unsigned* p)              { return __hip_atomic_load(p, __ATOMIC_RELAXED, __HIP_MEMORY_SCOPE_AGENT); }
__device__ __forceinline__ unsigned xb_add(unsigned* p, unsigned v) { return __hip_atomic_fetch_add(p, v, __ATOMIC_RELAXED, __HIP_MEMORY_SCOPE_AGENT); }
__device__ __forceinline__ unsigned xb_xcc_id() { return (unsigned)__builtin_amdgcn_s_getreg((3 << 11) | 20) & 0xFu; }
#define XB_SPIN(cond, bar) do { unsigned _sp = 0; while (cond) { __builtin_amdgcn_s_sleep(1); \
    if ((++_sp & 255u) == 0u) { if (xb_ld(&(bar)[XB_TMO])) break; if (_sp > XB_SPIN_CAP) { atomicAdd(&(bar)[XB_TMO], 1u); break; } } } } while (0)
struct XcdBarrier { unsigned* bar; unsigned x; volatile LAS unsigned* st; };
__device__ __forceinline__ XcdBarrier xcd_barrier_post(unsigned* bar, volatile LAS unsigned* st) {
    XcdBarrier b; b.bar = bar; b.x = xb_xcc_id(); b.st = st;
    if (threadIdx.x == 0) (void)xb_add(&bar[XB_XCNT(b.x)], 1u);
    return b;
}
__device__ __forceinline__ void xcd_barrier_complete(unsigned* bar, unsigned x, unsigned& nloc, unsigned& nx) {
    const unsigned G = gridDim.x * gridDim.y * gridDim.z;
    unsigned sum, cnt, mine, sp = 0u;
    for (;;) {
        sum = 0u; cnt = 0u; mine = 0u;
#pragma unroll
        for (unsigned j = 0; j < 16; ++j) { const unsigned c = xb_ld(&bar[XB_XCNT(j)]); sum += c; cnt += (c > 0u) ? 1u : 0u; mine = (j == x) ? c : mine; }
        if (sum == G) break;
        __builtin_amdgcn_s_sleep(1);
        if ((++sp & 255u) == 0u) { if (xb_ld(&bar[XB_TMO])) break; if (sp > XB_SPIN_CAP) { atomicAdd(&bar[XB_TMO], 1u); break; } }
    }
    nloc = mine > 0u ? mine : 1u; nx = cnt > 0u ? cnt : 1u;
}
__device__ __forceinline__ void xcd_barrier(const XcdBarrier& b, int tid) {
    asm volatile("s_waitcnt vmcnt(0)" ::: "memory");
    __syncthreads();
    if (tid == 0) {
        unsigned* bar = b.bar;
        __builtin_amdgcn_s_waitcnt(0);
        unsigned nloc = b.st[0], nx = b.st[1];
        if (nloc == 0u) { xcd_barrier_complete(bar, b.x, nloc, nx); b.st[0] = nloc; b.st[1] = nx; }
        const unsigned old = xb_add(&bar[XB_XSUB(b.x)], 1u);
        const unsigned gen = old / nloc;
        if (old + 1u == (gen + 1u) * nloc) {
            __builtin_amdgcn_fence(__ATOMIC_RELEASE, "agent");
            asm volatile("s_waitcnt vmcnt(0)" ::: "memory");
            const unsigned og = xb_add(&bar[XB_TOP], 1u);
            const unsigned tg = og / nx;
            if (og + 1u == (tg + 1u) * nx) xb_add(&bar[XB_TOPGEN], 1u);
            else XB_SPIN(xb_ld(&bar[XB_TOPGEN]) == tg, bar);
            __builtin_amdgcn_fence(__ATOMIC_ACQUIRE, "agent");
            xb_add(&bar[XB_XGEN(b.x)], 1u);
            asm volatile("s_waitcnt vmcnt(0)" ::: "memory");
        } else {
            __builtin_amdgcn_fence(__ATOMIC_ACQUIRE, "agent");
            XB_SPIN(xb_ld(&bar[XB_XGEN(b.x)]) == gen, bar);
            asm volatile("s_waitcnt vmcnt(0)" ::: "memory");
        }
    }
    __syncthreads();
}

constexpr int BM = 256, BK = 64, HALF = 128, HTB = HALF * BK * 2, STAGE_BYTES = 8 * HTB, NXCD = 8, WGM = 8;
__host__ __device__ __forceinline__ int lds_byte(int r, int c) { const int st = (r >> 4) * 2 + (c >> 5), rr = r & 15, cc = c & 31, ob = rr * 64 + cc * 2; return st * 1024 + (ob ^ (((ob >> 9) & 1) << 5)); }
__host__ __device__ __forceinline__ void stage_rc(int b, int& R, int& C) { const int st = b / 1024, sb = b % 1024, swz = sb ^ (((sb >> 9) & 1) << 5); R = (st >> 1) * 16 + swz / 64; C = (st & 1) * 32 + (swz % 64) / 2; }
__host__ __device__ __forceinline__ int perm32(int rho) { const int n = rho >> 4, i = rho & 15; return 8 * (i >> 2) + 4 * n + (i & 3); }

struct Unit { int pm, pn, g, aux; };
struct GemmDesc { const char* A; const char* B; long a_pm, a_g, b_pn, b_g, a_h, b_h, a_k, b_k; int nt;
                  const char* B2; long b2_pn, b2_g, b2_h, b2_k; int tsw; };

struct StaticOrder {
    int nM, nN, nwg, G, c;
    __device__ void init(int nM_, int nN_, int G_, int c_) { nM = nM_; nN = nN_; nwg = nM * nN; G = G_; c = c_; }
    __device__ bool next(int i, Unit& u) const {
        const long L = (long)i * G + c; if (L >= nwg) return false;
        int wgid = (int)L; { const int q = nwg / NXCD, r = nwg % NXCD, xcd = wgid % NXCD, off = wgid / NXCD; wgid = (xcd < r ? xcd * (q + 1) : r * (q + 1) + (xcd - r) * q) + off; }
        const int nig = WGM * nN, gid = wgid / nig, fm = gid * WGM, gsz = (nM - fm) < WGM ? (nM - fm) : WGM;
        u.pm = fm + ((wgid % nig) % gsz); u.pn = (wgid % nig) / gsz; u.g = 0; u.aux = 0; return true;
    }
};

template <class Epi, class Sched, bool ALIGN_EPI, bool SEG2 = false>
__device__ __forceinline__ void gemm_phase(LAS unsigned char* lds, const GemmDesc g, const unsigned (&voffA)[2], const unsigned (&voffB)[2], const Sched& S, Epi& E, int tid, unsigned long long* stp = nullptr, const unsigned* voffB2 = nullptr) {
    const int wid = __builtin_amdgcn_readfirstlane(tid >> 6), lane = tid & 63, wr = wid >> 2, wc = wid & 3, fr = lane & 15, fq = lane >> 4;
    const int nt = g.nt;
    const long kstepA = g.a_k, kstepB = g.b_k, hstepA = g.a_h, hstepB = g.b_h;
    const unsigned ldsw = (unsigned)wid * 1024u;
    const int aoff = lds_byte(wr * 64 + fr, fq * 8), boff = lds_byte(wc * 32 + fr, fq * 8);
#define PG8_SA(b, h) (((b) * 2 + (h)) * HTB)
#define PG8_SB(b, h) ((4 + (b) * 2 + (h)) * HTB)
#define PG8_STAGE(bufoff, gbase, voff) do { const char* _gb = (const char*)(gbase); asm volatile("" : "+s"(_gb));   _Pragma("unroll") for (int _i = 0; _i < 2; ++_i) \
        __builtin_amdgcn_global_load_lds((const unsigned*)(_gb + (voff)[_i]), (LAS unsigned*)(lds + (bufoff) + ldsw + _i * 8192), 16, 0, 0); } while (0)
#define PG8_LDA(dst, b, h) do { _Pragma("unroll") for (int m = 0; m < 4; ++m) _Pragma("unroll") for (int k = 0; k < 2; ++k) dst[m][k] = *(const LAS bf16x8*)(lds + PG8_SA(b, h) + aoff + m * 2048 + k * 1024); } while (0)
#define PG8_LDB(dst, b, h) do { _Pragma("unroll") for (int n = 0; n < 2; ++n) _Pragma("unroll") for (int k = 0; k < 2; ++k) dst[n][k] = *(const LAS bf16x8*)(lds + PG8_SB(b, h) + boff + n * 2048 + k * 1024); } while (0)
#define PG8_MMA(ai, bj, At, Bt) do { __builtin_amdgcn_s_setprio(1); _Pragma("unroll") for (int m = 0; m < 4; ++m) _Pragma("unroll") for (int n = 0; n < 2; ++n) _Pragma("unroll") for (int k = 0; k < 2; ++k) \
        acc[ai][bj][m][n] = __builtin_amdgcn_mfma_f32_16x16x32_bf16(Bt[n][k], At[m][k], acc[ai][bj][m][n], 0, 0, 0); __builtin_amdgcn_s_setprio(0); } while (0)
#define PG8_WAIT_V(n) asm volatile("s_waitcnt vmcnt(" #n ")" ::: "memory")
#define PG8_WAIT_L(n) asm volatile("s_waitcnt lgkmcnt(" #n ")" ::: "memory")
#define PG8_BAR __builtin_amdgcn_s_barrier()
#define PG8_SCHED __builtin_amdgcn_sched_barrier(0)
    Unit cur, nxt; int ui = 0;
    if (!S.next(0, cur)) return;
    f32x4 acc[2][2][4][2];
#pragma unroll
    for (int a = 0; a < 2; ++a)
#pragma unroll
        for (int b = 0; b < 2; ++b)
#pragma unroll
            for (int m = 0; m < 4; ++m)
#pragma unroll
                for (int n = 0; n < 2; ++n) acc[a][b][m][n] = (f32x4){0.f, 0.f, 0.f, 0.f};
    bf16x8 At[4][2], B0[2][2], B1[2][2];
    const char* cA = g.A + (long)cur.pm * g.a_pm + (long)cur.g * g.a_g; const char* cB = g.B + (long)cur.pn * g.b_pn + (long)cur.g * g.b_g;
    const char* cB2 = SEG2 ? g.B2 + (long)cur.pn * g.b2_pn + (long)cur.g * g.b2_g : nullptr;
    PG8_STAGE(PG8_SB(0, 0), cB, voffB); PG8_STAGE(PG8_SB(0, 1), cB + hstepB, voffB); PG8_STAGE(PG8_SA(0, 0), cA, voffA); PG8_STAGE(PG8_SA(0, 1), cA + hstepA, voffA);
    if constexpr (Epi::HAS_PRE) E.pre(S, tid);
    if (wr == 1) PG8_BAR;
    PG8_WAIT_V(2); PG8_BAR;
    PG8_STAGE(PG8_SB(1, 0), cB + kstepB, voffB); PG8_STAGE(PG8_SA(1, 0), cA + kstepA, voffA); PG8_STAGE(PG8_SB(1, 1), cB + hstepB + kstepB, voffB);
    PG8_WAIT_V(6); PG8_BAR;
    unsigned long long st_t0 = stp ? __builtin_amdgcn_s_memrealtime() : 0ull, st_loop = 0ull, st_epi = 0ull;
    for (;;) {
        if constexpr (Epi::HAS_UNIT) E.unit_top(cur, tid, lds);
        const bool has_next = S.next(ui + 1, nxt);
        const char* nA = has_next ? g.A + (long)nxt.pm * g.a_pm + (long)nxt.g * g.a_g : cA; const char* nB = has_next ? g.B + (long)nxt.pn * g.b_pn + (long)nxt.g * g.b_g : cB;
        for (int t = 0; t < nt; t += 2) {
            const bool last = (t == nt - 2);
            const char* a1 = cA + (long)(t + 1) * kstepA;
            const bool sg = SEG2 && !last && (t + 2 >= g.tsw);
            const char* a2 = last ? nA : cA + (long)(t + 2) * kstepA; const char* b2 = last ? nB : (sg ? cB2 + (long)(t + 2 - g.tsw) * g.b2_k : cB + (long)(t + 2) * kstepB);
            const char* a3 = a2 + kstepA; const char* b3 = b2 + (sg ? g.b2_k : kstepB);
            const long hB = sg ? g.b2_h : hstepB;
            unsigned vbs[2]; vbs[0] = sg ? voffB2[0] : voffB[0]; vbs[1] = sg ? voffB2[1] : voffB[1];
            PG8_LDB(B0, 0, 0); PG8_LDB(B1, 0, 1); PG8_SCHED; PG8_LDA(At, 0, 0); PG8_STAGE(PG8_SA(1, 1), a1 + hstepA, voffA);
            PG8_WAIT_V(8); PG8_WAIT_L(0); PG8_BAR; PG8_MMA(0, 0, At, B0); PG8_MMA(0, 1, At, B1); PG8_BAR; PG8_SCHED;
            PG8_LDA(At, 0, 1); PG8_STAGE(PG8_SB(0, 0), b2, vbs); PG8_STAGE(PG8_SB(0, 1), b2 + hB, vbs); PG8_STAGE(PG8_SA(0, 0), a2, voffA);
            PG8_WAIT_V(8); PG8_WAIT_L(0); PG8_BAR; PG8_MMA(1, 0, At, B0); PG8_MMA(1, 1, At, B1); PG8_BAR; PG8_SCHED;
            PG8_LDB(B0, 1, 0); PG8_LDB(B1, 1, 1); PG8_SCHED; PG8_LDA(At, 1, 0); PG8_STAGE(PG8_SA(0, 1), a2 + hstepA, voffA);
            PG8_WAIT_V(8); PG8_WAIT_L(0); PG8_BAR; PG8_MMA(0, 0, At, B0); PG8_MMA(0, 1, At, B1); PG8_BAR; PG8_SCHED;
            PG8_LDA(At, 1, 1); PG8_STAGE(PG8_SB(1, 0), b3, vbs); PG8_STAGE(PG8_SB(1, 1), b3 + hB, vbs); PG8_STAGE(PG8_SA(1, 0), a3, voffA);
            PG8_WAIT_V(8); PG8_WAIT_L(0); PG8_BAR; PG8_MMA(1, 0, At, B0); PG8_MMA(1, 1, At, B1); PG8_BAR; PG8_SCHED;
            if constexpr (Epi::HAS_MID) { if (t + 2 == Epi::MID_T) E.mid(acc, wr, fr); }
        }
        if (stp) { const unsigned long long t1 = __builtin_amdgcn_s_memrealtime(); st_loop += t1 - st_t0; st_t0 = t1; }
        if constexpr (ALIGN_EPI) { if (wr == 0) PG8_BAR; }
        if constexpr (!Epi::AFTER_DRAIN) { E(acc, cur, wr, wc, fr, fq); }
        if (stp) { const unsigned long long t1 = __builtin_amdgcn_s_memrealtime(); st_epi += t1 - st_t0; st_t0 = t1; }
        if (!has_next) break;
#pragma unroll
        for (int a = 0; a < 2; ++a)
#pragma unroll
            for (int b = 0; b < 2; ++b)
#pragma unroll
                for (int m = 0; m < 4; ++m)
#pragma unroll
                    for (int n = 0; n < 2; ++n) acc[a][b][m][n] = (f32x4){0.f, 0.f, 0.f, 0.f};
        cur = nxt; cA = nA; cB = nB; ++ui; if constexpr (SEG2) cB2 = g.B2 + (long)cur.pn * g.b2_pn + (long)cur.g * g.b2_g;
        if constexpr (ALIGN_EPI) { if (wr == 1) PG8_BAR; }
    }
    PG8_WAIT_V(0);
    if constexpr (!ALIGN_EPI) { if (wr == 0) PG8_BAR; }
    PG8_BAR;
    if (stp) { const unsigned long long t1 = __builtin_amdgcn_s_memrealtime(); st_loop += t1 - st_t0; st_t0 = t1; }
    if constexpr (Epi::AFTER_DRAIN) { E.fused(acc, cur, wr, wc, fr, fq, lds, wid, lane); }
    if (stp) { const unsigned long long t1 = __builtin_amdgcn_s_memrealtime(); st_epi += t1 - st_t0; if (tid == 0) { stp[0] = st_loop; stp[1] = st_epi; } }
#undef PG8_SA
#undef PG8_SB
#undef PG8_STAGE
#undef PG8_LDA
#undef PG8_LDB
#undef PG8_MMA
#undef PG8_WAIT_V
#undef PG8_WAIT_L
#undef PG8_BAR
#undef PG8_SCHED
}

__device__ __forceinline__ void voff_std(unsigned (&v)[2], int ld, bool perm, int tid) {
#pragma unroll
    for (int i = 0; i < 2; ++i) { int R, C; stage_rc(tid * 16 + i * 8192, R, C); const int Rb = perm ? ((R & ~31) + perm32(R & 31)) : R; v[i] = (unsigned)(Rb * ld + C) * 2u; }
}

typedef f32x4 Acc[2][2][4][2];

struct EpiU {
    static constexpr bool PERM = true, AFTER_DRAIN = false, HAS_MID = false; static constexpr int MID_T = 0; static constexpr bool HAS_PRE = true, HAS_UNIT = false;
    const float* r0; bf16_t* upool; bf16_t* ussm; LAS float* r0l;
    template <class Sched> __device__ __forceinline__ void pre(const Sched& S, int tid) {
        Unit u0; if (S.next(0, u0) && tid < 256) r0l[tid] = r0[u0.pm * BM + tid];
        __syncthreads();
    }
    __device__ __forceinline__ void operator()(Acc& acc, const Unit& u, int wr, int wc, int fr, int fq) const {
#pragma unroll
        for (int ai = 0; ai < 2; ++ai)
#pragma unroll
            for (int m = 0; m < 4; ++m) {
                const int row = u.pm * BM + ai * HALF + wr * 64 + m * 16 + fr; const float rs = r0l[ai * HALF + wr * 64 + m * 16 + fr];
#pragma unroll
                for (int bj = 0; bj < 2; ++bj) {
                    const int c8 = u.pn * BM + bj * HALF + wc * 32 + 8 * fq;
                    const u32x4 w = pack8(acc[ai][bj][m][0] * rs, acc[ai][bj][m][1] * rs);
                    if (u.pn < 2) st_wt16(upool + (size_t)row * DPOOL + c8, w);
                    else { const int cs = c8 - DPOOL, gg = cs >> 4, h0 = cs & 15, cr = row / TCH, p = row % TCH;
                           st_wt16(ussm + ((size_t)(gg * NCR + cr) * ROWLEN + 16 * p + h0), w); }
                }
            }
    }
};
struct cf { float r, i; };
__device__ __forceinline__ cf cmul(cf a, cf b) { return cf{a.r * b.r - a.i * b.i, a.r * b.i + a.i * b.r}; }
__device__ __forceinline__ cf cmad(cf a, cf b, cf c) { return cf{a.r * b.r - a.i * b.i + c.r, a.r * b.i + a.i * b.r + c.i}; }
template <int CTRL> __device__ __forceinline__ float dppz(float v) { return __builtin_bit_cast(float, __builtin_amdgcn_update_dpp(0, __builtin_bit_cast(int, v), CTRL, 0xf, 0xf, true)); }
template <int CTRL> __device__ __forceinline__ cf cdpp(cf v) { return cf{dppz<CTRL>(v.r), dppz<CTRL>(v.i)}; }
struct EpiScan {
    static constexpr bool PERM = false, AFTER_DRAIN = true, HAS_MID = false; static constexpr int MID_T = 0; static constexpr bool HAS_PRE = true, HAS_UNIT = false;
    const float* lamT; bf16_t* ussm; LAS float* laml;
    static constexpr int LAML_OFF = 8192 + 256 * 520;
    static_assert(LAML_OFF + 1024 <= LDSCTL_OFF, "lambda table fits under the LDS control words");
    template <class Sched> __device__ __forceinline__ void pre(const Sched& S, int tid) {
        Unit u0; if (S.next(0, u0) && tid < 128) *(LAS f32x2*)(laml + tid * 2) = *(const f32x2*)(lamT + ((size_t)((tid >> 6) * NG + u0.g) * NS + (tid & 63)) * 2);
        __syncthreads();
    }
    __device__ __forceinline__ void fused(Acc& acc, const Unit& u, int wr, int wc, int fr, int fq, LAS unsigned char* lds, int wid, int lane) const {
        LAS float* SEG = (LAS float*)lds;
        cf X[2][2][2], MX[2][2];
        LAS unsigned char* CIM = lds + 8192;
#define SC_A(j) cf{acc[(j) >> 2][bj][(j) & 3][np][2 * e], acc[(j) >> 2][bj][(j) & 3][np][2 * e + 1]}
#pragma unroll
        for (int bj = 0; bj < 2; ++bj)
#pragma unroll
            for (int np = 0; np < 2; ++np) {
                const int n0 = 16 * wc + 8 * np + 2 * fq;
                const f32x4 l4 = *(const LAS f32x4*)(laml + (bj * NS + n0) * 2);
#pragma unroll
                for (int e = 0; e < 2; ++e) {
                    const cf lam{l4[2 * e], l4[2 * e + 1]};
                    const cf l2 = cmul(lam, lam), l4p = cmul(l2, l2), M1 = cmul(l4p, l4p), M2 = cmul(M1, M1), M4 = cmul(M2, M2), M8 = cmul(M4, M4);
                    if (wr == 1 - bj) { const int ex = bj == 0 ? fr : 15 - fr;
                        cf Mx{1.f, 0.f};
                        if (ex & 1) Mx = cmul(Mx, M1); if (ex & 2) Mx = cmul(Mx, M2); if (ex & 4) Mx = cmul(Mx, M4); if (ex & 8) Mx = cmul(Mx, M8);
                        MX[np][e] = Mx; }
                    cf T;
                    if (bj == 0) { T = SC_A(0);
#pragma unroll
                        for (int j = 1; j < 8; ++j) T = cmad(lam, T, SC_A(j));
                        T = cmad(M1, cdpp<0x111>(T), T); T = cmad(M2, cdpp<0x112>(T), T); T = cmad(M4, cdpp<0x114>(T), T); T = cmad(M8, cdpp<0x118>(T), T);
                        X[bj][np][e] = cdpp<0x111>(T);
                        if (fr == 15) *(LAS f32x2*)(SEG + ((bj * 2 + wr) * 64 + n0 + e) * 2) = (f32x2){T.r, T.i};
                    } else {       T = SC_A(7);
#pragma unroll
                        for (int j = 6; j >= 0; --j) T = cmad(lam, T, SC_A(j));
                        T = cmad(M1, cdpp<0x101>(T), T); T = cmad(M2, cdpp<0x102>(T), T); T = cmad(M4, cdpp<0x104>(T), T); T = cmad(M8, cdpp<0x108>(T), T);
                        X[bj][np][e] = cdpp<0x101>(T);
                        if (fr == 0) *(LAS f32x2*)(SEG + ((bj * 2 + wr) * 64 + n0 + e) * 2) = (f32x2){T.r, T.i};
                    }
                }
            }
        LDS_WAIT(); __builtin_amdgcn_s_barrier(); asm volatile("" ::: "memory");
#pragma unroll
        for (int bj = 0; bj < 2; ++bj)
#pragma unroll
            for (int np = 0; np < 2; ++np) {
                const int n0 = 16 * wc + 8 * np + 2 * fq;
                const f32x4 l4 = *(const LAS f32x4*)(laml + (bj * NS + n0) * 2);
                const cf lam0{l4[0], l4[1]}, lam1{l4[2], l4[3]};
                cf c0 = X[bj][np][0], c1 = X[bj][np][1];
                LAS unsigned char* crow = CIM + (128 * wr + fr) * 520 + (bj * 128 + 2 * n0) * 2;
#define SC_A0(j) cf{acc[(j) >> 2][bj][(j) & 3][np][0], acc[(j) >> 2][bj][(j) & 3][np][1]}
#define SC_A1(j) cf{acc[(j) >> 2][bj][(j) & 3][np][2], acc[(j) >> 2][bj][(j) & 3][np][3]}
#define SC_PUT(j) do { u32x2 w; w.x = cvt_pk_bf16(c0.r, c0.i); w.y = cvt_pk_bf16(c1.r, c1.i); *(LAS u32x2*)(crow + (j) * (16 * 520)) = w; } while (0)
                if (bj == 0) {
                    if (wr == 1) { const f32x4 t = *(const LAS f32x4*)(SEG + ((bj * 2 + 0) * 64 + n0) * 2); c0 = cmad(MX[np][0], cf{t[0], t[1]}, c0); c1 = cmad(MX[np][1], cf{t[2], t[3]}, c1); }
                    SC_PUT(0);
#pragma unroll
                    for (int j = 1; j < 8; ++j) { c0 = cmad(lam0, c0, SC_A0(j - 1)); c1 = cmad(lam1, c1, SC_A1(j - 1)); SC_PUT(j); }
                } else {
                    if (wr == 0) { const f32x4 t = *(const LAS f32x4*)(SEG + ((bj * 2 + 1) * 64 + n0) * 2); c0 = cmad(MX[np][0], cf{t[0], t[1]}, c0); c1 = cmad(MX[np][1], cf{t[2], t[3]}, c1); }
                    SC_PUT(7);
#pragma unroll
                    for (int j = 6; j >= 0; --j) { c0 = cmad(lam0, c0, SC_A0(j + 1)); c1 = cmad(lam1, c1, SC_A1(j + 1)); SC_PUT(j); }
                }
#undef SC_A0
#undef SC_A1
#undef SC_PUT
            }
#undef SC_A
        LDS_WAIT(); __builtin_amdgcn_s_barrier(); asm volatile("" ::: "memory");
#pragma unroll 8
        for (int r = wid; r < 256; r += 8) { const int c = (r & 128) + 8 * (r & 15) + ((r >> 4) & 7);
            *(u32x2*)(ussm + ((size_t)(u.g * NCR + u.pm * NCHB + c) * ROWLEN + K1) + 4 * lane) = *(const LAS u32x2*)(CIM + r * 520 + 8 * lane); }
    }
};
struct EpiZ {
    static constexpr bool PERM = true, AFTER_DRAIN = false, HAS_MID = false; static constexpr int MID_T = 0; static constexpr bool HAS_PRE = false, HAS_UNIT = false;
    const bf16_t* ussm; const float* dvec; bf16_t* zg;
    __device__ __forceinline__ void operator()(Acc& acc, const Unit& u, int wr, int wc, int fr, int fq) const {
        u32x4 uw[2][2][4];
        f32x4 dd[2][2];
#pragma unroll
        for (int bj = 0; bj < 2; ++bj) {
            const int c8 = u.pn * BM + bj * HALF + wc * 32 + 8 * fq;
            dd[bj][0] = *(const f32x4*)(dvec + u.g * 16 + (c8 & 15)); dd[bj][1] = *(const f32x4*)(dvec + u.g * 16 + (c8 & 15) + 4);
#pragma unroll
            for (int ai = 0; ai < 2; ++ai)
#pragma unroll
                for (int m = 0; m < 4; ++m) { const int cr = u.pm * BM + ai * HALF + wr * 64 + m * 16 + fr; uw[bj][ai][m] = *(const u32x4*)(ussm + ((size_t)(u.g * NCR + cr) * ROWLEN + c8)); }
        }
#pragma unroll
        for (int bj = 0; bj < 2; ++bj) {
            const int c8 = u.pn * BM + bj * HALF + wc * 32 + 8 * fq;
#pragma unroll
            for (int ai = 0; ai < 2; ++ai)
#pragma unroll
                for (int m = 0; m < 4; ++m) {
                    const int cr = u.pm * BM + ai * HALF + wr * 64 + m * 16 + fr;
                    f32x4 u0, u1; unpack8(uw[bj][ai][m], u0, u1);
                    f32x4 y0 = acc[ai][bj][m][0] + dd[bj][0] * u0, y1 = acc[ai][bj][m][1] + dd[bj][1] * u1;
                    y0 = fast_gelu_tanh4(y0); y1 = fast_gelu_tanh4(y1);
                    st_wt16(zg + ((size_t)u.g * MT * 16 + (size_t)cr * K1 + c8), pack8(y0, y1));
                }
        }
    }
};
struct EpiPool {
    static constexpr bool PERM = true, AFTER_DRAIN = false, HAS_MID = false; static constexpr int MID_T = 0; static constexpr bool HAS_PRE = false, HAS_UNIT = false;
    const float* pscale; bf16_t* ycat; float* ss;
    __device__ __forceinline__ void operator()(Acc& acc, const Unit& u, int wr, int wc, int fr, int fq) const {
        f32x4 sc[2][2];
#pragma unroll
        for (int bj = 0; bj < 2; ++bj) { const int c8 = u.pn * BM + bj * HALF + wc * 32 + 8 * fq; sc[bj][0] = *(const f32x4*)(pscale + c8); sc[bj][1] = *(const f32x4*)(pscale + c8 + 4); }
#pragma unroll
        for (int ai = 0; ai < 2; ++ai)
#pragma unroll
            for (int m = 0; m < 4; ++m) {
                const int row = u.pm * BM + ai * HALF + wr * 64 + m * 16 + fr; float q = 0.f;
#pragma unroll
                for (int bj = 0; bj < 2; ++bj) {
                    const int c8 = u.pn * BM + bj * HALF + wc * 32 + 8 * fq;
                    const f32x4 v0 = acc[ai][bj][m][0] * sc[bj][0], v1 = acc[ai][bj][m][1] * sc[bj][1];
                    q += sumsq8(v0, v1);
                    st_wt16(ycat + (size_t)row * DM + c8, pack8(v0, v1));
                }
                q += __shfl_xor(q, 16); q += __shfl_xor(q, 32);
                if (fq == 0) ss[(size_t)(u.pn * 4 + wc) * MT + row] = q;
            }
    }
};
struct EpiGlu {
    static constexpr bool PERM = true, AFTER_DRAIN = false, HAS_MID = false; static constexpr int MID_T = 0; static constexpr bool HAS_PRE = false, HAS_UNIT = false;
    const float* gb; const bf16_t* zg; bf16_t* ycat; float* ss;
    __device__ __forceinline__ void operator()(Acc& acc, const Unit& u, int wr, int wc, int fr, int fq) const {
        f32x4 bv[2][2]; u32x4 zw[2][4][2];
#pragma unroll
        for (int bj = 0; bj < 2; ++bj) { const int c8 = u.pn * BM + bj * HALF + wc * 32 + 8 * fq; bv[bj][0] = *(const f32x4*)(gb + c8); bv[bj][1] = *(const f32x4*)(gb + c8 + 4); }
#pragma unroll
        for (int ai = 0; ai < 2; ++ai)
#pragma unroll
            for (int m = 0; m < 4; ++m) { const int row = u.pm * BM + ai * HALF + wr * 64 + m * 16 + fr;
#pragma unroll
                for (int bj = 0; bj < 2; ++bj) { const int c8 = u.pn * BM + bj * HALF + wc * 32 + 8 * fq; zw[ai][m][bj] = *(const u32x4*)(zg + ((size_t)(c8 >> 4) * MT + row) * 16 + (c8 & 15)); } }
#pragma unroll
        for (int ai = 0; ai < 2; ++ai)
#pragma unroll
            for (int m = 0; m < 4; ++m) {
                const int row = u.pm * BM + ai * HALF + wr * 64 + m * 16 + fr; float q = 0.f;
#pragma unroll
                for (int bj = 0; bj < 2; ++bj) {
                    const int c8 = u.pn * BM + bj * HALF + wc * 32 + 8 * fq;
                    f32x4 z0, z1; unpack8(zw[ai][m][bj], z0, z1);
                    f32x4 v0 = acc[ai][bj][m][0] + bv[bj][0], v1 = acc[ai][bj][m][1] + bv[bj][1];
                    v0 = z0 * fast_sigmoid4(v0); v1 = z1 * fast_sigmoid4(v1);
                    q += sumsq8(v0, v1);
                    st_wt16(ycat + (size_t)row * DM + DPOOL + c8, pack8(v0, v1));
                }
                q += __shfl_xor(q, 16); q += __shfl_xor(q, 32);
                if (fq == 0) ss[(size_t)(u.pn * 4 + wc) * MT + row] = q;
            }
    }
};
struct EpiOut {
    static constexpr bool PERM = true, AFTER_DRAIN = true, HAS_MID = true; static constexpr int MID_T = 8; static constexpr bool HAS_PRE = true, HAS_UNIT = false;
    const bf16_t* xb; bf16_t* h1b; float* ss; LAS f32x2* XR; float ratio[2][4];
    const float* sp; const float* sm;
    template <class Sched> __device__ __forceinline__ void pre(const Sched& S, int tid) {
        Unit u0;
        if (S.next(0, u0) && tid < 256) { const int row = u0.pm * BM + tid; float a0 = 0.f, a1 = 0.f;
#pragma unroll
            for (int k = 0; k < 8; ++k) { a0 += sp[(size_t)k * MT + row]; a1 += sm[(size_t)k * MT + row]; }
            const float rp = rsqrtf(a0 * (1.0f / DPOOL) + EPS), rsm = rsqrtf(a1 * (1.0f / DSSM) + EPS); XR[tid] = (f32x2){rp / rsm, rsm}; }
        __syncthreads();
        const int wr_ = tid >> 8, fr_ = tid & 15;
#pragma unroll
        for (int ai = 0; ai < 2; ++ai)
#pragma unroll
            for (int m = 0; m < 4; ++m) ratio[ai][m] = XR[ai * HALF + wr_ * 64 + m * 16 + fr_].x;
    }
    __device__ __forceinline__ void mid(Acc& acc, int wr, int fr) const {
#pragma unroll
        for (int ai = 0; ai < 2; ++ai)
#pragma unroll
            for (int m = 0; m < 4; ++m) { const float ratio = this->ratio[ai][m];
#pragma unroll
                for (int bj = 0; bj < 2; ++bj)
#pragma unroll
                    for (int n = 0; n < 2; ++n) acc[ai][bj][m][n] = acc[ai][bj][m][n] * ratio; }
    }
    __device__ __forceinline__ void fused(Acc& acc, const Unit& u, int wr, int wc, int fr, int fq, LAS unsigned char* lds, int wid, int lane) const {
        LAS float* P = (LAS float*)lds;
        const int col0 = u.pn * BM + wc * 32 + 8 * fq;
        u32x4 xw[2][4][2];
#pragma unroll
        for (int ai = 0; ai < 2; ++ai)
#pragma unroll
            for (int m = 0; m < 4; ++m)
#pragma unroll
                for (int bj = 0; bj < 2; ++bj) xw[ai][m][bj] = *(const u32x4*)(xb + (size_t)(u.pm * BM + ai * HALF + wr * 64 + m * 16 + fr) * DM + col0 + bj * HALF);
#pragma unroll
        for (int ai = 0; ai < 2; ++ai)
#pragma unroll
            for (int m = 0; m < 4; ++m) {
                const int lr = ai * HALF + wr * 64 + m * 16 + fr, row = u.pm * BM + lr; const float rs = XR[lr].y; float q = 0.f;
                const size_t prow = (size_t)(row >> 12) * PADROWS + 1 + (row & 4095);
#pragma unroll
                for (int bj = 0; bj < 2; ++bj) {
                    const int c = col0 + bj * HALF;
                    f32x4 x0, x1; unpack8(xw[ai][m][bj], x0, x1);
                    const f32x4 h0 = x0 + acc[ai][bj][m][0] * rs, h1v = x1 + acc[ai][bj][m][1] * rs;
                    q += sumsq8(h0, h1v);
                    st_wt16(h1b + prow * DM + c, pack8(h0, h1v));
                }
                q += __shfl_xor(q, 16); q += __shfl_xor(q, 32);
                if (fq == 0) P[lr * 4 + wc] = q;
            }
        LDS_WAIT(); __builtin_amdgcn_s_barrier(); asm volatile("" ::: "memory");
        const int tid = wid * 64 + lane;
        if (tid < 256) ss[(size_t)u.pn * MT + u.pm * BM + tid] = (P[tid * 4 + 0] + P[tid * 4 + 1]) + (P[tid * 4 + 2] + P[tid * 4 + 3]);
    }
};
struct EpiUp {
    static constexpr bool PERM = true, AFTER_DRAIN = false, HAS_MID = false; static constexpr int MID_T = 0; static constexpr bool HAS_PRE = true, HAS_UNIT = true;
    LAS float* rsl; const float* cw; const float* cb; bf16_t* act;
    const float* ssh1;
    static constexpr int TAB_OFF = XTRA_OFF + 6 * 256 * 4;
    static_assert(TAB_OFF + 2 * 4096 <= LDSCTL_OFF, "two filter slices (double-buffered by unit parity: waves leave the previous epilogue at different times) fit in the spare LDS");
    __device__ __forceinline__ void unit_top(const Unit& u, int tid, LAS unsigned char* lds) const {
        const int w = __builtin_amdgcn_readfirstlane(tid >> 6), l = tid & 63;
        if (w < 4) { const int row = 2 * w + (l >> 5), fc = 128 * u.pn + (l & 31) * 4, off = (row >= 4 ? DFF : 0) + fc;
            const float* src = (row & 3) < 3 ? cw + (row & 3) * DFF2 + off : cb + off;
            __builtin_amdgcn_global_load_lds((const unsigned*)src, (LAS unsigned*)(lds + TAB_OFF + (u.aux & 1) * 4096 + w * 1024), 16, 0, 0); }
    }
    template <class Sched> __device__ __forceinline__ void pre(const Sched& S, int tid) {
        if (tid < 256) {
#pragma unroll
            for (int i = 0; i < 6; ++i) { Unit uu; if (S.next(i, uu)) { const int t = UPROWS * uu.pm + tid - 1; const bool in = (t >= 0 && t < SEQ && tid < 254); const int tok = uu.g * SEQ + (in ? t : 0);
                const float sq = (ssh1[tok] + ssh1[MT + tok]) + (ssh1[2 * MT + tok] + ssh1[3 * MT + tok]); rsl[i * 256 + tid] = in ? rsqrtf(sq * (1.0f / DM) + EPS) : 0.f; } } }
        __syncthreads();
    }
    __device__ __forceinline__ void operator()(Acc& acc, const Unit& u, int wr, int wc, int fr, int fq) const {
        const int j = u.pm, b = u.g;
#pragma unroll
        for (int ai = 0; ai < 2; ++ai)
#pragma unroll
            for (int m = 0; m < 4; ++m) {
                const float rs = rsl[u.aux * 256 + 126 * wr + 64 * ai + 4 * fr + m];
#pragma unroll
                for (int bj = 0; bj < 2; ++bj)
#pragma unroll
                    for (int n = 0; n < 2; ++n) acc[ai][bj][m][n] = acc[ai][bj][m][n] * rs;
            }
        const int f0 = 128 * u.pn + 32 * wc + 8 * fq;
        u32x2 keep[8];
#pragma unroll
        for (int n = 0; n < 2; ++n) {
            const int fc = f0 + 4 * n;
            const LAS float* tab = rsl + 6 * 256 + (u.aux & 1) * 1024 + 32 * wc + 8 * fq + 4 * n;
            const f32x4 wv0 = *(const LAS f32x4*)(tab), wv1 = *(const LAS f32x4*)(tab + 128), wv2 = *(const LAS f32x4*)(tab + 256), bvv = *(const LAS f32x4*)(tab + 384);
            const f32x4 wg0 = *(const LAS f32x4*)(tab + 512), wg1 = *(const LAS f32x4*)(tab + 640), wg2 = *(const LAS f32x4*)(tab + 768), bgv = *(const LAS f32x4*)(tab + 896);
#pragma unroll
            for (int ai = 0; ai < 2; ++ai) {
                f32x4 pv, pg, nv, ng;
#pragma unroll
                for (int i = 0; i < 4; ++i) {
                    pv[i] = dpp_ror1(fr == 15 ? acc[ai ^ 1][0][3][n][i] : acc[ai][0][3][n][i]); pg[i] = dpp_ror1(fr == 15 ? acc[ai ^ 1][1][3][n][i] : acc[ai][1][3][n][i]);
                    nv[i] = dpp_ror15(fr == 0 ? acc[ai ^ 1][0][0][n][i] : acc[ai][0][0][n][i]); ng[i] = dpp_ror15(fr == 0 ? acc[ai ^ 1][1][0][n][i] : acc[ai][1][0][n][i]);
                }
#pragma unroll
                for (int m = 0; m < 4; ++m) {
                    const f32x4 cv = acc[ai][0][m][n], cg = acc[ai][1][m][n];
                    const f32x4 v_prev = m > 0 ? acc[ai][0][m - 1][n] : pv, g_prev = m > 0 ? acc[ai][1][m - 1][n] : pg;
                    const f32x4 v_next = m < 3 ? acc[ai][0][m + 1][n] : nv, g_next = m < 3 ? acc[ai][1][m + 1][n] : ng;
                    const f32x4 vv = bvv + wv0 * v_prev + wv1 * cv + wv2 * v_next;
                    const f32x4 gg = bgv + wg0 * g_prev + wg1 * cg + wg2 * g_next;
                    const f32x4 o = vv * gg * fast_sigmoid4(gg);
                    const u32x2 pk = pack4(o); const int gi = ai * 4 + m;
                    if (n == 0) keep[gi] = pk;
                    else { const int w = 64 * ai + 4 * fr + m, t = UPROWS * j + 126 * wr + w - 1;
                           if (t >= 0 && t < SEQ && w >= 1 && w <= 126) { u32x4 wv; wv.x = keep[gi].x; wv.y = keep[gi].y; wv.z = pk.x; wv.w = pk.y; st_wt16(act + (size_t)(b * SEQ + t) * DFF + f0, wv); } }
                }
            }
        }
    }
};
struct EpiDown {
    static constexpr bool PERM = true, AFTER_DRAIN = true, HAS_MID = false; static constexpr int MID_T = 0; static constexpr bool HAS_PRE = false, HAS_UNIT = false;
    const bf16_t* h1b; float* out; const float* gfin; float* ss;
    __device__ __forceinline__ void fused(Acc& acc, const Unit& u, int wr, int wc, int fr, int fq, LAS unsigned char* lds, int wid, int lane) const {
        LAS float* P = (LAS float*)lds;
        LAS float* Sr = (LAS float*)(lds + 8192);
        const int col0 = u.pn * BM + wc * 32 + 8 * fq;
#pragma unroll
        for (int ai = 0; ai < 2; ++ai)
#pragma unroll
            for (int m = 0; m < 4; ++m) {
                const int lr = ai * HALF + wr * 64 + m * 16 + fr, row = u.pm * BM + lr; float q = 0.f;
                const size_t prow = (size_t)(row >> 12) * PADROWS + 1 + (row & 4095);
#pragma unroll
                for (int bj = 0; bj < 2; ++bj) {
                    f32x4 b0, b1; unpack8(*(const u32x4*)(h1b + prow * DM + col0 + bj * HALF), b0, b1);
                    const f32x4 h0 = b0 + acc[ai][bj][m][0], h1v = b1 + acc[ai][bj][m][1];
                    acc[ai][bj][m][0] = h0; acc[ai][bj][m][1] = h1v;
                    q += sumsq8(h0, h1v);
                }
                q += __shfl_xor(q, 16); q += __shfl_xor(q, 32);
                if (fq == 0) P[lr * 4 + wc] = q;
            }
        LDS_WAIT(); __builtin_amdgcn_s_barrier(); asm volatile("" ::: "memory");
        const int tid = wid * 64 + lane;
        f32x4 gg[2][2];
#pragma unroll
        for (int bj = 0; bj < 2; ++bj) { gg[bj][0] = *(const f32x4*)(gfin + col0 + bj * HALF); gg[bj][1] = *(const f32x4*)(gfin + col0 + bj * HALF + 4); }
        if (tid < 256) { unsigned* sr = (unsigned*)ss + u.pm * BM + tid;
            __hip_atomic_store(sr + (size_t)u.pn * MT, __builtin_bit_cast(unsigned, (P[tid * 4 + 0] + P[tid * 4 + 1]) + (P[tid * 4 + 2] + P[tid * 4 + 3])), __ATOMIC_RELAXED, __HIP_MEMORY_SCOPE_AGENT);
            unsigned v0, v1, v2, v3, sp = 0;
            for (;;) {
                v0 = __hip_atomic_load(sr, __ATOMIC_RELAXED, __HIP_MEMORY_SCOPE_AGENT); v1 = __hip_atomic_load(sr + MT, __ATOMIC_RELAXED, __HIP_MEMORY_SCOPE_AGENT);
                v2 = __hip_atomic_load(sr + 2 * MT, __ATOMIC_RELAXED, __HIP_MEMORY_SCOPE_AGENT); v3 = __hip_atomic_load(sr + 3 * MT, __ATOMIC_RELAXED, __HIP_MEMORY_SCOPE_AGENT);
                if ((v0 != 0xFFFFFFFFu && v1 != 0xFFFFFFFFu && v2 != 0xFFFFFFFFu && v3 != 0xFFFFFFFFu) || ++sp > (1u << 20)) break;
                __builtin_amdgcn_s_sleep(1); }
            const float s = (__builtin_bit_cast(float, v0) + __builtin_bit_cast(float, v1)) + (__builtin_bit_cast(float, v2) + __builtin_bit_cast(float, v3));
            Sr[tid] = rsqrtf(s * (1.0f / DM) + EPS); }
        LDS_WAIT(); __builtin_amdgcn_s_barrier(); asm volatile("" ::: "memory");
#pragma unroll
        for (int bj = 0; bj < 2; ++bj) {
            const int c = col0 + bj * HALF; const f32x4 g0 = gg[bj][0], g1 = gg[bj][1];
#pragma unroll
            for (int ai = 0; ai < 2; ++ai)
#pragma unroll
                for (int m = 0; m < 4; ++m) { const int lr = ai * HALF + wr * 64 + m * 16 + fr; const float r = Sr[lr]; float* o = out + (size_t)(u.pm * BM + lr) * DM + c;
                    *(f32x4*)o = acc[ai][bj][m][0] * r * g0; *(f32x4*)(o + 4) = acc[ai][bj][m][1] * r * g1; }
        }
    }
};

struct OrdOne { Unit u; __device__ bool next(int i, Unit& o) const { if (i > 0) return false; o = u; return true; } };
struct OrdSsmB { int c; __device__ bool next(int i, Unit& u) const { if (i > 0 || c >= 128) return false; const int x = c & 7, k = c >> 3; u.g = x * 4 + (k >> 2); u.pm = k & 3; u.pn = 0; u.aux = 0; return true; } };
struct OrdPool { int c; __device__ bool next(int i, Unit& u) const { if (i > 0 || c < 128 || c >= 256) return false; const int cc = c - 128, x = cc & 7, k = cc >> 3; u.pm = x * 8 + (k >> 1); u.pn = k & 1; u.g = u.pn; u.aux = 0; return true; } };
struct OrdGlu  { int c; __device__ bool next(int i, Unit& u) const { if (i > 0 || c >= 128) return false; const int x = c & 7, k = c >> 3; u.pm = x * 8 + (k >> 1); u.pn = k & 1; u.g = 0; u.aux = 0; return true; } };
struct OrdUp { StaticOrder so; __device__ bool next(int i, Unit& u) const { if (!so.next(i, u)) return false; u.g = u.pm / UPT; u.pm = u.pm % UPT; u.aux = i; return true; } };

struct Args { const float* in[24]; float* out; unsigned char* ws; int ph_lo, ph_hi; };

struct Frame { LAS unsigned char* lds; int tid, lane, wave, G, bx; };

struct TrMat { const float* W; int K, N; const float* kg0; const float* kg1; int ksplit; bf16_t* WT; int map; int nitems; };
__device__ __forceinline__ void tr_load(const TrMat& m0, const TrMat& m1, int item, int lane, f32x4 (&v)[8]) {
    const bool second = item >= m0.nitems; const TrMat& m = second ? m1 : m0; const int it = second ? item - m0.nitems : item;
    const int nblk = m.N / 32, kb = it / nblk, nb = it % nblk, k0 = 64 * kb, n0 = 32 * nb, r = lane >> 3, c4 = lane & 7;
#pragma unroll
    for (int i = 0; i < 8; ++i) v[i] = __builtin_nontemporal_load((const f32x4*)(m.W + (size_t)(k0 + 8 * i + r) * m.N + n0 + 4 * c4));
}
__device__ __forceinline__ void tr_store(const TrMat& m0, const TrMat& m1, int item, int lane, const f32x4 (&v)[8], LAS float* scr) {
    const bool second = item >= m0.nitems; const TrMat& m = second ? m1 : m0; const int it = second ? item - m0.nitems : item;
    const int nblk = m.N / 32, kb = it / nblk, nb = it % nblk, k0 = 64 * kb, n0 = 32 * nb, r = lane >> 3, c4 = lane & 7;
#pragma unroll
    for (int i = 0; i < 8; ++i) { const int kk = 8 * i + r, k = k0 + kk; float gn = 1.f; if (m.kg0) gn = (k < m.ksplit ? m.kg0[k] : m.kg1[k - m.ksplit]);
        LAS float* d = scr + kk * 33 + 4 * c4; d[0] = v[i][0] * gn; d[1] = v[i][1] * gn; d[2] = v[i][2] * gn; d[3] = v[i][3] * gn; }
    LDS_WAIT(); asm volatile("" ::: "memory");
    const int c = lane & 7;
#pragma unroll
    for (int j = 0; j < 4; ++j) { const int n = (lane >> 3) + 8 * j; const LAS float* q = scr + (8 * c) * 33 + n;
        u32x4 o; o.x = pk2(q[0 * 33], q[1 * 33]); o.y = pk2(q[2 * 33], q[3 * 33]); o.z = pk2(q[4 * 33], q[5 * 33]); o.w = pk2(q[6 * 33], q[7 * 33]);
        int nr = n0 + n;
        if (m.map == 1) { const int bj = nr / DFF, rem = nr % DFF; nr = 256 * (rem >> 7) + 128 * bj + (rem & 127); }
        *(u32x4*)(m.WT + (size_t)nr * m.K + k0 + 8 * c) = o; }
    LDS_WAIT(); asm volatile("" ::: "memory");
}
__device__ __forceinline__ void tr_run(const TrMat& m0, const TrMat& m1, int first, int stride, int lane, LAS float* scr) {
    const int total = m0.nitems + m1.nitems; f32x4 va[8], vb[8];
    int it = first; if (it < total) tr_load(m0, m1, it, lane, va);
    while (it < total) {
        const int n1 = it + stride; if (n1 < total) tr_load(m0, m1, n1, lane, vb);
        tr_store(m0, m1, it, lane, va, scr);
        if (n1 >= total) break;
        const int n2 = n1 + stride; if (n2 < total) tr_load(m0, m1, n2, lane, va);
        tr_store(m0, m1, n1, lane, vb, scr);
        it = n2;
    }
}

struct SsmLds { LAS float* Bre; LAS float* Bim; LAS float* Cre; LAS float* Cim; LAS float* PAR; LAS float* Pc; LAS float* Kl; };
__device__ __forceinline__ SsmLds ssm_lds(const Frame& F) { SsmLds L; L.Bre = (LAS float*)(F.lds); L.Bim = L.Bre + 2048; L.Cre = L.Bim + 2048; L.Cim = L.Cre + 2048; L.PAR = L.Cim + 2048; L.Pc = L.PAR + 512; L.Kl = L.Pc + 1024; return L; }
__device__ __forceinline__ void ssm_stage(const Args& a, const Frame& F, const SsmLds& L, int g) {
    const float* lnar = a.in[5]; const float* aim = a.in[6]; const float* ldt = a.in[7];
    const float* bre = a.in[8]; const float* bim = a.in[9]; const float* cre = a.in[10]; const float* cim = a.in[11];
    const int tid = F.tid;
    for (int i = tid; i < 2048; i += 512) { const int dir = i >> 10, r = i & 1023;
        L.Bre[i] = bre[((size_t)(dir * NG + g)) * 1024 + r]; L.Bim[i] = bim[((size_t)(dir * NG + g)) * 1024 + r];
        L.Cre[i] = cre[((size_t)(dir * NG + g)) * 1024 + r]; L.Cim[i] = cim[((size_t)(dir * NG + g)) * 1024 + r]; }
    if (tid < 128) { const int dir = tid >> 6, n = tid & 63;
        const float dt = expf(ldt[dir * NG + g]); const float a_re = -expf(lnar[(dir * NG + g) * NS + n]), a_im = aim[(dir * NG + g) * NS + n];
        const float mag = expf(a_re * dt), ang = a_im * dt; const float lam_re = mag * cosf(ang), lam_im = mag * sinf(ang);
        const float den = a_re * a_re + a_im * a_im;
        L.PAR[tid * 4 + 0] = a_re * dt; L.PAR[tid * 4 + 1] = ang;
        L.PAR[tid * 4 + 2] = ((lam_re - 1.0f) * a_re + lam_im * a_im) / den; L.PAR[tid * 4 + 3] = (lam_im * a_re - (lam_re - 1.0f) * a_im) / den; }
    __syncthreads();
}
__device__ __forceinline__ void ssm_build_tb(const Args& a, const Frame& F, const SsmLds& L, int g, int lag0, int nl) {
    bf16_t* KC = (bf16_t*)(a.ws + WS_TB) + (size_t)g * (2 * TCH) * 256;
    bf16_t* TBC = (bf16_t*)(a.ws + WS_TBC) + (size_t)g * K1 * 256;
    const int tid = F.tid;
    { const int li = tid >> 7, dn = tid & 127, lag = lag0 + li; const float ad = L.PAR[dn * 4 + 0], ang = L.PAR[dn * 4 + 1], fr_ = L.PAR[dn * 4 + 2], fi_ = L.PAR[dn * 4 + 3];
      const float mg = expf((float)lag * ad); float sn, cs; sincosf((float)lag * ang, &sn, &cs); const float lr = mg * cs, lim = mg * sn;
      L.Pc[(li * 128 + dn) * 2 + 0] = lr * fr_ - lim * fi_; L.Pc[(li * 128 + dn) * 2 + 1] = lr * fi_ + lim * fr_; }
    __syncthreads();
    { const int li = F.wave >> 1, dir = F.wave & 1, i16 = F.lane & 15, kq = F.lane >> 4; f32x4 kacc = {0.f, 0.f, 0.f, 0.f};
#pragma unroll 8
      for (int kk0 = 0; kk0 < 128; kk0 += 4) { const int kk = kk0 + kq, n = kk >> 1; const bool im = (kk & 1) != 0;
          const float cr_ = L.Cre[dir * 1024 + i16 * 64 + n], ci_ = L.Cim[dir * 1024 + i16 * 64 + n], pr = L.Pc[(li * 128 + dir * 64 + n) * 2], pi = L.Pc[(li * 128 + dir * 64 + n) * 2 + 1];
          const float av = im ? -(cr_ * pi + ci_ * pr) : (cr_ * pr - ci_ * pi);
          const float bv = im ? L.Bim[dir * 1024 + n * 16 + i16] : L.Bre[dir * 1024 + n * 16 + i16];
          kacc = __builtin_amdgcn_mfma_f32_16x16x4f32(av, bv, kacc, 0, 0, 0); }
#pragma unroll
      for (int r = 0; r < 4; ++r) L.Kl[li * 512 + dir * 256 + (kq * 4 + r) * 16 + i16] = kacc[r]; }
    __syncthreads();
    { const int li = tid >> 7, dir = (tid >> 6) & 1, e4 = tid & 63, lag = lag0 + li;
      if (li < nl && !(lag == 0 && dir == 1)) {
          f32x4 v = *(const LAS f32x4*)(L.Kl + li * 512 + dir * 256 + 4 * e4);
          if (lag == 0) v = v + *(const LAS f32x4*)(L.Kl + li * 512 + 256 + 4 * e4);
          const int d = dir == 0 ? (TCH - 1) + lag : (TCH - 1) - lag; u32x2 w; w.x = pk2(v[0], v[1]); w.y = pk2(v[2], v[3]);
          st_wt8(KC + (size_t)d * 256 + 4 * e4, w); } }
    __syncthreads();
    { const int li = tid >> 7, dn = tid & 127, dir = dn >> 6, p = lag0 + li; const float ad = L.PAR[dn * 4 + 0], ang = L.PAR[dn * 4 + 1]; const float e = dir == 0 ? (float)(p + 1) : (float)(TCH - p);
      const float mg = expf(e * ad); float sn, cs; sincosf(e * ang, &sn, &cs); L.Pc[(li * 128 + dn) * 2 + 0] = mg * cs; L.Pc[(li * 128 + dn) * 2 + 1] = mg * sn; }
    __syncthreads();
    for (int li = 0; li < nl; ++li) {
        const int p = lag0 + li, h = tid >> 5, dir = (tid >> 4) & 1, n4 = tid & 15; float v[8];
#pragma unroll
        for (int e = 0; e < 4; ++e) { const int n = 4 * n4 + e; const float cr_ = L.Cre[dir * 1024 + h * 64 + n], ci_ = L.Cim[dir * 1024 + h * 64 + n], pr = L.Pc[(li * 128 + dir * 64 + n) * 2], pi = L.Pc[(li * 128 + dir * 64 + n) * 2 + 1];
            v[2 * e] = cr_ * pr - ci_ * pi; v[2 * e + 1] = -(cr_ * pi + ci_ * pr); }
        u32x4 w; w.x = pk2(v[0], v[1]); w.y = pk2(v[2], v[3]); w.z = pk2(v[4], v[5]); w.w = pk2(v[6], v[7]);
        st_wt16(TBC + (size_t)(16 * p + h) * 256 + dir * 128 + 8 * n4, w);
    }
    __syncthreads();
}
__device__ __forceinline__ void ssm_build_wab(const Args& a, const Frame& F, const SsmLds& L, int g, int jq) {
    bf16_t* WAB = (bf16_t*)(a.ws + WS_WAB) + (size_t)g * 256 * K1;
    const int tid = F.tid;
    if (jq == 0 && tid < 128) { const int dir = tid >> 6, n = tid & 63; const float ad = L.PAR[tid * 4 + 0], ang = L.PAR[tid * 4 + 1];
        const float mg = expf((float)TCH * ad); float sn, cs; sincosf((float)TCH * ang, &sn, &cs); *(f32x2*)((float*)(a.ws + WS_LAMT) + ((size_t)(dir * NG + g) * NS + n) * 2) = (f32x2){mg * cs, mg * sn}; }
    { const int li = tid >> 7, dn = tid & 127, dir = dn >> 6, q = 4 * jq + li; const float ad = L.PAR[dn * 4 + 0], ang = L.PAR[dn * 4 + 1], fr_ = L.PAR[dn * 4 + 2], fi_ = L.PAR[dn * 4 + 3]; const float e = dir == 0 ? (float)(TCH - 1 - q) : (float)q;
      const float mg = expf(e * ad); float sn, cs; sincosf(e * ang, &sn, &cs); const float lr = mg * cs, lim = mg * sn;
      L.Pc[(li * 128 + dn) * 2 + 0] = lr * fr_ - lim * fi_; L.Pc[(li * 128 + dn) * 2 + 1] = lr * fi_ + lim * fr_; }
    __syncthreads();
#pragma unroll
    for (int half = 0; half < 2; ++half) {
        const int li = 2 * half + (tid >> 8), q = 4 * jq + li, t2 = tid & 255, dir = t2 >> 7, n = (t2 >> 1) & 63, part = t2 & 1;
        const float pr = L.Pc[(li * 128 + dir * 64 + n) * 2], pi = L.Pc[(li * 128 + dir * 64 + n) * 2 + 1]; float v[16];
#pragma unroll
        for (int i = 0; i < 16; ++i) { const float br_ = L.Bre[dir * 1024 + n * 16 + i], bi_ = L.Bim[dir * 1024 + n * 16 + i]; v[i] = part == 0 ? (pr * br_ - pi * bi_) : (pr * bi_ + pi * br_); }
        u32x4 w0, w1; w0.x = pk2(v[0], v[1]); w0.y = pk2(v[2], v[3]); w0.z = pk2(v[4], v[5]); w0.w = pk2(v[6], v[7]); w1.x = pk2(v[8], v[9]); w1.y = pk2(v[10], v[11]); w1.z = pk2(v[12], v[13]); w1.w = pk2(v[14], v[15]);
        bf16_t* dst = WAB + (size_t)(dir * 128 + 2 * n + part) * K1 + 16 * q; *(u32x4*)dst = w0; *(u32x4*)(dst + 8) = w1;
    }
    __syncthreads();
}

__device__ __forceinline__ void p0_prologue(const Args& a, const Frame& F) {
    const float* x = a.in[0];
    LAS unsigned* ctr = (LAS unsigned*)(F.lds + LDSCTL_OFF) + 16;
    int row0; f32x4 pv[4];
    { unsigned r = 0; if (F.lane == 0) r = __hip_atomic_fetch_add(ctr, 1u, __ATOMIC_RELAXED, __HIP_MEMORY_SCOPE_WORKGROUP);
      r = (unsigned)__builtin_amdgcn_readfirstlane((int)r); row0 = F.bx * 8 + (int)(r & 7u) + F.G * 8 * (int)(r >> 3);
      const f32x4* xr = (const f32x4*)(x + (size_t)row0 * DM) + F.lane;
#pragma unroll
      for (int j = 0; j < 4; ++j) pv[j] = __builtin_nontemporal_load(xr + 64 * j); }
    { const SsmLds L = ssm_lds(F);
      for (int it = F.bx; it < NG * (TCH / 4); it += F.G) { ssm_stage(a, F, L, it / (TCH / 4)); ssm_build_wab(a, F, L, it / (TCH / 4), it % (TCH / 4)); } }
    __syncthreads();
    LAS float* scr = (LAS float*)(F.lds + F.wave * 16384);
    const int gw = F.bx * 8 + F.wave, NGW = F.G * 8;
    { const TrMat m0{a.in[2], DM, DM, a.in[1], a.in[1], DM, (bf16_t*)(a.ws + WS_WIN), 0, (DM / 64) * (DM / 32)}; const TrMat m1{nullptr, 0, 32, nullptr, nullptr, 0, nullptr, 0, 0};
      tr_run(m0, m1, F.wave < 2 ? F.bx * 2 + F.wave : m0.nitems, m0.nitems, F.lane, scr); }
    { bf16_t* PW = (bf16_t*)(a.ws + WS_PW); const float* pw = a.in[3];
      for (int idx = F.bx * 512 + F.tid; idx < 2 * 256 * 256; idx += F.G * 512) { const int pn = idx >> 16, j = (idx >> 8) & 255, k = idx & 255;
          const float v = ((j >> 7) == (k >> 7)) ? pw[((size_t)(2 * pn + (j >> 7)) * 128 + (k & 127)) * 128 + (j & 127)] : 0.f; PW[idx] = (bf16_t)f2bf(v); } }
    { bf16_t* h1b = (bf16_t*)(a.ws + WS_H1B);
      for (int idx = F.bx * 512 + F.tid; idx < BATCH * 256 * (DM / 8); idx += F.G * 512) { const int b = idx / (256 * 128), r = (idx / 128) % 256, c = idx % 128; const int prow = b * PADROWS + (r == 0 ? 0 : 4096 + r);
          *(u32x4*)(h1b + (size_t)prow * DM + 8 * c) = (u32x4){0u, 0u, 0u, 0u}; } }
    { unsigned* s2 = (unsigned*)(a.ws + WS_SSH2);
      for (int idx = F.bx * 512 + F.tid; idx < 4 * MT; idx += F.G * 512) s2[idx] = 0xFFFFFFFFu; }
    { bf16_t* xb = (bf16_t*)(a.ws + WS_XB); float* r0 = (float*)(a.ws + WS_R0);
      { float s = 0.f;
#pragma unroll
        for (int j = 0; j < 4; ++j) s += (pv[j][0] * pv[j][0] + pv[j][1] * pv[j][1]) + (pv[j][2] * pv[j][2] + pv[j][3] * pv[j][3]);
        s = wave_sum(s); if (F.lane == 0) r0[row0] = rsqrtf(s * (1.0f / DM) + EPS);
        u32x2* o = (u32x2*)(xb + (size_t)row0 * DM) + F.lane;
#pragma unroll
        for (int j = 0; j < 4; ++j) o[64 * j] = pack4(pv[j]); }
      for (;;) {
          unsigned r = 0; if (F.lane == 0) r = __hip_atomic_fetch_add(ctr, 1u, __ATOMIC_RELAXED, __HIP_MEMORY_SCOPE_WORKGROUP);
          r = (unsigned)__builtin_amdgcn_readfirstlane((int)r); if (r >= (unsigned)(MT / NGW * 8)) break;
          const int row = F.bx * 8 + (int)(r & 7u) + NGW * (int)(r >> 3);
          const f32x4* xr = (const f32x4*)(x + (size_t)row * DM) + F.lane; f32x4 v[4]; float s = 0.f;
#pragma unroll
          for (int j = 0; j < 4; ++j) { v[j] = __builtin_nontemporal_load(xr + 64 * j); s += (v[j][0] * v[j][0] + v[j][1] * v[j][1]) + (v[j][2] * v[j][2] + v[j][3] * v[j][3]); }
          s = wave_sum(s); if (F.lane == 0) r0[row] = rsqrtf(s * (1.0f / DM) + EPS);
          u32x2* o = (u32x2*)(xb + (size_t)row * DM) + F.lane;
#pragma unroll
          for (int j = 0; j < 4; ++j) o[64 * j] = pack4(v[j]);
      } }
}

__device__ __forceinline__ void ssm_side(const Args& a, const Frame& F, int first_block) {
    const int nb = F.G - first_block, sb = F.bx - first_block;
    { const SsmLds L = ssm_lds(F);
      const int g = sb >> 2, lag0 = (sb & 3) * 4;
      ssm_stage(a, F, L, g); ssm_build_tb(a, F, L, g, lag0, 4);
      VM_WAIT(); __syncthreads();
      if (F.tid == 0) {
          __hip_atomic_fetch_add((unsigned*)(a.ws + WS_CTL) + CW_TBCNT + 64 * g, 4u, __ATOMIC_RELAXED, __HIP_MEMORY_SCOPE_AGENT); } }
    __syncthreads();
    LAS float* scr = (LAS float*)(F.lds + F.wave * 16384);
    const TrMat m0{a.in[17], DM, DM, a.in[15], a.in[16], DPOOL, (bf16_t*)(a.ws + WS_WOUT), 0, (DM / 64) * (DM / 32)};
    const TrMat m1{a.in[13], DSSM, DSSM, nullptr, nullptr, 0, (bf16_t*)(a.ws + WS_WGLU), 0, (DSSM / 64) * (DSSM / 32)};
    tr_run(m0, m1, sb * 8 + F.wave, nb * 8, F.lane, scr);
    const TrMat m2{a.in[22], DFF, DM, nullptr, nullptr, 0, (bf16_t*)(a.ws + WS_WDOWN), 0, (DFF / 64) * (DM / 32)}; const TrMat m3{nullptr, 0, 32, nullptr, nullptr, 0, nullptr, 0, 0};
    { const int W = nb * 8, n01 = m0.nitems + m1.nitems;
      tr_run(m2, m3, (sb * 8 + F.wave + W - n01 % W) % W, W, F.lane, scr); }
}
__device__ __forceinline__ void tb_wait(const Args& a, const Frame& F, int g) {
    if (F.tid == 0) { unsigned* cnt = (unsigned*)(a.ws + WS_CTL) + CW_TBCNT + 64 * g; unsigned sp = 0;
        while (__hip_atomic_load(cnt, __ATOMIC_RELAXED, __HIP_MEMORY_SCOPE_AGENT) < (unsigned)TCH) { __builtin_amdgcn_s_sleep(2); if (++sp > (1u << 20)) break; }
        __builtin_amdgcn_fence(__ATOMIC_ACQUIRE, "agent"); }
    asm volatile("s_waitcnt vmcnt(0)" ::: "memory");
    __syncthreads();
}
__device__ __forceinline__ void p4_side(const Args& a, const Frame& F, int first_block) {
    const int nb = F.G - first_block, sb = F.bx - first_block;
    LAS float* scr = (LAS float*)(F.lds + F.wave * 16384);
    const TrMat m0{a.in[19], DM, DFF2, a.in[18], a.in[18], DM, (bf16_t*)(a.ws + WS_WUP), 1, (DM / 64) * (DFF2 / 32)};
    const TrMat m1{nullptr, 0, 32, nullptr, nullptr, 0, nullptr, 0, 0};
    tr_run(m0, m1, sb * 8 + F.wave, nb * 8, F.lane, scr);
}

__device__ __forceinline__ void p2_pooled(const Args& a, const Frame& F, int first_block) {
    const bf16_t* up = (const bf16_t*)(a.ws + WS_UPOOL); bf16_t* po = (bf16_t*)(a.ws + WS_POOLED);
    const int gw = (F.bx - first_block) * 8 + F.wave, NGW = (F.G - first_block) * 8;
    const int c0 = 8 * F.lane, half = 1 << (F.lane >> 4);
    for (int blk = gw; blk < MT / 4; blk += NGW) {
        const int row0 = blk * 4, b = row0 / SEQ, t0 = row0 % SEQ;
        u32x4 w[19];
#pragma unroll
        for (int o = 0; o < 19; ++o) { int q = t0 + o - 8; q = q < 0 ? 0 : (q >= SEQ ? SEQ - 1 : q); w[o] = *(const u32x4*)(up + (size_t)(b * SEQ + q) * DPOOL + c0); }
#pragma unroll
        for (int r = 0; r < 4; ++r) {
            f32x4 s0 = {0.f, 0.f, 0.f, 0.f}, s1 = {0.f, 0.f, 0.f, 0.f}; float cnt = 0.f;
#pragma unroll
            for (int d = -8; d < 8; ++d) { const int q = t0 + r + d; const float m = (d >= -half && d < half && q >= 0 && q < SEQ) ? 1.f : 0.f; f32x4 a0, a1; unpack8(w[r + d + 8], a0, a1); s0 = s0 + a0 * m; s1 = s1 + a1 * m; cnt += m; }
            f32x4 c0v, c1v; unpack8(w[r + 8], c0v, c1v);
            const float inv = __builtin_amdgcn_rcpf(cnt);
            *(u32x4*)(po + (size_t)(row0 + r) * DPOOL + c0) = pack8(s0 * inv - c0v, s1 * inv - c1v);
        }
    }
}

__global__ void __launch_bounds__(512, 2) mk_fwd(Args args) {
    extern __shared__ __attribute__((aligned(16))) unsigned char lds_raw[];
    Frame F; F.lds = (LAS unsigned char*)lds_raw; F.tid = threadIdx.x; F.lane = F.tid & 63; F.wave = __builtin_amdgcn_readfirstlane(F.tid >> 6); F.G = gridDim.x; F.bx = blockIdx.x;
    volatile LAS unsigned* MISC = (volatile LAS unsigned*)(F.lds + LDSCTL_OFF);
    for (int u = F.tid; u < (LDS_BYTES - LDSCTL_OFF) / 4; u += 512) ((LAS unsigned*)(F.lds + LDSCTL_OFF))[u] = 0u;
    __syncthreads();
    unsigned char* ws = args.ws;
    XcdBarrier bar = xcd_barrier_post((unsigned*)(ws + WS_CTL), MISC + 8);
    const int lo = args.ph_lo, hi = args.ph_hi;
#define IN(k) (lo <= (k) && (k) < hi)
#define BOTH(k) (IN(k) && IN((k) == 2 ? 4 : (k) + 1))
    if (IN(0)) { p0_prologue(args, F); if (BOTH(0)) xcd_barrier(bar, F.tid); }
    if (IN(1)) { F.lane = lane_id_fresh(); F.tid = F.wave * 64 + F.lane;
        GemmDesc g{(const char*)(ws + WS_XB), (const char*)(ws + WS_WIN), 256L * DM * 2, 0, 256L * DM * 2, 0, 128L * DM * 2, 128L * DM * 2, 128, 128, DM / BK};
        unsigned vA[2], vB[2]; voff_std(vA, DM, false, F.tid); voff_std(vB, DM, true, F.tid);
        StaticOrder S; S.init(MT / BM, DM / BM, F.G, F.bx);
        EpiU E{(const float*)(ws + WS_R0), (bf16_t*)(ws + WS_UPOOL), (bf16_t*)(ws + WS_USSM), (LAS float*)(F.lds + XTRA_OFF)};
        gemm_phase<EpiU, StaticOrder, true>(F.lds, g, vA, vB, S, E, F.tid, nullptr);
        if (BOTH(1)) xcd_barrier(bar, F.tid);
    }
    if (IN(2)) { F.lane = lane_id_fresh(); F.tid = F.wave * 64 + F.lane;
        if (F.bx < 128) {
            OrdSsmB S0{F.bx}; Unit u0; S0.next(0, u0);
            { GemmDesc g{(const char*)(ws + WS_USSM), (const char*)(ws + WS_WAB), 256L * ROWLEN * 2, (long)NCR * ROWLEN * 2, 0, 256L * K1 * 2, 4L * ROWLEN * 2, 128L * K1 * 2, 128, 128, K1 / BK};
              unsigned vA[2], vB[2]; voff_std(vB, K1, false, F.tid);
#pragma unroll
              for (int i = 0; i < 2; ++i) { int R, C; stage_rc(F.tid * 16 + i * 8192, R, C);
                  vA[i] = (unsigned)(((128 * (R >> 6) + 8 * (R & 15) + ((R >> 4) & 3)) * ROWLEN + C) * 2); }
              OrdOne S{u0}; EpiScan E{(const float*)(ws + WS_LAMT), (bf16_t*)(ws + WS_USSM), (LAS float*)(F.lds + EpiScan::LAML_OFF)};
              gemm_phase<EpiScan, OrdOne, false>(F.lds, g, vA, vB, S, E, F.tid, nullptr); }
            tb_wait(args, F, u0.g);
            F.lane = lane_id_fresh(); F.tid = F.wave * 64 + F.lane;
            { GemmDesc g{(const char*)(ws + WS_USSM), (const char*)(ws + WS_TB), 256L * ROWLEN * 2, (long)NCR * ROWLEN * 2, 0, (2L * TCH) * 512, 128L * ROWLEN * 2, 8L * 512, 128, -4L * 512, ROWLEN / BK,
                         (const char*)(ws + WS_TBC), 0, (long)K1 * 512, 128L * 512, 128, K1 / BK};
              unsigned vA[2], vB[2], vB2[2]; voff_std(vA, ROWLEN, false, F.tid); voff_std(vB2, 256, true, F.tid);
#pragma unroll
              for (int i = 0; i < 2; ++i) { int R, C; stage_rc(F.tid * 16 + i * 8192, R, C); const int Rb = (R & ~31) + perm32(R & 31);
                  vB[i] = (unsigned)((((Rb >> 4) - (C >> 4) + (TCH - 1)) * 256 + (Rb & 15) * 16 + (C & 15)) * 2); }
              asm volatile("" : "+v"(vA[0]), "+v"(vA[1]), "+v"(vB[0]), "+v"(vB[1]), "+v"(vB2[0]), "+v"(vB2[1]));
              OrdOne S{u0}; EpiZ E{(const bf16_t*)(ws + WS_USSM), args.in[12], (bf16_t*)(ws + WS_ZG)};
              gemm_phase<EpiZ, OrdOne, true, true>(F.lds, g, vA, vB, S, E, F.tid, nullptr, vB2); }
        } else { ssm_side(args, F, 128); p2_pooled(args, F, 128); }
        if (BOTH(2)) xcd_barrier(bar, F.tid);
    }
    if (IN(4)) { F.lane = lane_id_fresh(); F.tid = F.wave * 64 + F.lane;
        if (F.bx < 128) {
            constexpr long GSTR = (long)MT * 32;
            GemmDesc g{(const char*)(ws + WS_ZG), (const char*)(ws + WS_WGLU), 256L * 32, 0, 256L * DSSM * 2, 0, 128L * 32, 128L * DSSM * 2, 4 * GSTR, 128, DSSM / BK};
            unsigned vA[2], vB[2]; voff_std(vB, DSSM, true, F.tid);
#pragma unroll
            for (int i = 0; i < 2; ++i) { int R, C; stage_rc(F.tid * 16 + i * 8192, R, C); vA[i] = (unsigned)(R * 32 + (C >> 4) * (int)GSTR + (C & 15) * 2); }
            OrdGlu S{F.bx}; EpiGlu E{args.in[14], (const bf16_t*)(ws + WS_ZG), (bf16_t*)(ws + WS_YCAT), (float*)(ws + WS_SSSSM)};
            gemm_phase<EpiGlu, OrdGlu, true>(F.lds, g, vA, vB, S, E, F.tid, nullptr);
        } else {
            GemmDesc g{(const char*)(ws + WS_POOLED), (const char*)(ws + WS_PW), 256L * DPOOL * 2, 256L * 2, 256L * 256 * 2, 0, 128L * DPOOL * 2, 128L * 256 * 2, 128, 128, 256 / BK};
            unsigned vA[2], vB[2]; voff_std(vA, DPOOL, false, F.tid); voff_std(vB, 256, true, F.tid);
            OrdPool S{F.bx}; EpiPool E{args.in[4], (bf16_t*)(ws + WS_YCAT), (float*)(ws + WS_SSPOOL)};
            gemm_phase<EpiPool, OrdPool, true>(F.lds, g, vA, vB, S, E, F.tid, nullptr);

            __syncthreads();
            p4_side(args, F, 128);
        }
        if (BOTH(4)) xcd_barrier(bar, F.tid);
    }
    if (IN(5)) { F.lane = lane_id_fresh(); F.tid = F.wave * 64 + F.lane;
        StaticOrder S; S.init(MT / BM, DM / BM, F.G, F.bx);
        LAS f32x2* XR = (LAS f32x2*)(F.lds + XTRA_OFF);
        GemmDesc g{(const char*)(ws + WS_YCAT), (const char*)(ws + WS_WOUT), 256L * DM * 2, 0, 256L * DM * 2, 0, 128L * DM * 2, 128L * DM * 2, 128, 128, DM / BK};
        unsigned vA[2], vB[2]; voff_std(vA, DM, false, F.tid); voff_std(vB, DM, true, F.tid);
        EpiOut E{(const bf16_t*)(ws + WS_XB), (bf16_t*)(ws + WS_H1B), (float*)(ws + WS_SSH1), XR, {{0.f, 0.f, 0.f, 0.f}, {0.f, 0.f, 0.f, 0.f}}, (const float*)(ws + WS_SSPOOL), (const float*)(ws + WS_SSSSM)};
        gemm_phase<EpiOut, StaticOrder, false>(F.lds, g, vA, vB, S, E, F.tid, nullptr);
        if (BOTH(5)) xcd_barrier(bar, F.tid);
    }
    if (IN(6)) { F.lane = lane_id_fresh(); F.tid = F.wave * 64 + F.lane;
        GemmDesc g{(const char*)(ws + WS_H1B), (const char*)(ws + WS_WUP), (long)UPROWS * DM * 2, (long)PADROWS * DM * 2, 256L * DM * 2, 0, 64L * DM * 2, 128L * DM * 2, 128, 128, DM / BK};
        unsigned vA[2], vB[2]; voff_std(vB, DM, true, F.tid);
#pragma unroll
        for (int i = 0; i < 2; ++i) { int R, C; stage_rc(F.tid * 16 + i * 8192, R, C); vA[i] = (unsigned)(((126 * (R >> 6) + 4 * (R & 15) + ((R >> 4) & 3)) * DM + C) * 2); }
        OrdUp S; S.so.init(BATCH * UPT, DFF2 / BM, F.G, F.bx);
        LAS float* RSL = (LAS float*)(F.lds + XTRA_OFF);
        EpiUp E{RSL, args.in[20], args.in[21], (bf16_t*)(ws + WS_ACT), (const float*)(ws + WS_SSH1)};
        gemm_phase<EpiUp, OrdUp, true>(F.lds, g, vA, vB, S, E, F.tid, nullptr);
        if (BOTH(6)) xcd_barrier(bar, F.tid);
    }
    if (IN(7)) { F.lane = lane_id_fresh(); F.tid = F.wave * 64 + F.lane;
        GemmDesc g{(const char*)(ws + WS_ACT), (const char*)(ws + WS_WDOWN), 256L * DFF * 2, 0, 256L * DFF * 2, 0, 128L * DFF * 2, 128L * DFF * 2, 128, 128, DFF / BK};
        unsigned vA[2], vB[2]; voff_std(vA, DFF, false, F.tid); voff_std(vB, DFF, true, F.tid);
        StaticOrder S; S.init(MT / BM, DM / BM, F.G, F.bx);
        EpiDown E{(const bf16_t*)(ws + WS_H1B), args.out, args.in[23], (float*)(ws + WS_SSH2)};
        gemm_phase<EpiDown, StaticOrder, false>(F.lds, g, vA, vB, S, E, F.tid, nullptr);
    }
#undef IN
#undef BOTH
}
}

extern "C" void kernel_launch(void* const* d_in, const int* in_sizes, int n_in, void* d_out, int out_size, void* d_ws, size_t ws_size, hipStream_t stream) {
    static int grid = 0;
    if (grid == 0) {
        int dev = 0, cus = 0, per_cu = 0;
        if (n_in != 24 || out_size != MT * DM || ws_size < mk::WS_END) { fprintf(stderr, "kernel_launch: unexpected problem (n_in %d out %d ws %zu)\n", n_in, out_size, ws_size); grid = -1; return; }
        if (hipGetDevice(&dev) != hipSuccess || hipDeviceGetAttribute(&cus, hipDeviceAttributeMultiprocessorCount, dev) != hipSuccess) { grid = -1; return; }
        if (hipFuncSetAttribute((const void*)mk::mk_fwd, hipFuncAttributeMaxDynamicSharedMemorySize, mk::LDS_BYTES) != hipSuccess) { fprintf(stderr, "kernel_launch: hipFuncSetAttribute failed\n"); grid = -1; return; }
        if (hipOccupancyMaxActiveBlocksPerMultiprocessor(&per_cu, (const void*)mk::mk_fwd, 512, mk::LDS_BYTES) != hipSuccess || per_cu < 1) { fprintf(stderr, "kernel_launch: occupancy query says %d blocks/CU; nothing launched\n", per_cu); (void)hipGetLastError(); grid = -1; return; }
        grid = cus;
        if (grid != 256) { fprintf(stderr, "kernel_launch: built for a 256-CU device, found %d CUs\n", cus); grid = -1; return; }
    }
    if (grid < 0) return;
    (void)in_sizes;
    (void)hipMemsetAsync((char*)d_ws + mk::WS_CTL, 0, mk::CTL_ZERO_BYTES, stream);
    mk::Args a{};
    for (int i = 0; i < 24; ++i) a.in[i] = (const float*)d_in[i];
    a.out = (float*)d_out; a.ws = (unsigned char*)d_ws; a.ph_lo = 0; a.ph_hi = 8;
    hipLaunchKernelGGL(mk::mk_fwd, dim3(grid), dim3(512), mk::LDS_BYTES, stream, a);
}
```

```cpp
#include <hip/hip_runtime.h>
#include <math.h>

constexpr int BATCH = 4, SEQ = 4096, DM = 1024, MT = BATCH * SEQ;
constexpr int DPOOL = 512, DSSM = 512, NG = 32, NH = 16, NS = 64;
constexpr int DFF = 2816, DFF2 = 5632;
constexpr float EPS = 1e-6f;

#include <cstdio>
#include <cstdint>
#define LAS __attribute__((address_space(3)))
#define GAS __attribute__((address_space(1)))
typedef unsigned short bf16_t;
typedef short bf16x8 __attribute__((ext_vector_type(8)));
typedef float f32x4 __attribute__((ext_vector_type(4)));
typedef float f32x2 __attribute__((ext_vector_type(2)));
typedef unsigned u32x4 __attribute__((ext_vector_type(4)));
typedef unsigned u32x2 __attribute__((ext_vector_type(2)));

namespace mk {
constexpr int TCH = 16;
constexpr int K1 = 16 * TCH;
constexpr int ROWLEN = K1 + 256;
constexpr int NCR = MT / TCH;
constexpr int NCHB = SEQ / TCH;
constexpr int PADROWS = 4352;
constexpr int UPT = 17;
constexpr int UPROWS = 252;

constexpr size_t MiB = 1u << 20;
constexpr size_t WS_CTL = 0, CTL_ZERO_BYTES = 64 * 1024;
constexpr int CW_TBCNT = 4096;
constexpr size_t WS_R0 = 1 * MiB;
constexpr size_t WS_SSPOOL = 2 * MiB;
constexpr size_t WS_SSSSM = WS_SSPOOL + 8 * MT * 4;
constexpr size_t WS_SSH1 = WS_SSSSM + 8 * MT * 4;
constexpr size_t WS_SSH2 = WS_SSH1 + 4 * MT * 4;
constexpr size_t WS_LAMT = 6 * MiB;
constexpr size_t WS_WIN = 8 * MiB, WS_WOUT = 10 * MiB, WS_WGLU = 12 * MiB, WS_PW = 12 * MiB + 512 * 1024;
constexpr size_t WS_WUP = 13 * MiB, WS_WDOWN = 24 * MiB;
constexpr size_t WS_WAB = 30 * MiB;
constexpr size_t WS_TB = 38 * MiB;
constexpr size_t WS_TBC = 40 * MiB;
constexpr size_t WS_H1B = 62 * MiB;
constexpr size_t WS_XB = 96 * MiB;
constexpr size_t WS_YCAT = 128 * MiB;
constexpr size_t WS_UPOOL = 128 * MiB;
constexpr size_t WS_USSM = 144 * MiB;
constexpr size_t WS_POOLED = 208 * MiB;
constexpr size_t WS_ZG = 224 * MiB;
constexpr size_t WS_ACT = 96 * MiB;
constexpr size_t WS_END = 240 * MiB;

constexpr int RING_BYTES = 131072, XTRA_OFF = RING_BYTES, XTRA_BYTES = 16384, LDSCTL_OFF = XTRA_OFF + XTRA_BYTES, LDS_BYTES = 151552;

__device__ __forceinline__ unsigned f2bf(float f) { unsigned u = __builtin_bit_cast(unsigned, f); return (u + 0x7fffu + ((u >> 16) & 1u)) >> 16; }
__device__ __forceinline__ unsigned pk2(float lo, float hi) { return f2bf(lo) | (f2bf(hi) << 16); }
__device__ __forceinline__ unsigned cvt_pk_bf16(float lo, float hi) { unsigned r; asm volatile("v_cvt_pk_bf16_f32 %0, %1, %2" : "=v"(r) : "v"(lo), "v"(hi)); return r; }
__device__ __forceinline__ u32x4 pack8(f32x4 a, f32x4 b) { u32x4 w; w.x = cvt_pk_bf16(a[0], a[1]); w.y = cvt_pk_bf16(a[2], a[3]); w.z = cvt_pk_bf16(b[0], b[1]); w.w = cvt_pk_bf16(b[2], b[3]); return w; }
__device__ __forceinline__ u32x2 pack4(f32x4 a) { u32x2 w; w.x = cvt_pk_bf16(a[0], a[1]); w.y = cvt_pk_bf16(a[2], a[3]); return w; }
__device__ __forceinline__ float bflo(unsigned w) { return __builtin_bit_cast(float, w << 16); }
__device__ __forceinline__ float bfhi(unsigned w) { return __builtin_bit_cast(float, w & 0xffff0000u); }
__device__ __forceinline__ void unpack8(u32x4 w, f32x4& a, f32x4& b) { a[0] = bflo(w.x); a[1] = bfhi(w.x); a[2] = bflo(w.y); a[3] = bfhi(w.y); b[0] = bflo(w.z); b[1] = bfhi(w.z); b[2] = bflo(w.w); b[3] = bfhi(w.w); }
__device__ __forceinline__ float fast_sigmoid(float x) { return __builtin_amdgcn_rcpf(1.0f + __builtin_amdgcn_exp2f(-1.4426950408889634f * x)); }
__device__ __forceinline__ f32x4 fast_sigmoid4(f32x4 x) {
    const f32x4 t = x * -1.4426950408889634f; f32x4 e;
#pragma unroll
    for (int i = 0; i < 4; ++i) e[i] = __builtin_amdgcn_exp2f(t[i]);
    const f32x4 d = e + 1.0f; f32x4 r;
#pragma unroll
    for (int i = 0; i < 4; ++i) r[i] = __builtin_amdgcn_rcpf(d[i]);
    return r;
}
__device__ __forceinline__ float sumsq8(f32x4 a, f32x4 b) { const f32x4 s = a * a + b * b; return (s[0] + s[1]) + (s[2] + s[3]); }
__device__ __forceinline__ f32x4 fast_gelu_tanh4(f32x4 x) {
    constexpr float C = -2.0f * 0.7978845608028654f * 1.4426950408889634f;
    const f32x4 a = x * (x * x * (C * 0.044715f) + C); f32x4 e;
#pragma unroll
    for (int i = 0; i < 4; ++i) e[i] = __builtin_amdgcn_exp2f(a[i]);
    const f32x4 d = e + 1.0f; f32x4 r;
#pragma unroll
    for (int i = 0; i < 4; ++i) r[i] = __builtin_amdgcn_rcpf(d[i]);
    return x * r;
}
__device__ __forceinline__ float fast_gelu_tanh(float x) {
    const float t = x * (1.0f + 0.044715f * x * x);
    return x * __builtin_amdgcn_rcpf(1.0f + __builtin_amdgcn_exp2f(-2.0f * 0.7978845608028654f * 1.4426950408889634f * t));
}
__device__ __forceinline__ float wave_sum(float v) {
#pragma unroll
    for (int o = 1; o < 64; o <<= 1) v += __shfl_xor(v, o);
    return v;
}
__device__ __forceinline__ float dpp_ror1(float v)  { return __builtin_bit_cast(float, __builtin_amdgcn_update_dpp(0, __builtin_bit_cast(int, v), 0x121, 0xf, 0xf, false)); }
__device__ __forceinline__ float dpp_ror15(float v) { return __builtin_bit_cast(float, __builtin_amdgcn_update_dpp(0, __builtin_bit_cast(int, v), 0x12F, 0xf, 0xf, false)); }
__device__ __forceinline__ int lane_id_fresh() { int l; asm volatile("v_mbcnt_lo_u32_b32 %0, -1, 0\n\tv_mbcnt_hi_u32_b32 %0, -1, %0" : "=v"(l)); return l; }
#define LDS_WAIT() asm volatile("s_waitcnt lgkmcnt(0)" ::: "memory")
#define VM_WAIT() asm volatile("s_waitcnt vmcnt(0)" ::: "memory")
__device__ __forceinline__ void st_wt16(void* p, u32x4 v) { asm volatile("global_store_dwordx4 %0, %1, off sc1\n\ts_nop 1" :: "v"(p), "v"(v) : "memory"); }
__device__ __forceinline__ void st_wt8(void* p, u32x2 v)  { asm volatile("global_store_dwordx2 %0, %1, off sc1\n\ts_nop 1" :: "v"(p), "v"(v) : "memory"); }

#define XB_TMO      128
#define XB_XCNT(j)  (256  + 64 * (j))
#define XB_XSUB(j)  (1280 + 64 * (j))
#define XB_XGEN(j)  (2304 + 64 * (j))
#define XB_TOP      3328
#define XB_TOPGEN   3392
#define XCD_BAR_WORDS 3456
#define XB_SPIN_CAP (1u << 18)
__device__ __forceinline__ unsigned xb_ld(unsigned* p)              { return __hip_atomic_load(p, __ATOMIC_RELAXED, __HIP_MEMORY_SCOPE_AGENT); }
__device__ __forceinline__ unsigned xb_add(unsigned* p, unsigned v) { return __hip_atomic_fetch_add(p, v, __ATOMIC_RELAXED, __HIP_MEMORY_SCOPE_AGENT); }
__device__ __forceinline__ unsigned xb_xcc_id() { return (unsigned)__builtin_amdgcn_s_getreg((3 << 11) | 20) & 0xFu; }
#define XB_SPIN(cond, bar) do { unsigned _sp = 0; while (cond) { __builtin_amdgcn_s_sleep(1); \
    if ((++_sp & 255u) == 0u) { if (xb_ld(&(bar)[XB_TMO])) break; if (_sp > XB_SPIN_CAP) { atomicAdd(&(bar)[XB_TMO], 1u); break; } } } } while (0)
struct XcdBarrier { unsigned* bar; unsigned x; volatile LAS unsigned* st; };
__device__ __forceinline__ XcdBarrier xcd_barrier_post(unsigned* bar, volatile LAS unsigned* st) {
    XcdBarrier b; b.bar = bar; b.x = xb_xcc_id(); b.st = st;
    if (threadIdx.x == 0) (void)xb_add(&bar[XB_XCNT(b.x)], 1u);
    return b;
}
__device__ __forceinline__ void xcd_barrier_complete(unsigned* bar, unsigned x, unsigned& nloc, unsigned& nx) {
    const unsigned G = gridDim.x * gridDim.y * gridDim.z;
    unsigned sum, cnt, mine, sp = 0u;
    for (;;) {
        sum = 0u; cnt = 0u; mine = 0u;
#pragma unroll
        for (unsigned j = 0; j < 16; ++j) { const unsigned c = xb_ld(&bar[XB_XCNT(j)]); sum += c; cnt += (c > 0u) ? 1u : 0u; mine = (j == x) ? c : mine; }
        if (sum == G) break;
        __builtin_amdgcn_s_sleep(1);
        if ((++sp & 255u) == 0u) { if (xb_ld(&bar[XB_TMO])) break; if (sp > XB_SPIN_CAP) { atomicAdd(&bar[XB_TMO], 1u); break; } }
    }
    nloc = mine > 0u ? mine : 1u; nx = cnt > 0u ? cnt : 1u;
}
__device__ __forceinline__ void xcd_barrier(const XcdBarrier& b, int tid) {
    asm volatile("s_waitcnt vmcnt(0)" ::: "memory");
    __syncthreads();
    if (tid == 0) {
        unsigned* bar = b.bar;
        __builtin_amdgcn_s_waitcnt(0);
        unsigned nloc = b.st[0], nx = b.st[1];
        if (nloc == 0u) { xcd_barrier_complete(bar, b.x, nloc, nx); b.st[0] = nloc; b.st[1] = nx; }
        const unsigned old = xb_add(&bar[XB_XSUB(b.x)], 1u);
        const unsigned gen = old / nloc;
        if (old + 1u == (gen + 1u) * nloc) {
            __builtin_amdgcn_fence(__ATOMIC_RELEASE, "agent");
            asm volatile("s_waitcnt vmcnt(0)" ::: "memory");
            const unsigned og = xb_add(&bar[XB_TOP], 1u);
            const unsigned tg = og / nx;
            if (og + 1u == (tg + 1u) * nx) xb_add(&bar[XB_TOPGEN], 1u);
            else XB_SPIN(xb_ld(&bar[XB_TOPGEN]) == tg, bar);
            __builtin_amdgcn_fence(__ATOMIC_ACQUIRE, "agent");
            xb_add(&bar[XB_XGEN(b.x)], 1u);
            asm volatile("s_waitcnt vmcnt(0)" ::: "memory");
        } else {
            __builtin_amdgcn_fence(__ATOMIC_ACQUIRE, "agent");
            XB_SPIN(xb_ld(&bar[XB_XGEN(b.x)]) == gen, bar);
            asm volatile("s_waitcnt vmcnt(0)" ::: "memory");
        }
    }
    __syncthreads();
}

constexpr int BM = 256, BK = 64, HALF = 128, HTB = HALF * BK * 2, STAGE_BYTES = 8 * HTB, NXCD = 8, WGM = 8;
__host__ __device__ __forceinline__ int lds_byte(int r, int c) { const int st = (r >> 4) * 2 + (c >> 5), rr = r & 15, cc = c & 31, ob = rr * 64 + cc * 2; return st * 1024 + (ob ^ (((ob >> 9) & 1) << 5)); }
__host__ __device__ __forceinline__ void stage_rc(int b, int& R, int& C) { const int st = b / 1024, sb = b % 1024, swz = sb ^ (((sb >> 9) & 1) << 5); R = (st >> 1) * 16 + swz / 64; C = (st & 1) * 32 + (swz % 64) / 2; }
__host__ __device__ __forceinline__ int perm32(int rho) { const int n = rho >> 4, i = rho & 15; return 8 * (i >> 2) + 4 * n + (i & 3); }

struct Unit { int pm, pn, g, aux; };
struct GemmDesc { const char* A; const char* B; long a_pm, a_g, b_pn, b_g, a_h, b_h, a_k, b_k; int nt;
                  const char* B2; long b2_pn, b2_g, b2_h, b2_k; int tsw; };

struct StaticOrder {
    int nM, nN, nwg, G, c;
    __device__ void init(int nM_, int nN_, int G_, int c_) { nM = nM_; nN = nN_; nwg = nM * nN; G = G_; c = c_; }
    __device__ bool next(int i, Unit& u) const {
        const long L = (long)i * G + c; if (L >= nwg) return false;
        int wgid = (int)L; { const int q = nwg / NXCD, r = nwg % NXCD, xcd = wgid % NXCD, off = wgid / NXCD; wgid = (xcd < r ? xcd * (q + 1) : r * (q + 1) + (xcd - r) * q) + off; }
        const int nig = WGM * nN, gid = wgid / nig, fm = gid * WGM, gsz = (nM - fm) < WGM ? (nM - fm) : WGM;
        u.pm = fm + ((wgid % nig) % gsz); u.pn = (wgid % nig) / gsz; u.g = 0; u.aux = 0; return true;
    }
};

template <class Epi, class Sched, bool ALIGN_EPI, bool SEG2 = false>
__device__ __forceinline__ void gemm_phase(LAS unsigned char* lds, const GemmDesc g, const unsigned (&voffA)[2], const unsigned (&voffB)[2], const Sched& S, Epi& E, int tid, unsigned long long* stp = nullptr, const unsigned* voffB2 = nullptr) {
    const int wid = __builtin_amdgcn_readfirstlane(tid >> 6), lane = tid & 63, wr = wid >> 2, wc = wid & 3, fr = lane & 15, fq = lane >> 4;
    const int nt = g.nt;
    const long kstepA = g.a_k, kstepB = g.b_k, hstepA = g.a_h, hstepB = g.b_h;
    const unsigned ldsw = (unsigned)wid * 1024u;
    const int aoff = lds_byte(wr * 64 + fr, fq * 8), boff = lds_byte(wc * 32 + fr, fq * 8);
#define PG8_SA(b, h) (((b) * 2 + (h)) * HTB)
#define PG8_SB(b, h) ((4 + (b) * 2 + (h)) * HTB)
#define PG8_STAGE(bufoff, gbase, voff) do { const char* _gb = (const char*)(gbase); asm volatile("" : "+s"(_gb));   _Pragma("unroll") for (int _i = 0; _i < 2; ++_i) \
        __builtin_amdgcn_global_load_lds((const unsigned*)(_gb + (voff)[_i]), (LAS unsigned*)(lds + (bufoff) + ldsw + _i * 8192), 16, 0, 0); } while (0)
#define PG8_LDA(dst, b, h) do { _Pragma("unroll") for (int m = 0; m < 4; ++m) _Pragma("unroll") for (int k = 0; k < 2; ++k) dst[m][k] = *(const LAS bf16x8*)(lds + PG8_SA(b, h) + aoff + m * 2048 + k * 1024); } while (0)
#define PG8_LDB(dst, b, h) do { _Pragma("unroll") for (int n = 0; n < 2; ++n) _Pragma("unroll") for (int k = 0; k < 2; ++k) dst[n][k] = *(const LAS bf16x8*)(lds + PG8_SB(b, h) + boff + n * 2048 + k * 1024); } while (0)
#define PG8_MMA(ai, bj, At, Bt) do { __builtin_amdgcn_s_setprio(1); _Pragma("unroll") for (int m = 0; m < 4; ++m) _Pragma("unroll") for (int n = 0; n < 2; ++n) _Pragma("unroll") for (int k = 0; k < 2; ++k) \
        acc[ai][bj][m][n] = __builtin_amdgcn_mfma_f32_16x16x32_bf16(Bt[n][k], At[m][k], acc[ai][bj][m][n], 0, 0, 0); __builtin_amdgcn_s_setprio(0); } while (0)
#define PG8_WAIT_V(n) asm volatile("s_waitcnt vmcnt(" #n ")" ::: "memory")
#define PG8_WAIT_L(n) asm volatile("s_waitcnt lgkmcnt(" #n ")" ::: "memory")
#define PG8_BAR __builtin_amdgcn_s_barrier()
#define PG8_SCHED __builtin_amdgcn_sched_barrier(0)
    Unit cur, nxt; int ui = 0;
    if (!S.next(0, cur)) return;
    f32x4 acc[2][2][4][2];
#pragma unroll
    for (int a = 0; a < 2; ++a)
#pragma unroll
        for (int b = 0; b < 2; ++b)
#pragma unroll
            for (int m = 0; m < 4; ++m)
#pragma unroll
                for (int n = 0; n < 2; ++n) acc[a][b][m][n] = (f32x4){0.f, 0.f, 0.f, 0.f};
    bf16x8 At[4][2], B0[2][2], B1[2][2];
    const char* cA = g.A + (long)cur.pm * g.a_pm + (long)cur.g * g.a_g; const char* cB = g.B + (long)cur.pn * g.b_pn + (long)cur.g * g.b_g;
    const char* cB2 = SEG2 ? g.B2 + (long)cur.pn * g.b2_pn + (long)cur.g * g.b2_g : nullptr;
    PG8_STAGE(PG8_SB(0, 0), cB, voffB); PG8_STAGE(PG8_SB(0, 1), cB + hstepB, voffB); PG8_STAGE(PG8_SA(0, 0), cA, voffA); PG8_STAGE(PG8_SA(0, 1), cA + hstepA, voffA);
    if constexpr (Epi::HAS_PRE) E.pre(S, tid);
    if (wr == 1) PG8_BAR;
    PG8_WAIT_V(2); PG8_BAR;
    PG8_STAGE(PG8_SB(1, 0), cB + kstepB, voffB); PG8_STAGE(PG8_SA(1, 0), cA + kstepA, voffA); PG8_STAGE(PG8_SB(1, 1), cB + hstepB + kstepB, voffB);
    PG8_WAIT_V(6); PG8_BAR;
    unsigned long long st_t0 = stp ? __builtin_amdgcn_s_memrealtime() : 0ull, st_loop = 0ull, st_epi = 0ull;
    for (;;) {
        if constexpr (Epi::HAS_UNIT) E.unit_top(cur, tid, lds);
        const bool has_next = S.next(ui + 1, nxt);
        const char* nA = has_next ? g.A + (long)nxt.pm * g.a_pm + (long)nxt.g * g.a_g : cA; const char* nB = has_next ? g.B + (long)nxt.pn * g.b_pn + (long)nxt.g * g.b_g : cB;
        for (int t = 0; t < nt; t += 2) {
            const bool last = (t == nt - 2);
            const char* a1 = cA + (long)(t + 1) * kstepA;
            const bool sg = SEG2 && !last && (t + 2 >= g.tsw);
            const char* a2 = last ? nA : cA + (long)(t + 2) * kstepA; const char* b2 = last ? nB : (sg ? cB2 + (long)(t + 2 - g.tsw) * g.b2_k : cB + (long)(t + 2) * kstepB);
            const char* a3 = a2 + kstepA; const char* b3 = b2 + (sg ? g.b2_k : kstepB);
            const long hB = sg ? g.b2_h : hstepB;
            unsigned vbs[2]; vbs[0] = sg ? voffB2[0] : voffB[0]; vbs[1] = sg ? voffB2[1] : voffB[1];
            PG8_LDB(B0, 0, 0); PG8_LDB(B1, 0, 1); PG8_SCHED; PG8_LDA(At, 0, 0); PG8_STAGE(PG8_SA(1, 1), a1 + hstepA, voffA);
            PG8_WAIT_V(8); PG8_WAIT_L(0); PG8_BAR; PG8_MMA(0, 0, At, B0); PG8_MMA(0, 1, At, B1); PG8_BAR; PG8_SCHED;
            PG8_LDA(At, 0, 1); PG8_STAGE(PG8_SB(0, 0), b2, vbs); PG8_STAGE(PG8_SB(0, 1), b2 + hB, vbs); PG8_STAGE(PG8_SA(0, 0), a2, voffA);
            PG8_WAIT_V(8); PG8_WAIT_L(0); PG8_BAR; PG8_MMA(1, 0, At, B0); PG8_MMA(1, 1, At, B1); PG8_BAR; PG8_SCHED;
            PG8_LDB(B0, 1, 0); PG8_LDB(B1, 1, 1); PG8_SCHED; PG8_LDA(At, 1, 0); PG8_STAGE(PG8_SA(0, 1), a2 + hstepA, voffA);
            PG8_WAIT_V(8); PG8_WAIT_L(0); PG8_BAR; PG8_MMA(0, 0, At, B0); PG8_MMA(0, 1, At, B1); PG8_BAR; PG8_SCHED;
            PG8_LDA(At, 1, 1); PG8_STAGE(PG8_SB(1, 0), b3, vbs); PG8_STAGE(PG8_SB(1, 1), b3 + hB, vbs); PG8_STAGE(PG8_SA(1, 0), a3, voffA);
            PG8_WAIT_V(8); PG8_WAIT_L(0); PG8_BAR; PG8_MMA(1, 0, At, B0); PG8_MMA(1, 1, At, B1); PG8_BAR; PG8_SCHED;
            if constexpr (Epi::HAS_MID) { if (t + 2 == Epi::MID_T) E.mid(acc, wr, fr); }
        }
        if (stp) { const unsigned long long t1 = __builtin_amdgcn_s_memrealtime(); st_loop += t1 - st_t0; st_t0 = t1; }
        if constexpr (ALIGN_EPI) { if (wr == 0) PG8_BAR; }
        if constexpr (!Epi::AFTER_DRAIN) { E(acc, cur, wr, wc, fr, fq); }
        if (stp) { const unsigned long long t1 = __builtin_amdgcn_s_memrealtime(); st_epi += t1 - st_t0; st_t0 = t1; }
        if (!has_next) break;
#pragma unroll
        for (int a = 0; a < 2; ++a)
#pragma unroll
            for (int b = 0; b < 2; ++b)
#pragma unroll
                for (int m = 0; m < 4; ++m)
#pragma unroll
                    for (int n = 0; n < 2; ++n) acc[a][b][m][n] = (f32x4){0.f, 0.f, 0.f, 0.f};
        cur = nxt; cA = nA; cB = nB; ++ui; if constexpr (SEG2) cB2 = g.B2 + (long)cur.pn * g.b2_pn + (long)cur.g * g.b2_g;
        if constexpr (ALIGN_EPI) { if (wr == 1) PG8_BAR; }
    }
    PG8_WAIT_V(0);
    if constexpr (!ALIGN_EPI) { if (wr == 0) PG8_BAR; }
    PG8_BAR;
    if (stp) { const unsigned long long t1 = __builtin_amdgcn_s_memrealtime(); st_loop += t1 - st_t0; st_t0 = t1; }
    if constexpr (Epi::AFTER_DRAIN) { E.fused(acc, cur, wr, wc, fr, fq, lds, wid, lane); }
    if (stp) { const unsigned long long t1 = __builtin_amdgcn_s_memrealtime(); st_epi += t1 - st_t0; if (tid == 0) { stp[0] = st_loop; stp[1] = st_epi; } }
#undef PG8_SA
#undef PG8_SB
#undef PG8_STAGE
#undef PG8_LDA
#undef PG8_LDB
#undef PG8_MMA
#undef PG8_WAIT_V
#undef PG8_WAIT_L
#undef PG8_BAR
#undef PG8_SCHED
}

__device__ __forceinline__ void voff_std(unsigned (&v)[2], int ld, bool perm, int tid) {
#pragma unroll
    for (int i = 0; i < 2; ++i) { int R, C; stage_rc(tid * 16 + i * 8192, R, C); const int Rb = perm ? ((R & ~31) + perm32(R & 31)) : R; v[i] = (unsigned)(Rb * ld + C) * 2u; }
}

typedef f32x4 Acc[2][2][4][2];

struct EpiU {
    static constexpr bool PERM = true, AFTER_DRAIN = false, HAS_MID = false; static constexpr int MID_T = 0; static constexpr bool HAS_PRE = true, HAS_UNIT = false;
    const float* r0; bf16_t* upool; bf16_t* ussm; LAS float* r0l;
    template <class Sched> __device__ __forceinline__ void pre(const Sched& S, int tid) {
        Unit u0; if (S.next(0, u0) && tid < 256) r0l[tid] = r0[u0.pm * BM + tid];
        __syncthreads();
    }
    __device__ __forceinline__ void operator()(Acc& acc, const Unit& u, int wr, int wc, int fr, int fq) const {
#pragma unroll
        for (int ai = 0; ai < 2; ++ai)
#pragma unroll
            for (int m = 0; m < 4; ++m) {
                const int row = u.pm * BM + ai * HALF + wr * 64 + m * 16 + fr; const float rs = r0l[ai * HALF + wr * 64 + m * 16 + fr];
#pragma unroll
                for (int bj = 0; bj < 2; ++bj) {
                    const int c8 = u.pn * BM + bj * HALF + wc * 32 + 8 * fq;
                    const u32x4 w = pack8(acc[ai][bj][m][0] * rs, acc[ai][bj][m][1] * rs);
                    if (u.pn < 2) st_wt16(upool + (size_t)row * DPOOL + c8, w);
                    else { const int cs = c8 - DPOOL, gg = cs >> 4, h0 = cs & 15, cr = row / TCH, p = row % TCH;
                           st_wt16(ussm + ((size_t)(gg * NCR + cr) * ROWLEN + 16 * p + h0), w); }
                }
            }
    }
};
struct cf { float r, i; };
__device__ __forceinline__ cf cmul(cf a, cf b) { return cf{a.r * b.r - a.i * b.i, a.r * b.i + a.i * b.r}; }
__device__ __forceinline__ cf cmad(cf a, cf b, cf c) { return cf{a.r * b.r - a.i * b.i + c.r, a.r * b.i + a.i * b.r + c.i}; }
template <int CTRL> __device__ __forceinline__ float dppz(float v) { return __builtin_bit_cast(float, __builtin_amdgcn_update_dpp(0, __builtin_bit_cast(int, v), CTRL, 0xf, 0xf, true)); }
template <int CTRL> __device__ __forceinline__ cf cdpp(cf v) { return cf{dppz<CTRL>(v.r), dppz<CTRL>(v.i)}; }
struct EpiScan {
    static constexpr bool PERM = false, AFTER_DRAIN = true, HAS_MID = false; static constexpr int MID_T = 0; static constexpr bool HAS_PRE = true, HAS_UNIT = false;
    const float* lamT; bf16_t* ussm; LAS float* laml;
    static constexpr int LAML_OFF = 8192 + 256 * 520;
    static_assert(LAML_OFF + 1024 <= LDSCTL_OFF, "lambda table fits under the LDS control words");
    template <class Sched> __device__ __forceinline__ void pre(const Sched& S, int tid) {
        Unit u0; if (S.next(0, u0) && tid < 128) *(LAS f32x2*)(laml + tid * 2) = *(const f32x2*)(lamT + ((size_t)((tid >> 6) * NG + u0.g) * NS + (tid & 63)) * 2);
        __syncthreads();
    }
    __device__ __forceinline__ void fused(Acc& acc, const Unit& u, int wr, int wc, int fr, int fq, LAS unsigned char* lds, int wid, int lane) const {
        LAS float* SEG = (LAS float*)lds;
        cf X[2][2][2], MX[2][2];
        LAS unsigned char* CIM = lds + 8192;
#define SC_A(j) cf{acc[(j) >> 2][bj][(j) & 3][np][2 * e], acc[(j) >> 2][bj][(j) & 3][np][2 * e + 1]}
#pragma unroll
        for (int bj = 0; bj < 2; ++bj)
#pragma unroll
            for (int np = 0; np < 2; ++np) {
                const int n0 = 16 * wc + 8 * np + 2 * fq;
                const f32x4 l4 = *(const LAS f32x4*)(laml + (bj * NS + n0) * 2);
#pragma unroll
                for (int e = 0; e < 2; ++e) {
                    const cf lam{l4[2 * e], l4[2 * e + 1]};
                    const cf l2 = cmul(lam, lam), l4p = cmul(l2, l2), M1 = cmul(l4p, l4p), M2 = cmul(M1, M1), M4 = cmul(M2, M2), M8 = cmul(M4, M4);
                    if (wr == 1 - bj) { const int ex = bj == 0 ? fr : 15 - fr;
                        cf Mx{1.f, 0.f};
                        if (ex & 1) Mx = cmul(Mx, M1); if (ex & 2) Mx = cmul(Mx, M2); if (ex & 4) Mx = cmul(Mx, M4); if (ex & 8) Mx = cmul(Mx, M8);
                        MX[np][e] = Mx; }
                    cf T;
                    if (bj == 0) { T = SC_A(0);
#pragma unroll
                        for (int j = 1; j < 8; ++j) T = cmad(lam, T, SC_A(j));
                        T = cmad(M1, cdpp<0x111>(T), T); T = cmad(M2, cdpp<0x112>(T), T); T = cmad(M4, cdpp<0x114>(T), T); T = cmad(M8, cdpp<0x118>(T), T);
                        X[bj][np][e] = cdpp<0x111>(T);
                        if (fr == 15) *(LAS f32x2*)(SEG + ((bj * 2 + wr) * 64 + n0 + e) * 2) = (f32x2){T.r, T.i};
                    } else {       T = SC_A(7);
#pragma unroll
                        for (int j = 6; j >= 0; --j) T = cmad(lam, T, SC_A(j));
                        T = cmad(M1, cdpp<0x101>(T), T); T = cmad(M2, cdpp<0x102>(T), T); T = cmad(M4, cdpp<0x104>(T), T); T = cmad(M8, cdpp<0x108>(T), T);
                        X[bj][np][e] = cdpp<0x101>(T);
                        if (fr == 0) *(LAS f32x2*)(SEG + ((bj * 2 + wr) * 64 + n0 + e) * 2) = (f32x2){T.r, T.i};
                    }
                }
            }
        LDS_WAIT(); __builtin_amdgcn_s_barrier(); asm volatile("" ::: "memory");
#pragma unroll
        for (int bj = 0; bj < 2; ++bj)
#pragma unroll
            for (int np = 0; np < 2; ++np) {
                const int n0 = 16 * wc + 8 * np + 2 * fq;
                const f32x4 l4 = *(const LAS f32x4*)(laml + (bj * NS + n0) * 2);
                const cf lam0{l4[0], l4[1]}, lam1{l4[2], l4[3]};
                cf c0 = X[bj][np][0], c1 = X[bj][np][1];
                LAS unsigned char* crow = CIM + (128 * wr + fr) * 520 + (bj * 128 + 2 * n0) * 2;
#define SC_A0(j) cf{acc[(j) >> 2][bj][(j) & 3][np][0], acc[(j) >> 2][bj][(j) & 3][np][1]}
#define SC_A1(j) cf{acc[(j) >> 2][bj][(j) & 3][np][2], acc[(j) >> 2][bj][(j) & 3][np][3]}
#define SC_PUT(j) do { u32x2 w; w.x = cvt_pk_bf16(c0.r, c0.i); w.y = cvt_pk_bf16(c1.r, c1.i); *(LAS u32x2*)(crow + (j) * (16 * 520)) = w; } while (0)
                if (bj == 0) {
                    if (wr == 1) { const f32x4 t = *(const LAS f32x4*)(SEG + ((bj * 2 + 0) * 64 + n0) * 2); c0 = cmad(MX[np][0], cf{t[0], t[1]}, c0); c1 = cmad(MX[np][1], cf{t[2], t[3]}, c1); }
                    SC_PUT(0);
#pragma unroll
                    for (int j = 1; j < 8; ++j) { c0 = cmad(lam0, c0, SC_A0(j - 1)); c1 = cmad(lam1, c1, SC_A1(j - 1)); SC_PUT(j); }
                } else {
                    if (wr == 0) { const f32x4 t = *(const LAS f32x4*)(SEG + ((bj * 2 + 1) * 64 + n0) * 2); c0 = cmad(MX[np][0], cf{t[0], t[1]}, c0); c1 = cmad(MX[np][1], cf{t[2], t[3]}, c1); }
                    SC_PUT(7);
#pragma unroll
                    for (int j = 6; j >= 0; --j) { c0 = cmad(lam0, c0, SC_A0(j + 1)); c1 = cmad(lam1, c1, SC_A1(j + 1)); SC_PUT(j); }
                }
#undef SC_A0
#undef SC_A1
#undef SC_PUT
            }
#undef SC_A
        LDS_WAIT(); __builtin_amdgcn_s_barrier(); asm volatile("" ::: "memory");
#pragma unroll 8
        for (int r = wid; r < 256; r += 8) { const int c = (r & 128) + 8 * (r & 15) + ((r >> 4) & 7);
            *(u32x2*)(ussm + ((size_t)(u.g * NCR + u.pm * NCHB + c) * ROWLEN + K1) + 4 * lane) = *(const LAS u32x2*)(CIM + r * 520 + 8 * lane); }
    }
};
struct EpiZ {
    static constexpr bool PERM = true, AFTER_DRAIN = false, HAS_MID = false; static constexpr int MID_T = 0; static constexpr bool HAS_PRE = false, HAS_UNIT = false;
    const bf16_t* ussm; const float* dvec; bf16_t* zg;
    __device__ __forceinline__ void operator()(Acc& acc, const Unit& u, int wr, int wc, int fr, int fq) const {
        u32x4 uw[2][2][4];
        f32x4 dd[2][2];
#pragma unroll
        for (int bj = 0; bj < 2; ++bj) {
            const int c8 = u.pn * BM + bj * HALF + wc * 32 + 8 * fq;
            dd[bj][0] = *(const f32x4*)(dvec + u.g * 16 + (c8 & 15)); dd[bj][1] = *(const f32x4*)(dvec + u.g * 16 + (c8 & 15) + 4);
#pragma unroll
            for (int ai = 0; ai < 2; ++ai)
#pragma unroll
                for (int m = 0; m < 4; ++m) { const int cr = u.pm * BM + ai * HALF + wr * 64 + m * 16 + fr; uw[bj][ai][m] = *(const u32x4*)(ussm + ((size_t)(u.g * NCR + cr) * ROWLEN + c8)); }
        }
#pragma unroll
        for (int bj = 0; bj < 2; ++bj) {
            const int c8 = u.pn * BM + bj * HALF + wc * 32 + 8 * fq;
#pragma unroll
            for (int ai = 0; ai < 2; ++ai)
#pragma unroll
                for (int m = 0; m < 4; ++m) {
                    const int cr = u.pm * BM + ai * HALF + wr * 64 + m * 16 + fr;
                    f32x4 u0, u1; unpack8(uw[bj][ai][m], u0, u1);
                    f32x4 y0 = acc[ai][bj][m][0] + dd[bj][0] * u0, y1 = acc[ai][bj][m][1] + dd[bj][1] * u1;
                    y0 = fast_gelu_tanh4(y0); y1 = fast_gelu_tanh4(y1);
                    st_wt16(zg + ((size_t)u.g * MT * 16 + (size_t)cr * K1 + c8), pack8(y0, y1));
                }
        }
    }
};
struct EpiPool {
    static constexpr bool PERM = true, AFTER_DRAIN = false, HAS_MID = false; static constexpr int MID_T = 0; static constexpr bool HAS_PRE = false, HAS_UNIT = false;
    const float* pscale; bf16_t* ycat; float* ss;
    __device__ __forceinline__ void operator()(Acc& acc, const Unit& u, int wr, int wc, int fr, int fq) const {
        f32x4 sc[2][2];
#pragma unroll
        for (int bj = 0; bj < 2; ++bj) { const int c8 = u.pn * BM + bj * HALF + wc * 32 + 8 * fq; sc[bj][0] = *(const f32x4*)(pscale + c8); sc[bj][1] = *(const f32x4*)(pscale + c8 + 4); }
#pragma unroll
        for (int ai = 0; ai < 2; ++ai)
#pragma unroll
            for (int m = 0; m < 4; ++m) {
                const int row = u.pm * BM + ai * HALF + wr * 64 + m * 16 + fr; float q = 0.f;
#pragma unroll
                for (int bj = 0; bj < 2; ++bj) {
                    const int c8 = u.pn * BM + bj * HALF + wc * 32 + 8 * fq;
                    const f32x4 v0 = acc[ai][bj][m][0] * sc[bj][0], v1 = acc[ai][bj][m][1] * sc[bj][1];
                    q += sumsq8(v0, v1);
                    st_wt16(ycat + (size_t)row * DM + c8, pack8(v0, v1));
                }
                q += __shfl_xor(q, 16); q += __shfl_xor(q, 32);
                if (fq == 0) ss[(size_t)(u.pn * 4 + wc) * MT + row] = q;
            }
    }
};
struct EpiGlu {
    static constexpr bool PERM = true, AFTER_DRAIN = false, HAS_MID = false; static constexpr int MID_T = 0; static constexpr bool HAS_PRE = false, HAS_UNIT = false;
    const float* gb; const bf16_t* zg; bf16_t* ycat; float* ss;
    __device__ __forceinline__ void operator()(Acc& acc, const Unit& u, int wr, int wc, int fr, int fq) const {
        f32x4 bv[2][2]; u32x4 zw[2][4][2];
#pragma unroll
        for (int bj = 0; bj < 2; ++bj) { const int c8 = u.pn * BM + bj * HALF + wc * 32 + 8 * fq; bv[bj][0] = *(const f32x4*)(gb + c8); bv[bj][1] = *(const f32x4*)(gb + c8 + 4); }
#pragma unroll
        for (int ai = 0; ai < 2; ++ai)
#pragma unroll
            for (int m = 0; m < 4; ++m) { const int row = u.pm * BM + ai * HALF + wr * 64 + m * 16 + fr;
#pragma unroll
                for (int bj = 0; bj < 2; ++bj) { const int c8 = u.pn * BM + bj * HALF + wc * 32 + 8 * fq; zw[ai][m][bj] = *(const u32x4*)(zg + ((size_t)(c8 >> 4) * MT + row) * 16 + (c8 & 15)); } }
#pragma unroll
        for (int ai = 0; ai < 2; ++ai)
#pragma unroll
            for (int m = 0; m < 4; ++m) {
                const int row = u.pm * BM + ai * HALF + wr * 64 + m * 16 + fr; float q = 0.f;
#pragma unroll
                for (int bj = 0; bj < 2; ++bj) {
                    const int c8 = u.pn * BM + bj * HALF + wc * 32 + 8 * fq;
                    f32x4 z0, z1; unpack8(zw[ai][m][bj], z0, z1);
                    f32x4 v0 = acc[ai][bj][m][0] + bv[bj][0], v1 = acc[ai][bj][m][1] + bv[bj][1];
                    v0 = z0 * fast_sigmoid4(v0); v1 = z1 * fast_sigmoid4(v1);
                    q += sumsq8(v0, v1);
                    st_wt16(ycat + (size_t)row * DM + DPOOL + c8, pack8(v0, v1));
                }
                q += __shfl_xor(q, 16); q += __shfl_xor(q, 32);
                if (fq == 0) ss[(size_t)(u.pn * 4 + wc) * MT + row] = q;
            }
    }
};
struct EpiOut {
    static constexpr bool PERM = true, AFTER_DRAIN = true, HAS_MID = true; static constexpr int MID_T = 8; static constexpr bool HAS_PRE = true, HAS_UNIT = false;
    const bf16_t* xb; bf16_t* h1b; float* ss; LAS f32x2* XR; float ratio[2][4];
    const float* sp; const float* sm;
    template <class Sched> __device__ __forceinline__ void pre(const Sched& S, int tid) {
        Unit u0;
        if (S.next(0, u0) && tid < 256) { const int row = u0.pm * BM + tid; float a0 = 0.f, a1 = 0.f;
#pragma unroll
            for (int k = 0; k < 8; ++k) { a0 += sp[(size_t)k * MT + row]; a1 += sm[(size_t)k * MT + row]; }
            const float rp = rsqrtf(a0 * (1.0f / DPOOL) + EPS), rsm = rsqrtf(a1 * (1.0f / DSSM) + EPS); XR[tid] = (f32x2){rp / rsm, rsm}; }
        __syncthreads();
        const int wr_ = tid >> 8, fr_ = tid & 15;
#pragma unroll
        for (int ai = 0; ai < 2; ++ai)
#pragma unroll
            for (int m = 0; m < 4; ++m) ratio[ai][m] = XR[ai * HALF + wr_ * 64 + m * 16 + fr_].x;
    }
    __device__ __forceinline__ void mid(Acc& acc, int wr, int fr) const {
#pragma unroll
        for (int ai = 0; ai < 2; ++ai)
#pragma unroll
            for (int m = 0; m < 4; ++m) { const float ratio = this->ratio[ai][m];
#pragma unroll
                for (int bj = 0; bj < 2; ++bj)
#pragma unroll
                    for (int n = 0; n < 2; ++n) acc[ai][bj][m][n] = acc[ai][bj][m][n] * ratio; }
    }
    __device__ __forceinline__ void fused(Acc& acc, const Unit& u, int wr, int wc, int fr, int fq, LAS unsigned char* lds, int wid, int lane) const {
        LAS float* P = (LAS float*)lds;
        const int col0 = u.pn * BM + wc * 32 + 8 * fq;
        u32x4 xw[2][4][2];
#pragma unroll
        for (int ai = 0; ai < 2; ++ai)
#pragma unroll
            for (int m = 0; m < 4; ++m)
#pragma unroll
                for (int bj = 0; bj < 2; ++bj) xw[ai][m][bj] = *(const u32x4*)(xb + (size_t)(u.pm * BM + ai * HALF + wr * 64 + m * 16 + fr) * DM + col0 + bj * HALF);
#pragma unroll
        for (int ai = 0; ai < 2; ++ai)
#pragma unroll
            for (int m = 0; m < 4; ++m) {
                const int lr = ai * HALF + wr * 64 + m * 16 + fr, row = u.pm * BM + lr; const float rs = XR[lr].y; float q = 0.f;
                const size_t prow = (size_t)(row >> 12) * PADROWS + 1 + (row & 4095);
#pragma unroll
                for (int bj = 0; bj < 2; ++bj) {
                    const int c = col0 + bj * HALF;
                    f32x4 x0, x1; unpack8(xw[ai][m][bj], x0, x1);
                    const f32x4 h0 = x0 + acc[ai][bj][m][0] * rs, h1v = x1 + acc[ai][bj][m][1] * rs;
                    q += sumsq8(h0, h1v);
                    st_wt16(h1b + prow * DM + c, pack8(h0, h1v));
                }
                q += __shfl_xor(q, 16); q += __shfl_xor(q, 32);
                if (fq == 0) P[lr * 4 + wc] = q;
            }
        LDS_WAIT(); __builtin_amdgcn_s_barrier(); asm volatile("" ::: "memory");
        const int tid = wid * 64 + lane;
        if (tid < 256) ss[(size_t)u.pn * MT + u.pm * BM + tid] = (P[tid * 4 + 0] + P[tid * 4 + 1]) + (P[tid * 4 + 2] + P[tid * 4 + 3]);
    }
};
struct EpiUp {
    static constexpr bool PERM = true, AFTER_DRAIN = false, HAS_MID = false; static constexpr int MID_T = 0; static constexpr bool HAS_PRE = true, HAS_UNIT = true;
    LAS float* rsl; const float* cw; const float* cb; bf16_t* act;
    const float* ssh1;
    static constexpr int TAB_OFF = XTRA_OFF + 6 * 256 * 4;
    static_assert(TAB_OFF + 2 * 4096 <= LDSCTL_OFF, "two filter slices (double-buffered by unit parity: waves leave the previous epilogue at different times) fit in the spare LDS");
    __device__ __forceinline__ void unit_top(const Unit& u, int tid, LAS unsigned char* lds) const {
        const int w = __builtin_amdgcn_readfirstlane(tid >> 6), l = tid & 63;
        if (w < 4) { const int row = 2 * w + (l >> 5), fc = 128 * u.pn + (l & 31) * 4, off = (row >= 4 ? DFF : 0) + fc;
            const float* src = (row & 3) < 3 ? cw + (row & 3) * DFF2 + off : cb + off;
            __builtin_amdgcn_global_load_lds((const unsigned*)src, (LAS unsigned*)(lds + TAB_OFF + (u.aux & 1) * 4096 + w * 1024), 16, 0, 0); }
    }
    template <class Sched> __device__ __forceinline__ void pre(const Sched& S, int tid) {
        if (tid < 256) {
#pragma unroll
            for (int i = 0; i < 6; ++i) { Unit uu; if (S.next(i, uu)) { const int t = UPROWS * uu.pm + tid - 1; const bool in = (t >= 0 && t < SEQ && tid < 254); const int tok = uu.g * SEQ + (in ? t : 0);
                const float sq = (ssh1[tok] + ssh1[MT + tok]) + (ssh1[2 * MT + tok] + ssh1[3 * MT + tok]); rsl[i * 256 + tid] = in ? rsqrtf(sq * (1.0f / DM) + EPS) : 0.f; } } }
        __syncthreads();
    }
    __device__ __forceinline__ void operator()(Acc& acc, const Unit& u, int wr, int wc, int fr, int fq) const {
        const int j = u.pm, b = u.g;
#pragma unroll
        for (int ai = 0; ai < 2; ++ai)
#pragma unroll
            for (int m = 0; m < 4; ++m) {
                const float rs = rsl[u.aux * 256 + 126 * wr + 64 * ai + 4 * fr + m];
#pragma unroll
                for (int bj = 0; bj < 2; ++bj)
#pragma unroll
                    for (int n = 0; n < 2; ++n) acc[ai][bj][m][n] = acc[ai][bj][m][n] * rs;
            }
        const int f0 = 128 * u.pn + 32 * wc + 8 * fq;
        u32x2 keep[8];
#pragma unroll
        for (int n = 0; n < 2; ++n) {
            const int fc = f0 + 4 * n;
            const LAS float* tab = rsl + 6 * 256 + (u.aux & 1) * 1024 + 32 * wc + 8 * fq + 4 * n;
            const f32x4 wv0 = *(const LAS f32x4*)(tab), wv1 = *(const LAS f32x4*)(tab + 128), wv2 = *(const LAS f32x4*)(tab + 256), bvv = *(const LAS f32x4*)(tab + 384);
            const f32x4 wg0 = *(const LAS f32x4*)(tab + 512), wg1 = *(const LAS f32x4*)(tab + 640), wg2 = *(const LAS f32x4*)(tab + 768), bgv = *(const LAS f32x4*)(tab + 896);
#pragma unroll
            for (int ai = 0; ai < 2; ++ai) {
                f32x4 pv, pg, nv, ng;
#pragma unroll
                for (int i = 0; i < 4; ++i) {
                    pv[i] = dpp_ror1(fr == 15 ? acc[ai ^ 1][0][3][n][i] : acc[ai][0][3][n][i]); pg[i] = dpp_ror1(fr == 15 ? acc[ai ^ 1][1][3][n][i] : acc[ai][1][3][n][i]);
                    nv[i] = dpp_ror15(fr == 0 ? acc[ai ^ 1][0][0][n][i] : acc[ai][0][0][n][i]); ng[i] = dpp_ror15(fr == 0 ? acc[ai ^ 1][1][0][n][i] : acc[ai][1][0][n][i]);
                }
#pragma unroll
                for (int m = 0; m < 4; ++m) {
                    const f32x4 cv = acc[ai][0][m][n], cg = acc[ai][1][m][n];
                    const f32x4 v_prev = m > 0 ? acc[ai][0][m - 1][n] : pv, g_prev = m > 0 ? acc[ai][1][m - 1][n] : pg;
                    const f32x4 v_next = m < 3 ? acc[ai][0][m + 1][n] : nv, g_next = m < 3 ? acc[ai][1][m + 1][n] : ng;
                    const f32x4 vv = bvv + wv0 * v_prev + wv1 * cv + wv2 * v_next;
                    const f32x4 gg = bgv + wg0 * g_prev + wg1 * cg + wg2 * g_next;
                    const f32x4 o = vv * gg * fast_sigmoid4(gg);
                    const u32x2 pk = pack4(o); const int gi = ai * 4 + m;
                    if (n == 0) keep[gi] = pk;
                    else { const int w = 64 * ai + 4 * fr + m, t = UPROWS * j + 126 * wr + w - 1;
                           if (t >= 0 && t < SEQ && w >= 1 && w <= 126) { u32x4 wv; wv.x = keep[gi].x; wv.y = keep[gi].y; wv.z = pk.x; wv.w = pk.y; st_wt16(act + (size_t)(b * SEQ + t) * DFF + f0, wv); } }
                }
            }
        }
    }
};
struct EpiDown {
    static constexpr bool PERM = true, AFTER_DRAIN = true, HAS_MID = false; static constexpr int MID_T = 0; static constexpr bool HAS_PRE = false, HAS_UNIT = false;
    const bf16_t* h1b; float* out; const float* gfin; float* ss;
    __device__ __forceinline__ void fused(Acc& acc, const Unit& u, int wr, int wc, int fr, int fq, LAS unsigned char* lds, int wid, int lane) const {
        LAS float* P = (LAS float*)lds;
        LAS float* Sr = (LAS float*)(lds + 8192);
        const int col0 = u.pn * BM + wc * 32 + 8 * fq;
#pragma unroll
        for (int ai = 0; ai < 2; ++ai)
#pragma unroll
            for (int m = 0; m < 4; ++m) {
                const int lr = ai * HALF + wr * 64 + m * 16 + fr, row = u.pm * BM + lr; float q = 0.f;
                const size_t prow = (size_t)(row >> 12) * PADROWS + 1 + (row & 4095);
#pragma unroll
                for (int bj = 0; bj < 2; ++bj) {
                    f32x4 b0, b1; unpack8(*(const u32x4*)(h1b + prow * DM + col0 + bj * HALF), b0, b1);
                    const f32x4 h0 = b0 + acc[ai][bj][m][0], h1v = b1 + acc[ai][bj][m][1];
                    acc[ai][bj][m][0] = h0; acc[ai][bj][m][1] = h1v;
                    q += sumsq8(h0, h1v);
                }
                q += __shfl_xor(q, 16); q += __shfl_xor(q, 32);
                if (fq == 0) P[lr * 4 + wc] = q;
            }
        LDS_WAIT(); __builtin_amdgcn_s_barrier(); asm volatile("" ::: "memory");
        const int tid = wid * 64 + lane;
        f32x4 gg[2][2];
#pragma unroll
        for (int bj = 0; bj < 2; ++bj) { gg[bj][0] = *(const f32x4*)(gfin + col0 + bj * HALF); gg[bj][1] = *(const f32x4*)(gfin + col0 + bj * HALF + 4); }
        if (tid < 256) { unsigned* sr = (unsigned*)ss + u.pm * BM + tid;
            __hip_atomic_store(sr + (size_t)u.pn * MT, __builtin_bit_cast(unsigned, (P[tid * 4 + 0] + P[tid * 4 + 1]) + (P[tid * 4 + 2] + P[tid * 4 + 3])), __ATOMIC_RELAXED, __HIP_MEMORY_SCOPE_AGENT);
            unsigned v0, v1, v2, v3, sp = 0;
            for (;;) {
                v0 = __hip_atomic_load(sr, __ATOMIC_RELAXED, __HIP_MEMORY_SCOPE_AGENT); v1 = __hip_atomic_load(sr + MT, __ATOMIC_RELAXED, __HIP_MEMORY_SCOPE_AGENT);
                v2 = __hip_atomic_load(sr + 2 * MT, __ATOMIC_RELAXED, __HIP_MEMORY_SCOPE_AGENT); v3 = __hip_atomic_load(sr + 3 * MT, __ATOMIC_RELAXED, __HIP_MEMORY_SCOPE_AGENT);
                if ((v0 != 0xFFFFFFFFu && v1 != 0xFFFFFFFFu && v2 != 0xFFFFFFFFu && v3 != 0xFFFFFFFFu) || ++sp > (1u << 20)) break;
                __builtin_amdgcn_s_sleep(1); }
            const float s = (__builtin_bit_cast(float, v0) + __builtin_bit_cast(float, v1)) + (__builtin_bit_cast(float, v2) + __builtin_bit_cast(float, v3));
            Sr[tid] = rsqrtf(s * (1.0f / DM) + EPS); }
        LDS_WAIT(); __builtin_amdgcn_s_barrier(); asm volatile("" ::: "memory");
#pragma unroll
        for (int bj = 0; bj < 2; ++bj) {
            const int c = col0 + bj * HALF; const f32x4 g0 = gg[bj][0], g1 = gg[bj][1];
#pragma unroll
            for (int ai = 0; ai < 2; ++ai)
#pragma unroll
                for (int m = 0; m < 4; ++m) { const int lr = ai * HALF + wr * 64 + m * 16 + fr; const float r = Sr[lr]; float* o = out + (size_t)(u.pm * BM + lr) * DM + c;
                    *(f32x4*)o = acc[ai][bj][m][0] * r * g0; *(f32x4*)(o + 4) = acc[ai][bj][m][1] * r * g1; }
        }
    }
};

struct OrdOne { Unit u; __device__ bool next(int i, Unit& o) const { if (i > 0) return false; o = u; return true; } };
struct OrdSsmB { int c; __device__ bool next(int i, Unit& u) const { if (i > 0 || c >= 128) return false; const int x = c & 7, k = c >> 3; u.g = x * 4 + (k >> 2); u.pm = k & 3; u.pn = 0; u.aux = 0; return true; } };
struct OrdPool { int c; __device__ bool next(int i, Unit& u) const { if (i > 0 || c < 128 || c >= 256) return false; const int cc = c - 128, x = cc & 7, k = cc >> 3; u.pm = x * 8 + (k >> 1); u.pn = k & 1; u.g = u.pn; u.aux = 0; return true; } };
struct OrdGlu  { int c; __device__ bool next(int i, Unit& u) const { if (i > 0 || c >= 128) return false; const int x = c & 7, k = c >> 3; u.pm = x * 8 + (k >> 1); u.pn = k & 1; u.g = 0; u.aux = 0; return true; } };
struct OrdUp { StaticOrder so; __device__ bool next(int i, Unit& u) const { if (!so.next(i, u)) return false; u.g = u.pm / UPT; u.pm = u.pm % UPT; u.aux = i; return true; } };

struct Args { const float* in[24]; float* out; unsigned char* ws; int ph_lo, ph_hi; };

struct Frame { LAS unsigned char* lds; int tid, lane, wave, G, bx; };

struct TrMat { const float* W; int K, N; const float* kg0; const float* kg1; int ksplit; bf16_t* WT; int map; int nitems; };
__device__ __forceinline__ void tr_load(const TrMat& m0, const TrMat& m1, int item, int lane, f32x4 (&v)[8]) {
    const bool second = item >= m0.nitems; const TrMat& m = second ? m1 : m0; const int it = second ? item - m0.nitems : item;
    const int nblk = m.N / 32, kb = it / nblk, nb = it % nblk, k0 = 64 * kb, n0 = 32 * nb, r = lane >> 3, c4 = lane & 7;
#pragma unroll
    for (int i = 0; i < 8; ++i) v[i] = __builtin_nontemporal_load((const f32x4*)(m.W + (size_t)(k0 + 8 * i + r) * m.N + n0 + 4 * c4));
}
__device__ __forceinline__ void tr_store(const TrMat& m0, const TrMat& m1, int item, int lane, const f32x4 (&v)[8], LAS float* scr) {
    const bool second = item >= m0.nitems; const TrMat& m = second ? m1 : m0; const int it = second ? item - m0.nitems : item;
    const int nblk = m.N / 32, kb = it / nblk, nb = it % nblk, k0 = 64 * kb, n0 = 32 * nb, r = lane >> 3, c4 = lane & 7;
#pragma unroll
    for (int i = 0; i < 8; ++i) { const int kk = 8 * i + r, k = k0 + kk; float gn = 1.f; if (m.kg0) gn = (k < m.ksplit ? m.kg0[k] : m.kg1[k - m.ksplit]);
        LAS float* d = scr + kk * 33 + 4 * c4; d[0] = v[i][0] * gn; d[1] = v[i][1] * gn; d[2] = v[i][2] * gn; d[3] = v[i][3] * gn; }
    LDS_WAIT(); asm volatile("" ::: "memory");
    const int c = lane & 7;
#pragma unroll
    for (int j = 0; j < 4; ++j) { const int n = (lane >> 3) + 8 * j; const LAS float* q = scr + (8 * c) * 33 + n;
        u32x4 o; o.x = pk2(q[0 * 33], q[1 * 33]); o.y = pk2(q[2 * 33], q[3 * 33]); o.z = pk2(q[4 * 33], q[5 * 33]); o.w = pk2(q[6 * 33], q[7 * 33]);
        int nr = n0 + n;
        if (m.map == 1) { const int bj = nr / DFF, rem = nr % DFF; nr = 256 * (rem >> 7) + 128 * bj + (rem & 127); }
        *(u32x4*)(m.WT + (size_t)nr * m.K + k0 + 8 * c) = o; }
    LDS_WAIT(); asm volatile("" ::: "memory");
}
__device__ __forceinline__ void tr_run(const TrMat& m0, const TrMat& m1, int first, int stride, int lane, LAS float* scr) {
    const int total = m0.nitems + m1.nitems; f32x4 va[8], vb[8];
    int it = first; if (it < total) tr_load(m0, m1, it, lane, va);
    while (it < total) {
        const int n1 = it + stride; if (n1 < total) tr_load(m0, m1, n1, lane, vb);
        tr_store(m0, m1, it, lane, va, scr);
        if (n1 >= total) break;
        const int n2 = n1 + stride; if (n2 < total) tr_load(m0, m1, n2, lane, va);
        tr_store(m0, m1, n1, lane, vb, scr);
        it = n2;
    }
}

struct SsmLds { LAS float* Bre; LAS float* Bim; LAS float* Cre; LAS float* Cim; LAS float* PAR; LAS float* Pc; LAS float* Kl; };
__device__ __forceinline__ SsmLds ssm_lds(const Frame& F) { SsmLds L; L.Bre = (LAS float*)(F.lds); L.Bim = L.Bre + 2048; L.Cre = L.Bim + 2048; L.Cim = L.Cre + 2048; L.PAR = L.Cim + 2048; L.Pc = L.PAR + 512; L.Kl = L.Pc + 1024; return L; }
__device__ __forceinline__ void ssm_stage(const Args& a, const Frame& F, const SsmLds& L, int g) {
    const float* lnar = a.in[5]; const float* aim = a.in[6]; const float* ldt = a.in[7];
    const float* bre = a.in[8]; const float* bim = a.in[9]; const float* cre = a.in[10]; const float* cim = a.in[11];
    const int tid = F.tid;
    for (int i = tid; i < 2048; i += 512) { const int dir = i >> 10, r = i & 1023;
        L.Bre[i] = bre[((size_t)(dir * NG + g)) * 1024 + r]; L.Bim[i] = bim[((size_t)(dir * NG + g)) * 1024 + r];
        L.Cre[i] = cre[((size_t)(dir * NG + g)) * 1024 + r]; L.Cim[i] = cim[((size_t)(dir * NG + g)) * 1024 + r]; }
    if (tid < 128) { const int dir = tid >> 6, n = tid & 63;
        const float dt = expf(ldt[dir * NG + g]); const float a_re = -expf(lnar[(dir * NG + g) * NS + n]), a_im = aim[(dir * NG + g) * NS + n];
        const float mag = expf(a_re * dt), ang = a_im * dt; const float lam_re = mag * cosf(ang), lam_im = mag * sinf(ang);
        const float den = a_re * a_re + a_im * a_im;
        L.PAR[tid * 4 + 0] = a_re * dt; L.PAR[tid * 4 + 1] = ang;
        L.PAR[tid * 4 + 2] = ((lam_re - 1.0f) * a_re + lam_im * a_im) / den; L.PAR[tid * 4 + 3] = (lam_im * a_re - (lam_re - 1.0f) * a_im) / den; }
    __syncthreads();
}
__device__ __forceinline__ void ssm_build_tb(const Args& a, const Frame& F, const SsmLds& L, int g, int lag0, int nl) {
    bf16_t* KC = (bf16_t*)(a.ws + WS_TB) + (size_t)g * (2 * TCH) * 256;
    bf16_t* TBC = (bf16_t*)(a.ws + WS_TBC) + (size_t)g * K1 * 256;
    const int tid = F.tid;
    { const int li = tid >> 7, dn = tid & 127, lag = lag0 + li; const float ad = L.PAR[dn * 4 + 0], ang = L.PAR[dn * 4 + 1], fr_ = L.PAR[dn * 4 + 2], fi_ = L.PAR[dn * 4 + 3];
      const float mg = expf((float)lag * ad); float sn, cs; sincosf((float)lag * ang, &sn, &cs); const float lr = mg * cs, lim = mg * sn;
      L.Pc[(li * 128 + dn) * 2 + 0] = lr * fr_ - lim * fi_; L.Pc[(li * 128 + dn) * 2 + 1] = lr * fi_ + lim * fr_; }
    __syncthreads();
    { const int li = F.wave >> 1, dir = F.wave & 1, i16 = F.lane & 15, kq = F.lane >> 4; f32x4 kacc = {0.f, 0.f, 0.f, 0.f};
#pragma unroll 8
      for (int kk0 = 0; kk0 < 128; kk0 += 4) { const int kk = kk0 + kq, n = kk >> 1; const bool im = (kk & 1) != 0;
          const float cr_ = L.Cre[dir * 1024 + i16 * 64 + n], ci_ = L.Cim[dir * 1024 + i16 * 64 + n], pr = L.Pc[(li * 128 + dir * 64 + n) * 2], pi = L.Pc[(li * 128 + dir * 64 + n) * 2 + 1];
          const float av = im ? -(cr_ * pi + ci_ * pr) : (cr_ * pr - ci_ * pi);
          const float bv = im ? L.Bim[dir * 1024 + n * 16 + i16] : L.Bre[dir * 1024 + n * 16 + i16];
          kacc = __builtin_amdgcn_mfma_f32_16x16x4f32(av, bv, kacc, 0, 0, 0); }
#pragma unroll
      for (int r = 0; r < 4; ++r) L.Kl[li * 512 + dir * 256 + (kq * 4 + r) * 16 + i16] = kacc[r]; }
    __syncthreads();
    { const int li = tid >> 7, dir = (tid >> 6) & 1, e4 = tid & 63, lag = lag0 + li;
      if (li < nl && !(lag == 0 && dir == 1)) {
          f32x4 v = *(const LAS f32x4*)(L.Kl + li * 512 + dir * 256 + 4 * e4);
          if (lag == 0) v = v + *(const LAS f32x4*)(L.Kl + li * 512 + 256 + 4 * e4);
          const int d = dir == 0 ? (TCH - 1) + lag : (TCH - 1) - lag; u32x2 w; w.x = pk2(v[0], v[1]); w.y = pk2(v[2], v[3]);
          st_wt8(KC + (size_t)d * 256 + 4 * e4, w); } }
    __syncthreads();
    { const int li = tid >> 7, dn = tid & 127, dir = dn >> 6, p = lag0 + li; const float ad = L.PAR[dn * 4 + 0], ang = L.PAR[dn * 4 + 1]; const float e = dir == 0 ? (float)(p + 1) : (float)(TCH - p);
      const float mg = expf(e * ad); float sn, cs; sincosf(e * ang, &sn, &cs); L.Pc[(li * 128 + dn) * 2 + 0] = mg * cs; L.Pc[(li * 128 + dn) * 2 + 1] = mg * sn; }
    __syncthreads();
    for (int li = 0; li < nl; ++li) {
        const int p = lag0 + li, h = tid >> 5, dir = (tid >> 4) & 1, n4 = tid & 15; float v[8];
#pragma unroll
        for (int e = 0; e < 4; ++e) { const int n = 4 * n4 + e; const float cr_ = L.Cre[dir * 1024 + h * 64 + n], ci_ = L.Cim[dir * 1024 + h * 64 + n], pr = L.Pc[(li * 128 + dir * 64 + n) * 2], pi = L.Pc[(li * 128 + dir * 64 + n) * 2 + 1];
            v[2 * e] = cr_ * pr - ci_ * pi; v[2 * e + 1] = -(cr_ * pi + ci_ * pr); }
        u32x4 w; w.x = pk2(v[0], v[1]); w.y = pk2(v[2], v[3]); w.z = pk2(v[4], v[5]); w.w = pk2(v[6], v[7]);
        st_wt16(TBC + (size_t)(16 * p + h) * 256 + dir * 128 + 8 * n4, w);
    }
    __syncthreads();
}
__device__ __forceinline__ void ssm_build_wab(const Args& a, const Frame& F, const SsmLds& L, int g, int jq) {
    bf16_t* WAB = (bf16_t*)(a.ws + WS_WAB) + (size_t)g * 256 * K1;
    const int tid = F.tid;
    if (jq == 0 && tid < 128) { const int dir = tid >> 6, n = tid & 63; const float ad = L.PAR[tid * 4 + 0], ang = L.PAR[tid * 4 + 1];
        const float mg = expf((float)TCH * ad); float sn, cs; sincosf((float)TCH * ang, &sn, &cs); *(f32x2*)((float*)(a.ws + WS_LAMT) + ((size_t)(dir * NG + g) * NS + n) * 2) = (f32x2){mg * cs, mg * sn}; }
    { const int li = tid >> 7, dn = tid & 127, dir = dn >> 6, q = 4 * jq + li; const float ad = L.PAR[dn * 4 + 0], ang = L.PAR[dn * 4 + 1], fr_ = L.PAR[dn * 4 + 2], fi_ = L.PAR[dn * 4 + 3]; const float e = dir == 0 ? (float)(TCH - 1 - q) : (float)q;
      const float mg = expf(e * ad); float sn, cs; sincosf(e * ang, &sn, &cs); const float lr = mg * cs, lim = mg * sn;
      L.Pc[(li * 128 + dn) * 2 + 0] = lr * fr_ - lim * fi_; L.Pc[(li * 128 + dn) * 2 + 1] = lr * fi_ + lim * fr_; }
    __syncthreads();
#pragma unroll
    for (int half = 0; half < 2; ++half) {
        const int li = 2 * half + (tid >> 8), q = 4 * jq + li, t2 = tid & 255, dir = t2 >> 7, n = (t2 >> 1) & 63, part = t2 & 1;
        const float pr = L.Pc[(li * 128 + dir * 64 + n) * 2], pi = L.Pc[(li * 128 + dir * 64 + n) * 2 + 1]; float v[16];
#pragma unroll
        for (int i = 0; i < 16; ++i) { const float br_ = L.Bre[dir * 1024 + n * 16 + i], bi_ = L.Bim[dir * 1024 + n * 16 + i]; v[i] = part == 0 ? (pr * br_ - pi * bi_) : (pr * bi_ + pi * br_); }
        u32x4 w0, w1; w0.x = pk2(v[0], v[1]); w0.y = pk2(v[2], v[3]); w0.z = pk2(v[4], v[5]); w0.w = pk2(v[6], v[7]); w1.x = pk2(v[8], v[9]); w1.y = pk2(v[10], v[11]); w1.z = pk2(v[12], v[13]); w1.w = pk2(v[14], v[15]);
        bf16_t* dst = WAB + (size_t)(dir * 128 + 2 * n + part) * K1 + 16 * q; *(u32x4*)dst = w0; *(u32x4*)(dst + 8) = w1;
    }
    __syncthreads();
}

__device__ __forceinline__ void p0_prologue(const Args& a, const Frame& F) {
    const float* x = a.in[0];
    { const SsmLds L = ssm_lds(F);
      for (int it = F.bx; it < NG * (TCH / 4); it += F.G) { ssm_stage(a, F, L, it / (TCH / 4)); ssm_build_wab(a, F, L, it / (TCH / 4), it % (TCH / 4)); } }
    __syncthreads();
    LAS float* scr = (LAS float*)(F.lds + F.wave * 16384);
    const int gw = F.bx * 8 + F.wave, NGW = F.G * 8;
    { const TrMat m0{a.in[2], DM, DM, a.in[1], a.in[1], DM, (bf16_t*)(a.ws + WS_WIN), 0, (DM / 64) * (DM / 32)}; const TrMat m1{nullptr, 0, 32, nullptr, nullptr, 0, nullptr, 0, 0};
      tr_run(m0, m1, F.wave < 2 ? F.bx * 2 + F.wave : m0.nitems, m0.nitems, F.lane, scr); }
    { bf16_t* PW = (bf16_t*)(a.ws + WS_PW); const float* pw = a.in[3];
      for (int idx = F.bx * 512 + F.tid; idx < 2 * 256 * 256; idx += F.G * 512) { const int pn = idx >> 16, j = (idx >> 8) & 255, k = idx & 255;
          const float v = ((j >> 7) == (k >> 7)) ? pw[((size_t)(2 * pn + (j >> 7)) * 128 + (k & 127)) * 128 + (j & 127)] : 0.f; PW[idx] = (bf16_t)f2bf(v); } }
    { bf16_t* h1b = (bf16_t*)(a.ws + WS_H1B);
      for (int idx = F.bx * 512 + F.tid; idx < BATCH * 256 * (DM / 8); idx += F.G * 512) { const int b = idx / (256 * 128), r = (idx / 128) % 256, c = idx % 128; const int prow = b * PADROWS + (r == 0 ? 0 : 4096 + r);
          *(u32x4*)(h1b + (size_t)prow * DM + 8 * c) = (u32x4){0u, 0u, 0u, 0u}; } }
    { unsigned* s2 = (unsigned*)(a.ws + WS_SSH2);
      for (int idx = F.bx * 512 + F.tid; idx < 4 * MT; idx += F.G * 512) s2[idx] = 0xFFFFFFFFu; }
    { bf16_t* xb = (bf16_t*)(a.ws + WS_XB); float* r0 = (float*)(a.ws + WS_R0);
      LAS unsigned* ctr = (LAS unsigned*)(F.lds + LDSCTL_OFF) + 16;
      for (;;) {
          unsigned r = 0; if (F.lane == 0) r = __hip_atomic_fetch_add(ctr, 1u, __ATOMIC_RELAXED, __HIP_MEMORY_SCOPE_WORKGROUP);
          const bool heavy = F.bx < NG * (TCH / 4), donor = F.bx >= F.G - NG * (TCH / 4);
          r = (unsigned)__builtin_amdgcn_readfirstlane((int)r); if (r >= (heavy ? 48u : donor ? 80u : 64u)) break;
          const int row = r < 64u ? F.bx * 8 + (int)(r & 7u) + NGW * (int)(r >> 3) : (F.bx - (F.G - NG * (TCH / 4))) * 8 + (int)(r & 7u) + NGW * (6 + (int)((r - 64u) >> 3));
          const f32x4* xr = (const f32x4*)(x + (size_t)row * DM) + F.lane; f32x4 v[4]; float s = 0.f;
#pragma unroll
          for (int j = 0; j < 4; ++j) { v[j] = __builtin_nontemporal_load(xr + 64 * j); s += (v[j][0] * v[j][0] + v[j][1] * v[j][1]) + (v[j][2] * v[j][2] + v[j][3] * v[j][3]); }
          s = wave_sum(s); if (F.lane == 0) r0[row] = rsqrtf(s * (1.0f / DM) + EPS);
          u32x2* o = (u32x2*)(xb + (size_t)row * DM) + F.lane;
#pragma unroll
          for (int j = 0; j < 4; ++j) o[64 * j] = pack4(v[j]);
      } }
}

__device__ __forceinline__ void ssm_side(const Args& a, const Frame& F, int first_block) {
    const int nb = F.G - first_block, sb = F.bx - first_block;
    { const SsmLds L = ssm_lds(F);
      const int g = sb >> 2, lag0 = (sb & 3) * 4;
      ssm_stage(a, F, L, g); ssm_build_tb(a, F, L, g, lag0, 4);
      VM_WAIT(); __syncthreads();
      if (F.tid == 0) {
          __hip_atomic_fetch_add((unsigned*)(a.ws + WS_CTL) + CW_TBCNT + 64 * g, 4u, __ATOMIC_RELAXED, __HIP_MEMORY_SCOPE_AGENT); } }
    __syncthreads();
    LAS float* scr = (LAS float*)(F.lds + F.wave * 16384);
    const TrMat m0{a.in[17], DM, DM, a.in[15], a.in[16], DPOOL, (bf16_t*)(a.ws + WS_WOUT), 0, (DM / 64) * (DM / 32)};
    const TrMat m1{a.in[13], DSSM, DSSM, nullptr, nullptr, 0, (bf16_t*)(a.ws + WS_WGLU), 0, (DSSM / 64) * (DSSM / 32)};
    tr_run(m0, m1, sb * 8 + F.wave, nb * 8, F.lane, scr);
    const TrMat m2{a.in[22], DFF, DM, nullptr, nullptr, 0, (bf16_t*)(a.ws + WS_WDOWN), 0, (DFF / 64) * (DM / 32)}; const TrMat m3{nullptr, 0, 32, nullptr, nullptr, 0, nullptr, 0, 0};
    { const int W = nb * 8, n01 = m0.nitems + m1.nitems;
      tr_run(m2, m3, (sb * 8 + F.wave + W - n01 % W) % W, W, F.lane, scr); }
}
__device__ __forceinline__ void tb_wait(const Args& a, const Frame& F, int g) {
    if (F.tid == 0) { unsigned* cnt = (unsigned*)(a.ws + WS_CTL) + CW_TBCNT + 64 * g; unsigned sp = 0;
        while (__hip_atomic_load(cnt, __ATOMIC_RELAXED, __HIP_MEMORY_SCOPE_AGENT) < (unsigned)TCH) { __builtin_amdgcn_s_sleep(2); if (++sp > (1u << 20)) break; }
        __builtin_amdgcn_fence(__ATOMIC_ACQUIRE, "agent"); }
    asm volatile("s_waitcnt vmcnt(0)" ::: "memory");
    __syncthreads();
}
__device__ __forceinline__ void p4_side(const Args& a, const Frame& F, int first_block) {
    const int nb = F.G - first_block, sb = F.bx - first_block;
    LAS float* scr = (LAS float*)(F.lds + F.wave * 16384);
    const TrMat m0{a.in[19], DM, DFF2, a.in[18], a.in[18], DM, (bf16_t*)(a.ws + WS_WUP), 1, (DM / 64) * (DFF2 / 32)};
    const TrMat m1{nullptr, 0, 32, nullptr, nullptr, 0, nullptr, 0, 0};
    tr_run(m0, m1, sb * 8 + F.wave, nb * 8, F.lane, scr);
}

__device__ __forceinline__ void p2_pooled(const Args& a, const Frame& F, int first_block) {
    const bf16_t* up = (const bf16_t*)(a.ws + WS_UPOOL); bf16_t* po = (bf16_t*)(a.ws + WS_POOLED);
    const int gw = (F.bx - first_block) * 8 + F.wave, NGW = (F.G - first_block) * 8;
    const int c0 = 8 * F.lane, half = 1 << (F.lane >> 4);
    for (int blk = gw; blk < MT / 4; blk += NGW) {
        const int row0 = blk * 4, b = row0 / SEQ, t0 = row0 % SEQ;
        u32x4 w[19];
#pragma unroll
        for (int o = 0; o < 19; ++o) { int q = t0 + o - 8; q = q < 0 ? 0 : (q >= SEQ ? SEQ - 1 : q); w[o] = *(const u32x4*)(up + (size_t)(b * SEQ + q) * DPOOL + c0); }
#pragma unroll
        for (int r = 0; r < 4; ++r) {
            f32x4 s0 = {0.f, 0.f, 0.f, 0.f}, s1 = {0.f, 0.f, 0.f, 0.f}; float cnt = 0.f;
#pragma unroll
            for (int d = -8; d < 8; ++d) { const int q = t0 + r + d; const float m = (d >= -half && d < half && q >= 0 && q < SEQ) ? 1.f : 0.f; f32x4 a0, a1; unpack8(w[r + d + 8], a0, a1); s0 = s0 + a0 * m; s1 = s1 + a1 * m; cnt += m; }
            f32x4 c0v, c1v; unpack8(w[r + 8], c0v, c1v);
            const float inv = __builtin_amdgcn_rcpf(cnt);
            *(u32x4*)(po + (size_t)(row0 + r) * DPOOL + c0) = pack8(s0 * inv - c0v, s1 * inv - c1v);
        }
    }
}

__global__ void __launch_bounds__(512, 2) mk_fwd(Args args) {
    extern __shared__ __attribute__((aligned(16))) unsigned char lds_raw[];
    Frame F; F.lds = (LAS unsigned char*)lds_raw; F.tid = threadIdx.x; F.lane = F.tid & 63; F.wave = __builtin_amdgcn_readfirstlane(F.tid >> 6); F.G = gridDim.x; F.bx = blockIdx.x;
    volatile LAS unsigned* MISC = (volatile LAS unsigned*)(F.lds + LDSCTL_OFF);
    for (int u = F.tid; u < (LDS_BYTES - LDSCTL_OFF) / 4; u += 512) ((LAS unsigned*)(F.lds + LDSCTL_OFF))[u] = 0u;
    __syncthreads();
    unsigned char* ws = args.ws;
    XcdBarrier bar = xcd_barrier_post((unsigned*)(ws + WS_CTL), MISC + 8);
    const int lo = args.ph_lo, hi = args.ph_hi;
#define IN(k) (lo <= (k) && (k) < hi)
#define BOTH(k) (IN(k) && IN((k) == 2 ? 4 : (k) + 1))
    if (IN(0)) { p0_prologue(args, F); if (BOTH(0)) xcd_barrier(bar, F.tid); }
    if (IN(1)) { F.lane = lane_id_fresh(); F.tid = F.wave * 64 + F.lane;
        GemmDesc g{(const char*)(ws + WS_XB), (const char*)(ws + WS_WIN), 256L * DM * 2, 0, 256L * DM * 2, 0, 128L * DM * 2, 128L * DM * 2, 128, 128, DM / BK};
        unsigned vA[2], vB[2]; voff_std(vA, DM, false, F.tid); voff_std(vB, DM, true, F.tid);
        StaticOrder S; S.init(MT / BM, DM / BM, F.G, F.bx);
        EpiU E{(const float*)(ws + WS_R0), (bf16_t*)(ws + WS_UPOOL), (bf16_t*)(ws + WS_USSM), (LAS float*)(F.lds + XTRA_OFF)};
        gemm_phase<EpiU, StaticOrder, true>(F.lds, g, vA, vB, S, E, F.tid, nullptr);
        if (BOTH(1)) xcd_barrier(bar, F.tid);
    }
    if (IN(2)) { F.lane = lane_id_fresh(); F.tid = F.wave * 64 + F.lane;
        if (F.bx < 128) {
            OrdSsmB S0{F.bx}; Unit u0; S0.next(0, u0);
            { GemmDesc g{(const char*)(ws + WS_USSM), (const char*)(ws + WS_WAB), 256L * ROWLEN * 2, (long)NCR * ROWLEN * 2, 0, 256L * K1 * 2, 4L * ROWLEN * 2, 128L * K1 * 2, 128, 128, K1 / BK};
              unsigned vA[2], vB[2]; voff_std(vB, K1, false, F.tid);
#pragma unroll
              for (int i = 0; i < 2; ++i) { int R, C; stage_rc(F.tid * 16 + i * 8192, R, C);
                  vA[i] = (unsigned)(((128 * (R >> 6) + 8 * (R & 15) + ((R >> 4) & 3)) * ROWLEN + C) * 2); }
              OrdOne S{u0}; EpiScan E{(const float*)(ws + WS_LAMT), (bf16_t*)(ws + WS_USSM), (LAS float*)(F.lds + EpiScan::LAML_OFF)};
              gemm_phase<EpiScan, OrdOne, false>(F.lds, g, vA, vB, S, E, F.tid, nullptr); }
            tb_wait(args, F, u0.g);
            F.lane = lane_id_fresh(); F.tid = F.wave * 64 + F.lane;
            { GemmDesc g{(const char*)(ws + WS_USSM), (const char*)(ws + WS_TB), 256L * ROWLEN * 2, (long)NCR * ROWLEN * 2, 0, (2L * TCH) * 512, 128L * ROWLEN * 2, 8L * 512, 128, -4L * 512, ROWLEN / BK,
                         (const char*)(ws + WS_TBC), 0, (long)K1 * 512, 128L * 512, 128, K1 / BK};
              unsigned vA[2], vB[2], vB2[2]; voff_std(vA, ROWLEN, false, F.tid); voff_std(vB2, 256, true, F.tid);
#pragma unroll
              for (int i = 0; i < 2; ++i) { int R, C; stage_rc(F.tid * 16 + i * 8192, R, C); const int Rb = (R & ~31) + perm32(R & 31);
                  vB[i] = (unsigned)((((Rb >> 4) - (C >> 4) + (TCH - 1)) * 256 + (Rb & 15) * 16 + (C & 15)) * 2); }
              asm volatile("" : "+v"(vA[0]), "+v"(vA[1]), "+v"(vB[0]), "+v"(vB[1]), "+v"(vB2[0]), "+v"(vB2[1]));
              OrdOne S{u0}; EpiZ E{(const bf16_t*)(ws + WS_USSM), args.in[12], (bf16_t*)(ws + WS_ZG)};
              gemm_phase<EpiZ, OrdOne, true, true>(F.lds, g, vA, vB, S, E, F.tid, nullptr, vB2); }
        } else { ssm_side(args, F, 128); p2_pooled(args, F, 128); }
        if (BOTH(2)) xcd_barrier(bar, F.tid);
    }
    if (IN(4)) { F.lane = lane_id_fresh(); F.tid = F.wave * 64 + F.lane;
        if (F.bx < 128) {
            constexpr long GSTR = (long)MT * 32;
            GemmDesc g{(const char*)(ws + WS_ZG), (const char*)(ws + WS_WGLU), 256L * 32, 0, 256L * DSSM * 2, 0, 128L * 32, 128L * DSSM * 2, 4 * GSTR, 128, DSSM / BK};
            unsigned vA[2], vB[2]; voff_std(vB, DSSM, true, F.tid);
#pragma unroll
            for (int i = 0; i < 2; ++i) { int R, C; stage_rc(F.tid * 16 + i * 8192, R, C); vA[i] = (unsigned)(R * 32 + (C >> 4) * (int)GSTR + (C & 15) * 2); }
            OrdGlu S{F.bx}; EpiGlu E{args.in[14], (const bf16_t*)(ws + WS_ZG), (bf16_t*)(ws + WS_YCAT), (float*)(ws + WS_SSSSM)};
            gemm_phase<EpiGlu, OrdGlu, true>(F.lds, g, vA, vB, S, E, F.tid, nullptr);
        } else {
            GemmDesc g{(const char*)(ws + WS_POOLED), (const char*)(ws + WS_PW), 256L * DPOOL * 2, 256L * 2, 256L * 256 * 2, 0, 128L * DPOOL * 2, 128L * 256 * 2, 128, 128, 256 / BK};
            unsigned vA[2], vB[2]; voff_std(vA, DPOOL, false, F.tid); voff_std(vB, 256, true, F.tid);
            OrdPool S{F.bx}; EpiPool E{args.in[4], (bf16_t*)(ws + WS_YCAT), (float*)(ws + WS_SSPOOL)};
            gemm_phase<EpiPool, OrdPool, true>(F.lds, g, vA, vB, S, E, F.tid, nullptr);

            __syncthreads();
            p4_side(args, F, 128);
        }
        if (BOTH(4)) xcd_barrier(bar, F.tid);
    }
    if (IN(5)) { F.lane = lane_id_fresh(); F.tid = F.wave * 64 + F.lane;
        StaticOrder S; S.init(MT / BM, DM / BM, F.G, F.bx);
        LAS f32x2* XR = (LAS f32x2*)(F.lds + XTRA_OFF);
        GemmDesc g{(const char*)(ws + WS_YCAT), (const char*)(ws + WS_WOUT), 256L * DM * 2, 0, 256L * DM * 2, 0, 128L * DM * 2, 128L * DM * 2, 128, 128, DM / BK};
        unsigned vA[2], vB[2]; voff_std(vA, DM, false, F.tid); voff_std(vB, DM, true, F.tid);
        EpiOut E{(const bf16_t*)(ws + WS_XB), (bf16_t*)(ws + WS_H1B), (float*)(ws + WS_SSH1), XR, {{0.f, 0.f, 0.f, 0.f}, {0.f, 0.f, 0.f, 0.f}}, (const float*)(ws + WS_SSPOOL), (const float*)(ws + WS_SSSSM)};
        gemm_phase<EpiOut, StaticOrder, false>(F.lds, g, vA, vB, S, E, F.tid, nullptr);
        if (BOTH(5)) xcd_barrier(bar, F.tid);
    }
    if (IN(6)) { F.lane = lane_id_fresh(); F.tid = F.wave * 64 + F.lane;
        GemmDesc g{(const char*)(ws + WS_H1B), (const char*)(ws + WS_WUP), (long)UPROWS * DM * 2, (long)PADROWS * DM * 2, 256L * DM * 2, 0, 64L * DM * 2, 128L * DM * 2, 128, 128, DM / BK};
        unsigned vA[2], vB[2]; voff_std(vB, DM, true, F.tid);
#pragma unroll
        for (int i = 0; i < 2; ++i) { int R, C; stage_rc(F.tid * 16 + i * 8192, R, C); vA[i] = (unsigned)(((126 * (R >> 6) + 4 * (R & 15) + ((R >> 4) & 3)) * DM + C) * 2); }
        OrdUp S; S.so.init(BATCH * UPT, DFF2 / BM, F.G, F.bx);
        LAS float* RSL = (LAS float*)(F.lds + XTRA_OFF);
        EpiUp E{RSL, args.in[20], args.in[21], (bf16_t*)(ws + WS_ACT), (const float*)(ws + WS_SSH1)};
        gemm_phase<EpiUp, OrdUp, true>(F.lds, g, vA, vB, S, E, F.tid, nullptr);
        if (BOTH(6)) xcd_barrier(bar, F.tid);
    }
    if (IN(7)) { F.lane = lane_id_fresh(); F.tid = F.wave * 64 + F.lane;
        GemmDesc g{(const char*)(ws + WS_ACT), (const char*)(ws + WS_WDOWN), 256L * DFF * 2, 0, 256L * DFF * 2, 0, 128L * DFF * 2, 128L * DFF * 2, 128, 128, DFF / BK};
        unsigned vA[2], vB[2]; voff_std(vA, DFF, false, F.tid); voff_std(vB, DFF, true, F.tid);
        StaticOrder S; S.init(MT / BM, DM / BM, F.G, F.bx);
        EpiDown E{(const bf16_t*)(ws + WS_H1B), args.out, args.in[23], (float*)(ws + WS_SSH2)};
        gemm_phase<EpiDown, StaticOrder, false>(F.lds, g, vA, vB, S, E, F.tid, nullptr);
    }
#undef IN
#undef BOTH
}
}

extern "C" void kernel_launch(void* const* d_in, const int* in_sizes, int n_in, void* d_out, int out_size, void* d_ws, size_t ws_size, hipStream_t stream) {
    static int grid = 0;
    if (grid == 0) {
        int dev = 0, cus = 0, per_cu = 0;
        if (n_in != 24 || out_size != MT * DM || ws_size < mk::WS_END) { fprintf(stderr, "kernel_launch: unexpected problem (n_in %d out %d ws %zu)\n", n_in, out_size, ws_size); grid = -1; return; }
        if (hipGetDevice(&dev) != hipSuccess || hipDeviceGetAttribute(&cus, hipDeviceAttributeMultiprocessorCount, dev) != hipSuccess) { grid = -1; return; }
        if (hipFuncSetAttribute((const void*)mk::mk_fwd, hipFuncAttributeMaxDynamicSharedMemorySize, mk::LDS_BYTES) != hipSuccess) { fprintf(stderr, "kernel_launch: hipFuncSetAttribute failed\n"); grid = -1; return; }
        if (hipOccupancyMaxActiveBlocksPerMultiprocessor(&per_cu, (const void*)mk::mk_fwd, 512, mk::LDS_BYTES) != hipSuccess || per_cu < 1) { fprintf(stderr, "kernel_launch: occupancy query says %d blocks/CU; nothing launched\n", per_cu); (void)hipGetLastError(); grid = -1; return; }
        grid = cus;
        if (grid != 256) { fprintf(stderr, "kernel_launch: built for a 256-CU device, found %d CUs\n", cus); grid = -1; return; }
    }
    if (grid < 0) return;
    (void)in_sizes;
    (void)hipMemsetAsync((char*)d_ws + mk::WS_CTL, 0, mk::CTL_ZERO_BYTES, stream);
    mk::Args a{};
    for (int i = 0; i < 24; ++i) a.in[i] = (const float*)d_in[i];
    a.out = (float*)d_out; a.ws = (unsigned char*)d_ws; a.ph_lo = 0; a.ph_hi = 8;
    hipLaunchKernelGGL(mk::mk_fwd, dim3(grid), dim3(512), mk::LDS_BYTES, stream, a);
}
```

```cpp
#include <hip/hip_runtime.h>
#include <math.h>

constexpr int BATCH = 4, SEQ = 4096, DM = 1024, MT = BATCH * SEQ;
constexpr int DPOOL = 512, DSSM = 512, NG = 32, NH = 16, NS = 64;
constexpr int DFF = 2816, DFF2 = 5632;
constexpr float EPS = 1e-6f;

#include <cstdio>
#include <cstdint>
#define LAS __attribute__((address_space(3)))
#define GAS __attribute__((address_space(1)))
typedef unsigned short bf16_t;
typedef short bf16x8 __attribute__((ext_vector_type(8)));
typedef float f32x4 __attribute__((ext_vector_type(4)));
typedef float f32x2 __attribute__((ext_vector_type(2)));
typedef unsigned u32x4 __attribute__((ext_vector_type(4)));
typedef unsigned u32x2 __attribute__((ext_vector_type(2)));

namespace mk {
constexpr int TCH = 16;
constexpr int K1 = 16 * TCH;
constexpr int ROWLEN = K1 + 256;
constexpr int NCR = MT / TCH;
constexpr int NCHB = SEQ / TCH;
constexpr int PADROWS = 4352;
constexpr int UPT = 17;
constexpr int UPROWS = 252;

constexpr size_t MiB = 1u << 20;
constexpr size_t WS_CTL = 0, CTL_ZERO_BYTES = 64 * 1024;
constexpr int CW_TBCNT = 4096;
constexpr size_t WS_R0 = 1 * MiB;
constexpr size_t WS_SSPOOL = 2 * MiB;
constexpr size_t WS_SSSSM = WS_SSPOOL + 8 * MT * 4;
constexpr size_t WS_SSH1 = WS_SSSSM + 8 * MT * 4;
constexpr size_t WS_SSH2 = WS_SSH1 + 4 * MT * 4;
constexpr size_t WS_LAMT = 6 * MiB;
constexpr size_t WS_WIN = 8 * MiB, WS_WOUT = 10 * MiB, WS_WGLU = 12 * MiB, WS_PW = 12 * MiB + 512 * 1024;
constexpr size_t WS_WUP = 13 * MiB, WS_WDOWN = 24 * MiB;
constexpr size_t WS_WAB = 30 * MiB;
constexpr size_t WS_TB = 38 * MiB;
constexpr size_t WS_TBC = 40 * MiB;
constexpr size_t WS_H1B = 62 * MiB;
constexpr size_t WS_XB = 96 * MiB;
constexpr size_t WS_YCAT = 128 * MiB;
constexpr size_t WS_UPOOL = 128 * MiB;
constexpr size_t WS_USSM = 144 * MiB;
constexpr size_t WS_POOLED = 208 * MiB;
constexpr size_t WS_ZG = 224 * MiB;
constexpr size_t WS_ACT = 96 * MiB;
constexpr size_t WS_END = 240 * MiB;

constexpr int RING_BYTES = 131072, XTRA_OFF = RING_BYTES, XTRA_BYTES = 16384, LDSCTL_OFF = XTRA_OFF + XTRA_BYTES, LDS_BYTES = 151552;

__device__ __forceinline__ unsigned f2bf(float f) { unsigned u = __builtin_bit_cast(unsigned, f); return (u + 0x7fffu + ((u >> 16) & 1u)) >> 16; }
__device__ __forceinline__ unsigned pk2(float lo, float hi) { return f2bf(lo) | (f2bf(hi) << 16); }
__device__ __forceinline__ unsigned cvt_pk_bf16(float lo, float hi) { unsigned r; asm volatile("v_cvt_pk_bf16_f32 %0, %1, %2" : "=v"(r) : "v"(lo), "v"(hi)); return r; }
__device__ __forceinline__ u32x4 pack8(f32x4 a, f32x4 b) { u32x4 w; w.x = cvt_pk_bf16(a[0], a[1]); w.y = cvt_pk_bf16(a[2], a[3]); w.z = cvt_pk_bf16(b[0], b[1]); w.w = cvt_pk_bf16(b[2], b[3]); return w; }
__device__ __forceinline__ u32x2 pack4(f32x4 a) { u32x2 w; w.x = cvt_pk_bf16(a[0], a[1]); w.y = cvt_pk_bf16(a[2], a[3]); return w; }
__device__ __forceinline__ float bflo(unsigned w) { return __builtin_bit_cast(float, w << 16); }
__device__ __forceinline__ float bfhi(unsigned w) { return __builtin_bit_cast(float, w & 0xffff0000u); }
__device__ __forceinline__ void unpack8(u32x4 w, f32x4& a, f32x4& b) { a[0] = bflo(w.x); a[1] = bfhi(w.x); a[2] = bflo(w.y); a[3] = bfhi(w.y); b[0] = bflo(w.z); b[1] = bfhi(w.z); b[2] = bflo(w.w); b[3] = bfhi(w.w); }
__device__ __forceinline__ float fast_sigmoid(float x) { return __builtin_amdgcn_rcpf(1.0f + __builtin_amdgcn_exp2f(-1.4426950408889634f * x)); }
__device__ __forceinline__ f32x4 fast_sigmoid4(f32x4 x) {
    const f32x4 t = x * -1.4426950408889634f; f32x4 e;
#pragma unroll
    for (int i = 0; i < 4; ++i) e[i] = __builtin_amdgcn_exp2f(t[i]);
    const f32x4 d = e + 1.0f; f32x4 r;
#pragma unroll
    for (int i = 0; i < 4; ++i) r[i] = __builtin_amdgcn_rcpf(d[i]);
    return r;
}
__device__ __forceinline__ float sumsq8(f32x4 a, f32x4 b) { const f32x4 s = a * a + b * b; return (s[0] + s[1]) + (s[2] + s[3]); }
__device__ __forceinline__ f32x4 fast_gelu_tanh4(f32x4 x) {
    constexpr float C = -2.0f * 0.7978845608028654f * 1.4426950408889634f;
    const f32x4 a = x * (x * x * (C * 0.044715f) + C); f32x4 e;
#pragma unroll
    for (int i = 0; i < 4; ++i) e[i] = __builtin_amdgcn_exp2f(a[i]);
    const f32x4 d = e + 1.0f; f32x4 r;
#pragma unroll
    for (int i = 0; i < 4; ++i) r[i] = __builtin_amdgcn_rcpf(d[i]);
    return x * r;
}
__device__ __forceinline__ float fast_gelu_tanh(float x) {
    const float t = x * (1.0f + 0.044715f * x * x);
    return x * __builtin_amdgcn_rcpf(1.0f + __builtin_amdgcn_exp2f(-2.0f * 0.7978845608028654f * 1.4426950408889634f * t));
}
__device__ __forceinline__ float wave_sum(float v) {
#pragma unroll
    for (int o = 1; o < 64; o <<= 1) v += __shfl_xor(v, o);
    return v;
}
__device__ __forceinline__ float dpp_ror1(float v)  { return __builtin_bit_cast(float, __builtin_amdgcn_update_dpp(0, __builtin_bit_cast(int, v), 0x121, 0xf, 0xf, false)); }
__device__ __forceinline__ float dpp_ror15(float v) { return __builtin_bit_cast(float, __builtin_amdgcn_update_dpp(0, __builtin_bit_cast(int, v), 0x12F, 0xf, 0xf, false)); }
__device__ __forceinline__ int lane_id_fresh() { int l; asm volatile("v_mbcnt_lo_u32_b32 %0, -1, 0\n\tv_mbcnt_hi_u32_b32 %0, -1, %0" : "=v"(l)); return l; }
#define LDS_WAIT() asm volatile("s_waitcnt lgkmcnt(0)" ::: "memory")
#define VM_WAIT() asm volatile("s_waitcnt vmcnt(0)" ::: "memory")
__device__ __forceinline__ void st_wt16(void* p, u32x4 v) { asm volatile("global_store_dwordx4 %0, %1, off sc1\n\ts_nop 1" :: "v"(p), "v"(v) : "memory"); }
__device__ __forceinline__ void st_wt8(void* p, u32x2 v)  { asm volatile("global_store_dwordx2 %0, %1, off sc1\n\ts_nop 1" :: "v"(p), "v"(v) : "memory"); }

#define XB_TMO      128
#define XB_XCNT(j)  (256  + 64 * (j))
#define XB_XSUB(j)  (1280 + 64 * (j))
#define XB_XGEN(j)  (2304 + 64 * (j))
#define XB_TOP      3328
#define XB_TOPGEN   3392
#define XCD_BAR_WORDS 3456
#define XB_SPIN_CAP (1u << 18)
__device__ __forceinline__ unsigned xb_ld(unsigned* p)              { return __hip_atomic_load(p, __ATOMIC_RELAXED, __HIP_MEMORY_SCOPE_AGENT); }
__device__ __forceinline__ unsigned xb_add(unsigned* p, unsigned v) { return __hip_atomic_fetch_add(p, v, __ATOMIC_RELAXED, __HIP_MEMORY_SCOPE_AGENT); }
__device__ __forceinline__ unsigned xb_xcc_id() { return (unsigned)__builtin_amdgcn_s_getreg((3 << 11) | 20) & 0xFu; }
#define XB_SPIN(cond, bar) do { unsigned _sp = 0; while (cond) { __builtin_amdgcn_s_sleep(1); \
    if ((++_sp & 255u) == 0u) { if (xb_ld(&(bar)[XB_TMO])) break; if (_sp > XB_SPIN_CAP) { atomicAdd(&(bar)[XB_TMO], 1u); break; } } } } while (0)
struct XcdBarrier { unsigned* bar; unsigned x; volatile LAS unsigned* st; };
__device__ __forceinline__ XcdBarrier xcd_barrier_post(unsigned* bar, volatile LAS unsigned* st) {
    XcdBarrier b; b.bar = bar; b.x = xb_xcc_id(); b.st = st;
    if (threadIdx.x == 0) (void)xb_add(&bar[XB_XCNT(b.x)], 1u);
    return b;
}
__device__ __forceinline__ void xcd_barrier_complete(unsigned* bar, unsigned x, unsigned& nloc, unsigned& nx) {
    const unsigned G = gridDim.x * gridDim.y * gridDim.z;
    unsigned sum, cnt, mine, sp = 0u;
    for (;;) {
        sum = 0u; cnt = 0u; mine = 0u;
#pragma unroll
        for (unsigned j = 0; j < 16; ++j) { const unsigned c = xb_ld(&bar[XB_XCNT(j)]); sum += c; cnt += (c > 0u) ? 1u : 0u; mine = (j == x) ? c : mine; }
        if (sum == G) break;
        __builtin_amdgcn_s_sleep(1);
        if ((++sp & 255u) == 0u) { if (xb_ld(&bar[XB_TMO])) break; if (sp > XB_SPIN_CAP) { atomicAdd(&bar[XB_TMO], 1u); break; } }
    }
    nloc = mine > 0u ? mine : 1u; nx = cnt > 0u ? cnt : 1u;
}
__device__ __forceinline__ void xcd_barrier(const XcdBarrier& b, int tid) {
    asm volatile("s_waitcnt vmcnt(0)" ::: "memory");
    __syncthreads();
    if (tid == 0) {
        unsigned* bar = b.bar;
        __builtin_amdgcn_s_waitcnt(0);
        unsigned nloc = b.st[0], nx = b.st[1];
        if (nloc == 0u) { xcd_barrier_complete(bar, b.x, nloc, nx); b.st[0] = nloc; b.st[1] = nx; }
        const unsigned old = xb_add(&bar[XB_XSUB(b.x)], 1u);
        const unsigned gen = old / nloc;
        if (old + 1u == (gen + 1u) * nloc) {
            __builtin_amdgcn_fence(__ATOMIC_RELEASE, "agent");
            asm volatile("s_waitcnt vmcnt(0)" ::: "memory");
            const unsigned og = xb_add(&bar[XB_TOP], 1u);
            const unsigned tg = og / nx;
            if (og + 1u == (tg + 1u) * nx) xb_add(&bar[XB_TOPGEN], 1u);
            else XB_SPIN(xb_ld(&bar[XB_TOPGEN]) == tg, bar);
            __builtin_amdgcn_fence(__ATOMIC_ACQUIRE, "agent");
            xb_add(&bar[XB_XGEN(b.x)], 1u);
            asm volatile("s_waitcnt vmcnt(0)" ::: "memory");
        } else {
            __builtin_amdgcn_fence(__ATOMIC_ACQUIRE, "agent");
            XB_SPIN(xb_ld(&bar[XB_XGEN(b.x)]) == gen, bar);
            asm volatile("s_waitcnt vmcnt(0)" ::: "memory");
        }
    }
    __syncthreads();
}

constexpr int BM = 256, BK = 64, HALF = 128, HTB = HALF * BK * 2, STAGE_BYTES = 8 * HTB, NXCD = 8, WGM = 8;
__host__ __device__ __forceinline__ int lds_byte(int r, int c) { const int st = (r >> 4) * 2 + (c >> 5), rr = r & 15, cc = c & 31, ob = rr * 64 + cc * 2; return st * 1024 + (ob ^ (((ob >> 9) & 1) << 5)); }
__host__ __device__ __forceinline__ void stage_rc(int b, int& R, int& C) { const int st = b / 1024, sb = b % 1024, swz = sb ^ (((sb >> 9) & 1) << 5); R = (st >> 1) * 16 + swz / 64; C = (st & 1) * 32 + (swz % 64) / 2; }
__host__ __device__ __forceinline__ int perm32(int rho) { const int n = rho >> 4, i = rho & 15; return 8 * (i >> 2) + 4 * n + (i & 3); }

struct Unit { int pm, pn, g, aux; };
struct GemmDesc { const char* A; const char* B; long a_pm, a_g, b_pn, b_g, a_h, b_h, a_k, b_k; int nt;
                  const char* B2; long b2_pn, b2_g, b2_h, b2_k; int tsw; };

struct StaticOrder {
    int nM, nN, nwg, G, c;
    __device__ void init(int nM_, int nN_, int G_, int c_) { nM = nM_; nN = nN_; nwg = nM * nN; G = G_; c = c_; }
    __device__ bool next(int i, Unit& u) const {
        const long L = (long)i * G + c; if (L >= nwg) return false;
        int wgid = (int)L; { const int q = nwg / NXCD, r = nwg % NXCD, xcd = wgid % NXCD, off = wgid / NXCD; wgid = (xcd < r ? xcd * (q + 1) : r * (q + 1) + (xcd - r) * q) + off; }
        const int nig = WGM * nN, gid = wgid / nig, fm = gid * WGM, gsz = (nM - fm) < WGM ? (nM - fm) : WGM;
        u.pm = fm + ((wgid % nig) % gsz); u.pn = (wgid % nig) / gsz; u.g = 0; u.aux = 0; return true;
    }
};

template <class Epi, class Sched, bool ALIGN_EPI, bool SEG2 = false>
__device__ __forceinline__ void gemm_phase(LAS unsigned char* lds, const GemmDesc g, const unsigned (&voffA)[2], const unsigned (&voffB)[2], const Sched& S, Epi& E, int tid, unsigned long long* stp = nullptr, const unsigned* voffB2 = nullptr) {
    const int wid = __builtin_amdgcn_readfirstlane(tid >> 6), lane = tid & 63, wr = wid >> 2, wc = wid & 3, fr = lane & 15, fq = lane >> 4;
    const int nt = g.nt;
    const long kstepA = g.a_k, kstepB = g.b_k, hstepA = g.a_h, hstepB = g.b_h;
    const unsigned ldsw = (unsigned)wid * 1024u;
    const int aoff = lds_byte(wr * 64 + fr, fq * 8), boff = lds_byte(wc * 32 + fr, fq * 8);
#define PG8_SA(b, h) (((b) * 2 + (h)) * HTB)
#define PG8_SB(b, h) ((4 + (b) * 2 + (h)) * HTB)
#define PG8_STAGE(bufoff, gbase, voff) do { const char* _gb = (const char*)(gbase); asm volatile("" : "+s"(_gb));   _Pragma("unroll") for (int _i = 0; _i < 2; ++_i) \
        __builtin_amdgcn_global_load_lds((const unsigned*)(_gb + (voff)[_i]), (LAS unsigned*)(lds + (bufoff) + ldsw + _i * 8192), 16, 0, 0); } while (0)
#define PG8_LDA(dst, b, h) do { _Pragma("unroll") for (int m = 0; m < 4; ++m) _Pragma("unroll") for (int k = 0; k < 2; ++k) dst[m][k] = *(const LAS bf16x8*)(lds + PG8_SA(b, h) + aoff + m * 2048 + k * 1024); } while (0)
#define PG8_LDB(dst, b, h) do { _Pragma("unroll") for (int n = 0; n < 2; ++n) _Pragma("unroll") for (int k = 0; k < 2; ++k) dst[n][k] = *(const LAS bf16x8*)(lds + PG8_SB(b, h) + boff + n * 2048 + k * 1024); } while (0)
#define PG8_MMA(ai, bj, At, Bt) do { __builtin_amdgcn_s_setprio(1); _Pragma("unroll") for (int m = 0; m < 4; ++m) _Pragma("unroll") for (int n = 0; n < 2; ++n) _Pragma("unroll") for (int k = 0; k < 2; ++k) \
        acc[ai][bj][m][n] = __builtin_amdgcn_mfma_f32_16x16x32_bf16(Bt[n][k], At[m][k], acc[ai][bj][m][n], 0, 0, 0); __builtin_amdgcn_s_setprio(0); } while (0)
#define PG8_WAIT_V(n) asm volatile("s_waitcnt vmcnt(" #n ")" ::: "memory")
#define PG8_WAIT_L(n) asm volatile("s_waitcnt lgkmcnt(" #n ")" ::: "memory")
#define PG8_BAR __builtin_amdgcn_s_barrier()
#define PG8_SCHED __builtin_amdgcn_sched_barrier(0)
    Unit cur, nxt; int ui = 0;
    if (!S.next(0, cur)) return;
    f32x4 acc[2][2][4][2];
#pragma unroll
    for (int a = 0; a < 2; ++a)
#pragma unroll
        for (int b = 0; b < 2; ++b)
#pragma unroll
            for (int m = 0; m < 4; ++m)
#pragma unroll
                for (int n = 0; n < 2; ++n) acc[a][b][m][n] = (f32x4){0.f, 0.f, 0.f, 0.f};
    bf16x8 At[4][2], B0[2][2], B1[2][2];
    const char* cA = g.A + (long)cur.pm * g.a_pm + (long)cur.g * g.a_g; const char* cB = g.B + (long)cur.pn * g.b_pn + (long)cur.g * g.b_g;
    const char* cB2 = SEG2 ? g.B2 + (long)cur.pn * g.b2_pn + (long)cur.g * g.b2_g : nullptr;
    PG8_STAGE(PG8_SB(0, 0), cB, voffB); PG8_STAGE(PG8_SB(0, 1), cB + hstepB, voffB); PG8_STAGE(PG8_SA(0, 0), cA, voffA); PG8_STAGE(PG8_SA(0, 1), cA + hstepA, voffA);
    if constexpr (Epi::HAS_PRE) E.pre(S, tid);
    if (wr == 1) PG8_BAR;
    PG8_WAIT_V(2); PG8_BAR;
    PG8_STAGE(PG8_SB(1, 0), cB + kstepB, voffB); PG8_STAGE(PG8_SA(1, 0), cA + kstepA, voffA); PG8_STAGE(PG8_SB(1, 1), cB + hstepB + kstepB, voffB);
    PG8_WAIT_V(6); PG8_BAR;
    unsigned long long st_t0 = stp ? __builtin_amdgcn_s_memrealtime() : 0ull, st_loop = 0ull, st_epi = 0ull;
    for (;;) {
        if constexpr (Epi::HAS_UNIT) E.unit_top(cur, tid, lds);
        const bool has_next = S.next(ui + 1, nxt);
        const char* nA = has_next ? g.A + (long)nxt.pm * g.a_pm + (long)nxt.g * g.a_g : cA; const char* nB = has_next ? g.B + (long)nxt.pn * g.b_pn + (long)nxt.g * g.b_g : cB;
        for (int t = 0; t < nt; t += 2) {
            const bool last = (t == nt - 2);
            const char* a1 = cA + (long)(t + 1) * kstepA;
            const bool sg = SEG2 && !last && (t + 2 >= g.tsw);
            const char* a2 = last ? nA : cA + (long)(t + 2) * kstepA; const char* b2 = last ? nB : (sg ? cB2 + (long)(t + 2 - g.tsw) * g.b2_k : cB + (long)(t + 2) * kstepB);
            const char* a3 = a2 + kstepA; const char* b3 = b2 + (sg ? g.b2_k : kstepB);
            const long hB = sg ? g.b2_h : hstepB;
            unsigned vbs[2]; vbs[0] = sg ? voffB2[0] : voffB[0]; vbs[1] = sg ? voffB2[1] : voffB[1];
            PG8_LDB(B0, 0, 0); PG8_LDB(B1, 0, 1); PG8_SCHED; PG8_LDA(At, 0, 0); PG8_STAGE(PG8_SA(1, 1), a1 + hstepA, voffA);
            PG8_WAIT_V(8); PG8_WAIT_L(0); PG8_BAR; PG8_MMA(0, 0, At, B0); PG8_MMA(0, 1, At, B1); PG8_BAR; PG8_SCHED;
            PG8_LDA(At, 0, 1); PG8_STAGE(PG8_SB(0, 0), b2, vbs); PG8_STAGE(PG8_SB(0, 1), b2 + hB, vbs); PG8_STAGE(PG8_SA(0, 0), a2, voffA);
            PG8_WAIT_V(8); PG8_WAIT_L(0); PG8_BAR; PG8_MMA(1, 0, At, B0); PG8_MMA(1, 1, At, B1); PG8_BAR; PG8_SCHED;
            PG8_LDB(B0, 1, 0); PG8_LDB(B1, 1, 1); PG8_SCHED; PG8_LDA(At, 1, 0); PG8_STAGE(PG8_SA(0, 1), a2 + hstepA, voffA);
            PG8_WAIT_V(8); PG8_WAIT_L(0); PG8_BAR; PG8_MMA(0, 0, At, B0); PG8_MMA(0, 1, At, B1); PG8_BAR; PG8_SCHED;
            PG8_LDA(At, 1, 1); PG8_STAGE(PG8_SB(1, 0), b3, vbs); PG8_STAGE(PG8_SB(1, 1), b3 + hB, vbs); PG8_STAGE(PG8_SA(1, 0), a3, voffA);
            PG8_WAIT_V(8); PG8_WAIT_L(0); PG8_BAR; PG8_MMA(1, 0, At, B0); PG8_MMA(1, 1, At, B1); PG8_BAR; PG8_SCHED;
            if constexpr (Epi::HAS_MID) { if (t + 2 == Epi::MID_T) E.mid(acc, wr, fr); }
        }
        if (stp) { const unsigned long long t1 = __builtin_amdgcn_s_memrealtime(); st_loop += t1 - st_t0; st_t0 = t1; }
        if constexpr (ALIGN_EPI) { if (wr == 0) PG8_BAR; }
        if constexpr (!Epi::AFTER_DRAIN) { E(acc, cur, wr, wc, fr, fq); }
        if (stp) { const unsigned long long t1 = __builtin_amdgcn_s_memrealtime(); st_epi += t1 - st_t0; st_t0 = t1; }
        if (!has_next) break;
#pragma unroll
        for (int a = 0; a < 2; ++a)
#pragma unroll
            for (int b = 0; b < 2; ++b)
#pragma unroll
                for (int m = 0; m < 4; ++m)
#pragma unroll
                    for (int n = 0; n < 2; ++n) acc[a][b][m][n] = (f32x4){0.f, 0.f, 0.f, 0.f};
        cur = nxt; cA = nA; cB = nB; ++ui; if constexpr (SEG2) cB2 = g.B2 + (long)cur.pn * g.b2_pn + (long)cur.g * g.b2_g;
        if constexpr (ALIGN_EPI) { if (wr == 1) PG8_BAR; }
    }
    PG8_WAIT_V(0);
    if constexpr (!ALIGN_EPI) { if (wr == 0) PG8_BAR; }
    PG8_BAR;
    if (stp) { const unsigned long long t1 = __builtin_amdgcn_s_memrealtime(); st_loop += t1 - st_t0; st_t0 = t1; }
    if constexpr (Epi::AFTER_DRAIN) { E.fused(acc, cur, wr, wc, fr, fq, lds, wid, lane); }
    if (stp) { const unsigned long long t1 = __builtin_amdgcn_s_memrealtime(); st_epi += t1 - st_t0; if (tid == 0) { stp[0] = st_loop; stp[1] = st_epi; } }
#undef PG8_SA
#undef PG8_SB
#undef PG8_STAGE
#undef PG8_LDA
#undef PG8_LDB
#undef PG8_MMA
#undef PG8_WAIT_V
#undef PG8_WAIT_L
#undef PG8_BAR
#undef PG8_SCHED
}

__device__ __forceinline__ void voff_std(unsigned (&v)[2], int ld, bool perm, int tid) {
#pragma unroll
    for (int i = 0; i < 2; ++i) { int R, C; stage_rc(tid * 16 + i * 8192, R, C); const int Rb = perm ? ((R & ~31) + perm32(R & 31)) : R; v[i] = (unsigned)(Rb * ld + C) * 2u; }
}

typedef f32x4 Acc[2][2][4][2];

struct EpiU {
    static constexpr bool PERM = true, AFTER_DRAIN = false, HAS_MID = false; static constexpr int MID_T = 0; static constexpr bool HAS_PRE = true, HAS_UNIT = false;
    const float* r0; bf16_t* upool; bf16_t* ussm; LAS float* r0l;
    template <class Sched> __device__ __forceinline__ void pre(const Sched& S, int tid) {
        Unit u0; if (S.next(0, u0) && tid < 256) r0l[tid] = r0[u0.pm * BM + tid];
        __syncthreads();
    }
    __device__ __forceinline__ void operator()(Acc& acc, const Unit& u, int wr, int wc, int fr, int fq) const {
#pragma unroll
        for (int ai = 0; ai < 2; ++ai)
#pragma unroll
            for (int m = 0; m < 4; ++m) {
                const int row = u.pm * BM + ai * HALF + wr * 64 + m * 16 + fr; const float rs = r0l[ai * HALF + wr * 64 + m * 16 + fr];
#pragma unroll
                for (int bj = 0; bj < 2; ++bj) {
                    const int c8 = u.pn * BM + bj * HALF + wc * 32 + 8 * fq;
                    const u32x4 w = pack8(acc[ai][bj][m][0] * rs, acc[ai][bj][m][1] * rs);
                    if (u.pn < 2) st_wt16(upool + (size_t)row * DPOOL + c8, w);
                    else { const int cs = c8 - DPOOL, gg = cs >> 4, h0 = cs & 15, cr = row / TCH, p = row % TCH;
                           st_wt16(ussm + ((size_t)(gg * NCR + cr) * ROWLEN + 16 * p + h0), w); }
                }
            }
    }
};
struct cf { float r, i; };
__device__ __forceinline__ cf cmul(cf a, cf b) { return cf{a.r * b.r - a.i * b.i, a.r * b.i + a.i * b.r}; }
__device__ __forceinline__ cf cmad(cf a, cf b, cf c) { return cf{a.r * b.r - a.i * b.i + c.r, a.r * b.i + a.i * b.r + c.i}; }
template <int CTRL> __device__ __forceinline__ float dppz(float v) { return __builtin_bit_cast(float, __builtin_amdgcn_update_dpp(0, __builtin_bit_cast(int, v), CTRL, 0xf, 0xf, true)); }
template <int CTRL> __device__ __forceinline__ cf cdpp(cf v) { return cf{dppz<CTRL>(v.r), dppz<CTRL>(v.i)}; }
struct EpiScan {
    static constexpr bool PERM = false, AFTER_DRAIN = true, HAS_MID = false; static constexpr int MID_T = 0; static constexpr bool HAS_PRE = true, HAS_UNIT = false;
    const float* lamT; bf16_t* ussm; LAS float* laml;
    static constexpr int LAML_OFF = 8192 + 256 * 520;
    static_assert(LAML_OFF + 1024 <= LDSCTL_OFF, "lambda table fits under the LDS control words");
    template <class Sched> __device__ __forceinline__ void pre(const Sched& S, int tid) {
        Unit u0; if (S.next(0, u0) && tid < 128) *(LAS f32x2*)(laml + tid * 2) = *(const f32x2*)(lamT + ((size_t)((tid >> 6) * NG + u0.g) * NS + (tid & 63)) * 2);
        __syncthreads();
    }
    __device__ __forceinline__ void fused(Acc& acc, const Unit& u, int wr, int wc, int fr, int fq, LAS unsigned char* lds, int wid, int lane) const {
        LAS float* SEG = (LAS float*)lds;
        cf X[2][2][2], MX[2][2];
        LAS unsigned char* CIM = lds + 8192;
#define SC_A(j) cf{acc[(j) >> 2][bj][(j) & 3][np][2 * e], acc[(j) >> 2][bj][(j) & 3][np][2 * e + 1]}
#pragma unroll
        for (int bj = 0; bj < 2; ++bj)
#pragma unroll
            for (int np = 0; np < 2; ++np) {
                const int n0 = 16 * wc + 8 * np + 2 * fq;
                const f32x4 l4 = *(const LAS f32x4*)(laml + (bj * NS + n0) * 2);
#pragma unroll
                for (int e = 0; e < 2; ++e) {
                    const cf lam{l4[2 * e], l4[2 * e + 1]};
                    const cf l2 = cmul(lam, lam), l4p = cmul(l2, l2), M1 = cmul(l4p, l4p), M2 = cmul(M1, M1), M4 = cmul(M2, M2), M8 = cmul(M4, M4);
                    if (wr == 1 - bj) { const int ex = bj == 0 ? fr : 15 - fr;
                        cf Mx{1.f, 0.f};
                        if (ex & 1) Mx = cmul(Mx, M1); if (ex & 2) Mx = cmul(Mx, M2); if (ex & 4) Mx = cmul(Mx, M4); if (ex & 8) Mx = cmul(Mx, M8);
                        MX[np][e] = Mx; }
                    cf T;
                    if (bj == 0) { T = SC_A(0);
#pragma unroll
                        for (int j = 1; j < 8; ++j) T = cmad(lam, T, SC_A(j));
                        T = cmad(M1, cdpp<0x111>(T), T); T = cmad(M2, cdpp<0x112>(T), T); T = cmad(M4, cdpp<0x114>(T), T); T = cmad(M8, cdpp<0x118>(T), T);
                        X[bj][np][e] = cdpp<0x111>(T);
                        if (fr == 15) *(LAS f32x2*)(SEG + ((bj * 2 + wr) * 64 + n0 + e) * 2) = (f32x2){T.r, T.i};
                    } else {       T = SC_A(7);
#pragma unroll
                        for (int j = 6; j >= 0; --j) T = cmad(lam, T, SC_A(j));
                        T = cmad(M1, cdpp<0x101>(T), T); T = cmad(M2, cdpp<0x102>(T), T); T = cmad(M4, cdpp<0x104>(T), T); T = cmad(M8, cdpp<0x108>(T), T);
                        X[bj][np][e] = cdpp<0x101>(T);
                        if (fr == 0) *(LAS f32x2*)(SEG + ((bj * 2 + wr) * 64 + n0 + e) * 2) = (f32x2){T.r, T.i};
                    }
                }
            }
        LDS_WAIT(); __builtin_amdgcn_s_barrier(); asm volatile("" ::: "memory");
#pragma unroll
        for (int bj = 0; bj < 2; ++bj)
#pragma unroll
            for (int np = 0; np < 2; ++np) {
                const int n0 = 16 * wc + 8 * np + 2 * fq;
                const f32x4 l4 = *(const LAS f32x4*)(laml + (bj * NS + n0) * 2);
                const cf lam0{l4[0], l4[1]}, lam1{l4[2], l4[3]};
                cf c0 = X[bj][np][0], c1 = X[bj][np][1];
                LAS unsigned char* crow = CIM + (128 * wr + fr) * 520 + (bj * 128 + 2 * n0) * 2;
#define SC_A0(j) cf{acc[(j) >> 2][bj][(j) & 3][np][0], acc[(j) >> 2][bj][(j) & 3][np][1]}
#define SC_A1(j) cf{acc[(j) >> 2][bj][(j) & 3][np][2], acc[(j) >> 2][bj][(j) & 3][np][3]}
#define SC_PUT(j) do { u32x2 w; w.x = cvt_pk_bf16(c0.r, c0.i); w.y = cvt_pk_bf16(c1.r, c1.i); *(LAS u32x2*)(crow + (j) * (16 * 520)) = w; } while (0)
                if (bj == 0) {
                    if (wr == 1) { const f32x4 t = *(const LAS f32x4*)(SEG + ((bj * 2 + 0) * 64 + n0) * 2); c0 = cmad(MX[np][0], cf{t[0], t[1]}, c0); c1 = cmad(MX[np][1], cf{t[2], t[3]}, c1); }
                    SC_PUT(0);
#pragma unroll
                    for (int j = 1; j < 8; ++j) { c0 = cmad(lam0, c0, SC_A0(j - 1)); c1 = cmad(lam1, c1, SC_A1(j - 1)); SC_PUT(j); }
                } else {
                    if (wr == 0) { const f32x4 t = *(const LAS f32x4*)(SEG + ((bj * 2 + 1) * 64 + n0) * 2); c0 = cmad(MX[np][0], cf{t[0], t[1]}, c0); c1 = cmad(MX[np][1], cf{t[2], t[3]}, c1); }
                    SC_PUT(7);
#pragma unroll
                    for (int j = 6; j >= 0; --j) { c0 = cmad(lam0, c0, SC_A0(j + 1)); c1 = cmad(lam1, c1, SC_A1(j + 1)); SC_PUT(j); }
                }
#undef SC_A0
#undef SC_A1
#undef SC_PUT
            }
#undef SC_A
        LDS_WAIT(); __builtin_amdgcn_s_barrier(); asm volatile("" ::: "memory");
#pragma unroll 8
        for (int r = wid; r < 256; r += 8) { const int c = (r & 128) + 8 * (r & 15) + ((r >> 4) & 7);
            *(u32x2*)(ussm + ((size_t)(u.g * NCR + u.pm * NCHB + c) * ROWLEN + K1) + 4 * lane) = *(const LAS u32x2*)(CIM + r * 520 + 8 * lane); }
    }
};
struct EpiZ {
    static constexpr bool PERM = true, AFTER_DRAIN = false, HAS_MID = false; static constexpr int MID_T = 0; static constexpr bool HAS_PRE = false, HAS_UNIT = false;
    const bf16_t* ussm; const float* dvec; bf16_t* zg;
    __device__ __forceinline__ void operator()(Acc& acc, const Unit& u, int wr, int wc, int fr, int fq) const {
        u32x4 uw[2][2][4];
        f32x4 dd[2][2];
#pragma unroll
        for (int bj = 0; bj < 2; ++bj) {
            const int c8 = u.pn * BM + bj * HALF + wc * 32 + 8 * fq;
            dd[bj][0] = *(const f32x4*)(dvec + u.g * 16 + (c8 & 15)); dd[bj][1] = *(const f32x4*)(dvec + u.g * 16 + (c8 & 15) + 4);
#pragma unroll
            for (int ai = 0; ai < 2; ++ai)
#pragma unroll
                for (int m = 0; m < 4; ++m) { const int cr = u.pm * BM + ai * HALF + wr * 64 + m * 16 + fr; uw[bj][ai][m] = *(const u32x4*)(ussm + ((size_t)(u.g * NCR + cr) * ROWLEN + c8)); }
        }
#pragma unroll
        for (int bj = 0; bj < 2; ++bj) {
            const int c8 = u.pn * BM + bj * HALF + wc * 32 + 8 * fq;
#pragma unroll
            for (int ai = 0; ai < 2; ++ai)
#pragma unroll
                for (int m = 0; m < 4; ++m) {
                    const int cr = u.pm * BM + ai * HALF + wr * 64 + m * 16 + fr;
                    f32x4 u0, u1; unpack8(uw[bj][ai][m], u0, u1);
                    f32x4 y0 = acc[ai][bj][m][0] + dd[bj][0] * u0, y1 = acc[ai][bj][m][1] + dd[bj][1] * u1;
                    y0 = fast_gelu_tanh4(y0); y1 = fast_gelu_tanh4(y1);
                    st_wt16(zg + ((size_t)u.g * MT * 16 + (size_t)cr * K1 + c8), pack8(y0, y1));
                }
        }
    }
};
struct EpiPool {
    static constexpr bool PERM = true, AFTER_DRAIN = false, HAS_MID = false; static constexpr int MID_T = 0; static constexpr bool HAS_PRE = false, HAS_UNIT = false;
    const float* pscale; bf16_t* ycat; float* ss;
    __device__ __forceinline__ void operator()(Acc& acc, const Unit& u, int wr, int wc, int fr, int fq) const {
        f32x4 sc[2][2];
#pragma unroll
        for (int bj = 0; bj < 2; ++bj) { const int c8 = u.pn * BM + bj * HALF + wc * 32 + 8 * fq; sc[bj][0] = *(const f32x4*)(pscale + c8); sc[bj][1] = *(const f32x4*)(pscale + c8 + 4); }
#pragma unroll
        for (int ai = 0; ai < 2; ++ai)
#pragma unroll
            for (int m = 0; m < 4; ++m) {
                const int row = u.pm * BM + ai * HALF + wr * 64 + m * 16 + fr; float q = 0.f;
#pragma unroll
                for (int bj = 0; bj < 2; ++bj) {
                    const int c8 = u.pn * BM + bj * HALF + wc * 32 + 8 * fq;
                    const f32x4 v0 = acc[ai][bj][m][0] * sc[bj][0], v1 = acc[ai][bj][m][1] * sc[bj][1];
                    q += sumsq8(v0, v1);
                    st_wt16(ycat + (size_t)row * DM + c8, pack8(v0, v1));
                }
                q += __shfl_xor(q, 16); q += __shfl_xor(q, 32);
                if (fq == 0) ss[(size_t)(u.pn * 4 + wc) * MT + row] = q;
            }
    }
};
struct EpiGlu {
    static constexpr bool PERM = true, AFTER_DRAIN = false, HAS_MID = false; static constexpr int MID_T = 0; static constexpr bool HAS_PRE = false, HAS_UNIT = false;
    const float* gb; const bf16_t* zg; bf16_t* ycat; float* ss;
    __device__ __forceinline__ void operator()(Acc& acc, const Unit& u, int wr, int wc, int fr, int fq) const {
        f32x4 bv[2][2]; u32x4 zw[2][4][2];
#pragma unroll
        for (int bj = 0; bj < 2; ++bj) { const int c8 = u.pn * BM + bj * HALF + wc * 32 + 8 * fq; bv[bj][0] = *(const f32x4*)(gb + c8); bv[bj][1] = *(const f32x4*)(gb + c8 + 4); }
#pragma unroll
        for (int ai = 0; ai < 2; ++ai)
#pragma unroll
            for (int m = 0; m < 4; ++m) { const int row = u.pm * BM + ai * HALF + wr * 64 + m * 16 + fr;
#pragma unroll
                for (int bj = 0; bj < 2; ++bj) { const int c8 = u.pn * BM + bj * HALF + wc * 32 + 8 * fq; zw[ai][m][bj] = *(const u32x4*)(zg + ((size_t)(c8 >> 4) * MT + row) * 16 + (c8 & 15)); } }
#pragma unroll
        for (int ai = 0; ai < 2; ++ai)
#pragma unroll
            for (int m = 0; m < 4; ++m) {
                const int row = u.pm * BM + ai * HALF + wr * 64 + m * 16 + fr; float q = 0.f;
#pragma unroll
                for (int bj = 0; bj < 2; ++bj) {
                    const int c8 = u.pn * BM + bj * HALF + wc * 32 + 8 * fq;
                    f32x4 z0, z1; unpack8(zw[ai][m][bj], z0, z1);
                    f32x4 v0 = acc[ai][bj][m][0] + bv[bj][0], v1 = acc[ai][bj][m][1] + bv[bj][1];
                    v0 = z0 * fast_sigmoid4(v0); v1 = z1 * fast_sigmoid4(v1);
                    q += sumsq8(v0, v1);
                    st_wt16(ycat + (size_t)row * DM + DPOOL + c8, pack8(v0, v1));
                }
                q += __shfl_xor(q, 16); q += __shfl_xor(q, 32);
                if (fq == 0) ss[(size_t)(u.pn * 4 + wc) * MT + row] = q;
            }
    }
};
struct EpiOut {
    static constexpr bool PERM = true, AFTER_DRAIN = true, HAS_MID = true; static constexpr int MID_T = 8; static constexpr bool HAS_PRE = true, HAS_UNIT = false;
    const bf16_t* xb; bf16_t* h1b; float* ss; LAS f32x2* XR; float ratio[2][4];
    const float* sp; const float* sm;
    template <class Sched> __device__ __forceinline__ void pre(const Sched& S, int tid) {
        Unit u0;
        if (S.next(0, u0) && tid < 256) { const int row = u0.pm * BM + tid; float a0 = 0.f, a1 = 0.f;
#pragma unroll
            for (int k = 0; k < 8; ++k) { a0 += sp[(size_t)k * MT + row]; a1 += sm[(size_t)k * MT + row]; }
            const float rp = rsqrtf(a0 * (1.0f / DPOOL) + EPS), rsm = rsqrtf(a1 * (1.0f / DSSM) + EPS); XR[tid] = (f32x2){rp / rsm, rsm}; }
        __syncthreads();
        const int wr_ = tid >> 8, fr_ = tid & 15;
#pragma unroll
        for (int ai = 0; ai < 2; ++ai)
#pragma unroll
            for (int m = 0; m < 4; ++m) ratio[ai][m] = XR[ai * HALF + wr_ * 64 + m * 16 + fr_].x;
    }
    __device__ __forceinline__ void mid(Acc& acc, int wr, int fr) const {
#pragma unroll
        for (int ai = 0; ai < 2; ++ai)
#pragma unroll
            for (int m = 0; m < 4; ++m) { const float ratio = this->ratio[ai][m];
#pragma unroll
                for (int bj = 0; bj < 2; ++bj)
#pragma unroll
                    for (int n = 0; n < 2; ++n) acc[ai][bj][m][n] = acc[ai][bj][m][n] * ratio; }
    }
    __device__ __forceinline__ void fused(Acc& acc, const Unit& u, int wr, int wc, int fr, int fq, LAS unsigned char* lds, int wid, int lane) const {
        LAS float* P = (LAS float*)lds;
        const int col0 = u.pn * BM + wc * 32 + 8 * fq;
        u32x4 xw[2][4][2];
#pragma unroll
        for (int ai = 0; ai < 2; ++ai)
#pragma unroll
            for (int m = 0; m < 4; ++m)
#pragma unroll
                for (int bj = 0; bj < 2; ++bj) xw[ai][m][bj] = *(const u32x4*)(xb + (size_t)(u.pm * BM + ai * HALF + wr * 64 + m * 16 + fr) * DM + col0 + bj * HALF);
#pragma unroll
        for (int ai = 0; ai < 2; ++ai)
#pragma unroll
            for (int m = 0; m < 4; ++m) {
                const int lr = ai * HALF + wr * 64 + m * 16 + fr, row = u.pm * BM + lr; const float rs = XR[lr].y; float q = 0.f;
                const size_t prow = (size_t)(row >> 12) * PADROWS + 1 + (row & 4095);
#pragma unroll
                for (int bj = 0; bj < 2; ++bj) {
                    const int c = col0 + bj * HALF;
                    f32x4 x0, x1; unpack8(xw[ai][m][bj], x0, x1);
                    const f32x4 h0 = x0 + acc[ai][bj][m][0] * rs, h1v = x1 + acc[ai][bj][m][1] * rs;
                    q += sumsq8(h0, h1v);
                    st_wt16(h1b + prow * DM + c, pack8(h0, h1v));
                }
                q += __shfl_xor(q, 16); q += __shfl_xor(q, 32);
                if (fq == 0) P[lr * 4 + wc] = q;
            }
        LDS_WAIT(); __builtin_amdgcn_s_barrier(); asm volatile("" ::: "memory");
        const int tid = wid * 64 + lane;
        if (tid < 256) ss[(size_t)u.pn * MT + u.pm * BM + tid] = (P[tid * 4 + 0] + P[tid * 4 + 1]) + (P[tid * 4 + 2] + P[tid * 4 + 3]);
    }
};
struct EpiUp {
    static constexpr bool PERM = true, AFTER_DRAIN = false, HAS_MID = false; static constexpr int MID_T = 0; static constexpr bool HAS_PRE = true, HAS_UNIT = true;
    LAS float* rsl; const float* cw; const float* cb; bf16_t* act;
    const float* ssh1;
    static constexpr int TAB_OFF = XTRA_OFF + 6 * 256 * 4;
    static_assert(TAB_OFF + 2 * 4096 <= LDSCTL_OFF, "two filter slices (double-buffered by unit parity: waves leave the previous epilogue at different times) fit in the spare LDS");
    __device__ __forceinline__ void unit_top(const Unit& u, int tid, LAS unsigned char* lds) const {
        const int w = __builtin_amdgcn_readfirstlane(tid >> 6), l = tid & 63;
        if (w < 4) { const int row = 2 * w + (l >> 5), fc = 128 * u.pn + (l & 31) * 4, off = (row >= 4 ? DFF : 0) + fc;
            const float* src = (row & 3) < 3 ? cw + (row & 3) * DFF2 + off : cb + off;
            __builtin_amdgcn_global_load_lds((const unsigned*)src, (LAS unsigned*)(lds + TAB_OFF + (u.aux & 1) * 4096 + w * 1024), 16, 0, 0); }
    }
    template <class Sched> __device__ __forceinline__ void pre(const Sched& S, int tid) {
        if (tid < 256) {
#pragma unroll
            for (int i = 0; i < 6; ++i) { Unit uu; if (S.next(i, uu)) { const int t = UPROWS * uu.pm + tid - 1; const bool in = (t >= 0 && t < SEQ && tid < 254); const int tok = uu.g * SEQ + (in ? t : 0);
                const float sq = (ssh1[tok] + ssh1[MT + tok]) + (ssh1[2 * MT + tok] + ssh1[3 * MT + tok]); rsl[i * 256 + tid] = in ? rsqrtf(sq * (1.0f / DM) + EPS) : 0.f; } } }
        __syncthreads();
    }
    __device__ __forceinline__ void operator()(Acc& acc, const Unit& u, int wr, int wc, int fr, int fq) const {
        const int j = u.pm, b = u.g;
#pragma unroll
        for (int ai = 0; ai < 2; ++ai)
#pragma unroll
            for (int m = 0; m < 4; ++m) {
                const float rs = rsl[u.aux * 256 + 126 * wr + 8 * fr + 4 * ai + m];
#pragma unroll
                for (int bj = 0; bj < 2; ++bj)
#pragma unroll
                    for (int n = 0; n < 2; ++n) acc[ai][bj][m][n] = acc[ai][bj][m][n] * rs;
            }
        const int f0 = 128 * u.pn + 32 * wc + 8 * fq;
        u32x2 keep[8];
#pragma unroll
        for (int n = 0; n < 2; ++n) {
            const int fc = f0 + 4 * n;
            const LAS float* tab = rsl + 6 * 256 + (u.aux & 1) * 1024 + 32 * wc + 8 * fq + 4 * n;
            const f32x4 wv0 = *(const LAS f32x4*)(tab), wv1 = *(const LAS f32x4*)(tab + 128), wv2 = *(const LAS f32x4*)(tab + 256), bvv = *(const LAS f32x4*)(tab + 384);
            const f32x4 wg0 = *(const LAS f32x4*)(tab + 512), wg1 = *(const LAS f32x4*)(tab + 640), wg2 = *(const LAS f32x4*)(tab + 768), bgv = *(const LAS f32x4*)(tab + 896);
#pragma unroll
            for (int ai = 0; ai < 2; ++ai) {
                f32x4 pv, pg, nv, ng;
#pragma unroll
                for (int i = 0; i < 4; ++i) {
                    if (ai == 0) { pv[i] = dppz<0x111>(acc[1][0][3][n][i]); pg[i] = dppz<0x111>(acc[1][1][3][n][i]); nv[i] = acc[1][0][0][n][i]; ng[i] = acc[1][1][0][n][i]; }
                    else         { pv[i] = acc[0][0][3][n][i]; pg[i] = acc[0][1][3][n][i]; nv[i] = dppz<0x101>(acc[0][0][0][n][i]); ng[i] = dppz<0x101>(acc[0][1][0][n][i]); }
                }
#pragma unroll
                for (int m = 0; m < 4; ++m) {
                    const f32x4 cv = acc[ai][0][m][n], cg = acc[ai][1][m][n];
                    const f32x4 v_prev = m > 0 ? acc[ai][0][m - 1][n] : pv, g_prev = m > 0 ? acc[ai][1][m - 1][n] : pg;
                    const f32x4 v_next = m < 3 ? acc[ai][0][m + 1][n] : nv, g_next = m < 3 ? acc[ai][1][m + 1][n] : ng;
                    const f32x4 vv = bvv + wv0 * v_prev + wv1 * cv + wv2 * v_next;
                    const f32x4 gg = bgv + wg0 * g_prev + wg1 * cg + wg2 * g_next;
                    const f32x4 o = vv * gg * fast_sigmoid4(gg);
                    const u32x2 pk = pack4(o); const int gi = ai * 4 + m;
                    if (n == 0) keep[gi] = pk;
                    else { const int w = 8 * fr + 4 * ai + m, t = UPROWS * j + 126 * wr + w - 1;
                           if (t >= 0 && t < SEQ && w >= 1 && w <= 126) { u32x4 wv; wv.x = keep[gi].x; wv.y = keep[gi].y; wv.z = pk.x; wv.w = pk.y; st_wt16(act + (size_t)(b * SEQ + t) * DFF + f0, wv); } }
                }
            }
        }
    }
};
struct EpiDown {
    static constexpr bool PERM = true, AFTER_DRAIN = true, HAS_MID = false; static constexpr int MID_T = 0; static constexpr bool HAS_PRE = false, HAS_UNIT = false;
    const bf16_t* h1b; float* out; const float* gfin; float* ss;
    __device__ __forceinline__ void fused(Acc& acc, const Unit& u, int wr, int wc, int fr, int fq, LAS unsigned char* lds, int wid, int lane) const {
        LAS float* P = (LAS float*)lds;
        LAS float* Sr = (LAS float*)(lds + 8192);
        const int col0 = u.pn * BM + wc * 32 + 8 * fq;
#pragma unroll
        for (int ai = 0; ai < 2; ++ai)
#pragma unroll
            for (int m = 0; m < 4; ++m) {
                const int lr = ai * HALF + wr * 64 + m * 16 + fr, row = u.pm * BM + lr; float q = 0.f;
                const size_t prow = (size_t)(row >> 12) * PADROWS + 1 + (row & 4095);
#pragma unroll
                for (int bj = 0; bj < 2; ++bj) {
                    f32x4 b0, b1; unpack8(*(const u32x4*)(h1b + prow * DM + col0 + bj * HALF), b0, b1);
                    const f32x4 h0 = b0 + acc[ai][bj][m][0], h1v = b1 + acc[ai][bj][m][1];
                    acc[ai][bj][m][0] = h0; acc[ai][bj][m][1] = h1v;
                    q += sumsq8(h0, h1v);
                }
                q += __shfl_xor(q, 16); q += __shfl_xor(q, 32);
                if (fq == 0) P[lr * 4 + wc] = q;
            }
        LDS_WAIT(); __builtin_amdgcn_s_barrier(); asm volatile("" ::: "memory");
        const int tid = wid * 64 + lane;
        f32x4 gg[2][2];
#pragma unroll
        for (int bj = 0; bj < 2; ++bj) { gg[bj][0] = *(const f32x4*)(gfin + col0 + bj * HALF); gg[bj][1] = *(const f32x4*)(gfin + col0 + bj * HALF + 4); }
        if (tid < 256) { unsigned* sr = (unsigned*)ss + u.pm * BM + tid;
            __hip_atomic_store(sr + (size_t)u.pn * MT, __builtin_bit_cast(unsigned, (P[tid * 4 + 0] + P[tid * 4 + 1]) + (P[tid * 4 + 2] + P[tid * 4 + 3])), __ATOMIC_RELAXED, __HIP_MEMORY_SCOPE_AGENT);
            unsigned v0, v1, v2, v3, sp = 0;
            for (;;) {
                v0 = __hip_atomic_load(sr, __ATOMIC_RELAXED, __HIP_MEMORY_SCOPE_AGENT); v1 = __hip_atomic_load(sr + MT, __ATOMIC_RELAXED, __HIP_MEMORY_SCOPE_AGENT);
                v2 = __hip_atomic_load(sr + 2 * MT, __ATOMIC_RELAXED, __HIP_MEMORY_SCOPE_AGENT); v3 = __hip_atomic_load(sr + 3 * MT, __ATOMIC_RELAXED, __HIP_MEMORY_SCOPE_AGENT);
                if ((v0 != 0xFFFFFFFFu && v1 != 0xFFFFFFFFu && v2 != 0xFFFFFFFFu && v3 != 0xFFFFFFFFu) || ++sp > (1u << 20)) break;
                __builtin_amdgcn_s_sleep(1); }
            const float s = (__builtin_bit_cast(float, v0) + __builtin_bit_cast(float, v1)) + (__builtin_bit_cast(float, v2) + __builtin_bit_cast(float, v3));
            Sr[tid] = rsqrtf(s * (1.0f / DM) + EPS); }
        LDS_WAIT(); __builtin_amdgcn_s_barrier(); asm volatile("" ::: "memory");
#pragma unroll
        for (int bj = 0; bj < 2; ++bj) {
            const int c = col0 + bj * HALF; const f32x4 g0 = gg[bj][0], g1 = gg[bj][1];
#pragma unroll
            for (int ai = 0; ai < 2; ++ai)
#pragma unroll
                for (int m = 0; m < 4; ++m) { const int lr = ai * HALF + wr * 64 + m * 16 + fr; const float r = Sr[lr]; float* o = out + (size_t)(u.pm * BM + lr) * DM + c;
                    *(f32x4*)o = acc[ai][bj][m][0] * r * g0; *(f32x4*)(o + 4) = acc[ai][bj][m][1] * r * g1; }
        }
    }
};

struct OrdOne { Unit u; __device__ bool next(int i, Unit& o) const { if (i > 0) return false; o = u; return true; } };
struct OrdSsmB { int c; __device__ bool next(int i, Unit& u) const { if (i > 0 || c >= 128) return false; const int x = c & 7, k = c >> 3; u.g = x * 4 + (k >> 2); u.pm = k & 3; u.pn = 0; u.aux = 0; return true; } };
struct OrdPool { int c; __device__ bool next(int i, Unit& u) const { if (i > 0 || c < 128 || c >= 256) return false; const int cc = c - 128, x = cc & 7, k = cc >> 3; u.pm = x * 8 + (k >> 1); u.pn = k & 1; u.g = u.pn; u.aux = 0; return true; } };
struct OrdGlu  { int c; __device__ bool next(int i, Unit& u) const { if (i > 0 || c >= 128) return false; const int x = c & 7, k = c >> 3; u.pm = x * 8 + (k >> 1); u.pn = k & 1; u.g = 0; u.aux = 0; return true; } };
struct OrdUp { StaticOrder so; __device__ bool next(int i, Unit& u) const { if (!so.next(i, u)) return false; u.g = u.pm / UPT; u.pm = u.pm % UPT; u.aux = i; return true; } };

struct Args { const float* in[24]; float* out; unsigned char* ws; int ph_lo, ph_hi; };

struct Frame { LAS unsigned char* lds; int tid, lane, wave, G, bx; };

struct TrMat { const float* W; int K, N; const float* kg0; const float* kg1; int ksplit; bf16_t* WT; int map; int nitems; };
__device__ __forceinline__ void tr_load(const TrMat& m0, const TrMat& m1, int item, int lane, f32x4 (&v)[8]) {
    const bool second = item >= m0.nitems; const TrMat& m = second ? m1 : m0; const int it = second ? item - m0.nitems : item;
    const int nblk = m.N / 32, kb = it / nblk, nb = it % nblk, k0 = 64 * kb, n0 = 32 * nb, r = lane >> 3, c4 = lane & 7;
#pragma unroll
    for (int i = 0; i < 8; ++i) v[i] = __builtin_nontemporal_load((const f32x4*)(m.W + (size_t)(k0 + 8 * i + r) * m.N + n0 + 4 * c4));
}
__device__ __forceinline__ void tr_store(const TrMat& m0, const TrMat& m1, int item, int lane, const f32x4 (&v)[8], LAS float* scr) {
    const bool second = item >= m0.nitems; const TrMat& m = second ? m1 : m0; const int it = second ? item - m0.nitems : item;
    const int nblk = m.N / 32, kb = it / nblk, nb = it % nblk, k0 = 64 * kb, n0 = 32 * nb, r = lane >> 3, c4 = lane & 7;
#pragma unroll
    for (int i = 0; i < 8; ++i) { const int kk = 8 * i + r, k = k0 + kk; float gn = 1.f; if (m.kg0) gn = (k < m.ksplit ? m.kg0[k] : m.kg1[k - m.ksplit]);
        LAS float* d = scr + kk * 33 + 4 * c4; d[0] = v[i][0] * gn; d[1] = v[i][1] * gn; d[2] = v[i][2] * gn; d[3] = v[i][3] * gn; }
    LDS_WAIT(); asm volatile("" ::: "memory");
    const int c = lane & 7;
#pragma unroll
    for (int j = 0; j < 4; ++j) { const int n = (lane >> 3) + 8 * j; const LAS float* q = scr + (8 * c) * 33 + n;
        u32x4 o; o.x = pk2(q[0 * 33], q[1 * 33]); o.y = pk2(q[2 * 33], q[3 * 33]); o.z = pk2(q[4 * 33], q[5 * 33]); o.w = pk2(q[6 * 33], q[7 * 33]);
        int nr = n0 + n;
        if (m.map == 1) { const int bj = nr / DFF, rem = nr % DFF; nr = 256 * (rem >> 7) + 128 * bj + (rem & 127); }
        *(u32x4*)(m.WT + (size_t)nr * m.K + k0 + 8 * c) = o; }
    LDS_WAIT(); asm volatile("" ::: "memory");
}
__device__ __forceinline__ void tr_run(const TrMat& m0, const TrMat& m1, int first, int stride, int lane, LAS float* scr) {
    const int total = m0.nitems + m1.nitems; f32x4 va[8], vb[8];
    int it = first; if (it < total) tr_load(m0, m1, it, lane, va);
    while (it < total) {
        const int n1 = it + stride; if (n1 < total) tr_load(m0, m1, n1, lane, vb);
        tr_store(m0, m1, it, lane, va, scr);
        if (n1 >= total) break;
        const int n2 = n1 + stride; if (n2 < total) tr_load(m0, m1, n2, lane, va);
        tr_store(m0, m1, n1, lane, vb, scr);
        it = n2;
    }
}

struct SsmLds { LAS float* Bre; LAS float* Bim; LAS float* Cre; LAS float* Cim; LAS float* PAR; LAS float* Pc; LAS float* Kl; };
__device__ __forceinline__ SsmLds ssm_lds(const Frame& F) { SsmLds L; L.Bre = (LAS float*)(F.lds); L.Bim = L.Bre + 2048; L.Cre = L.Bim + 2048; L.Cim = L.Cre + 2048; L.PAR = L.Cim + 2048; L.Pc = L.PAR + 512; L.Kl = L.Pc + 1024; return L; }
__device__ __forceinline__ void ssm_stage(const Args& a, const Frame& F, const SsmLds& L, int g) {
    const float* lnar = a.in[5]; const float* aim = a.in[6]; const float* ldt = a.in[7];
    const float* bre = a.in[8]; const float* bim = a.in[9]; const float* cre = a.in[10]; const float* cim = a.in[11];
    const int tid = F.tid;
    for (int i = tid; i < 2048; i += 512) { const int dir = i >> 10, r = i & 1023;
        L.Bre[i] = bre[((size_t)(dir * NG + g)) * 1024 + r]; L.Bim[i] = bim[((size_t)(dir * NG + g)) * 1024 + r];
        L.Cre[i] = cre[((size_t)(dir * NG + g)) * 1024 + r]; L.Cim[i] = cim[((size_t)(dir * NG + g)) * 1024 + r]; }
    if (tid < 128) { const int dir = tid >> 6, n = tid & 63;
        const float dt = expf(ldt[dir * NG + g]); const float a_re = -expf(lnar[(dir * NG + g) * NS + n]), a_im = aim[(dir * NG + g) * NS + n];
        const float mag = expf(a_re * dt), ang = a_im * dt; const float lam_re = mag * cosf(ang), lam_im = mag * sinf(ang);
        const float den = a_re * a_re + a_im * a_im;
        L.PAR[tid * 4 + 0] = a_re * dt; L.PAR[tid * 4 + 1] = ang;
        L.PAR[tid * 4 + 2] = ((lam_re - 1.0f) * a_re + lam_im * a_im) / den; L.PAR[tid * 4 + 3] = (lam_im * a_re - (lam_re - 1.0f) * a_im) / den; }
    __syncthreads();
}
__device__ __forceinline__ void ssm_build_tb(const Args& a, const Frame& F, const SsmLds& L, int g, int lag0, int nl) {
    bf16_t* KC = (bf16_t*)(a.ws + WS_TB) + (size_t)g * (2 * TCH) * 256;
    bf16_t* TBC = (bf16_t*)(a.ws + WS_TBC) + (size_t)g * K1 * 256;
    const int tid = F.tid;
    { const int li = tid >> 7, dn = tid & 127, lag = lag0 + li; const float ad = L.PAR[dn * 4 + 0], ang = L.PAR[dn * 4 + 1], fr_ = L.PAR[dn * 4 + 2], fi_ = L.PAR[dn * 4 + 3];
      const float mg = expf((float)lag * ad); float sn, cs; sincosf((float)lag * ang, &sn, &cs); const float lr = mg * cs, lim = mg * sn;
      L.Pc[(li * 128 + dn) * 2 + 0] = lr * fr_ - lim * fi_; L.Pc[(li * 128 + dn) * 2 + 1] = lr * fi_ + lim * fr_; }
    __syncthreads();
    { const int li = F.wave >> 1, dir = F.wave & 1, i16 = F.lane & 15, kq = F.lane >> 4; f32x4 kacc = {0.f, 0.f, 0.f, 0.f};
#pragma unroll 8
      for (int kk0 = 0; kk0 < 128; kk0 += 4) { const int kk = kk0 + kq, n = kk >> 1; const bool im = (kk & 1) != 0;
          const float cr_ = L.Cre[dir * 1024 + i16 * 64 + n], ci_ = L.Cim[dir * 1024 + i16 * 64 + n], pr = L.Pc[(li * 128 + dir * 64 + n) * 2], pi = L.Pc[(li * 128 + dir * 64 + n) * 2 + 1];
          const float av = im ? -(cr_ * pi + ci_ * pr) : (cr_ * pr - ci_ * pi);
          const float bv = im ? L.Bim[dir * 1024 + n * 16 + i16] : L.Bre[dir * 1024 + n * 16 + i16];
          kacc = __builtin_amdgcn_mfma_f32_16x16x4f32(av, bv, kacc, 0, 0, 0); }
#pragma unroll
      for (int r = 0; r < 4; ++r) L.Kl[li * 512 + dir * 256 + (kq * 4 + r) * 16 + i16] = kacc[r]; }
    __syncthreads();
    { const int li = tid >> 7, dir = (tid >> 6) & 1, e4 = tid & 63, lag = lag0 + li;
      if (li < nl && !(lag == 0 && dir == 1)) {
          f32x4 v = *(const LAS f32x4*)(L.Kl + li * 512 + dir * 256 + 4 * e4);
          if (lag == 0) v = v + *(const LAS f32x4*)(L.Kl + li * 512 + 256 + 4 * e4);
          const int d = dir == 0 ? (TCH - 1) + lag : (TCH - 1) - lag; u32x2 w; w.x = pk2(v[0], v[1]); w.y = pk2(v[2], v[3]);
          st_wt8(KC + (size_t)d * 256 + 4 * e4, w); } }
    __syncthreads();
    { const int li = tid >> 7, dn = tid & 127, dir = dn >> 6, p = lag0 + li; const float ad = L.PAR[dn * 4 + 0], ang = L.PAR[dn * 4 + 1]; const float e = dir == 0 ? (float)(p + 1) : (float)(TCH - p);
      const float mg = expf(e * ad); float sn, cs; sincosf(e * ang, &sn, &cs); L.Pc[(li * 128 + dn) * 2 + 0] = mg * cs; L.Pc[(li * 128 + dn) * 2 + 1] = mg * sn; }
    __syncthreads();
    for (int li = 0; li < nl; ++li) {
        const int p = lag0 + li, h = tid >> 5, dir = (tid >> 4) & 1, n4 = tid & 15; float v[8];
#pragma unroll
        for (int e = 0; e < 4; ++e) { const int n = 4 * n4 + e; const float cr_ = L.Cre[dir * 1024 + h * 64 + n], ci_ = L.Cim[dir * 1024 + h * 64 + n], pr = L.Pc[(li * 128 + dir * 64 + n) * 2], pi = L.Pc[(li * 128 + dir * 64 + n) * 2 + 1];
            v[2 * e] = cr_ * pr - ci_ * pi; v[2 * e + 1] = -(cr_ * pi + ci_ * pr); }
        u32x4 w; w.x = pk2(v[0], v[1]); w.y = pk2(v[2], v[3]); w.z = pk2(v[4], v[5]); w.w = pk2(v[6], v[7]);
        st_wt16(TBC + (size_t)(16 * p + h) * 256 + dir * 128 + 8 * n4, w);
    }
    __syncthreads();
}
__device__ __forceinline__ void ssm_build_wab(const Args& a, const Frame& F, const SsmLds& L, int g, int jq) {
    bf16_t* WAB = (bf16_t*)(a.ws + WS_WAB) + (size_t)g * 256 * K1;
    const int tid = F.tid;
    if (jq == 0 && tid < 128) { const int dir = tid >> 6, n = tid & 63; const float ad = L.PAR[tid * 4 + 0], ang = L.PAR[tid * 4 + 1];
        const float mg = expf((float)TCH * ad); float sn, cs; sincosf((float)TCH * ang, &sn, &cs); *(f32x2*)((float*)(a.ws + WS_LAMT) + ((size_t)(dir * NG + g) * NS + n) * 2) = (f32x2){mg * cs, mg * sn}; }
    { const int li = tid >> 7, dn = tid & 127, dir = dn >> 6, q = 4 * jq + li; const float ad = L.PAR[dn * 4 + 0], ang = L.PAR[dn * 4 + 1], fr_ = L.PAR[dn * 4 + 2], fi_ = L.PAR[dn * 4 + 3]; const float e = dir == 0 ? (float)(TCH - 1 - q) : (float)q;
      const float mg = expf(e * ad); float sn, cs; sincosf(e * ang, &sn, &cs); const float lr = mg * cs, lim = mg * sn;
      L.Pc[(li * 128 + dn) * 2 + 0] = lr * fr_ - lim * fi_; L.Pc[(li * 128 + dn) * 2 + 1] = lr * fi_ + lim * fr_; }
    __syncthreads();
#pragma unroll
    for (int half = 0; half < 2; ++half) {
        const int li = 2 * half + (tid >> 8), q = 4 * jq + li, t2 = tid & 255, dir = t2 >> 7, n = (t2 >> 1) & 63, part = t2 & 1;
        const float pr = L.Pc[(li * 128 + dir * 64 + n) * 2], pi = L.Pc[(li * 128 + dir * 64 + n) * 2 + 1]; float v[16];
#pragma unroll
        for (int i = 0; i < 16; ++i) { const float br_ = L.Bre[dir * 1024 + n * 16 + i], bi_ = L.Bim[dir * 1024 + n * 16 + i]; v[i] = part == 0 ? (pr * br_ - pi * bi_) : (pr * bi_ + pi * br_); }
        u32x4 w0, w1; w0.x = pk2(v[0], v[1]); w0.y = pk2(v[2], v[3]); w0.z = pk2(v[4], v[5]); w0.w = pk2(v[6], v[7]); w1.x = pk2(v[8], v[9]); w1.y = pk2(v[10], v[11]); w1.z = pk2(v[12], v[13]); w1.w = pk2(v[14], v[15]);
        bf16_t* dst = WAB + (size_t)(dir * 128 + 2 * n + part) * K1 + 16 * q; *(u32x4*)dst = w0; *(u32x4*)(dst + 8) = w1;
    }
    __syncthreads();
}

__device__ __forceinline__ void p0_prologue(const Args& a, const Frame& F) {
    const float* x = a.in[0];
    { const SsmLds L = ssm_lds(F);
      for (int it = F.bx; it < NG * (TCH / 4); it += F.G) { ssm_stage(a, F, L, it / (TCH / 4)); ssm_build_wab(a, F, L, it / (TCH / 4), it % (TCH / 4)); } }
    __syncthreads();
    LAS float* scr = (LAS float*)(F.lds + F.wave * 16384);
    const int gw = F.bx * 8 + F.wave, NGW = F.G * 8;
    { const TrMat m0{a.in[2], DM, DM, a.in[1], a.in[1], DM, (bf16_t*)(a.ws + WS_WIN), 0, (DM / 64) * (DM / 32)}; const TrMat m1{nullptr, 0, 32, nullptr, nullptr, 0, nullptr, 0, 0};
      tr_run(m0, m1, F.wave < 2 ? F.bx * 2 + F.wave : m0.nitems, m0.nitems, F.lane, scr); }
    { bf16_t* PW = (bf16_t*)(a.ws + WS_PW); const float* pw = a.in[3];
      for (int idx = F.bx * 512 + F.tid; idx < 2 * 256 * 256; idx += F.G * 512) { const int pn = idx >> 16, j = (idx >> 8) & 255, k = idx & 255;
          const float v = ((j >> 7) == (k >> 7)) ? pw[((size_t)(2 * pn + (j >> 7)) * 128 + (k & 127)) * 128 + (j & 127)] : 0.f; PW[idx] = (bf16_t)f2bf(v); } }
    { bf16_t* h1b = (bf16_t*)(a.ws + WS_H1B);
      for (int idx = F.bx * 512 + F.tid; idx < BATCH * 256 * (DM / 8); idx += F.G * 512) { const int b = idx / (256 * 128), r = (idx / 128) % 256, c = idx % 128; const int prow = b * PADROWS + (r == 0 ? 0 : 4096 + r);
          *(u32x4*)(h1b + (size_t)prow * DM + 8 * c) = (u32x4){0u, 0u, 0u, 0u}; } }
    { unsigned* s2 = (unsigned*)(a.ws + WS_SSH2);
      for (int idx = F.bx * 512 + F.tid; idx < 4 * MT; idx += F.G * 512) s2[idx] = 0xFFFFFFFFu; }
    { bf16_t* xb = (bf16_t*)(a.ws + WS_XB); float* r0 = (float*)(a.ws + WS_R0);
      LAS unsigned* ctr = (LAS unsigned*)(F.lds + LDSCTL_OFF) + 16;
      for (;;) {
          unsigned r = 0; if (F.lane == 0) r = __hip_atomic_fetch_add(ctr, 1u, __ATOMIC_RELAXED, __HIP_MEMORY_SCOPE_WORKGROUP);
          const bool heavy = F.bx < NG * (TCH / 4), donor = F.bx >= F.G - NG * (TCH / 4);
          r = (unsigned)__builtin_amdgcn_readfirstlane((int)r); if (r >= (heavy ? 48u : donor ? 80u : 64u)) break;
          const int row = r < 64u ? F.bx * 8 + (int)(r & 7u) + NGW * (int)(r >> 3) : (F.bx - (F.G - NG * (TCH / 4))) * 8 + (int)(r & 7u) + NGW * (6 + (int)((r - 64u) >> 3));
          const f32x4* xr = (const f32x4*)(x + (size_t)row * DM) + F.lane; f32x4 v[4]; float s = 0.f;
#pragma unroll
          for (int j = 0; j < 4; ++j) { v[j] = __builtin_nontemporal_load(xr + 64 * j); s += (v[j][0] * v[j][0] + v[j][1] * v[j][1]) + (v[j][2] * v[j][2] + v[j][3] * v[j][3]); }
          s = wave_sum(s); if (F.lane == 0) r0[row] = rsqrtf(s * (1.0f / DM) + EPS);
          u32x2* o = (u32x2*)(xb + (size_t)row * DM) + F.lane;
#pragma unroll
          for (int j = 0; j < 4; ++j) o[64 * j] = pack4(v[j]);
      } }
}

__device__ __forceinline__ void ssm_side(const Args& a, const Frame& F, int first_block) {
    const int nb = F.G - first_block, sb = F.bx - first_block;
    { const SsmLds L = ssm_lds(F);
      const int g = sb >> 2, lag0 = (sb & 3) * 4;
      ssm_stage(a, F, L, g); ssm_build_tb(a, F, L, g, lag0, 4);
      VM_WAIT(); __syncthreads();
      if (F.tid == 0) {
          __hip_atomic_fetch_add((unsigned*)(a.ws + WS_CTL) + CW_TBCNT + 64 * g, 4u, __ATOMIC_RELAXED, __HIP_MEMORY_SCOPE_AGENT); } }
    __syncthreads();
    LAS float* scr = (LAS float*)(F.lds + F.wave * 16384);
    const TrMat m0{a.in[17], DM, DM, a.in[15], a.in[16], DPOOL, (bf16_t*)(a.ws + WS_WOUT), 0, (DM / 64) * (DM / 32)};
    const TrMat m1{a.in[13], DSSM, DSSM, nullptr, nullptr, 0, (bf16_t*)(a.ws + WS_WGLU), 0, (DSSM / 64) * (DSSM / 32)};
    tr_run(m0, m1, sb * 8 + F.wave, nb * 8, F.lane, scr);
    const TrMat m2{a.in[22], DFF, DM, nullptr, nullptr, 0, (bf16_t*)(a.ws + WS_WDOWN), 0, (DFF / 64) * (DM / 32)}; const TrMat m3{nullptr, 0, 32, nullptr, nullptr, 0, nullptr, 0, 0};
    { const int W = nb * 8, n01 = m0.nitems + m1.nitems;
      tr_run(m2, m3, (sb * 8 + F.wave + W - n01 % W) % W, W, F.lane, scr); }
}
__device__ __forceinline__ void tb_wait(const Args& a, const Frame& F, int g) {
    if (F.tid == 0) { unsigned* cnt = (unsigned*)(a.ws + WS_CTL) + CW_TBCNT + 64 * g; unsigned sp = 0;
        while (__hip_atomic_load(cnt, __ATOMIC_RELAXED, __HIP_MEMORY_SCOPE_AGENT) < (unsigned)TCH) { __builtin_amdgcn_s_sleep(2); if (++sp > (1u << 20)) break; }
        __builtin_amdgcn_fence(__ATOMIC_ACQUIRE, "agent"); }
    asm volatile("s_waitcnt vmcnt(0)" ::: "memory");
    __syncthreads();
}
__device__ __forceinline__ void p4_side(const Args& a, const Frame& F, int first_block) {
    const int nb = F.G - first_block, sb = F.bx - first_block;
    LAS float* scr = (LAS float*)(F.lds + F.wave * 16384);
    const TrMat m0{a.in[19], DM, DFF2, a.in[18], a.in[18], DM, (bf16_t*)(a.ws + WS_WUP), 1, (DM / 64) * (DFF2 / 32)};
    const TrMat m1{nullptr, 0, 32, nullptr, nullptr, 0, nullptr, 0, 0};
    tr_run(m0, m1, sb * 8 + F.wave, nb * 8, F.lane, scr);
}

__device__ __forceinline__ void p2_pooled(const Args& a, const Frame& F, int first_block) {
    const bf16_t* up = (const bf16_t*)(a.ws + WS_UPOOL); bf16_t* po = (bf16_t*)(a.ws + WS_POOLED);
    const int gw = (F.bx - first_block) * 8 + F.wave, NGW = (F.G - first_block) * 8;
    const int c0 = 8 * F.lane, half = 1 << (F.lane >> 4);
    for (int blk = gw; blk < MT / 4; blk += NGW) {
        const int row0 = blk * 4, b = row0 / SEQ, t0 = row0 % SEQ;
        u32x4 w[19];
#pragma unroll
        for (int o = 0; o < 19; ++o) { int q = t0 + o - 8; q = q < 0 ? 0 : (q >= SEQ ? SEQ - 1 : q); w[o] = *(const u32x4*)(up + (size_t)(b * SEQ + q) * DPOOL + c0); }
#pragma unroll
        for (int r = 0; r < 4; ++r) {
            f32x4 s0 = {0.f, 0.f, 0.f, 0.f}, s1 = {0.f, 0.f, 0.f, 0.f}; float cnt = 0.f;
#pragma unroll
            for (int d = -8; d < 8; ++d) { const int q = t0 + r + d; const float m = (d >= -half && d < half && q >= 0 && q < SEQ) ? 1.f : 0.f; f32x4 a0, a1; unpack8(w[r + d + 8], a0, a1); s0 = s0 + a0 * m; s1 = s1 + a1 * m; cnt += m; }
            f32x4 c0v, c1v; unpack8(w[r + 8], c0v, c1v);
            const float inv = __builtin_amdgcn_rcpf(cnt);
            *(u32x4*)(po + (size_t)(row0 + r) * DPOOL + c0) = pack8(s0 * inv - c0v, s1 * inv - c1v);
        }
    }
}

__global__ void __launch_bounds__(512, 2) mk_fwd(Args args) {
    extern __shared__ __attribute__((aligned(16))) unsigned char lds_raw[];
    Frame F; F.lds = (LAS unsigned char*)lds_raw; F.tid = threadIdx.x; F.lane = F.tid & 63; F.wave = __builtin_amdgcn_readfirstlane(F.tid >> 6); F.G = gridDim.x; F.bx = blockIdx.x;
    volatile LAS unsigned* MISC = (volatile LAS unsigned*)(F.lds + LDSCTL_OFF);
    for (int u = F.tid; u < (LDS_BYTES - LDSCTL_OFF) / 4; u += 512) ((LAS unsigned*)(F.lds + LDSCTL_OFF))[u] = 0u;
    __syncthreads();
    unsigned char* ws = args.ws;
    XcdBarrier bar = xcd_barrier_post((unsigned*)(ws + WS_CTL), MISC + 8);
    const int lo = args.ph_lo, hi = args.ph_hi;
#define IN(k) (lo <= (k) && (k) < hi)
#define BOTH(k) (IN(k) && IN((k) == 2 ? 4 : (k) + 1))
    if (IN(0)) { p0_prologue(args, F); if (BOTH(0)) xcd_barrier(bar, F.tid); }
    if (IN(1)) { F.lane = lane_id_fresh(); F.tid = F.wave * 64 + F.lane;
        GemmDesc g{(const char*)(ws + WS_XB), (const char*)(ws + WS_WIN), 256L * DM * 2, 0, 256L * DM * 2, 0, 128L * DM * 2, 128L * DM * 2, 128, 128, DM / BK};
        unsigned vA[2], vB[2]; voff_std(vA, DM, false, F.tid); voff_std(vB, DM, true, F.tid);
        StaticOrder S; S.init(MT / BM, DM / BM, F.G, F.bx);
        EpiU E{(const float*)(ws + WS_R0), (bf16_t*)(ws + WS_UPOOL), (bf16_t*)(ws + WS_USSM), (LAS float*)(F.lds + XTRA_OFF)};
        gemm_phase<EpiU, StaticOrder, true>(F.lds, g, vA, vB, S, E, F.tid, nullptr);
        if (BOTH(1)) xcd_barrier(bar, F.tid);
    }
    if (IN(2)) { F.lane = lane_id_fresh(); F.tid = F.wave * 64 + F.lane;
        if (F.bx < 128) {
            OrdSsmB S0{F.bx}; Unit u0; S0.next(0, u0);
            { GemmDesc g{(const char*)(ws + WS_USSM), (const char*)(ws + WS_WAB), 256L * ROWLEN * 2, (long)NCR * ROWLEN * 2, 0, 256L * K1 * 2, 4L * ROWLEN * 2, 128L * K1 * 2, 128, 128, K1 / BK};
              unsigned vA[2], vB[2]; voff_std(vB, K1, false, F.tid);
#pragma unroll
              for (int i = 0; i < 2; ++i) { int R, C; stage_rc(F.tid * 16 + i * 8192, R, C);
                  vA[i] = (unsigned)(((128 * (R >> 6) + 8 * (R & 15) + ((R >> 4) & 3)) * ROWLEN + C) * 2); }
              OrdOne S{u0}; EpiScan E{(const float*)(ws + WS_LAMT), (bf16_t*)(ws + WS_USSM), (LAS float*)(F.lds + EpiScan::LAML_OFF)};
              gemm_phase<EpiScan, OrdOne, false>(F.lds, g, vA, vB, S, E, F.tid, nullptr); }
            F.lane = lane_id_fresh(); F.tid = F.wave * 64 + F.lane;
            { GemmDesc g{(const char*)(ws + WS_USSM), (const char*)(ws + WS_TB), 256L * ROWLEN * 2, (long)NCR * ROWLEN * 2, 0, (2L * TCH) * 512, 128L * ROWLEN * 2, 8L * 512, 128, -4L * 512, ROWLEN / BK,
                         (const char*)(ws + WS_TBC), 0, (long)K1 * 512, 128L * 512, 128, K1 / BK};
              unsigned vA[2], vB[2], vB2[2]; voff_std(vA, ROWLEN, false, F.tid); voff_std(vB2, 256, true, F.tid);
#pragma unroll
              for (int i = 0; i < 2; ++i) { int R, C; stage_rc(F.tid * 16 + i * 8192, R, C); const int Rb = (R & ~31) + perm32(R & 31);
                  vB[i] = (unsigned)((((Rb >> 4) - (C >> 4) + (TCH - 1)) * 256 + (Rb & 15) * 16 + (C & 15)) * 2); }
              asm volatile("" : "+v"(vA[0]), "+v"(vA[1]), "+v"(vB[0]), "+v"(vB[1]), "+v"(vB2[0]), "+v"(vB2[1]));
              tb_wait(args, F, u0.g);
              OrdOne S{u0}; EpiZ E{(const bf16_t*)(ws + WS_USSM), args.in[12], (bf16_t*)(ws + WS_ZG)};
              gemm_phase<EpiZ, OrdOne, true, true>(F.lds, g, vA, vB, S, E, F.tid, nullptr, vB2); }
        } else { ssm_side(args, F, 128); p2_pooled(args, F, 128); }
        if (BOTH(2)) xcd_barrier(bar, F.tid);
    }
    if (IN(4)) { F.lane = lane_id_fresh(); F.tid = F.wave * 64 + F.lane;
        if (F.bx < 128) {
            constexpr long GSTR = (long)MT * 32;
            GemmDesc g{(const char*)(ws + WS_ZG), (const char*)(ws + WS_WGLU), 256L * 32, 0, 256L * DSSM * 2, 0, 128L * 32, 128L * DSSM * 2, 4 * GSTR, 128, DSSM / BK};
            unsigned vA[2], vB[2]; voff_std(vB, DSSM, true, F.tid);
#pragma unroll
            for (int i = 0; i < 2; ++i) { int R, C; stage_rc(F.tid * 16 + i * 8192, R, C); vA[i] = (unsigned)(R * 32 + (C >> 4) * (int)GSTR + (C & 15) * 2); }
            OrdGlu S{F.bx}; EpiGlu E{args.in[14], (const bf16_t*)(ws + WS_ZG), (bf16_t*)(ws + WS_YCAT), (float*)(ws + WS_SSSSM)};
            gemm_phase<EpiGlu, OrdGlu, true>(F.lds, g, vA, vB, S, E, F.tid, nullptr);
        } else {
            GemmDesc g{(const char*)(ws + WS_POOLED), (const char*)(ws + WS_PW), 256L * DPOOL * 2, 256L * 2, 256L * 256 * 2, 0, 128L * DPOOL * 2, 128L * 256 * 2, 128, 128, 256 / BK};
            unsigned vA[2], vB[2]; voff_std(vA, DPOOL, false, F.tid); voff_std(vB, 256, true, F.tid);
            OrdPool S{F.bx}; EpiPool E{args.in[4], (bf16_t*)(ws + WS_YCAT), (float*)(ws + WS_SSPOOL)};
            gemm_phase<EpiPool, OrdPool, true>(F.lds, g, vA, vB, S, E, F.tid, nullptr);

            __syncthreads();
            p4_side(args, F, 128);
        }
        if (BOTH(4)) xcd_barrier(bar, F.tid);
    }
    if (IN(5)) { F.lane = lane_id_fresh(); F.tid = F.wave * 64 + F.lane;
        StaticOrder S; S.init(MT / BM, DM / BM, F.G, F.bx);
        LAS f32x2* XR = (LAS f32x2*)(F.lds + XTRA_OFF);
        GemmDesc g{(const char*)(ws + WS_YCAT), (const char*)(ws + WS_WOUT), 256L * DM * 2, 0, 256L * DM * 2, 0, 128L * DM * 2, 128L * DM * 2, 128, 128, DM / BK};
        unsigned vA[2], vB[2]; voff_std(vA, DM, false, F.tid); voff_std(vB, DM, true, F.tid);
        EpiOut E{(const bf16_t*)(ws + WS_XB), (bf16_t*)(ws + WS_H1B), (float*)(ws + WS_SSH1), XR, {{0.f, 0.f, 0.f, 0.f}, {0.f, 0.f, 0.f, 0.f}}, (const float*)(ws + WS_SSPOOL), (const float*)(ws + WS_SSSSM)};
        gemm_phase<EpiOut, StaticOrder, false>(F.lds, g, vA, vB, S, E, F.tid, nullptr);
        if (BOTH(5)) xcd_barrier(bar, F.tid);
    }
    if (IN(6)) { F.lane = lane_id_fresh(); F.tid = F.wave * 64 + F.lane;
        GemmDesc g{(const char*)(ws + WS_H1B), (const char*)(ws + WS_WUP), (long)UPROWS * DM * 2, (long)PADROWS * DM * 2, 256L * DM * 2, 0, 4L * DM * 2, 128L * DM * 2, 128, 128, DM / BK};
        unsigned vA[2], vB[2]; voff_std(vB, DM, true, F.tid);
#pragma unroll
        for (int i = 0; i < 2; ++i) { int R, C; stage_rc(F.tid * 16 + i * 8192, R, C); vA[i] = (unsigned)(((126 * (R >> 6) + 8 * (R & 15) + ((R >> 4) & 3)) * DM + C) * 2); }
        OrdUp S; S.so.init(BATCH * UPT, DFF2 / BM, F.G, F.bx);
        LAS float* RSL = (LAS float*)(F.lds + XTRA_OFF);
        EpiUp E{RSL, args.in[20], args.in[21], (bf16_t*)(ws + WS_ACT), (const float*)(ws + WS_SSH1)};
        gemm_phase<EpiUp, OrdUp, true>(F.lds, g, vA, vB, S, E, F.tid, nullptr);
        if (BOTH(6)) xcd_barrier(bar, F.tid);
    }
    if (IN(7)) { F.lane = lane_id_fresh(); F.tid = F.wave * 64 + F.lane;
        GemmDesc g{(const char*)(ws + WS_ACT), (const char*)(ws + WS_WDOWN), 256L * DFF * 2, 0, 256L * DFF * 2, 0, 128L * DFF * 2, 128L * DFF * 2, 128, 128, DFF / BK};
        unsigned vA[2], vB[2]; voff_std(vA, DFF, false, F.tid); voff_std(vB, DFF, true, F.tid);
        StaticOrder S; S.init(MT / BM, DM / BM, F.G, F.bx);
        EpiDown E{(const bf16_t*)(ws + WS_H1B), args.out, args.in[23], (float*)(ws + WS_SSH2)};
        gemm_phase<EpiDown, StaticOrder, false>(F.lds, g, vA, vB, S, E, F.tid, nullptr);
    }
#undef IN
#undef BOTH
}
}

extern "C" void kernel_launch(void* const* d_in, const int* in_sizes, int n_in, void* d_out, int out_size, void* d_ws, size_t ws_size, hipStream_t stream) {
    static int grid = 0;
    if (grid == 0) {
        int dev = 0, cus = 0, per_cu = 0;
        if (n_in != 24 || out_size != MT * DM || ws_size < mk::WS_END) { fprintf(stderr, "kernel_launch: unexpected problem (n_in %d out %d ws %zu)\n", n_in, out_size, ws_size); grid = -1; return; }
        if (hipGetDevice(&dev) != hipSuccess || hipDeviceGetAttribute(&cus, hipDeviceAttributeMultiprocessorCount, dev) != hipSuccess) { grid = -1; return; }
        if (hipFuncSetAttribute((const void*)mk::mk_fwd, hipFuncAttributeMaxDynamicSharedMemorySize, mk::LDS_BYTES) != hipSuccess) { fprintf(stderr, "kernel_launch: hipFuncSetAttribute failed\n"); grid = -1; return; }
        if (hipOccupancyMaxActiveBlocksPerMultiprocessor(&per_cu, (const void*)mk::mk_fwd, 512, mk::LDS_BYTES) != hipSuccess || per_cu < 1) { fprintf(stderr, "kernel_launch: occupancy query says %d blocks/CU; nothing launched\n", per_cu); (void)hipGetLastError(); grid = -1; return; }
        grid = cus;
        if (grid != 256) { fprintf(stderr, "kernel_launch: built for a 256-CU device, found %d CUs\n", cus); grid = -1; return; }
    }
    if (grid < 0) return;
    (void)in_sizes;
    (void)hipMemsetAsync((char*)d_ws + mk::WS_CTL, 0, mk::CTL_ZERO_BYTES, stream);
    mk::Args a{};
    for (int i = 0; i < 24; ++i) a.in[i] = (const float*)d_in[i];
    a.out = (float*)d_out; a.ws = (unsigned char*)d_ws; a.ph_lo = 0; a.ph_hi = 8;
    hipLaunchKernelGGL(mk::mk_fwd, dim3(grid), dim3(512), mk::LDS_BYTES, stream, a);
}
```
